# Optimizing an MI355X kernel written in HIP

```python
import math
import jax, jax.numpy as jnp
from jax import lax
import numpy as np

D_MODEL = 1024
BATCH = 8
SEQ = 4096
DEPTH = 2

NORM_EPS = 1e-6
MLA_HEADS = 8
QK_NOPE_DIM = 64
QK_ROPE_DIM = 32
QK_HEAD_DIM = QK_NOPE_DIM + QK_ROPE_DIM
V_HEAD_DIM = 64
Q_LORA_RANK = 256
KV_LORA_RANK = 128
ROPE_THETA = 10000.0
Q_BLOCK = 128
S5_WIDTH = D_MODEL // 2
S5_GROUP = 16
S5_GROUPS = S5_WIDTH // S5_GROUP
S5_STATE = 64
S5_DT_MIN = 1e-3
S5_DT_MAX = 1e-1
POOL_WINDOWS = (2, 4, 8, 16)
POOL_WIDTH = D_MODEL // 2
POOL_GROUP = POOL_WIDTH // len(POOL_WINDOWS)
SGU_WIDTH = D_MODEL // 2
SGU_HEADS = 4
SGU_HEAD_DIM = SGU_WIDTH // SGU_HEADS
SGU_CHUNK = 128
N_EXPERTS = 32
TOP_K = 4
EXPERT_FF = D_MODEL
SWIGLU_ALPHA = 1.702
SWIGLU_LIMIT = 7.0
MOE_BLOCK = 128
EVEN_IN = Q_LORA_RANK + KV_LORA_RANK + QK_ROPE_DIM + S5_WIDTH
EVEN_MIX = MLA_HEADS * V_HEAD_DIM + S5_WIDTH
ODD_IN = POOL_WIDTH + 2 * SGU_WIDTH
ODD_MIX = POOL_WIDTH + SGU_WIDTH

kernel_name = "hybrid_mla_s5_pool_sgu_moe_adaln"


def rmsnorm(x, g):
    xf = x.astype(jnp.float32)
    y = xf * lax.rsqrt(jnp.mean(xf * xf, axis=-1, keepdims=True) + NORM_EPS)
    return (y * g.astype(jnp.float32)).astype(x.dtype)


def rope_tables(positions):
    half = QK_ROPE_DIM // 2
    inv_freq = 1.0 / (ROPE_THETA ** (jnp.arange(half, dtype=jnp.float32) / half))
    ang = positions.astype(jnp.float32)[..., None] * inv_freq
    return jnp.cos(ang), jnp.sin(ang)


def apply_rope(x, cos, sin):
    x1, x2 = jnp.split(x, 2, axis=-1)
    cs = cos[:, :, None, :]
    sn = sin[:, :, None, :]
    return jnp.concatenate([x1 * cs - x2 * sn, x1 * sn + x2 * cs], axis=-1).astype(x.dtype)


def causal_attention(q, k, v):
    B, S, H, Dq = q.shape
    nb = S // Q_BLOCK
    scale = Dq ** -0.5
    qb = q.reshape(B, nb, Q_BLOCK, H, Dq).swapaxes(0, 1)
    kpos = jnp.arange(S)

    def one_block(args):
        q_blk, i = args
        s = jnp.einsum('bqhd,bkhd->bhqk', q_blk, k, preferred_element_type=jnp.float32) * scale
        qpos = i * Q_BLOCK + jnp.arange(Q_BLOCK)
        s = jnp.where(kpos[None, :] <= qpos[:, None], s, -jnp.inf)
        p = jax.nn.softmax(s, axis=-1)
        return jnp.einsum('bhqk,bkhd->bqhd', p.astype(v.dtype), v)

    out = lax.map(one_block, (qb, jnp.arange(nb)))
    return out.swapaxes(0, 1).reshape(B, S, H, v.shape[-1])


def mla_mixer(q_c, kv_c, k_pe, cos, sin, q_norm_g, w_uq, kv_norm_g, w_ukv, q_head_g, k_head_g):
    B, S, _ = q_c.shape
    q = jnp.einsum('bsr,rhd->bshd', rmsnorm(q_c, q_norm_g), w_uq)
    kv = jnp.einsum('bsr,rhd->bshd', rmsnorm(kv_c, kv_norm_g), w_ukv)
    k_nope, v = kv[..., :QK_NOPE_DIM], kv[..., QK_NOPE_DIM:]
    k_rope = jnp.broadcast_to(k_pe[:, :, None, :], (B, S, MLA_HEADS, QK_ROPE_DIM))
    q = rmsnorm(q, q_head_g)
    k = rmsnorm(jnp.concatenate([k_nope, k_rope], axis=-1), k_head_g)
    q = jnp.concatenate([q[..., :QK_NOPE_DIM], apply_rope(q[..., QK_NOPE_DIM:], cos, sin)], axis=-1)
    k = jnp.concatenate([k[..., :QK_NOPE_DIM], apply_rope(k[..., QK_NOPE_DIM:], cos, sin)], axis=-1)
    return causal_attention(q, k, v).reshape(B, S, MLA_HEADS * V_HEAD_DIM)


def _complex_affine_combine(e1, e2):
    a1r, a1i, b1r, b1i = e1
    a2r, a2i, b2r, b2i = e2
    return (a1r * a2r - a1i * a2i,
            a1r * a2i + a1i * a2r,
            a2r * b1r - a2i * b1i + b2r,
            a2r * b1i + a2i * b1r + b2i)


def s5_mixer(u, a_re, a_im, log_dt, b_re, b_im, c_re, c_im, d_skip, glu_w, glu_b):
    B, S, W = u.shape
    f32 = jnp.float32
    uf = u.astype(f32)
    ug = uf.reshape(B, S, S5_GROUPS, S5_GROUP)
    dt = jnp.exp(log_dt.astype(f32))[:, None]
    lam_re = jnp.minimum(a_re.astype(f32), -1e-4)
    lam_im = a_im.astype(f32)
    mag = jnp.exp(lam_re * dt)
    ab_re = mag * jnp.cos(lam_im * dt)
    ab_im = mag * jnp.sin(lam_im * dt)
    den = lam_re * lam_re + lam_im * lam_im
    num_re = ab_re - 1.0
    f_re = (num_re * lam_re + ab_im * lam_im) / den
    f_im = (ab_im * lam_re - num_re * lam_im) / den
    br = b_re.astype(f32)
    bi = b_im.astype(f32)
    bb_re = f_re[..., None] * br - f_im[..., None] * bi
    bb_im = f_re[..., None] * bi + f_im[..., None] * br
    drive_re = jnp.einsum('bsgi,gpi->bsgp', ug, bb_re)
    drive_im = jnp.einsum('bsgi,gpi->bsgp', ug, bb_im)
    a_seq_re = jnp.broadcast_to(ab_re, (S,) + ab_re.shape)
    a_seq_im = jnp.broadcast_to(ab_im, (S,) + ab_im.shape)

    def scan_one(dr, di):
        _, _, xr, xi = lax.associative_scan(_complex_affine_combine, (a_seq_re, a_seq_im, dr, di), axis=0)
        return xr, xi

    st_re, st_im = jax.vmap(scan_one)(drive_re, drive_im)
    y = (jnp.einsum('gip,bsgp->bsgi', c_re.astype(f32), st_re)
         - jnp.einsum('gip,bsgp->bsgi', c_im.astype(f32), st_im))
    y = y.reshape(B, S, W) + d_skip.astype(f32) * uf
    g = jax.nn.gelu(y)
    out = g * jax.nn.sigmoid(g @ glu_w.astype(f32) + glu_b.astype(f32))
    return out.astype(u.dtype)


def pool_mixer(u, w_pool, pool_scale):
    B, S, _ = u.shape
    uf = u.astype(jnp.float32).reshape(B, S, len(POOL_WINDOWS), POOL_GROUP)
    csum = jnp.cumsum(uf, axis=1)
    t = jnp.arange(S)
    outs = []
    for gi, w in enumerate(POOL_WINDOWS):
        cg = csum[:, :, gi]
        lag = jnp.pad(cg, ((0, 0), (w, 0), (0, 0)))[:, :S]
        cnt = jnp.minimum(t + 1, w).astype(jnp.float32)[None, :, None]
        outs.append((cg - lag) / cnt - uf[:, :, gi])
    pooled = jnp.stack(outs, axis=2)
    mixed = jnp.einsum('bsgi,gio->bsgo', pooled, w_pool.astype(jnp.float32)).reshape(B, S, POOL_WIDTH)
    return (mixed * pool_scale.astype(jnp.float32)).astype(u.dtype)


def sgu_mixer(zu, zv, v_norm_g, w_sp, b_sp):
    B, S, _ = zu.shape
    nc = S // SGU_CHUNK
    u = jax.nn.gelu(zu)
    v = rmsnorm(jax.nn.gelu(zv), v_norm_g)
    v = v.reshape(B, nc, SGU_CHUNK, SGU_HEADS, SGU_HEAD_DIM)
    w_causal = jnp.tril(w_sp)
    mixed = jnp.einsum('hts,bnshd->bnthd', w_causal, v) + b_sp.T[None, None, :, :, None]
    return (u.reshape(B, nc, SGU_CHUNK, SGU_HEADS, SGU_HEAD_DIM) * mixed).reshape(B, S, SGU_WIDTH)


def clamped_swiglu(z):
    gate, lin = jnp.split(z, 2, axis=-1)
    gate = jnp.minimum(gate, SWIGLU_LIMIT)
    lin = jnp.clip(lin, -SWIGLU_LIMIT, SWIGLU_LIMIT)
    return gate * jax.nn.sigmoid(SWIGLU_ALPHA * gate) * (lin + 1.0)


def moe_ffn(h, router_w, router_b, w_gu, b_gu, w_dn, b_dn):
    B, S, Dm = h.shape
    x = h.reshape(-1, Dm)
    T = x.shape[0]
    logits = (x @ router_w + router_b).astype(jnp.float32)
    top_logit, top_e = lax.top_k(logits, TOP_K)
    gate = jax.nn.softmax(top_logit, axis=-1)
    flat_e = top_e.reshape(-1)
    flat_tok = jnp.repeat(jnp.arange(T, dtype=jnp.int32), TOP_K)
    flat_gate = gate.reshape(-1)
    order = jnp.argsort(flat_e)
    se, st, sg = flat_e[order], flat_tok[order], flat_gate[order]
    counts = jnp.bincount(flat_e, length=N_EXPERTS)
    padded = (counts + MOE_BLOCK - 1) // MOE_BLOCK * MOE_BLOCK
    pad_end = jnp.cumsum(padded)
    pad_start = pad_end - padded
    start = jnp.cumsum(counts) - counts
    dest = pad_start[se] + (jnp.arange(T * TOP_K) - start[se])
    n_blocks = -(-(T * TOP_K + N_EXPERTS * (MOE_BLOCK - 1)) // MOE_BLOCK)
    n_rows = n_blocks * MOE_BLOCK
    row_tok = jnp.zeros((n_rows,), jnp.int32).at[dest].set(st)
    row_gate = jnp.zeros((n_rows,), jnp.float32).at[dest].set(sg)
    block_e = jnp.minimum(jnp.searchsorted(pad_end, jnp.arange(n_blocks) * MOE_BLOCK, side='right'), N_EXPERTS - 1)
    xb = x[row_tok].reshape(n_blocks, MOE_BLOCK, Dm)

    def expert_block(args):
        xblk, e = args
        z = xblk @ w_gu[e] + b_gu[e]
        return clamped_swiglu(z) @ w_dn[e] + b_dn[e]

    yb = lax.map(expert_block, (xb, block_e)).reshape(n_rows, Dm)
    out = jnp.zeros((T, Dm), jnp.float32).at[row_tok].add(yb.astype(jnp.float32) * row_gate[:, None])
    return out.astype(h.dtype).reshape(B, S, Dm)


def setup_inputs(seed: int = 0) -> dict:
    key = jax.random.key(seed)
    ks = iter(jax.random.split(key, 64))
    f32 = jnp.float32
    D = D_MODEL
    ne = (DEPTH + 1) // 2
    no = DEPTH // 2

    def nrm(shape, s):
        return jax.random.normal(next(ks), shape, f32) * s

    def gain(shape):
        return 1.0 + nrm(shape, 0.1)

    x = nrm((BATCH, SEQ, D), 1.0)
    c = nrm((BATCH, D), 1.0)
    positions = (jax.random.randint(next(ks), (BATCH, 1), 0, 1024, jnp.int32)
                 + jnp.arange(SEQ, dtype=jnp.int32)[None, :])
    return {
        "x": x, "c": c, "positions": positions,
        "ada_w": nrm((DEPTH, D, 6 * D), 0.5 * D ** -0.5),
        "ada_b": nrm((DEPTH, 6 * D), 0.02),
        "norm_mix_g": gain((DEPTH, D)),
        "norm_ffn_g": gain((DEPTH, D)),
        "router_w": nrm((DEPTH, D, N_EXPERTS), D ** -0.5),
        "router_b": nrm((DEPTH, N_EXPERTS), 0.01),
        "moe_w_gu": nrm((DEPTH, N_EXPERTS, D, 2 * EXPERT_FF), D ** -0.5),
        "moe_b_gu": nrm((DEPTH, N_EXPERTS, 2 * EXPERT_FF), 0.01),
        "moe_w_dn": nrm((DEPTH, N_EXPERTS, EXPERT_FF, D), EXPERT_FF ** -0.5),
        "moe_b_dn": nrm((DEPTH, N_EXPERTS, D), 0.01),
        "even_w_in": nrm((ne, D, EVEN_IN), D ** -0.5),
        "mla_q_norm_g": gain((ne, Q_LORA_RANK)),
        "mla_w_uq": nrm((ne, Q_LORA_RANK, MLA_HEADS, QK_HEAD_DIM), Q_LORA_RANK ** -0.5),
        "mla_kv_norm_g": gain((ne, KV_LORA_RANK)),
        "mla_w_ukv": nrm((ne, KV_LORA_RANK, MLA_HEADS, QK_NOPE_DIM + V_HEAD_DIM), KV_LORA_RANK ** -0.5),
        "mla_q_head_g": gain((ne, QK_HEAD_DIM)),
        "mla_k_head_g": gain((ne, QK_HEAD_DIM)),
        "s5_a_re": -0.5 * (1.0 + nrm((ne, S5_GROUPS, S5_STATE), 0.01)),
        "s5_a_im": math.pi * jnp.arange(S5_STATE, dtype=f32) + nrm((ne, S5_GROUPS, S5_STATE), 0.01),
        "s5_log_dt": jax.random.uniform(next(ks), (ne, S5_GROUPS), f32, math.log(S5_DT_MIN), math.log(S5_DT_MAX)),
        "s5_b_re": nrm((ne, S5_GROUPS, S5_STATE, S5_GROUP), (2 * S5_GROUP) ** -0.5),
        "s5_b_im": nrm((ne, S5_GROUPS, S5_STATE, S5_GROUP), (2 * S5_GROUP) ** -0.5),
        "s5_c_re": nrm((ne, S5_GROUPS, S5_GROUP, S5_STATE), S5_STATE ** -0.5),
        "s5_c_im": nrm((ne, S5_GROUPS, S5_GROUP, S5_STATE), S5_STATE ** -0.5),
        "s5_d": nrm((ne, S5_WIDTH), 1.0),
        "s5_glu_w": nrm((ne, S5_WIDTH, S5_WIDTH), S5_WIDTH ** -0.5),
        "s5_glu_b": nrm((ne, S5_WIDTH), 0.02),
        "even_w_out": nrm((ne, EVEN_MIX, D), EVEN_MIX ** -0.5),
        "odd_w_in": nrm((no, D, ODD_IN), D ** -0.5),
        "pool_w": nrm((no, len(POOL_WINDOWS), POOL_GROUP, POOL_GROUP), POOL_GROUP ** -0.5),
        "pool_scale": gain((no, POOL_WIDTH)),
        "sgu_norm_g": gain((no, SGU_WIDTH)),
        "sgu_w": nrm((no, SGU_HEADS, SGU_CHUNK, SGU_CHUNK), SGU_CHUNK ** -0.5),
        "sgu_b": gain((no, SGU_HEADS, SGU_CHUNK)),
        "odd_w_out": nrm((no, ODD_MIX, D), ODD_MIX ** -0.5),
    }


def reference(x, c, positions, ada_w, ada_b, norm_mix_g, norm_ffn_g, router_w, router_b,
              moe_w_gu, moe_b_gu, moe_w_dn, moe_b_dn,
              even_w_in, mla_q_norm_g, mla_w_uq, mla_kv_norm_g, mla_w_ukv, mla_q_head_g, mla_k_head_g,
              s5_a_re, s5_a_im, s5_log_dt, s5_b_re, s5_b_im, s5_c_re, s5_c_im, s5_d, s5_glu_w, s5_glu_b,
              even_w_out,
              odd_w_in, pool_w, pool_scale, sgu_norm_g, sgu_w, sgu_b, odd_w_out):
    cos, sin = rope_tables(positions)
    c_act = jax.nn.silu(c)
    split_even = [Q_LORA_RANK, Q_LORA_RANK + KV_LORA_RANK, Q_LORA_RANK + KV_LORA_RANK + QK_ROPE_DIM]
    split_odd = [POOL_WIDTH, POOL_WIDTH + SGU_WIDTH]
    for layer in range(DEPTH):
        mod = (c_act @ ada_w[layer] + ada_b[layer])[:, None, :]
        sh_m, sc_m, g_m, sh_f, sc_f, g_f = jnp.split(mod, 6, axis=-1)
        h = rmsnorm(x, norm_mix_g[layer]) * (1.0 + sc_m) + sh_m
        i = layer // 2
        if layer % 2 == 0:
            z = h @ even_w_in[i]
            q_c, kv_c, k_pe, u_s5 = jnp.split(z, split_even, axis=-1)
            attn = mla_mixer(q_c, kv_c, k_pe, cos, sin, mla_q_norm_g[i], mla_w_uq[i],
                             mla_kv_norm_g[i], mla_w_ukv[i], mla_q_head_g[i], mla_k_head_g[i])
            ssm = s5_mixer(u_s5, s5_a_re[i], s5_a_im[i], s5_log_dt[i], s5_b_re[i], s5_b_im[i],
                           s5_c_re[i], s5_c_im[i], s5_d[i], s5_glu_w[i], s5_glu_b[i])
            mix = jnp.concatenate([attn, ssm.astype(attn.dtype)], axis=-1) @ even_w_out[i]
        else:
            z = h @ odd_w_in[i]
            u_pool, zu, zv = jnp.split(z, split_odd, axis=-1)
            pooled = pool_mixer(u_pool, pool_w[i], pool_scale[i])
            gated = sgu_mixer(zu, zv, sgu_norm_g[i], sgu_w[i], sgu_b[i])
            mix = jnp.concatenate([pooled, gated], axis=-1) @ odd_w_out[i]
        x = x + g_m * mix
        h = rmsnorm(x, norm_ffn_g[layer]) * (1.0 + sc_f) + sh_f
        x = x + g_f * moe_ffn(h, router_w[layer], router_b[layer], moe_w_gu[layer], moe_b_gu[layer],
                              moe_w_dn[layer], moe_b_dn[layer])
    return x
```

```cpp
#include <hip/hip_runtime.h>
#include <cstdio>
#include <cstdint>

#ifndef MK_ONE_LAUNCH
#define MK_ONE_LAUNCH 0
#endif

typedef unsigned short bf16_t;
typedef short bf16x8 __attribute__((ext_vector_type(8)));
typedef short s16x4 __attribute__((ext_vector_type(4)));
typedef float f32x4 __attribute__((ext_vector_type(4)));
typedef float f32x16 __attribute__((ext_vector_type(16)));
typedef unsigned u32x4 __attribute__((ext_vector_type(4)));
typedef unsigned u32x2 __attribute__((ext_vector_type(2)));

constexpr int D = 1024, NB = 8, S = 4096, T = NB * S;
constexpr int NTHR = 512, NWAVE = 8;
constexpr int MOE_ROWS = 139264;
constexpr int NPHASE = 27;

constexpr size_t MiB = 1u << 20;
constexpr size_t WS_CTL = 0, CTL_ZERO_BYTES = 1 * MiB;
constexpr size_t WS_MOD = 1 * MiB;
constexpr size_t WS_S5AB = 2 * MiB;
constexpr size_t WS_PW = 3 * MiB;
constexpr size_t WS_KTAB = 5 * MiB;
constexpr size_t WS_TOK = 7 * MiB;
constexpr size_t WS_ROW = 9 * MiB;
constexpr size_t WS_LOGIT = 11 * MiB;
constexpr size_t WS_W_IN_E = 16 * MiB, WS_W_UQ = 18 * MiB, WS_W_UKV = 19 * MiB, WS_W_GLU = 20 * MiB, WS_W_OUT_E = 21 * MiB, WS_W_IN_O = 23 * MiB,
                 WS_W_OUT_O = 26 * MiB, WS_W_POOL = 28 * MiB, WS_W_SGU = 29 * MiB, WS_W_RT = 30 * MiB;
constexpr size_t WS_BT_END = 32 * MiB;
constexpr size_t WS_BT_MAIN = 40 * MiB;
constexpr size_t WS_W_GU = 112 * MiB;
constexpr size_t WS_W_DN = 368 * MiB;
constexpr size_t WS_HB = 496 * MiB;
constexpr size_t WS_MIXIN = 560 * MiB;
constexpr size_t WS_Y = 624 * MiB;
constexpr size_t WS_XB = 880 * MiB;
constexpr size_t WS_ACT = 1152 * MiB;
constexpr size_t WS_END = 1424 * MiB;
constexpr size_t WS_Z = 880 * MiB;
constexpr size_t WS_QN = 976 * MiB, WS_KVN = 992 * MiB, WS_QRAW = 1000 * MiB, WS_KVRAW = 1048 * MiB, WS_Q = 1112 * MiB, WS_K = 1160 * MiB, WS_VT = 1208 * MiB,
                 WS_AS5 = 1240 * MiB, WS_LEND = 1276 * MiB, WS_GACT = 1284 * MiB;
constexpr size_t WS_POOLED = 976 * MiB, WS_VTS = 1008 * MiB;
constexpr int CW_BAR = 4096, CW_CNT = 16384;

constexpr int LDS_BYTES = 147456;
constexpr int LDS_MISC = 140 * 1024;

struct Params {
    const float *x, *c; const int* pos;
    const float *ada_w, *ada_b, *norm_mix_g, *norm_ffn_g, *router_w, *router_b, *moe_w_gu, *moe_b_gu, *moe_w_dn, *moe_b_dn;
    const float *even_w_in, *q_norm_g, *w_uq, *kv_norm_g, *w_ukv, *q_head_g, *k_head_g;
    const float *s5_a_re, *s5_a_im, *s5_log_dt, *s5_b_re, *s5_b_im, *s5_c_re, *s5_c_im, *s5_d, *s5_glu_w, *s5_glu_b, *even_w_out;
    const float *odd_w_in, *pool_w, *pool_scale, *sgu_norm_g, *sgu_w, *sgu_b, *odd_w_out;
    float* out; unsigned char* ws; int ph_lo, ph_hi;
};

__device__ __forceinline__ float bf2f(unsigned short b) { return __uint_as_float(((unsigned)b) << 16); }
__device__ __forceinline__ unsigned pk2(float lo, float hi) {
    typedef float f2 __attribute__((ext_vector_type(2))); typedef __bf16 b2 __attribute__((ext_vector_type(2)));
    f2 v = {lo, hi}; b2 b = __builtin_convertvector(v, b2); return __builtin_bit_cast(unsigned, b);
}
__device__ __forceinline__ unsigned short f2bf(float f) { return (unsigned short)(pk2(f, 0.f) & 0xffffu); }
__device__ __forceinline__ float wave_sum(float v) {
#pragma unroll
    for (int o = 1; o < 64; o <<= 1) v += __shfl_xor(v, o);
    return v;
}
__device__ __forceinline__ float sigmoidf_(float x) { return 1.0f / (1.0f + __expf(-x)); }
__device__ __forceinline__ float gelu_tanh(float x) {
    const float u = 0.7978845608028654f * (x + 0.044715f * x * x * x);
    return x * sigmoidf_(2.0f * u);
}
__device__ __forceinline__ int crow(int r, int hi) { return (r & 3) + 8 * (r >> 2) + 4 * hi; }

#define LAS __attribute__((address_space(3)))
#define XB_TMO      128
#define XB_XCNT(j)  (256  + 64 * (j))
#define XB_XSUB(j)  (1280 + 64 * (j))
#define XB_XGEN(j)  (2304 + 64 * (j))
#define XB_TOP      3328
#define XB_TOPGEN   3392
#define XCD_BAR_WORDS 3456
#define XB_SPIN_CAP (1u << 20)
__device__ __forceinline__ unsigned xb_ld(unsigned* p)              { return __hip_atomic_load(p, __ATOMIC_RELAXED, __HIP_MEMORY_SCOPE_AGENT); }
__device__ __forceinline__ unsigned xb_add(unsigned* p, unsigned v) { return __hip_atomic_fetch_add(p, v, __ATOMIC_RELAXED, __HIP_MEMORY_SCOPE_AGENT); }
__device__ __forceinline__ unsigned xb_xcc_id() { return (unsigned)__builtin_amdgcn_s_getreg((3 << 11) | 20) & 0xFu; }
#define XB_SPIN(cond, bar) do { unsigned _sp = 0; while (cond) { __builtin_amdgcn_s_sleep(1); \
    if ((++_sp & 255u) == 0u) { if (xb_ld(&(bar)[XB_TMO])) break; if (_sp > XB_SPIN_CAP) { atomicAdd(&(bar)[XB_TMO], 1u); break; } } } } while (0)
struct XcdBarrier { unsigned* bar; unsigned x; volatile LAS unsigned* st; };
__device__ __forceinline__ XcdBarrier xcd_barrier_post(unsigned* bar, volatile LAS unsigned* st) {
    XcdBarrier b; b.bar = bar; b.x = xb_xcc_id(); b.st = st;
    if (threadIdx.x == 0) (void)xb_add(&bar[XB_XCNT(b.x)], 1u);
    return b;
}
__device__ __forceinline__ void xcd_barrier_complete(unsigned* bar, unsigned x, unsigned& nloc, unsigned& nx) {
    const unsigned G = gridDim.x * gridDim.y * gridDim.z;
    unsigned sum, cnt, mine, sp = 0u;
    for (;;) {
        sum = 0u; cnt = 0u; mine = 0u;
#pragma unroll
        for (unsigned j = 0; j < 16; ++j) { const unsigned c = xb_ld(&bar[XB_XCNT(j)]); sum += c; cnt += (c > 0u) ? 1u : 0u; mine = (j == x) ? c : mine; }
        if (sum == G) break;
        __builtin_amdgcn_s_sleep(1);
        if ((++sp & 255u) == 0u) { if (xb_ld(&bar[XB_TMO])) break; if (sp > XB_SPIN_CAP) { atomicAdd(&bar[XB_TMO], 1u); break; } }
    }
    nloc = mine > 0u ? mine : 1u; nx = cnt > 0u ? cnt : 1u;
}
__device__ __forceinline__ void xcd_barrier(const XcdBarrier& b) {
    asm volatile("s_waitcnt vmcnt(0)" ::: "memory");
    __syncthreads();
    if (threadIdx.x == 0) {
        unsigned* bar = b.bar;
        __builtin_amdgcn_s_waitcnt(0);
        unsigned nloc = b.st[0], nx = b.st[1];
        if (nloc == 0u) { xcd_barrier_complete(bar, b.x, nloc, nx); b.st[0] = nloc; b.st[1] = nx; }
        const unsigned old = xb_add(&bar[XB_XSUB(b.x)], 1u);
        const unsigned gen = old / nloc;
        if (old + 1u == (gen + 1u) * nloc) {
            __builtin_amdgcn_fence(__ATOMIC_RELEASE, "agent");
            asm volatile("s_waitcnt vmcnt(0)" ::: "memory");
            const unsigned og = xb_add(&bar[XB_TOP], 1u);
            const unsigned tg = og / nx;
            if (og + 1u == (tg + 1u) * nx) xb_add(&bar[XB_TOPGEN], 1u);
            else XB_SPIN(xb_ld(&bar[XB_TOPGEN]) == tg, bar);
            __builtin_amdgcn_fence(__ATOMIC_ACQUIRE, "agent");
            xb_add(&bar[XB_XGEN(b.x)], 1u);
            asm volatile("s_waitcnt vmcnt(0)" ::: "memory");
        } else {
            XB_SPIN(xb_ld(&bar[XB_XGEN(b.x)]) == gen, bar);
            __builtin_amdgcn_fence(__ATOMIC_ACQUIRE, "agent");
            asm volatile("s_waitcnt vmcnt(0)" ::: "memory");
        }
    }
    __syncthreads();
}

constexpr int SG_LDS = 2 * 128 * 144;
template <class Epi>
__device__ __forceinline__ void sg_tile(unsigned char* lds, const bf16_t* A, int lda, const bf16_t* Bt, int ldb, int K, Epi epi) {
    const int tid = threadIdx.x, lane = tid & 63, wid = tid >> 6, wr = wid >> 2, wc = wid & 3, fr = lane & 15, fq = lane >> 4;
    unsigned char* As = lds; unsigned char* Bs = lds + 128 * 144;
    f32x4 acc[4][2];
#pragma unroll
    for (int m = 0; m < 4; ++m)
#pragma unroll
        for (int n = 0; n < 2; ++n) acc[m][n] = (f32x4){0.f, 0.f, 0.f, 0.f};
    const int nt = K / 64;
    u32x4 ra[2], rb[2];
    const int r0 = tid >> 3, cc = tid & 7;
#pragma unroll
    for (int i = 0; i < 2; ++i) {
        ra[i] = *(const u32x4*)(A + (size_t)(r0 + 64 * i) * lda + cc * 8);
        rb[i] = *(const u32x4*)(Bt + (size_t)(r0 + 64 * i) * ldb + cc * 8);
    }
    for (int kt = 0; kt < nt; ++kt) {
        __syncthreads();
#pragma unroll
        for (int i = 0; i < 2; ++i) {
            *(u32x4*)(As + (r0 + 64 * i) * 144 + cc * 16) = ra[i];
            *(u32x4*)(Bs + (r0 + 64 * i) * 144 + cc * 16) = rb[i];
        }
        __syncthreads();
        if (kt + 1 < nt) {
#pragma unroll
            for (int i = 0; i < 2; ++i) {
                ra[i] = *(const u32x4*)(A + (size_t)(r0 + 64 * i) * lda + (kt + 1) * 64 + cc * 8);
                rb[i] = *(const u32x4*)(Bt + (size_t)(r0 + 64 * i) * ldb + (kt + 1) * 64 + cc * 8);
            }
        }
#pragma unroll
        for (int kk = 0; kk < 2; ++kk) {
            bf16x8 a[4], b[2];
#pragma unroll
            for (int m = 0; m < 4; ++m) a[m] = *(const bf16x8*)(As + (wr * 64 + m * 16 + fr) * 144 + kk * 64 + fq * 16);
#pragma unroll
            for (int n = 0; n < 2; ++n) b[n] = *(const bf16x8*)(Bs + (wc * 32 + n * 16 + fr) * 144 + kk * 64 + fq * 16);
#pragma unroll
            for (int m = 0; m < 4; ++m)
#pragma unroll
                for (int n = 0; n < 2; ++n) acc[m][n] = __builtin_amdgcn_mfma_f32_16x16x32_bf16(b[n], a[m], acc[m][n], 0, 0, 0);
        }
    }
#pragma unroll
    for (int m = 0; m < 4; ++m) epi(wr * 64 + m * 16 + fr, wc * 32 + fq * 4, acc[m][0], acc[m][1]);
}

__device__ __forceinline__ void transpose_item(const float* W, int K, int N, bf16_t* WT, float* scr, int item, int lane, int mode) {
    const int nblk = N / 32, kb = item / nblk, nb = item % nblk, k0 = 64 * kb, n0 = 32 * nb;
#pragma unroll 8
    for (int i = 0; i < 32; ++i) { const int kk = 2 * i + (lane >> 5); scr[kk * 33 + (lane & 31)] = W[(size_t)(k0 + kk) * N + n0 + (lane & 31)]; }
    __builtin_amdgcn_s_waitcnt(0xC07F); asm volatile("" ::: "memory");
    const int c = lane & 7;
#pragma unroll
    for (int j = 0; j < 4; ++j) {
        const int n = (lane >> 3) + 8 * j; const float* s = scr + (8 * c) * 33 + n;
        u32x4 o; o.x = pk2(s[0 * 33], s[1 * 33]); o.y = pk2(s[2 * 33], s[3 * 33]); o.z = pk2(s[4 * 33], s[5 * 33]); o.w = pk2(s[6 * 33], s[7 * 33]);
        int nn = n0 + n;
        if (mode == 1) { const int half = nn >= 1024; const int jj = nn - half * 1024; nn = 32 * (jj >> 4) + 16 * half + (jj & 15); }
        *(u32x4*)(WT + (size_t)nn * K + k0 + 8 * c) = o;
    }
    __builtin_amdgcn_s_waitcnt(0xC07F); asm volatile("" ::: "memory");
}
__device__ __forceinline__ void transpose_many(const float* W, int nmat, int K, int N, bf16_t* WT, size_t dst_stride, float* scr, int gw, int NGW, int lane, int mode) {
    const int per = (K / 64) * (N / 32); const long tot = (long)nmat * per;
    for (long it = gw; it < tot; it += NGW) {
        const int mt = (int)(it / per), r = (int)(it % per);
        transpose_item(W + (size_t)mt * K * N, K, N, WT + (size_t)mt * dst_stride, scr, r, lane, mode);
    }
}

__device__ __forceinline__ void norm_mod_store(f32x4 (&v)[4], const float* g, const float* sc, const float* sh, bf16_t* orow, int lane) {
    float s = 0.f;
#pragma unroll
    for (int j = 0; j < 4; ++j) s += (v[j].x * v[j].x + v[j].y * v[j].y) + (v[j].z * v[j].z + v[j].w * v[j].w);
    const float r = rsqrtf(wave_sum(s) * (1.0f / D) + 1e-6f);
#pragma unroll
    for (int j = 0; j < 4; ++j) {
        const int c = 4 * lane + 256 * j;
        const f32x4 gg = *(const f32x4*)(g + c), s1 = *(const f32x4*)(sc + c), s0 = *(const f32x4*)(sh + c);
        const float a = v[j].x * r * gg.x * (1.f + s1.x) + s0.x, b = v[j].y * r * gg.y * (1.f + s1.y) + s0.y,
                    cc = v[j].z * r * gg.z * (1.f + s1.z) + s0.z, d = v[j].w * r * gg.w * (1.f + s1.w) + s0.w;
        u32x2 o; o.x = pk2(a, b); o.y = pk2(cc, d);
        *(u32x2*)(orow + c) = o;
    }
}

template <int PHSEL> __global__ void __launch_bounds__(NTHR, 2) hybrid_fwd(Params p) {
    extern __shared__ __attribute__((aligned(16))) unsigned char lds[];
    const int tid = threadIdx.x, lane = tid & 63, wave = tid >> 6;
    const int G = gridDim.x, vb = blockIdx.x;
    const int gw = vb * NWAVE + wave, NGW = G * NWAVE;
    unsigned char* ws = p.ws;
    unsigned* ctl = (unsigned*)(ws + WS_CTL);
    float* MOD = (float*)(ws + WS_MOD);
    float* S5AB = (float*)(ws + WS_S5AB); float* S5BB = (float*)(ws + WS_S5AB + 65536);
    float* PW = (float*)(ws + WS_PW); float* KTAB = (float*)(ws + WS_KTAB);
    int* tok_e = (int*)(ws + WS_TOK); int* tok_pos = (int*)(ws + WS_TOK + 512 * 1024); float* tok_gate = (float*)(ws + WS_TOK + 1024 * 1024);
    int* row_slot = (int*)(ws + WS_ROW); float* row_gate = (float*)(ws + WS_ROW + MiB);
    float* LOGIT = (float*)(ws + WS_LOGIT);
    bf16_t* W_IN_E = (bf16_t*)(ws + WS_W_IN_E); bf16_t* W_UQ = (bf16_t*)(ws + WS_W_UQ); bf16_t* W_UKV = (bf16_t*)(ws + WS_W_UKV); bf16_t* W_GLU = (bf16_t*)(ws + WS_W_GLU);
    bf16_t* W_OUT_E = (bf16_t*)(ws + WS_W_OUT_E); bf16_t* W_IN_O = (bf16_t*)(ws + WS_W_IN_O); bf16_t* W_OUT_O = (bf16_t*)(ws + WS_W_OUT_O);
    bf16_t* W_POOL = (bf16_t*)(ws + WS_W_POOL); bf16_t* W_SGU = (bf16_t*)(ws + WS_W_SGU); bf16_t* W_RT = (bf16_t*)(ws + WS_W_RT);
    bf16_t* BT_END = (bf16_t*)(ws + WS_BT_END); bf16_t* BT_MAIN = (bf16_t*)(ws + WS_BT_MAIN);
    bf16_t* W_GU = (bf16_t*)(ws + WS_W_GU); bf16_t* W_DN = (bf16_t*)(ws + WS_W_DN);
    bf16_t* HB = (bf16_t*)(ws + WS_HB); bf16_t* MIXIN = (bf16_t*)(ws + WS_MIXIN); bf16_t* Y = (bf16_t*)(ws + WS_Y);
    bf16_t* XB = (bf16_t*)(ws + WS_XB); bf16_t* ACT = (bf16_t*)(ws + WS_ACT);
    bf16_t* Z = (bf16_t*)(ws + WS_Z); bf16_t* QN = (bf16_t*)(ws + WS_QN); bf16_t* KVN = (bf16_t*)(ws + WS_KVN); bf16_t* QRAW = (bf16_t*)(ws + WS_QRAW); bf16_t* KVRAW = (bf16_t*)(ws + WS_KVRAW);
    bf16_t* Qb = (bf16_t*)(ws + WS_Q); bf16_t* Kb = (bf16_t*)(ws + WS_K); bf16_t* VT = (bf16_t*)(ws + WS_VT);
    bf16_t* AS5 = (bf16_t*)(ws + WS_AS5); float* LEND = (float*)(ws + WS_LEND); bf16_t* GACT = (bf16_t*)(ws + WS_GACT);
    bf16_t* POOLED = (bf16_t*)(ws + WS_POOLED); bf16_t* VTS = (bf16_t*)(ws + WS_VTS);
    float* OUT = p.out; const float* XIN = p.x;
    const float* s5d = p.s5_d; const float* glub = p.s5_glu_b; const float* poolsc = p.pool_scale; const float* sgub = p.sgu_b;
    const float* bgu_all = p.moe_b_gu; const float* bdn_all = p.moe_b_dn; const float* rtb_all = p.router_b;

    for (int u = tid; u < (LDS_BYTES - LDS_MISC) / 4; u += NTHR) ((unsigned*)(lds + LDS_MISC))[u] = 0u;
    __syncthreads();
    volatile LAS unsigned* MISC = (volatile LAS unsigned*)((LAS unsigned char*)lds + LDS_MISC);
#if MK_ONE_LAUNCH
    XcdBarrier bar = xcd_barrier_post(ctl + CW_BAR, MISC + 8);
#endif

    const int ph_lo = (PHSEL >= 0) ? PHSEL : p.ph_lo, ph_hi = (PHSEL >= 0) ? PHSEL + 1 : p.ph_hi;
    for (int ph = ph_lo; ph < ph_hi; ++ph) {
        int layer = 0, mph = ph;
        if (ph >= 20 && ph <= 25) { layer = 1; mph = ph - 11; }
        const float* mod_l = MOD + (size_t)layer * NB * 6144;

        if (ph == 0) {
            const int gt = vb * NTHR + tid;
            if (gt < 2048) {
                const int g = gt >> 6, pp = gt & 63;
                const float dt = expf(p.s5_log_dt[g]);
                const float lre = fminf(p.s5_a_re[g * 64 + pp], -1e-4f), lim = p.s5_a_im[g * 64 + pp];
                const float mag = expf(lre * dt);
                const float abr = mag * cosf(lim * dt), abi = mag * sinf(lim * dt);
                const float den = lre * lre + lim * lim, nr = abr - 1.0f;
                const float fre = (nr * lre + abi * lim) / den, fim = (abi * lre - nr * lim) / den;
                S5AB[(g * 64 + pp) * 2 + 0] = abr; S5AB[(g * 64 + pp) * 2 + 1] = abi;
                for (int j = 0; j < 16; ++j) {
                    const float br = p.s5_b_re[(g * 64 + pp) * 16 + j], bi = p.s5_b_im[(g * 64 + pp) * 16 + j];
                    S5BB[((g * 64 + pp) * 16 + j) * 2 + 0] = fre * br - fim * bi;
                    S5BB[((g * 64 + pp) * 16 + j) * 2 + 1] = fre * bi + fim * br;
                }
                float pr = 1.f, pi = 0.f;
                for (int tau = 0; tau <= 64; ++tau) {
                    PW[((g * 64 + pp) * 65 + tau) * 2 + 0] = pr; PW[((g * 64 + pp) * 65 + tau) * 2 + 1] = pi;
                    const float nr2 = pr * abr - pi * abi, ni2 = pr * abi + pi * abr; pr = nr2; pi = ni2;
                }
            }
            {
                float* ca = (float*)lds;
                for (int i = tid; i < NB * D; i += NTHR) { const float cv = p.c[i]; ca[i] = cv * sigmoidf_(cv); }
                __syncthreads();
                for (int task = gw; task < 2 * 96; task += NGW) {
                    const int l = task / 96, cb = task % 96, col = cb * 64 + lane;
                    const float* W = p.ada_w + (size_t)l * D * 6144 + col;
                    float acc[8];
#pragma unroll
                    for (int b = 0; b < 8; ++b) acc[b] = 0.f;
                    for (int k = 0; k < D; k += 8) {
                        float w[8];
#pragma unroll
                        for (int u = 0; u < 8; ++u) w[u] = W[(size_t)(k + u) * 6144];
#pragma unroll
                        for (int u = 0; u < 8; ++u)
#pragma unroll
                            for (int b = 0; b < 8; ++b) acc[b] += ca[b * D + k + u] * w[u];
                    }
                    const float bias = p.ada_b[l * 6144 + col];
#pragma unroll
                    for (int b = 0; b < 8; ++b) MOD[((size_t)l * NB + b) * 6144 + col] = acc[b] + bias;
                }
                __syncthreads();
            }
            {
                float* scr = (float*)(lds + wave * 16384);
                transpose_many(p.even_w_in, 1, 1024, 928, W_IN_E, 0, scr, gw, NGW, lane, 0);
                transpose_many(p.w_uq, 1, 256, 768, W_UQ, 0, scr, gw, NGW, lane, 0);
                transpose_many(p.w_ukv, 1, 128, 1024, W_UKV, 0, scr, gw, NGW, lane, 0);
                transpose_many(p.s5_glu_w, 1, 512, 512, W_GLU, 0, scr, gw, NGW, lane, 0);
                transpose_many(p.even_w_out, 1, 1024, 1024, W_OUT_E, 0, scr, gw, NGW, lane, 0);
                transpose_many(p.odd_w_in, 1, 1024, 1536, W_IN_O, 0, scr, gw, NGW, lane, 0);
                transpose_many(p.odd_w_out, 1, 1024, 1024, W_OUT_O, 0, scr, gw, NGW, lane, 0);
                transpose_many(p.pool_w, 4, 128, 128, W_POOL, 128 * 128, scr, gw, NGW, lane, 0);
                transpose_many(p.router_w, 2, 1024, 32, W_RT, 128 * 1024, scr, gw, NGW, lane, 0);
                transpose_many(p.moe_w_gu, 64, 1024, 2048, W_GU, (size_t)2048 * 1024, scr, gw, NGW, lane, 1);
                transpose_many(p.moe_w_dn, 64, 1024, 1024, W_DN, (size_t)1024 * 1024, scr, gw, NGW, lane, 0);
                for (int i = vb * NTHR + tid; i < 4 * 128 * 128; i += G * NTHR) {
                    const int t = (i >> 7) & 127, s_ = i & 127;
                    W_SGU[i] = (s_ <= t) ? f2bf(p.sgu_w[i]) : (bf16_t)0;
                }
            }
        }
        else if (ph == 1 || ph == 9 || ph == 15 || ph == 20 || ph == 26) {
            const int lyr = (ph == 1 || ph == 9) ? 0 : 1;
            const bool combine = (ph == 15 || ph == 26), donorm = (ph != 26);
            const int comb_layer = (ph == 15) ? 0 : 1;
            const bool ffn = (ph == 9 || ph == 20);
            const float* src = (ph == 1) ? p.x : p.out;
            const float* ng = (ffn ? p.norm_ffn_g : p.norm_mix_g) + lyr * D;
            for (int row = gw; row < T; row += NGW) {
                const int b = row / S;
                f32x4 v[4];
#pragma unroll
                for (int j = 0; j < 4; ++j) v[j] = *(const f32x4*)(src + (size_t)row * D + 4 * lane + 256 * j);
                if (combine) {
                    const float* gf = MOD + ((size_t)comb_layer * NB + b) * 6144 + 5 * D;
#pragma unroll
                    for (int j = 0; j < 4; ++j) {
                        const int c = 4 * lane + 256 * j;
                        float a0 = 0.f, a1 = 0.f, a2 = 0.f, a3 = 0.f;
#pragma unroll
                        for (int k = 0; k < 4; ++k) {
                            const u32x2 yy = *(const u32x2*)(Y + ((size_t)row * 4 + k) * D + c);
                            a0 += __uint_as_float(yy.x << 16); a1 += __uint_as_float(yy.x & 0xffff0000u);
                            a2 += __uint_as_float(yy.y << 16); a3 += __uint_as_float(yy.y & 0xffff0000u);
                        }
                        const f32x4 g4 = *(const f32x4*)(gf + c);
                        v[j].x += g4.x * a0; v[j].y += g4.y * a1; v[j].z += g4.z * a2; v[j].w += g4.w * a3;
                        *(f32x4*)(p.out + (size_t)row * D + c) = v[j];
                    }
                }
                if (donorm) {
                    const float* mm = MOD + ((size_t)lyr * NB + b) * 6144 + (ffn ? 3 * D : 0);
                    norm_mod_store(v, ng, mm + D, mm, HB + (size_t)row * D, lane);
                }
            }
            if (ph == 1) {
                for (int idx = vb * NTHR + tid; idx < 32 * 64 * 256; idx += G * NTHR) {
                    const int j = idx & 15, i = (idx >> 4) & 15, tau = (idx >> 8) & 63, g = idx >> 14;
                    float acc = 0.f;
                    for (int pp = 0; pp < 64; ++pp) {
                        const float cr = p.s5_c_re[(g * 16 + i) * 64 + pp], ci = p.s5_c_im[(g * 16 + i) * 64 + pp];
                        const float pr = PW[((g * 64 + pp) * 65 + tau) * 2], pi = PW[((g * 64 + pp) * 65 + tau) * 2 + 1];
                        const float br = S5BB[((g * 64 + pp) * 16 + j) * 2], bi = S5BB[((g * 64 + pp) * 16 + j) * 2 + 1];
                        const float qr = pr * br - pi * bi, qi = pr * bi + pi * br;
                        acc += cr * qr - ci * qi;
                    }
                    KTAB[idx] = acc;
                }
            }
        }
        else if (ph == 2) {
            for (int u = vb; u < 256 * 8; u += G) {
                const int pm = u >> 3, pn = u & 7;
                sg_tile(lds, HB + (size_t)pm * 128 * D, D, W_IN_E + (size_t)pn * 128 * D, D, D,
                    [=](int r, int c, f32x4 v0, f32x4 v1) {
                        const int row = pm * 128 + r;
#pragma unroll
                        for (int h = 0; h < 2; ++h) {
                            const int col = pn * 128 + c + 16 * h; const f32x4 v = h ? v1 : v0;
                            u32x2 o; o.x = pk2(v.x, v.y); o.y = pk2(v.z, v.w);
                            if (col < 416) *(u32x2*)(Z + (size_t)row * 1024 + col) = o;
                            else if (col < 928) {
                                const int ch = col - 416, g = ch >> 4, j = ch & 15, b = row / S, t = row % S;
                                *(u32x2*)(AS5 + ((size_t)g * 512 + b * 64 + (t >> 6)) * 1152 + 128 + (t & 63) * 16 + j) = o;
                            }
                        }
                    });
            }
            for (int idx = vb * NTHR + tid; idx < 32 * 128 * 128; idx += G * NTHR) {
                const int k8 = idx & 127, n = (idx >> 7) & 127, g = idx >> 14;
                const int ri = n >> 6, pp = n & 63, s_ = k8 >> 1, j0 = (k8 & 1) * 8;
                const float pr = PW[((g * 64 + pp) * 65 + (63 - s_)) * 2], pi = PW[((g * 64 + pp) * 65 + (63 - s_)) * 2 + 1];
                float o[8];
#pragma unroll
                for (int j = 0; j < 8; ++j) {
                    const float br = S5BB[((g * 64 + pp) * 16 + j0 + j) * 2], bi = S5BB[((g * 64 + pp) * 16 + j0 + j) * 2 + 1];
                    o[j] = ri ? (pr * bi + pi * br) : (pr * br - pi * bi);
                }
                u32x4 w; w.x = pk2(o[0], o[1]); w.y = pk2(o[2], o[3]); w.z = pk2(o[4], o[5]); w.w = pk2(o[6], o[7]);
                *(u32x4*)(BT_END + ((size_t)g * 128 + n) * 1024 + k8 * 8) = w;
            }
            for (int idx = vb * NTHR + tid; idx < 32 * 1024 * 144; idx += G * NTHR) {
                const int k8 = idx % 144, n = (idx / 144) & 1023, g = idx / (144 * 1024);
                const int t = n >> 4, i = n & 15;
                float o[8];
                if (k8 < 16) {
                    const int ri = k8 >> 3, p0 = (k8 & 7) * 8;
#pragma unroll
                    for (int j = 0; j < 8; ++j) {
                        const int pp = p0 + j;
                        const float cr = p.s5_c_re[(g * 16 + i) * 64 + pp], ci = p.s5_c_im[(g * 16 + i) * 64 + pp];
                        const float pr = PW[((g * 64 + pp) * 65 + t + 1) * 2], pi = PW[((g * 64 + pp) * 65 + t + 1) * 2 + 1];
                        o[j] = ri ? -(cr * pi + ci * pr) : (cr * pr - ci * pi);
                    }
                } else {
                    const int kk = (k8 - 16) * 8, s_ = kk >> 4, j0 = kk & 15;
#pragma unroll
                    for (int j = 0; j < 8; ++j) o[j] = (s_ <= t) ? KTAB[((g * 64 + (t - s_)) * 16 + i) * 16 + j0 + j] : 0.f;
                }
                u32x4 w; w.x = pk2(o[0], o[1]); w.y = pk2(o[2], o[3]); w.z = pk2(o[4], o[5]); w.w = pk2(o[6], o[7]);
                *(u32x4*)(BT_MAIN + ((size_t)g * 1024 + n) * 1152 + k8 * 8) = w;
            }
        }
        else if (ph == 3) {
            for (int row = gw; row < T; row += NGW) {
                const u32x2 qv = *(const u32x2*)(Z + (size_t)row * 1024 + lane * 4);
                const unsigned kv = *(const unsigned*)(Z + (size_t)row * 1024 + 256 + lane * 2);
                const float q0 = __uint_as_float(qv.x << 16), q1 = __uint_as_float(qv.x & 0xffff0000u), q2 = __uint_as_float(qv.y << 16), q3 = __uint_as_float(qv.y & 0xffff0000u);
                const float k0 = __uint_as_float(kv << 16), k1 = __uint_as_float(kv & 0xffff0000u);
                const float rq = rsqrtf(wave_sum(q0 * q0 + q1 * q1 + q2 * q2 + q3 * q3) * (1.f / 256.f) + 1e-6f);
                const float rk = rsqrtf(wave_sum(k0 * k0 + k1 * k1) * (1.f / 128.f) + 1e-6f);
                const f32x4 gq = *(const f32x4*)(p.q_norm_g + lane * 4);
                u32x2 o; o.x = pk2(q0 * rq * gq.x, q1 * rq * gq.y); o.y = pk2(q2 * rq * gq.z, q3 * rq * gq.w);
                *(u32x2*)(QN + (size_t)row * 256 + lane * 4) = o;
                *(unsigned*)(KVN + (size_t)row * 128 + lane * 2) = pk2(k0 * rk * p.kv_norm_g[lane * 2], k1 * rk * p.kv_norm_g[lane * 2 + 1]);
            }
        }
        else if (ph == 4) {
            for (int u = vb; u < 256 * 6 + 256 * 8 + 128; u += G) {
                if (u < 256 * 6) {
                    const int pm = u / 6, pn = u % 6;
                    sg_tile(lds, QN + (size_t)pm * 128 * 256, 256, W_UQ + (size_t)pn * 128 * 256, 256, 256,
                        [=](int r, int c, f32x4 v0, f32x4 v1) {
                            bf16_t* o = QRAW + (size_t)(pm * 128 + r) * 768 + pn * 128 + c;
                            u32x2 a; a.x = pk2(v0.x, v0.y); a.y = pk2(v0.z, v0.w); *(u32x2*)o = a;
                            u32x2 b; b.x = pk2(v1.x, v1.y); b.y = pk2(v1.z, v1.w); *(u32x2*)(o + 16) = b;
                        });
                } else if (u < 256 * 14) {
                    const int uu = u - 256 * 6, pm = uu >> 3, pn = uu & 7;
                    sg_tile(lds, KVN + (size_t)pm * 128 * 128, 128, W_UKV + (size_t)pn * 128 * 128, 128, 128,
                        [=](int r, int c, f32x4 v0, f32x4 v1) {
                            bf16_t* o = KVRAW + (size_t)(pm * 128 + r) * 1024 + pn * 128 + c;
                            u32x2 a; a.x = pk2(v0.x, v0.y); a.y = pk2(v0.z, v0.w); *(u32x2*)o = a;
                            u32x2 b; b.x = pk2(v1.x, v1.y); b.y = pk2(v1.z, v1.w); *(u32x2*)(o + 16) = b;
                        });
                } else {
                    const int uu = u - 256 * 14, g = uu >> 2, pm = uu & 3;
                    sg_tile(lds, AS5 + ((size_t)g * 512 + pm * 128) * 1152 + 128, 1152, BT_END + (size_t)g * 128 * 1024, 1024, 1024,
                        [=](int r, int c, f32x4 v0, f32x4 v1) {
                            float* o = LEND + ((size_t)g * 512 + pm * 128 + r) * 128 + c;
                            *(f32x4*)o = v0; *(f32x4*)(o + 16) = v1;
                        });
                }
            }
        }
        else if (ph == 5) {
            bf16_t* stq = (bf16_t*)(lds + 65536) + wave * 1536;
            bf16_t* vts = (bf16_t*)lds;
            const float qscale = 0.10206207261596577f * 1.4426950408889634f;
            for (int tile = vb; tile < T / 64; tile += G) {
                const int hh = lane >> 3, pp = lane & 7;
                for (int tt = 0; tt < 8; ++tt) {
                    const int tl = wave * 8 + tt, row = tile * 64 + tl, b = row / S, t = row % S;
                    float qv[12], kv[12];
#pragma unroll
                    for (int j = 0; j < 12; ++j) {
                        const int d = pp + 8 * j;
                        qv[j] = bf2f(QRAW[(size_t)row * 768 + hh * 96 + d]);
                        kv[j] = (j < 8) ? bf2f(KVRAW[(size_t)row * 1024 + hh * 128 + d]) : bf2f(Z[(size_t)row * 1024 + 384 + d - 64]);
                    }
                    float sq = 0.f, sk = 0.f;
#pragma unroll
                    for (int j = 0; j < 12; ++j) { sq += qv[j] * qv[j]; sk += kv[j] * kv[j]; }
                    sq += __shfl_xor(sq, 1); sq += __shfl_xor(sq, 2); sq += __shfl_xor(sq, 4);
                    sk += __shfl_xor(sk, 1); sk += __shfl_xor(sk, 2); sk += __shfl_xor(sk, 4);
                    const float rq = rsqrtf(sq * (1.f / 96.f) + 1e-6f), rk = rsqrtf(sk * (1.f / 96.f) + 1e-6f);
#pragma unroll
                    for (int j = 0; j < 12; ++j) { const int d = pp + 8 * j; qv[j] *= rq * p.q_head_g[d]; kv[j] *= rk * p.k_head_g[d]; }
                    const float posf = (float)p.pos[row];
#pragma unroll
                    for (int e = 0; e < 2; ++e) {
                        const int i = pp + 8 * e;
                        const float invf = exp2f(-(float)i * (13.287712379549449f / 16.0f));
                        const float ang = posf * invf;
                        const float kq = rintf(ang * 0.15915494309189535f);
                        float rr = __builtin_fmaf(-kq, 6.28318548202514648f, ang); rr = __builtin_fmaf(-kq, -1.7484556e-7f, rr);
                        const float cs = __cosf(rr), sn = __sinf(rr);
                        const float q1 = qv[8 + e], q2 = qv[10 + e], k1 = kv[8 + e], k2 = kv[10 + e];
                        qv[8 + e] = q1 * cs - q2 * sn; qv[10 + e] = q1 * sn + q2 * cs;
                        kv[8 + e] = k1 * cs - k2 * sn; kv[10 + e] = k1 * sn + k2 * cs;
                    }
#pragma unroll
                    for (int j = 0; j < 12; ++j) { const int d = pp + 8 * j; stq[hh * 96 + d] = f2bf(qv[j] * qscale); stq[768 + hh * 96 + d] = f2bf(kv[j]); }
#pragma unroll
                    for (int j = 0; j < 8; ++j) { const int dv = pp + 8 * j; vts[(hh * 64 + dv) * 64 + tl] = KVRAW[(size_t)row * 1024 + hh * 128 + 64 + dv]; }
                    __builtin_amdgcn_s_waitcnt(0xC07F); asm volatile("" ::: "memory");
                    for (int ch = lane; ch < 192; ch += 64) {
                        const int isk = ch >= 96, c2 = ch - 96 * isk, h2 = c2 / 12, part = c2 % 12;
                        const u32x4 vv = *(const u32x4*)(stq + isk * 768 + h2 * 96 + part * 8);
                        bf16_t* dst = (isk ? Kb : Qb) + (((size_t)b * 8 + h2) * S + t) * 96 + part * 8;
                        *(u32x4*)dst = vv;
                    }
                    __builtin_amdgcn_s_waitcnt(0xC07F); asm volatile("" ::: "memory");
                }
                __syncthreads();
                {
                    const int hd = tid, b = (tile * 64) / S, t0 = (tile * 64) % S;
                    bf16_t* dst = VT + (((size_t)b * 8 + (hd >> 6)) * 64 + (hd & 63)) * S + t0;
#pragma unroll
                    for (int i = 0; i < 8; ++i) *(u32x4*)(dst + i * 8) = *(const u32x4*)(vts + hd * 64 + i * 8);
                }
                __syncthreads();
            }
            for (int ch = vb * NTHR + tid; ch < NB * 32 * 64; ch += G * NTHR) {
                const int pp = ch & 63, g = (ch >> 6) & 31, b = ch >> 11;
                const float ar = PW[((g * 64 + pp) * 65 + 64) * 2], ai = PW[((g * 64 + pp) * 65 + 64) * 2 + 1];
                float cr = 0.f, ci = 0.f;
                for (int c = 0; c < 64; ++c) {
                    bf16_t* dst = AS5 + ((size_t)g * 512 + b * 64 + c) * 1152;
                    dst[pp] = f2bf(cr); dst[64 + pp] = f2bf(ci);
                    const float* le = LEND + ((size_t)g * 512 + b * 64 + c) * 128;
                    const float nr = ar * cr - ai * ci + le[pp], ni = ar * ci + ai * cr + le[64 + pp];
                    cr = nr; ci = ni;
                }
            }
        }
        else if (ph == 6) {
            unsigned char* Ks = lds;
            unsigned char* Vs = lds + 64 * 208;
            const int r32 = lane & 31, hi = lane >> 5;
            for (int ui = 0; ui < 4; ++ui) {
                if (vb >= 256) break;
                const int bh = vb & 63, kq = vb >> 6;
                const int qb = (ui == 0) ? 15 - kq : (ui == 1) ? 8 + kq : (ui == 2) ? 7 - kq : kq;
                const int q0 = qb * 256 + wave * 32;
                const bf16_t* Qg = Qb + ((size_t)bh * S + q0 + r32) * 96;
                const bf16_t* Kg = Kb + (size_t)bh * S * 96;
                const bf16_t* Vg = VT + (size_t)bh * 64 * S;
                bf16x8 qf[6];
#pragma unroll
                for (int d0 = 0; d0 < 6; ++d0) qf[d0] = *(const bf16x8*)(Qg + d0 * 16 + hi * 8);
                f32x16 o0, o1;
#pragma unroll
                for (int r = 0; r < 16; ++r) { o0[r] = 0.f; o1[r] = 0.f; }
                float m_run = -1e30f, l_run = 0.f;
                const int ntile = 4 * (qb + 1);
                u32x4 rk0, rk1, rv;
                const int kr0 = tid / 12, kc0 = tid % 12, kr1 = (tid + 512) / 12, kc1 = (tid + 512) % 12;
                const int vr = tid >> 3, vc = tid & 7;
                rk0 = *(const u32x4*)(Kg + (size_t)kr0 * 96 + kc0 * 8);
                if (tid < 256) rk1 = *(const u32x4*)(Kg + (size_t)kr1 * 96 + kc1 * 8);
                rv = *(const u32x4*)(Vg + (size_t)vr * S + vc * 8);
                for (int t = 0; t < ntile; ++t) {
                    __syncthreads();
                    *(u32x4*)(Ks + kr0 * 208 + kc0 * 16) = rk0;
                    if (tid < 256) *(u32x4*)(Ks + kr1 * 208 + kc1 * 16) = rk1;
                    { u32x2 a; a.x = rv.x; a.y = rv.y; u32x2 b2; b2.x = rv.z; b2.y = rv.w;
                      *(u32x2*)(Vs + vr * 136 + vc * 16) = a; *(u32x2*)(Vs + vr * 136 + vc * 16 + 8) = b2; }
                    __syncthreads();
                    if (t + 1 < ntile) {
                        rk0 = *(const u32x4*)(Kg + (size_t)((t + 1) * 64 + kr0) * 96 + kc0 * 8);
                        if (tid < 256) rk1 = *(const u32x4*)(Kg + (size_t)((t + 1) * 64 + kr1) * 96 + kc1 * 8);
                        rv = *(const u32x4*)(Vg + (size_t)vr * S + (t + 1) * 64 + vc * 8);
                    }
                    if (t * 64 > q0 + 31) continue;
                    f32x16 s0, s1;
#pragma unroll
                    for (int r = 0; r < 16; ++r) { s0[r] = 0.f; s1[r] = 0.f; }
#pragma unroll
                    for (int d0 = 0; d0 < 6; ++d0) {
                        const bf16x8 k0 = *(const bf16x8*)(Ks + r32 * 208 + d0 * 32 + hi * 16);
                        const bf16x8 k1 = *(const bf16x8*)(Ks + (32 + r32) * 208 + d0 * 32 + hi * 16);
                        s0 = __builtin_amdgcn_mfma_f32_32x32x16_bf16(k0, qf[d0], s0, 0, 0, 0);
                        s1 = __builtin_amdgcn_mfma_f32_32x32x16_bf16(k1, qf[d0], s1, 0, 0, 0);
                    }
                    if (t * 64 + 63 > q0) {
                        const int qi = q0 + r32;
#pragma unroll
                        for (int r = 0; r < 16; ++r) {
                            const int key = t * 64 + crow(r, hi);
                            if (key > qi) s0[r] = -INFINITY;
                            if (key + 32 > qi) s1[r] = -INFINITY;
                        }
                    }
                    float mx = s0[0];
#pragma unroll
                    for (int r = 1; r < 16; ++r) mx = fmaxf(mx, s0[r]);
#pragma unroll
                    for (int r = 0; r < 16; ++r) mx = fmaxf(mx, s1[r]);
                    mx = fmaxf(mx, __shfl_xor(mx, 32));
                    const float m_new = fmaxf(m_run, mx);
                    const float alpha = __builtin_amdgcn_exp2f(m_run - m_new);
                    m_run = m_new;
                    float ls = 0.f;
#pragma unroll
                    for (int r = 0; r < 16; ++r) { s0[r] = __builtin_amdgcn_exp2f(s0[r] - m_new); s1[r] = __builtin_amdgcn_exp2f(s1[r] - m_new); ls += s0[r] + s1[r]; }
                    l_run = l_run * alpha + ls;
#pragma unroll
                    for (int r = 0; r < 16; ++r) { o0[r] *= alpha; o1[r] *= alpha; }
                    bf16x8 pf[2][2];
#pragma unroll
                    for (int ks = 0; ks < 2; ++ks) {
                        u32x4 w0, w1;
                        w0.x = pk2(s0[8 * ks + 0], s0[8 * ks + 1]); w0.y = pk2(s0[8 * ks + 2], s0[8 * ks + 3]); w0.z = pk2(s0[8 * ks + 4], s0[8 * ks + 5]); w0.w = pk2(s0[8 * ks + 6], s0[8 * ks + 7]);
                        w1.x = pk2(s1[8 * ks + 0], s1[8 * ks + 1]); w1.y = pk2(s1[8 * ks + 2], s1[8 * ks + 3]); w1.z = pk2(s1[8 * ks + 4], s1[8 * ks + 5]); w1.w = pk2(s1[8 * ks + 6], s1[8 * ks + 7]);
                        pf[0][ks] = __builtin_bit_cast(bf16x8, w0); pf[1][ks] = __builtin_bit_cast(bf16x8, w1);
                    }
#pragma unroll
                    for (int kb = 0; kb < 2; ++kb)
#pragma unroll
                        for (int ks = 0; ks < 2; ++ks) {
                            const int koff = (kb * 32 + 16 * ks + 4 * hi) * 2;
#pragma unroll
                            for (int dvb = 0; dvb < 2; ++dvb) {
                                const unsigned char* vp = Vs + (dvb * 32 + r32) * 136 + koff;
                                const u32x2 lo = *(const u32x2*)vp, hi2 = *(const u32x2*)(vp + 16);
                                u32x4 w; w.x = lo.x; w.y = lo.y; w.z = hi2.x; w.w = hi2.y;
                                const bf16x8 vf = __builtin_bit_cast(bf16x8, w);
                                if (dvb == 0) o0 = __builtin_amdgcn_mfma_f32_32x32x16_bf16(vf, pf[kb][ks], o0, 0, 0, 0);
                                else o1 = __builtin_amdgcn_mfma_f32_32x32x16_bf16(vf, pf[kb][ks], o1, 0, 0, 0);
                            }
                        }
                }
                l_run += __shfl_xor(l_run, 32);
                const float rl = 1.0f / l_run;
                const int b = bh >> 3, h = bh & 7;
                bf16_t* orow = MIXIN + ((size_t)b * S + q0 + r32) * 1024 + h * 64;
#pragma unroll
                for (int rg = 0; rg < 4; ++rg) {
                    u32x2 a; a.x = pk2(o0[4 * rg] * rl, o0[4 * rg + 1] * rl); a.y = pk2(o0[4 * rg + 2] * rl, o0[4 * rg + 3] * rl);
                    *(u32x2*)(orow + 8 * rg + 4 * hi) = a;
                    u32x2 c2; c2.x = pk2(o1[4 * rg] * rl, o1[4 * rg + 1] * rl); c2.y = pk2(o1[4 * rg + 2] * rl, o1[4 * rg + 3] * rl);
                    *(u32x2*)(orow + 32 + 8 * rg + 4 * hi) = c2;
                }
            }
            __syncthreads();
            for (int u = vb; u < 32 * 4 * 8; u += G) {
                const int g = u >> 5, pm = (u >> 3) & 3, pn = u & 7;
                sg_tile(lds, AS5 + ((size_t)g * 512 + pm * 128) * 1152, 1152, BT_MAIN + ((size_t)g * 1024 + pn * 128) * 1152, 1152, 1152,
                    [=](int r, int c, f32x4 v0, f32x4 v1) {
                        const int m = pm * 128 + r, b = m >> 6, ck = m & 63;
#pragma unroll
                        for (int h = 0; h < 2; ++h) {
                            const int n = pn * 128 + c + 16 * h; const f32x4 v = h ? v1 : v0;
                            const int tq = n >> 4, i = n & 15;
                            const u32x2 uu = *(const u32x2*)(AS5 + ((size_t)g * 512 + m) * 1152 + 128 + n);
                            const f32x4 dd = *(const f32x4*)(s5d + g * 16 + i);
                            const float y0 = v.x + dd.x * __uint_as_float(uu.x << 16), y1 = v.y + dd.y * __uint_as_float(uu.x & 0xffff0000u),
                                        y2 = v.z + dd.z * __uint_as_float(uu.y << 16), y3 = v.w + dd.w * __uint_as_float(uu.y & 0xffff0000u);
                            u32x2 o; o.x = pk2(gelu_tanh(y0), gelu_tanh(y1)); o.y = pk2(gelu_tanh(y2), gelu_tanh(y3));
                            *(u32x2*)(GACT + ((size_t)b * S + ck * 64 + tq) * 512 + g * 16 + i) = o;
                        }
                    });
            }
        }
        else if (ph == 7) {
            for (int u = vb; u < 256 * 4; u += G) {
                const int pm = u >> 2, pn = u & 3;
                sg_tile(lds, GACT + (size_t)pm * 128 * 512, 512, W_GLU + (size_t)pn * 128 * 512, 512, 512,
                    [=](int r, int c, f32x4 v0, f32x4 v1) {
                        const int row = pm * 128 + r;
#pragma unroll
                        for (int h = 0; h < 2; ++h) {
                            const int col = pn * 128 + c + 16 * h; const f32x4 v = h ? v1 : v0;
                            const u32x2 gg = *(const u32x2*)(GACT + (size_t)row * 512 + col);
                            const f32x4 bb = *(const f32x4*)(glub + col);
                            const float g0 = __uint_as_float(gg.x << 16), g1 = __uint_as_float(gg.x & 0xffff0000u), g2 = __uint_as_float(gg.y << 16), g3 = __uint_as_float(gg.y & 0xffff0000u);
                            u32x2 o; o.x = pk2(g0 * sigmoidf_(v.x + bb.x), g1 * sigmoidf_(v.y + bb.y)); o.y = pk2(g2 * sigmoidf_(v.z + bb.z), g3 * sigmoidf_(v.w + bb.w));
                            *(u32x2*)(MIXIN + (size_t)row * 1024 + 512 + col) = o;
                        }
                    });
            }
        }
        else if (ph == 8 || ph == 19) {
            const int lyr = (ph == 8) ? 0 : 1;
            const bf16_t* W = lyr ? W_OUT_O : W_OUT_E;
            const float* src = lyr ? OUT : XIN;
            for (int u = vb; u < 256 * 8; u += G) {
                const int pm = u >> 3, pn = u & 7;
                sg_tile(lds, MIXIN + (size_t)pm * 128 * D, D, W + (size_t)pn * 128 * D, D, D,
                    [=](int r, int c, f32x4 v0, f32x4 v1) {
                        const int row = pm * 128 + r, b = row / S;
                        const float* gm = MOD + ((size_t)lyr * NB + b) * 6144 + 2 * D;
#pragma unroll
                        for (int h = 0; h < 2; ++h) {
                            const int col = pn * 128 + c + 16 * h; const f32x4 v = h ? v1 : v0;
                            const f32x4 xs = *(const f32x4*)(src + (size_t)row * D + col), g4 = *(const f32x4*)(gm + col);
                            f32x4 o; o.x = xs.x + g4.x * v.x; o.y = xs.y + g4.y * v.y; o.z = xs.z + g4.z * v.z; o.w = xs.w + g4.w * v.w;
                            *(f32x4*)(OUT + (size_t)row * D + col) = o;
                        }
                    });
            }
        }
        else if (mph == 10) {
            const bf16_t* W = W_RT + (size_t)layer * 128 * 1024;
            const float* rb = rtb_all + layer * 32;
            for (int u = vb; u < 256; u += G) {
                const int pm = u;
                sg_tile(lds, HB + (size_t)pm * 128 * D, D, W, D, D,
                    [=](int r, int c, f32x4 v0, f32x4 v1) {
                        const int row = pm * 128 + r;
                        if (c < 32) {
                            const f32x4 b0 = *(const f32x4*)(rb + c), b1 = *(const f32x4*)(rb + c + 16);
                            f32x4 a = v0 + b0, bq = v1 + b1;
                            *(f32x4*)(LOGIT + (size_t)row * 32 + c) = a; *(f32x4*)(LOGIT + (size_t)row * 32 + c + 16) = bq;
                        }
                    });
            }
        }
        else if (mph == 11) {
            unsigned* hist = (unsigned*)lds;
            unsigned* gcnt = ctl + CW_CNT + layer * 64;
            for (int blk = vb; blk < T / NTHR; blk += G) {
                if (tid < 64) hist[tid] = 0u;
                __syncthreads();
                const int tok = blk * NTHR + tid;
                float lg[32];
#pragma unroll
                for (int i = 0; i < 8; ++i) { const f32x4 v = *(const f32x4*)(LOGIT + (size_t)tok * 32 + 4 * i); lg[4 * i] = v.x; lg[4 * i + 1] = v.y; lg[4 * i + 2] = v.z; lg[4 * i + 3] = v.w; }
                int e4[4]; float v4[4];
#pragma unroll
                for (int k = 0; k < 4; ++k) {
                    float best = -INFINITY; int bi = 0;
#pragma unroll
                    for (int e = 0; e < 32; ++e) { const bool tk = lg[e] > best; best = tk ? lg[e] : best; bi = tk ? e : bi; }
                    e4[k] = bi; v4[k] = best;
#pragma unroll
                    for (int e = 0; e < 32; ++e) lg[e] = (e == bi) ? -INFINITY : lg[e];
                }
                float den = 0.f, ex[4];
#pragma unroll
                for (int k = 0; k < 4; ++k) { ex[k] = __expf(v4[k] - v4[0]); den += ex[k]; }
                unsigned lp[4];
#pragma unroll
                for (int k = 0; k < 4; ++k) lp[k] = atomicAdd(hist + e4[k], 1u);
                __syncthreads();
                if (tid < 32) hist[32 + tid] = atomicAdd(gcnt + tid, (unsigned)hist[tid]);
                __syncthreads();
#pragma unroll
                for (int k = 0; k < 4; ++k) {
                    tok_e[tok * 4 + k] = e4[k]; tok_pos[tok * 4 + k] = (int)(hist[32 + e4[k]] + lp[k]); tok_gate[tok * 4 + k] = ex[k] / den;
                }
                __syncthreads();
            }
        }
        else if (mph == 12 || mph == 13 || mph == 14) {
            int* pst = (int*)(lds + 140 * 1024 - 1024);
            if (tid == 0) {
                const unsigned* gcnt = ctl + CW_CNT + layer * 64; int acc = 0;
                for (int e = 0; e < 32; ++e) { const int c = (int)gcnt[e]; pst[e] = acc; pst[64 + e] = c; acc += (c + 255) & ~255; }
                pst[32] = acc;
            }
            __syncthreads();
            const int total_rows = pst[32];
            if (mph == 12) {
                for (int it = gw; it < T * 4; it += NGW) {
                    const int tok = it >> 2, e = tok_e[it], row = pst[e] + tok_pos[it];
                    const u32x4* s = (const u32x4*)(HB + (size_t)tok * D);
                    u32x4* d = (u32x4*)(XB + (size_t)row * D);
                    d[lane] = s[lane]; d[lane + 64] = s[lane + 64];
                    if (lane == 0) { row_slot[row] = it; row_gate[row] = tok_gate[it]; }
                }
                for (int e = 0; e < 32; ++e) {
                    const int lo = pst[e] + pst[64 + e], hi2 = pst[e + 1];
                    for (int r = lo + vb * NTHR + tid; r < hi2; r += G * NTHR) { row_slot[r] = -1; row_gate[r] = 0.f; }
                }
            } else if (mph == 13) {
                const int nt128 = total_rows >> 7;
                for (int u = vb; u < nt128 * 16; u += G) {
                    const int pm = u >> 4, pn = u & 15, row0 = pm * 128;
                    int e = 0;
                    for (int q = 1; q < 32; ++q) e = (row0 >= pst[q]) ? q : e;
                    const bf16_t* W = W_GU + ((size_t)(layer * 32 + e) * 2048 + pn * 128) * 1024;
                    const float* bg = bgu_all + (size_t)(layer * 32 + e) * 2048;
                    sg_tile(lds, XB + (size_t)row0 * D, D, W, D, D,
                        [=](int r, int c, f32x4 v0, f32x4 v1) {
                            const int j = pn * 64 + (c >> 5) * 16 + (c & 15);
                            const f32x4 b0 = *(const f32x4*)(bg + j), b1 = *(const f32x4*)(bg + 1024 + j);
                            float o[4];
#pragma unroll
                            for (int i = 0; i < 4; ++i) {
                                const float gt = fminf(v0[i] + b0[i], 7.0f), ln = fminf(fmaxf(v1[i] + b1[i], -7.0f), 7.0f);
                                o[i] = gt * sigmoidf_(1.702f * gt) * (ln + 1.0f);
                            }
                            u32x2 w; w.x = pk2(o[0], o[1]); w.y = pk2(o[2], o[3]);
                            *(u32x2*)(ACT + (size_t)(row0 + r) * D + j) = w;
                        });
                }
            } else {
                const int nt128 = total_rows >> 7;
                for (int u = vb; u < nt128 * 8; u += G) {
                    const int pm = u >> 3, pn = u & 7, row0 = pm * 128;
                    int e = 0;
                    for (int q = 1; q < 32; ++q) e = (row0 >= pst[q]) ? q : e;
                    const bf16_t* W = W_DN + ((size_t)(layer * 32 + e) * 1024 + pn * 128) * 1024;
                    const float* bd = bdn_all + (size_t)(layer * 32 + e) * 1024;
                    sg_tile(lds, ACT + (size_t)row0 * D, D, W, D, D,
                        [=](int r, int c, f32x4 v0, f32x4 v1) {
                            const int row = row0 + r, slot = row_slot[row];
                            if (slot >= 0) {
                                const float gt = row_gate[row];
#pragma unroll
                                for (int h = 0; h < 2; ++h) {
                                    const int col = pn * 128 + c + 16 * h; const f32x4 v = h ? v1 : v0;
                                    const f32x4 bb = *(const f32x4*)(bd + col);
                                    u32x2 o; o.x = pk2((v.x + bb.x) * gt, (v.y + bb.y) * gt); o.y = pk2((v.z + bb.z) * gt, (v.w + bb.w) * gt);
                                    *(u32x2*)(Y + (size_t)slot * D + col) = o;
                                }
                            }
                        });
                }
            }
        }
        else if (ph == 16) {
            for (int u = vb; u < 256 * 12; u += G) {
                const int pm = u / 12, pn = u % 12;
                sg_tile(lds, HB + (size_t)pm * 128 * D, D, W_IN_O + (size_t)pn * 128 * D, D, D,
                    [=](int r, int c, f32x4 v0, f32x4 v1) {
                        const int row = pm * 128 + r;
#pragma unroll
                        for (int h = 0; h < 2; ++h) {
                            const int col = pn * 128 + c + 16 * h; f32x4 v = h ? v1 : v0;
                            if (col >= 512) { v.x = gelu_tanh(v.x); v.y = gelu_tanh(v.y); v.z = gelu_tanh(v.z); v.w = gelu_tanh(v.w); }
                            u32x2 o; o.x = pk2(v.x, v.y); o.y = pk2(v.z, v.w);
                            *(u32x2*)(Z + (size_t)row * 1536 + col) = o;
                        }
                    });
            }
        }
        else if (ph == 17) {
            for (int ck = vb; ck < T / 128; ck += G) {
                bf16_t* tile = (bf16_t*)lds;
                for (int tt = 0; tt < 16; ++tt) {
                    const int sl = wave * 16 + tt, row = ck * 128 + sl, t = row % S;
                    {
                        const int ch0 = lane * 8, w = 2 << (ch0 >> 7);
                        float acc[8], own[8];
#pragma unroll
                        for (int i = 0; i < 8; ++i) acc[i] = 0.f;
                        const int n = (t + 1 < w) ? t + 1 : w;
                        for (int q = 0; q < n; ++q) {
                            const u32x4 uv = *(const u32x4*)(Z + (size_t)(row - q) * 1536 + ch0);
                            const float f[8] = {__uint_as_float(uv.x << 16), __uint_as_float(uv.x & 0xffff0000u), __uint_as_float(uv.y << 16), __uint_as_float(uv.y & 0xffff0000u),
                                                __uint_as_float(uv.z << 16), __uint_as_float(uv.z & 0xffff0000u), __uint_as_float(uv.w << 16), __uint_as_float(uv.w & 0xffff0000u)};
#pragma unroll
                            for (int i = 0; i < 8; ++i) { acc[i] += f[i]; if (q == 0) own[i] = f[i]; }
                        }
                        const float inv = 1.0f / (float)n;
                        u32x4 o; o.x = pk2(acc[0] * inv - own[0], acc[1] * inv - own[1]); o.y = pk2(acc[2] * inv - own[2], acc[3] * inv - own[3]);
                        o.z = pk2(acc[4] * inv - own[4], acc[5] * inv - own[5]); o.w = pk2(acc[6] * inv - own[6], acc[7] * inv - own[7]);
                        *(u32x4*)(POOLED + (size_t)row * 512 + ch0) = o;
                    }
                    {
                        const u32x4 uv = *(const u32x4*)(Z + (size_t)row * 1536 + 1024 + lane * 8);
                        float f[8] = {__uint_as_float(uv.x << 16), __uint_as_float(uv.x & 0xffff0000u), __uint_as_float(uv.y << 16), __uint_as_float(uv.y & 0xffff0000u),
                                      __uint_as_float(uv.z << 16), __uint_as_float(uv.z & 0xffff0000u), __uint_as_float(uv.w << 16), __uint_as_float(uv.w & 0xffff0000u)};
                        float ss = 0.f;
#pragma unroll
                        for (int i = 0; i < 8; ++i) ss += f[i] * f[i];
                        const float rr = rsqrtf(wave_sum(ss) * (1.f / 512.f) + 1e-6f);
                        u32x4 o;
                        const float* gg = p.sgu_norm_g + lane * 8;
                        o.x = pk2(f[0] * rr * gg[0], f[1] * rr * gg[1]); o.y = pk2(f[2] * rr * gg[2], f[3] * rr * gg[3]);
                        o.z = pk2(f[4] * rr * gg[4], f[5] * rr * gg[5]); o.w = pk2(f[6] * rr * gg[6], f[7] * rr * gg[7]);
                        *(u32x4*)(tile + sl * 520 + lane * 8) = o;
                    }
                }
                __syncthreads();
                {
                    const int ch = tid;
                    bf16_t* dst = VTS + ((size_t)ck * 512 + ch) * 128;
                    for (int s8 = 0; s8 < 16; ++s8) {
                        unsigned w[4];
#pragma unroll
                        for (int i = 0; i < 4; ++i) w[i] = (unsigned)tile[(s8 * 8 + 2 * i) * 520 + ch] | ((unsigned)tile[(s8 * 8 + 2 * i + 1) * 520 + ch] << 16);
                        u32x4 o; o.x = w[0]; o.y = w[1]; o.z = w[2]; o.w = w[3];
                        *(u32x4*)(dst + s8 * 8) = o;
                    }
                }
                __syncthreads();
            }
        }
        else if (ph == 18) {
            for (int u = vb; u < 2048; u += G) {
                if (u < 1024) {
                    const int pm = u >> 2, gi = u & 3;
                    sg_tile(lds, POOLED + (size_t)pm * 128 * 512 + gi * 128, 512, W_POOL + (size_t)gi * 128 * 128, 128, 128,
                        [=](int r, int c, f32x4 v0, f32x4 v1) {
                            const int row = pm * 128 + r;
#pragma unroll
                            for (int h = 0; h < 2; ++h) {
                                const int col = gi * 128 + c + 16 * h; const f32x4 v = h ? v1 : v0;
                                const f32x4 sc = *(const f32x4*)(poolsc + col);
                                u32x2 o; o.x = pk2(v.x * sc.x, v.y * sc.y); o.y = pk2(v.z * sc.z, v.w * sc.w);
                                *(u32x2*)(MIXIN + (size_t)row * 1024 + col) = o;
                            }
                        });
                } else {
                    const int uu = u - 1024, ck = uu >> 2, h4 = uu & 3;
                    sg_tile(lds, W_SGU + (size_t)h4 * 128 * 128, 128, VTS + ((size_t)ck * 512 + h4 * 128) * 128, 128, 128,
                        [=](int r, int c, f32x4 v0, f32x4 v1) {
                            const int row = ck * 128 + r;
                            const float bias = sgub[h4 * 128 + r];
#pragma unroll
                            for (int h = 0; h < 2; ++h) {
                                const int dcol = c + 16 * h; const f32x4 v = h ? v1 : v0;
                                const u32x2 ug = *(const u32x2*)(Z + (size_t)row * 1536 + 512 + h4 * 128 + dcol);
                                u32x2 o; o.x = pk2((v.x + bias) * __uint_as_float(ug.x << 16), (v.y + bias) * __uint_as_float(ug.x & 0xffff0000u));
                                o.y = pk2((v.z + bias) * __uint_as_float(ug.y << 16), (v.w + bias) * __uint_as_float(ug.y & 0xffff0000u));
                                *(u32x2*)(MIXIN + (size_t)row * 1024 + 512 + h4 * 128 + dcol) = o;
                            }
                        });
                }
            }
        }

#if MK_ONE_LAUNCH
        if (ph + 1 < ph_hi) xcd_barrier(bar);
#endif
    }
}

typedef void (*kfn_t)(Params);
template <int PH> struct Tab { static void fill(kfn_t* t) { t[PH] = hybrid_fwd<PH>; Tab<PH - 1>::fill(t); } };
template <> struct Tab<-1> { static void fill(kfn_t*) {} };
static kfn_t g_tab[NPHASE];
static void set_attrs() {
#if MK_ONE_LAUNCH
    (void)hipFuncSetAttribute((const void*)hybrid_fwd<-1>, hipFuncAttributeMaxDynamicSharedMemorySize, LDS_BYTES);
#else
    Tab<NPHASE - 1>::fill(g_tab);
    for (int i = 0; i < NPHASE; ++i) (void)hipFuncSetAttribute((const void*)g_tab[i], hipFuncAttributeMaxDynamicSharedMemorySize, LDS_BYTES);
#endif
}
#if !MK_ONE_LAUNCH
static void launch_all(const Params& p, int grid, hipStream_t stream) {
    for (int ph = 0; ph < NPHASE; ++ph) hipLaunchKernelGGL(g_tab[ph], dim3(grid), dim3(NTHR), LDS_BYTES, stream, p);
}
#endif
extern "C" void kernel_launch(void* const* d_in, const int* in_sizes, int n_in, void* d_out, int out_size, void* d_ws, size_t ws_size, hipStream_t stream) {
    static int ready = 0;
    if (ready == 0) {
        if (n_in != 38 || ws_size < WS_END) { fprintf(stderr, "kernel_launch: unexpected n_in %d / ws %zu\n", n_in, ws_size); ready = -1; return; }
        set_attrs();
        ready = 1;
    }
    if (ready < 0) return;
    (void)hipMemsetAsync((char*)d_ws + WS_CTL, 0, CTL_ZERO_BYTES, stream);
    Params p{};
    const float** fp = (const float**)&p.x;
    (void)fp;
    p.x = (const float*)d_in[0]; p.c = (const float*)d_in[1]; p.pos = (const int*)d_in[2];
    p.ada_w = (const float*)d_in[3]; p.ada_b = (const float*)d_in[4]; p.norm_mix_g = (const float*)d_in[5]; p.norm_ffn_g = (const float*)d_in[6];
    p.router_w = (const float*)d_in[7]; p.router_b = (const float*)d_in[8]; p.moe_w_gu = (const float*)d_in[9]; p.moe_b_gu = (const float*)d_in[10];
    p.moe_w_dn = (const float*)d_in[11]; p.moe_b_dn = (const float*)d_in[12];
    p.even_w_in = (const float*)d_in[13]; p.q_norm_g = (const float*)d_in[14]; p.w_uq = (const float*)d_in[15]; p.kv_norm_g = (const float*)d_in[16];
    p.w_ukv = (const float*)d_in[17]; p.q_head_g = (const float*)d_in[18]; p.k_head_g = (const float*)d_in[19];
    p.s5_a_re = (const float*)d_in[20]; p.s5_a_im = (const float*)d_in[21]; p.s5_log_dt = (const float*)d_in[22]; p.s5_b_re = (const float*)d_in[23];
    p.s5_b_im = (const float*)d_in[24]; p.s5_c_re = (const float*)d_in[25]; p.s5_c_im = (const float*)d_in[26]; p.s5_d = (const float*)d_in[27];
    p.s5_glu_w = (const float*)d_in[28]; p.s5_glu_b = (const float*)d_in[29]; p.even_w_out = (const float*)d_in[30];
    p.odd_w_in = (const float*)d_in[31]; p.pool_w = (const float*)d_in[32]; p.pool_scale = (const float*)d_in[33]; p.sgu_norm_g = (const float*)d_in[34];
    p.sgu_w = (const float*)d_in[35]; p.sgu_b = (const float*)d_in[36]; p.odd_w_out = (const float*)d_in[37];
    p.out = (float*)d_out; p.ws = (unsigned char*)d_ws;
    const int grid = 256;
#if MK_ONE_LAUNCH
    p.ph_lo = 0; p.ph_hi = NPHASE;
    hipLaunchKernelGGL(hybrid_fwd<-1>, dim3(grid), dim3(NTHR), LDS_BYTES, stream, p);
#else
    p.ph_lo = 0; p.ph_hi = 1;
    launch_all(p, grid, stream);
#endif
}
```

```cpp
#include <hip/hip_runtime.h>
#include <cstdio>
#include <cstdint>

#ifndef MK_ONE_LAUNCH
#define MK_ONE_LAUNCH 1
#endif

typedef unsigned short bf16_t;
typedef short bf16x8 __attribute__((ext_vector_type(8)));
typedef short s16x4 __attribute__((ext_vector_type(4)));
typedef float f32x4 __attribute__((ext_vector_type(4)));
typedef float f32x16 __attribute__((ext_vector_type(16)));
typedef unsigned u32x4 __attribute__((ext_vector_type(4)));
typedef unsigned u32x2 __attribute__((ext_vector_type(2)));

constexpr int D = 1024, NB = 8, S = 4096, T = NB * S;
constexpr int NTHR = 512, NWAVE = 8;
constexpr int MOE_ROWS = 139264;
constexpr int NPHASE = 27;

constexpr size_t MiB = 1u << 20;
constexpr size_t WS_CTL = 0, CTL_ZERO_BYTES = 1 * MiB;
constexpr size_t WS_MOD = 1 * MiB;
constexpr size_t WS_S5AB = 2 * MiB;
constexpr size_t WS_PW = 3 * MiB;
constexpr size_t WS_KTAB = 5 * MiB;
constexpr size_t WS_TOK = 7 * MiB;
constexpr size_t WS_ROW = 9 * MiB;
constexpr size_t WS_LOGIT = 11 * MiB;
constexpr size_t WS_W_IN_E = 16 * MiB, WS_W_UQ = 18 * MiB, WS_W_UKV = 19 * MiB, WS_W_GLU = 20 * MiB, WS_W_OUT_E = 21 * MiB, WS_W_IN_O = 23 * MiB,
                 WS_W_OUT_O = 26 * MiB, WS_W_POOL = 28 * MiB, WS_W_SGU = 29 * MiB, WS_W_RT = 30 * MiB;
constexpr size_t WS_BT_END = 32 * MiB;
constexpr size_t WS_BT_MAIN = 40 * MiB;
constexpr size_t WS_W_GU = 112 * MiB;
constexpr size_t WS_W_DN = 368 * MiB;
constexpr size_t WS_HB = 496 * MiB;
constexpr size_t WS_MIXIN = 560 * MiB;
constexpr size_t WS_Y = 624 * MiB;
constexpr size_t WS_XB = 880 * MiB;
constexpr size_t WS_ACT = 1152 * MiB;
constexpr size_t WS_END = 1424 * MiB;
constexpr size_t WS_Z = 880 * MiB;
constexpr size_t WS_QN = 976 * MiB, WS_KVN = 992 * MiB, WS_QRAW = 1000 * MiB, WS_KVRAW = 1048 * MiB, WS_Q = 1112 * MiB, WS_K = 1160 * MiB, WS_VT = 1208 * MiB,
                 WS_AS5 = 1240 * MiB, WS_LEND = 1276 * MiB, WS_GACT = 1284 * MiB;
constexpr size_t WS_POOLED = 976 * MiB, WS_VTS = 1008 * MiB;
constexpr int CW_BAR = 4096, CW_CNT = 16384;

constexpr int LDS_BYTES = 147456;
constexpr int LDS_MISC = 140 * 1024;

struct Params {
    const float *x, *c; const int* pos;
    const float *ada_w, *ada_b, *norm_mix_g, *norm_ffn_g, *router_w, *router_b, *moe_w_gu, *moe_b_gu, *moe_w_dn, *moe_b_dn;
    const float *even_w_in, *q_norm_g, *w_uq, *kv_norm_g, *w_ukv, *q_head_g, *k_head_g;
    const float *s5_a_re, *s5_a_im, *s5_log_dt, *s5_b_re, *s5_b_im, *s5_c_re, *s5_c_im, *s5_d, *s5_glu_w, *s5_glu_b, *even_w_out;
    const float *odd_w_in, *pool_w, *pool_scale, *sgu_norm_g, *sgu_w, *sgu_b, *odd_w_out;
    float* out; unsigned char* ws; int ph_lo, ph_hi;
};

__device__ __forceinline__ float bf2f(unsigned short b) { return __uint_as_float(((unsigned)b) << 16); }
__device__ __forceinline__ unsigned pk2(float lo, float hi) {
    typedef float f2 __attribute__((ext_vector_type(2))); typedef __bf16 b2 __attribute__((ext_vector_type(2)));
    f2 v = {lo, hi}; b2 b = __builtin_convertvector(v, b2); return __builtin_bit_cast(unsigned, b);
}
__device__ __forceinline__ unsigned short f2bf(float f) { return (unsigned short)(pk2(f, 0.f) & 0xffffu); }
__device__ __forceinline__ float wave_sum(float v) {
#pragma unroll
    for (int o = 1; o < 64; o <<= 1) v += __shfl_xor(v, o);
    return v;
}
__device__ __forceinline__ float sigmoidf_(float x) { return 1.0f / (1.0f + __expf(-x)); }
__device__ __forceinline__ float gelu_tanh(float x) {
    const float u = 0.7978845608028654f * (x + 0.044715f * x * x * x);
    return x * sigmoidf_(2.0f * u);
}
__device__ __forceinline__ int crow(int r, int hi) { return (r & 3) + 8 * (r >> 2) + 4 * hi; }

#define LAS __attribute__((address_space(3)))
#define XB_TMO      128
#define XB_XCNT(j)  (256  + 64 * (j))
#define XB_XSUB(j)  (1280 + 64 * (j))
#define XB_XGEN(j)  (2304 + 64 * (j))
#define XB_TOP      3328
#define XB_TOPGEN   3392
#define XCD_BAR_WORDS 3456
#define XB_SPIN_CAP (1u << 20)
__device__ __forceinline__ unsigned xb_ld(unsigned* p)              { return __hip_atomic_load(p, __ATOMIC_RELAXED, __HIP_MEMORY_SCOPE_AGENT); }
__device__ __forceinline__ unsigned xb_add(unsigned* p, unsigned v) { return __hip_atomic_fetch_add(p, v, __ATOMIC_RELAXED, __HIP_MEMORY_SCOPE_AGENT); }
__device__ __forceinline__ unsigned xb_xcc_id() { return (unsigned)__builtin_amdgcn_s_getreg((3 << 11) | 20) & 0xFu; }
#define XB_SPIN(cond, bar) do { unsigned _sp = 0; while (cond) { __builtin_amdgcn_s_sleep(1); \
    if ((++_sp & 255u) == 0u) { if (xb_ld(&(bar)[XB_TMO])) break; if (_sp > XB_SPIN_CAP) { atomicAdd(&(bar)[XB_TMO], 1u); break; } } } } while (0)
struct XcdBarrier { unsigned* bar; unsigned x; volatile LAS unsigned* st; };
__device__ __forceinline__ XcdBarrier xcd_barrier_post(unsigned* bar, volatile LAS unsigned* st) {
    XcdBarrier b; b.bar = bar; b.x = xb_xcc_id(); b.st = st;
    if (threadIdx.x == 0) (void)xb_add(&bar[XB_XCNT(b.x)], 1u);
    return b;
}
__device__ __forceinline__ void xcd_barrier_complete(unsigned* bar, unsigned x, unsigned& nloc, unsigned& nx) {
    const unsigned G = gridDim.x * gridDim.y * gridDim.z;
    unsigned sum, cnt, mine, sp = 0u;
    for (;;) {
        sum = 0u; cnt = 0u; mine = 0u;
#pragma unroll
        for (unsigned j = 0; j < 16; ++j) { const unsigned c = xb_ld(&bar[XB_XCNT(j)]); sum += c; cnt += (c > 0u) ? 1u : 0u; mine = (j == x) ? c : mine; }
        if (sum == G) break;
        __builtin_amdgcn_s_sleep(1);
        if ((++sp & 255u) == 0u) { if (xb_ld(&bar[XB_TMO])) break; if (sp > XB_SPIN_CAP) { atomicAdd(&bar[XB_TMO], 1u); break; } }
    }
    nloc = mine > 0u ? mine : 1u; nx = cnt > 0u ? cnt : 1u;
}
__device__ __forceinline__ void xcd_barrier(const XcdBarrier& b) {
    asm volatile("s_waitcnt vmcnt(0)" ::: "memory");
    __syncthreads();
    if (threadIdx.x == 0) {
        unsigned* bar = b.bar;
        __builtin_amdgcn_s_waitcnt(0);
        unsigned nloc = b.st[0], nx = b.st[1];
        if (nloc == 0u) { xcd_barrier_complete(bar, b.x, nloc, nx); b.st[0] = nloc; b.st[1] = nx; }
        const unsigned old = xb_add(&bar[XB_XSUB(b.x)], 1u);
        const unsigned gen = old / nloc;
        if (old + 1u == (gen + 1u) * nloc) {
            __builtin_amdgcn_fence(__ATOMIC_RELEASE, "agent");
            asm volatile("s_waitcnt vmcnt(0)" ::: "memory");
            const unsigned og = xb_add(&bar[XB_TOP], 1u);
            const unsigned tg = og / nx;
            if (og + 1u == (tg + 1u) * nx) xb_add(&bar[XB_TOPGEN], 1u);
            else XB_SPIN(xb_ld(&bar[XB_TOPGEN]) == tg, bar);
            __builtin_amdgcn_fence(__ATOMIC_ACQUIRE, "agent");
            xb_add(&bar[XB_XGEN(b.x)], 1u);
            asm volatile("s_waitcnt vmcnt(0)" ::: "memory");
        } else {
            XB_SPIN(xb_ld(&bar[XB_XGEN(b.x)]) == gen, bar);
            __builtin_amdgcn_fence(__ATOMIC_ACQUIRE, "agent");
            asm volatile("s_waitcnt vmcnt(0)" ::: "memory");
        }
    }
    __syncthreads();
}

constexpr int SG_LDS = 2 * 128 * 144;
template <class Epi>
__device__ __forceinline__ void sg_tile(unsigned char* lds, const bf16_t* A, int lda, const bf16_t* Bt, int ldb, int K, Epi epi) {
    const int tid = threadIdx.x, lane = tid & 63, wid = tid >> 6, wr = wid >> 2, wc = wid & 3, fr = lane & 15, fq = lane >> 4;
    unsigned char* As = lds; unsigned char* Bs = lds + 128 * 144;
    f32x4 acc[4][2];
#pragma unroll
    for (int m = 0; m < 4; ++m)
#pragma unroll
        for (int n = 0; n < 2; ++n) acc[m][n] = (f32x4){0.f, 0.f, 0.f, 0.f};
    const int nt = K / 64;
    u32x4 ra[2], rb[2];
    const int r0 = tid >> 3, cc = tid & 7;
#pragma unroll
    for (int i = 0; i < 2; ++i) {
        ra[i] = *(const u32x4*)(A + (size_t)(r0 + 64 * i) * lda + cc * 8);
        rb[i] = *(const u32x4*)(Bt + (size_t)(r0 + 64 * i) * ldb + cc * 8);
    }
    for (int kt = 0; kt < nt; ++kt) {
        __syncthreads();
#pragma unroll
        for (int i = 0; i < 2; ++i) {
            *(u32x4*)(As + (r0 + 64 * i) * 144 + cc * 16) = ra[i];
            *(u32x4*)(Bs + (r0 + 64 * i) * 144 + cc * 16) = rb[i];
        }
        __syncthreads();
        if (kt + 1 < nt) {
#pragma unroll
            for (int i = 0; i < 2; ++i) {
                ra[i] = *(const u32x4*)(A + (size_t)(r0 + 64 * i) * lda + (kt + 1) * 64 + cc * 8);
                rb[i] = *(const u32x4*)(Bt + (size_t)(r0 + 64 * i) * ldb + (kt + 1) * 64 + cc * 8);
            }
        }
#pragma unroll
        for (int kk = 0; kk < 2; ++kk) {
            bf16x8 a[4], b[2];
#pragma unroll
            for (int m = 0; m < 4; ++m) a[m] = *(const bf16x8*)(As + (wr * 64 + m * 16 + fr) * 144 + kk * 64 + fq * 16);
#pragma unroll
            for (int n = 0; n < 2; ++n) b[n] = *(const bf16x8*)(Bs + (wc * 32 + n * 16 + fr) * 144 + kk * 64 + fq * 16);
#pragma unroll
            for (int m = 0; m < 4; ++m)
#pragma unroll
                for (int n = 0; n < 2; ++n) acc[m][n] = __builtin_amdgcn_mfma_f32_16x16x32_bf16(b[n], a[m], acc[m][n], 0, 0, 0);
        }
    }
#pragma unroll
    for (int m = 0; m < 4; ++m) epi(wr * 64 + m * 16 + fr, wc * 32 + fq * 4, acc[m][0], acc[m][1]);
}

__device__ __forceinline__ void transpose_item(const float* W, int K, int N, bf16_t* WT, float* scr, int item, int lane, int mode) {
    const int nblk = N / 32, kb = item / nblk, nb = item % nblk, k0 = 64 * kb, n0 = 32 * nb;
#pragma unroll 8
    for (int i = 0; i < 32; ++i) { const int kk = 2 * i + (lane >> 5); scr[kk * 33 + (lane & 31)] = W[(size_t)(k0 + kk) * N + n0 + (lane & 31)]; }
    __builtin_amdgcn_s_waitcnt(0xC07F); asm volatile("" ::: "memory");
    const int c = lane & 7;
#pragma unroll
    for (int j = 0; j < 4; ++j) {
        const int n = (lane >> 3) + 8 * j; const float* s = scr + (8 * c) * 33 + n;
        u32x4 o; o.x = pk2(s[0 * 33], s[1 * 33]); o.y = pk2(s[2 * 33], s[3 * 33]); o.z = pk2(s[4 * 33], s[5 * 33]); o.w = pk2(s[6 * 33], s[7 * 33]);
        int nn = n0 + n;
        if (mode == 1) { const int half = nn >= 1024; const int jj = nn - half * 1024; nn = 32 * (jj >> 4) + 16 * half + (jj & 15); }
        *(u32x4*)(WT + (size_t)nn * K + k0 + 8 * c) = o;
    }
    __builtin_amdgcn_s_waitcnt(0xC07F); asm volatile("" ::: "memory");
}
__device__ __forceinline__ void transpose_many(const float* W, int nmat, int K, int N, bf16_t* WT, size_t dst_stride, float* scr, int gw, int NGW, int lane, int mode) {
    const int per = (K / 64) * (N / 32); const long tot = (long)nmat * per;
    for (long it = gw; it < tot; it += NGW) {
        const int mt = (int)(it / per), r = (int)(it % per);
        transpose_item(W + (size_t)mt * K * N, K, N, WT + (size_t)mt * dst_stride, scr, r, lane, mode);
    }
}

__device__ __forceinline__ void norm_mod_store(f32x4 (&v)[4], const float* g, const float* sc, const float* sh, bf16_t* orow, int lane) {
    float s = 0.f;
#pragma unroll
    for (int j = 0; j < 4; ++j) s += (v[j].x * v[j].x + v[j].y * v[j].y) + (v[j].z * v[j].z + v[j].w * v[j].w);
    const float r = rsqrtf(wave_sum(s) * (1.0f / D) + 1e-6f);
#pragma unroll
    for (int j = 0; j < 4; ++j) {
        const int c = 4 * lane + 256 * j;
        const f32x4 gg = *(const f32x4*)(g + c), s1 = *(const f32x4*)(sc + c), s0 = *(const f32x4*)(sh + c);
        const float a = v[j].x * r * gg.x * (1.f + s1.x) + s0.x, b = v[j].y * r * gg.y * (1.f + s1.y) + s0.y,
                    cc = v[j].z * r * gg.z * (1.f + s1.z) + s0.z, d = v[j].w * r * gg.w * (1.f + s1.w) + s0.w;
        u32x2 o; o.x = pk2(a, b); o.y = pk2(cc, d);
        *(u32x2*)(orow + c) = o;
    }
}

template <int PHSEL> __global__ void __launch_bounds__(NTHR, 2) hybrid_fwd(Params p) {
    extern __shared__ __attribute__((aligned(16))) unsigned char lds[];
    const int tid0 = threadIdx.x;
    unsigned* ctl0 = (unsigned*)(p.ws + WS_CTL);
    for (int u = tid0; u < (LDS_BYTES - LDS_MISC) / 4; u += NTHR) ((unsigned*)(lds + LDS_MISC))[u] = 0u;
    __syncthreads();
    volatile LAS unsigned* MISC = (volatile LAS unsigned*)((LAS unsigned char*)lds + LDS_MISC);
#if MK_ONE_LAUNCH
    XcdBarrier bar = xcd_barrier_post(ctl0 + CW_BAR, MISC + 8);
#endif

    const int ph_lo = (PHSEL >= 0) ? PHSEL : p.ph_lo, ph_hi = (PHSEL >= 0) ? PHSEL + 1 : p.ph_hi;
    for (int ph = ph_lo; ph < ph_hi; ++ph) {
        int tid = threadIdx.x; asm volatile("" : "+v"(tid));
        int vb = blockIdx.x, G = gridDim.x; asm volatile("" : "+s"(vb), "+s"(G));
        const int lane = tid & 63, wave = tid >> 6;
        const int gw = vb * NWAVE + wave, NGW = G * NWAVE;
        unsigned char* ws = p.ws; asm volatile("" : "+s"(ws));
        unsigned* ctl = (unsigned*)(ws + WS_CTL);
        float* MOD = (float*)(ws + WS_MOD);
        float* S5AB = (float*)(ws + WS_S5AB); float* S5BB = (float*)(ws + WS_S5AB + 65536);
        float* PW = (float*)(ws + WS_PW); float* KTAB = (float*)(ws + WS_KTAB);
        int* tok_e = (int*)(ws + WS_TOK); int* tok_pos = (int*)(ws + WS_TOK + 512 * 1024); float* tok_gate = (float*)(ws + WS_TOK + 1024 * 1024);
        int* row_slot = (int*)(ws + WS_ROW); float* row_gate = (float*)(ws + WS_ROW + MiB);
        float* LOGIT = (float*)(ws + WS_LOGIT);
        bf16_t* W_IN_E = (bf16_t*)(ws + WS_W_IN_E); bf16_t* W_UQ = (bf16_t*)(ws + WS_W_UQ); bf16_t* W_UKV = (bf16_t*)(ws + WS_W_UKV); bf16_t* W_GLU = (bf16_t*)(ws + WS_W_GLU);
        bf16_t* W_OUT_E = (bf16_t*)(ws + WS_W_OUT_E); bf16_t* W_IN_O = (bf16_t*)(ws + WS_W_IN_O); bf16_t* W_OUT_O = (bf16_t*)(ws + WS_W_OUT_O);
        bf16_t* W_POOL = (bf16_t*)(ws + WS_W_POOL); bf16_t* W_SGU = (bf16_t*)(ws + WS_W_SGU); bf16_t* W_RT = (bf16_t*)(ws + WS_W_RT);
        bf16_t* BT_END = (bf16_t*)(ws + WS_BT_END); bf16_t* BT_MAIN = (bf16_t*)(ws + WS_BT_MAIN);
        bf16_t* W_GU = (bf16_t*)(ws + WS_W_GU); bf16_t* W_DN = (bf16_t*)(ws + WS_W_DN);
        bf16_t* HB = (bf16_t*)(ws + WS_HB); bf16_t* MIXIN = (bf16_t*)(ws + WS_MIXIN); bf16_t* Y = (bf16_t*)(ws + WS_Y);
        bf16_t* XB = (bf16_t*)(ws + WS_XB); bf16_t* ACT = (bf16_t*)(ws + WS_ACT);
        bf16_t* Z = (bf16_t*)(ws + WS_Z); bf16_t* QN = (bf16_t*)(ws + WS_QN); bf16_t* KVN = (bf16_t*)(ws + WS_KVN); bf16_t* QRAW = (bf16_t*)(ws + WS_QRAW); bf16_t* KVRAW = (bf16_t*)(ws + WS_KVRAW);
        bf16_t* Qb = (bf16_t*)(ws + WS_Q); bf16_t* Kb = (bf16_t*)(ws + WS_K); bf16_t* VT = (bf16_t*)(ws + WS_VT);
        bf16_t* AS5 = (bf16_t*)(ws + WS_AS5); float* LEND = (float*)(ws + WS_LEND); bf16_t* GACT = (bf16_t*)(ws + WS_GACT);
        bf16_t* POOLED = (bf16_t*)(ws + WS_POOLED); bf16_t* VTS = (bf16_t*)(ws + WS_VTS);
        float* OUT = p.out; const float* XIN = p.x;
        const float* s5d = p.s5_d; const float* glub = p.s5_glu_b; const float* poolsc = p.pool_scale; const float* sgub = p.sgu_b;
        const float* bgu_all = p.moe_b_gu; const float* bdn_all = p.moe_b_dn; const float* rtb_all = p.router_b;

        int layer = 0, mph = ph;
        if (ph >= 20 && ph <= 25) { layer = 1; mph = ph - 11; }
        const float* mod_l = MOD + (size_t)layer * NB * 6144;

        if (ph == 0) {
            const int gt = vb * NTHR + tid;
            if (gt < 2048) {
                const int g = gt >> 6, pp = gt & 63;
                const float dt = expf(p.s5_log_dt[g]);
                const float lre = fminf(p.s5_a_re[g * 64 + pp], -1e-4f), lim = p.s5_a_im[g * 64 + pp];
                const float mag = expf(lre * dt);
                const float abr = mag * cosf(lim * dt), abi = mag * sinf(lim * dt);
                const float den = lre * lre + lim * lim, nr = abr - 1.0f;
                const float fre = (nr * lre + abi * lim) / den, fim = (abi * lre - nr * lim) / den;
                S5AB[(g * 64 + pp) * 2 + 0] = abr; S5AB[(g * 64 + pp) * 2 + 1] = abi;
                for (int j = 0; j < 16; ++j) {
                    const float br = p.s5_b_re[(g * 64 + pp) * 16 + j], bi = p.s5_b_im[(g * 64 + pp) * 16 + j];
                    S5BB[((g * 64 + pp) * 16 + j) * 2 + 0] = fre * br - fim * bi;
                    S5BB[((g * 64 + pp) * 16 + j) * 2 + 1] = fre * bi + fim * br;
                }
                float pr = 1.f, pi = 0.f;
                for (int tau = 0; tau <= 64; ++tau) {
                    PW[((g * 64 + pp) * 65 + tau) * 2 + 0] = pr; PW[((g * 64 + pp) * 65 + tau) * 2 + 1] = pi;
                    const float nr2 = pr * abr - pi * abi, ni2 = pr * abi + pi * abr; pr = nr2; pi = ni2;
                }
            }
            {
                float* ca = (float*)lds;
                for (int i = tid; i < NB * D; i += NTHR) { const float cv = p.c[i]; ca[i] = cv * sigmoidf_(cv); }
                __syncthreads();
                for (int task = gw; task < 2 * 96; task += NGW) {
                    const int l = task / 96, cb = task % 96, col = cb * 64 + lane;
                    const float* W = p.ada_w + (size_t)l * D * 6144 + col;
                    float acc[8];
#pragma unroll
                    for (int b = 0; b < 8; ++b) acc[b] = 0.f;
                    for (int k = 0; k < D; k += 8) {
                        float w[8];
#pragma unroll
                        for (int u = 0; u < 8; ++u) w[u] = W[(size_t)(k + u) * 6144];
#pragma unroll
                        for (int u = 0; u < 8; ++u)
#pragma unroll
                            for (int b = 0; b < 8; ++b) acc[b] += ca[b * D + k + u] * w[u];
                    }
                    const float bias = p.ada_b[l * 6144 + col];
#pragma unroll
                    for (int b = 0; b < 8; ++b) MOD[((size_t)l * NB + b) * 6144 + col] = acc[b] + bias;
                }
                __syncthreads();
            }
            {
                float* scr = (float*)(lds + wave * 16384);
                transpose_many(p.even_w_in, 1, 1024, 928, W_IN_E, 0, scr, gw, NGW, lane, 0);
                transpose_many(p.w_uq, 1, 256, 768, W_UQ, 0, scr, gw, NGW, lane, 0);
                transpose_many(p.w_ukv, 1, 128, 1024, W_UKV, 0, scr, gw, NGW, lane, 0);
                transpose_many(p.s5_glu_w, 1, 512, 512, W_GLU, 0, scr, gw, NGW, lane, 0);
                transpose_many(p.even_w_out, 1, 1024, 1024, W_OUT_E, 0, scr, gw, NGW, lane, 0);
                transpose_many(p.odd_w_in, 1, 1024, 1536, W_IN_O, 0, scr, gw, NGW, lane, 0);
                transpose_many(p.odd_w_out, 1, 1024, 1024, W_OUT_O, 0, scr, gw, NGW, lane, 0);
                transpose_many(p.pool_w, 4, 128, 128, W_POOL, 128 * 128, scr, gw, NGW, lane, 0);
                transpose_many(p.router_w, 2, 1024, 32, W_RT, 128 * 1024, scr, gw, NGW, lane, 0);
                transpose_many(p.moe_w_gu, 64, 1024, 2048, W_GU, (size_t)2048 * 1024, scr, gw, NGW, lane, 1);
                transpose_many(p.moe_w_dn, 64, 1024, 1024, W_DN, (size_t)1024 * 1024, scr, gw, NGW, lane, 0);
                for (int i = vb * NTHR + tid; i < 4 * 128 * 128; i += G * NTHR) {
                    const int t = (i >> 7) & 127, s_ = i & 127;
                    W_SGU[i] = (s_ <= t) ? f2bf(p.sgu_w[i]) : (bf16_t)0;
                }
            }
        }
        else if (ph == 1 || ph == 9 || ph == 15 || ph == 20 || ph == 26) {
            const int lyr = (ph == 1 || ph == 9) ? 0 : 1;
            const bool combine = (ph == 15 || ph == 26), donorm = (ph != 26);
            const int comb_layer = (ph == 15) ? 0 : 1;
            const bool ffn = (ph == 9 || ph == 20);
            const float* src = (ph == 1) ? p.x : p.out;
            const float* ng = (ffn ? p.norm_ffn_g : p.norm_mix_g) + lyr * D;
            for (int row = gw; row < T; row += NGW) {
                const int b = row / S;
                f32x4 v[4];
#pragma unroll
                for (int j = 0; j < 4; ++j) v[j] = *(const f32x4*)(src + (size_t)row * D + 4 * lane + 256 * j);
                if (combine) {
                    const float* gf = MOD + ((size_t)comb_layer * NB + b) * 6144 + 5 * D;
#pragma unroll
                    for (int j = 0; j < 4; ++j) {
                        const int c = 4 * lane + 256 * j;
                        float a0 = 0.f, a1 = 0.f, a2 = 0.f, a3 = 0.f;
#pragma unroll
                        for (int k = 0; k < 4; ++k) {
                            const u32x2 yy = *(const u32x2*)(Y + ((size_t)row * 4 + k) * D + c);
                            a0 += __uint_as_float(yy.x << 16); a1 += __uint_as_float(yy.x & 0xffff0000u);
                            a2 += __uint_as_float(yy.y << 16); a3 += __uint_as_float(yy.y & 0xffff0000u);
                        }
                        const f32x4 g4 = *(const f32x4*)(gf + c);
                        v[j].x += g4.x * a0; v[j].y += g4.y * a1; v[j].z += g4.z * a2; v[j].w += g4.w * a3;
                        *(f32x4*)(p.out + (size_t)row * D + c) = v[j];
                    }
                }
                if (donorm) {
                    const float* mm = MOD + ((size_t)lyr * NB + b) * 6144 + (ffn ? 3 * D : 0);
                    norm_mod_store(v, ng, mm + D, mm, HB + (size_t)row * D, lane);
                }
            }
            if (ph == 1) {
                for (int idx = vb * NTHR + tid; idx < 32 * 64 * 256; idx += G * NTHR) {
                    const int j = idx & 15, i = (idx >> 4) & 15, tau = (idx >> 8) & 63, g = idx >> 14;
                    float acc = 0.f;
                    for (int pp = 0; pp < 64; ++pp) {
                        const float cr = p.s5_c_re[(g * 16 + i) * 64 + pp], ci = p.s5_c_im[(g * 16 + i) * 64 + pp];
                        const float pr = PW[((g * 64 + pp) * 65 + tau) * 2], pi = PW[((g * 64 + pp) * 65 + tau) * 2 + 1];
                        const float br = S5BB[((g * 64 + pp) * 16 + j) * 2], bi = S5BB[((g * 64 + pp) * 16 + j) * 2 + 1];
                        const float qr = pr * br - pi * bi, qi = pr * bi + pi * br;
                        acc += cr * qr - ci * qi;
                    }
                    KTAB[idx] = acc;
                }
            }
        }
        else if (ph == 2) {
            for (int u = vb; u < 256 * 8; u += G) {
                const int pm = u >> 3, pn = u & 7;
                sg_tile(lds, HB + (size_t)pm * 128 * D, D, W_IN_E + (size_t)pn * 128 * D, D, D,
                    [=](int r, int c, f32x4 v0, f32x4 v1) {
                        const int row = pm * 128 + r;
#pragma unroll
                        for (int h = 0; h < 2; ++h) {
                            const int col = pn * 128 + c + 16 * h; const f32x4 v = h ? v1 : v0;
                            u32x2 o; o.x = pk2(v.x, v.y); o.y = pk2(v.z, v.w);
                            if (col < 416) *(u32x2*)(Z + (size_t)row * 1024 + col) = o;
                            else if (col < 928) {
                                const int ch = col - 416, g = ch >> 4, j = ch & 15, b = row / S, t = row % S;
                                *(u32x2*)(AS5 + ((size_t)g * 512 + b * 64 + (t >> 6)) * 1152 + 128 + (t & 63) * 16 + j) = o;
                            }
                        }
                    });
            }
            for (int idx = vb * NTHR + tid; idx < 32 * 128 * 128; idx += G * NTHR) {
                const int k8 = idx & 127, n = (idx >> 7) & 127, g = idx >> 14;
                const int ri = n >> 6, pp = n & 63, s_ = k8 >> 1, j0 = (k8 & 1) * 8;
                const float pr = PW[((g * 64 + pp) * 65 + (63 - s_)) * 2], pi = PW[((g * 64 + pp) * 65 + (63 - s_)) * 2 + 1];
                float o[8];
#pragma unroll
                for (int j = 0; j < 8; ++j) {
                    const float br = S5BB[((g * 64 + pp) * 16 + j0 + j) * 2], bi = S5BB[((g * 64 + pp) * 16 + j0 + j) * 2 + 1];
                    o[j] = ri ? (pr * bi + pi * br) : (pr * br - pi * bi);
                }
                u32x4 w; w.x = pk2(o[0], o[1]); w.y = pk2(o[2], o[3]); w.z = pk2(o[4], o[5]); w.w = pk2(o[6], o[7]);
                *(u32x4*)(BT_END + ((size_t)g * 128 + n) * 1024 + k8 * 8) = w;
            }
            for (int idx = vb * NTHR + tid; idx < 32 * 1024 * 144; idx += G * NTHR) {
                const int k8 = idx % 144, n = (idx / 144) & 1023, g = idx / (144 * 1024);
                const int t = n >> 4, i = n & 15;
                float o[8];
                if (k8 < 16) {
                    const int ri = k8 >> 3, p0 = (k8 & 7) * 8;
#pragma unroll
                    for (int j = 0; j < 8; ++j) {
                        const int pp = p0 + j;
                        const float cr = p.s5_c_re[(g * 16 + i) * 64 + pp], ci = p.s5_c_im[(g * 16 + i) * 64 + pp];
                        const float pr = PW[((g * 64 + pp) * 65 + t + 1) * 2], pi = PW[((g * 64 + pp) * 65 + t + 1) * 2 + 1];
                        o[j] = ri ? -(cr * pi + ci * pr) : (cr * pr - ci * pi);
                    }
                } else {
                    const int kk = (k8 - 16) * 8, s_ = kk >> 4, j0 = kk & 15;
#pragma unroll
                    for (int j = 0; j < 8; ++j) o[j] = (s_ <= t) ? KTAB[((g * 64 + (t - s_)) * 16 + i) * 16 + j0 + j] : 0.f;
                }
                u32x4 w; w.x = pk2(o[0], o[1]); w.y = pk2(o[2], o[3]); w.z = pk2(o[4], o[5]); w.w = pk2(o[6], o[7]);
                *(u32x4*)(BT_MAIN + ((size_t)g * 1024 + n) * 1152 + k8 * 8) = w;
            }
        }
        else if (ph == 3) {
            for (int row = gw; row < T; row += NGW) {
                const u32x2 qv = *(const u32x2*)(Z + (size_t)row * 1024 + lane * 4);
                const unsigned kv = *(const unsigned*)(Z + (size_t)row * 1024 + 256 + lane * 2);
                const float q0 = __uint_as_float(qv.x << 16), q1 = __uint_as_float(qv.x & 0xffff0000u), q2 = __uint_as_float(qv.y << 16), q3 = __uint_as_float(qv.y & 0xffff0000u);
                const float k0 = __uint_as_float(kv << 16), k1 = __uint_as_float(kv & 0xffff0000u);
                const float rq = rsqrtf(wave_sum(q0 * q0 + q1 * q1 + q2 * q2 + q3 * q3) * (1.f / 256.f) + 1e-6f);
                const float rk = rsqrtf(wave_sum(k0 * k0 + k1 * k1) * (1.f / 128.f) + 1e-6f);
                const f32x4 gq = *(const f32x4*)(p.q_norm_g + lane * 4);
                u32x2 o; o.x = pk2(q0 * rq * gq.x, q1 * rq * gq.y); o.y = pk2(q2 * rq * gq.z, q3 * rq * gq.w);
                *(u32x2*)(QN + (size_t)row * 256 + lane * 4) = o;
                *(unsigned*)(KVN + (size_t)row * 128 + lane * 2) = pk2(k0 * rk * p.kv_norm_g[lane * 2], k1 * rk * p.kv_norm_g[lane * 2 + 1]);
            }
        }
        else if (ph == 4) {
            for (int u = vb; u < 256 * 6 + 256 * 8 + 128; u += G) {
                if (u < 256 * 6) {
                    const int pm = u / 6, pn = u % 6;
                    sg_tile(lds, QN + (size_t)pm * 128 * 256, 256, W_UQ + (size_t)pn * 128 * 256, 256, 256,
                        [=](int r, int c, f32x4 v0, f32x4 v1) {
                            bf16_t* o = QRAW + (size_t)(pm * 128 + r) * 768 + pn * 128 + c;
                            u32x2 a; a.x = pk2(v0.x, v0.y); a.y = pk2(v0.z, v0.w); *(u32x2*)o = a;
                            u32x2 b; b.x = pk2(v1.x, v1.y); b.y = pk2(v1.z, v1.w); *(u32x2*)(o + 16) = b;
                        });
                } else if (u < 256 * 14) {
                    const int uu = u - 256 * 6, pm = uu >> 3, pn = uu & 7;
                    sg_tile(lds, KVN + (size_t)pm * 128 * 128, 128, W_UKV + (size_t)pn * 128 * 128, 128, 128,
                        [=](int r, int c, f32x4 v0, f32x4 v1) {
                            bf16_t* o = KVRAW + (size_t)(pm * 128 + r) * 1024 + pn * 128 + c;
                            u32x2 a; a.x = pk2(v0.x, v0.y); a.y = pk2(v0.z, v0.w); *(u32x2*)o = a;
                            u32x2 b; b.x = pk2(v1.x, v1.y); b.y = pk2(v1.z, v1.w); *(u32x2*)(o + 16) = b;
                        });
                } else {
                    const int uu = u - 256 * 14, g = uu >> 2, pm = uu & 3;
                    sg_tile(lds, AS5 + ((size_t)g * 512 + pm * 128) * 1152 + 128, 1152, BT_END + (size_t)g * 128 * 1024, 1024, 1024,
                        [=](int r, int c, f32x4 v0, f32x4 v1) {
                            float* o = LEND + ((size_t)g * 512 + pm * 128 + r) * 128 + c;
                            *(f32x4*)o = v0; *(f32x4*)(o + 16) = v1;
                        });
                }
            }
        }
        else if (ph == 5) {
            bf16_t* stq = (bf16_t*)(lds + 65536) + wave * 1536;
            bf16_t* vts = (bf16_t*)lds;
            const float qscale = 0.10206207261596577f * 1.4426950408889634f;
            for (int tile = vb; tile < T / 64; tile += G) {
                const int hh = lane >> 3, pp = lane & 7;
                for (int tt = 0; tt < 8; ++tt) {
                    const int tl = wave * 8 + tt, row = tile * 64 + tl, b = row / S, t = row % S;
                    float qv[12], kv[12];
#pragma unroll
                    for (int j = 0; j < 12; ++j) {
                        const int d = pp + 8 * j;
                        qv[j] = bf2f(QRAW[(size_t)row * 768 + hh * 96 + d]);
                        kv[j] = (j < 8) ? bf2f(KVRAW[(size_t)row * 1024 + hh * 128 + d]) : bf2f(Z[(size_t)row * 1024 + 384 + d - 64]);
                    }
                    float sq = 0.f, sk = 0.f;
#pragma unroll
                    for (int j = 0; j < 12; ++j) { sq += qv[j] * qv[j]; sk += kv[j] * kv[j]; }
                    sq += __shfl_xor(sq, 1); sq += __shfl_xor(sq, 2); sq += __shfl_xor(sq, 4);
                    sk += __shfl_xor(sk, 1); sk += __shfl_xor(sk, 2); sk += __shfl_xor(sk, 4);
                    const float rq = rsqrtf(sq * (1.f / 96.f) + 1e-6f), rk = rsqrtf(sk * (1.f / 96.f) + 1e-6f);
#pragma unroll
                    for (int j = 0; j < 12; ++j) { const int d = pp + 8 * j; qv[j] *= rq * p.q_head_g[d]; kv[j] *= rk * p.k_head_g[d]; }
                    const float posf = (float)p.pos[row];
#pragma unroll
                    for (int e = 0; e < 2; ++e) {
                        const int i = pp + 8 * e;
                        const float invf = exp2f(-(float)i * (13.287712379549449f / 16.0f));
                        const float ang = posf * invf;
                        const float kq = rintf(ang * 0.15915494309189535f);
                        float rr = __builtin_fmaf(-kq, 6.28318548202514648f, ang); rr = __builtin_fmaf(-kq, -1.7484556e-7f, rr);
                        const float cs = __cosf(rr), sn = __sinf(rr);
                        const float q1 = qv[8 + e], q2 = qv[10 + e], k1 = kv[8 + e], k2 = kv[10 + e];
                        qv[8 + e] = q1 * cs - q2 * sn; qv[10 + e] = q1 * sn + q2 * cs;
                        kv[8 + e] = k1 * cs - k2 * sn; kv[10 + e] = k1 * sn + k2 * cs;
                    }
#pragma unroll
                    for (int j = 0; j < 12; ++j) { const int d = pp + 8 * j; stq[hh * 96 + d] = f2bf(qv[j] * qscale); stq[768 + hh * 96 + d] = f2bf(kv[j]); }
#pragma unroll
                    for (int j = 0; j < 8; ++j) { const int dv = pp + 8 * j; vts[(hh * 64 + dv) * 64 + tl] = KVRAW[(size_t)row * 1024 + hh * 128 + 64 + dv]; }
                    __builtin_amdgcn_s_waitcnt(0xC07F); asm volatile("" ::: "memory");
                    for (int ch = lane; ch < 192; ch += 64) {
                        const int isk = ch >= 96, c2 = ch - 96 * isk, h2 = c2 / 12, part = c2 % 12;
                        const u32x4 vv = *(const u32x4*)(stq + isk * 768 + h2 * 96 + part * 8);
                        bf16_t* dst = (isk ? Kb : Qb) + (((size_t)b * 8 + h2) * S + t) * 96 + part * 8;
                        *(u32x4*)dst = vv;
                    }
                    __builtin_amdgcn_s_waitcnt(0xC07F); asm volatile("" ::: "memory");
                }
                __syncthreads();
                {
                    const int hd = tid, b = (tile * 64) / S, t0 = (tile * 64) % S;
                    bf16_t* dst = VT + (((size_t)b * 8 + (hd >> 6)) * 64 + (hd & 63)) * S + t0;
#pragma unroll
                    for (int i = 0; i < 8; ++i) *(u32x4*)(dst + i * 8) = *(const u32x4*)(vts + hd * 64 + i * 8);
                }
                __syncthreads();
            }
            for (int ch = vb * NTHR + tid; ch < NB * 32 * 64; ch += G * NTHR) {
                const int pp = ch & 63, g = (ch >> 6) & 31, b = ch >> 11;
                const float ar = PW[((g * 64 + pp) * 65 + 64) * 2], ai = PW[((g * 64 + pp) * 65 + 64) * 2 + 1];
                float cr = 0.f, ci = 0.f;
                for (int c = 0; c < 64; ++c) {
                    bf16_t* dst = AS5 + ((size_t)g * 512 + b * 64 + c) * 1152;
                    dst[pp] = f2bf(cr); dst[64 + pp] = f2bf(ci);
                    const float* le = LEND + ((size_t)g * 512 + b * 64 + c) * 128;
                    const float nr = ar * cr - ai * ci + le[pp], ni = ar * ci + ai * cr + le[64 + pp];
                    cr = nr; ci = ni;
                }
            }
        }
        else if (ph == 6) {
            unsigned char* Ks = lds;
            unsigned char* Vs = lds + 64 * 208;
            const int r32 = lane & 31, hi = lane >> 5;
            for (int ui = 0; ui < 4; ++ui) {
                if (vb >= 256) break;
                const int bh = vb & 63, kq = vb >> 6;
                const int qb = (ui == 0) ? 15 - kq : (ui == 1) ? 8 + kq : (ui == 2) ? 7 - kq : kq;
                const int q0 = qb * 256 + wave * 32;
                const bf16_t* Qg = Qb + ((size_t)bh * S + q0 + r32) * 96;
                const bf16_t* Kg = Kb + (size_t)bh * S * 96;
                const bf16_t* Vg = VT + (size_t)bh * 64 * S;
                bf16x8 qf[6];
#pragma unroll
                for (int d0 = 0; d0 < 6; ++d0) qf[d0] = *(const bf16x8*)(Qg + d0 * 16 + hi * 8);
                f32x16 o0, o1;
#pragma unroll
                for (int r = 0; r < 16; ++r) { o0[r] = 0.f; o1[r] = 0.f; }
                float m_run = -1e30f, l_run = 0.f;
                const int ntile = 4 * (qb + 1);
                u32x4 rk0, rk1, rv;
                const int kr0 = tid / 12, kc0 = tid % 12, kr1 = (tid + 512) / 12, kc1 = (tid + 512) % 12;
                const int vr = tid >> 3, vc = tid & 7;
                rk0 = *(const u32x4*)(Kg + (size_t)kr0 * 96 + kc0 * 8);
                if (tid < 256) rk1 = *(const u32x4*)(Kg + (size_t)kr1 * 96 + kc1 * 8);
                rv = *(const u32x4*)(Vg + (size_t)vr * S + vc * 8);
                for (int t = 0; t < ntile; ++t) {
                    __syncthreads();
                    *(u32x4*)(Ks + kr0 * 208 + kc0 * 16) = rk0;
                    if (tid < 256) *(u32x4*)(Ks + kr1 * 208 + kc1 * 16) = rk1;
                    { u32x2 a; a.x = rv.x; a.y = rv.y; u32x2 b2; b2.x = rv.z; b2.y = rv.w;
                      *(u32x2*)(Vs + vr * 136 + vc * 16) = a; *(u32x2*)(Vs + vr * 136 + vc * 16 + 8) = b2; }
                    __syncthreads();
                    if (t + 1 < ntile) {
                        rk0 = *(const u32x4*)(Kg + (size_t)((t + 1) * 64 + kr0) * 96 + kc0 * 8);
                        if (tid < 256) rk1 = *(const u32x4*)(Kg + (size_t)((t + 1) * 64 + kr1) * 96 + kc1 * 8);
                        rv = *(const u32x4*)(Vg + (size_t)vr * S + (t + 1) * 64 + vc * 8);
                    }
                    if (t * 64 > q0 + 31) continue;
                    f32x16 s0, s1;
#pragma unroll
                    for (int r = 0; r < 16; ++r) { s0[r] = 0.f; s1[r] = 0.f; }
#pragma unroll
                    for (int d0 = 0; d0 < 6; ++d0) {
                        const bf16x8 k0 = *(const bf16x8*)(Ks + r32 * 208 + d0 * 32 + hi * 16);
                        const bf16x8 k1 = *(const bf16x8*)(Ks + (32 + r32) * 208 + d0 * 32 + hi * 16);
                        s0 = __builtin_amdgcn_mfma_f32_32x32x16_bf16(k0, qf[d0], s0, 0, 0, 0);
                        s1 = __builtin_amdgcn_mfma_f32_32x32x16_bf16(k1, qf[d0], s1, 0, 0, 0);
                    }
                    if (t * 64 + 63 > q0) {
                        const int qi = q0 + r32;
#pragma unroll
                        for (int r = 0; r < 16; ++r) {
                            const int key = t * 64 + crow(r, hi);
                            if (key > qi) s0[r] = -INFINITY;
                            if (key + 32 > qi) s1[r] = -INFINITY;
                        }
                    }
                    float mx = s0[0];
#pragma unroll
                    for (int r = 1; r < 16; ++r) mx = fmaxf(mx, s0[r]);
#pragma unroll
                    for (int r = 0; r < 16; ++r) mx = fmaxf(mx, s1[r]);
                    mx = fmaxf(mx, __shfl_xor(mx, 32));
                    const float m_new = fmaxf(m_run, mx);
                    const float alpha = __builtin_amdgcn_exp2f(m_run - m_new);
                    m_run = m_new;
                    float ls = 0.f;
#pragma unroll
                    for (int r = 0; r < 16; ++r) { s0[r] = __builtin_amdgcn_exp2f(s0[r] - m_new); s1[r] = __builtin_amdgcn_exp2f(s1[r] - m_new); ls += s0[r] + s1[r]; }
                    l_run = l_run * alpha + ls;
#pragma unroll
                    for (int r = 0; r < 16; ++r) { o0[r] *= alpha; o1[r] *= alpha; }
                    bf16x8 pf[2][2];
#pragma unroll
                    for (int ks = 0; ks < 2; ++ks) {
                        u32x4 w0, w1;
                        w0.x = pk2(s0[8 * ks + 0], s0[8 * ks + 1]); w0.y = pk2(s0[8 * ks + 2], s0[8 * ks + 3]); w0.z = pk2(s0[8 * ks + 4], s0[8 * ks + 5]); w0.w = pk2(s0[8 * ks + 6], s0[8 * ks + 7]);
                        w1.x = pk2(s1[8 * ks + 0], s1[8 * ks + 1]); w1.y = pk2(s1[8 * ks + 2], s1[8 * ks + 3]); w1.z = pk2(s1[8 * ks + 4], s1[8 * ks + 5]); w1.w = pk2(s1[8 * ks + 6], s1[8 * ks + 7]);
                        pf[0][ks] = __builtin_bit_cast(bf16x8, w0); pf[1][ks] = __builtin_bit_cast(bf16x8, w1);
                    }
#pragma unroll
                    for (int kb = 0; kb < 2; ++kb)
#pragma unroll
                        for (int ks = 0; ks < 2; ++ks) {
                            const int koff = (kb * 32 + 16 * ks + 4 * hi) * 2;
#pragma unroll
                            for (int dvb = 0; dvb < 2; ++dvb) {
                                const unsigned char* vp = Vs + (dvb * 32 + r32) * 136 + koff;
                                const u32x2 lo = *(const u32x2*)vp, hi2 = *(const u32x2*)(vp + 16);
                                u32x4 w; w.x = lo.x; w.y = lo.y; w.z = hi2.x; w.w = hi2.y;
                                const bf16x8 vf = __builtin_bit_cast(bf16x8, w);
                                if (dvb == 0) o0 = __builtin_amdgcn_mfma_f32_32x32x16_bf16(vf, pf[kb][ks], o0, 0, 0, 0);
                                else o1 = __builtin_amdgcn_mfma_f32_32x32x16_bf16(vf, pf[kb][ks], o1, 0, 0, 0);
                            }
                        }
                }
                l_run += __shfl_xor(l_run, 32);
                const float rl = 1.0f / l_run;
                const int b = bh >> 3, h = bh & 7;
                bf16_t* orow = MIXIN + ((size_t)b * S + q0 + r32) * 1024 + h * 64;
#pragma unroll
                for (int rg = 0; rg < 4; ++rg) {
                    u32x2 a; a.x = pk2(o0[4 * rg] * rl, o0[4 * rg + 1] * rl); a.y = pk2(o0[4 * rg + 2] * rl, o0[4 * rg + 3] * rl);
                    *(u32x2*)(orow + 8 * rg + 4 * hi) = a;
                    u32x2 c2; c2.x = pk2(o1[4 * rg] * rl, o1[4 * rg + 1] * rl); c2.y = pk2(o1[4 * rg + 2] * rl, o1[4 * rg + 3] * rl);
                    *(u32x2*)(orow + 32 + 8 * rg + 4 * hi) = c2;
                }
            }
            __syncthreads();
            for (int u = vb; u < 32 * 4 * 8; u += G) {
                const int g = u >> 5, pm = (u >> 3) & 3, pn = u & 7;
                sg_tile(lds, AS5 + ((size_t)g * 512 + pm * 128) * 1152, 1152, BT_MAIN + ((size_t)g * 1024 + pn * 128) * 1152, 1152, 1152,
                    [=](int r, int c, f32x4 v0, f32x4 v1) {
                        const int m = pm * 128 + r, b = m >> 6, ck = m & 63;
#pragma unroll
                        for (int h = 0; h < 2; ++h) {
                            const int n = pn * 128 + c + 16 * h; const f32x4 v = h ? v1 : v0;
                            const int tq = n >> 4, i = n & 15;
                            const u32x2 uu = *(const u32x2*)(AS5 + ((size_t)g * 512 + m) * 1152 + 128 + n);
                            const f32x4 dd = *(const f32x4*)(s5d + g * 16 + i);
                            const float y0 = v.x + dd.x * __uint_as_float(uu.x << 16), y1 = v.y + dd.y * __uint_as_float(uu.x & 0xffff0000u),
                                        y2 = v.z + dd.z * __uint_as_float(uu.y << 16), y3 = v.w + dd.w * __uint_as_float(uu.y & 0xffff0000u);
                            u32x2 o; o.x = pk2(gelu_tanh(y0), gelu_tanh(y1)); o.y = pk2(gelu_tanh(y2), gelu_tanh(y3));
                            *(u32x2*)(GACT + ((size_t)b * S + ck * 64 + tq) * 512 + g * 16 + i) = o;
                        }
                    });
            }
        }
        else if (ph == 7) {
            for (int u = vb; u < 256 * 4; u += G) {
                const int pm = u >> 2, pn = u & 3;
                sg_tile(lds, GACT + (size_t)pm * 128 * 512, 512, W_GLU + (size_t)pn * 128 * 512, 512, 512,
                    [=](int r, int c, f32x4 v0, f32x4 v1) {
                        const int row = pm * 128 + r;
#pragma unroll
                        for (int h = 0; h < 2; ++h) {
                            const int col = pn * 128 + c + 16 * h; const f32x4 v = h ? v1 : v0;
                            const u32x2 gg = *(const u32x2*)(GACT + (size_t)row * 512 + col);
                            const f32x4 bb = *(const f32x4*)(glub + col);
                            const float g0 = __uint_as_float(gg.x << 16), g1 = __uint_as_float(gg.x & 0xffff0000u), g2 = __uint_as_float(gg.y << 16), g3 = __uint_as_float(gg.y & 0xffff0000u);
                            u32x2 o; o.x = pk2(g0 * sigmoidf_(v.x + bb.x), g1 * sigmoidf_(v.y + bb.y)); o.y = pk2(g2 * sigmoidf_(v.z + bb.z), g3 * sigmoidf_(v.w + bb.w));
                            *(u32x2*)(MIXIN + (size_t)row * 1024 + 512 + col) = o;
                        }
                    });
            }
        }
        else if (ph == 8 || ph == 19) {
            const int lyr = (ph == 8) ? 0 : 1;
            const bf16_t* W = lyr ? W_OUT_O : W_OUT_E;
            const float* src = lyr ? OUT : XIN;
            for (int u = vb; u < 256 * 8; u += G) {
                const int pm = u >> 3, pn = u & 7;
                sg_tile(lds, MIXIN + (size_t)pm * 128 * D, D, W + (size_t)pn * 128 * D, D, D,
                    [=](int r, int c, f32x4 v0, f32x4 v1) {
                        const int row = pm * 128 + r, b = row / S;
                        const float* gm = MOD + ((size_t)lyr * NB + b) * 6144 + 2 * D;
#pragma unroll
                        for (int h = 0; h < 2; ++h) {
                            const int col = pn * 128 + c + 16 * h; const f32x4 v = h ? v1 : v0;
                            const f32x4 xs = *(const f32x4*)(src + (size_t)row * D + col), g4 = *(const f32x4*)(gm + col);
                            f32x4 o; o.x = xs.x + g4.x * v.x; o.y = xs.y + g4.y * v.y; o.z = xs.z + g4.z * v.z; o.w = xs.w + g4.w * v.w;
                            *(f32x4*)(OUT + (size_t)row * D + col) = o;
                        }
                    });
            }
        }
        else if (mph == 10) {
            const bf16_t* W = W_RT + (size_t)layer * 128 * 1024;
            const float* rb = rtb_all + layer * 32;
            for (int u = vb; u < 256; u += G) {
                const int pm = u;
                sg_tile(lds, HB + (size_t)pm * 128 * D, D, W, D, D,
                    [=](int r, int c, f32x4 v0, f32x4 v1) {
                        const int row = pm * 128 + r;
                        if (c < 32) {
                            const f32x4 b0 = *(const f32x4*)(rb + c), b1 = *(const f32x4*)(rb + c + 16);
                            f32x4 a = v0 + b0, bq = v1 + b1;
                            *(f32x4*)(LOGIT + (size_t)row * 32 + c) = a; *(f32x4*)(LOGIT + (size_t)row * 32 + c + 16) = bq;
                        }
                    });
            }
        }
        else if (mph == 11) {
            unsigned* hist = (unsigned*)lds;
            unsigned* gcnt = ctl + CW_CNT + layer * 64;
            for (int blk = vb; blk < T / NTHR; blk += G) {
                if (tid < 64) hist[tid] = 0u;
                __syncthreads();
                const int tok = blk * NTHR + tid;
                float lg[32];
#pragma unroll
                for (int i = 0; i < 8; ++i) { const f32x4 v = *(const f32x4*)(LOGIT + (size_t)tok * 32 + 4 * i); lg[4 * i] = v.x; lg[4 * i + 1] = v.y; lg[4 * i + 2] = v.z; lg[4 * i + 3] = v.w; }
                int e4[4]; float v4[4];
#pragma unroll
                for (int k = 0; k < 4; ++k) {
                    float best = -INFINITY; int bi = 0;
#pragma unroll
                    for (int e = 0; e < 32; ++e) { const bool tk = lg[e] > best; best = tk ? lg[e] : best; bi = tk ? e : bi; }
                    e4[k] = bi; v4[k] = best;
#pragma unroll
                    for (int e = 0; e < 32; ++e) lg[e] = (e == bi) ? -INFINITY : lg[e];
                }
                float den = 0.f, ex[4];
#pragma unroll
                for (int k = 0; k < 4; ++k) { ex[k] = __expf(v4[k] - v4[0]); den += ex[k]; }
                unsigned lp[4];
#pragma unroll
                for (int k = 0; k < 4; ++k) lp[k] = atomicAdd(hist + e4[k], 1u);
                __syncthreads();
                if (tid < 32) hist[32 + tid] = atomicAdd(gcnt + tid, (unsigned)hist[tid]);
                __syncthreads();
#pragma unroll
                for (int k = 0; k < 4; ++k) {
                    tok_e[tok * 4 + k] = e4[k]; tok_pos[tok * 4 + k] = (int)(hist[32 + e4[k]] + lp[k]); tok_gate[tok * 4 + k] = ex[k] / den;
                }
                __syncthreads();
            }
        }
        else if (mph == 12 || mph == 13 || mph == 14) {
            int* pst = (int*)(lds + 140 * 1024 - 1024);
            if (tid == 0) {
                const unsigned* gcnt = ctl + CW_CNT + layer * 64; int acc = 0;
                for (int e = 0; e < 32; ++e) { const int c = (int)gcnt[e]; pst[e] = acc; pst[64 + e] = c; acc += (c + 255) & ~255; }
                pst[32] = acc;
            }
            __syncthreads();
            const int total_rows = pst[32];
            if (mph == 12) {
                for (int it = gw; it < T * 4; it += NGW) {
                    const int tok = it >> 2, e = tok_e[it], row = pst[e] + tok_pos[it];
                    const u32x4* s = (const u32x4*)(HB + (size_t)tok * D);
                    u32x4* d = (u32x4*)(XB + (size_t)row * D);
                    d[lane] = s[lane]; d[lane + 64] = s[lane + 64];
                    if (lane == 0) { row_slot[row] = it; row_gate[row] = tok_gate[it]; }
                }
                for (int e = 0; e < 32; ++e) {
                    const int lo = pst[e] + pst[64 + e], hi2 = pst[e + 1];
                    for (int r = lo + vb * NTHR + tid; r < hi2; r += G * NTHR) { row_slot[r] = -1; row_gate[r] = 0.f; }
                }
            } else if (mph == 13) {
                const int nt128 = total_rows >> 7;
                for (int u = vb; u < nt128 * 16; u += G) {
                    const int pm = u >> 4, pn = u & 15, row0 = pm * 128;
                    int e = 0;
                    for (int q = 1; q < 32; ++q) e = (row0 >= pst[q]) ? q : e;
                    const bf16_t* W = W_GU + ((size_t)(layer * 32 + e) * 2048 + pn * 128) * 1024;
                    const float* bg = bgu_all + (size_t)(layer * 32 + e) * 2048;
                    sg_tile(lds, XB + (size_t)row0 * D, D, W, D, D,
                        [=](int r, int c, f32x4 v0, f32x4 v1) {
                            const int j = pn * 64 + (c >> 5) * 16 + (c & 15);
                            const f32x4 b0 = *(const f32x4*)(bg + j), b1 = *(const f32x4*)(bg + 1024 + j);
                            float o[4];
#pragma unroll
                            for (int i = 0; i < 4; ++i) {
                                const float gt = fminf(v0[i] + b0[i], 7.0f), ln = fminf(fmaxf(v1[i] + b1[i], -7.0f), 7.0f);
                                o[i] = gt * sigmoidf_(1.702f * gt) * (ln + 1.0f);
                            }
                            u32x2 w; w.x = pk2(o[0], o[1]); w.y = pk2(o[2], o[3]);
                            *(u32x2*)(ACT + (size_t)(row0 + r) * D + j) = w;
                        });
                }
            } else {
                const int nt128 = total_rows >> 7;
                for (int u = vb; u < nt128 * 8; u += G) {
                    const int pm = u >> 3, pn = u & 7, row0 = pm * 128;
                    int e = 0;
                    for (int q = 1; q < 32; ++q) e = (row0 >= pst[q]) ? q : e;
                    const bf16_t* W = W_DN + ((size_t)(layer * 32 + e) * 1024 + pn * 128) * 1024;
                    const float* bd = bdn_all + (size_t)(layer * 32 + e) * 1024;
                    sg_tile(lds, ACT + (size_t)row0 * D, D, W, D, D,
                        [=](int r, int c, f32x4 v0, f32x4 v1) {
                            const int row = row0 + r, slot = row_slot[row];
                            if (slot >= 0) {
                                const float gt = row_gate[row];
#pragma unroll
                                for (int h = 0; h < 2; ++h) {
                                    const int col = pn * 128 + c + 16 * h; const f32x4 v = h ? v1 : v0;
                                    const f32x4 bb = *(const f32x4*)(bd + col);
                                    u32x2 o; o.x = pk2((v.x + bb.x) * gt, (v.y + bb.y) * gt); o.y = pk2((v.z + bb.z) * gt, (v.w + bb.w) * gt);
                                    *(u32x2*)(Y + (size_t)slot * D + col) = o;
                                }
                            }
                        });
                }
            }
        }
        else if (ph == 16) {
            for (int u = vb; u < 256 * 12; u += G) {
                const int pm = u / 12, pn = u % 12;
                sg_tile(lds, HB + (size_t)pm * 128 * D, D, W_IN_O + (size_t)pn * 128 * D, D, D,
                    [=](int r, int c, f32x4 v0, f32x4 v1) {
                        const int row = pm * 128 + r;
#pragma unroll
                        for (int h = 0; h < 2; ++h) {
                            const int col = pn * 128 + c + 16 * h; f32x4 v = h ? v1 : v0;
                            if (col >= 512) { v.x = gelu_tanh(v.x); v.y = gelu_tanh(v.y); v.z = gelu_tanh(v.z); v.w = gelu_tanh(v.w); }
                            u32x2 o; o.x = pk2(v.x, v.y); o.y = pk2(v.z, v.w);
                            *(u32x2*)(Z + (size_t)row * 1536 + col) = o;
                        }
                    });
            }
        }
        else if (ph == 17) {
            for (int ck = vb; ck < T / 128; ck += G) {
                bf16_t* tile = (bf16_t*)lds;
                for (int tt = 0; tt < 16; ++tt) {
                    const int sl = wave * 16 + tt, row = ck * 128 + sl, t = row % S;
                    {
                        const int ch0 = lane * 8, w = 2 << (ch0 >> 7);
                        float acc[8], own[8];
#pragma unroll
                        for (int i = 0; i < 8; ++i) acc[i] = 0.f;
                        const int n = (t + 1 < w) ? t + 1 : w;
                        for (int q = 0; q < n; ++q) {
                            const u32x4 uv = *(const u32x4*)(Z + (size_t)(row - q) * 1536 + ch0);
                            const float f[8] = {__uint_as_float(uv.x << 16), __uint_as_float(uv.x & 0xffff0000u), __uint_as_float(uv.y << 16), __uint_as_float(uv.y & 0xffff0000u),
                                                __uint_as_float(uv.z << 16), __uint_as_float(uv.z & 0xffff0000u), __uint_as_float(uv.w << 16), __uint_as_float(uv.w & 0xffff0000u)};
#pragma unroll
                            for (int i = 0; i < 8; ++i) { acc[i] += f[i]; if (q == 0) own[i] = f[i]; }
                        }
                        const float inv = 1.0f / (float)n;
                        u32x4 o; o.x = pk2(acc[0] * inv - own[0], acc[1] * inv - own[1]); o.y = pk2(acc[2] * inv - own[2], acc[3] * inv - own[3]);
                        o.z = pk2(acc[4] * inv - own[4], acc[5] * inv - own[5]); o.w = pk2(acc[6] * inv - own[6], acc[7] * inv - own[7]);
                        *(u32x4*)(POOLED + (size_t)row * 512 + ch0) = o;
                    }
                    {
                        const u32x4 uv = *(const u32x4*)(Z + (size_t)row * 1536 + 1024 + lane * 8);
                        float f[8] = {__uint_as_float(uv.x << 16), __uint_as_float(uv.x & 0xffff0000u), __uint_as_float(uv.y << 16), __uint_as_float(uv.y & 0xffff0000u),
                                      __uint_as_float(uv.z << 16), __uint_as_float(uv.z & 0xffff0000u), __uint_as_float(uv.w << 16), __uint_as_float(uv.w & 0xffff0000u)};
                        float ss = 0.f;
#pragma unroll
                        for (int i = 0; i < 8; ++i) ss += f[i] * f[i];
                        const float rr = rsqrtf(wave_sum(ss) * (1.f / 512.f) + 1e-6f);
                        u32x4 o;
                        const float* gg = p.sgu_norm_g + lane * 8;
                        o.x = pk2(f[0] * rr * gg[0], f[1] * rr * gg[1]); o.y = pk2(f[2] * rr * gg[2], f[3] * rr * gg[3]);
                        o.z = pk2(f[4] * rr * gg[4], f[5] * rr * gg[5]); o.w = pk2(f[6] * rr * gg[6], f[7] * rr * gg[7]);
                        *(u32x4*)(tile + sl * 520 + lane * 8) = o;
                    }
                }
                __syncthreads();
                {
                    const int ch = tid;
                    bf16_t* dst = VTS + ((size_t)ck * 512 + ch) * 128;
                    for (int s8 = 0; s8 < 16; ++s8) {
                        unsigned w[4];
#pragma unroll
                        for (int i = 0; i < 4; ++i) w[i] = (unsigned)tile[(s8 * 8 + 2 * i) * 520 + ch] | ((unsigned)tile[(s8 * 8 + 2 * i + 1) * 520 + ch] << 16);
                        u32x4 o; o.x = w[0]; o.y = w[1]; o.z = w[2]; o.w = w[3];
                        *(u32x4*)(dst + s8 * 8) = o;
                    }
                }
                __syncthreads();
            }
        }
        else if (ph == 18) {
            for (int u = vb; u < 2048; u += G) {
                if (u < 1024) {
                    const int pm = u >> 2, gi = u & 3;
                    sg_tile(lds, POOLED + (size_t)pm * 128 * 512 + gi * 128, 512, W_POOL + (size_t)gi * 128 * 128, 128, 128,
                        [=](int r, int c, f32x4 v0, f32x4 v1) {
                            const int row = pm * 128 + r;
#pragma unroll
                            for (int h = 0; h < 2; ++h) {
                                const int col = gi * 128 + c + 16 * h; const f32x4 v = h ? v1 : v0;
                                const f32x4 sc = *(const f32x4*)(poolsc + col);
                                u32x2 o; o.x = pk2(v.x * sc.x, v.y * sc.y); o.y = pk2(v.z * sc.z, v.w * sc.w);
                                *(u32x2*)(MIXIN + (size_t)row * 1024 + col) = o;
                            }
                        });
                } else {
                    const int uu = u - 1024, ck = uu >> 2, h4 = uu & 3;
                    sg_tile(lds, W_SGU + (size_t)h4 * 128 * 128, 128, VTS + ((size_t)ck * 512 + h4 * 128) * 128, 128, 128,
                        [=](int r, int c, f32x4 v0, f32x4 v1) {
                            const int row = ck * 128 + r;
                            const float bias = sgub[h4 * 128 + r];
#pragma unroll
                            for (int h = 0; h < 2; ++h) {
                                const int dcol = c + 16 * h; const f32x4 v = h ? v1 : v0;
                                const u32x2 ug = *(const u32x2*)(Z + (size_t)row * 1536 + 512 + h4 * 128 + dcol);
                                u32x2 o; o.x = pk2((v.x + bias) * __uint_as_float(ug.x << 16), (v.y + bias) * __uint_as_float(ug.x & 0xffff0000u));
                                o.y = pk2((v.z + bias) * __uint_as_float(ug.y << 16), (v.w + bias) * __uint_as_float(ug.y & 0xffff0000u));
                                *(u32x2*)(MIXIN + (size_t)row * 1024 + 512 + h4 * 128 + dcol) = o;
                            }
                        });
                }
            }
        }

#if MK_ONE_LAUNCH
        if (ph + 1 < ph_hi) xcd_barrier(bar);
#endif
    }
}

typedef void (*kfn_t)(Params);
template <int PH> struct Tab { static void fill(kfn_t* t) { t[PH] = hybrid_fwd<PH>; Tab<PH - 1>::fill(t); } };
template <> struct Tab<-1> { static void fill(kfn_t*) {} };
static kfn_t g_tab[NPHASE];
static void set_attrs() {
#if MK_ONE_LAUNCH
    (void)hipFuncSetAttribute((const void*)hybrid_fwd<-1>, hipFuncAttributeMaxDynamicSharedMemorySize, LDS_BYTES);
#else
    Tab<NPHASE - 1>::fill(g_tab);
    for (int i = 0; i < NPHASE; ++i) (void)hipFuncSetAttribute((const void*)g_tab[i], hipFuncAttributeMaxDynamicSharedMemorySize, LDS_BYTES);
#endif
}
#if !MK_ONE_LAUNCH
static void launch_all(const Params& p, int grid, hipStream_t stream) {
    for (int ph = 0; ph < NPHASE; ++ph) hipLaunchKernelGGL(g_tab[ph], dim3(grid), dim3(NTHR), LDS_BYTES, stream, p);
}
#endif
extern "C" void kernel_launch(void* const* d_in, const int* in_sizes, int n_in, void* d_out, int out_size, void* d_ws, size_t ws_size, hipStream_t stream) {
    static int ready = 0;
    if (ready == 0) {
        if (n_in != 38 || ws_size < WS_END) { fprintf(stderr, "kernel_launch: unexpected n_in %d / ws %zu\n", n_in, ws_size); ready = -1; return; }
        set_attrs();
        ready = 1;
    }
    if (ready < 0) return;
    (void)hipMemsetAsync((char*)d_ws + WS_CTL, 0, CTL_ZERO_BYTES, stream);
    Params p{};
    const float** fp = (const float**)&p.x;
    (void)fp;
    p.x = (const float*)d_in[0]; p.c = (const float*)d_in[1]; p.pos = (const int*)d_in[2];
    p.ada_w = (const float*)d_in[3]; p.ada_b = (const float*)d_in[4]; p.norm_mix_g = (const float*)d_in[5]; p.norm_ffn_g = (const float*)d_in[6];
    p.router_w = (const float*)d_in[7]; p.router_b = (const float*)d_in[8]; p.moe_w_gu = (const float*)d_in[9]; p.moe_b_gu = (const float*)d_in[10];
    p.moe_w_dn = (const float*)d_in[11]; p.moe_b_dn = (const float*)d_in[12];
    p.even_w_in = (const float*)d_in[13]; p.q_norm_g = (const float*)d_in[14]; p.w_uq = (const float*)d_in[15]; p.kv_norm_g = (const float*)d_in[16];
    p.w_ukv = (const float*)d_in[17]; p.q_head_g = (const float*)d_in[18]; p.k_head_g = (const float*)d_in[19];
    p.s5_a_re = (const float*)d_in[20]; p.s5_a_im = (const float*)d_in[21]; p.s5_log_dt = (const float*)d_in[22]; p.s5_b_re = (const float*)d_in[23];
    p.s5_b_im = (const float*)d_in[24]; p.s5_c_re = (const float*)d_in[25]; p.s5_c_im = (const float*)d_in[26]; p.s5_d = (const float*)d_in[27];
    p.s5_glu_w = (const float*)d_in[28]; p.s5_glu_b = (const float*)d_in[29]; p.even_w_out = (const float*)d_in[30];
    p.odd_w_in = (const float*)d_in[31]; p.pool_w = (const float*)d_in[32]; p.pool_scale = (const float*)d_in[33]; p.sgu_norm_g = (const float*)d_in[34];
    p.sgu_w = (const float*)d_in[35]; p.sgu_b = (const float*)d_in[36]; p.odd_w_out = (const float*)d_in[37];
    p.out = (float*)d_out; p.ws = (unsigned char*)d_ws;
    const int grid = 256;
#if MK_ONE_LAUNCH
    p.ph_lo = 0; p.ph_hi = NPHASE;
    hipLaunchKernelGGL(hybrid_fwd<-1>, dim3(grid), dim3(NTHR), LDS_BYTES, stream, p);
#else
    p.ph_lo = 0; p.ph_hi = 1;
    launch_all(p, grid, stream);
#endif
}
```

```cpp
#include <hip/hip_runtime.h>
#include <cstdio>
#include <cstdint>

#ifndef MK_ONE_LAUNCH
#define MK_ONE_LAUNCH 1
#endif

typedef unsigned short bf16_t;
typedef short bf16x8 __attribute__((ext_vector_type(8)));
typedef short s16x4 __attribute__((ext_vector_type(4)));
typedef float f32x4 __attribute__((ext_vector_type(4)));
typedef float f32x16 __attribute__((ext_vector_type(16)));
typedef unsigned u32x4 __attribute__((ext_vector_type(4)));
typedef unsigned u32x2 __attribute__((ext_vector_type(2)));

constexpr int D = 1024, NB = 8, S = 4096, T = NB * S;
constexpr int NTHR = 512, NWAVE = 8;
constexpr int MOE_ROWS = 139264;
constexpr int NPHASE = 27;

constexpr size_t MiB = 1u << 20;
constexpr size_t WS_CTL = 0, CTL_ZERO_BYTES = 1 * MiB;
constexpr size_t WS_MOD = 1 * MiB;
constexpr size_t WS_S5AB = 2 * MiB;
constexpr size_t WS_PW = 3 * MiB;
constexpr size_t WS_KTAB = 5 * MiB;
constexpr size_t WS_TOK = 7 * MiB;
constexpr size_t WS_ROW = 9 * MiB;
constexpr size_t WS_LOGIT = 11 * MiB;
constexpr size_t WS_W_IN_E = 16 * MiB, WS_W_UP = 18 * MiB  , WS_W_GLU = 20 * MiB, WS_W_OUT_E = 21 * MiB, WS_W_IN_O = 23 * MiB,
                 WS_W_OUT_O = 26 * MiB, WS_W_POOL = 28 * MiB, WS_W_SGU = 29 * MiB, WS_W_RT = 30 * MiB;
constexpr size_t WS_BT_END = 32 * MiB;
constexpr size_t WS_BT_MAIN = 40 * MiB;
constexpr size_t WS_W_GU = 112 * MiB;
constexpr size_t WS_W_DN = 368 * MiB;
constexpr size_t WS_HB = 496 * MiB;
constexpr size_t WS_MIXIN = 560 * MiB;
constexpr size_t WS_Y = 624 * MiB;
constexpr size_t WS_XB = 880 * MiB;
constexpr size_t WS_ACT = 1152 * MiB;
constexpr size_t WS_END = 1424 * MiB;
constexpr size_t WS_Z = 880 * MiB;
constexpr size_t WS_QKN = 976 * MiB  , WS_QKVRAW = 1000 * MiB  , WS_Q = 1112 * MiB, WS_K = 1160 * MiB, WS_VT = 1208 * MiB,
                 WS_AS5 = 1240 * MiB, WS_LEND = 1276 * MiB, WS_GACT = 1284 * MiB;
constexpr size_t WS_POOLED = 976 * MiB, WS_VTS = 1008 * MiB;
constexpr int CW_BAR = 4096, CW_CNT = 16384;

constexpr int LDS_BYTES = 147456;
constexpr int LDS_MISC = 140 * 1024;

struct Params {
    const float *x, *c; const int* pos;
    const float *ada_w, *ada_b, *norm_mix_g, *norm_ffn_g, *router_w, *router_b, *moe_w_gu, *moe_b_gu, *moe_w_dn, *moe_b_dn;
    const float *even_w_in, *q_norm_g, *w_uq, *kv_norm_g, *w_ukv, *q_head_g, *k_head_g;
    const float *s5_a_re, *s5_a_im, *s5_log_dt, *s5_b_re, *s5_b_im, *s5_c_re, *s5_c_im, *s5_d, *s5_glu_w, *s5_glu_b, *even_w_out;
    const float *odd_w_in, *pool_w, *pool_scale, *sgu_norm_g, *sgu_w, *sgu_b, *odd_w_out;
    float* out; unsigned char* ws; int ph_lo, ph_hi;
};

__device__ __forceinline__ float bf2f(unsigned short b) { return __uint_as_float(((unsigned)b) << 16); }
__device__ __forceinline__ unsigned pk2(float lo, float hi) {
    typedef float f2 __attribute__((ext_vector_type(2))); typedef __bf16 b2 __attribute__((ext_vector_type(2)));
    f2 v = {lo, hi}; b2 b = __builtin_convertvector(v, b2); return __builtin_bit_cast(unsigned, b);
}
__device__ __forceinline__ unsigned short f2bf(float f) { return (unsigned short)(pk2(f, 0.f) & 0xffffu); }
__device__ __forceinline__ float wave_sum(float v) {
#pragma unroll
    for (int o = 1; o < 64; o <<= 1) v += __shfl_xor(v, o);
    return v;
}
__device__ __forceinline__ float sigmoidf_(float x) { return 1.0f / (1.0f + __expf(-x)); }
__device__ __forceinline__ float gelu_tanh(float x) {
    const float u = 0.7978845608028654f * (x + 0.044715f * x * x * x);
    return x * sigmoidf_(2.0f * u);
}
__device__ __forceinline__ int crow(int r, int hi) { return (r & 3) + 8 * (r >> 2) + 4 * hi; }

#define LAS __attribute__((address_space(3)))
#define XB_TMO      128
#define XB_XCNT(j)  (256  + 64 * (j))
#define XB_XSUB(j)  (1280 + 64 * (j))
#define XB_XGEN(j)  (2304 + 64 * (j))
#define XB_TOP      3328
#define XB_TOPGEN   3392
#define XCD_BAR_WORDS 3456
#define XB_SPIN_CAP (1u << 20)
__device__ __forceinline__ unsigned xb_ld(unsigned* p)              { return __hip_atomic_load(p, __ATOMIC_RELAXED, __HIP_MEMORY_SCOPE_AGENT); }
__device__ __forceinline__ unsigned xb_add(unsigned* p, unsigned v) { return __hip_atomic_fetch_add(p, v, __ATOMIC_RELAXED, __HIP_MEMORY_SCOPE_AGENT); }
__device__ __forceinline__ unsigned xb_xcc_id() { return (unsigned)__builtin_amdgcn_s_getreg((3 << 11) | 20) & 0xFu; }
#define XB_SPIN(cond, bar) do { unsigned _sp = 0; while (cond) { __builtin_amdgcn_s_sleep(1); \
    if ((++_sp & 255u) == 0u) { if (xb_ld(&(bar)[XB_TMO])) break; if (_sp > XB_SPIN_CAP) { atomicAdd(&(bar)[XB_TMO], 1u); break; } } } } while (0)
struct XcdBarrier { unsigned* bar; unsigned x; volatile LAS unsigned* st; };
__device__ __forceinline__ XcdBarrier xcd_barrier_post(unsigned* bar, volatile LAS unsigned* st) {
    XcdBarrier b; b.bar = bar; b.x = xb_xcc_id(); b.st = st;
    if (threadIdx.x == 0) (void)xb_add(&bar[XB_XCNT(b.x)], 1u);
    return b;
}
__device__ __forceinline__ void xcd_barrier_complete(unsigned* bar, unsigned x, unsigned& nloc, unsigned& nx) {
    const unsigned G = gridDim.x * gridDim.y * gridDim.z;
    unsigned sum, cnt, mine, sp = 0u;
    for (;;) {
        sum = 0u; cnt = 0u; mine = 0u;
#pragma unroll
        for (unsigned j = 0; j < 16; ++j) { const unsigned c = xb_ld(&bar[XB_XCNT(j)]); sum += c; cnt += (c > 0u) ? 1u : 0u; mine = (j == x) ? c : mine; }
        if (sum == G) break;
        __builtin_amdgcn_s_sleep(1);
        if ((++sp & 255u) == 0u) { if (xb_ld(&bar[XB_TMO])) break; if (sp > XB_SPIN_CAP) { atomicAdd(&bar[XB_TMO], 1u); break; } }
    }
    nloc = mine > 0u ? mine : 1u; nx = cnt > 0u ? cnt : 1u;
}
__device__ __forceinline__ void xcd_barrier(const XcdBarrier& b) {
    asm volatile("s_waitcnt vmcnt(0)" ::: "memory");
    __syncthreads();
    if (threadIdx.x == 0) {
        unsigned* bar = b.bar;
        __builtin_amdgcn_s_waitcnt(0);
        unsigned nloc = b.st[0], nx = b.st[1];
        if (nloc == 0u) { xcd_barrier_complete(bar, b.x, nloc, nx); b.st[0] = nloc; b.st[1] = nx; }
        const unsigned old = xb_add(&bar[XB_XSUB(b.x)], 1u);
        const unsigned gen = old / nloc;
        if (old + 1u == (gen + 1u) * nloc) {
            __builtin_amdgcn_fence(__ATOMIC_RELEASE, "agent");
            asm volatile("s_waitcnt vmcnt(0)" ::: "memory");
            const unsigned og = xb_add(&bar[XB_TOP], 1u);
            const unsigned tg = og / nx;
            if (og + 1u == (tg + 1u) * nx) xb_add(&bar[XB_TOPGEN], 1u);
            else XB_SPIN(xb_ld(&bar[XB_TOPGEN]) == tg, bar);
            __builtin_amdgcn_fence(__ATOMIC_ACQUIRE, "agent");
            xb_add(&bar[XB_XGEN(b.x)], 1u);
            asm volatile("s_waitcnt vmcnt(0)" ::: "memory");
        } else {
            XB_SPIN(xb_ld(&bar[XB_XGEN(b.x)]) == gen, bar);
            __builtin_amdgcn_fence(__ATOMIC_ACQUIRE, "agent");
            asm volatile("s_waitcnt vmcnt(0)" ::: "memory");
        }
    }
    __syncthreads();
}

constexpr int SG_LDS = 2 * 128 * 144;
template <class Epi>
__device__ __forceinline__ void sg_tile(int tid, unsigned char* lds, const bf16_t* A, int lda, const bf16_t* Bt, int ldb, int K, Epi epi) {
    const int lane = tid & 63, wid = tid >> 6, wr = wid >> 2, wc = wid & 3, fr = lane & 15, fq = lane >> 4;
    unsigned char* As = lds; unsigned char* Bs = lds + 128 * 144;
    f32x4 acc[4][2];
#pragma unroll
    for (int m = 0; m < 4; ++m)
#pragma unroll
        for (int n = 0; n < 2; ++n) acc[m][n] = (f32x4){0.f, 0.f, 0.f, 0.f};
    const int nt = K / 64;
    u32x4 ra[2], rb[2];
    const int r0 = tid >> 3, cc = tid & 7;
#pragma unroll
    for (int i = 0; i < 2; ++i) {
        ra[i] = *(const u32x4*)(A + (size_t)(r0 + 64 * i) * lda + cc * 8);
        rb[i] = *(const u32x4*)(Bt + (size_t)(r0 + 64 * i) * ldb + cc * 8);
    }
    for (int kt = 0; kt < nt; ++kt) {
        __syncthreads();
#pragma unroll
        for (int i = 0; i < 2; ++i) {
            *(u32x4*)(As + (r0 + 64 * i) * 144 + cc * 16) = ra[i];
            *(u32x4*)(Bs + (r0 + 64 * i) * 144 + cc * 16) = rb[i];
        }
        __syncthreads();
        if (kt + 1 < nt) {
#pragma unroll
            for (int i = 0; i < 2; ++i) {
                ra[i] = *(const u32x4*)(A + (size_t)(r0 + 64 * i) * lda + (kt + 1) * 64 + cc * 8);
                rb[i] = *(const u32x4*)(Bt + (size_t)(r0 + 64 * i) * ldb + (kt + 1) * 64 + cc * 8);
            }
        }
#pragma unroll
        for (int kk = 0; kk < 2; ++kk) {
            bf16x8 a[4], b[2];
#pragma unroll
            for (int m = 0; m < 4; ++m) a[m] = *(const bf16x8*)(As + (wr * 64 + m * 16 + fr) * 144 + kk * 64 + fq * 16);
#pragma unroll
            for (int n = 0; n < 2; ++n) b[n] = *(const bf16x8*)(Bs + (wc * 32 + n * 16 + fr) * 144 + kk * 64 + fq * 16);
#pragma unroll
            for (int m = 0; m < 4; ++m)
#pragma unroll
                for (int n = 0; n < 2; ++n) acc[m][n] = __builtin_amdgcn_mfma_f32_16x16x32_bf16(b[n], a[m], acc[m][n], 0, 0, 0);
        }
    }
#pragma unroll
    for (int m = 0; m < 4; ++m) epi(wr * 64 + m * 16 + fr, wc * 32 + fq * 4, acc[m][0], acc[m][1]);
}


namespace pg8 {
#define PG8_LAS __attribute__((address_space(3)))
constexpr int BM = 256, BK = 64, HALF = 128, HTB = HALF * BK * 2, STAGE_BYTES = 8 * HTB;
__device__ __forceinline__ int lds_byte(int r, int c) { const int st = (r >> 4) * 2 + (c >> 5), rr = r & 15, cc = c & 31, ob = rr * 64 + cc * 2; return st * 1024 + (ob ^ (((ob >> 9) & 1) << 5)); }
__device__ __forceinline__ void stage_rc(int b, int& R, int& C) { const int st = b / 1024, sb = b % 1024, swz = sb ^ (((sb >> 9) & 1) << 5); R = (st >> 1) * 16 + swz / 64; C = (st & 1) * 32 + (swz % 64) / 2; }
struct Unit { int pm, pb, pn, aux; };
struct Gemm { const bf16_t* A; const bf16_t* Bt; int lda, ldb, K; };
template <class F> struct Epi {
    F f;
    __device__ __forceinline__ void operator()(const f32x4 (&acc)[2][2][4][2], const Unit& u, int wr, int wc, int fr, int fq) const {
#pragma unroll
        for (int ai = 0; ai < 2; ++ai)
#pragma unroll
            for (int m = 0; m < 4; ++m)
#pragma unroll
                for (int bj = 0; bj < 2; ++bj) f(u, ai * HALF + wr * 64 + m * 16 + fr, bj * HALF + wc * 32 + 4 * fq, acc[ai][bj][m][0], acc[ai][bj][m][1]);
    }
};
template <class F, class Sched>
__device__ __forceinline__ void gemm_phase(int tid, PG8_LAS unsigned char* lds, const Gemm g, const Sched& S, const Epi<F>& E) {
    const int wid = __builtin_amdgcn_readfirstlane(tid >> 6), lane = tid & 63, wr = wid >> 2, wc = wid & 3, fr = lane & 15, fq = lane >> 4;
    int K = g.K; asm volatile("" : "+s"(K));
    const int nt = K / BK;
    unsigned voffA[2], voffB[2];
#pragma unroll
    for (int i = 0; i < 2; ++i) { int R, C; stage_rc(tid * 16 + i * 8192, R, C); voffA[i] = (unsigned)(R * g.lda + C) * 2u; voffB[i] = (unsigned)(R * g.ldb + C) * 2u; }
    const size_t kstep = (size_t)(BK * 2);
    const size_t hstepA = (size_t)HALF * g.lda * 2, hstepB = (size_t)HALF * g.ldb * 2;
    const size_t tstepA = 2 * hstepA, tstepB = 2 * hstepB;
    const unsigned ldsw = (unsigned)wid * 1024u;
    const int aoff = lds_byte(wr * 64 + fr, fq * 8), boff = lds_byte(wc * 32 + fr, fq * 8);
#define PG8_SA(b, h) (((b) * 2 + (h)) * HTB)
#define PG8_SB(b, h) ((4 + (b) * 2 + (h)) * HTB)
#define PG8_STAGE(bufoff, gbase, voff) do { _Pragma("unroll") for (int _i = 0; _i < 2; ++_i) \
        __builtin_amdgcn_global_load_lds((const unsigned*)((const char*)(gbase) + (voff)[_i]), (PG8_LAS unsigned*)(lds + (bufoff) + ldsw + _i * 8192), 16, 0, 0); } while (0)
#define PG8_LDA(dst, b, h) do { _Pragma("unroll") for (int m = 0; m < 4; ++m) _Pragma("unroll") for (int k = 0; k < 2; ++k) dst[m][k] = *(const PG8_LAS bf16x8*)(lds + PG8_SA(b, h) + aoff + m * 2048 + k * 1024); } while (0)
#define PG8_LDB(dst, b, h) do { _Pragma("unroll") for (int n = 0; n < 2; ++n) _Pragma("unroll") for (int k = 0; k < 2; ++k) dst[n][k] = *(const PG8_LAS bf16x8*)(lds + PG8_SB(b, h) + boff + n * 2048 + k * 1024); } while (0)
#define PG8_MMA(ai, bj, At, Bt) do { __builtin_amdgcn_s_setprio(1); _Pragma("unroll") for (int m = 0; m < 4; ++m) _Pragma("unroll") for (int n = 0; n < 2; ++n) _Pragma("unroll") for (int k = 0; k < 2; ++k) \
        acc[ai][bj][m][n] = __builtin_amdgcn_mfma_f32_16x16x32_bf16(Bt[n][k], At[m][k], acc[ai][bj][m][n], 0, 0, 0); __builtin_amdgcn_s_setprio(0); } while (0)
#define PG8_WAIT_V(n) asm volatile("s_waitcnt vmcnt(" #n ")" ::: "memory")
#define PG8_WAIT_L(n) asm volatile("s_waitcnt lgkmcnt(" #n ")" ::: "memory")
#define PG8_BAR __builtin_amdgcn_s_barrier()
#define PG8_SCHED __builtin_amdgcn_sched_barrier(0)
    Unit cur, nxt; int ui = 0;
    if (!S.next(0, cur)) return;
    f32x4 acc[2][2][4][2];
#pragma unroll
    for (int a = 0; a < 2; ++a)
#pragma unroll
        for (int b = 0; b < 2; ++b)
#pragma unroll
            for (int m = 0; m < 4; ++m)
#pragma unroll
                for (int n = 0; n < 2; ++n) acc[a][b][m][n] = (f32x4){0.f, 0.f, 0.f, 0.f};
    bf16x8 At[4][2], B0[2][2], B1[2][2];
    const char* cA = (const char*)g.A + (size_t)cur.pm * tstepA; const char* cB = (const char*)g.Bt + (size_t)cur.pb * tstepB;
    PG8_STAGE(PG8_SB(0, 0), cB, voffB); PG8_STAGE(PG8_SB(0, 1), cB + hstepB, voffB); PG8_STAGE(PG8_SA(0, 0), cA, voffA); PG8_STAGE(PG8_SA(0, 1), cA + hstepA, voffA);
    if (wr == 1) PG8_BAR;
    PG8_WAIT_V(2); PG8_BAR;
    PG8_STAGE(PG8_SB(1, 0), cB + kstep, voffB); PG8_STAGE(PG8_SA(1, 0), cA + kstep, voffA); PG8_STAGE(PG8_SB(1, 1), cB + hstepB + kstep, voffB);
    PG8_WAIT_V(6); PG8_BAR;
    for (;;) {
        const bool has_next = S.next(ui + 1, nxt);
        const char* nA = has_next ? (const char*)g.A + (size_t)nxt.pm * tstepA : cA; const char* nB = has_next ? (const char*)g.Bt + (size_t)nxt.pb * tstepB : cB;
        for (int t = 0; t < nt; t += 2) {
            const bool last = (t == nt - 2);
            const char* a1 = cA + (size_t)(t + 1) * kstep;
            const char* a2 = last ? nA : cA + (size_t)(t + 2) * kstep; const char* b2 = last ? nB : cB + (size_t)(t + 2) * kstep;
            const char* a3 = a2 + kstep; const char* b3 = b2 + kstep;
            PG8_LDB(B0, 0, 0); PG8_LDB(B1, 0, 1); PG8_SCHED; PG8_LDA(At, 0, 0); PG8_STAGE(PG8_SA(1, 1), a1 + hstepA, voffA);
            PG8_WAIT_V(8); PG8_WAIT_L(0); PG8_BAR; PG8_MMA(0, 0, At, B0); PG8_MMA(0, 1, At, B1); PG8_BAR; PG8_SCHED;
            PG8_LDA(At, 0, 1); PG8_STAGE(PG8_SB(0, 0), b2, voffB); PG8_STAGE(PG8_SB(0, 1), b2 + hstepB, voffB); PG8_STAGE(PG8_SA(0, 0), a2, voffA);
            PG8_WAIT_V(8); PG8_WAIT_L(0); PG8_BAR; PG8_MMA(1, 0, At, B0); PG8_MMA(1, 1, At, B1); PG8_BAR; PG8_SCHED;
            PG8_LDB(B0, 1, 0); PG8_LDB(B1, 1, 1); PG8_SCHED; PG8_LDA(At, 1, 0); PG8_STAGE(PG8_SA(0, 1), a2 + hstepA, voffA);
            PG8_WAIT_V(8); PG8_WAIT_L(0); PG8_BAR; PG8_MMA(0, 0, At, B0); PG8_MMA(0, 1, At, B1); PG8_BAR; PG8_SCHED;
            PG8_LDA(At, 1, 1); PG8_STAGE(PG8_SB(1, 0), b3, voffB); PG8_STAGE(PG8_SB(1, 1), b3 + hstepB, voffB); PG8_STAGE(PG8_SA(1, 0), a3, voffA);
            PG8_WAIT_V(8); PG8_WAIT_L(0); PG8_BAR; PG8_MMA(1, 0, At, B0); PG8_MMA(1, 1, At, B1); PG8_BAR; PG8_SCHED;
        }
        if (wr == 0) PG8_BAR;
        E(acc, cur, wr, wc, fr, fq);
        if (!has_next) break;
#pragma unroll
        for (int a = 0; a < 2; ++a)
#pragma unroll
            for (int b = 0; b < 2; ++b)
#pragma unroll
                for (int m = 0; m < 4; ++m)
#pragma unroll
                    for (int n = 0; n < 2; ++n) acc[a][b][m][n] = (f32x4){0.f, 0.f, 0.f, 0.f};
        cur = nxt; cA = nA; cB = nB; ++ui;
        if (wr == 1) PG8_BAR;
    }
    PG8_WAIT_V(0);
    PG8_BAR;
#undef PG8_SA
#undef PG8_SB
#undef PG8_STAGE
#undef PG8_LDA
#undef PG8_LDB
#undef PG8_MMA
#undef PG8_WAIT_V
#undef PG8_WAIT_L
#undef PG8_BAR
#undef PG8_SCHED
}
struct GridOrder {
    int nM, nN, nwg, G, c;
    __device__ __forceinline__ void init(int nM_, int nN_, int G_, int c_) { nM = nM_; nN = nN_; nwg = nM * nN; G = G_; c = c_; }
    __device__ __forceinline__ bool tile(int i, int& pm, int& pn) const {
        const long L = (long)i * G + c; if (L >= nwg) return false;
        int wgid = (int)L; { const int q = nwg / 8, r = nwg % 8, xcd = wgid % 8, off = wgid / 8; wgid = (xcd < r ? xcd * (q + 1) : r * (q + 1) + (xcd - r) * q) + off; }
        const int nig = 8 * nN, gid = wgid / nig, fm = gid * 8, gsz = (nM - fm) < 8 ? (nM - fm) : 8;
        pm = fm + ((wgid % nig) % gsz); pn = (wgid % nig) / gsz; return true;
    }
};
}


struct DenseOrder { pg8::GridOrder go;
    __device__ __forceinline__ bool next(int i, pg8::Unit& u) const { int pm, pn; if (!go.tile(i, pm, pn)) return false; u.pm = pm; u.pb = pn; u.pn = pn; u.aux = 0; return true; } };
struct MoeOrder { pg8::GridOrder go; const int* pst; int NT, ebase;
    __device__ __forceinline__ bool next(int i, pg8::Unit& u) const { int pm, pn; if (!go.tile(i, pm, pn)) return false; int e = 0;
#pragma unroll
        for (int q = 1; q < 32; ++q) e = (pm * 256 >= pst[q]) ? q : e;
        u.pm = pm; u.pn = pn; u.pb = (ebase + e) * NT + pn; u.aux = e; return true; } };
struct S5Order { int G, c;
    __device__ __forceinline__ bool next(int i, pg8::Unit& u) const { const int L = i * G + c; if (L >= 256) return false; const int g = L >> 3, pmL = (L >> 2) & 1, pnL = L & 3;
        u.pm = g * 2 + pmL; u.pb = g * 4 + pnL; u.pn = pnL; u.aux = g; return true; } };

__device__ __forceinline__ void transpose_item(const float* W, int K, int N, bf16_t* WT, int ldt, float* scr, int item, int lane, int mode) {
    const int nblk = N / 32, kb = item / nblk, nb = item % nblk, k0 = 64 * kb, n0 = 32 * nb;
#pragma unroll 8
    for (int i = 0; i < 32; ++i) { const int kk = 2 * i + (lane >> 5); scr[kk * 33 + (lane & 31)] = W[(size_t)(k0 + kk) * N + n0 + (lane & 31)]; }
    __builtin_amdgcn_s_waitcnt(0xC07F); asm volatile("" ::: "memory");
    const int c = lane & 7;
#pragma unroll
    for (int j = 0; j < 4; ++j) {
        const int n = (lane >> 3) + 8 * j; const float* s = scr + (8 * c) * 33 + n;
        u32x4 o; o.x = pk2(s[0 * 33], s[1 * 33]); o.y = pk2(s[2 * 33], s[3 * 33]); o.z = pk2(s[4 * 33], s[5 * 33]); o.w = pk2(s[6 * 33], s[7 * 33]);
        int nn = n0 + n;
        if (mode == 1) { const int half = nn >= 1024; const int jj = nn - half * 1024; nn = 32 * (jj >> 4) + 16 * half + (jj & 15); }
        *(u32x4*)(WT + (size_t)nn * ldt + k0 + 8 * c) = o;
    }
    __builtin_amdgcn_s_waitcnt(0xC07F); asm volatile("" ::: "memory");
}
__device__ __forceinline__ void transpose_many(const float* W, int nmat, int K, int N, bf16_t* WT, size_t dst_stride, float* scr, int gw, int NGW, int lane, int mode, int ldt = 0) {
    if (ldt == 0) ldt = K;
    const int per = (K / 64) * (N / 32); const long tot = (long)nmat * per;
    for (long it = gw; it < tot; it += NGW) {
        const int mt = (int)(it / per), r = (int)(it % per);
        transpose_item(W + (size_t)mt * K * N, K, N, WT + (size_t)mt * dst_stride, ldt, scr, r, lane, mode);
    }
}

__device__ __forceinline__ void norm_mod_store(f32x4 (&v)[4], const float* g, const float* sc, const float* sh, bf16_t* orow, int lane) {
    float s = 0.f;
#pragma unroll
    for (int j = 0; j < 4; ++j) s += (v[j].x * v[j].x + v[j].y * v[j].y) + (v[j].z * v[j].z + v[j].w * v[j].w);
    const float r = rsqrtf(wave_sum(s) * (1.0f / D) + 1e-6f);
#pragma unroll
    for (int j = 0; j < 4; ++j) {
        const int c = 4 * lane + 256 * j;
        const f32x4 gg = *(const f32x4*)(g + c), s1 = *(const f32x4*)(sc + c), s0 = *(const f32x4*)(sh + c);
        const float a = v[j].x * r * gg.x * (1.f + s1.x) + s0.x, b = v[j].y * r * gg.y * (1.f + s1.y) + s0.y,
                    cc = v[j].z * r * gg.z * (1.f + s1.z) + s0.z, d = v[j].w * r * gg.w * (1.f + s1.w) + s0.w;
        u32x2 o; o.x = pk2(a, b); o.y = pk2(cc, d);
        *(u32x2*)(orow + c) = o;
    }
}

template <int ph> __device__ __forceinline__ void phase_body() {
    extern __shared__ __attribute__((aligned(16))) unsigned char lds[];
    {
        int tid = threadIdx.x; asm volatile("" : "+v"(tid));
        int vb = blockIdx.x, G = gridDim.x; asm volatile("" : "+s"(vb), "+s"(G));
        const int lane = tid & 63, wave = tid >> 6;
        const int gw = vb * NWAVE + wave, NGW = G * NWAVE;
        const __attribute__((address_space(4))) Params* kp = (const __attribute__((address_space(4))) Params*)__builtin_amdgcn_kernarg_segment_ptr();
        asm volatile("" : "+s"(kp));
        unsigned char* ws = kp->ws;
        unsigned* ctl = (unsigned*)(ws + WS_CTL);
        float* MOD = (float*)(ws + WS_MOD);
        float* S5AB = (float*)(ws + WS_S5AB); float* S5BB = (float*)(ws + WS_S5AB + 65536);
        float* PW = (float*)(ws + WS_PW); float* KTAB = (float*)(ws + WS_KTAB);
        int* tok_e = (int*)(ws + WS_TOK); int* tok_pos = (int*)(ws + WS_TOK + 512 * 1024); float* tok_gate = (float*)(ws + WS_TOK + 1024 * 1024);
        int* row_slot = (int*)(ws + WS_ROW); float* row_gate = (float*)(ws + WS_ROW + MiB);
        float* LOGIT = (float*)(ws + WS_LOGIT);
        bf16_t* W_IN_E = (bf16_t*)(ws + WS_W_IN_E); bf16_t* W_UP = (bf16_t*)(ws + WS_W_UP); bf16_t* W_GLU = (bf16_t*)(ws + WS_W_GLU);
        bf16_t* W_OUT_E = (bf16_t*)(ws + WS_W_OUT_E); bf16_t* W_IN_O = (bf16_t*)(ws + WS_W_IN_O); bf16_t* W_OUT_O = (bf16_t*)(ws + WS_W_OUT_O);
        bf16_t* W_POOL = (bf16_t*)(ws + WS_W_POOL); bf16_t* W_SGU = (bf16_t*)(ws + WS_W_SGU); bf16_t* W_RT = (bf16_t*)(ws + WS_W_RT);
        bf16_t* BT_END = (bf16_t*)(ws + WS_BT_END); bf16_t* BT_MAIN = (bf16_t*)(ws + WS_BT_MAIN);
        bf16_t* W_GU = (bf16_t*)(ws + WS_W_GU); bf16_t* W_DN = (bf16_t*)(ws + WS_W_DN);
        bf16_t* HB = (bf16_t*)(ws + WS_HB); bf16_t* MIXIN = (bf16_t*)(ws + WS_MIXIN); bf16_t* Y = (bf16_t*)(ws + WS_Y);
        bf16_t* XB = (bf16_t*)(ws + WS_XB); bf16_t* ACT = (bf16_t*)(ws + WS_ACT);
        bf16_t* Z = (bf16_t*)(ws + WS_Z); bf16_t* QKN = (bf16_t*)(ws + WS_QKN); bf16_t* QKVRAW = (bf16_t*)(ws + WS_QKVRAW);
        bf16_t* Qb = (bf16_t*)(ws + WS_Q); bf16_t* Kb = (bf16_t*)(ws + WS_K); bf16_t* VT = (bf16_t*)(ws + WS_VT);
        bf16_t* AS5 = (bf16_t*)(ws + WS_AS5); float* LEND = (float*)(ws + WS_LEND); bf16_t* GACT = (bf16_t*)(ws + WS_GACT);
        bf16_t* POOLED = (bf16_t*)(ws + WS_POOLED); bf16_t* VTS = (bf16_t*)(ws + WS_VTS);
        float* OUT = kp->out; const float* XIN = kp->x;
        const float* s5d = kp->s5_d; const float* glub = kp->s5_glu_b; const float* poolsc = kp->pool_scale; const float* sgub = kp->sgu_b;
        const float* bgu_all = kp->moe_b_gu; const float* bdn_all = kp->moe_b_dn; const float* rtb_all = kp->router_b;

        int layer = 0, mph = ph;
        if (ph >= 20 && ph <= 25) { layer = 1; mph = ph - 11; }
        const float* mod_l = MOD + (size_t)layer * NB * 6144;

        if (ph == 0) {
            const int gt = vb * NTHR + tid;
            if (gt < 2048) {
                const int g = gt >> 6, pp = gt & 63;
                const float dt = expf(kp->s5_log_dt[g]);
                const float lre = fminf(kp->s5_a_re[g * 64 + pp], -1e-4f), lim = kp->s5_a_im[g * 64 + pp];
                const float mag = expf(lre * dt);
                const float abr = mag * cosf(lim * dt), abi = mag * sinf(lim * dt);
                const float den = lre * lre + lim * lim, nr = abr - 1.0f;
                const float fre = (nr * lre + abi * lim) / den, fim = (abi * lre - nr * lim) / den;
                S5AB[(g * 64 + pp) * 2 + 0] = abr; S5AB[(g * 64 + pp) * 2 + 1] = abi;
                for (int j = 0; j < 16; ++j) {
                    const float br = kp->s5_b_re[(g * 64 + pp) * 16 + j], bi = kp->s5_b_im[(g * 64 + pp) * 16 + j];
                    S5BB[((g * 64 + pp) * 16 + j) * 2 + 0] = fre * br - fim * bi;
                    S5BB[((g * 64 + pp) * 16 + j) * 2 + 1] = fre * bi + fim * br;
                }
                float pr = 1.f, pi = 0.f;
                for (int tau = 0; tau <= 64; ++tau) {
                    PW[((g * 64 + pp) * 65 + tau) * 2 + 0] = pr; PW[((g * 64 + pp) * 65 + tau) * 2 + 1] = pi;
                    const float nr2 = pr * abr - pi * abi, ni2 = pr * abi + pi * abr; pr = nr2; pi = ni2;
                }
            }
            {
                float* ca = (float*)lds;
                for (int i = tid; i < NB * D; i += NTHR) { const float cv = kp->c[i]; ca[i] = cv * sigmoidf_(cv); }
                __syncthreads();
                for (int task = gw; task < 2 * 96; task += NGW) {
                    const int l = task / 96, cb = task % 96, col = cb * 64 + lane;
                    const float* W = kp->ada_w + (size_t)l * D * 6144 + col;
                    float acc[8];
#pragma unroll
                    for (int b = 0; b < 8; ++b) acc[b] = 0.f;
                    for (int k = 0; k < D; k += 8) {
                        float w[8];
#pragma unroll
                        for (int u = 0; u < 8; ++u) w[u] = W[(size_t)(k + u) * 6144];
#pragma unroll
                        for (int u = 0; u < 8; ++u)
#pragma unroll
                            for (int b = 0; b < 8; ++b) acc[b] += ca[b * D + k + u] * w[u];
                    }
                    const float bias = kp->ada_b[l * 6144 + col];
#pragma unroll
                    for (int b = 0; b < 8; ++b) MOD[((size_t)l * NB + b) * 6144 + col] = acc[b] + bias;
                }
                __syncthreads();
            }
            {
                float* scr = (float*)(lds + wave * 16384);
                transpose_many(kp->even_w_in, 1, 1024, 928, W_IN_E, 0, scr, gw, NGW, lane, 0);
                transpose_many(kp->w_uq, 1, 256, 768, W_UP, 0, scr, gw, NGW, lane, 0, 384);
                transpose_many(kp->w_ukv, 1, 128, 1024, W_UP + (size_t)768 * 384 + 256, 0, scr, gw, NGW, lane, 0, 384);
                for (int i = vb * NTHR + tid; i < 768 * 16 + 1024 * 32; i += G * NTHR) {
                    const u32x4 z = {0u, 0u, 0u, 0u};
                    if (i < 768 * 16) *(u32x4*)(W_UP + (size_t)(i >> 4) * 384 + 256 + (i & 15) * 8) = z;
                    else { const int q = i - 768 * 16; *(u32x4*)(W_UP + (size_t)(768 + (q >> 5)) * 384 + (q & 31) * 8) = z; }
                }
                transpose_many(kp->s5_glu_w, 1, 512, 512, W_GLU, 0, scr, gw, NGW, lane, 0);
                transpose_many(kp->even_w_out, 1, 1024, 1024, W_OUT_E, 0, scr, gw, NGW, lane, 0);
                transpose_many(kp->odd_w_in, 1, 1024, 1536, W_IN_O, 0, scr, gw, NGW, lane, 0);
                transpose_many(kp->odd_w_out, 1, 1024, 1024, W_OUT_O, 0, scr, gw, NGW, lane, 0);
                transpose_many(kp->pool_w, 4, 128, 128, W_POOL, 128 * 128, scr, gw, NGW, lane, 0);
                transpose_many(kp->router_w, 2, 1024, 32, W_RT, 128 * 1024, scr, gw, NGW, lane, 0);
                transpose_many(kp->moe_w_gu, 64, 1024, 2048, W_GU, (size_t)2048 * 1024, scr, gw, NGW, lane, 1);
                transpose_many(kp->moe_w_dn, 64, 1024, 1024, W_DN, (size_t)1024 * 1024, scr, gw, NGW, lane, 0);
                for (int i = vb * NTHR + tid; i < 4 * 128 * 128; i += G * NTHR) {
                    const int t = (i >> 7) & 127, s_ = i & 127;
                    W_SGU[i] = (s_ <= t) ? f2bf(kp->sgu_w[i]) : (bf16_t)0;
                }
            }
        }
        else if (ph == 1 || ph == 9 || ph == 15 || ph == 20 || ph == 26) {
            const int lyr = (ph == 1 || ph == 9) ? 0 : 1;
            const bool combine = (ph == 15 || ph == 26), donorm = (ph != 26);
            const int comb_layer = (ph == 15) ? 0 : 1;
            const bool ffn = (ph == 9 || ph == 20);
            const float* src = (ph == 1) ? kp->x : kp->out;
            const float* ng = (ffn ? kp->norm_ffn_g : kp->norm_mix_g) + lyr * D;
            for (int row = gw; row < T; row += NGW) {
                const int b = row / S;
                f32x4 v[4];
#pragma unroll
                for (int j = 0; j < 4; ++j) v[j] = *(const f32x4*)(src + (size_t)row * D + 4 * lane + 256 * j);
                if (combine) {
                    const float* gf = MOD + ((size_t)comb_layer * NB + b) * 6144 + 5 * D;
#pragma unroll
                    for (int j = 0; j < 4; ++j) {
                        const int c = 4 * lane + 256 * j;
                        float a0 = 0.f, a1 = 0.f, a2 = 0.f, a3 = 0.f;
#pragma unroll
                        for (int k = 0; k < 4; ++k) {
                            const u32x2 yy = *(const u32x2*)(Y + ((size_t)row * 4 + k) * D + c);
                            a0 += __uint_as_float(yy.x << 16); a1 += __uint_as_float(yy.x & 0xffff0000u);
                            a2 += __uint_as_float(yy.y << 16); a3 += __uint_as_float(yy.y & 0xffff0000u);
                        }
                        const f32x4 g4 = *(const f32x4*)(gf + c);
                        v[j].x += g4.x * a0; v[j].y += g4.y * a1; v[j].z += g4.z * a2; v[j].w += g4.w * a3;
                        *(f32x4*)(kp->out + (size_t)row * D + c) = v[j];
                    }
                }
                if (donorm) {
                    const float* mm = MOD + ((size_t)lyr * NB + b) * 6144 + (ffn ? 3 * D : 0);
                    norm_mod_store(v, ng, mm + D, mm, HB + (size_t)row * D, lane);
                }
            }
            if (ph == 1) {
                for (int idx = vb * NTHR + tid; idx < 32 * 64 * 256; idx += G * NTHR) {
                    const int j = idx & 15, i = (idx >> 4) & 15, tau = (idx >> 8) & 63, g = idx >> 14;
                    float acc = 0.f;
                    for (int pp = 0; pp < 64; ++pp) {
                        const float cr = kp->s5_c_re[(g * 16 + i) * 64 + pp], ci = kp->s5_c_im[(g * 16 + i) * 64 + pp];
                        const float pr = PW[((g * 64 + pp) * 65 + tau) * 2], pi = PW[((g * 64 + pp) * 65 + tau) * 2 + 1];
                        const float br = S5BB[((g * 64 + pp) * 16 + j) * 2], bi = S5BB[((g * 64 + pp) * 16 + j) * 2 + 1];
                        const float qr = pr * br - pi * bi, qi = pr * bi + pi * br;
                        acc += cr * qr - ci * qi;
                    }
                    KTAB[idx] = acc;
                }
            }
        }
        else if (ph == 2) {
            {
                DenseOrder so; so.go.init(T / 256, 4, G, vb);
                auto f = [=](const pg8::Unit& u, int r, int c, f32x4 v0, f32x4 v1) {
                        const int row = u.pm * 256 + r;
#pragma unroll
                        for (int h = 0; h < 2; ++h) {
                            const int col = u.pn * 256 + c + 16 * h; const f32x4 v = h ? v1 : v0;
                            u32x2 o; o.x = pk2(v.x, v.y); o.y = pk2(v.z, v.w);
                            if (col < 416) *(u32x2*)(Z + (size_t)row * 1024 + col) = o;
                            else if (col < 928) {
                                const int ch = col - 416, g = ch >> 4, j = ch & 15, b = row / S, t = row % S;
                                *(u32x2*)(AS5 + ((size_t)g * 512 + b * 64 + (t >> 6)) * 1152 + 128 + (t & 63) * 16 + j) = o;
                            }
                        }
                    };
                pg8::gemm_phase(tid, (PG8_LAS unsigned char*)lds, pg8::Gemm{HB, W_IN_E, D, D, D}, so, pg8::Epi<decltype(f)>{f});
            }
            for (int idx = vb * NTHR + tid; idx < 32 * 128 * 128; idx += G * NTHR) {
                const int k8 = idx & 127, n = (idx >> 7) & 127, g = idx >> 14;
                const int ri = n >> 6, pp = n & 63, s_ = k8 >> 1, j0 = (k8 & 1) * 8;
                const float pr = PW[((g * 64 + pp) * 65 + (63 - s_)) * 2], pi = PW[((g * 64 + pp) * 65 + (63 - s_)) * 2 + 1];
                float o[8];
#pragma unroll
                for (int j = 0; j < 8; ++j) {
                    const float br = S5BB[((g * 64 + pp) * 16 + j0 + j) * 2], bi = S5BB[((g * 64 + pp) * 16 + j0 + j) * 2 + 1];
                    o[j] = ri ? (pr * bi + pi * br) : (pr * br - pi * bi);
                }
                u32x4 w; w.x = pk2(o[0], o[1]); w.y = pk2(o[2], o[3]); w.z = pk2(o[4], o[5]); w.w = pk2(o[6], o[7]);
                *(u32x4*)(BT_END + ((size_t)g * 128 + n) * 1024 + k8 * 8) = w;
            }
            for (int idx = vb * NTHR + tid; idx < 32 * 1024 * 144; idx += G * NTHR) {
                const int k8 = idx % 144, n = (idx / 144) & 1023, g = idx / (144 * 1024);
                const int t = n >> 4, i = n & 15;
                float o[8];
                if (k8 < 16) {
                    const int ri = k8 >> 3, p0 = (k8 & 7) * 8;
#pragma unroll
                    for (int j = 0; j < 8; ++j) {
                        const int pp = p0 + j;
                        const float cr = kp->s5_c_re[(g * 16 + i) * 64 + pp], ci = kp->s5_c_im[(g * 16 + i) * 64 + pp];
                        const float pr = PW[((g * 64 + pp) * 65 + t + 1) * 2], pi = PW[((g * 64 + pp) * 65 + t + 1) * 2 + 1];
                        o[j] = ri ? -(cr * pi + ci * pr) : (cr * pr - ci * pi);
                    }
                } else {
                    const int kk = (k8 - 16) * 8, s_ = kk >> 4, j0 = kk & 15;
#pragma unroll
                    for (int j = 0; j < 8; ++j) o[j] = (s_ <= t) ? KTAB[((g * 64 + (t - s_)) * 16 + i) * 16 + j0 + j] : 0.f;
                }
                u32x4 w; w.x = pk2(o[0], o[1]); w.y = pk2(o[2], o[3]); w.z = pk2(o[4], o[5]); w.w = pk2(o[6], o[7]);
                *(u32x4*)(BT_MAIN + ((size_t)g * 1024 + n) * 1152 + k8 * 8) = w;
            }
        }
        else if (ph == 3) {
            for (int row = gw; row < T; row += NGW) {
                const u32x2 qv = *(const u32x2*)(Z + (size_t)row * 1024 + lane * 4);
                const unsigned kv = *(const unsigned*)(Z + (size_t)row * 1024 + 256 + lane * 2);
                const float q0 = __uint_as_float(qv.x << 16), q1 = __uint_as_float(qv.x & 0xffff0000u), q2 = __uint_as_float(qv.y << 16), q3 = __uint_as_float(qv.y & 0xffff0000u);
                const float k0 = __uint_as_float(kv << 16), k1 = __uint_as_float(kv & 0xffff0000u);
                const float rq = rsqrtf(wave_sum(q0 * q0 + q1 * q1 + q2 * q2 + q3 * q3) * (1.f / 256.f) + 1e-6f);
                const float rk = rsqrtf(wave_sum(k0 * k0 + k1 * k1) * (1.f / 128.f) + 1e-6f);
                const f32x4 gq = *(const f32x4*)(kp->q_norm_g + lane * 4);
                u32x2 o; o.x = pk2(q0 * rq * gq.x, q1 * rq * gq.y); o.y = pk2(q2 * rq * gq.z, q3 * rq * gq.w);
                *(u32x2*)(QKN + (size_t)row * 384 + lane * 4) = o;
                *(unsigned*)(QKN + (size_t)row * 384 + 256 + lane * 2) = pk2(k0 * rk * kp->kv_norm_g[lane * 2], k1 * rk * kp->kv_norm_g[lane * 2 + 1]);
            }
            for (int u = vb; u < 128; u += G) {
                const int g = u >> 2, pm = u & 3;
                sg_tile(tid, lds, AS5 + ((size_t)g * 512 + pm * 128) * 1152 + 128, 1152, BT_END + (size_t)g * 128 * 1024, 1024, 1024,
                    [=](int r, int c, f32x4 v0, f32x4 v1) {
                        float* o = LEND + ((size_t)g * 512 + pm * 128 + r) * 128 + c;
                        *(f32x4*)o = v0; *(f32x4*)(o + 16) = v1;
                    });
            }
        }
        else if (ph == 4) {
            {
                DenseOrder so; so.go.init(T / 256, 7, G, vb);
                auto f = [=](const pg8::Unit& u, int r, int c, f32x4 v0, f32x4 v1) {
                            bf16_t* o = QKVRAW + (size_t)(u.pm * 256 + r) * 1792 + u.pn * 256 + c;
                            u32x2 a; a.x = pk2(v0.x, v0.y); a.y = pk2(v0.z, v0.w); *(u32x2*)o = a;
                            u32x2 b; b.x = pk2(v1.x, v1.y); b.y = pk2(v1.z, v1.w); *(u32x2*)(o + 16) = b;
                        };
                pg8::gemm_phase(tid, (PG8_LAS unsigned char*)lds, pg8::Gemm{QKN, W_UP, 384, 384, 384}, so, pg8::Epi<decltype(f)>{f});
            }
        }
        else if (ph == 5) {
            bf16_t* stq = (bf16_t*)(lds + 65536) + wave * 1536;
            bf16_t* vts = (bf16_t*)lds;
            const float qscale = 0.10206207261596577f * 1.4426950408889634f;
            for (int tile = vb; tile < T / 64; tile += G) {
                const int hh = lane >> 3, pp = lane & 7;
                for (int tt = 0; tt < 8; ++tt) {
                    const int tl = wave * 8 + tt, row = tile * 64 + tl, b = row / S, t = row % S;
                    float qv[12], kv[12];
#pragma unroll
                    for (int j = 0; j < 12; ++j) {
                        const int d = pp + 8 * j;
                        qv[j] = bf2f(QKVRAW[(size_t)row * 1792 + hh * 96 + d]);
                        kv[j] = (j < 8) ? bf2f(QKVRAW[(size_t)row * 1792 + 768 + hh * 128 + d]) : bf2f(Z[(size_t)row * 1024 + 384 + d - 64]);
                    }
                    float sq = 0.f, sk = 0.f;
#pragma unroll
                    for (int j = 0; j < 12; ++j) { sq += qv[j] * qv[j]; sk += kv[j] * kv[j]; }
                    sq += __shfl_xor(sq, 1); sq += __shfl_xor(sq, 2); sq += __shfl_xor(sq, 4);
                    sk += __shfl_xor(sk, 1); sk += __shfl_xor(sk, 2); sk += __shfl_xor(sk, 4);
                    const float rq = rsqrtf(sq * (1.f / 96.f) + 1e-6f), rk = rsqrtf(sk * (1.f / 96.f) + 1e-6f);
#pragma unroll
                    for (int j = 0; j < 12; ++j) { const int d = pp + 8 * j; qv[j] *= rq * kp->q_head_g[d]; kv[j] *= rk * kp->k_head_g[d]; }
                    const float posf = (float)kp->pos[row];
#pragma unroll
                    for (int e = 0; e < 2; ++e) {
                        const int i = pp + 8 * e;
                        const float invf = exp2f(-(float)i * (13.287712379549449f / 16.0f));
                        const float ang = posf * invf;
                        const float kq = rintf(ang * 0.15915494309189535f);
                        float rr = __builtin_fmaf(-kq, 6.28318548202514648f, ang); rr = __builtin_fmaf(-kq, -1.7484556e-7f, rr);
                        const float cs = __cosf(rr), sn = __sinf(rr);
                        const float q1 = qv[8 + e], q2 = qv[10 + e], k1 = kv[8 + e], k2 = kv[10 + e];
                        qv[8 + e] = q1 * cs - q2 * sn; qv[10 + e] = q1 * sn + q2 * cs;
                        kv[8 + e] = k1 * cs - k2 * sn; kv[10 + e] = k1 * sn + k2 * cs;
                    }
#pragma unroll
                    for (int j = 0; j < 12; ++j) { const int d = pp + 8 * j; stq[hh * 96 + d] = f2bf(qv[j] * qscale); stq[768 + hh * 96 + d] = f2bf(kv[j]); }
#pragma unroll
                    for (int j = 0; j < 8; ++j) { const int dv = pp + 8 * j; vts[(hh * 64 + dv) * 64 + tl] = QKVRAW[(size_t)row * 1792 + 768 + hh * 128 + 64 + dv]; }
                    __builtin_amdgcn_s_waitcnt(0xC07F); asm volatile("" ::: "memory");
                    for (int ch = lane; ch < 192; ch += 64) {
                        const int isk = ch >= 96, c2 = ch - 96 * isk, h2 = c2 / 12, part = c2 % 12;
                        const u32x4 vv = *(const u32x4*)(stq + isk * 768 + h2 * 96 + part * 8);
                        bf16_t* dst = (isk ? Kb : Qb) + (((size_t)b * 8 + h2) * S + t) * 96 + part * 8;
                        *(u32x4*)dst = vv;
                    }
                    __builtin_amdgcn_s_waitcnt(0xC07F); asm volatile("" ::: "memory");
                }
                __syncthreads();
                {
                    const int hd = tid, b = (tile * 64) / S, t0 = (tile * 64) % S;
                    bf16_t* dst = VT + (((size_t)b * 8 + (hd >> 6)) * 64 + (hd & 63)) * S + t0;
#pragma unroll
                    for (int i = 0; i < 8; ++i) *(u32x4*)(dst + i * 8) = *(const u32x4*)(vts + hd * 64 + i * 8);
                }
                __syncthreads();
            }
            for (int ch = vb * NTHR + tid; ch < NB * 32 * 64; ch += G * NTHR) {
                const int pp = ch & 63, g = (ch >> 6) & 31, b = ch >> 11;
                const float ar = PW[((g * 64 + pp) * 65 + 64) * 2], ai = PW[((g * 64 + pp) * 65 + 64) * 2 + 1];
                float cr = 0.f, ci = 0.f;
                for (int c = 0; c < 64; ++c) {
                    bf16_t* dst = AS5 + ((size_t)g * 512 + b * 64 + c) * 1152;
                    dst[pp] = f2bf(cr); dst[64 + pp] = f2bf(ci);
                    const float* le = LEND + ((size_t)g * 512 + b * 64 + c) * 128;
                    const float nr = ar * cr - ai * ci + le[pp], ni = ar * ci + ai * cr + le[64 + pp];
                    cr = nr; ci = ni;
                }
            }
        }
        else if (ph == 6) {
            unsigned char* Ks = lds;
            unsigned char* Vs = lds + 64 * 208;
            const int r32 = lane & 31, hi = lane >> 5;
            for (int ui = 0; ui < 4; ++ui) {
                if (vb >= 256) break;
                const int bh = vb & 63, kq = vb >> 6;
                const int qb = (ui == 0) ? 15 - kq : (ui == 1) ? 8 + kq : (ui == 2) ? 7 - kq : kq;
                const int q0 = qb * 256 + wave * 32;
                const bf16_t* Qg = Qb + ((size_t)bh * S + q0 + r32) * 96;
                const bf16_t* Kg = Kb + (size_t)bh * S * 96;
                const bf16_t* Vg = VT + (size_t)bh * 64 * S;
                bf16x8 qf[6];
#pragma unroll
                for (int d0 = 0; d0 < 6; ++d0) qf[d0] = *(const bf16x8*)(Qg + d0 * 16 + hi * 8);
                f32x16 o0, o1;
#pragma unroll
                for (int r = 0; r < 16; ++r) { o0[r] = 0.f; o1[r] = 0.f; }
                float m_run = -1e30f, l_run = 0.f;
                const int ntile = 4 * (qb + 1);
                u32x4 rk0, rk1, rv;
                const int kr0 = tid / 12, kc0 = tid % 12, kr1 = (tid + 512) / 12, kc1 = (tid + 512) % 12;
                const int vr = tid >> 3, vc = tid & 7;
                rk0 = *(const u32x4*)(Kg + (size_t)kr0 * 96 + kc0 * 8);
                if (tid < 256) rk1 = *(const u32x4*)(Kg + (size_t)kr1 * 96 + kc1 * 8);
                rv = *(const u32x4*)(Vg + (size_t)vr * S + vc * 8);
                for (int t = 0; t < ntile; ++t) {
                    __syncthreads();
                    *(u32x4*)(Ks + kr0 * 208 + kc0 * 16) = rk0;
                    if (tid < 256) *(u32x4*)(Ks + kr1 * 208 + kc1 * 16) = rk1;
                    { u32x2 a; a.x = rv.x; a.y = rv.y; u32x2 b2; b2.x = rv.z; b2.y = rv.w;
                      *(u32x2*)(Vs + vr * 136 + vc * 16) = a; *(u32x2*)(Vs + vr * 136 + vc * 16 + 8) = b2; }
                    __syncthreads();
                    if (t + 1 < ntile) {
                        rk0 = *(const u32x4*)(Kg + (size_t)((t + 1) * 64 + kr0) * 96 + kc0 * 8);
                        if (tid < 256) rk1 = *(const u32x4*)(Kg + (size_t)((t + 1) * 64 + kr1) * 96 + kc1 * 8);
                        rv = *(const u32x4*)(Vg + (size_t)vr * S + (t + 1) * 64 + vc * 8);
                    }
                    if (t * 64 > q0 + 31) continue;
                    f32x16 s0, s1;
#pragma unroll
                    for (int r = 0; r < 16; ++r) { s0[r] = 0.f; s1[r] = 0.f; }
#pragma unroll
                    for (int d0 = 0; d0 < 6; ++d0) {
                        const bf16x8 k0 = *(const bf16x8*)(Ks + r32 * 208 + d0 * 32 + hi * 16);
                        const bf16x8 k1 = *(const bf16x8*)(Ks + (32 + r32) * 208 + d0 * 32 + hi * 16);
                        s0 = __builtin_amdgcn_mfma_f32_32x32x16_bf16(k0, qf[d0], s0, 0, 0, 0);
                        s1 = __builtin_amdgcn_mfma_f32_32x32x16_bf16(k1, qf[d0], s1, 0, 0, 0);
                    }
                    if (t * 64 + 63 > q0) {
                        const int qi = q0 + r32;
#pragma unroll
                        for (int r = 0; r < 16; ++r) {
                            const int key = t * 64 + crow(r, hi);
                            if (key > qi) s0[r] = -INFINITY;
                            if (key + 32 > qi) s1[r] = -INFINITY;
                        }
                    }
                    float mx = s0[0];
#pragma unroll
                    for (int r = 1; r < 16; ++r) mx = fmaxf(mx, s0[r]);
#pragma unroll
                    for (int r = 0; r < 16; ++r) mx = fmaxf(mx, s1[r]);
                    mx = fmaxf(mx, __shfl_xor(mx, 32));
                    const float m_new = fmaxf(m_run, mx);
                    const float alpha = __builtin_amdgcn_exp2f(m_run - m_new);
                    m_run = m_new;
                    float ls = 0.f;
#pragma unroll
                    for (int r = 0; r < 16; ++r) { s0[r] = __builtin_amdgcn_exp2f(s0[r] - m_new); s1[r] = __builtin_amdgcn_exp2f(s1[r] - m_new); ls += s0[r] + s1[r]; }
                    l_run = l_run * alpha + ls;
#pragma unroll
                    for (int r = 0; r < 16; ++r) { o0[r] *= alpha; o1[r] *= alpha; }
                    bf16x8 pf[2][2];
#pragma unroll
                    for (int ks = 0; ks < 2; ++ks) {
                        u32x4 w0, w1;
                        w0.x = pk2(s0[8 * ks + 0], s0[8 * ks + 1]); w0.y = pk2(s0[8 * ks + 2], s0[8 * ks + 3]); w0.z = pk2(s0[8 * ks + 4], s0[8 * ks + 5]); w0.w = pk2(s0[8 * ks + 6], s0[8 * ks + 7]);
                        w1.x = pk2(s1[8 * ks + 0], s1[8 * ks + 1]); w1.y = pk2(s1[8 * ks + 2], s1[8 * ks + 3]); w1.z = pk2(s1[8 * ks + 4], s1[8 * ks + 5]); w1.w = pk2(s1[8 * ks + 6], s1[8 * ks + 7]);
                        pf[0][ks] = __builtin_bit_cast(bf16x8, w0); pf[1][ks] = __builtin_bit_cast(bf16x8, w1);
                    }
#pragma unroll
                    for (int kb = 0; kb < 2; ++kb)
#pragma unroll
                        for (int ks = 0; ks < 2; ++ks) {
                            const int koff = (kb * 32 + 16 * ks + 4 * hi) * 2;
#pragma unroll
                            for (int dvb = 0; dvb < 2; ++dvb) {
                                const unsigned char* vp = Vs + (dvb * 32 + r32) * 136 + koff;
                                const u32x2 lo = *(const u32x2*)vp, hi2 = *(const u32x2*)(vp + 16);
                                u32x4 w; w.x = lo.x; w.y = lo.y; w.z = hi2.x; w.w = hi2.y;
                                const bf16x8 vf = __builtin_bit_cast(bf16x8, w);
                                if (dvb == 0) o0 = __builtin_amdgcn_mfma_f32_32x32x16_bf16(vf, pf[kb][ks], o0, 0, 0, 0);
                                else o1 = __builtin_amdgcn_mfma_f32_32x32x16_bf16(vf, pf[kb][ks], o1, 0, 0, 0);
                            }
                        }
                }
                l_run += __shfl_xor(l_run, 32);
                const float rl = 1.0f / l_run;
                const int b = bh >> 3, h = bh & 7;
                bf16_t* orow = MIXIN + ((size_t)b * S + q0 + r32) * 1024 + h * 64;
#pragma unroll
                for (int rg = 0; rg < 4; ++rg) {
                    u32x2 a; a.x = pk2(o0[4 * rg] * rl, o0[4 * rg + 1] * rl); a.y = pk2(o0[4 * rg + 2] * rl, o0[4 * rg + 3] * rl);
                    *(u32x2*)(orow + 8 * rg + 4 * hi) = a;
                    u32x2 c2; c2.x = pk2(o1[4 * rg] * rl, o1[4 * rg + 1] * rl); c2.y = pk2(o1[4 * rg + 2] * rl, o1[4 * rg + 3] * rl);
                    *(u32x2*)(orow + 32 + 8 * rg + 4 * hi) = c2;
                }
            }
            __syncthreads();
            {
                S5Order so; so.G = G; so.c = vb;
                auto f = [=](const pg8::Unit& u, int r, int c, f32x4 v0, f32x4 v1) {
                        const int g = u.aux, m = (u.pm & 1) * 256 + r, b = m >> 6, ck = m & 63;
#pragma unroll
                        for (int h = 0; h < 2; ++h) {
                            const int n = u.pn * 256 + c + 16 * h; const f32x4 v = h ? v1 : v0;
                            const int tq = n >> 4, i = n & 15;
                            const u32x2 uu = *(const u32x2*)(AS5 + ((size_t)g * 512 + m) * 1152 + 128 + n);
                            const f32x4 dd = *(const f32x4*)(s5d + g * 16 + i);
                            const float y0 = v.x + dd.x * __uint_as_float(uu.x << 16), y1 = v.y + dd.y * __uint_as_float(uu.x & 0xffff0000u),
                                        y2 = v.z + dd.z * __uint_as_float(uu.y << 16), y3 = v.w + dd.w * __uint_as_float(uu.y & 0xffff0000u);
                            u32x2 o; o.x = pk2(gelu_tanh(y0), gelu_tanh(y1)); o.y = pk2(gelu_tanh(y2), gelu_tanh(y3));
                            *(u32x2*)(GACT + ((size_t)b * S + ck * 64 + tq) * 512 + g * 16 + i) = o;
                        }
                    };
                pg8::gemm_phase(tid, (PG8_LAS unsigned char*)lds, pg8::Gemm{AS5, BT_MAIN, 1152, 1152, 1152}, so, pg8::Epi<decltype(f)>{f});
            }
        }
        else if (ph == 7) {
            {
                DenseOrder so; so.go.init(T / 256, 2, G, vb);
                auto f = [=](const pg8::Unit& u, int r, int c, f32x4 v0, f32x4 v1) {
                        const int row = u.pm * 256 + r;
#pragma unroll
                        for (int h = 0; h < 2; ++h) {
                            const int col = u.pn * 256 + c + 16 * h; const f32x4 v = h ? v1 : v0;
                            const u32x2 gg = *(const u32x2*)(GACT + (size_t)row * 512 + col);
                            const f32x4 bb = *(const f32x4*)(glub + col);
                            const float g0 = __uint_as_float(gg.x << 16), g1 = __uint_as_float(gg.x & 0xffff0000u), g2 = __uint_as_float(gg.y << 16), g3 = __uint_as_float(gg.y & 0xffff0000u);
                            u32x2 o; o.x = pk2(g0 * sigmoidf_(v.x + bb.x), g1 * sigmoidf_(v.y + bb.y)); o.y = pk2(g2 * sigmoidf_(v.z + bb.z), g3 * sigmoidf_(v.w + bb.w));
                            *(u32x2*)(MIXIN + (size_t)row * 1024 + 512 + col) = o;
                        }
                    };
                pg8::gemm_phase(tid, (PG8_LAS unsigned char*)lds, pg8::Gemm{GACT, W_GLU, 512, 512, 512}, so, pg8::Epi<decltype(f)>{f});
            }
        }
        else if (ph == 8 || ph == 19) {
            const int lyr = (ph == 8) ? 0 : 1;
            const bf16_t* W = lyr ? W_OUT_O : W_OUT_E;
            const float* src = lyr ? OUT : XIN;
            {
                DenseOrder so; so.go.init(T / 256, 4, G, vb);
                auto f = [=](const pg8::Unit& u, int r, int c, f32x4 v0, f32x4 v1) {
                        const int row = u.pm * 256 + r, b = row / S;
                        const float* gm = MOD + ((size_t)lyr * NB + b) * 6144 + 2 * D;
#pragma unroll
                        for (int h = 0; h < 2; ++h) {
                            const int col = u.pn * 256 + c + 16 * h; const f32x4 v = h ? v1 : v0;
                            const f32x4 xs = *(const f32x4*)(src + (size_t)row * D + col), g4 = *(const f32x4*)(gm + col);
                            f32x4 o; o.x = xs.x + g4.x * v.x; o.y = xs.y + g4.y * v.y; o.z = xs.z + g4.z * v.z; o.w = xs.w + g4.w * v.w;
                            *(f32x4*)(OUT + (size_t)row * D + col) = o;
                        }
                    };
                pg8::gemm_phase(tid, (PG8_LAS unsigned char*)lds, pg8::Gemm{MIXIN, W, D, D, D}, so, pg8::Epi<decltype(f)>{f});
            }
        }
        else if (mph == 10) {
            const bf16_t* W = W_RT + (size_t)layer * 128 * 1024;
            const float* rb = rtb_all + layer * 32;
            for (int u = vb; u < 256; u += G) {
                const int pm = u;
                sg_tile(tid, lds, HB + (size_t)pm * 128 * D, D, W, D, D,
                    [=](int r, int c, f32x4 v0, f32x4 v1) {
                        const int row = pm * 128 + r;
                        if (c < 32) {
                            const f32x4 b0 = *(const f32x4*)(rb + c), b1 = *(const f32x4*)(rb + c + 16);
                            f32x4 a = v0 + b0, bq = v1 + b1;
                            *(f32x4*)(LOGIT + (size_t)row * 32 + c) = a; *(f32x4*)(LOGIT + (size_t)row * 32 + c + 16) = bq;
                        }
                    });
            }
        }
        else if (mph == 11) {
            unsigned* hist = (unsigned*)lds;
            unsigned* gcnt = ctl + CW_CNT + layer * 64;
            for (int blk = vb; blk < T / NTHR; blk += G) {
                if (tid < 64) hist[tid] = 0u;
                __syncthreads();
                const int tok = blk * NTHR + tid;
                float lg[32];
#pragma unroll
                for (int i = 0; i < 8; ++i) { const f32x4 v = *(const f32x4*)(LOGIT + (size_t)tok * 32 + 4 * i); lg[4 * i] = v.x; lg[4 * i + 1] = v.y; lg[4 * i + 2] = v.z; lg[4 * i + 3] = v.w; }
                int e4[4]; float v4[4];
#pragma unroll
                for (int k = 0; k < 4; ++k) {
                    float best = -INFINITY; int bi = 0;
#pragma unroll
                    for (int e = 0; e < 32; ++e) { const bool tk = lg[e] > best; best = tk ? lg[e] : best; bi = tk ? e : bi; }
                    e4[k] = bi; v4[k] = best;
#pragma unroll
                    for (int e = 0; e < 32; ++e) lg[e] = (e == bi) ? -INFINITY : lg[e];
                }
                float den = 0.f, ex[4];
#pragma unroll
                for (int k = 0; k < 4; ++k) { ex[k] = __expf(v4[k] - v4[0]); den += ex[k]; }
                unsigned lp[4];
#pragma unroll
                for (int k = 0; k < 4; ++k) lp[k] = atomicAdd(hist + e4[k], 1u);
                __syncthreads();
                if (tid < 32) hist[32 + tid] = atomicAdd(gcnt + tid, (unsigned)hist[tid]);
                __syncthreads();
#pragma unroll
                for (int k = 0; k < 4; ++k) {
                    tok_e[tok * 4 + k] = e4[k]; tok_pos[tok * 4 + k] = (int)(hist[32 + e4[k]] + lp[k]); tok_gate[tok * 4 + k] = ex[k] / den;
                }
                __syncthreads();
            }
        }
        else if (mph == 12 || mph == 13 || mph == 14) {
            int* pst = (int*)(lds + 140 * 1024 - 1024);
            if (tid == 0) {
                const unsigned* gcnt = ctl + CW_CNT + layer * 64; int acc = 0;
                for (int e = 0; e < 32; ++e) { const int c = (int)gcnt[e]; pst[e] = acc; pst[64 + e] = c; acc += (c + 255) & ~255; }
                pst[32] = acc;
            }
            __syncthreads();
            const int total_rows = pst[32];
            if (mph == 12) {
                for (int it = gw; it < T * 4; it += NGW) {
                    const int tok = it >> 2, e = tok_e[it], row = pst[e] + tok_pos[it];
                    const u32x4* s = (const u32x4*)(HB + (size_t)tok * D);
                    u32x4* d = (u32x4*)(XB + (size_t)row * D);
                    d[lane] = s[lane]; d[lane + 64] = s[lane + 64];
                    if (lane == 0) { row_slot[row] = it; row_gate[row] = tok_gate[it]; }
                }
                for (int e = 0; e < 32; ++e) {
                    const int lo = pst[e] + pst[64 + e], hi2 = pst[e + 1];
                    for (int r = lo + vb * NTHR + tid; r < hi2; r += G * NTHR) { row_slot[r] = -1; row_gate[r] = 0.f; }
                }
            } else if (mph == 13) {
                {
                    MoeOrder so; so.go.init(total_rows >> 8, 8, G, vb); so.pst = pst; so.NT = 8; so.ebase = layer * 32;
                    auto f = [=](const pg8::Unit& u, int r, int c, f32x4 v0, f32x4 v1) {
                            const int row0 = u.pm * 256, cc = u.pn * 256 + c;
                            const float* bg = bgu_all + (size_t)(layer * 32 + u.aux) * 2048;
                            const int j = (cc >> 5) * 16 + (cc & 15);
                            const f32x4 b0 = *(const f32x4*)(bg + j), b1 = *(const f32x4*)(bg + 1024 + j);
                            float o[4];
#pragma unroll
                            for (int i = 0; i < 4; ++i) {
                                const float gt = fminf(v0[i] + b0[i], 7.0f), ln = fminf(fmaxf(v1[i] + b1[i], -7.0f), 7.0f);
                                o[i] = gt * sigmoidf_(1.702f * gt) * (ln + 1.0f);
                            }
                            u32x2 w; w.x = pk2(o[0], o[1]); w.y = pk2(o[2], o[3]);
                            *(u32x2*)(ACT + (size_t)(row0 + r) * D + j) = w;
                        };
                    pg8::gemm_phase(tid, (PG8_LAS unsigned char*)lds, pg8::Gemm{XB, W_GU, D, D, D}, so, pg8::Epi<decltype(f)>{f});
                }
            } else {
                {
                    MoeOrder so; so.go.init(total_rows >> 8, 4, G, vb); so.pst = pst; so.NT = 4; so.ebase = layer * 32;
                    auto f = [=](const pg8::Unit& u, int r, int c, f32x4 v0, f32x4 v1) {
                            const float* bd = bdn_all + (size_t)(layer * 32 + u.aux) * 1024;
                            const int row = u.pm * 256 + r, slot = row_slot[row];
                            if (slot >= 0) {
                                const float gt = row_gate[row];
#pragma unroll
                                for (int h = 0; h < 2; ++h) {
                                    const int col = u.pn * 256 + c + 16 * h; const f32x4 v = h ? v1 : v0;
                                    const f32x4 bb = *(const f32x4*)(bd + col);
                                    u32x2 o; o.x = pk2((v.x + bb.x) * gt, (v.y + bb.y) * gt); o.y = pk2((v.z + bb.z) * gt, (v.w + bb.w) * gt);
                                    *(u32x2*)(Y + (size_t)slot * D + col) = o;
                                }
                            }
                        };
                    pg8::gemm_phase(tid, (PG8_LAS unsigned char*)lds, pg8::Gemm{ACT, W_DN, D, D, D}, so, pg8::Epi<decltype(f)>{f});
                }
            }
        }
        else if (ph == 16) {
            {
                DenseOrder so; so.go.init(T / 256, 6, G, vb);
                auto f = [=](const pg8::Unit& u, int r, int c, f32x4 v0, f32x4 v1) {
                        const int row = u.pm * 256 + r;
#pragma unroll
                        for (int h = 0; h < 2; ++h) {
                            const int col = u.pn * 256 + c + 16 * h; f32x4 v = h ? v1 : v0;
                            if (col >= 512) { v.x = gelu_tanh(v.x); v.y = gelu_tanh(v.y); v.z = gelu_tanh(v.z); v.w = gelu_tanh(v.w); }
                            u32x2 o; o.x = pk2(v.x, v.y); o.y = pk2(v.z, v.w);
                            *(u32x2*)(Z + (size_t)row * 1536 + col) = o;
                        }
                    };
                pg8::gemm_phase(tid, (PG8_LAS unsigned char*)lds, pg8::Gemm{HB, W_IN_O, D, D, D}, so, pg8::Epi<decltype(f)>{f});
            }
        }
        else if (ph == 17) {
            for (int ck = vb; ck < T / 128; ck += G) {
                bf16_t* tile = (bf16_t*)lds;
                for (int tt = 0; tt < 16; ++tt) {
                    const int sl = wave * 16 + tt, row = ck * 128 + sl, t = row % S;
                    {
                        const int ch0 = lane * 8, w = 2 << (ch0 >> 7);
                        float acc[8], own[8];
#pragma unroll
                        for (int i = 0; i < 8; ++i) acc[i] = 0.f;
                        const int n = (t + 1 < w) ? t + 1 : w;
                        for (int q = 0; q < n; ++q) {
                            const u32x4 uv = *(const u32x4*)(Z + (size_t)(row - q) * 1536 + ch0);
                            const float f[8] = {__uint_as_float(uv.x << 16), __uint_as_float(uv.x & 0xffff0000u), __uint_as_float(uv.y << 16), __uint_as_float(uv.y & 0xffff0000u),
                                                __uint_as_float(uv.z << 16), __uint_as_float(uv.z & 0xffff0000u), __uint_as_float(uv.w << 16), __uint_as_float(uv.w & 0xffff0000u)};
#pragma unroll
                            for (int i = 0; i < 8; ++i) { acc[i] += f[i]; if (q == 0) own[i] = f[i]; }
                        }
                        const float inv = 1.0f / (float)n;
                        u32x4 o; o.x = pk2(acc[0] * inv - own[0], acc[1] * inv - own[1]); o.y = pk2(acc[2] * inv - own[2], acc[3] * inv - own[3]);
                        o.z = pk2(acc[4] * inv - own[4], acc[5] * inv - own[5]); o.w = pk2(acc[6] * inv - own[6], acc[7] * inv - own[7]);
                        *(u32x4*)(POOLED + (size_t)row * 512 + ch0) = o;
                    }
                    {
                        const u32x4 uv = *(const u32x4*)(Z + (size_t)row * 1536 + 1024 + lane * 8);
                        float f[8] = {__uint_as_float(uv.x << 16), __uint_as_float(uv.x & 0xffff0000u), __uint_as_float(uv.y << 16), __uint_as_float(uv.y & 0xffff0000u),
                                      __uint_as_float(uv.z << 16), __uint_as_float(uv.z & 0xffff0000u), __uint_as_float(uv.w << 16), __uint_as_float(uv.w & 0xffff0000u)};
                        float ss = 0.f;
#pragma unroll
                        for (int i = 0; i < 8; ++i) ss += f[i] * f[i];
                        const float rr = rsqrtf(wave_sum(ss) * (1.f / 512.f) + 1e-6f);
                        u32x4 o;
                        const float* gg = kp->sgu_norm_g + lane * 8;
                        o.x = pk2(f[0] * rr * gg[0], f[1] * rr * gg[1]); o.y = pk2(f[2] * rr * gg[2], f[3] * rr * gg[3]);
                        o.z = pk2(f[4] * rr * gg[4], f[5] * rr * gg[5]); o.w = pk2(f[6] * rr * gg[6], f[7] * rr * gg[7]);
                        *(u32x4*)(tile + sl * 520 + lane * 8) = o;
                    }
                }
                __syncthreads();
                {
                    const int ch = tid;
                    bf16_t* dst = VTS + ((size_t)ck * 512 + ch) * 128;
                    for (int s8 = 0; s8 < 16; ++s8) {
                        unsigned w[4];
#pragma unroll
                        for (int i = 0; i < 4; ++i) w[i] = (unsigned)tile[(s8 * 8 + 2 * i) * 520 + ch] | ((unsigned)tile[(s8 * 8 + 2 * i + 1) * 520 + ch] << 16);
                        u32x4 o; o.x = w[0]; o.y = w[1]; o.z = w[2]; o.w = w[3];
                        *(u32x4*)(dst + s8 * 8) = o;
                    }
                }
                __syncthreads();
            }
        }
        else if (ph == 18) {
            for (int u = vb; u < 2048; u += G) {
                if (u < 1024) {
                    const int pm = u >> 2, gi = u & 3;
                    sg_tile(tid, lds, POOLED + (size_t)pm * 128 * 512 + gi * 128, 512, W_POOL + (size_t)gi * 128 * 128, 128, 128,
                        [=](int r, int c, f32x4 v0, f32x4 v1) {
                            const int row = pm * 128 + r;
#pragma unroll
                            for (int h = 0; h < 2; ++h) {
                                const int col = gi * 128 + c + 16 * h; const f32x4 v = h ? v1 : v0;
                                const f32x4 sc = *(const f32x4*)(poolsc + col);
                                u32x2 o; o.x = pk2(v.x * sc.x, v.y * sc.y); o.y = pk2(v.z * sc.z, v.w * sc.w);
                                *(u32x2*)(MIXIN + (size_t)row * 1024 + col) = o;
                            }
                        });
                } else {
                    const int uu = u - 1024, ck = uu >> 2, h4 = uu & 3;
                    sg_tile(tid, lds, W_SGU + (size_t)h4 * 128 * 128, 128, VTS + ((size_t)ck * 512 + h4 * 128) * 128, 128, 128,
                        [=](int r, int c, f32x4 v0, f32x4 v1) {
                            const int row = ck * 128 + r;
                            const float bias = sgub[h4 * 128 + r];
#pragma unroll
                            for (int h = 0; h < 2; ++h) {
                                const int dcol = c + 16 * h; const f32x4 v = h ? v1 : v0;
                                const u32x2 ug = *(const u32x2*)(Z + (size_t)row * 1536 + 512 + h4 * 128 + dcol);
                                u32x2 o; o.x = pk2((v.x + bias) * __uint_as_float(ug.x << 16), (v.y + bias) * __uint_as_float(ug.x & 0xffff0000u));
                                o.y = pk2((v.z + bias) * __uint_as_float(ug.y << 16), (v.w + bias) * __uint_as_float(ug.y & 0xffff0000u));
                                *(u32x2*)(MIXIN + (size_t)row * 1024 + 512 + h4 * 128 + dcol) = o;
                            }
                        });
                }
            }
        }

    }
}
template <int PH> struct PhaseSeq {
    static __device__ __forceinline__ void run(const XcdBarrier& bar) { PhaseSeq<PH - 1>::run(bar); phase_body<PH>(); if (PH + 1 < NPHASE) xcd_barrier(bar); }
};
template <> struct PhaseSeq<-1> { static __device__ __forceinline__ void run(const XcdBarrier&) {} };

template <int PHSEL> __global__ void __launch_bounds__(NTHR, 2) hybrid_fwd(Params p) {
    extern __shared__ __attribute__((aligned(16))) unsigned char lds[];
    const int tid0 = threadIdx.x;
    for (int u = tid0; u < (LDS_BYTES - LDS_MISC) / 4; u += NTHR) ((unsigned*)(lds + LDS_MISC))[u] = 0u;
    __syncthreads();
    if constexpr (PHSEL >= 0) { phase_body<PHSEL>(); }
    else {
        volatile LAS unsigned* MISC = (volatile LAS unsigned*)((LAS unsigned char*)lds + LDS_MISC);
        unsigned* ctl0 = (unsigned*)(p.ws + WS_CTL);
        XcdBarrier bar = xcd_barrier_post(ctl0 + CW_BAR, MISC + 8);
        PhaseSeq<NPHASE - 1>::run(bar);
    }
}

typedef void (*kfn_t)(Params);
template <int PH> struct Tab { static void fill(kfn_t* t) { t[PH] = hybrid_fwd<PH>; Tab<PH - 1>::fill(t); } };
template <> struct Tab<-1> { static void fill(kfn_t*) {} };
static kfn_t g_tab[NPHASE];
static void set_attrs() {
#if MK_ONE_LAUNCH
    (void)hipFuncSetAttribute((const void*)hybrid_fwd<-1>, hipFuncAttributeMaxDynamicSharedMemorySize, LDS_BYTES);
#else
    Tab<NPHASE - 1>::fill(g_tab);
    for (int i = 0; i < NPHASE; ++i) (void)hipFuncSetAttribute((const void*)g_tab[i], hipFuncAttributeMaxDynamicSharedMemorySize, LDS_BYTES);
#endif
}
#if !MK_ONE_LAUNCH
static void launch_all(const Params& p, int grid, hipStream_t stream) {
    for (int ph = 0; ph < NPHASE; ++ph) hipLaunchKernelGGL(g_tab[ph], dim3(grid), dim3(NTHR), LDS_BYTES, stream, p);
}
#endif
extern "C" void kernel_launch(void* const* d_in, const int* in_sizes, int n_in, void* d_out, int out_size, void* d_ws, size_t ws_size, hipStream_t stream) {
    static int ready = 0;
    if (ready == 0) {
        if (n_in != 38 || ws_size < WS_END) { fprintf(stderr, "kernel_launch: unexpected n_in %d / ws %zu\n", n_in, ws_size); ready = -1; return; }
        set_attrs();
        ready = 1;
    }
    if (ready < 0) return;
    (void)hipMemsetAsync((char*)d_ws + WS_CTL, 0, CTL_ZERO_BYTES, stream);
    Params p{};
    const float** fp = (const float**)&p.x;
    (void)fp;
    p.x = (const float*)d_in[0]; p.c = (const float*)d_in[1]; p.pos = (const int*)d_in[2];
    p.ada_w = (const float*)d_in[3]; p.ada_b = (const float*)d_in[4]; p.norm_mix_g = (const float*)d_in[5]; p.norm_ffn_g = (const float*)d_in[6];
    p.router_w = (const float*)d_in[7]; p.router_b = (const float*)d_in[8]; p.moe_w_gu = (const float*)d_in[9]; p.moe_b_gu = (const float*)d_in[10];
    p.moe_w_dn = (const float*)d_in[11]; p.moe_b_dn = (const float*)d_in[12];
    p.even_w_in = (const float*)d_in[13]; p.q_norm_g = (const float*)d_in[14]; p.w_uq = (const float*)d_in[15]; p.kv_norm_g = (const float*)d_in[16];
    p.w_ukv = (const float*)d_in[17]; p.q_head_g = (const float*)d_in[18]; p.k_head_g = (const float*)d_in[19];
    p.s5_a_re = (const float*)d_in[20]; p.s5_a_im = (const float*)d_in[21]; p.s5_log_dt = (const float*)d_in[22]; p.s5_b_re = (const float*)d_in[23];
    p.s5_b_im = (const float*)d_in[24]; p.s5_c_re = (const float*)d_in[25]; p.s5_c_im = (const float*)d_in[26]; p.s5_d = (const float*)d_in[27];
    p.s5_glu_w = (const float*)d_in[28]; p.s5_glu_b = (const float*)d_in[29]; p.even_w_out = (const float*)d_in[30];
    p.odd_w_in = (const float*)d_in[31]; p.pool_w = (const float*)d_in[32]; p.pool_scale = (const float*)d_in[33]; p.sgu_norm_g = (const float*)d_in[34];
    p.sgu_w = (const float*)d_in[35]; p.sgu_b = (const float*)d_in[36]; p.odd_w_out = (const float*)d_in[37];
    p.out = (float*)d_out; p.ws = (unsigned char*)d_ws;
    const int grid = 256;
#if MK_ONE_LAUNCH
    p.ph_lo = 0; p.ph_hi = NPHASE;
    hipLaunchKernelGGL(hybrid_fwd<-1>, dim3(grid), dim3(NTHR), LDS_BYTES, stream, p);
#else
    p.ph_lo = 0; p.ph_hi = 1;
    launch_all(p, grid, stream);
#endif
}
```

```cpp
#include <hip/hip_runtime.h>
#include <cstdio>
#include <cstdint>

#ifndef PROBE_DUP_MASK
#define PROBE_DUP_MASK 0x0ull
#endif
#ifndef MK_ONE_LAUNCH
#define MK_ONE_LAUNCH 1
#endif

typedef unsigned short bf16_t;
typedef short bf16x8 __attribute__((ext_vector_type(8)));
typedef short s16x4 __attribute__((ext_vector_type(4)));
typedef float f32x4 __attribute__((ext_vector_type(4)));
typedef float f32x16 __attribute__((ext_vector_type(16)));
typedef unsigned u32x4 __attribute__((ext_vector_type(4)));
typedef unsigned u32x2 __attribute__((ext_vector_type(2)));

constexpr int D = 1024, NB = 8, S = 4096, T = NB * S;
constexpr int NTHR = 512, NWAVE = 8;
constexpr int MOE_ROWS = 139264;
constexpr int NPHASE = 27;

constexpr size_t MiB = 1u << 20;
constexpr size_t WS_CTL = 0, CTL_ZERO_BYTES = 1 * MiB;
constexpr size_t WS_MOD = 1 * MiB;
constexpr size_t WS_S5AB = 2 * MiB;
constexpr size_t WS_PW = 3 * MiB;
constexpr size_t WS_KTAB = 5 * MiB;
constexpr size_t WS_TOK = 7 * MiB;
constexpr size_t WS_ROW = 9 * MiB;
constexpr size_t WS_LOGIT = 11 * MiB;
constexpr size_t WS_W_IN_E = 16 * MiB, WS_W_UP = 18 * MiB  , WS_W_GLU = 20 * MiB, WS_W_OUT_E = 21 * MiB, WS_W_IN_O = 23 * MiB,
                 WS_W_OUT_O = 26 * MiB, WS_W_POOL = 28 * MiB, WS_W_SGU = 29 * MiB, WS_W_RT = 30 * MiB;
constexpr size_t WS_BT_END = 32 * MiB;
constexpr size_t WS_BT_MAIN = 40 * MiB;
constexpr size_t WS_W_GU = 112 * MiB;
constexpr size_t WS_W_DN = 240 * MiB;
constexpr size_t WS_HB8 = 304 * MiB;
constexpr size_t WS_HB = 496 * MiB;
constexpr size_t WS_MIXIN = 560 * MiB;
constexpr size_t WS_Y = 624 * MiB;
constexpr size_t WS_XB = 880 * MiB;
constexpr size_t WS_ACT = 1152 * MiB;
constexpr size_t WS_END = 1424 * MiB;
constexpr size_t WS_Z = 880 * MiB;
constexpr size_t WS_QKN = 976 * MiB  , WS_QKVRAW = 1000 * MiB  , WS_Q = 1112 * MiB, WS_K = 1160 * MiB, WS_VT = 1208 * MiB,
                 WS_AS5 = 1240 * MiB, WS_LEND = 1276 * MiB, WS_GACT = 1284 * MiB;
constexpr size_t WS_POOLED = 976 * MiB, WS_VTS = 1008 * MiB;
constexpr int CW_BAR = 4096, CW_CNT = 16384;

constexpr int LDS_BYTES = 147456;
constexpr int LDS_MISC = 140 * 1024;

struct Params {
    const float *x, *c; const int* pos;
    const float *ada_w, *ada_b, *norm_mix_g, *norm_ffn_g, *router_w, *router_b, *moe_w_gu, *moe_b_gu, *moe_w_dn, *moe_b_dn;
    const float *even_w_in, *q_norm_g, *w_uq, *kv_norm_g, *w_ukv, *q_head_g, *k_head_g;
    const float *s5_a_re, *s5_a_im, *s5_log_dt, *s5_b_re, *s5_b_im, *s5_c_re, *s5_c_im, *s5_d, *s5_glu_w, *s5_glu_b, *even_w_out;
    const float *odd_w_in, *pool_w, *pool_scale, *sgu_norm_g, *sgu_w, *sgu_b, *odd_w_out;
    float* out; unsigned char* ws; int ph_lo, ph_hi;
};

__device__ __forceinline__ float bf2f(unsigned short b) { return __uint_as_float(((unsigned)b) << 16); }
__device__ __forceinline__ unsigned pk2(float lo, float hi) {
    typedef float f2 __attribute__((ext_vector_type(2))); typedef __bf16 b2 __attribute__((ext_vector_type(2)));
    f2 v = {lo, hi}; b2 b = __builtin_convertvector(v, b2); return __builtin_bit_cast(unsigned, b);
}
__device__ __forceinline__ unsigned short f2bf(float f) { return (unsigned short)(pk2(f, 0.f) & 0xffffu); }
__device__ __forceinline__ float wave_sum(float v) {
#pragma unroll
    for (int o = 1; o < 64; o <<= 1) v += __shfl_xor(v, o);
    return v;
}
__device__ __forceinline__ float sigmoidf_(float x) { return 1.0f / (1.0f + __expf(-x)); }
__device__ __forceinline__ float gelu_tanh(float x) {
    const float u = 0.7978845608028654f * (x + 0.044715f * x * x * x);
    return x * sigmoidf_(2.0f * u);
}
__device__ __forceinline__ unsigned pk4_fp8(float a, float b, float c, float d) {
    int w = 0; w = __builtin_amdgcn_cvt_pk_fp8_f32(a, b, w, false); w = __builtin_amdgcn_cvt_pk_fp8_f32(c, d, w, true); return (unsigned)w;
}
__device__ __forceinline__ int crow(int r, int hi) { return (r & 3) + 8 * (r >> 2) + 4 * hi; }

#define LAS __attribute__((address_space(3)))
#define XB_TMO      128
#define XB_XCNT(j)  (256  + 64 * (j))
#define XB_XSUB(j)  (1280 + 64 * (j))
#define XB_XGEN(j)  (2304 + 64 * (j))
#define XB_TOP      3328
#define XB_TOPGEN   3392
#define XCD_BAR_WORDS 3456
#define XB_SPIN_CAP (1u << 20)
__device__ __forceinline__ unsigned xb_ld(unsigned* p)              { return __hip_atomic_load(p, __ATOMIC_RELAXED, __HIP_MEMORY_SCOPE_AGENT); }
__device__ __forceinline__ unsigned xb_add(unsigned* p, unsigned v) { return __hip_atomic_fetch_add(p, v, __ATOMIC_RELAXED, __HIP_MEMORY_SCOPE_AGENT); }
__device__ __forceinline__ unsigned xb_xcc_id() { return (unsigned)__builtin_amdgcn_s_getreg((3 << 11) | 20) & 0xFu; }
#define XB_SPIN(cond, bar) do { unsigned _sp = 0; while (cond) { __builtin_amdgcn_s_sleep(1); \
    if ((++_sp & 255u) == 0u) { if (xb_ld(&(bar)[XB_TMO])) break; if (_sp > XB_SPIN_CAP) { atomicAdd(&(bar)[XB_TMO], 1u); break; } } } } while (0)
struct XcdBarrier { unsigned* bar; unsigned x; volatile LAS unsigned* st; };
__device__ __forceinline__ XcdBarrier xcd_barrier_post(unsigned* bar, volatile LAS unsigned* st) {
    XcdBarrier b; b.bar = bar; b.x = xb_xcc_id(); b.st = st;
    if (threadIdx.x == 0) (void)xb_add(&bar[XB_XCNT(b.x)], 1u);
    return b;
}
__device__ __forceinline__ void xcd_barrier_complete(unsigned* bar, unsigned x, unsigned& nloc, unsigned& nx) {
    const unsigned G = gridDim.x * gridDim.y * gridDim.z;
    unsigned sum, cnt, mine, sp = 0u;
    for (;;) {
        sum = 0u; cnt = 0u; mine = 0u;
#pragma unroll
        for (unsigned j = 0; j < 16; ++j) { const unsigned c = xb_ld(&bar[XB_XCNT(j)]); sum += c; cnt += (c > 0u) ? 1u : 0u; mine = (j == x) ? c : mine; }
        if (sum == G) break;
        __builtin_amdgcn_s_sleep(1);
        if ((++sp & 255u) == 0u) { if (xb_ld(&bar[XB_TMO])) break; if (sp > XB_SPIN_CAP) { atomicAdd(&bar[XB_TMO], 1u); break; } }
    }
    nloc = mine > 0u ? mine : 1u; nx = cnt > 0u ? cnt : 1u;
}
__device__ __forceinline__ void xcd_barrier(const XcdBarrier& b) {
    asm volatile("s_waitcnt vmcnt(0)" ::: "memory");
    __syncthreads();
    if (threadIdx.x == 0) {
        unsigned* bar = b.bar;
        __builtin_amdgcn_s_waitcnt(0);
        unsigned nloc = b.st[0], nx = b.st[1];
        if (nloc == 0u) { xcd_barrier_complete(bar, b.x, nloc, nx); b.st[0] = nloc; b.st[1] = nx; }
        const unsigned old = xb_add(&bar[XB_XSUB(b.x)], 1u);
        const unsigned gen = old / nloc;
        if (old + 1u == (gen + 1u) * nloc) {
            __builtin_amdgcn_fence(__ATOMIC_RELEASE, "agent");
            asm volatile("s_waitcnt vmcnt(0)" ::: "memory");
            const unsigned og = xb_add(&bar[XB_TOP], 1u);
            const unsigned tg = og / nx;
            if (og + 1u == (tg + 1u) * nx) xb_add(&bar[XB_TOPGEN], 1u);
            else XB_SPIN(xb_ld(&bar[XB_TOPGEN]) == tg, bar);
            __builtin_amdgcn_fence(__ATOMIC_ACQUIRE, "agent");
            xb_add(&bar[XB_XGEN(b.x)], 1u);
            asm volatile("s_waitcnt vmcnt(0)" ::: "memory");
        } else {
            XB_SPIN(xb_ld(&bar[XB_XGEN(b.x)]) == gen, bar);
            __builtin_amdgcn_fence(__ATOMIC_ACQUIRE, "agent");
            asm volatile("s_waitcnt vmcnt(0)" ::: "memory");
        }
    }
    __syncthreads();
}

constexpr int SG_LDS = 2 * 128 * 144;
template <class Epi>
__device__ __forceinline__ void sg_tile(int tid, unsigned char* lds, const bf16_t* A, int lda, const bf16_t* Bt, int ldb, int K, Epi epi) {
    const int lane = tid & 63, wid = tid >> 6, wr = wid >> 2, wc = wid & 3, fr = lane & 15, fq = lane >> 4;
    unsigned char* As = lds; unsigned char* Bs = lds + 128 * 144;
    f32x4 acc[4][2];
#pragma unroll
    for (int m = 0; m < 4; ++m)
#pragma unroll
        for (int n = 0; n < 2; ++n) acc[m][n] = (f32x4){0.f, 0.f, 0.f, 0.f};
    const int nt = K / 64;
    u32x4 ra[2], rb[2];
    const int r0 = tid >> 3, cc = tid & 7;
#pragma unroll
    for (int i = 0; i < 2; ++i) {
        ra[i] = *(const u32x4*)(A + (size_t)(r0 + 64 * i) * lda + cc * 8);
        rb[i] = *(const u32x4*)(Bt + (size_t)(r0 + 64 * i) * ldb + cc * 8);
    }
    for (int kt = 0; kt < nt; ++kt) {
        __syncthreads();
#pragma unroll
        for (int i = 0; i < 2; ++i) {
            *(u32x4*)(As + (r0 + 64 * i) * 144 + cc * 16) = ra[i];
            *(u32x4*)(Bs + (r0 + 64 * i) * 144 + cc * 16) = rb[i];
        }
        __syncthreads();
        if (kt + 1 < nt) {
#pragma unroll
            for (int i = 0; i < 2; ++i) {
                ra[i] = *(const u32x4*)(A + (size_t)(r0 + 64 * i) * lda + (kt + 1) * 64 + cc * 8);
                rb[i] = *(const u32x4*)(Bt + (size_t)(r0 + 64 * i) * ldb + (kt + 1) * 64 + cc * 8);
            }
        }
#pragma unroll
        for (int kk = 0; kk < 2; ++kk) {
            bf16x8 a[4], b[2];
#pragma unroll
            for (int m = 0; m < 4; ++m) a[m] = *(const bf16x8*)(As + (wr * 64 + m * 16 + fr) * 144 + kk * 64 + fq * 16);
#pragma unroll
            for (int n = 0; n < 2; ++n) b[n] = *(const bf16x8*)(Bs + (wc * 32 + n * 16 + fr) * 144 + kk * 64 + fq * 16);
#pragma unroll
            for (int m = 0; m < 4; ++m)
#pragma unroll
                for (int n = 0; n < 2; ++n) acc[m][n] = __builtin_amdgcn_mfma_f32_16x16x32_bf16(b[n], a[m], acc[m][n], 0, 0, 0);
        }
    }
#pragma unroll
    for (int m = 0; m < 4; ++m) epi(wr * 64 + m * 16 + fr, wc * 32 + fq * 4, acc[m][0], acc[m][1]);
}


namespace pg8 {
#define PG8_LAS __attribute__((address_space(3)))
constexpr int BM = 256, BK = 64, HALF = 128, HTB = HALF * BK * 2, STAGE_BYTES = 8 * HTB;
__device__ __forceinline__ int lds_byte(int r, int c) { const int st = (r >> 4) * 2 + (c >> 5), rr = r & 15, cc = c & 31, ob = rr * 64 + cc * 2; return st * 1024 + (ob ^ (((ob >> 9) & 1) << 5)); }
__device__ __forceinline__ void stage_rc(int b, int& R, int& C) { const int st = b / 1024, sb = b % 1024, swz = sb ^ (((sb >> 9) & 1) << 5); R = (st >> 1) * 16 + swz / 64; C = (st & 1) * 32 + (swz % 64) / 2; }
typedef int v8i_t __attribute__((ext_vector_type(8)));
typedef int v4i_t __attribute__((ext_vector_type(4)));
struct FragT { union { v8i_t v; struct { v4i_t lo, hi; }; }; };
struct Unit { int pm, pb, pn, aux; };
struct Gemm { const bf16_t* A; const bf16_t* Bt; int lda, ldb, K; };
template <class F> struct Epi {
    F f;
    __device__ __forceinline__ void operator()(const f32x4 (&acc)[2][2][4][2], const Unit& u, int wr, int wc, int fr, int fq) const {
#pragma unroll
        for (int ai = 0; ai < 2; ++ai)
#pragma unroll
            for (int m = 0; m < 4; ++m)
#pragma unroll
                for (int bj = 0; bj < 2; ++bj) {
                    f32x4 v0, v1;
                    asm volatile("v_accvgpr_read_b32 %0, %8\n\tv_accvgpr_read_b32 %1, %9\n\tv_accvgpr_read_b32 %2, %10\n\tv_accvgpr_read_b32 %3, %11\n\t"
                                 "v_accvgpr_read_b32 %4, %12\n\tv_accvgpr_read_b32 %5, %13\n\tv_accvgpr_read_b32 %6, %14\n\tv_accvgpr_read_b32 %7, %15"
                                 : "=v"(v0.x), "=v"(v0.y), "=v"(v0.z), "=v"(v0.w), "=v"(v1.x), "=v"(v1.y), "=v"(v1.z), "=v"(v1.w)
                                 : "a"(acc[ai][bj][m][0].x), "a"(acc[ai][bj][m][0].y), "a"(acc[ai][bj][m][0].z), "a"(acc[ai][bj][m][0].w),
                                   "a"(acc[ai][bj][m][1].x), "a"(acc[ai][bj][m][1].y), "a"(acc[ai][bj][m][1].z), "a"(acc[ai][bj][m][1].w));
                    f(u, ai * HALF + wr * 64 + m * 16 + fr, bj * HALF + wc * 32 + 4 * fq, v0, v1);
                    asm volatile("" ::: "memory");
                }
    }
};
template <bool FP8 = false, class F, class Sched>
__device__ __forceinline__ void gemm_phase(int tid, PG8_LAS unsigned char* lds, const Gemm g, const Sched& S, const Epi<F>& E) {
    const int wid = __builtin_amdgcn_readfirstlane(tid >> 6), lane = tid & 63, wr = wid >> 2, wc = wid & 3, fr = lane & 15, fq = lane >> 4;
    int K = g.K; asm volatile("" : "+s"(K));
    const int nt = K / BK;
    unsigned voffA[2], voffB[2];
#pragma unroll
    for (int i = 0; i < 2; ++i) { int R, C; stage_rc(tid * 16 + i * 8192, R, C); voffA[i] = (unsigned)(R * g.lda + C) * 2u; voffB[i] = (unsigned)(R * g.ldb + C) * 2u; }
    const size_t kstep = (size_t)(BK * 2);
    const size_t hstepA = (size_t)HALF * g.lda * 2, hstepB = (size_t)HALF * g.ldb * 2;
    const size_t tstepA = 2 * hstepA, tstepB = 2 * hstepB;
    const unsigned ldsw = (unsigned)wid * 1024u;
    const int aoff = lds_byte(wr * 64 + fr, fq * 8), boff = lds_byte(wc * 32 + fr, fq * 8);
#define PG8_SA(b, h) (((b) * 2 + (h)) * HTB)
#define PG8_SB(b, h) ((4 + (b) * 2 + (h)) * HTB)
#define PG8_STAGE(bufoff, gbase, voff) do { _Pragma("unroll") for (int _i = 0; _i < 2; ++_i) \
        __builtin_amdgcn_global_load_lds((const unsigned*)((const char*)(gbase) + (voff)[_i]), (PG8_LAS unsigned*)(lds + (bufoff) + ldsw + _i * 8192), 16, 0, 0); } while (0)
#define PG8_LDA(dst, b, h) do { _Pragma("unroll") for (int m = 0; m < 4; ++m) { dst[m].lo = *(const PG8_LAS v4i_t*)(lds + PG8_SA(b, h) + aoff + m * 2048); dst[m].hi = *(const PG8_LAS v4i_t*)(lds + PG8_SA(b, h) + aoff + m * 2048 + 1024); } } while (0)
#define PG8_LDB(dst, b, h) do { _Pragma("unroll") for (int n = 0; n < 2; ++n) { dst[n].lo = *(const PG8_LAS v4i_t*)(lds + PG8_SB(b, h) + boff + n * 2048); dst[n].hi = *(const PG8_LAS v4i_t*)(lds + PG8_SB(b, h) + boff + n * 2048 + 1024); } } while (0)
#define PG8_MMA(ai, bj, At, Bt) do { __builtin_amdgcn_s_setprio(1); _Pragma("unroll") for (int m = 0; m < 4; ++m) _Pragma("unroll") for (int n = 0; n < 2; ++n) { \
        if constexpr (FP8) { asm volatile("s_nop 1\n\tv_mfma_scale_f32_16x16x128_f8f6f4 %0, %1, %2, %0, %3, %4 op_sel_hi:[0,0,0]" : "+a"(acc[ai][bj][m][n]) : "v"(Bt[n].v), "v"(At[m].v), "v"(scw), "v"(scx)); } \
        else { asm volatile("s_nop 1\n\tv_mfma_f32_16x16x32_bf16 %0, %1, %2, %0\n\tv_mfma_f32_16x16x32_bf16 %0, %3, %4, %0" : "+a"(acc[ai][bj][m][n]) : "v"(Bt[n].lo), "v"(At[m].lo), "v"(Bt[n].hi), "v"(At[m].hi)); } } \
        __builtin_amdgcn_s_setprio(0); } while (0)
#define PG8_WAIT_V(n) asm volatile("s_waitcnt vmcnt(" #n ")" ::: "memory")
#define PG8_WAIT_L(n) asm volatile("s_waitcnt lgkmcnt(" #n ")" ::: "memory")
#define PG8_BAR __builtin_amdgcn_s_barrier()
#define PG8_SCHED __builtin_amdgcn_sched_barrier(0)
    Unit cur, nxt; int ui = 0;
    if (!S.next(0, cur)) return;
    f32x4 acc[2][2][4][2];
#pragma unroll
    for (int a = 0; a < 2; ++a)
#pragma unroll
        for (int b = 0; b < 2; ++b)
#pragma unroll
            for (int m = 0; m < 4; ++m)
#pragma unroll
                for (int n = 0; n < 2; ++n) acc[a][b][m][n] = (f32x4){0.f, 0.f, 0.f, 0.f};
    FragT At[4], B0[2], B1[2];
    int scw = 0x7a7a7a7a, scx = 0x7f7f7f7f; asm volatile("" : "+v"(scw), "+v"(scx));
    const char* cA = (const char*)g.A + (size_t)cur.pm * tstepA; const char* cB = (const char*)g.Bt + (size_t)cur.pb * tstepB;
    PG8_STAGE(PG8_SB(0, 0), cB, voffB); PG8_STAGE(PG8_SB(0, 1), cB + hstepB, voffB); PG8_STAGE(PG8_SA(0, 0), cA, voffA); PG8_STAGE(PG8_SA(0, 1), cA + hstepA, voffA);
    if (wr == 1) PG8_BAR;
    PG8_WAIT_V(2); PG8_BAR;
    PG8_STAGE(PG8_SB(1, 0), cB + kstep, voffB); PG8_STAGE(PG8_SA(1, 0), cA + kstep, voffA); PG8_STAGE(PG8_SB(1, 1), cB + hstepB + kstep, voffB);
    PG8_WAIT_V(6); PG8_BAR;
    for (;;) {
        const bool has_next = S.next(ui + 1, nxt);
        const char* nA = has_next ? (const char*)g.A + (size_t)nxt.pm * tstepA : cA; const char* nB = has_next ? (const char*)g.Bt + (size_t)nxt.pb * tstepB : cB;
        for (int t = 0; t < nt; t += 2) {
            const bool last = (t == nt - 2);
            const char* a1 = cA + (size_t)(t + 1) * kstep;
            const char* a2 = last ? nA : cA + (size_t)(t + 2) * kstep; const char* b2 = last ? nB : cB + (size_t)(t + 2) * kstep;
            const char* a3 = a2 + kstep; const char* b3 = b2 + kstep;
            PG8_LDB(B0, 0, 0); PG8_LDB(B1, 0, 1); PG8_SCHED; PG8_LDA(At, 0, 0); PG8_STAGE(PG8_SA(1, 1), a1 + hstepA, voffA);
            PG8_WAIT_V(8); PG8_WAIT_L(0); PG8_BAR; PG8_MMA(0, 0, At, B0); PG8_MMA(0, 1, At, B1); PG8_BAR; PG8_SCHED;
            PG8_LDA(At, 0, 1); PG8_STAGE(PG8_SB(0, 0), b2, voffB); PG8_STAGE(PG8_SB(0, 1), b2 + hstepB, voffB); PG8_STAGE(PG8_SA(0, 0), a2, voffA);
            PG8_WAIT_V(8); PG8_WAIT_L(0); PG8_BAR; PG8_MMA(1, 0, At, B0); PG8_MMA(1, 1, At, B1); PG8_BAR; PG8_SCHED;
            PG8_LDB(B0, 1, 0); PG8_LDB(B1, 1, 1); PG8_SCHED; PG8_LDA(At, 1, 0); PG8_STAGE(PG8_SA(0, 1), a2 + hstepA, voffA);
            PG8_WAIT_V(8); PG8_WAIT_L(0); PG8_BAR; PG8_MMA(0, 0, At, B0); PG8_MMA(0, 1, At, B1); PG8_BAR; PG8_SCHED;
            PG8_LDA(At, 1, 1); PG8_STAGE(PG8_SB(1, 0), b3, voffB); PG8_STAGE(PG8_SB(1, 1), b3 + hstepB, voffB); PG8_STAGE(PG8_SA(1, 0), a3, voffA);
            PG8_WAIT_V(8); PG8_WAIT_L(0); PG8_BAR; PG8_MMA(1, 0, At, B0); PG8_MMA(1, 1, At, B1); PG8_BAR; PG8_SCHED;
        }
        if (wr == 0) PG8_BAR;
        asm volatile("s_nop 15\n\ts_nop 15" ::: "memory");
        E(acc, cur, wr, wc, fr, fq);
        if (!has_next) break;
#pragma unroll
        for (int a = 0; a < 2; ++a)
#pragma unroll
            for (int b = 0; b < 2; ++b)
#pragma unroll
                for (int m = 0; m < 4; ++m)
#pragma unroll
                    for (int n = 0; n < 2; ++n) acc[a][b][m][n] = (f32x4){0.f, 0.f, 0.f, 0.f};
        cur = nxt; cA = nA; cB = nB; ++ui;
        if (wr == 1) PG8_BAR;
    }
    PG8_WAIT_V(0);
    PG8_BAR;
#undef PG8_SA
#undef PG8_SB
#undef PG8_STAGE
#undef PG8_LDA
#undef PG8_LDB
#undef PG8_MMA
#undef PG8_WAIT_V
#undef PG8_WAIT_L
#undef PG8_BAR
#undef PG8_SCHED
}
struct GridOrder {
    int nM, nN, nwg, G, c;
    __device__ __forceinline__ void init(int nM_, int nN_, int G_, int c_) { nM = nM_; nN = nN_; nwg = nM * nN; G = G_; c = c_; }
    __device__ __forceinline__ bool tile(int i, int& pm, int& pn) const {
        const long L = (long)i * G + c; if (L >= nwg) return false;
        int wgid = (int)L; { const int q = nwg / 8, r = nwg % 8, xcd = wgid % 8, off = wgid / 8; wgid = (xcd < r ? xcd * (q + 1) : r * (q + 1) + (xcd - r) * q) + off; }
        const int nig = 8 * nN, gid = wgid / nig, fm = gid * 8, gsz = (nM - fm) < 8 ? (nM - fm) : 8;
        pm = fm + ((wgid % nig) % gsz); pn = (wgid % nig) / gsz; return true;
    }
};
}


struct DenseOrder { pg8::GridOrder go;
    __device__ __forceinline__ bool next(int i, pg8::Unit& u) const { int pm, pn; if (!go.tile(i, pm, pn)) return false; u.pm = pm; u.pb = pn; u.pn = pn; u.aux = 0; return true; } };
struct MoeOrder { pg8::GridOrder go; const int* pst; int NT, ebase;
    __device__ __forceinline__ bool next(int i, pg8::Unit& u) const { int pm, pn; if (!go.tile(i, pm, pn)) return false; int e = 0;
#pragma unroll
        for (int q = 1; q < 32; ++q) e = (pm * 256 >= pst[q]) ? q : e;
        e = __builtin_amdgcn_readfirstlane(e);
        u.pm = pm; u.pn = pn; u.pb = (ebase + e) * NT + pn; u.aux = e; return true; } };
struct S5Order { int G, c;
    __device__ __forceinline__ bool next(int i, pg8::Unit& u) const { const int L = i * G + c; if (L >= 256) return false; const int g = L >> 3, pmL = (L >> 2) & 1, pnL = L & 3;
        u.pm = g * 2 + pmL; u.pb = g * 4 + pnL; u.pn = pnL; u.aux = g; return true; } };

__device__ __forceinline__ void transpose_item(const float* W, int K, int N, bf16_t* WT, int ldt, float* scr, int item, int lane, int mode) {
    const int nblk = N / 32, kb = item / nblk, nb = item % nblk, k0 = 64 * kb, n0 = 32 * nb;
#pragma unroll 8
    for (int i = 0; i < 32; ++i) { const int kk = 2 * i + (lane >> 5); scr[kk * 33 + (lane & 31)] = W[(size_t)(k0 + kk) * N + n0 + (lane & 31)]; }
    __builtin_amdgcn_s_waitcnt(0xC07F); asm volatile("" ::: "memory");
    const int c = lane & 7;
#pragma unroll
    for (int j = 0; j < 4; ++j) {
        const int n = (lane >> 3) + 8 * j; const float* s = scr + (8 * c) * 33 + n;
        u32x4 o; o.x = pk2(s[0 * 33], s[1 * 33]); o.y = pk2(s[2 * 33], s[3 * 33]); o.z = pk2(s[4 * 33], s[5 * 33]); o.w = pk2(s[6 * 33], s[7 * 33]);
        int nn = n0 + n;
        if (mode == 1) { const int half = nn >= 1024; const int jj = nn - half * 1024; nn = 32 * (jj >> 4) + 16 * half + (jj & 15); }
        *(u32x4*)(WT + (size_t)nn * ldt + k0 + 8 * c) = o;
    }
    __builtin_amdgcn_s_waitcnt(0xC07F); asm volatile("" ::: "memory");
}
__device__ __forceinline__ void transpose_item_fp8(const float* W, int K, int N, unsigned char* WT, float* scr, int item, int lane, int mode, float scale) {
    const int nblk = N / 32, kb = item / nblk, nb = item % nblk, k0 = 128 * kb, n0 = 32 * nb;
#pragma unroll 8
    for (int i = 0; i < 64; ++i) { const int kk = 2 * i + (lane >> 5); scr[kk * 33 + (lane & 31)] = W[(size_t)(k0 + kk) * N + n0 + (lane & 31)] * scale; }
    __builtin_amdgcn_s_waitcnt(0xC07F); asm volatile("" ::: "memory");
    const int c = lane & 7;
#pragma unroll
    for (int j = 0; j < 4; ++j) {
        const int n = (lane >> 3) + 8 * j; const float* s = scr + (16 * c) * 33 + n;
        u32x4 o; o.x = pk4_fp8(s[0 * 33], s[1 * 33], s[2 * 33], s[3 * 33]); o.y = pk4_fp8(s[4 * 33], s[5 * 33], s[6 * 33], s[7 * 33]);
        o.z = pk4_fp8(s[8 * 33], s[9 * 33], s[10 * 33], s[11 * 33]); o.w = pk4_fp8(s[12 * 33], s[13 * 33], s[14 * 33], s[15 * 33]);
        int nn = n0 + n;
        if (mode == 1) { const int half = nn >= 1024; const int jj = nn - half * 1024; nn = 32 * (jj >> 4) + 16 * half + (jj & 15); }
        *(u32x4*)(WT + (size_t)nn * K + k0 + 16 * c) = o;
    }
    __builtin_amdgcn_s_waitcnt(0xC07F); asm volatile("" ::: "memory");
}
__device__ __forceinline__ void transpose_many_fp8(const float* W, int nmat, int K, int N, unsigned char* WT, size_t dst_stride, float* scr, int gw, int NGW, int lane, int mode, float scale) {
    const int per = (K / 128) * (N / 32); const long tot = (long)nmat * per;
    for (long it = gw; it < tot; it += NGW) {
        const int mt = (int)(it / per), r = (int)(it % per);
        transpose_item_fp8(W + (size_t)mt * K * N, K, N, WT + (size_t)mt * dst_stride, scr, r, lane, mode, scale);
    }
}
__device__ __forceinline__ void transpose_many(const float* W, int nmat, int K, int N, bf16_t* WT, size_t dst_stride, float* scr, int gw, int NGW, int lane, int mode, int ldt = 0) {
    if (ldt == 0) ldt = K;
    const int per = (K / 64) * (N / 32); const long tot = (long)nmat * per;
    for (long it = gw; it < tot; it += NGW) {
        const int mt = (int)(it / per), r = (int)(it % per);
        transpose_item(W + (size_t)mt * K * N, K, N, WT + (size_t)mt * dst_stride, ldt, scr, r, lane, mode);
    }
}

__device__ __forceinline__ void norm_mod_store(f32x4 (&v)[4], const float* g, const float* sc, const float* sh, bf16_t* orow, unsigned char* orow8, int lane) {
    float s = 0.f;
#pragma unroll
    for (int j = 0; j < 4; ++j) s += (v[j].x * v[j].x + v[j].y * v[j].y) + (v[j].z * v[j].z + v[j].w * v[j].w);
    const float r = rsqrtf(wave_sum(s) * (1.0f / D) + 1e-6f);
#pragma unroll
    for (int j = 0; j < 4; ++j) {
        const int c = 4 * lane + 256 * j;
        const f32x4 gg = *(const f32x4*)(g + c), s1 = *(const f32x4*)(sc + c), s0 = *(const f32x4*)(sh + c);
        const float a = v[j].x * r * gg.x * (1.f + s1.x) + s0.x, b = v[j].y * r * gg.y * (1.f + s1.y) + s0.y,
                    cc = v[j].z * r * gg.z * (1.f + s1.z) + s0.z, d = v[j].w * r * gg.w * (1.f + s1.w) + s0.w;
        u32x2 o; o.x = pk2(a, b); o.y = pk2(cc, d);
        *(u32x2*)(orow + c) = o;
        if (orow8) *(unsigned*)(orow8 + c) = pk4_fp8(a, b, cc, d);
    }
}

template <int ph> __device__ __forceinline__ void phase_body() {
    extern __shared__ __attribute__((aligned(16))) unsigned char lds[];
    {
        int tid = threadIdx.x; asm volatile("" : "+v"(tid));
        int vb = blockIdx.x, G = gridDim.x; asm volatile("" : "+s"(vb), "+s"(G));
        const int lane = tid & 63, wave = tid >> 6;
        const int gw = vb * NWAVE + wave, NGW = G * NWAVE;
        const __attribute__((address_space(4))) Params* kp = (const __attribute__((address_space(4))) Params*)__builtin_amdgcn_kernarg_segment_ptr();
        asm volatile("" : "+s"(kp));
        unsigned char* ws = kp->ws;
        unsigned* ctl = (unsigned*)(ws + WS_CTL);
        float* MOD = (float*)(ws + WS_MOD);
        float* S5AB = (float*)(ws + WS_S5AB); float* S5BB = (float*)(ws + WS_S5AB + 65536);
        float* PW = (float*)(ws + WS_PW); float* KTAB = (float*)(ws + WS_KTAB);
        int* tok_e = (int*)(ws + WS_TOK); int* tok_pos = (int*)(ws + WS_TOK + 512 * 1024); float* tok_gate = (float*)(ws + WS_TOK + 1024 * 1024);
        int* row_slot = (int*)(ws + WS_ROW); float* row_gate = (float*)(ws + WS_ROW + MiB);
        float* LOGIT = (float*)(ws + WS_LOGIT);
        bf16_t* W_IN_E = (bf16_t*)(ws + WS_W_IN_E); bf16_t* W_UP = (bf16_t*)(ws + WS_W_UP); bf16_t* W_GLU = (bf16_t*)(ws + WS_W_GLU);
        bf16_t* W_OUT_E = (bf16_t*)(ws + WS_W_OUT_E); bf16_t* W_IN_O = (bf16_t*)(ws + WS_W_IN_O); bf16_t* W_OUT_O = (bf16_t*)(ws + WS_W_OUT_O);
        bf16_t* W_POOL = (bf16_t*)(ws + WS_W_POOL); bf16_t* W_SGU = (bf16_t*)(ws + WS_W_SGU); bf16_t* W_RT = (bf16_t*)(ws + WS_W_RT);
        bf16_t* BT_END = (bf16_t*)(ws + WS_BT_END); bf16_t* BT_MAIN = (bf16_t*)(ws + WS_BT_MAIN);
        unsigned char* W_GU = ws + WS_W_GU; unsigned char* W_DN = ws + WS_W_DN; unsigned char* HB8 = ws + WS_HB8;
        bf16_t* HB = (bf16_t*)(ws + WS_HB); bf16_t* MIXIN = (bf16_t*)(ws + WS_MIXIN); bf16_t* Y = (bf16_t*)(ws + WS_Y);
        unsigned char* XB = ws + WS_XB; unsigned char* ACT = ws + WS_ACT;
        bf16_t* Z = (bf16_t*)(ws + WS_Z); bf16_t* QKN = (bf16_t*)(ws + WS_QKN); bf16_t* QKVRAW = (bf16_t*)(ws + WS_QKVRAW);
        bf16_t* Qb = (bf16_t*)(ws + WS_Q); bf16_t* Kb = (bf16_t*)(ws + WS_K); bf16_t* VT = (bf16_t*)(ws + WS_VT);
        bf16_t* AS5 = (bf16_t*)(ws + WS_AS5); float* LEND = (float*)(ws + WS_LEND); bf16_t* GACT = (bf16_t*)(ws + WS_GACT);
        bf16_t* POOLED = (bf16_t*)(ws + WS_POOLED); bf16_t* VTS = (bf16_t*)(ws + WS_VTS);
        float* OUT = kp->out; const float* XIN = kp->x;
        const float* s5d = kp->s5_d; const float* glub = kp->s5_glu_b; const float* poolsc = kp->pool_scale; const float* sgub = kp->sgu_b;
        const float* bgu_all = kp->moe_b_gu; const float* bdn_all = kp->moe_b_dn; const float* rtb_all = kp->router_b;

        int layer = 0, mph = ph;
        if (ph >= 20 && ph <= 25) { layer = 1; mph = ph - 11; }
        const float* mod_l = MOD + (size_t)layer * NB * 6144;

        if (ph == 0) {
            const int gt = vb * NTHR + tid;
            if (gt < 2048) {
                const int g = gt >> 6, pp = gt & 63;
                const float dt = expf(kp->s5_log_dt[g]);
                const float lre = fminf(kp->s5_a_re[g * 64 + pp], -1e-4f), lim = kp->s5_a_im[g * 64 + pp];
                const float mag = expf(lre * dt);
                const float abr = mag * cosf(lim * dt), abi = mag * sinf(lim * dt);
                const float den = lre * lre + lim * lim, nr = abr - 1.0f;
                const float fre = (nr * lre + abi * lim) / den, fim = (abi * lre - nr * lim) / den;
                S5AB[(g * 64 + pp) * 2 + 0] = abr; S5AB[(g * 64 + pp) * 2 + 1] = abi;
                for (int j = 0; j < 16; ++j) {
                    const float br = kp->s5_b_re[(g * 64 + pp) * 16 + j], bi = kp->s5_b_im[(g * 64 + pp) * 16 + j];
                    S5BB[((g * 64 + pp) * 16 + j) * 2 + 0] = fre * br - fim * bi;
                    S5BB[((g * 64 + pp) * 16 + j) * 2 + 1] = fre * bi + fim * br;
                }
                float pr = 1.f, pi = 0.f;
                for (int tau = 0; tau <= 64; ++tau) {
                    PW[((g * 64 + pp) * 65 + tau) * 2 + 0] = pr; PW[((g * 64 + pp) * 65 + tau) * 2 + 1] = pi;
                    const float nr2 = pr * abr - pi * abi, ni2 = pr * abi + pi * abr; pr = nr2; pi = ni2;
                }
            }
            {
                float* ca = (float*)lds;
                for (int i = tid; i < NB * D; i += NTHR) { const float cv = kp->c[i]; ca[i] = cv * sigmoidf_(cv); }
                __syncthreads();
                for (int task = gw; task < 2 * 96; task += NGW) {
                    const int l = task / 96, cb = task % 96, col = cb * 64 + lane;
                    const float* W = kp->ada_w + (size_t)l * D * 6144 + col;
                    float acc[8];
#pragma unroll
                    for (int b = 0; b < 8; ++b) acc[b] = 0.f;
                    for (int k = 0; k < D; k += 8) {
                        float w[8];
#pragma unroll
                        for (int u = 0; u < 8; ++u) w[u] = W[(size_t)(k + u) * 6144];
#pragma unroll
                        for (int u = 0; u < 8; ++u)
#pragma unroll
                            for (int b = 0; b < 8; ++b) acc[b] += ca[b * D + k + u] * w[u];
                    }
                    const float bias = kp->ada_b[l * 6144 + col];
#pragma unroll
                    for (int b = 0; b < 8; ++b) MOD[((size_t)l * NB + b) * 6144 + col] = acc[b] + bias;
                }
                __syncthreads();
            }
            {
                float* scr = (float*)(lds + wave * 16384);
                transpose_many(kp->even_w_in, 1, 1024, 928, W_IN_E, 0, scr, gw, NGW, lane, 0);
                transpose_many(kp->w_uq, 1, 256, 768, W_UP, 0, scr, gw, NGW, lane, 0, 384);
                transpose_many(kp->w_ukv, 1, 128, 1024, W_UP + (size_t)768 * 384 + 256, 0, scr, gw, NGW, lane, 0, 384);
                for (int i = vb * NTHR + tid; i < 768 * 16 + 1024 * 32; i += G * NTHR) {
                    const u32x4 z = {0u, 0u, 0u, 0u};
                    if (i < 768 * 16) *(u32x4*)(W_UP + (size_t)(i >> 4) * 384 + 256 + (i & 15) * 8) = z;
                    else { const int q = i - 768 * 16; *(u32x4*)(W_UP + (size_t)(768 + (q >> 5)) * 384 + (q & 31) * 8) = z; }
                }
                transpose_many(kp->s5_glu_w, 1, 512, 512, W_GLU, 0, scr, gw, NGW, lane, 0);
                transpose_many(kp->even_w_out, 1, 1024, 1024, W_OUT_E, 0, scr, gw, NGW, lane, 0);
                transpose_many(kp->odd_w_in, 1, 1024, 1536, W_IN_O, 0, scr, gw, NGW, lane, 0);
                transpose_many(kp->odd_w_out, 1, 1024, 1024, W_OUT_O, 0, scr, gw, NGW, lane, 0);
                transpose_many(kp->pool_w, 4, 128, 128, W_POOL, 128 * 128, scr, gw, NGW, lane, 0);
                transpose_many(kp->router_w, 2, 1024, 32, W_RT, 128 * 1024, scr, gw, NGW, lane, 0);
                {
                    float* scr8 = (float*)(lds + wave * 16896);
                    transpose_many_fp8(kp->moe_w_gu, 64, 1024, 2048, W_GU, (size_t)2048 * 1024, scr8, gw, NGW, lane, 1, 32.0f);
                    transpose_many_fp8(kp->moe_w_dn, 64, 1024, 1024, W_DN, (size_t)1024 * 1024, scr8, gw, NGW, lane, 0, 32.0f);
                }
                for (int i = vb * NTHR + tid; i < 4 * 128 * 128; i += G * NTHR) {
                    const int t = (i >> 7) & 127, s_ = i & 127;
                    W_SGU[i] = (s_ <= t) ? f2bf(kp->sgu_w[i]) : (bf16_t)0;
                }
            }
        }
        else if (ph == 1 || ph == 9 || ph == 15 || ph == 20 || ph == 26) {
            const int lyr = (ph == 1 || ph == 9) ? 0 : 1;
            const bool combine = (ph == 15 || ph == 26), donorm = (ph != 26);
            const int comb_layer = (ph == 15) ? 0 : 1;
            const bool ffn = (ph == 9 || ph == 20);
            const float* src = (ph == 1) ? kp->x : kp->out;
            const float* ng = (ffn ? kp->norm_ffn_g : kp->norm_mix_g) + lyr * D;
            for (int row = gw; row < T; row += NGW) {
                const int b = row / S;
                f32x4 v[4];
#pragma unroll
                for (int j = 0; j < 4; ++j) v[j] = *(const f32x4*)(src + (size_t)row * D + 4 * lane + 256 * j);
                if (combine) {
                    const float* gf = MOD + ((size_t)comb_layer * NB + b) * 6144 + 5 * D;
#pragma unroll
                    for (int j = 0; j < 4; ++j) {
                        const int c = 4 * lane + 256 * j;
                        float a0 = 0.f, a1 = 0.f, a2 = 0.f, a3 = 0.f;
#pragma unroll
                        for (int k = 0; k < 4; ++k) {
                            const u32x2 yy = *(const u32x2*)(Y + ((size_t)row * 4 + k) * D + c);
                            a0 += __uint_as_float(yy.x << 16); a1 += __uint_as_float(yy.x & 0xffff0000u);
                            a2 += __uint_as_float(yy.y << 16); a3 += __uint_as_float(yy.y & 0xffff0000u);
                        }
                        const f32x4 g4 = *(const f32x4*)(gf + c);
                        v[j].x += g4.x * a0; v[j].y += g4.y * a1; v[j].z += g4.z * a2; v[j].w += g4.w * a3;
                        *(f32x4*)(kp->out + (size_t)row * D + c) = v[j];
                    }
                }
                if (donorm) {
                    const float* mm = MOD + ((size_t)lyr * NB + b) * 6144 + (ffn ? 3 * D : 0);
                    norm_mod_store(v, ng, mm + D, mm, HB + (size_t)row * D, ffn ? HB8 + (size_t)row * D : (unsigned char*)nullptr, lane);
                }
            }
            if (ph == 1) {
                for (int idx = vb * NTHR + tid; idx < 32 * 64 * 256; idx += G * NTHR) {
                    const int j = idx & 15, i = (idx >> 4) & 15, tau = (idx >> 8) & 63, g = idx >> 14;
                    float acc = 0.f;
                    for (int pp = 0; pp < 64; ++pp) {
                        const float cr = kp->s5_c_re[(g * 16 + i) * 64 + pp], ci = kp->s5_c_im[(g * 16 + i) * 64 + pp];
                        const float pr = PW[((g * 64 + pp) * 65 + tau) * 2], pi = PW[((g * 64 + pp) * 65 + tau) * 2 + 1];
                        const float br = S5BB[((g * 64 + pp) * 16 + j) * 2], bi = S5BB[((g * 64 + pp) * 16 + j) * 2 + 1];
                        const float qr = pr * br - pi * bi, qi = pr * bi + pi * br;
                        acc += cr * qr - ci * qi;
                    }
                    KTAB[idx] = acc;
                }
            }
        }
        else if (ph == 2) {
            {
                DenseOrder so; so.go.init(T / 256, 4, G, vb);
                auto f = [=](const pg8::Unit& u, int r, int c, f32x4 v0, f32x4 v1) {
                        const int row = u.pm * 256 + r;
#pragma unroll
                        for (int h = 0; h < 2; ++h) {
                            const int col = u.pn * 256 + c + 16 * h; const f32x4 v = h ? v1 : v0;
                            u32x2 o; o.x = pk2(v.x, v.y); o.y = pk2(v.z, v.w);
                            if (col < 416) *(u32x2*)(Z + (size_t)row * 1024 + col) = o;
                            else if (col < 928) {
                                const int ch = col - 416, g = ch >> 4, j = ch & 15, b = row / S, t = row % S;
                                *(u32x2*)(AS5 + ((size_t)g * 512 + b * 64 + (t >> 6)) * 1152 + 128 + (t & 63) * 16 + j) = o;
                            }
                        }
                    };
                pg8::gemm_phase(tid, (PG8_LAS unsigned char*)lds, pg8::Gemm{HB, W_IN_E, D, D, D}, so, pg8::Epi<decltype(f)>{f});
            }
            for (int idx = vb * NTHR + tid; idx < 32 * 128 * 128; idx += G * NTHR) {
                const int k8 = idx & 127, n = (idx >> 7) & 127, g = idx >> 14;
                const int ri = n >> 6, pp = n & 63, s_ = k8 >> 1, j0 = (k8 & 1) * 8;
                const float pr = PW[((g * 64 + pp) * 65 + (63 - s_)) * 2], pi = PW[((g * 64 + pp) * 65 + (63 - s_)) * 2 + 1];
                float o[8];
#pragma unroll
                for (int j = 0; j < 8; ++j) {
                    const float br = S5BB[((g * 64 + pp) * 16 + j0 + j) * 2], bi = S5BB[((g * 64 + pp) * 16 + j0 + j) * 2 + 1];
                    o[j] = ri ? (pr * bi + pi * br) : (pr * br - pi * bi);
                }
                u32x4 w; w.x = pk2(o[0], o[1]); w.y = pk2(o[2], o[3]); w.z = pk2(o[4], o[5]); w.w = pk2(o[6], o[7]);
                *(u32x4*)(BT_END + ((size_t)g * 128 + n) * 1024 + k8 * 8) = w;
            }
            for (int idx = vb * NTHR + tid; idx < 32 * 1024 * 144; idx += G * NTHR) {
                const int k8 = idx % 144, n = (idx / 144) & 1023, g = idx / (144 * 1024);
                const int t = n >> 4, i = n & 15;
                float o[8];
                if (k8 < 16) {
                    const int ri = k8 >> 3, p0 = (k8 & 7) * 8;
#pragma unroll
                    for (int j = 0; j < 8; ++j) {
                        const int pp = p0 + j;
                        const float cr = kp->s5_c_re[(g * 16 + i) * 64 + pp], ci = kp->s5_c_im[(g * 16 + i) * 64 + pp];
                        const float pr = PW[((g * 64 + pp) * 65 + t + 1) * 2], pi = PW[((g * 64 + pp) * 65 + t + 1) * 2 + 1];
                        o[j] = ri ? -(cr * pi + ci * pr) : (cr * pr - ci * pi);
                    }
                } else {
                    const int kk = (k8 - 16) * 8, s_ = kk >> 4, j0 = kk & 15;
#pragma unroll
                    for (int j = 0; j < 8; ++j) o[j] = (s_ <= t) ? KTAB[((g * 64 + (t - s_)) * 16 + i) * 16 + j0 + j] : 0.f;
                }
                u32x4 w; w.x = pk2(o[0], o[1]); w.y = pk2(o[2], o[3]); w.z = pk2(o[4], o[5]); w.w = pk2(o[6], o[7]);
                *(u32x4*)(BT_MAIN + ((size_t)g * 1024 + n) * 1152 + k8 * 8) = w;
            }
        }
        else if (ph == 3) {
            for (int row = gw; row < T; row += NGW) {
                const u32x2 qv = *(const u32x2*)(Z + (size_t)row * 1024 + lane * 4);
                const unsigned kv = *(const unsigned*)(Z + (size_t)row * 1024 + 256 + lane * 2);
                const float q0 = __uint_as_float(qv.x << 16), q1 = __uint_as_float(qv.x & 0xffff0000u), q2 = __uint_as_float(qv.y << 16), q3 = __uint_as_float(qv.y & 0xffff0000u);
                const float k0 = __uint_as_float(kv << 16), k1 = __uint_as_float(kv & 0xffff0000u);
                const float rq = rsqrtf(wave_sum(q0 * q0 + q1 * q1 + q2 * q2 + q3 * q3) * (1.f / 256.f) + 1e-6f);
                const float rk = rsqrtf(wave_sum(k0 * k0 + k1 * k1) * (1.f / 128.f) + 1e-6f);
                const f32x4 gq = *(const f32x4*)(kp->q_norm_g + lane * 4);
                u32x2 o; o.x = pk2(q0 * rq * gq.x, q1 * rq * gq.y); o.y = pk2(q2 * rq * gq.z, q3 * rq * gq.w);
                *(u32x2*)(QKN + (size_t)row * 384 + lane * 4) = o;
                *(unsigned*)(QKN + (size_t)row * 384 + 256 + lane * 2) = pk2(k0 * rk * kp->kv_norm_g[lane * 2], k1 * rk * kp->kv_norm_g[lane * 2 + 1]);
            }
            for (int u = vb; u < 128; u += G) {
                const int g = u >> 2, pm = u & 3;
                sg_tile(tid, lds, AS5 + ((size_t)g * 512 + pm * 128) * 1152 + 128, 1152, BT_END + (size_t)g * 128 * 1024, 1024, 1024,
                    [=](int r, int c, f32x4 v0, f32x4 v1) {
                        float* o = LEND + ((size_t)g * 512 + pm * 128 + r) * 128 + c;
                        *(f32x4*)o = v0; *(f32x4*)(o + 16) = v1;
                    });
            }
        }
        else if (ph == 4) {
            {
                DenseOrder so; so.go.init(T / 256, 7, G, vb);
                auto f = [=](const pg8::Unit& u, int r, int c, f32x4 v0, f32x4 v1) {
                            bf16_t* o = QKVRAW + (size_t)(u.pm * 256 + r) * 1792 + u.pn * 256 + c;
                            u32x2 a; a.x = pk2(v0.x, v0.y); a.y = pk2(v0.z, v0.w); *(u32x2*)o = a;
                            u32x2 b; b.x = pk2(v1.x, v1.y); b.y = pk2(v1.z, v1.w); *(u32x2*)(o + 16) = b;
                        };
                pg8::gemm_phase(tid, (PG8_LAS unsigned char*)lds, pg8::Gemm{QKN, W_UP, 384, 384, 384}, so, pg8::Epi<decltype(f)>{f});
            }
        }
        else if (ph == 5) {
            bf16_t* stq = (bf16_t*)(lds + 65536) + wave * 1536;
            bf16_t* vts = (bf16_t*)lds;
            const float qscale = 0.10206207261596577f * 1.4426950408889634f;
            for (int tile = vb; tile < T / 64; tile += G) {
                const int hh = lane >> 3, pp = lane & 7;
                for (int tt = 0; tt < 8; ++tt) {
                    const int tl = wave * 8 + tt, row = tile * 64 + tl, b = row / S, t = row % S;
                    float qv[12], kv[12];
#pragma unroll
                    for (int j = 0; j < 12; ++j) {
                        const int d = pp + 8 * j;
                        qv[j] = bf2f(QKVRAW[(size_t)row * 1792 + hh * 96 + d]);
                        kv[j] = (j < 8) ? bf2f(QKVRAW[(size_t)row * 1792 + 768 + hh * 128 + d]) : bf2f(Z[(size_t)row * 1024 + 384 + d - 64]);
                    }
                    float sq = 0.f, sk = 0.f;
#pragma unroll
                    for (int j = 0; j < 12; ++j) { sq += qv[j] * qv[j]; sk += kv[j] * kv[j]; }
                    sq += __shfl_xor(sq, 1); sq += __shfl_xor(sq, 2); sq += __shfl_xor(sq, 4);
                    sk += __shfl_xor(sk, 1); sk += __shfl_xor(sk, 2); sk += __shfl_xor(sk, 4);
                    const float rq = rsqrtf(sq * (1.f / 96.f) + 1e-6f), rk = rsqrtf(sk * (1.f / 96.f) + 1e-6f);
#pragma unroll
                    for (int j = 0; j < 12; ++j) { const int d = pp + 8 * j; qv[j] *= rq * kp->q_head_g[d]; kv[j] *= rk * kp->k_head_g[d]; }
                    const float posf = (float)kp->pos[row];
#pragma unroll
                    for (int e = 0; e < 2; ++e) {
                        const int i = pp + 8 * e;
                        const float invf = exp2f(-(float)i * (13.287712379549449f / 16.0f));
                        const float ang = posf * invf;
                        const float kq = rintf(ang * 0.15915494309189535f);
                        float rr = __builtin_fmaf(-kq, 6.28318548202514648f, ang); rr = __builtin_fmaf(-kq, -1.7484556e-7f, rr);
                        const float cs = __cosf(rr), sn = __sinf(rr);
                        const float q1 = qv[8 + e], q2 = qv[10 + e], k1 = kv[8 + e], k2 = kv[10 + e];
                        qv[8 + e] = q1 * cs - q2 * sn; qv[10 + e] = q1 * sn + q2 * cs;
                        kv[8 + e] = k1 * cs - k2 * sn; kv[10 + e] = k1 * sn + k2 * cs;
                    }
#pragma unroll
                    for (int j = 0; j < 12; ++j) { const int d = pp + 8 * j; stq[hh * 96 + d] = f2bf(qv[j] * qscale); stq[768 + hh * 96 + d] = f2bf(kv[j]); }
#pragma unroll
                    for (int j = 0; j < 8; ++j) { const int dv = pp + 8 * j; vts[(hh * 64 + dv) * 64 + tl] = QKVRAW[(size_t)row * 1792 + 768 + hh * 128 + 64 + dv]; }
                    __builtin_amdgcn_s_waitcnt(0xC07F); asm volatile("" ::: "memory");
                    for (int ch = lane; ch < 192; ch += 64) {
                        const int isk = ch >= 96, c2 = ch - 96 * isk, h2 = c2 / 12, part = c2 % 12;
                        const u32x4 vv = *(const u32x4*)(stq + isk * 768 + h2 * 96 + part * 8);
                        bf16_t* dst = (isk ? Kb : Qb) + (((size_t)b * 8 + h2) * S + t) * 96 + part * 8;
                        *(u32x4*)dst = vv;
                    }
                    __builtin_amdgcn_s_waitcnt(0xC07F); asm volatile("" ::: "memory");
                }
                __syncthreads();
                {
                    const int hd = tid, b = (tile * 64) / S, t0 = (tile * 64) % S;
                    bf16_t* dst = VT + (((size_t)b * 8 + (hd >> 6)) * 64 + (hd & 63)) * S + t0;
#pragma unroll
                    for (int i = 0; i < 8; ++i) *(u32x4*)(dst + i * 8) = *(const u32x4*)(vts + hd * 64 + i * 8);
                }
                __syncthreads();
            }
            for (int ch = vb * NTHR + tid; ch < NB * 32 * 64; ch += G * NTHR) {
                const int pp = ch & 63, g = (ch >> 6) & 31, b = ch >> 11;
                const float ar = PW[((g * 64 + pp) * 65 + 64) * 2], ai = PW[((g * 64 + pp) * 65 + 64) * 2 + 1];
                float cr = 0.f, ci = 0.f;
                for (int c = 0; c < 64; ++c) {
                    bf16_t* dst = AS5 + ((size_t)g * 512 + b * 64 + c) * 1152;
                    dst[pp] = f2bf(cr); dst[64 + pp] = f2bf(ci);
                    const float* le = LEND + ((size_t)g * 512 + b * 64 + c) * 128;
                    const float nr = ar * cr - ai * ci + le[pp], ni = ar * ci + ai * cr + le[64 + pp];
                    cr = nr; ci = ni;
                }
            }
        }
        else if (ph == 6) {
            unsigned char* Ks = lds;
            unsigned char* Vs = lds + 64 * 208;
            const int r32 = lane & 31, hi = lane >> 5;
            for (int ui = 0; ui < 4; ++ui) {
                if (vb >= 256) break;
                const int bh = vb & 63, kq = vb >> 6;
                const int qb = (ui == 0) ? 15 - kq : (ui == 1) ? 8 + kq : (ui == 2) ? 7 - kq : kq;
                const int q0 = qb * 256 + wave * 32;
                const bf16_t* Qg = Qb + ((size_t)bh * S + q0 + r32) * 96;
                const bf16_t* Kg = Kb + (size_t)bh * S * 96;
                const bf16_t* Vg = VT + (size_t)bh * 64 * S;
                bf16x8 qf[6];
#pragma unroll
                for (int d0 = 0; d0 < 6; ++d0) qf[d0] = *(const bf16x8*)(Qg + d0 * 16 + hi * 8);
                f32x16 o0, o1;
#pragma unroll
                for (int r = 0; r < 16; ++r) { o0[r] = 0.f; o1[r] = 0.f; }
                float m_run = -1e30f, l_run = 0.f;
                const int ntile = 4 * (qb + 1);
                u32x4 rk0, rk1, rv;
                const int kr0 = tid / 12, kc0 = tid % 12, kr1 = (tid + 512) / 12, kc1 = (tid + 512) % 12;
                const int vr = tid >> 3, vc = tid & 7;
                rk0 = *(const u32x4*)(Kg + (size_t)kr0 * 96 + kc0 * 8);
                if (tid < 256) rk1 = *(const u32x4*)(Kg + (size_t)kr1 * 96 + kc1 * 8);
                rv = *(const u32x4*)(Vg + (size_t)vr * S + vc * 8);
                for (int t = 0; t < ntile; ++t) {
                    __syncthreads();
                    *(u32x4*)(Ks + kr0 * 208 + kc0 * 16) = rk0;
                    if (tid < 256) *(u32x4*)(Ks + kr1 * 208 + kc1 * 16) = rk1;
                    { u32x2 a; a.x = rv.x; a.y = rv.y; u32x2 b2; b2.x = rv.z; b2.y = rv.w;
                      *(u32x2*)(Vs + vr * 136 + vc * 16) = a; *(u32x2*)(Vs + vr * 136 + vc * 16 + 8) = b2; }
                    __syncthreads();
                    if (t + 1 < ntile) {
                        rk0 = *(const u32x4*)(Kg + (size_t)((t + 1) * 64 + kr0) * 96 + kc0 * 8);
                        if (tid < 256) rk1 = *(const u32x4*)(Kg + (size_t)((t + 1) * 64 + kr1) * 96 + kc1 * 8);
                        rv = *(const u32x4*)(Vg + (size_t)vr * S + (t + 1) * 64 + vc * 8);
                    }
                    if (t * 64 > q0 + 31) continue;
                    f32x16 s0, s1;
#pragma unroll
                    for (int r = 0; r < 16; ++r) { s0[r] = 0.f; s1[r] = 0.f; }
#pragma unroll
                    for (int d0 = 0; d0 < 6; ++d0) {
                        const bf16x8 k0 = *(const bf16x8*)(Ks + r32 * 208 + d0 * 32 + hi * 16);
                        const bf16x8 k1 = *(const bf16x8*)(Ks + (32 + r32) * 208 + d0 * 32 + hi * 16);
                        s0 = __builtin_amdgcn_mfma_f32_32x32x16_bf16(k0, qf[d0], s0, 0, 0, 0);
                        s1 = __builtin_amdgcn_mfma_f32_32x32x16_bf16(k1, qf[d0], s1, 0, 0, 0);
                    }
                    if (t * 64 + 63 > q0) {
                        const int qi = q0 + r32;
#pragma unroll
                        for (int r = 0; r < 16; ++r) {
                            const int key = t * 64 + crow(r, hi);
                            if (key > qi) s0[r] = -INFINITY;
                            if (key + 32 > qi) s1[r] = -INFINITY;
                        }
                    }
                    float mx = s0[0];
#pragma unroll
                    for (int r = 1; r < 16; ++r) mx = fmaxf(mx, s0[r]);
#pragma unroll
                    for (int r = 0; r < 16; ++r) mx = fmaxf(mx, s1[r]);
                    mx = fmaxf(mx, __shfl_xor(mx, 32));
                    const float m_new = fmaxf(m_run, mx);
                    const float alpha = __builtin_amdgcn_exp2f(m_run - m_new);
                    m_run = m_new;
                    float ls = 0.f;
#pragma unroll
                    for (int r = 0; r < 16; ++r) { s0[r] = __builtin_amdgcn_exp2f(s0[r] - m_new); s1[r] = __builtin_amdgcn_exp2f(s1[r] - m_new); ls += s0[r] + s1[r]; }
                    l_run = l_run * alpha + ls;
#pragma unroll
                    for (int r = 0; r < 16; ++r) { o0[r] *= alpha; o1[r] *= alpha; }
                    bf16x8 pf[2][2];
#pragma unroll
                    for (int ks = 0; ks < 2; ++ks) {
                        u32x4 w0, w1;
                        w0.x = pk2(s0[8 * ks + 0], s0[8 * ks + 1]); w0.y = pk2(s0[8 * ks + 2], s0[8 * ks + 3]); w0.z = pk2(s0[8 * ks + 4], s0[8 * ks + 5]); w0.w = pk2(s0[8 * ks + 6], s0[8 * ks + 7]);
                        w1.x = pk2(s1[8 * ks + 0], s1[8 * ks + 1]); w1.y = pk2(s1[8 * ks + 2], s1[8 * ks + 3]); w1.z = pk2(s1[8 * ks + 4], s1[8 * ks + 5]); w1.w = pk2(s1[8 * ks + 6], s1[8 * ks + 7]);
                        pf[0][ks] = __builtin_bit_cast(bf16x8, w0); pf[1][ks] = __builtin_bit_cast(bf16x8, w1);
                    }
#pragma unroll
                    for (int kb = 0; kb < 2; ++kb)
#pragma unroll
                        for (int ks = 0; ks < 2; ++ks) {
                            const int koff = (kb * 32 + 16 * ks + 4 * hi) * 2;
#pragma unroll
                            for (int dvb = 0; dvb < 2; ++dvb) {
                                const unsigned char* vp = Vs + (dvb * 32 + r32) * 136 + koff;
                                const u32x2 lo = *(const u32x2*)vp, hi2 = *(const u32x2*)(vp + 16);
                                u32x4 w; w.x = lo.x; w.y = lo.y; w.z = hi2.x; w.w = hi2.y;
                                const bf16x8 vf = __builtin_bit_cast(bf16x8, w);
                                if (dvb == 0) o0 = __builtin_amdgcn_mfma_f32_32x32x16_bf16(vf, pf[kb][ks], o0, 0, 0, 0);
                                else o1 = __builtin_amdgcn_mfma_f32_32x32x16_bf16(vf, pf[kb][ks], o1, 0, 0, 0);
                            }
                        }
                }
                l_run += __shfl_xor(l_run, 32);
                const float rl = 1.0f / l_run;
                const int b = bh >> 3, h = bh & 7;
                bf16_t* orow = MIXIN + ((size_t)b * S + q0 + r32) * 1024 + h * 64;
#pragma unroll
                for (int rg = 0; rg < 4; ++rg) {
                    u32x2 a; a.x = pk2(o0[4 * rg] * rl, o0[4 * rg + 1] * rl); a.y = pk2(o0[4 * rg + 2] * rl, o0[4 * rg + 3] * rl);
                    *(u32x2*)(orow + 8 * rg + 4 * hi) = a;
                    u32x2 c2; c2.x = pk2(o1[4 * rg] * rl, o1[4 * rg + 1] * rl); c2.y = pk2(o1[4 * rg + 2] * rl, o1[4 * rg + 3] * rl);
                    *(u32x2*)(orow + 32 + 8 * rg + 4 * hi) = c2;
                }
            }
            __syncthreads();
            {
                S5Order so; so.G = G; so.c = vb;
                auto f = [=](const pg8::Unit& u, int r, int c, f32x4 v0, f32x4 v1) {
                        const int g = u.aux, m = (u.pm & 1) * 256 + r, b = m >> 6, ck = m & 63;
#pragma unroll
                        for (int h = 0; h < 2; ++h) {
                            const int n = u.pn * 256 + c + 16 * h; const f32x4 v = h ? v1 : v0;
                            const int tq = n >> 4, i = n & 15;
                            const u32x2 uu = *(const u32x2*)(AS5 + ((size_t)g * 512 + m) * 1152 + 128 + n);
                            const f32x4 dd = *(const f32x4*)(s5d + g * 16 + i);
                            const float y0 = v.x + dd.x * __uint_as_float(uu.x << 16), y1 = v.y + dd.y * __uint_as_float(uu.x & 0xffff0000u),
                                        y2 = v.z + dd.z * __uint_as_float(uu.y << 16), y3 = v.w + dd.w * __uint_as_float(uu.y & 0xffff0000u);
                            u32x2 o; o.x = pk2(gelu_tanh(y0), gelu_tanh(y1)); o.y = pk2(gelu_tanh(y2), gelu_tanh(y3));
                            *(u32x2*)(GACT + ((size_t)b * S + ck * 64 + tq) * 512 + g * 16 + i) = o;
                        }
                    };
                pg8::gemm_phase(tid, (PG8_LAS unsigned char*)lds, pg8::Gemm{AS5, BT_MAIN, 1152, 1152, 1152}, so, pg8::Epi<decltype(f)>{f});
            }
        }
        else if (ph == 7) {
            {
                DenseOrder so; so.go.init(T / 256, 2, G, vb);
                auto f = [=](const pg8::Unit& u, int r, int c, f32x4 v0, f32x4 v1) {
                        const int row = u.pm * 256 + r;
#pragma unroll
                        for (int h = 0; h < 2; ++h) {
                            const int col = u.pn * 256 + c + 16 * h; const f32x4 v = h ? v1 : v0;
                            const u32x2 gg = *(const u32x2*)(GACT + (size_t)row * 512 + col);
                            const f32x4 bb = *(const f32x4*)(glub + col);
                            const float g0 = __uint_as_float(gg.x << 16), g1 = __uint_as_float(gg.x & 0xffff0000u), g2 = __uint_as_float(gg.y << 16), g3 = __uint_as_float(gg.y & 0xffff0000u);
                            u32x2 o; o.x = pk2(g0 * sigmoidf_(v.x + bb.x), g1 * sigmoidf_(v.y + bb.y)); o.y = pk2(g2 * sigmoidf_(v.z + bb.z), g3 * sigmoidf_(v.w + bb.w));
                            *(u32x2*)(MIXIN + (size_t)row * 1024 + 512 + col) = o;
                        }
                    };
                pg8::gemm_phase(tid, (PG8_LAS unsigned char*)lds, pg8::Gemm{GACT, W_GLU, 512, 512, 512}, so, pg8::Epi<decltype(f)>{f});
            }
        }
        else if (ph == 8 || ph == 19) {
            const int lyr = (ph == 8) ? 0 : 1;
            const bf16_t* W = lyr ? W_OUT_O : W_OUT_E;
            const float* src = lyr ? OUT : XIN;
            {
                DenseOrder so; so.go.init(T / 256, 4, G, vb);
                auto f = [=](const pg8::Unit& u, int r, int c, f32x4 v0, f32x4 v1) {
                        const int row = u.pm * 256 + r, b = row / S;
                        const float* gm = MOD + ((size_t)lyr * NB + b) * 6144 + 2 * D;
#pragma unroll
                        for (int h = 0; h < 2; ++h) {
                            const int col = u.pn * 256 + c + 16 * h; const f32x4 v = h ? v1 : v0;
                            const f32x4 xs = *(const f32x4*)(src + (size_t)row * D + col), g4 = *(const f32x4*)(gm + col);
                            f32x4 o; o.x = xs.x + g4.x * v.x; o.y = xs.y + g4.y * v.y; o.z = xs.z + g4.z * v.z; o.w = xs.w + g4.w * v.w;
                            *(f32x4*)(OUT + (size_t)row * D + col) = o;
                        }
                    };
                pg8::gemm_phase(tid, (PG8_LAS unsigned char*)lds, pg8::Gemm{MIXIN, W, D, D, D}, so, pg8::Epi<decltype(f)>{f});
            }
        }
        else if (mph == 10) {
            const bf16_t* W = W_RT + (size_t)layer * 128 * 1024;
            const float* rb = rtb_all + layer * 32;
            for (int u = vb; u < 256; u += G) {
                const int pm = u;
                sg_tile(tid, lds, HB + (size_t)pm * 128 * D, D, W, D, D,
                    [=](int r, int c, f32x4 v0, f32x4 v1) {
                        const int row = pm * 128 + r;
                        if (c < 32) {
                            const f32x4 b0 = *(const f32x4*)(rb + c), b1 = *(const f32x4*)(rb + c + 16);
                            f32x4 a = v0 + b0, bq = v1 + b1;
                            *(f32x4*)(LOGIT + (size_t)row * 32 + c) = a; *(f32x4*)(LOGIT + (size_t)row * 32 + c + 16) = bq;
                        }
                    });
            }
        }
        else if (mph == 11) {
            unsigned* hist = (unsigned*)lds;
            unsigned* gcnt = ctl + CW_CNT + layer * 64;
            for (int blk = vb; blk < T / NTHR; blk += G) {
                if (tid < 64) hist[tid] = 0u;
                __syncthreads();
                const int tok = blk * NTHR + tid;
                float lg[32];
#pragma unroll
                for (int i = 0; i < 8; ++i) { const f32x4 v = *(const f32x4*)(LOGIT + (size_t)tok * 32 + 4 * i); lg[4 * i] = v.x; lg[4 * i + 1] = v.y; lg[4 * i + 2] = v.z; lg[4 * i + 3] = v.w; }
                int e4[4]; float v4[4];
#pragma unroll
                for (int k = 0; k < 4; ++k) {
                    float best = -INFINITY; int bi = 0;
#pragma unroll
                    for (int e = 0; e < 32; ++e) { const bool tk = lg[e] > best; best = tk ? lg[e] : best; bi = tk ? e : bi; }
                    e4[k] = bi; v4[k] = best;
#pragma unroll
                    for (int e = 0; e < 32; ++e) lg[e] = (e == bi) ? -INFINITY : lg[e];
                }
                float den = 0.f, ex[4];
#pragma unroll
                for (int k = 0; k < 4; ++k) { ex[k] = __expf(v4[k] - v4[0]); den += ex[k]; }
                unsigned lp[4];
#pragma unroll
                for (int k = 0; k < 4; ++k) lp[k] = atomicAdd(hist + e4[k], 1u);
                __syncthreads();
                if (tid < 32) hist[32 + tid] = atomicAdd(gcnt + tid, (unsigned)hist[tid]);
                __syncthreads();
#pragma unroll
                for (int k = 0; k < 4; ++k) {
                    tok_e[tok * 4 + k] = e4[k]; tok_pos[tok * 4 + k] = (int)(hist[32 + e4[k]] + lp[k]); tok_gate[tok * 4 + k] = ex[k] / den;
                }
                __syncthreads();
            }
        }
        else if (mph == 12 || mph == 13 || mph == 14) {
            int* pst = (int*)(lds + 140 * 1024 - 1024);
            if (tid == 0) {
                const unsigned* gcnt = ctl + CW_CNT + layer * 64; int acc = 0;
                for (int e = 0; e < 32; ++e) { const int c = (int)gcnt[e]; pst[e] = acc; pst[64 + e] = c; acc += (c + 255) & ~255; }
                pst[32] = acc;
            }
            __syncthreads();
            const int total_rows = pst[32];
            if (mph == 12) {
                for (int it = gw; it < T * 4; it += NGW) {
                    const int tok = it >> 2, e = tok_e[it], row = pst[e] + tok_pos[it];
                    const u32x4* s = (const u32x4*)(HB8 + (size_t)tok * D);
                    u32x4* d = (u32x4*)(XB + (size_t)row * D);
                    d[lane] = s[lane];
                    if (lane == 0) { row_slot[row] = it; row_gate[row] = tok_gate[it]; }
                }
                for (int e = 0; e < 32; ++e) {
                    const int lo = pst[e] + pst[64 + e], hi2 = pst[e + 1];
                    for (int r = lo + vb * NTHR + tid; r < hi2; r += G * NTHR) { row_slot[r] = -1; row_gate[r] = 0.f; }
                }
            } else if (mph == 13) {
                {
                    MoeOrder so; so.go.init(total_rows >> 8, 8, G, vb); so.pst = pst; so.NT = 8; so.ebase = layer * 32;
                    auto f = [=](const pg8::Unit& u, int r, int c, f32x4 v0, f32x4 v1) {
                            const int row0 = u.pm * 256, cc = u.pn * 256 + c;
                            const float* bg = bgu_all + (size_t)(layer * 32 + u.aux) * 2048;
                            const int j = (cc >> 5) * 16 + (cc & 15);
                            const f32x4 b0 = *(const f32x4*)(bg + j), b1 = *(const f32x4*)(bg + 1024 + j);
                            float o[4];
#pragma unroll
                            for (int i = 0; i < 4; ++i) {
                                const float gt = fminf(v0[i] + b0[i], 7.0f), ln = fminf(fmaxf(v1[i] + b1[i], -7.0f), 7.0f);
                                o[i] = gt * sigmoidf_(1.702f * gt) * (ln + 1.0f);
                            }
                            *(unsigned*)(ACT + (size_t)(row0 + r) * D + j) = pk4_fp8(o[0], o[1], o[2], o[3]);
                        };
                    pg8::gemm_phase<true>(tid, (PG8_LAS unsigned char*)lds, pg8::Gemm{(const bf16_t*)XB, (const bf16_t*)W_GU, 512, 512, 512}, so, pg8::Epi<decltype(f)>{f});
                }
            } else {
                {
                    MoeOrder so; so.go.init(total_rows >> 8, 4, G, vb); so.pst = pst; so.NT = 4; so.ebase = layer * 32;
                    auto f = [=](const pg8::Unit& u, int r, int c, f32x4 v0, f32x4 v1) {
                            const float* bd = bdn_all + (size_t)(layer * 32 + u.aux) * 1024;
                            const int row = u.pm * 256 + r, slot = row_slot[row];
                            if (slot >= 0) {
                                const float gt = row_gate[row];
#pragma unroll
                                for (int h = 0; h < 2; ++h) {
                                    const int col = u.pn * 256 + c + 16 * h; const f32x4 v = h ? v1 : v0;
                                    const f32x4 bb = *(const f32x4*)(bd + col);
                                    u32x2 o; o.x = pk2((v.x + bb.x) * gt, (v.y + bb.y) * gt); o.y = pk2((v.z + bb.z) * gt, (v.w + bb.w) * gt);
                                    *(u32x2*)(Y + (size_t)slot * D + col) = o;
                                }
                            }
                        };
                    pg8::gemm_phase<true>(tid, (PG8_LAS unsigned char*)lds, pg8::Gemm{(const bf16_t*)ACT, (const bf16_t*)W_DN, 512, 512, 512}, so, pg8::Epi<decltype(f)>{f});
                }
            }
        }
        else if (ph == 16) {
            {
                DenseOrder so; so.go.init(T / 256, 6, G, vb);
                auto f = [=](const pg8::Unit& u, int r, int c, f32x4 v0, f32x4 v1) {
                        const int row = u.pm * 256 + r;
#pragma unroll
                        for (int h = 0; h < 2; ++h) {
                            const int col = u.pn * 256 + c + 16 * h; f32x4 v = h ? v1 : v0;
                            if (col >= 512) { v.x = gelu_tanh(v.x); v.y = gelu_tanh(v.y); v.z = gelu_tanh(v.z); v.w = gelu_tanh(v.w); }
                            u32x2 o; o.x = pk2(v.x, v.y); o.y = pk2(v.z, v.w);
                            *(u32x2*)(Z + (size_t)row * 1536 + col) = o;
                        }
                    };
                pg8::gemm_phase(tid, (PG8_LAS unsigned char*)lds, pg8::Gemm{HB, W_IN_O, D, D, D}, so, pg8::Epi<decltype(f)>{f});
            }
        }
        else if (ph == 17) {
            for (int ck = vb; ck < T / 128; ck += G) {
                bf16_t* tile = (bf16_t*)lds;
                for (int tt = 0; tt < 16; ++tt) {
                    const int sl = wave * 16 + tt, row = ck * 128 + sl, t = row % S;
                    {
                        const int ch0 = lane * 8, w = 2 << (ch0 >> 7);
                        float acc[8], own[8];
#pragma unroll
                        for (int i = 0; i < 8; ++i) acc[i] = 0.f;
                        const int n = (t + 1 < w) ? t + 1 : w;
                        for (int q = 0; q < n; ++q) {
                            const u32x4 uv = *(const u32x4*)(Z + (size_t)(row - q) * 1536 + ch0);
                            const float f[8] = {__uint_as_float(uv.x << 16), __uint_as_float(uv.x & 0xffff0000u), __uint_as_float(uv.y << 16), __uint_as_float(uv.y & 0xffff0000u),
                                                __uint_as_float(uv.z << 16), __uint_as_float(uv.z & 0xffff0000u), __uint_as_float(uv.w << 16), __uint_as_float(uv.w & 0xffff0000u)};
#pragma unroll
                            for (int i = 0; i < 8; ++i) { acc[i] += f[i]; if (q == 0) own[i] = f[i]; }
                        }
                        const float inv = 1.0f / (float)n;
                        u32x4 o; o.x = pk2(acc[0] * inv - own[0], acc[1] * inv - own[1]); o.y = pk2(acc[2] * inv - own[2], acc[3] * inv - own[3]);
                        o.z = pk2(acc[4] * inv - own[4], acc[5] * inv - own[5]); o.w = pk2(acc[6] * inv - own[6], acc[7] * inv - own[7]);
                        *(u32x4*)(POOLED + (size_t)row * 512 + ch0) = o;
                    }
                    {
                        const u32x4 uv = *(const u32x4*)(Z + (size_t)row * 1536 + 1024 + lane * 8);
                        float f[8] = {__uint_as_float(uv.x << 16), __uint_as_float(uv.x & 0xffff0000u), __uint_as_float(uv.y << 16), __uint_as_float(uv.y & 0xffff0000u),
                                      __uint_as_float(uv.z << 16), __uint_as_float(uv.z & 0xffff0000u), __uint_as_float(uv.w << 16), __uint_as_float(uv.w & 0xffff0000u)};
                        float ss = 0.f;
#pragma unroll
                        for (int i = 0; i < 8; ++i) ss += f[i] * f[i];
                        const float rr = rsqrtf(wave_sum(ss) * (1.f / 512.f) + 1e-6f);
                        u32x4 o;
                        const float* gg = kp->sgu_norm_g + lane * 8;
                        o.x = pk2(f[0] * rr * gg[0], f[1] * rr * gg[1]); o.y = pk2(f[2] * rr * gg[2], f[3] * rr * gg[3]);
                        o.z = pk2(f[4] * rr * gg[4], f[5] * rr * gg[5]); o.w = pk2(f[6] * rr * gg[6], f[7] * rr * gg[7]);
                        *(u32x4*)(tile + sl * 520 + lane * 8) = o;
                    }
                }
                __syncthreads();
                {
                    const int ch = tid;
                    bf16_t* dst = VTS + ((size_t)ck * 512 + ch) * 128;
                    for (int s8 = 0; s8 < 16; ++s8) {
                        unsigned w[4];
#pragma unroll
                        for (int i = 0; i < 4; ++i) w[i] = (unsigned)tile[(s8 * 8 + 2 * i) * 520 + ch] | ((unsigned)tile[(s8 * 8 + 2 * i + 1) * 520 + ch] << 16);
                        u32x4 o; o.x = w[0]; o.y = w[1]; o.z = w[2]; o.w = w[3];
                        *(u32x4*)(dst + s8 * 8) = o;
                    }
                }
                __syncthreads();
            }
        }
        else if (ph == 18) {
            for (int u = vb; u < 2048; u += G) {
                if (u < 1024) {
                    const int pm = u >> 2, gi = u & 3;
                    sg_tile(tid, lds, POOLED + (size_t)pm * 128 * 512 + gi * 128, 512, W_POOL + (size_t)gi * 128 * 128, 128, 128,
                        [=](int r, int c, f32x4 v0, f32x4 v1) {
                            const int row = pm * 128 + r;
#pragma unroll
                            for (int h = 0; h < 2; ++h) {
                                const int col = gi * 128 + c + 16 * h; const f32x4 v = h ? v1 : v0;
                                const f32x4 sc = *(const f32x4*)(poolsc + col);
                                u32x2 o; o.x = pk2(v.x * sc.x, v.y * sc.y); o.y = pk2(v.z * sc.z, v.w * sc.w);
                                *(u32x2*)(MIXIN + (size_t)row * 1024 + col) = o;
                            }
                        });
                } else {
                    const int uu = u - 1024, ck = uu >> 2, h4 = uu & 3;
                    sg_tile(tid, lds, W_SGU + (size_t)h4 * 128 * 128, 128, VTS + ((size_t)ck * 512 + h4 * 128) * 128, 128, 128,
                        [=](int r, int c, f32x4 v0, f32x4 v1) {
                            const int row = ck * 128 + r;
                            const float bias = sgub[h4 * 128 + r];
#pragma unroll
                            for (int h = 0; h < 2; ++h) {
                                const int dcol = c + 16 * h; const f32x4 v = h ? v1 : v0;
                                const u32x2 ug = *(const u32x2*)(Z + (size_t)row * 1536 + 512 + h4 * 128 + dcol);
                                u32x2 o; o.x = pk2((v.x + bias) * __uint_as_float(ug.x << 16), (v.y + bias) * __uint_as_float(ug.x & 0xffff0000u));
                                o.y = pk2((v.z + bias) * __uint_as_float(ug.y << 16), (v.w + bias) * __uint_as_float(ug.y & 0xffff0000u));
                                *(u32x2*)(MIXIN + (size_t)row * 1024 + 512 + h4 * 128 + dcol) = o;
                            }
                        });
                }
            }
        }

    }
}
template <int PH> struct PhaseSeq {
    static __device__ __forceinline__ void run(const XcdBarrier& bar) { PhaseSeq<PH - 1>::run(bar); phase_body<PH>();
        if constexpr (((PROBE_DUP_MASK >> PH) & 1ull) != 0) { xcd_barrier(bar); phase_body<PH>(); }
        if (PH + 1 < NPHASE) xcd_barrier(bar); }
};
template <> struct PhaseSeq<-1> { static __device__ __forceinline__ void run(const XcdBarrier&) {} };

template <int PHSEL> __global__ void __launch_bounds__(NTHR, 2) hybrid_fwd(Params p) {
    extern __shared__ __attribute__((aligned(16))) unsigned char lds[];
    const int tid0 = threadIdx.x;
    for (int u = tid0; u < (LDS_BYTES - LDS_MISC) / 4; u += NTHR) ((unsigned*)(lds + LDS_MISC))[u] = 0u;
    __syncthreads();
    if constexpr (PHSEL >= 0) { phase_body<PHSEL>(); }
    else {
        volatile LAS unsigned* MISC = (volatile LAS unsigned*)((LAS unsigned char*)lds + LDS_MISC);
        unsigned* ctl0 = (unsigned*)(p.ws + WS_CTL);
        XcdBarrier bar = xcd_barrier_post(ctl0 + CW_BAR, MISC + 8);
        PhaseSeq<NPHASE - 1>::run(bar);
    }
}

typedef void (*kfn_t)(Params);
template <int PH> struct Tab { static void fill(kfn_t* t) { t[PH] = hybrid_fwd<PH>; Tab<PH - 1>::fill(t); } };
template <> struct Tab<-1> { static void fill(kfn_t*) {} };
static kfn_t g_tab[NPHASE];
static void set_attrs() {
#if MK_ONE_LAUNCH
    (void)hipFuncSetAttribute((const void*)hybrid_fwd<-1>, hipFuncAttributeMaxDynamicSharedMemorySize, LDS_BYTES);
#else
    Tab<NPHASE - 1>::fill(g_tab);
    for (int i = 0; i < NPHASE; ++i) (void)hipFuncSetAttribute((const void*)g_tab[i], hipFuncAttributeMaxDynamicSharedMemorySize, LDS_BYTES);
#endif
}
#if !MK_ONE_LAUNCH
static void launch_all(const Params& p, int grid, hipStream_t stream) {
    for (int ph = 0; ph < NPHASE; ++ph) hipLaunchKernelGGL(g_tab[ph], dim3(grid), dim3(NTHR), LDS_BYTES, stream, p);
}
#endif
extern "C" void kernel_launch(void* const* d_in, const int* in_sizes, int n_in, void* d_out, int out_size, void* d_ws, size_t ws_size, hipStream_t stream) {
    static int ready = 0;
    if (ready == 0) {
        if (n_in != 38 || ws_size < WS_END) { fprintf(stderr, "kernel_launch: unexpected n_in %d / ws %zu\n", n_in, ws_size); ready = -1; return; }
        set_attrs();
        ready = 1;
    }
    if (ready < 0) return;
    (void)hipMemsetAsync((char*)d_ws + WS_CTL, 0, CTL_ZERO_BYTES, stream);
    Params p{};
    const float** fp = (const float**)&p.x;
    (void)fp;
    p.x = (const float*)d_in[0]; p.c = (const float*)d_in[1]; p.pos = (const int*)d_in[2];
    p.ada_w = (const float*)d_in[3]; p.ada_b = (const float*)d_in[4]; p.norm_mix_g = (const float*)d_in[5]; p.norm_ffn_g = (const float*)d_in[6];
    p.router_w = (const float*)d_in[7]; p.router_b = (const float*)d_in[8]; p.moe_w_gu = (const float*)d_in[9]; p.moe_b_gu = (const float*)d_in[10];
    p.moe_w_dn = (const float*)d_in[11]; p.moe_b_dn = (const float*)d_in[12];
    p.even_w_in = (const float*)d_in[13]; p.q_norm_g = (const float*)d_in[14]; p.w_uq = (const float*)d_in[15]; p.kv_norm_g = (const float*)d_in[16];
    p.w_ukv = (const float*)d_in[17]; p.q_head_g = (const float*)d_in[18]; p.k_head_g = (const float*)d_in[19];
    p.s5_a_re = (const float*)d_in[20]; p.s5_a_im = (const float*)d_in[21]; p.s5_log_dt = (const float*)d_in[22]; p.s5_b_re = (const float*)d_in[23];
    p.s5_b_im = (const float*)d_in[24]; p.s5_c_re = (const float*)d_in[25]; p.s5_c_im = (const float*)d_in[26]; p.s5_d = (const float*)d_in[27];
    p.s5_glu_w = (const float*)d_in[28]; p.s5_glu_b = (const float*)d_in[29]; p.even_w_out = (const float*)d_in[30];
    p.odd_w_in = (const float*)d_in[31]; p.pool_w = (const float*)d_in[32]; p.pool_scale = (const float*)d_in[33]; p.sgu_norm_g = (const float*)d_in[34];
    p.sgu_w = (const float*)d_in[35]; p.sgu_b = (const float*)d_in[36]; p.odd_w_out = (const float*)d_in[37];
    p.out = (float*)d_out; p.ws = (unsigned char*)d_ws;
    const int grid = 256;
#if MK_ONE_LAUNCH
    p.ph_lo = 0; p.ph_hi = NPHASE;
    hipLaunchKernelGGL(hybrid_fwd<-1>, dim3(grid), dim3(NTHR), LDS_BYTES, stream, p);
#else
    p.ph_lo = 0; p.ph_hi = 1;
    launch_all(p, grid, stream);
#endif
}
```

```cpp
#include <hip/hip_runtime.h>
#include <cstdio>
#include <cstdint>

#ifndef PROBE_DUP_MASK
#define PROBE_DUP_MASK 0x0ull
#endif
#ifndef PROBE_KX2
#define PROBE_KX2 0
#endif
#ifndef MK_ONE_LAUNCH
#define MK_ONE_LAUNCH 1
#endif

typedef unsigned short bf16_t;
typedef short bf16x8 __attribute__((ext_vector_type(8)));
typedef short s16x4 __attribute__((ext_vector_type(4)));
typedef float f32x4 __attribute__((ext_vector_type(4)));
typedef float f32x16 __attribute__((ext_vector_type(16)));
typedef unsigned u32x4 __attribute__((ext_vector_type(4)));
typedef unsigned u32x2 __attribute__((ext_vector_type(2)));

constexpr int D = 1024, NB = 8, S = 4096, T = NB * S;
constexpr int NTHR = 512, NWAVE = 8;
constexpr int MOE_ROWS = 139264;
constexpr int NPHASE = 27;

constexpr size_t MiB = 1u << 20;
constexpr size_t WS_CTL = 0, CTL_ZERO_BYTES = 1 * MiB;
constexpr size_t WS_MOD = 1 * MiB;
constexpr size_t WS_S5AB = 2 * MiB;
constexpr size_t WS_PW = 3 * MiB;
constexpr size_t WS_KTAB = 5 * MiB;
constexpr size_t WS_TOK = 7 * MiB;
constexpr size_t WS_ROW = 9 * MiB;
constexpr size_t WS_LOGIT = 11 * MiB;
constexpr size_t WS_W_IN_E = 16 * MiB, WS_W_UP = 18 * MiB  , WS_W_GLU = 20 * MiB, WS_W_OUT_E = 21 * MiB, WS_W_IN_O = 23 * MiB,
                 WS_W_OUT_O = 26 * MiB, WS_W_POOL = 28 * MiB, WS_W_SGU = 29 * MiB, WS_W_RT = 30 * MiB;
constexpr size_t WS_BT_END = 32 * MiB;
constexpr size_t WS_BT_MAIN = 40 * MiB;
constexpr size_t WS_W_GU = 112 * MiB;
constexpr size_t WS_W_DN = 240 * MiB;
constexpr size_t WS_HB8 = 304 * MiB;
constexpr size_t WS_HB = 496 * MiB;
constexpr size_t WS_MIXIN = 560 * MiB;
constexpr size_t WS_Y = 624 * MiB;
constexpr size_t WS_XB = 880 * MiB;
constexpr size_t WS_ACT = 1152 * MiB;
constexpr size_t WS_END = 1424 * MiB;
constexpr size_t WS_Z = 880 * MiB;
constexpr size_t WS_QKN = 976 * MiB  , WS_QKVRAW = 1000 * MiB  , WS_Q = 1112 * MiB, WS_K = 1160 * MiB, WS_VT = 1208 * MiB,
                 WS_AS5 = 1240 * MiB, WS_LEND = 1276 * MiB, WS_GACT = 1284 * MiB;
constexpr size_t WS_POOLED = 976 * MiB, WS_VTS = 1008 * MiB;
constexpr int CW_BAR = 4096, CW_CNT = 16384;

constexpr int LDS_BYTES = 147456;
constexpr int LDS_MISC = 140 * 1024;

struct Params {
    const float *x, *c; const int* pos;
    const float *ada_w, *ada_b, *norm_mix_g, *norm_ffn_g, *router_w, *router_b, *moe_w_gu, *moe_b_gu, *moe_w_dn, *moe_b_dn;
    const float *even_w_in, *q_norm_g, *w_uq, *kv_norm_g, *w_ukv, *q_head_g, *k_head_g;
    const float *s5_a_re, *s5_a_im, *s5_log_dt, *s5_b_re, *s5_b_im, *s5_c_re, *s5_c_im, *s5_d, *s5_glu_w, *s5_glu_b, *even_w_out;
    const float *odd_w_in, *pool_w, *pool_scale, *sgu_norm_g, *sgu_w, *sgu_b, *odd_w_out;
    float* out; unsigned char* ws; int ph_lo, ph_hi;
};

__device__ __forceinline__ float bf2f(unsigned short b) { return __uint_as_float(((unsigned)b) << 16); }
__device__ __forceinline__ unsigned pk2(float lo, float hi) {
    typedef float f2 __attribute__((ext_vector_type(2))); typedef __bf16 b2 __attribute__((ext_vector_type(2)));
    f2 v = {lo, hi}; b2 b = __builtin_convertvector(v, b2); return __builtin_bit_cast(unsigned, b);
}
__device__ __forceinline__ unsigned short f2bf(float f) { return (unsigned short)(pk2(f, 0.f) & 0xffffu); }
__device__ __forceinline__ float wave_sum(float v) {
#pragma unroll
    for (int o = 1; o < 64; o <<= 1) v += __shfl_xor(v, o);
    return v;
}
__device__ __forceinline__ float sigmoidf_(float x) { return __builtin_amdgcn_rcpf(1.0f + __builtin_amdgcn_exp2f(-1.4426950408889634f * x)); }
__device__ __forceinline__ float gelu_tanh(float x) {
    const float u = 0.7978845608028654f * (x + 0.044715f * x * x * x);
    return x * sigmoidf_(2.0f * u);
}
__device__ __forceinline__ unsigned pk4_fp8(float a, float b, float c, float d) {
    int w = 0; w = __builtin_amdgcn_cvt_pk_fp8_f32(a, b, w, false); w = __builtin_amdgcn_cvt_pk_fp8_f32(c, d, w, true); return (unsigned)w;
}
__device__ __forceinline__ int crow(int r, int hi) { return (r & 3) + 8 * (r >> 2) + 4 * hi; }

#define LAS __attribute__((address_space(3)))
#define XB_TMO      128
#define XB_XCNT(j)  (256  + 64 * (j))
#define XB_XSUB(j)  (1280 + 64 * (j))
#define XB_XGEN(j)  (2304 + 64 * (j))
#define XB_TOP      3328
#define XB_TOPGEN   3392
#define XCD_BAR_WORDS 3456
#define XB_SPIN_CAP (1u << 20)
__device__ __forceinline__ unsigned xb_ld(unsigned* p)              { return __hip_atomic_load(p, __ATOMIC_RELAXED, __HIP_MEMORY_SCOPE_AGENT); }
__device__ __forceinline__ unsigned xb_add(unsigned* p, unsigned v) { return __hip_atomic_fetch_add(p, v, __ATOMIC_RELAXED, __HIP_MEMORY_SCOPE_AGENT); }
__device__ __forceinline__ unsigned xb_xcc_id() { return (unsigned)__builtin_amdgcn_s_getreg((3 << 11) | 20) & 0xFu; }
#define XB_SPIN(cond, bar) do { unsigned _sp = 0; while (cond) { __builtin_amdgcn_s_sleep(1); \
    if ((++_sp & 255u) == 0u) { if (xb_ld(&(bar)[XB_TMO])) break; if (_sp > XB_SPIN_CAP) { atomicAdd(&(bar)[XB_TMO], 1u); break; } } } } while (0)
struct XcdBarrier { unsigned* bar; unsigned x; volatile LAS unsigned* st; };
__device__ __forceinline__ XcdBarrier xcd_barrier_post(unsigned* bar, volatile LAS unsigned* st) {
    XcdBarrier b; b.bar = bar; b.x = xb_xcc_id(); b.st = st;
    if (threadIdx.x == 0) (void)xb_add(&bar[XB_XCNT(b.x)], 1u);
    return b;
}
__device__ __forceinline__ void xcd_barrier_complete(unsigned* bar, unsigned x, unsigned& nloc, unsigned& nx) {
    const unsigned G = gridDim.x * gridDim.y * gridDim.z;
    unsigned sum, cnt, mine, sp = 0u;
    for (;;) {
        sum = 0u; cnt = 0u; mine = 0u;
#pragma unroll
        for (unsigned j = 0; j < 16; ++j) { const unsigned c = xb_ld(&bar[XB_XCNT(j)]); sum += c; cnt += (c > 0u) ? 1u : 0u; mine = (j == x) ? c : mine; }
        if (sum == G) break;
        __builtin_amdgcn_s_sleep(1);
        if ((++sp & 255u) == 0u) { if (xb_ld(&bar[XB_TMO])) break; if (sp > XB_SPIN_CAP) { atomicAdd(&bar[XB_TMO], 1u); break; } }
    }
    nloc = mine > 0u ? mine : 1u; nx = cnt > 0u ? cnt : 1u;
}
__device__ __forceinline__ void xcd_barrier(const XcdBarrier& b) {
    asm volatile("s_waitcnt vmcnt(0)" ::: "memory");
    __syncthreads();
    if (threadIdx.x == 0) {
        unsigned* bar = b.bar;
        __builtin_amdgcn_s_waitcnt(0);
        unsigned nloc = b.st[0], nx = b.st[1];
        if (nloc == 0u) { xcd_barrier_complete(bar, b.x, nloc, nx); b.st[0] = nloc; b.st[1] = nx; }
        const unsigned old = xb_add(&bar[XB_XSUB(b.x)], 1u);
        const unsigned gen = old / nloc;
        if (old + 1u == (gen + 1u) * nloc) {
            __builtin_amdgcn_fence(__ATOMIC_RELEASE, "agent");
            asm volatile("s_waitcnt vmcnt(0)" ::: "memory");
            const unsigned og = xb_add(&bar[XB_TOP], 1u);
            const unsigned tg = og / nx;
            if (og + 1u == (tg + 1u) * nx) xb_add(&bar[XB_TOPGEN], 1u);
            else XB_SPIN(xb_ld(&bar[XB_TOPGEN]) == tg, bar);
            __builtin_amdgcn_fence(__ATOMIC_ACQUIRE, "agent");
            xb_add(&bar[XB_XGEN(b.x)], 1u);
            asm volatile("s_waitcnt vmcnt(0)" ::: "memory");
        } else {
            XB_SPIN(xb_ld(&bar[XB_XGEN(b.x)]) == gen, bar);
            __builtin_amdgcn_fence(__ATOMIC_ACQUIRE, "agent");
            asm volatile("s_waitcnt vmcnt(0)" ::: "memory");
        }
    }
    __syncthreads();
}

constexpr int SG_LDS = 2 * 128 * 144;
template <class Epi>
__device__ __forceinline__ void sg_tile(int tid, unsigned char* lds, const bf16_t* A, int lda, const bf16_t* Bt, int ldb, int K, Epi epi) {
    const int lane = tid & 63, wid = tid >> 6, wr = wid >> 2, wc = wid & 3, fr = lane & 15, fq = lane >> 4;
    unsigned char* As = lds; unsigned char* Bs = lds + 128 * 144;
    f32x4 acc[4][2];
#pragma unroll
    for (int m = 0; m < 4; ++m)
#pragma unroll
        for (int n = 0; n < 2; ++n) acc[m][n] = (f32x4){0.f, 0.f, 0.f, 0.f};
    const int nt = K / 64;
    u32x4 ra[2], rb[2];
    const int r0 = tid >> 3, cc = tid & 7;
#pragma unroll
    for (int i = 0; i < 2; ++i) {
        ra[i] = *(const u32x4*)(A + (size_t)(r0 + 64 * i) * lda + cc * 8);
        rb[i] = *(const u32x4*)(Bt + (size_t)(r0 + 64 * i) * ldb + cc * 8);
    }
    for (int kt = 0; kt < nt; ++kt) {
        __syncthreads();
#pragma unroll
        for (int i = 0; i < 2; ++i) {
            *(u32x4*)(As + (r0 + 64 * i) * 144 + cc * 16) = ra[i];
            *(u32x4*)(Bs + (r0 + 64 * i) * 144 + cc * 16) = rb[i];
        }
        __syncthreads();
        if (kt + 1 < nt) {
#pragma unroll
            for (int i = 0; i < 2; ++i) {
                ra[i] = *(const u32x4*)(A + (size_t)(r0 + 64 * i) * lda + (kt + 1) * 64 + cc * 8);
                rb[i] = *(const u32x4*)(Bt + (size_t)(r0 + 64 * i) * ldb + (kt + 1) * 64 + cc * 8);
            }
        }
#pragma unroll
        for (int kk = 0; kk < 2; ++kk) {
            bf16x8 a[4], b[2];
#pragma unroll
            for (int m = 0; m < 4; ++m) a[m] = *(const bf16x8*)(As + (wr * 64 + m * 16 + fr) * 144 + kk * 64 + fq * 16);
#pragma unroll
            for (int n = 0; n < 2; ++n) b[n] = *(const bf16x8*)(Bs + (wc * 32 + n * 16 + fr) * 144 + kk * 64 + fq * 16);
#pragma unroll
            for (int m = 0; m < 4; ++m)
#pragma unroll
                for (int n = 0; n < 2; ++n) acc[m][n] = __builtin_amdgcn_mfma_f32_16x16x32_bf16(b[n], a[m], acc[m][n], 0, 0, 0);
        }
    }
#pragma unroll
    for (int m = 0; m < 4; ++m) epi(wr * 64 + m * 16 + fr, wc * 32 + fq * 4, acc[m][0], acc[m][1]);
}


namespace pg8 {
#define PG8_LAS __attribute__((address_space(3)))
constexpr int BM = 256, BK = 64, HALF = 128, HTB = HALF * BK * 2, STAGE_BYTES = 8 * HTB;
__device__ __forceinline__ int lds_byte(int r, int c) { const int st = (r >> 4) * 2 + (c >> 5), rr = r & 15, cc = c & 31, ob = rr * 64 + cc * 2; return st * 1024 + (ob ^ (((ob >> 9) & 1) << 5)); }
__device__ __forceinline__ void stage_rc(int b, int& R, int& C) { const int st = b / 1024, sb = b % 1024, swz = sb ^ (((sb >> 9) & 1) << 5); R = (st >> 1) * 16 + swz / 64; C = (st & 1) * 32 + (swz % 64) / 2; }
typedef int v8i_t __attribute__((ext_vector_type(8)));
typedef int v4i_t __attribute__((ext_vector_type(4)));
struct FragT { union { v8i_t v; struct { v4i_t lo, hi; }; }; };
struct Unit { int pm, pb, pn, aux; };
struct Gemm { const bf16_t* A; const bf16_t* Bt; int lda, ldb, K; };
struct NoCtx {};
struct NoPre { __device__ __forceinline__ NoCtx operator()(const Unit&, int, int, int, int) const { return NoCtx{}; } };
template <class PF, class F> struct Epi {
    PF pre; F f;
    template <class Ctx>
    __device__ __forceinline__ void operator()(const f32x4 (&acc)[2][2][4][2], const Ctx& ctx, const Unit& u, int wr, int wc, int fr, int fq) const {
#pragma unroll
        for (int ai = 0; ai < 2; ++ai)
#pragma unroll
            for (int m = 0; m < 4; ++m)
#pragma unroll
                for (int bj = 0; bj < 2; ++bj) {
                    f32x4 v0, v1;
                    asm volatile("v_accvgpr_read_b32 %0, %8\n\tv_accvgpr_read_b32 %1, %9\n\tv_accvgpr_read_b32 %2, %10\n\tv_accvgpr_read_b32 %3, %11\n\t"
                                 "v_accvgpr_read_b32 %4, %12\n\tv_accvgpr_read_b32 %5, %13\n\tv_accvgpr_read_b32 %6, %14\n\tv_accvgpr_read_b32 %7, %15"
                                 : "=v"(v0.x), "=v"(v0.y), "=v"(v0.z), "=v"(v0.w), "=v"(v1.x), "=v"(v1.y), "=v"(v1.z), "=v"(v1.w)
                                 : "a"(acc[ai][bj][m][0].x), "a"(acc[ai][bj][m][0].y), "a"(acc[ai][bj][m][0].z), "a"(acc[ai][bj][m][0].w),
                                   "a"(acc[ai][bj][m][1].x), "a"(acc[ai][bj][m][1].y), "a"(acc[ai][bj][m][1].z), "a"(acc[ai][bj][m][1].w));
                    f(u, ctx, ai, m, bj, ai * HALF + wr * 64 + m * 16 + fr, bj * HALF + wc * 32 + 4 * fq, v0, v1);
                }
    }
};
template <class PF, class F> __device__ __forceinline__ Epi<PF, F> make_epi(PF p, F f) { return Epi<PF, F>{p, f}; }
template <bool FP8 = false, class EpiT, class Sched>
__device__ __forceinline__ void gemm_phase(int tid, PG8_LAS unsigned char* lds, const Gemm g, const Sched& S, const EpiT& E) {
    const int wid = __builtin_amdgcn_readfirstlane(tid >> 6), lane = tid & 63, wr = wid >> 2, wc = wid & 3, fr = lane & 15, fq = lane >> 4;
    int K = g.K; asm volatile("" : "+s"(K));
    const int nt = K / BK;
    unsigned voffA[2], voffB[2];
#pragma unroll
    for (int i = 0; i < 2; ++i) { int R, C; stage_rc(tid * 16 + i * 8192, R, C); voffA[i] = (unsigned)(R * g.lda + C) * 2u; voffB[i] = (unsigned)(R * g.ldb + C) * 2u; }
    const size_t kstep = (size_t)(BK * 2);
    const size_t hstepA = (size_t)HALF * g.lda * 2, hstepB = (size_t)HALF * g.ldb * 2;
    const size_t tstepA = 2 * hstepA, tstepB = 2 * hstepB;
    const unsigned ldsw = (unsigned)wid * 1024u;
    const int aoff = lds_byte(wr * 64 + fr, fq * 8), boff = lds_byte(wc * 32 + fr, fq * 8);
#define PG8_SA(b, h) (((b) * 2 + (h)) * HTB)
#define PG8_SB(b, h) ((4 + (b) * 2 + (h)) * HTB)
#define PG8_STAGE(bufoff, gbase, voff) do { _Pragma("unroll") for (int _i = 0; _i < 2; ++_i) \
        __builtin_amdgcn_global_load_lds((const unsigned*)((const char*)(gbase) + (voff)[_i]), (PG8_LAS unsigned*)(lds + (bufoff) + ldsw + _i * 8192), 16, 0, 0); } while (0)
#define PG8_LDA(dst, b, h) do { _Pragma("unroll") for (int m = 0; m < 4; ++m) { dst[m].lo = *(const PG8_LAS v4i_t*)(lds + PG8_SA(b, h) + aoff + m * 2048); dst[m].hi = *(const PG8_LAS v4i_t*)(lds + PG8_SA(b, h) + aoff + m * 2048 + 1024); } } while (0)
#define PG8_LDB(dst, b, h) do { _Pragma("unroll") for (int n = 0; n < 2; ++n) { dst[n].lo = *(const PG8_LAS v4i_t*)(lds + PG8_SB(b, h) + boff + n * 2048); dst[n].hi = *(const PG8_LAS v4i_t*)(lds + PG8_SB(b, h) + boff + n * 2048 + 1024); } } while (0)
#define PG8_MMA(ai, bj, At, Bt) do { __builtin_amdgcn_s_setprio(1); _Pragma("unroll") for (int m = 0; m < 4; ++m) _Pragma("unroll") for (int n = 0; n < 2; ++n) { \
        if constexpr (FP8) { asm volatile("s_nop 1\n\tv_mfma_scale_f32_16x16x128_f8f6f4 %0, %1, %2, %0, %3, %4 op_sel_hi:[0,0,0]" : "+a"(acc[ai][bj][m][n]) : "v"(Bt[n].v), "v"(At[m].v), "v"(scw), "v"(scx)); } \
        else { asm volatile("s_nop 1\n\tv_mfma_f32_16x16x32_bf16 %0, %1, %2, %0\n\tv_mfma_f32_16x16x32_bf16 %0, %3, %4, %0" : "+a"(acc[ai][bj][m][n]) : "v"(Bt[n].lo), "v"(At[m].lo), "v"(Bt[n].hi), "v"(At[m].hi)); } } \
        __builtin_amdgcn_s_setprio(0); } while (0)
#define PG8_WAIT_V(n) asm volatile("s_waitcnt vmcnt(" #n ")" ::: "memory")
#define PG8_WAIT_L(n) asm volatile("s_waitcnt lgkmcnt(" #n ")" ::: "memory")
#define PG8_BAR __builtin_amdgcn_s_barrier()
#define PG8_SCHED __builtin_amdgcn_sched_barrier(0)
    Unit cur, nxt; int ui = 0;
    if (!S.next(0, cur)) return;
    f32x4 acc[2][2][4][2];
#pragma unroll
    for (int a = 0; a < 2; ++a)
#pragma unroll
        for (int b = 0; b < 2; ++b)
#pragma unroll
            for (int m = 0; m < 4; ++m)
#pragma unroll
                for (int n = 0; n < 2; ++n) acc[a][b][m][n] = (f32x4){0.f, 0.f, 0.f, 0.f};
    FragT At[4], B0[2], B1[2];
    int scw = (FP8 && PROBE_KX2) ? 0x79797979 : 0x7a7a7a7a, scx = 0x7f7f7f7f; asm volatile("" : "+v"(scw), "+v"(scx));
    const char* cA = (const char*)g.A + (size_t)cur.pm * tstepA; const char* cB = (const char*)g.Bt + (size_t)cur.pb * tstepB;
    PG8_STAGE(PG8_SB(0, 0), cB, voffB); PG8_STAGE(PG8_SB(0, 1), cB + hstepB, voffB); PG8_STAGE(PG8_SA(0, 0), cA, voffA); PG8_STAGE(PG8_SA(0, 1), cA + hstepA, voffA);
    if (wr == 1) PG8_BAR;
    PG8_WAIT_V(2); PG8_BAR;
    PG8_STAGE(PG8_SB(1, 0), cB + kstep, voffB); PG8_STAGE(PG8_SA(1, 0), cA + kstep, voffA); PG8_STAGE(PG8_SB(1, 1), cB + hstepB + kstep, voffB);
    PG8_WAIT_V(6); PG8_BAR;
    for (;;) {
        const bool has_next = S.next(ui + 1, nxt);
        const char* nA = has_next ? (const char*)g.A + (size_t)nxt.pm * tstepA : cA; const char* nB = has_next ? (const char*)g.Bt + (size_t)nxt.pb * tstepB : cB;
        constexpr int KX = (FP8 && PROBE_KX2) ? 2 : 1;
        for (int t = 0; t < KX * nt; t += 2) {
            const bool last = (t == KX * nt - 2);
            const char* a1 = cA + (size_t)((t + 1) % nt) * kstep;
            const char* a2 = last ? nA : cA + (size_t)((t + 2) % nt) * kstep; const char* b2 = last ? nB : cB + (size_t)((t + 2) % nt) * kstep;
            const char* a3 = a2 + kstep; const char* b3 = b2 + kstep;
            PG8_LDB(B0, 0, 0); PG8_LDB(B1, 0, 1); PG8_SCHED; PG8_LDA(At, 0, 0); PG8_STAGE(PG8_SA(1, 1), a1 + hstepA, voffA);
            PG8_WAIT_V(8); PG8_WAIT_L(0); PG8_BAR; PG8_MMA(0, 0, At, B0); PG8_MMA(0, 1, At, B1); PG8_BAR; PG8_SCHED;
            PG8_LDA(At, 0, 1); PG8_STAGE(PG8_SB(0, 0), b2, voffB); PG8_STAGE(PG8_SB(0, 1), b2 + hstepB, voffB); PG8_STAGE(PG8_SA(0, 0), a2, voffA);
            PG8_WAIT_V(8); PG8_WAIT_L(0); PG8_BAR; PG8_MMA(1, 0, At, B0); PG8_MMA(1, 1, At, B1); PG8_BAR; PG8_SCHED;
            PG8_LDB(B0, 1, 0); PG8_LDB(B1, 1, 1); PG8_SCHED; PG8_LDA(At, 1, 0); PG8_STAGE(PG8_SA(0, 1), a2 + hstepA, voffA);
            PG8_WAIT_V(8); PG8_WAIT_L(0); PG8_BAR; PG8_MMA(0, 0, At, B0); PG8_MMA(0, 1, At, B1); PG8_BAR; PG8_SCHED;
            PG8_LDA(At, 1, 1); PG8_STAGE(PG8_SB(1, 0), b3, voffB); PG8_STAGE(PG8_SB(1, 1), b3 + hstepB, voffB); PG8_STAGE(PG8_SA(1, 0), a3, voffA);
            PG8_WAIT_V(8); PG8_WAIT_L(0); PG8_BAR; PG8_MMA(1, 0, At, B0); PG8_MMA(1, 1, At, B1); PG8_BAR; PG8_SCHED;
        }
        const auto ectx = E.pre(cur, wr, wc, fr, fq);
        if (wr == 0) PG8_BAR;
        asm volatile("s_nop 15\n\ts_nop 15" ::: "memory");
        E(acc, ectx, cur, wr, wc, fr, fq);
        if (!has_next) break;
#pragma unroll
        for (int a = 0; a < 2; ++a)
#pragma unroll
            for (int b = 0; b < 2; ++b)
#pragma unroll
                for (int m = 0; m < 4; ++m)
#pragma unroll
                    for (int n = 0; n < 2; ++n) acc[a][b][m][n] = (f32x4){0.f, 0.f, 0.f, 0.f};
        cur = nxt; cA = nA; cB = nB; ++ui;
        if (wr == 1) PG8_BAR;
    }
    PG8_WAIT_V(0);
    PG8_BAR;
#undef PG8_SA
#undef PG8_SB
#undef PG8_STAGE
#undef PG8_LDA
#undef PG8_LDB
#undef PG8_MMA
#undef PG8_WAIT_V
#undef PG8_WAIT_L
#undef PG8_BAR
#undef PG8_SCHED
}
struct GridOrder {
    int nM, nN, nwg, G, c;
    __device__ __forceinline__ void init(int nM_, int nN_, int G_, int c_) { nM = nM_; nN = nN_; nwg = nM * nN; G = G_; c = c_; }
    __device__ __forceinline__ bool tile(int i, int& pm, int& pn) const {
        const long L = (long)i * G + c; if (L >= nwg) return false;
        int wgid = (int)L; { const int q = nwg / 8, r = nwg % 8, xcd = wgid % 8, off = wgid / 8; wgid = (xcd < r ? xcd * (q + 1) : r * (q + 1) + (xcd - r) * q) + off; }
        const int nig = 8 * nN, gid = wgid / nig, fm = gid * 8, gsz = (nM - fm) < 8 ? (nM - fm) : 8;
        pm = fm + ((wgid % nig) % gsz); pn = (wgid % nig) / gsz; return true;
    }
};
}


struct DenseOrder { pg8::GridOrder go;
    __device__ __forceinline__ bool next(int i, pg8::Unit& u) const { int pm, pn; if (!go.tile(i, pm, pn)) return false; u.pm = pm; u.pb = pn; u.pn = pn; u.aux = 0; return true; } };
struct MoeOrder { pg8::GridOrder go; const int* pst; int NT, ebase;
    __device__ __forceinline__ bool next(int i, pg8::Unit& u) const { int pm, pn; if (!go.tile(i, pm, pn)) return false; int e = 0;
#pragma unroll
        for (int q = 1; q < 32; ++q) e = (pm * 256 >= pst[q]) ? q : e;
        e = __builtin_amdgcn_readfirstlane(e);
        u.pm = pm; u.pn = pn; u.pb = (ebase + e) * NT + pn; u.aux = e; return true; } };
struct S5Order { int G, c;
    __device__ __forceinline__ bool next(int i, pg8::Unit& u) const { const int L = i * G + c; if (L >= 256) return false; const int g = L >> 3, pmL = (L >> 2) & 1, pnL = L & 3;
        u.pm = g * 2 + pmL; u.pb = g * 4 + pnL; u.pn = pnL; u.aux = g; return true; } };

__device__ __forceinline__ void transpose_item(const float* W, int K, int N, bf16_t* WT, int ldt, float* scr, int item, int lane, int mode) {
    const int nblk = N / 32, kb = item / nblk, nb = item % nblk, k0 = 64 * kb, n0 = 32 * nb;
#pragma unroll 8
    for (int i = 0; i < 32; ++i) { const int kk = 2 * i + (lane >> 5); scr[kk * 33 + (lane & 31)] = W[(size_t)(k0 + kk) * N + n0 + (lane & 31)]; }
    __builtin_amdgcn_s_waitcnt(0xC07F); asm volatile("" ::: "memory");
    const int c = lane & 7;
#pragma unroll
    for (int j = 0; j < 4; ++j) {
        const int n = (lane >> 3) + 8 * j; const float* s = scr + (8 * c) * 33 + n;
        u32x4 o; o.x = pk2(s[0 * 33], s[1 * 33]); o.y = pk2(s[2 * 33], s[3 * 33]); o.z = pk2(s[4 * 33], s[5 * 33]); o.w = pk2(s[6 * 33], s[7 * 33]);
        int nn = n0 + n;
        if (mode == 1) { const int half = nn >= 1024; const int jj = nn - half * 1024; nn = 32 * (jj >> 4) + 16 * half + (jj & 15); }
        *(u32x4*)(WT + (size_t)nn * ldt + k0 + 8 * c) = o;
    }
    __builtin_amdgcn_s_waitcnt(0xC07F); asm volatile("" ::: "memory");
}
__device__ __forceinline__ void transpose_item_fp8(const float* W, int K, int N, unsigned char* WT, float* scr, int item, int lane, int mode, float scale) {
    const int nblk = N / 32, kb = item / nblk, nb = item % nblk, k0 = 128 * kb, n0 = 32 * nb;
#pragma unroll 8
    for (int i = 0; i < 64; ++i) { const int kk = 2 * i + (lane >> 5); scr[kk * 33 + (lane & 31)] = W[(size_t)(k0 + kk) * N + n0 + (lane & 31)] * scale; }
    __builtin_amdgcn_s_waitcnt(0xC07F); asm volatile("" ::: "memory");
    const int c = lane & 7;
#pragma unroll
    for (int j = 0; j < 4; ++j) {
        const int n = (lane >> 3) + 8 * j; const float* s = scr + (16 * c) * 33 + n;
        u32x4 o; o.x = pk4_fp8(s[0 * 33], s[1 * 33], s[2 * 33], s[3 * 33]); o.y = pk4_fp8(s[4 * 33], s[5 * 33], s[6 * 33], s[7 * 33]);
        o.z = pk4_fp8(s[8 * 33], s[9 * 33], s[10 * 33], s[11 * 33]); o.w = pk4_fp8(s[12 * 33], s[13 * 33], s[14 * 33], s[15 * 33]);
        int nn = n0 + n;
        if (mode == 1) { const int half = nn >= 1024; const int jj = nn - half * 1024; nn = 32 * (jj >> 4) + 16 * half + (jj & 15); }
        *(u32x4*)(WT + (size_t)nn * K + k0 + 16 * c) = o;
    }
    __builtin_amdgcn_s_waitcnt(0xC07F); asm volatile("" ::: "memory");
}
__device__ __forceinline__ void transpose_many_fp8(const float* W, int nmat, int K, int N, unsigned char* WT, size_t dst_stride, float* scr, int gw, int NGW, int lane, int mode, float scale) {
    const int per = (K / 128) * (N / 32); const long tot = (long)nmat * per;
    for (long it = gw; it < tot; it += NGW) {
        const int mt = (int)(it / per), r = (int)(it % per);
        transpose_item_fp8(W + (size_t)mt * K * N, K, N, WT + (size_t)mt * dst_stride, scr, r, lane, mode, scale);
    }
}
__device__ __forceinline__ void transpose_many(const float* W, int nmat, int K, int N, bf16_t* WT, size_t dst_stride, float* scr, int gw, int NGW, int lane, int mode, int ldt = 0) {
    if (ldt == 0) ldt = K;
    const int per = (K / 64) * (N / 32); const long tot = (long)nmat * per;
    for (long it = gw; it < tot; it += NGW) {
        const int mt = (int)(it / per), r = (int)(it % per);
        transpose_item(W + (size_t)mt * K * N, K, N, WT + (size_t)mt * dst_stride, ldt, scr, r, lane, mode);
    }
}

__device__ __forceinline__ void norm_mod_store(f32x4 (&v)[4], const float* g, const float* sc, const float* sh, bf16_t* orow, unsigned char* orow8, int lane) {
    float s = 0.f;
#pragma unroll
    for (int j = 0; j < 4; ++j) s += (v[j].x * v[j].x + v[j].y * v[j].y) + (v[j].z * v[j].z + v[j].w * v[j].w);
    const float r = rsqrtf(wave_sum(s) * (1.0f / D) + 1e-6f);
#pragma unroll
    for (int j = 0; j < 4; ++j) {
        const int c = 4 * lane + 256 * j;
        const f32x4 gg = *(const f32x4*)(g + c), s1 = *(const f32x4*)(sc + c), s0 = *(const f32x4*)(sh + c);
        const float a = v[j].x * r * gg.x * (1.f + s1.x) + s0.x, b = v[j].y * r * gg.y * (1.f + s1.y) + s0.y,
                    cc = v[j].z * r * gg.z * (1.f + s1.z) + s0.z, d = v[j].w * r * gg.w * (1.f + s1.w) + s0.w;
        u32x2 o; o.x = pk2(a, b); o.y = pk2(cc, d);
        *(u32x2*)(orow + c) = o;
        if (orow8) *(unsigned*)(orow8 + c) = pk4_fp8(a, b, cc, d);
    }
}

template <int ph> __device__ __forceinline__ void phase_body() {
    extern __shared__ __attribute__((aligned(16))) unsigned char lds[];
    {
        int tid = threadIdx.x; asm volatile("" : "+v"(tid));
        int vb = blockIdx.x, G = gridDim.x; asm volatile("" : "+s"(vb), "+s"(G));
        const int lane = tid & 63, wave = tid >> 6;
        const int gw = vb * NWAVE + wave, NGW = G * NWAVE;
        const __attribute__((address_space(4))) Params* kp = (const __attribute__((address_space(4))) Params*)__builtin_amdgcn_kernarg_segment_ptr();
        asm volatile("" : "+s"(kp));
        unsigned char* ws = kp->ws;
        unsigned* ctl = (unsigned*)(ws + WS_CTL);
        float* MOD = (float*)(ws + WS_MOD);
        float* S5AB = (float*)(ws + WS_S5AB); float* S5BB = (float*)(ws + WS_S5AB + 65536);
        float* PW = (float*)(ws + WS_PW); float* KTAB = (float*)(ws + WS_KTAB);
        int* tok_e = (int*)(ws + WS_TOK); int* tok_pos = (int*)(ws + WS_TOK + 512 * 1024); float* tok_gate = (float*)(ws + WS_TOK + 1024 * 1024);
        int* row_slot = (int*)(ws + WS_ROW); float* row_gate = (float*)(ws + WS_ROW + MiB);
        float* LOGIT = (float*)(ws + WS_LOGIT);
        bf16_t* W_IN_E = (bf16_t*)(ws + WS_W_IN_E); bf16_t* W_UP = (bf16_t*)(ws + WS_W_UP); bf16_t* W_GLU = (bf16_t*)(ws + WS_W_GLU);
        bf16_t* W_OUT_E = (bf16_t*)(ws + WS_W_OUT_E); bf16_t* W_IN_O = (bf16_t*)(ws + WS_W_IN_O); bf16_t* W_OUT_O = (bf16_t*)(ws + WS_W_OUT_O);
        bf16_t* W_POOL = (bf16_t*)(ws + WS_W_POOL); bf16_t* W_SGU = (bf16_t*)(ws + WS_W_SGU); bf16_t* W_RT = (bf16_t*)(ws + WS_W_RT);
        bf16_t* BT_END = (bf16_t*)(ws + WS_BT_END); bf16_t* BT_MAIN = (bf16_t*)(ws + WS_BT_MAIN);
        unsigned char* W_GU = ws + WS_W_GU; unsigned char* W_DN = ws + WS_W_DN; unsigned char* HB8 = ws + WS_HB8;
        bf16_t* HB = (bf16_t*)(ws + WS_HB); bf16_t* MIXIN = (bf16_t*)(ws + WS_MIXIN); bf16_t* Y = (bf16_t*)(ws + WS_Y);
        unsigned char* XB = ws + WS_XB; unsigned char* ACT = ws + WS_ACT;
        bf16_t* Z = (bf16_t*)(ws + WS_Z); bf16_t* QKN = (bf16_t*)(ws + WS_QKN); bf16_t* QKVRAW = (bf16_t*)(ws + WS_QKVRAW);
        bf16_t* Qb = (bf16_t*)(ws + WS_Q); bf16_t* Kb = (bf16_t*)(ws + WS_K); bf16_t* VT = (bf16_t*)(ws + WS_VT);
        bf16_t* AS5 = (bf16_t*)(ws + WS_AS5); float* LEND = (float*)(ws + WS_LEND); bf16_t* GACT = (bf16_t*)(ws + WS_GACT);
        bf16_t* POOLED = (bf16_t*)(ws + WS_POOLED); bf16_t* VTS = (bf16_t*)(ws + WS_VTS);
        float* OUT = kp->out; const float* XIN = kp->x;
        const float* s5d = kp->s5_d; const float* glub = kp->s5_glu_b; const float* poolsc = kp->pool_scale; const float* sgub = kp->sgu_b;
        const float* bgu_all = kp->moe_b_gu; const float* bdn_all = kp->moe_b_dn; const float* rtb_all = kp->router_b;

        int layer = 0, mph = ph;
        if (ph >= 20 && ph <= 25) { layer = 1; mph = ph - 11; }
        const float* mod_l = MOD + (size_t)layer * NB * 6144;

        if (ph == 0) {
            const int gt = vb * NTHR + tid;
            if (gt < 2048) {
                const int g = gt >> 6, pp = gt & 63;
                const float dt = expf(kp->s5_log_dt[g]);
                const float lre = fminf(kp->s5_a_re[g * 64 + pp], -1e-4f), lim = kp->s5_a_im[g * 64 + pp];
                const float mag = expf(lre * dt);
                const float abr = mag * cosf(lim * dt), abi = mag * sinf(lim * dt);
                const float den = lre * lre + lim * lim, nr = abr - 1.0f;
                const float fre = (nr * lre + abi * lim) / den, fim = (abi * lre - nr * lim) / den;
                S5AB[(g * 64 + pp) * 2 + 0] = abr; S5AB[(g * 64 + pp) * 2 + 1] = abi;
                for (int j = 0; j < 16; ++j) {
                    const float br = kp->s5_b_re[(g * 64 + pp) * 16 + j], bi = kp->s5_b_im[(g * 64 + pp) * 16 + j];
                    S5BB[((g * 64 + pp) * 16 + j) * 2 + 0] = fre * br - fim * bi;
                    S5BB[((g * 64 + pp) * 16 + j) * 2 + 1] = fre * bi + fim * br;
                }
                float pr = 1.f, pi = 0.f;
                for (int tau = 0; tau <= 64; ++tau) {
                    PW[((g * 64 + pp) * 65 + tau) * 2 + 0] = pr; PW[((g * 64 + pp) * 65 + tau) * 2 + 1] = pi;
                    const float nr2 = pr * abr - pi * abi, ni2 = pr * abi + pi * abr; pr = nr2; pi = ni2;
                }
            }
            {
                float* ca = (float*)lds;
                for (int i = tid; i < NB * D; i += NTHR) { const float cv = kp->c[i]; ca[i] = cv * sigmoidf_(cv); }
                __syncthreads();
                for (int task = gw; task < 2 * 96; task += NGW) {
                    const int l = task / 96, cb = task % 96, col = cb * 64 + lane;
                    const float* W = kp->ada_w + (size_t)l * D * 6144 + col;
                    float acc[8];
#pragma unroll
                    for (int b = 0; b < 8; ++b) acc[b] = 0.f;
                    for (int k = 0; k < D; k += 8) {
                        float w[8];
#pragma unroll
                        for (int u = 0; u < 8; ++u) w[u] = W[(size_t)(k + u) * 6144];
#pragma unroll
                        for (int u = 0; u < 8; ++u)
#pragma unroll
                            for (int b = 0; b < 8; ++b) acc[b] += ca[b * D + k + u] * w[u];
                    }
                    const float bias = kp->ada_b[l * 6144 + col];
#pragma unroll
                    for (int b = 0; b < 8; ++b) MOD[((size_t)l * NB + b) * 6144 + col] = acc[b] + bias;
                }
                __syncthreads();
            }
            {
                float* scr = (float*)(lds + wave * 16384);
                transpose_many(kp->even_w_in, 1, 1024, 928, W_IN_E, 0, scr, gw, NGW, lane, 0);
                transpose_many(kp->w_uq, 1, 256, 768, W_UP, 0, scr, gw, NGW, lane, 0, 384);
                transpose_many(kp->w_ukv, 1, 128, 1024, W_UP + (size_t)768 * 384 + 256, 0, scr, gw, NGW, lane, 0, 384);
                for (int i = vb * NTHR + tid; i < 768 * 16 + 1024 * 32; i += G * NTHR) {
                    const u32x4 z = {0u, 0u, 0u, 0u};
                    if (i < 768 * 16) *(u32x4*)(W_UP + (size_t)(i >> 4) * 384 + 256 + (i & 15) * 8) = z;
                    else { const int q = i - 768 * 16; *(u32x4*)(W_UP + (size_t)(768 + (q >> 5)) * 384 + (q & 31) * 8) = z; }
                }
                transpose_many(kp->s5_glu_w, 1, 512, 512, W_GLU, 0, scr, gw, NGW, lane, 0);
                transpose_many(kp->even_w_out, 1, 1024, 1024, W_OUT_E, 0, scr, gw, NGW, lane, 0);
                transpose_many(kp->odd_w_in, 1, 1024, 1536, W_IN_O, 0, scr, gw, NGW, lane, 0);
                transpose_many(kp->odd_w_out, 1, 1024, 1024, W_OUT_O, 0, scr, gw, NGW, lane, 0);
                transpose_many(kp->pool_w, 4, 128, 128, W_POOL, 128 * 128, scr, gw, NGW, lane, 0);
                transpose_many(kp->router_w, 2, 1024, 32, W_RT, 128 * 1024, scr, gw, NGW, lane, 0);
                {
                    float* scr8 = (float*)(lds + wave * 16896);
                    transpose_many_fp8(kp->moe_w_gu, 64, 1024, 2048, W_GU, (size_t)2048 * 1024, scr8, gw, NGW, lane, 1, 32.0f);
                    transpose_many_fp8(kp->moe_w_dn, 64, 1024, 1024, W_DN, (size_t)1024 * 1024, scr8, gw, NGW, lane, 0, 32.0f);
                }
                for (int i = vb * NTHR + tid; i < 4 * 128 * 128; i += G * NTHR) {
                    const int t = (i >> 7) & 127, s_ = i & 127;
                    W_SGU[i] = (s_ <= t) ? f2bf(kp->sgu_w[i]) : (bf16_t)0;
                }
            }
        }
        else if (ph == 1 || ph == 9 || ph == 15 || ph == 20 || ph == 26) {
            const int lyr = (ph == 1 || ph == 9) ? 0 : 1;
            const bool combine = (ph == 15 || ph == 26), donorm = (ph != 26);
            const int comb_layer = (ph == 15) ? 0 : 1;
            const bool ffn = (ph == 9 || ph == 20);
            const float* src = (ph == 1) ? kp->x : kp->out;
            const float* ng = (ffn ? kp->norm_ffn_g : kp->norm_mix_g) + lyr * D;
            for (int row = gw; row < T; row += NGW) {
                const int b = row / S;
                f32x4 v[4];
#pragma unroll
                for (int j = 0; j < 4; ++j) v[j] = *(const f32x4*)(src + (size_t)row * D + 4 * lane + 256 * j);
                if (combine) {
                    const float* gf = MOD + ((size_t)comb_layer * NB + b) * 6144 + 5 * D;
#pragma unroll
                    for (int j = 0; j < 4; ++j) {
                        const int c = 4 * lane + 256 * j;
                        float a0 = 0.f, a1 = 0.f, a2 = 0.f, a3 = 0.f;
#pragma unroll
                        for (int k = 0; k < 4; ++k) {
                            const u32x2 yy = *(const u32x2*)(Y + ((size_t)row * 4 + k) * D + c);
                            a0 += __uint_as_float(yy.x << 16); a1 += __uint_as_float(yy.x & 0xffff0000u);
                            a2 += __uint_as_float(yy.y << 16); a3 += __uint_as_float(yy.y & 0xffff0000u);
                        }
                        const f32x4 g4 = *(const f32x4*)(gf + c);
                        v[j].x += g4.x * a0; v[j].y += g4.y * a1; v[j].z += g4.z * a2; v[j].w += g4.w * a3;
                        *(f32x4*)(kp->out + (size_t)row * D + c) = v[j];
                    }
                }
                if (donorm) {
                    const float* mm = MOD + ((size_t)lyr * NB + b) * 6144 + (ffn ? 3 * D : 0);
                    norm_mod_store(v, ng, mm + D, mm, HB + (size_t)row * D, ffn ? HB8 + (size_t)row * D : (unsigned char*)nullptr, lane);
                }
            }
            if (ph == 1) {
                for (int idx = vb * NTHR + tid; idx < 32 * 64 * 256; idx += G * NTHR) {
                    const int j = idx & 15, i = (idx >> 4) & 15, tau = (idx >> 8) & 63, g = idx >> 14;
                    float acc = 0.f;
                    for (int pp = 0; pp < 64; ++pp) {
                        const float cr = kp->s5_c_re[(g * 16 + i) * 64 + pp], ci = kp->s5_c_im[(g * 16 + i) * 64 + pp];
                        const float pr = PW[((g * 64 + pp) * 65 + tau) * 2], pi = PW[((g * 64 + pp) * 65 + tau) * 2 + 1];
                        const float br = S5BB[((g * 64 + pp) * 16 + j) * 2], bi = S5BB[((g * 64 + pp) * 16 + j) * 2 + 1];
                        const float qr = pr * br - pi * bi, qi = pr * bi + pi * br;
                        acc += cr * qr - ci * qi;
                    }
                    KTAB[idx] = acc;
                }
            }
        }
        else if (ph == 2) {
            {
                DenseOrder so; so.go.init(T / 256, 4, G, vb);
                auto f = [=](const pg8::Unit& u, const pg8::NoCtx&, int ai, int m, int bj, int r, int c, f32x4 v0, f32x4 v1) {
                        const int row = u.pm * 256 + r;
#pragma unroll
                        for (int h = 0; h < 2; ++h) {
                            const int col = u.pn * 256 + c + 16 * h; const f32x4 v = h ? v1 : v0;
                            u32x2 o; o.x = pk2(v.x, v.y); o.y = pk2(v.z, v.w);
                            if (col < 416) *(u32x2*)(Z + (size_t)row * 1024 + col) = o;
                            else if (col < 928) {
                                const int ch = col - 416, g = ch >> 4, j = ch & 15, b = row / S, t = row % S;
                                *(u32x2*)(AS5 + ((size_t)g * 512 + b * 64 + (t >> 6)) * 1152 + 128 + (t & 63) * 16 + j) = o;
                            }
                        }
                    };
                pg8::gemm_phase(tid, (PG8_LAS unsigned char*)lds, pg8::Gemm{HB, W_IN_E, D, D, D}, so, pg8::make_epi(pg8::NoPre{}, f));
            }
            for (int idx = vb * NTHR + tid; idx < 32 * 128 * 128; idx += G * NTHR) {
                const int k8 = idx & 127, n = (idx >> 7) & 127, g = idx >> 14;
                const int ri = n >> 6, pp = n & 63, s_ = k8 >> 1, j0 = (k8 & 1) * 8;
                const float pr = PW[((g * 64 + pp) * 65 + (63 - s_)) * 2], pi = PW[((g * 64 + pp) * 65 + (63 - s_)) * 2 + 1];
                float o[8];
#pragma unroll
                for (int j = 0; j < 8; ++j) {
                    const float br = S5BB[((g * 64 + pp) * 16 + j0 + j) * 2], bi = S5BB[((g * 64 + pp) * 16 + j0 + j) * 2 + 1];
                    o[j] = ri ? (pr * bi + pi * br) : (pr * br - pi * bi);
                }
                u32x4 w; w.x = pk2(o[0], o[1]); w.y = pk2(o[2], o[3]); w.z = pk2(o[4], o[5]); w.w = pk2(o[6], o[7]);
                *(u32x4*)(BT_END + ((size_t)g * 128 + n) * 1024 + k8 * 8) = w;
            }
            for (int idx = vb * NTHR + tid; idx < 32 * 1024 * 144; idx += G * NTHR) {
                const int k8 = idx % 144, n = (idx / 144) & 1023, g = idx / (144 * 1024);
                const int t = n >> 4, i = n & 15;
                float o[8];
                if (k8 < 16) {
                    const int ri = k8 >> 3, p0 = (k8 & 7) * 8;
#pragma unroll
                    for (int j = 0; j < 8; ++j) {
                        const int pp = p0 + j;
                        const float cr = kp->s5_c_re[(g * 16 + i) * 64 + pp], ci = kp->s5_c_im[(g * 16 + i) * 64 + pp];
                        const float pr = PW[((g * 64 + pp) * 65 + t + 1) * 2], pi = PW[((g * 64 + pp) * 65 + t + 1) * 2 + 1];
                        o[j] = ri ? -(cr * pi + ci * pr) : (cr * pr - ci * pi);
                    }
                } else {
                    const int kk = (k8 - 16) * 8, s_ = kk >> 4, j0 = kk & 15;
#pragma unroll
                    for (int j = 0; j < 8; ++j) o[j] = (s_ <= t) ? KTAB[((g * 64 + (t - s_)) * 16 + i) * 16 + j0 + j] : 0.f;
                }
                u32x4 w; w.x = pk2(o[0], o[1]); w.y = pk2(o[2], o[3]); w.z = pk2(o[4], o[5]); w.w = pk2(o[6], o[7]);
                *(u32x4*)(BT_MAIN + ((size_t)g * 1024 + n) * 1152 + k8 * 8) = w;
            }
        }
        else if (ph == 3) {
            for (int row = gw; row < T; row += NGW) {
                const u32x2 qv = *(const u32x2*)(Z + (size_t)row * 1024 + lane * 4);
                const unsigned kv = *(const unsigned*)(Z + (size_t)row * 1024 + 256 + lane * 2);
                const float q0 = __uint_as_float(qv.x << 16), q1 = __uint_as_float(qv.x & 0xffff0000u), q2 = __uint_as_float(qv.y << 16), q3 = __uint_as_float(qv.y & 0xffff0000u);
                const float k0 = __uint_as_float(kv << 16), k1 = __uint_as_float(kv & 0xffff0000u);
                const float rq = rsqrtf(wave_sum(q0 * q0 + q1 * q1 + q2 * q2 + q3 * q3) * (1.f / 256.f) + 1e-6f);
                const float rk = rsqrtf(wave_sum(k0 * k0 + k1 * k1) * (1.f / 128.f) + 1e-6f);
                const f32x4 gq = *(const f32x4*)(kp->q_norm_g + lane * 4);
                u32x2 o; o.x = pk2(q0 * rq * gq.x, q1 * rq * gq.y); o.y = pk2(q2 * rq * gq.z, q3 * rq * gq.w);
                *(u32x2*)(QKN + (size_t)row * 384 + lane * 4) = o;
                *(unsigned*)(QKN + (size_t)row * 384 + 256 + lane * 2) = pk2(k0 * rk * kp->kv_norm_g[lane * 2], k1 * rk * kp->kv_norm_g[lane * 2 + 1]);
            }
            for (int u = vb; u < 128; u += G) {
                const int g = u >> 2, pm = u & 3;
                sg_tile(tid, lds, AS5 + ((size_t)g * 512 + pm * 128) * 1152 + 128, 1152, BT_END + (size_t)g * 128 * 1024, 1024, 1024,
                    [=](int r, int c, f32x4 v0, f32x4 v1) {
                        float* o = LEND + ((size_t)g * 512 + pm * 128 + r) * 128 + c;
                        *(f32x4*)o = v0; *(f32x4*)(o + 16) = v1;
                    });
            }
        }
        else if (ph == 4) {
            {
                DenseOrder so; so.go.init(T / 256, 7, G, vb);
                auto f = [=](const pg8::Unit& u, const pg8::NoCtx&, int ai, int m, int bj, int r, int c, f32x4 v0, f32x4 v1) {
                            bf16_t* o = QKVRAW + (size_t)(u.pm * 256 + r) * 1792 + u.pn * 256 + c;
                            u32x2 a; a.x = pk2(v0.x, v0.y); a.y = pk2(v0.z, v0.w); *(u32x2*)o = a;
                            u32x2 b; b.x = pk2(v1.x, v1.y); b.y = pk2(v1.z, v1.w); *(u32x2*)(o + 16) = b;
                        };
                pg8::gemm_phase(tid, (PG8_LAS unsigned char*)lds, pg8::Gemm{QKN, W_UP, 384, 384, 384}, so, pg8::make_epi(pg8::NoPre{}, f));
            }
        }
        else if (ph == 5) {
            bf16_t* stq = (bf16_t*)(lds + 65536) + wave * 1536;
            bf16_t* vts = (bf16_t*)lds;
            const float qscale = 0.10206207261596577f * 1.4426950408889634f;
            for (int tile = vb; tile < T / 64; tile += G) {
                const int hh = lane >> 3, pp = lane & 7;
                for (int tt = 0; tt < 8; ++tt) {
                    const int tl = wave * 8 + tt, row = tile * 64 + tl, b = row / S, t = row % S;
                    float qv[12], kv[12];
#pragma unroll
                    for (int j = 0; j < 12; ++j) {
                        const int d = pp + 8 * j;
                        qv[j] = bf2f(QKVRAW[(size_t)row * 1792 + hh * 96 + d]);
                        kv[j] = (j < 8) ? bf2f(QKVRAW[(size_t)row * 1792 + 768 + hh * 128 + d]) : bf2f(Z[(size_t)row * 1024 + 384 + d - 64]);
                    }
                    float sq = 0.f, sk = 0.f;
#pragma unroll
                    for (int j = 0; j < 12; ++j) { sq += qv[j] * qv[j]; sk += kv[j] * kv[j]; }
                    sq += __shfl_xor(sq, 1); sq += __shfl_xor(sq, 2); sq += __shfl_xor(sq, 4);
                    sk += __shfl_xor(sk, 1); sk += __shfl_xor(sk, 2); sk += __shfl_xor(sk, 4);
                    const float rq = rsqrtf(sq * (1.f / 96.f) + 1e-6f), rk = rsqrtf(sk * (1.f / 96.f) + 1e-6f);
#pragma unroll
                    for (int j = 0; j < 12; ++j) { const int d = pp + 8 * j; qv[j] *= rq * kp->q_head_g[d]; kv[j] *= rk * kp->k_head_g[d]; }
                    const float posf = (float)kp->pos[row];
#pragma unroll
                    for (int e = 0; e < 2; ++e) {
                        const int i = pp + 8 * e;
                        const float invf = exp2f(-(float)i * (13.287712379549449f / 16.0f));
                        const float ang = posf * invf;
                        const float kq = rintf(ang * 0.15915494309189535f);
                        float rr = __builtin_fmaf(-kq, 6.28318548202514648f, ang); rr = __builtin_fmaf(-kq, -1.7484556e-7f, rr);
                        const float cs = __cosf(rr), sn = __sinf(rr);
                        const float q1 = qv[8 + e], q2 = qv[10 + e], k1 = kv[8 + e], k2 = kv[10 + e];
                        qv[8 + e] = q1 * cs - q2 * sn; qv[10 + e] = q1 * sn + q2 * cs;
                        kv[8 + e] = k1 * cs - k2 * sn; kv[10 + e] = k1 * sn + k2 * cs;
                    }
#pragma unroll
                    for (int j = 0; j < 12; ++j) { const int d = pp + 8 * j; stq[hh * 96 + d] = f2bf(qv[j] * qscale); stq[768 + hh * 96 + d] = f2bf(kv[j]); }
#pragma unroll
                    for (int j = 0; j < 8; ++j) { const int dv = pp + 8 * j; vts[(hh * 64 + dv) * 64 + tl] = QKVRAW[(size_t)row * 1792 + 768 + hh * 128 + 64 + dv]; }
                    __builtin_amdgcn_s_waitcnt(0xC07F); asm volatile("" ::: "memory");
                    for (int ch = lane; ch < 192; ch += 64) {
                        const int isk = ch >= 96, c2 = ch - 96 * isk, h2 = c2 / 12, part = c2 % 12;
                        const u32x4 vv = *(const u32x4*)(stq + isk * 768 + h2 * 96 + part * 8);
                        bf16_t* dst = (isk ? Kb : Qb) + (((size_t)b * 8 + h2) * S + t) * 96 + part * 8;
                        *(u32x4*)dst = vv;
                    }
                    __builtin_amdgcn_s_waitcnt(0xC07F); asm volatile("" ::: "memory");
                }
                __syncthreads();
                {
                    const int hd = tid, b = (tile * 64) / S, t0 = (tile * 64) % S;
                    bf16_t* dst = VT + (((size_t)b * 8 + (hd >> 6)) * 64 + (hd & 63)) * S + t0;
#pragma unroll
                    for (int i = 0; i < 8; ++i) *(u32x4*)(dst + i * 8) = *(const u32x4*)(vts + hd * 64 + i * 8);
                }
                __syncthreads();
            }
            for (int ch = vb * NTHR + tid; ch < NB * 32 * 64; ch += G * NTHR) {
                const int pp = ch & 63, g = (ch >> 6) & 31, b = ch >> 11;
                const float ar = PW[((g * 64 + pp) * 65 + 64) * 2], ai = PW[((g * 64 + pp) * 65 + 64) * 2 + 1];
                float cr = 0.f, ci = 0.f;
                for (int c = 0; c < 64; ++c) {
                    bf16_t* dst = AS5 + ((size_t)g * 512 + b * 64 + c) * 1152;
                    dst[pp] = f2bf(cr); dst[64 + pp] = f2bf(ci);
                    const float* le = LEND + ((size_t)g * 512 + b * 64 + c) * 128;
                    const float nr = ar * cr - ai * ci + le[pp], ni = ar * ci + ai * cr + le[64 + pp];
                    cr = nr; ci = ni;
                }
            }
        }
        else if (ph == 6) {
            unsigned char* Ks = lds;
            unsigned char* Vs = lds + 64 * 208;
            const int r32 = lane & 31, hi = lane >> 5;
            for (int ui = 0; ui < 4; ++ui) {
                if (vb >= 256) break;
                const int bh = vb & 63, kq = vb >> 6;
                const int qb = (ui == 0) ? 15 - kq : (ui == 1) ? 8 + kq : (ui == 2) ? 7 - kq : kq;
                const int q0 = qb * 256 + wave * 32;
                const bf16_t* Qg = Qb + ((size_t)bh * S + q0 + r32) * 96;
                const bf16_t* Kg = Kb + (size_t)bh * S * 96;
                const bf16_t* Vg = VT + (size_t)bh * 64 * S;
                bf16x8 qf[6];
#pragma unroll
                for (int d0 = 0; d0 < 6; ++d0) qf[d0] = *(const bf16x8*)(Qg + d0 * 16 + hi * 8);
                f32x16 o0, o1;
#pragma unroll
                for (int r = 0; r < 16; ++r) { o0[r] = 0.f; o1[r] = 0.f; }
                float m_run = -1e30f, l_run = 0.f;
                const int ntile = 4 * (qb + 1);
                u32x4 rk0, rk1, rv;
                const int kr0 = tid / 12, kc0 = tid % 12, kr1 = (tid + 512) / 12, kc1 = (tid + 512) % 12;
                const int vr = tid >> 3, vc = tid & 7;
                rk0 = *(const u32x4*)(Kg + (size_t)kr0 * 96 + kc0 * 8);
                if (tid < 256) rk1 = *(const u32x4*)(Kg + (size_t)kr1 * 96 + kc1 * 8);
                rv = *(const u32x4*)(Vg + (size_t)vr * S + vc * 8);
                for (int t = 0; t < ntile; ++t) {
                    __syncthreads();
                    *(u32x4*)(Ks + kr0 * 208 + kc0 * 16) = rk0;
                    if (tid < 256) *(u32x4*)(Ks + kr1 * 208 + kc1 * 16) = rk1;
                    { u32x2 a; a.x = rv.x; a.y = rv.y; u32x2 b2; b2.x = rv.z; b2.y = rv.w;
                      *(u32x2*)(Vs + vr * 136 + vc * 16) = a; *(u32x2*)(Vs + vr * 136 + vc * 16 + 8) = b2; }
                    __syncthreads();
                    if (t + 1 < ntile) {
                        rk0 = *(const u32x4*)(Kg + (size_t)((t + 1) * 64 + kr0) * 96 + kc0 * 8);
                        if (tid < 256) rk1 = *(const u32x4*)(Kg + (size_t)((t + 1) * 64 + kr1) * 96 + kc1 * 8);
                        rv = *(const u32x4*)(Vg + (size_t)vr * S + (t + 1) * 64 + vc * 8);
                    }
                    if (t * 64 > q0 + 31) continue;
                    f32x16 s0, s1;
#pragma unroll
                    for (int r = 0; r < 16; ++r) { s0[r] = 0.f; s1[r] = 0.f; }
#pragma unroll
                    for (int d0 = 0; d0 < 6; ++d0) {
                        const bf16x8 k0 = *(const bf16x8*)(Ks + r32 * 208 + d0 * 32 + hi * 16);
                        const bf16x8 k1 = *(const bf16x8*)(Ks + (32 + r32) * 208 + d0 * 32 + hi * 16);
                        s0 = __builtin_amdgcn_mfma_f32_32x32x16_bf16(k0, qf[d0], s0, 0, 0, 0);
                        s1 = __builtin_amdgcn_mfma_f32_32x32x16_bf16(k1, qf[d0], s1, 0, 0, 0);
                    }
                    if (t * 64 + 63 > q0) {
                        const int qi = q0 + r32;
#pragma unroll
                        for (int r = 0; r < 16; ++r) {
                            const int key = t * 64 + crow(r, hi);
                            if (key > qi) s0[r] = -INFINITY;
                            if (key + 32 > qi) s1[r] = -INFINITY;
                        }
                    }
                    float mx = s0[0];
#pragma unroll
                    for (int r = 1; r < 16; ++r) mx = fmaxf(mx, s0[r]);
#pragma unroll
                    for (int r = 0; r < 16; ++r) mx = fmaxf(mx, s1[r]);
                    mx = fmaxf(mx, __shfl_xor(mx, 32));
                    const float m_new = fmaxf(m_run, mx);
                    const float alpha = __builtin_amdgcn_exp2f(m_run - m_new);
                    m_run = m_new;
                    float ls = 0.f;
#pragma unroll
                    for (int r = 0; r < 16; ++r) { s0[r] = __builtin_amdgcn_exp2f(s0[r] - m_new); s1[r] = __builtin_amdgcn_exp2f(s1[r] - m_new); ls += s0[r] + s1[r]; }
                    l_run = l_run * alpha + ls;
#pragma unroll
                    for (int r = 0; r < 16; ++r) { o0[r] *= alpha; o1[r] *= alpha; }
                    bf16x8 pf[2][2];
#pragma unroll
                    for (int ks = 0; ks < 2; ++ks) {
                        u32x4 w0, w1;
                        w0.x = pk2(s0[8 * ks + 0], s0[8 * ks + 1]); w0.y = pk2(s0[8 * ks + 2], s0[8 * ks + 3]); w0.z = pk2(s0[8 * ks + 4], s0[8 * ks + 5]); w0.w = pk2(s0[8 * ks + 6], s0[8 * ks + 7]);
                        w1.x = pk2(s1[8 * ks + 0], s1[8 * ks + 1]); w1.y = pk2(s1[8 * ks + 2], s1[8 * ks + 3]); w1.z = pk2(s1[8 * ks + 4], s1[8 * ks + 5]); w1.w = pk2(s1[8 * ks + 6], s1[8 * ks + 7]);
                        pf[0][ks] = __builtin_bit_cast(bf16x8, w0); pf[1][ks] = __builtin_bit_cast(bf16x8, w1);
                    }
#pragma unroll
                    for (int kb = 0; kb < 2; ++kb)
#pragma unroll
                        for (int ks = 0; ks < 2; ++ks) {
                            const int koff = (kb * 32 + 16 * ks + 4 * hi) * 2;
#pragma unroll
                            for (int dvb = 0; dvb < 2; ++dvb) {
                                const unsigned char* vp = Vs + (dvb * 32 + r32) * 136 + koff;
                                const u32x2 lo = *(const u32x2*)vp, hi2 = *(const u32x2*)(vp + 16);
                                u32x4 w; w.x = lo.x; w.y = lo.y; w.z = hi2.x; w.w = hi2.y;
                                const bf16x8 vf = __builtin_bit_cast(bf16x8, w);
                                if (dvb == 0) o0 = __builtin_amdgcn_mfma_f32_32x32x16_bf16(vf, pf[kb][ks], o0, 0, 0, 0);
                                else o1 = __builtin_amdgcn_mfma_f32_32x32x16_bf16(vf, pf[kb][ks], o1, 0, 0, 0);
                            }
                        }
                }
                l_run += __shfl_xor(l_run, 32);
                const float rl = 1.0f / l_run;
                const int b = bh >> 3, h = bh & 7;
                bf16_t* orow = MIXIN + ((size_t)b * S + q0 + r32) * 1024 + h * 64;
#pragma unroll
                for (int rg = 0; rg < 4; ++rg) {
                    u32x2 a; a.x = pk2(o0[4 * rg] * rl, o0[4 * rg + 1] * rl); a.y = pk2(o0[4 * rg + 2] * rl, o0[4 * rg + 3] * rl);
                    *(u32x2*)(orow + 8 * rg + 4 * hi) = a;
                    u32x2 c2; c2.x = pk2(o1[4 * rg] * rl, o1[4 * rg + 1] * rl); c2.y = pk2(o1[4 * rg + 2] * rl, o1[4 * rg + 3] * rl);
                    *(u32x2*)(orow + 32 + 8 * rg + 4 * hi) = c2;
                }
            }
            __syncthreads();
            {
                S5Order so; so.G = G; so.c = vb;
                auto f = [=](const pg8::Unit& u, const pg8::NoCtx&, int ai, int m, int bj, int r, int c, f32x4 v0, f32x4 v1) {
                        const int g = u.aux, mr = (u.pm & 1) * 256 + r, b = mr >> 6, ck = mr & 63;
#pragma unroll
                        for (int h = 0; h < 2; ++h) {
                            const int n = u.pn * 256 + c + 16 * h; const f32x4 v = h ? v1 : v0;
                            const int tq = n >> 4, i = n & 15;
                            const u32x2 uu = *(const u32x2*)(AS5 + ((size_t)g * 512 + mr) * 1152 + 128 + n);
                            const f32x4 dd = *(const f32x4*)(s5d + g * 16 + i);
                            const float y0 = v.x + dd.x * __uint_as_float(uu.x << 16), y1 = v.y + dd.y * __uint_as_float(uu.x & 0xffff0000u),
                                        y2 = v.z + dd.z * __uint_as_float(uu.y << 16), y3 = v.w + dd.w * __uint_as_float(uu.y & 0xffff0000u);
                            u32x2 o; o.x = pk2(gelu_tanh(y0), gelu_tanh(y1)); o.y = pk2(gelu_tanh(y2), gelu_tanh(y3));
                            *(u32x2*)(GACT + ((size_t)b * S + ck * 64 + tq) * 512 + g * 16 + i) = o;
                        }
                    };
                pg8::gemm_phase(tid, (PG8_LAS unsigned char*)lds, pg8::Gemm{AS5, BT_MAIN, 1152, 1152, 1152}, so, pg8::make_epi(pg8::NoPre{}, f));
            }
        }
        else if (ph == 7) {
            {
                DenseOrder so; so.go.init(T / 256, 2, G, vb);
                auto f = [=](const pg8::Unit& u, const pg8::NoCtx&, int ai, int m, int bj, int r, int c, f32x4 v0, f32x4 v1) {
                        const int row = u.pm * 256 + r;
#pragma unroll
                        for (int h = 0; h < 2; ++h) {
                            const int col = u.pn * 256 + c + 16 * h; const f32x4 v = h ? v1 : v0;
                            const u32x2 gg = *(const u32x2*)(GACT + (size_t)row * 512 + col);
                            const f32x4 bb = *(const f32x4*)(glub + col);
                            const float g0 = __uint_as_float(gg.x << 16), g1 = __uint_as_float(gg.x & 0xffff0000u), g2 = __uint_as_float(gg.y << 16), g3 = __uint_as_float(gg.y & 0xffff0000u);
                            u32x2 o; o.x = pk2(g0 * sigmoidf_(v.x + bb.x), g1 * sigmoidf_(v.y + bb.y)); o.y = pk2(g2 * sigmoidf_(v.z + bb.z), g3 * sigmoidf_(v.w + bb.w));
                            *(u32x2*)(MIXIN + (size_t)row * 1024 + 512 + col) = o;
                        }
                    };
                pg8::gemm_phase(tid, (PG8_LAS unsigned char*)lds, pg8::Gemm{GACT, W_GLU, 512, 512, 512}, so, pg8::make_epi(pg8::NoPre{}, f));
            }
        }
        else if (ph == 8 || ph == 19) {
            const int lyr = (ph == 8) ? 0 : 1;
            const bf16_t* W = lyr ? W_OUT_O : W_OUT_E;
            const float* src = lyr ? OUT : XIN;
            {
                DenseOrder so; so.go.init(T / 256, 4, G, vb);
                auto f = [=](const pg8::Unit& u, const pg8::NoCtx&, int ai, int m, int bj, int r, int c, f32x4 v0, f32x4 v1) {
                        const int row = u.pm * 256 + r, b = row / S;
                        const float* gm = MOD + ((size_t)lyr * NB + b) * 6144 + 2 * D;
#pragma unroll
                        for (int h = 0; h < 2; ++h) {
                            const int col = u.pn * 256 + c + 16 * h; const f32x4 v = h ? v1 : v0;
                            const f32x4 xs = *(const f32x4*)(src + (size_t)row * D + col), g4 = *(const f32x4*)(gm + col);
                            f32x4 o; o.x = xs.x + g4.x * v.x; o.y = xs.y + g4.y * v.y; o.z = xs.z + g4.z * v.z; o.w = xs.w + g4.w * v.w;
                            *(f32x4*)(OUT + (size_t)row * D + col) = o;
                        }
                    };
                pg8::gemm_phase(tid, (PG8_LAS unsigned char*)lds, pg8::Gemm{MIXIN, W, D, D, D}, so, pg8::make_epi(pg8::NoPre{}, f));
            }
        }
        else if (mph == 10) {
            const bf16_t* W = W_RT + (size_t)layer * 128 * 1024;
            const float* rb = rtb_all + layer * 32;
            for (int u = vb; u < 256; u += G) {
                const int pm = u;
                sg_tile(tid, lds, HB + (size_t)pm * 128 * D, D, W, D, D,
                    [=](int r, int c, f32x4 v0, f32x4 v1) {
                        const int row = pm * 128 + r;
                        if (c < 32) {
                            const f32x4 b0 = *(const f32x4*)(rb + c), b1 = *(const f32x4*)(rb + c + 16);
                            f32x4 a = v0 + b0, bq = v1 + b1;
                            *(f32x4*)(LOGIT + (size_t)row * 32 + c) = a; *(f32x4*)(LOGIT + (size_t)row * 32 + c + 16) = bq;
                        }
                    });
            }
        }
        else if (mph == 11) {
            unsigned* hist = (unsigned*)lds;
            unsigned* gcnt = ctl + CW_CNT + layer * 64;
            for (int blk = vb; blk < T / NTHR; blk += G) {
                if (tid < 64) hist[tid] = 0u;
                __syncthreads();
                const int tok = blk * NTHR + tid;
                float lg[32];
#pragma unroll
                for (int i = 0; i < 8; ++i) { const f32x4 v = *(const f32x4*)(LOGIT + (size_t)tok * 32 + 4 * i); lg[4 * i] = v.x; lg[4 * i + 1] = v.y; lg[4 * i + 2] = v.z; lg[4 * i + 3] = v.w; }
                int e4[4]; float v4[4];
#pragma unroll
                for (int k = 0; k < 4; ++k) {
                    float best = -INFINITY; int bi = 0;
#pragma unroll
                    for (int e = 0; e < 32; ++e) { const bool tk = lg[e] > best; best = tk ? lg[e] : best; bi = tk ? e : bi; }
                    e4[k] = bi; v4[k] = best;
#pragma unroll
                    for (int e = 0; e < 32; ++e) lg[e] = (e == bi) ? -INFINITY : lg[e];
                }
                float den = 0.f, ex[4];
#pragma unroll
                for (int k = 0; k < 4; ++k) { ex[k] = __expf(v4[k] - v4[0]); den += ex[k]; }
                unsigned lp[4];
#pragma unroll
                for (int k = 0; k < 4; ++k) lp[k] = atomicAdd(hist + e4[k], 1u);
                __syncthreads();
                if (tid < 32) hist[32 + tid] = atomicAdd(gcnt + tid, (unsigned)hist[tid]);
                __syncthreads();
#pragma unroll
                for (int k = 0; k < 4; ++k) {
                    tok_e[tok * 4 + k] = e4[k]; tok_pos[tok * 4 + k] = (int)(hist[32 + e4[k]] + lp[k]); tok_gate[tok * 4 + k] = ex[k] / den;
                }
                __syncthreads();
            }
        }
        else if (mph == 12 || mph == 13 || mph == 14) {
            int* pst = (int*)(lds + 140 * 1024 - 1024);
            if (tid == 0) {
                const unsigned* gcnt = ctl + CW_CNT + layer * 64; int acc = 0;
                for (int e = 0; e < 32; ++e) { const int c = (int)gcnt[e]; pst[e] = acc; pst[64 + e] = c; acc += (c + 255) & ~255; }
                pst[32] = acc;
            }
            __syncthreads();
            const int total_rows = pst[32];
            if (mph == 12) {
                for (int it = gw; it < T * 4; it += NGW) {
                    const int tok = it >> 2, e = tok_e[it], row = pst[e] + tok_pos[it];
                    const u32x4* s = (const u32x4*)(HB8 + (size_t)tok * D);
                    u32x4* d = (u32x4*)(XB + (size_t)row * D);
                    d[lane] = s[lane];
                    if (lane == 0) { row_slot[row] = it; row_gate[row] = tok_gate[it]; }
                }
                for (int e = 0; e < 32; ++e) {
                    const int lo = pst[e] + pst[64 + e], hi2 = pst[e + 1];
                    for (int r = lo + vb * NTHR + tid; r < hi2; r += G * NTHR) { row_slot[r] = -1; row_gate[r] = 0.f; }
                }
            } else if (mph == 13) {
                {
                    MoeOrder so; so.go.init(total_rows >> 8, 8, G, vb); so.pst = pst; so.NT = 8; so.ebase = layer * 32;
                    struct G1Ctx { f32x4 b0[2], b1[2]; };
                    auto pre = [=](const pg8::Unit& u, int wr, int wc, int fr, int fq) {
                            G1Ctx cx; const float* bg = bgu_all + (size_t)(layer * 32 + u.aux) * 2048;
#pragma unroll
                            for (int bj = 0; bj < 2; ++bj) { const int cc = u.pn * 256 + bj * 128 + wc * 32 + 4 * fq, j = (cc >> 5) * 16 + (cc & 15);
                                cx.b0[bj] = *(const f32x4*)(bg + j); cx.b1[bj] = *(const f32x4*)(bg + 1024 + j); }
                            return cx; };
                    auto f = [=](const pg8::Unit& u, const G1Ctx& cx, int ai, int m, int bj, int r, int c, f32x4 v0, f32x4 v1) {
                            const int row0 = u.pm * 256, cc = u.pn * 256 + c;
                            const int j = (cc >> 5) * 16 + (cc & 15);
                            const f32x4 b0 = cx.b0[bj], b1 = cx.b1[bj];
                            float o[4];
#pragma unroll
                            for (int i = 0; i < 4; ++i) {
                                const float gt = fminf(v0[i] + b0[i], 7.0f), ln = fminf(fmaxf(v1[i] + b1[i], -7.0f), 7.0f);
                                o[i] = gt * sigmoidf_(1.702f * gt) * (ln + 1.0f);
                            }
                            *(unsigned*)(ACT + (size_t)(row0 + r) * D + j) = pk4_fp8(o[0], o[1], o[2], o[3]);
                        };
                    pg8::gemm_phase<true>(tid, (PG8_LAS unsigned char*)lds, pg8::Gemm{(const bf16_t*)XB, (const bf16_t*)W_GU, 512, 512, 512}, so, pg8::make_epi(pre, f));
                }
            } else {
                {
                    MoeOrder so; so.go.init(total_rows >> 8, 4, G, vb); so.pst = pst; so.NT = 4; so.ebase = layer * 32;
                    struct G2Ctx { int slot[8]; float gate[8]; f32x4 bb[2][2]; };
                    auto pre = [=](const pg8::Unit& u, int wr, int wc, int fr, int fq) {
                            G2Ctx cx; const float* bd = bdn_all + (size_t)(layer * 32 + u.aux) * 1024;
#pragma unroll
                            for (int q = 0; q < 8; ++q) { const int row = u.pm * 256 + (q >> 2) * 128 + wr * 64 + (q & 3) * 16 + fr; cx.slot[q] = row_slot[row]; cx.gate[q] = row_gate[row]; }
#pragma unroll
                            for (int bj = 0; bj < 2; ++bj)
#pragma unroll
                                for (int h = 0; h < 2; ++h) cx.bb[bj][h] = *(const f32x4*)(bd + u.pn * 256 + bj * 128 + wc * 32 + 4 * fq + 16 * h);
                            return cx; };
                    auto f = [=](const pg8::Unit& u, const G2Ctx& cx, int ai, int m, int bj, int r, int c, f32x4 v0, f32x4 v1) {
                            const int slot = cx.slot[ai * 4 + m];
                            if (slot >= 0) {
                                const float gt = cx.gate[ai * 4 + m];
#pragma unroll
                                for (int h = 0; h < 2; ++h) {
                                    const int col = u.pn * 256 + c + 16 * h; const f32x4 v = h ? v1 : v0;
                                    const f32x4 bb = cx.bb[bj][h];
                                    u32x2 o; o.x = pk2((v.x + bb.x) * gt, (v.y + bb.y) * gt); o.y = pk2((v.z + bb.z) * gt, (v.w + bb.w) * gt);
                                    *(u32x2*)(Y + (size_t)slot * D + col) = o;
                                }
                            }
                        };
                    pg8::gemm_phase<true>(tid, (PG8_LAS unsigned char*)lds, pg8::Gemm{(const bf16_t*)ACT, (const bf16_t*)W_DN, 512, 512, 512}, so, pg8::make_epi(pre, f));
                }
            }
        }
        else if (ph == 16) {
            {
                DenseOrder so; so.go.init(T / 256, 6, G, vb);
                auto f = [=](const pg8::Unit& u, const pg8::NoCtx&, int ai, int m, int bj, int r, int c, f32x4 v0, f32x4 v1) {
                        const int row = u.pm * 256 + r;
#pragma unroll
                        for (int h = 0; h < 2; ++h) {
                            const int col = u.pn * 256 + c + 16 * h; f32x4 v = h ? v1 : v0;
                            if (col >= 512) { v.x = gelu_tanh(v.x); v.y = gelu_tanh(v.y); v.z = gelu_tanh(v.z); v.w = gelu_tanh(v.w); }
                            u32x2 o; o.x = pk2(v.x, v.y); o.y = pk2(v.z, v.w);
                            *(u32x2*)(Z + (size_t)row * 1536 + col) = o;
                        }
                    };
                pg8::gemm_phase(tid, (PG8_LAS unsigned char*)lds, pg8::Gemm{HB, W_IN_O, D, D, D}, so, pg8::make_epi(pg8::NoPre{}, f));
            }
        }
        else if (ph == 17) {
            for (int ck = vb; ck < T / 128; ck += G) {
                bf16_t* tile = (bf16_t*)lds;
                for (int tt = 0; tt < 16; ++tt) {
                    const int sl = wave * 16 + tt, row = ck * 128 + sl, t = row % S;
                    {
                        const int ch0 = lane * 8, w = 2 << (ch0 >> 7);
                        float acc[8], own[8];
#pragma unroll
                        for (int i = 0; i < 8; ++i) acc[i] = 0.f;
                        const int n = (t + 1 < w) ? t + 1 : w;
                        for (int q = 0; q < n; ++q) {
                            const u32x4 uv = *(const u32x4*)(Z + (size_t)(row - q) * 1536 + ch0);
                            const float f[8] = {__uint_as_float(uv.x << 16), __uint_as_float(uv.x & 0xffff0000u), __uint_as_float(uv.y << 16), __uint_as_float(uv.y & 0xffff0000u),
                                                __uint_as_float(uv.z << 16), __uint_as_float(uv.z & 0xffff0000u), __uint_as_float(uv.w << 16), __uint_as_float(uv.w & 0xffff0000u)};
#pragma unroll
                            for (int i = 0; i < 8; ++i) { acc[i] += f[i]; if (q == 0) own[i] = f[i]; }
                        }
                        const float inv = 1.0f / (float)n;
                        u32x4 o; o.x = pk2(acc[0] * inv - own[0], acc[1] * inv - own[1]); o.y = pk2(acc[2] * inv - own[2], acc[3] * inv - own[3]);
                        o.z = pk2(acc[4] * inv - own[4], acc[5] * inv - own[5]); o.w = pk2(acc[6] * inv - own[6], acc[7] * inv - own[7]);
                        *(u32x4*)(POOLED + (size_t)row * 512 + ch0) = o;
                    }
                    {
                        const u32x4 uv = *(const u32x4*)(Z + (size_t)row * 1536 + 1024 + lane * 8);
                        float f[8] = {__uint_as_float(uv.x << 16), __uint_as_float(uv.x & 0xffff0000u), __uint_as_float(uv.y << 16), __uint_as_float(uv.y & 0xffff0000u),
                                      __uint_as_float(uv.z << 16), __uint_as_float(uv.z & 0xffff0000u), __uint_as_float(uv.w << 16), __uint_as_float(uv.w & 0xffff0000u)};
                        float ss = 0.f;
#pragma unroll
                        for (int i = 0; i < 8; ++i) ss += f[i] * f[i];
                        const float rr = rsqrtf(wave_sum(ss) * (1.f / 512.f) + 1e-6f);
                        u32x4 o;
                        const float* gg = kp->sgu_norm_g + lane * 8;
                        o.x = pk2(f[0] * rr * gg[0], f[1] * rr * gg[1]); o.y = pk2(f[2] * rr * gg[2], f[3] * rr * gg[3]);
                        o.z = pk2(f[4] * rr * gg[4], f[5] * rr * gg[5]); o.w = pk2(f[6] * rr * gg[6], f[7] * rr * gg[7]);
                        *(u32x4*)(tile + sl * 520 + lane * 8) = o;
                    }
                }
                __syncthreads();
                {
                    const int ch = tid;
                    bf16_t* dst = VTS + ((size_t)ck * 512 + ch) * 128;
                    for (int s8 = 0; s8 < 16; ++s8) {
                        unsigned w[4];
#pragma unroll
                        for (int i = 0; i < 4; ++i) w[i] = (unsigned)tile[(s8 * 8 + 2 * i) * 520 + ch] | ((unsigned)tile[(s8 * 8 + 2 * i + 1) * 520 + ch] << 16);
                        u32x4 o; o.x = w[0]; o.y = w[1]; o.z = w[2]; o.w = w[3];
                        *(u32x4*)(dst + s8 * 8) = o;
                    }
                }
                __syncthreads();
            }
        }
        else if (ph == 18) {
            for (int u = vb; u < 2048; u += G) {
                if (u < 1024) {
                    const int pm = u >> 2, gi = u & 3;
                    sg_tile(tid, lds, POOLED + (size_t)pm * 128 * 512 + gi * 128, 512, W_POOL + (size_t)gi * 128 * 128, 128, 128,
                        [=](int r, int c, f32x4 v0, f32x4 v1) {
                            const int row = pm * 128 + r;
#pragma unroll
                            for (int h = 0; h < 2; ++h) {
                                const int col = gi * 128 + c + 16 * h; const f32x4 v = h ? v1 : v0;
                                const f32x4 sc = *(const f32x4*)(poolsc + col);
                                u32x2 o; o.x = pk2(v.x * sc.x, v.y * sc.y); o.y = pk2(v.z * sc.z, v.w * sc.w);
                                *(u32x2*)(MIXIN + (size_t)row * 1024 + col) = o;
                            }
                        });
                } else {
                    const int uu = u - 1024, ck = uu >> 2, h4 = uu & 3;
                    sg_tile(tid, lds, W_SGU + (size_t)h4 * 128 * 128, 128, VTS + ((size_t)ck * 512 + h4 * 128) * 128, 128, 128,
                        [=](int r, int c, f32x4 v0, f32x4 v1) {
                            const int row = ck * 128 + r;
                            const float bias = sgub[h4 * 128 + r];
#pragma unroll
                            for (int h = 0; h < 2; ++h) {
                                const int dcol = c + 16 * h; const f32x4 v = h ? v1 : v0;
                                const u32x2 ug = *(const u32x2*)(Z + (size_t)row * 1536 + 512 + h4 * 128 + dcol);
                                u32x2 o; o.x = pk2((v.x + bias) * __uint_as_float(ug.x << 16), (v.y + bias) * __uint_as_float(ug.x & 0xffff0000u));
                                o.y = pk2((v.z + bias) * __uint_as_float(ug.y << 16), (v.w + bias) * __uint_as_float(ug.y & 0xffff0000u));
                                *(u32x2*)(MIXIN + (size_t)row * 1024 + 512 + h4 * 128 + dcol) = o;
                            }
                        });
                }
            }
        }

    }
}
template <int PH> struct PhaseSeq {
    static __device__ __forceinline__ void run(const XcdBarrier& bar) { PhaseSeq<PH - 1>::run(bar); phase_body<PH>();
        if constexpr (((PROBE_DUP_MASK >> PH) & 1ull) != 0) { xcd_barrier(bar); phase_body<PH>(); }
        if (PH + 1 < NPHASE) xcd_barrier(bar); }
};
template <> struct PhaseSeq<-1> { static __device__ __forceinline__ void run(const XcdBarrier&) {} };

template <int PHSEL> __global__ void __launch_bounds__(NTHR, 2) hybrid_fwd(Params p) {
    extern __shared__ __attribute__((aligned(16))) unsigned char lds[];
    const int tid0 = threadIdx.x;
    for (int u = tid0; u < (LDS_BYTES - LDS_MISC) / 4; u += NTHR) ((unsigned*)(lds + LDS_MISC))[u] = 0u;
    __syncthreads();
    if constexpr (PHSEL >= 0) { phase_body<PHSEL>(); }
    else {
        volatile LAS unsigned* MISC = (volatile LAS unsigned*)((LAS unsigned char*)lds + LDS_MISC);
        unsigned* ctl0 = (unsigned*)(p.ws + WS_CTL);
        XcdBarrier bar = xcd_barrier_post(ctl0 + CW_BAR, MISC + 8);
        PhaseSeq<NPHASE - 1>::run(bar);
    }
}

typedef void (*kfn_t)(Params);
template <int PH> struct Tab { static void fill(kfn_t* t) { t[PH] = hybrid_fwd<PH>; Tab<PH - 1>::fill(t); } };
template <> struct Tab<-1> { static void fill(kfn_t*) {} };
static kfn_t g_tab[NPHASE];
static void set_attrs() {
#if MK_ONE_LAUNCH
    (void)hipFuncSetAttribute((const void*)hybrid_fwd<-1>, hipFuncAttributeMaxDynamicSharedMemorySize, LDS_BYTES);
#else
    Tab<NPHASE - 1>::fill(g_tab);
    for (int i = 0; i < NPHASE; ++i) (void)hipFuncSetAttribute((const void*)g_tab[i], hipFuncAttributeMaxDynamicSharedMemorySize, LDS_BYTES);
#endif
}
#if !MK_ONE_LAUNCH
static void launch_all(const Params& p, int grid, hipStream_t stream) {
    for (int ph = 0; ph < NPHASE; ++ph) hipLaunchKernelGGL(g_tab[ph], dim3(grid), dim3(NTHR), LDS_BYTES, stream, p);
}
#endif
extern "C" void kernel_launch(void* const* d_in, const int* in_sizes, int n_in, void* d_out, int out_size, void* d_ws, size_t ws_size, hipStream_t stream) {
    static int ready = 0;
    if (ready == 0) {
        if (n_in != 38 || ws_size < WS_END) { fprintf(stderr, "kernel_launch: unexpected n_in %d / ws %zu\n", n_in, ws_size); ready = -1; return; }
        set_attrs();
        ready = 1;
    }
    if (ready < 0) return;
    (void)hipMemsetAsync((char*)d_ws + WS_CTL, 0, CTL_ZERO_BYTES, stream);
    Params p{};
    const float** fp = (const float**)&p.x;
    (void)fp;
    p.x = (const float*)d_in[0]; p.c = (const float*)d_in[1]; p.pos = (const int*)d_in[2];
    p.ada_w = (const float*)d_in[3]; p.ada_b = (const float*)d_in[4]; p.norm_mix_g = (const float*)d_in[5]; p.norm_ffn_g = (const float*)d_in[6];
    p.router_w = (const float*)d_in[7]; p.router_b = (const float*)d_in[8]; p.moe_w_gu = (const float*)d_in[9]; p.moe_b_gu = (const float*)d_in[10];
    p.moe_w_dn = (const float*)d_in[11]; p.moe_b_dn = (const float*)d_in[12];
    p.even_w_in = (const float*)d_in[13]; p.q_norm_g = (const float*)d_in[14]; p.w_uq = (const float*)d_in[15]; p.kv_norm_g = (const float*)d_in[16];
    p.w_ukv = (const float*)d_in[17]; p.q_head_g = (const float*)d_in[18]; p.k_head_g = (const float*)d_in[19];
    p.s5_a_re = (const float*)d_in[20]; p.s5_a_im = (const float*)d_in[21]; p.s5_log_dt = (const float*)d_in[22]; p.s5_b_re = (const float*)d_in[23];
    p.s5_b_im = (const float*)d_in[24]; p.s5_c_re = (const float*)d_in[25]; p.s5_c_im = (const float*)d_in[26]; p.s5_d = (const float*)d_in[27];
    p.s5_glu_w = (const float*)d_in[28]; p.s5_glu_b = (const float*)d_in[29]; p.even_w_out = (const float*)d_in[30];
    p.odd_w_in = (const float*)d_in[31]; p.pool_w = (const float*)d_in[32]; p.pool_scale = (const float*)d_in[33]; p.sgu_norm_g = (const float*)d_in[34];
    p.sgu_w = (const float*)d_in[35]; p.sgu_b = (const float*)d_in[36]; p.odd_w_out = (const float*)d_in[37];
    p.out = (float*)d_out; p.ws = (unsigned char*)d_ws;
    const int grid = 256;
#if MK_ONE_LAUNCH
    p.ph_lo = 0; p.ph_hi = NPHASE;
    hipLaunchKernelGGL(hybrid_fwd<-1>, dim3(grid), dim3(NTHR), LDS_BYTES, stream, p);
#else
    p.ph_lo = 0; p.ph_hi = 1;
    launch_all(p, grid, stream);
#endif
}
```

```cpp
#include <hip/hip_runtime.h>
#include <cstdio>
#include <cstdint>

#ifndef PROBE_DUP_MASK
#define PROBE_DUP_MASK 0x0ull
#endif
#ifndef PROBE_EPI2
#define PROBE_EPI2 0
#endif
#ifndef PROBE_KX2
#define PROBE_KX2 0
#endif
#ifndef MK_ONE_LAUNCH
#define MK_ONE_LAUNCH 1
#endif

typedef unsigned short bf16_t;
typedef short bf16x8 __attribute__((ext_vector_type(8)));
typedef short s16x4 __attribute__((ext_vector_type(4)));
typedef float f32x4 __attribute__((ext_vector_type(4)));
typedef float f32x16 __attribute__((ext_vector_type(16)));
typedef unsigned u32x4 __attribute__((ext_vector_type(4)));
typedef unsigned u32x2 __attribute__((ext_vector_type(2)));

constexpr int D = 1024, NB = 8, S = 4096, T = NB * S;
constexpr int NTHR = 512, NWAVE = 8;
constexpr int MOE_ROWS = 139264;
constexpr int NPHASE = 21;

constexpr size_t MiB = 1u << 20;
constexpr size_t WS_CTL = 0, CTL_ZERO_BYTES = 1 * MiB;
constexpr size_t WS_MOD = 1 * MiB;
constexpr size_t WS_S5AB = 2 * MiB;
constexpr size_t WS_PW = 3 * MiB;
constexpr size_t WS_KTAB = 5 * MiB;
constexpr size_t WS_TOK = 7 * MiB;
constexpr size_t WS_ROW = 9 * MiB;
constexpr size_t WS_LOGIT = 11 * MiB;
constexpr size_t WS_W_IN_E = 16 * MiB, WS_W_UP = 18 * MiB  , WS_W_GLU = 20 * MiB, WS_W_OUT_E = 21 * MiB, WS_W_IN_O = 23 * MiB,
                 WS_W_OUT_O = 26 * MiB, WS_W_POOL = 28 * MiB, WS_W_SGU = 29 * MiB, WS_W_RT = 30 * MiB;
constexpr size_t WS_BT_END = 32 * MiB;
constexpr size_t WS_BT_MAIN = 40 * MiB;
constexpr size_t WS_W_GU = 112 * MiB;
constexpr size_t WS_W_DN = 240 * MiB;
constexpr size_t WS_HB8 = 304 * MiB;
constexpr size_t WS_HB = 496 * MiB;
constexpr size_t WS_MIXIN = 560 * MiB;
constexpr size_t WS_Y = 624 * MiB;
constexpr size_t WS_EL = 880 * MiB;
constexpr size_t WS_ACT = 1152 * MiB;
constexpr size_t WS_END = 1424 * MiB;
constexpr size_t WS_Z = 880 * MiB;
constexpr size_t WS_QKN = 976 * MiB  , WS_QKVRAW = 1000 * MiB  , WS_Q = 1112 * MiB, WS_K = 1160 * MiB, WS_VT = 1208 * MiB,
                 WS_AS5 = 1240 * MiB, WS_LEND = 1276 * MiB, WS_GACT = 1284 * MiB;
constexpr size_t WS_POOLED = 976 * MiB, WS_VTS = 1008 * MiB;
constexpr int CW_BAR = 4096, CW_CNT = 16384;

constexpr int LDS_BYTES = 152 * 1024;
constexpr int LDS_MISC = 148 * 1024;

struct Params {
    const float *x, *c; const int* pos;
    const float *ada_w, *ada_b, *norm_mix_g, *norm_ffn_g, *router_w, *router_b, *moe_w_gu, *moe_b_gu, *moe_w_dn, *moe_b_dn;
    const float *even_w_in, *q_norm_g, *w_uq, *kv_norm_g, *w_ukv, *q_head_g, *k_head_g;
    const float *s5_a_re, *s5_a_im, *s5_log_dt, *s5_b_re, *s5_b_im, *s5_c_re, *s5_c_im, *s5_d, *s5_glu_w, *s5_glu_b, *even_w_out;
    const float *odd_w_in, *pool_w, *pool_scale, *sgu_norm_g, *sgu_w, *sgu_b, *odd_w_out;
    float* out; unsigned char* ws; int ph_lo, ph_hi;
};

__device__ __forceinline__ float bf2f(unsigned short b) { return __uint_as_float(((unsigned)b) << 16); }
__device__ __forceinline__ unsigned pk2(float lo, float hi) {
    typedef float f2 __attribute__((ext_vector_type(2))); typedef __bf16 b2 __attribute__((ext_vector_type(2)));
    f2 v = {lo, hi}; b2 b = __builtin_convertvector(v, b2); return __builtin_bit_cast(unsigned, b);
}
__device__ __forceinline__ unsigned short f2bf(float f) { return (unsigned short)(pk2(f, 0.f) & 0xffffu); }
__device__ __forceinline__ float wave_sum(float v) {
#pragma unroll
    for (int o = 1; o < 64; o <<= 1) v += __shfl_xor(v, o);
    return v;
}
__device__ __forceinline__ float sigmoidf_(float x) { return __builtin_amdgcn_rcpf(1.0f + __builtin_amdgcn_exp2f(-1.4426950408889634f * x)); }
__device__ __forceinline__ float gelu_tanh(float x) {
    const float u = 0.7978845608028654f * (x + 0.044715f * x * x * x);
    return x * sigmoidf_(2.0f * u);
}
__device__ __forceinline__ unsigned pk4_fp8(float a, float b, float c, float d) {
    int w = 0; w = __builtin_amdgcn_cvt_pk_fp8_f32(a, b, w, false); w = __builtin_amdgcn_cvt_pk_fp8_f32(c, d, w, true); return (unsigned)w;
}
__device__ __forceinline__ int crow(int r, int hi) { return (r & 3) + 8 * (r >> 2) + 4 * hi; }

#define LAS __attribute__((address_space(3)))
#define XB_TMO      128
#define XB_XCNT(j)  (256  + 64 * (j))
#define XB_XSUB(j)  (1280 + 64 * (j))
#define XB_XGEN(j)  (2304 + 64 * (j))
#define XB_TOP      3328
#define XB_TOPGEN   3392
#define XCD_BAR_WORDS 3456
#define XB_SPIN_CAP (1u << 20)
__device__ __forceinline__ unsigned xb_ld(unsigned* p)              { return __hip_atomic_load(p, __ATOMIC_RELAXED, __HIP_MEMORY_SCOPE_AGENT); }
__device__ __forceinline__ unsigned xb_add(unsigned* p, unsigned v) { return __hip_atomic_fetch_add(p, v, __ATOMIC_RELAXED, __HIP_MEMORY_SCOPE_AGENT); }
__device__ __forceinline__ unsigned xb_xcc_id() { return (unsigned)__builtin_amdgcn_s_getreg((3 << 11) | 20) & 0xFu; }
#define XB_SPIN(cond, bar) do { unsigned _sp = 0; while (cond) { __builtin_amdgcn_s_sleep(1); \
    if ((++_sp & 255u) == 0u) { if (xb_ld(&(bar)[XB_TMO])) break; if (_sp > XB_SPIN_CAP) { atomicAdd(&(bar)[XB_TMO], 1u); break; } } } } while (0)
struct XcdBarrier { unsigned* bar; unsigned x; volatile LAS unsigned* st; };
__device__ __forceinline__ XcdBarrier xcd_barrier_post(unsigned* bar, volatile LAS unsigned* st) {
    XcdBarrier b; b.bar = bar; b.x = xb_xcc_id(); b.st = st;
    if (threadIdx.x == 0) (void)xb_add(&bar[XB_XCNT(b.x)], 1u);
    return b;
}
__device__ __forceinline__ void xcd_barrier_complete(unsigned* bar, unsigned x, unsigned& nloc, unsigned& nx) {
    const unsigned G = gridDim.x * gridDim.y * gridDim.z;
    unsigned sum, cnt, mine, sp = 0u;
    for (;;) {
        sum = 0u; cnt = 0u; mine = 0u;
#pragma unroll
        for (unsigned j = 0; j < 16; ++j) { const unsigned c = xb_ld(&bar[XB_XCNT(j)]); sum += c; cnt += (c > 0u) ? 1u : 0u; mine = (j == x) ? c : mine; }
        if (sum == G) break;
        __builtin_amdgcn_s_sleep(1);
        if ((++sp & 255u) == 0u) { if (xb_ld(&bar[XB_TMO])) break; if (sp > XB_SPIN_CAP) { atomicAdd(&bar[XB_TMO], 1u); break; } }
    }
    nloc = mine > 0u ? mine : 1u; nx = cnt > 0u ? cnt : 1u;
}
__device__ __forceinline__ void xcd_barrier(const XcdBarrier& b) {
    asm volatile("s_waitcnt vmcnt(0)" ::: "memory");
    __syncthreads();
    if (threadIdx.x == 0) {
        unsigned* bar = b.bar;
        __builtin_amdgcn_s_waitcnt(0);
        unsigned nloc = b.st[0], nx = b.st[1];
        if (nloc == 0u) { xcd_barrier_complete(bar, b.x, nloc, nx); b.st[0] = nloc; b.st[1] = nx; }
        const unsigned old = xb_add(&bar[XB_XSUB(b.x)], 1u);
        const unsigned gen = old / nloc;
        if (old + 1u == (gen + 1u) * nloc) {
            __builtin_amdgcn_fence(__ATOMIC_RELEASE, "agent");
            asm volatile("s_waitcnt vmcnt(0)" ::: "memory");
            const unsigned og = xb_add(&bar[XB_TOP], 1u);
            const unsigned tg = og / nx;
            if (og + 1u == (tg + 1u) * nx) xb_add(&bar[XB_TOPGEN], 1u);
            else XB_SPIN(xb_ld(&bar[XB_TOPGEN]) == tg, bar);
            __builtin_amdgcn_fence(__ATOMIC_ACQUIRE, "agent");
            xb_add(&bar[XB_XGEN(b.x)], 1u);
            asm volatile("s_waitcnt vmcnt(0)" ::: "memory");
        } else {
            XB_SPIN(xb_ld(&bar[XB_XGEN(b.x)]) == gen, bar);
            __builtin_amdgcn_fence(__ATOMIC_ACQUIRE, "agent");
            asm volatile("s_waitcnt vmcnt(0)" ::: "memory");
        }
    }
    __syncthreads();
}

constexpr int SG_LDS = 2 * 128 * 144;
template <class Epi>
__device__ __forceinline__ void sg_tile(int tid, unsigned char* lds, const bf16_t* A, int lda, const bf16_t* Bt, int ldb, int K, Epi epi) {
    const int lane = tid & 63, wid = tid >> 6, wr = wid >> 2, wc = wid & 3, fr = lane & 15, fq = lane >> 4;
    unsigned char* As = lds; unsigned char* Bs = lds + 128 * 144;
    f32x4 acc[4][2];
#pragma unroll
    for (int m = 0; m < 4; ++m)
#pragma unroll
        for (int n = 0; n < 2; ++n) acc[m][n] = (f32x4){0.f, 0.f, 0.f, 0.f};
    const int nt = K / 64;
    u32x4 ra[2], rb[2];
    const int r0 = tid >> 3, cc = tid & 7;
#pragma unroll
    for (int i = 0; i < 2; ++i) {
        ra[i] = *(const u32x4*)(A + (size_t)(r0 + 64 * i) * lda + cc * 8);
        rb[i] = *(const u32x4*)(Bt + (size_t)(r0 + 64 * i) * ldb + cc * 8);
    }
    for (int kt = 0; kt < nt; ++kt) {
        __syncthreads();
#pragma unroll
        for (int i = 0; i < 2; ++i) {
            *(u32x4*)(As + (r0 + 64 * i) * 144 + cc * 16) = ra[i];
            *(u32x4*)(Bs + (r0 + 64 * i) * 144 + cc * 16) = rb[i];
        }
        __syncthreads();
        if (kt + 1 < nt) {
#pragma unroll
            for (int i = 0; i < 2; ++i) {
                ra[i] = *(const u32x4*)(A + (size_t)(r0 + 64 * i) * lda + (kt + 1) * 64 + cc * 8);
                rb[i] = *(const u32x4*)(Bt + (size_t)(r0 + 64 * i) * ldb + (kt + 1) * 64 + cc * 8);
            }
        }
#pragma unroll
        for (int kk = 0; kk < 2; ++kk) {
            bf16x8 a[4], b[2];
#pragma unroll
            for (int m = 0; m < 4; ++m) a[m] = *(const bf16x8*)(As + (wr * 64 + m * 16 + fr) * 144 + kk * 64 + fq * 16);
#pragma unroll
            for (int n = 0; n < 2; ++n) b[n] = *(const bf16x8*)(Bs + (wc * 32 + n * 16 + fr) * 144 + kk * 64 + fq * 16);
#pragma unroll
            for (int m = 0; m < 4; ++m)
#pragma unroll
                for (int n = 0; n < 2; ++n) acc[m][n] = __builtin_amdgcn_mfma_f32_16x16x32_bf16(b[n], a[m], acc[m][n], 0, 0, 0);
        }
    }
#pragma unroll
    for (int m = 0; m < 4; ++m) epi(wr * 64 + m * 16 + fr, wc * 32 + fq * 4, acc[m][0], acc[m][1]);
}


namespace pg8 {
#define PG8_LAS __attribute__((address_space(3)))
constexpr int BM = 256, BK = 64, HALF = 128, HTB = HALF * BK * 2, STAGE_BYTES = 8 * HTB;
__device__ __forceinline__ int lds_byte(int r, int c) { const int st = (r >> 4) * 2 + (c >> 5), rr = r & 15, cc = c & 31, ob = rr * 64 + cc * 2; return st * 1024 + (ob ^ (((ob >> 9) & 1) << 5)); }
__device__ __forceinline__ void stage_rc(int b, int& R, int& C) { const int st = b / 1024, sb = b % 1024, swz = sb ^ (((sb >> 9) & 1) << 5); R = (st >> 1) * 16 + swz / 64; C = (st & 1) * 32 + (swz % 64) / 2; }
typedef int v8i_t __attribute__((ext_vector_type(8)));
typedef int v4i_t __attribute__((ext_vector_type(4)));
struct FragT { union { v8i_t v; struct { v4i_t lo, hi; }; }; };
struct Unit { int pm, pb, pn, aux; };
struct Gemm { const bf16_t* A; const bf16_t* Bt; int lda, ldb, K; };
struct NoCtx {};
struct NoPre { __device__ __forceinline__ NoCtx operator()(const Unit&, int, int, int, int) const { return NoCtx{}; } };
template <class PF, class F> struct Epi {
    PF pre; F f;
    template <class Ctx>
    __device__ __forceinline__ void operator()(const f32x4 (&acc)[2][2][4][2], const Ctx& ctx, const Unit& u, int wr, int wc, int fr, int fq, PG8_LAS unsigned char*, int) const {
#pragma unroll
        for (int ai = 0; ai < 2; ++ai)
#pragma unroll
            for (int m = 0; m < 4; ++m)
#pragma unroll
                for (int bj = 0; bj < 2; ++bj) {
                    f32x4 v0, v1;
                    asm volatile("v_accvgpr_read_b32 %0, %8\n\tv_accvgpr_read_b32 %1, %9\n\tv_accvgpr_read_b32 %2, %10\n\tv_accvgpr_read_b32 %3, %11\n\t"
                                 "v_accvgpr_read_b32 %4, %12\n\tv_accvgpr_read_b32 %5, %13\n\tv_accvgpr_read_b32 %6, %14\n\tv_accvgpr_read_b32 %7, %15"
                                 : "=v"(v0.x), "=v"(v0.y), "=v"(v0.z), "=v"(v0.w), "=v"(v1.x), "=v"(v1.y), "=v"(v1.z), "=v"(v1.w)
                                 : "a"(acc[ai][bj][m][0].x), "a"(acc[ai][bj][m][0].y), "a"(acc[ai][bj][m][0].z), "a"(acc[ai][bj][m][0].w),
                                   "a"(acc[ai][bj][m][1].x), "a"(acc[ai][bj][m][1].y), "a"(acc[ai][bj][m][1].z), "a"(acc[ai][bj][m][1].w));
                    f(u, ctx, ai, m, bj, ai * HALF + wr * 64 + m * 16 + fr, bj * HALF + wc * 32 + 4 * fq, v0, v1);
                }
    }
};
template <class PF, class F> __device__ __forceinline__ Epi<PF, F> make_epi(PF p, F f) { return Epi<PF, F>{p, f}; }
template <int MG, class PF, class F, class FL> struct EpiStaged {
    PF pre; F f; FL flush;
    template <class Ctx>
    __device__ __forceinline__ void operator()(const f32x4 (&acc)[2][2][4][2], const Ctx& ctx, const Unit& u, int wr, int wc, int fr, int fq, PG8_LAS unsigned char* tile, int tid) const {
#pragma unroll
        for (int ai = 0; ai < 2; ++ai)
#pragma unroll
            for (int m = 0; m < 4; ++m) {
#pragma unroll
                for (int bj = 0; bj < 2; ++bj) {
                    f32x4 v0, v1;
                    asm volatile("v_accvgpr_read_b32 %0, %8\n\tv_accvgpr_read_b32 %1, %9\n\tv_accvgpr_read_b32 %2, %10\n\tv_accvgpr_read_b32 %3, %11\n\t"
                                 "v_accvgpr_read_b32 %4, %12\n\tv_accvgpr_read_b32 %5, %13\n\tv_accvgpr_read_b32 %6, %14\n\tv_accvgpr_read_b32 %7, %15"
                                 : "=v"(v0.x), "=v"(v0.y), "=v"(v0.z), "=v"(v0.w), "=v"(v1.x), "=v"(v1.y), "=v"(v1.z), "=v"(v1.w)
                                 : "a"(acc[ai][bj][m][0].x), "a"(acc[ai][bj][m][0].y), "a"(acc[ai][bj][m][0].z), "a"(acc[ai][bj][m][0].w),
                                   "a"(acc[ai][bj][m][1].x), "a"(acc[ai][bj][m][1].y), "a"(acc[ai][bj][m][1].z), "a"(acc[ai][bj][m][1].w));
                    f(u, ctx, ai, m, bj, (m % MG) * 32 + wr * 16 + fr, bj * HALF + wc * 32 + 4 * fq, v0, v1, tile);
                }
                if ((m % MG) == MG - 1) {
                    asm volatile("s_waitcnt lgkmcnt(0)" ::: "memory"); __builtin_amdgcn_s_barrier(); asm volatile("" ::: "memory");
                    flush(u, ai, m - (MG - 1), tid, tile);
                }
            }
    }
};
template <int MG, class PF, class F, class FL> __device__ __forceinline__ EpiStaged<MG, PF, F, FL> make_epi_staged(PF p, F f, FL fl) { return EpiStaged<MG, PF, F, FL>{p, f, fl}; }
template <bool FP8 = false, bool GATHER = false, class EpiT, class Sched>
__device__ __forceinline__ void gemm_phase(int tid, PG8_LAS unsigned char* lds, const Gemm g, const Sched& S, const EpiT& E) {
    const int wid = __builtin_amdgcn_readfirstlane(tid >> 6), lane = tid & 63, wr = wid >> 2, wc = wid & 3, fr = lane & 15, fq = lane >> 4;
    int K = g.K; asm volatile("" : "+s"(K));
    const int nt = K / BK;
    unsigned voffA[2], voffB[2];
    int Rl[2], Cl[2];
#pragma unroll
    for (int i = 0; i < 2; ++i) { int R, C; stage_rc(tid * 16 + i * 8192, R, C); Rl[i] = R; Cl[i] = C; voffA[i] = (unsigned)(R * g.lda + C) * 2u; voffB[i] = (unsigned)(R * g.ldb + C) * 2u; }
    unsigned gA00 = 0, gA01 = 0, gA10 = 0, gA11 = 0, gN00 = 0, gN01 = 0, gN10 = 0, gN11 = 0;
    const size_t kstep = (size_t)(BK * 2);
    const size_t hstepA = (size_t)HALF * g.lda * 2, hstepB = (size_t)HALF * g.ldb * 2;
    const size_t tstepA = 2 * hstepA, tstepB = 2 * hstepB;
    const unsigned ldsw = (unsigned)wid * 1024u;
    const int aoff = lds_byte(wr * 64 + fr, fq * 8), boff = lds_byte(wc * 32 + fr, fq * 8);
#define PG8_SA(b, h) (((b) * 2 + (h)) * HTB)
#define PG8_SB(b, h) ((4 + (b) * 2 + (h)) * HTB)
#define PG8_STAGE(bufoff, gbase, voff) do { _Pragma("unroll") for (int _i = 0; _i < 2; ++_i) \
        __builtin_amdgcn_global_load_lds((const unsigned*)((const char*)(gbase) + (voff)[_i]), (PG8_LAS unsigned*)(lds + (bufoff) + ldsw + _i * 8192), 16, 0, 0); } while (0)
#define PG8_LDA(dst, b, h) do { _Pragma("unroll") for (int m = 0; m < 4; ++m) { dst[m].lo = *(const PG8_LAS v4i_t*)(lds + PG8_SA(b, h) + aoff + m * 2048); dst[m].hi = *(const PG8_LAS v4i_t*)(lds + PG8_SA(b, h) + aoff + m * 2048 + 1024); } } while (0)
#define PG8_LDB(dst, b, h) do { _Pragma("unroll") for (int n = 0; n < 2; ++n) { dst[n].lo = *(const PG8_LAS v4i_t*)(lds + PG8_SB(b, h) + boff + n * 2048); dst[n].hi = *(const PG8_LAS v4i_t*)(lds + PG8_SB(b, h) + boff + n * 2048 + 1024); } } while (0)
#define PG8_MMA(ai, bj, At, Bt) do { __builtin_amdgcn_s_setprio(1); _Pragma("unroll") for (int m = 0; m < 4; ++m) _Pragma("unroll") for (int n = 0; n < 2; ++n) { \
        if constexpr (FP8) { asm volatile("s_nop 1\n\tv_mfma_scale_f32_16x16x128_f8f6f4 %0, %1, %2, %0, %3, %4 op_sel_hi:[0,0,0]" : "+a"(acc[ai][bj][m][n]) : "v"(Bt[n].v), "v"(At[m].v), "v"(scw), "v"(scx)); } \
        else { asm volatile("s_nop 1\n\tv_mfma_f32_16x16x32_bf16 %0, %1, %2, %0\n\tv_mfma_f32_16x16x32_bf16 %0, %3, %4, %0" : "+a"(acc[ai][bj][m][n]) : "v"(Bt[n].lo), "v"(At[m].lo), "v"(Bt[n].hi), "v"(At[m].hi)); } } \
        __builtin_amdgcn_s_setprio(0); } while (0)
#define PG8_WAIT_V(n) asm volatile("s_waitcnt vmcnt(" #n ")" ::: "memory")
#define PG8_WAIT_L(n) asm volatile("s_waitcnt lgkmcnt(" #n ")" ::: "memory")
#define PG8_BAR __builtin_amdgcn_s_barrier()
#define PG8_SCHED __builtin_amdgcn_sched_barrier(0)
    Unit cur, nxt; int ui = 0;
    if (!S.next(0, cur)) return;
    f32x4 acc[2][2][4][2];
#pragma unroll
    for (int a = 0; a < 2; ++a)
#pragma unroll
        for (int b = 0; b < 2; ++b)
#pragma unroll
            for (int m = 0; m < 4; ++m)
#pragma unroll
                for (int n = 0; n < 2; ++n) acc[a][b][m][n] = (f32x4){0.f, 0.f, 0.f, 0.f};
    FragT At[4], B0[2], B1[2];
    int scw = (FP8 && PROBE_KX2) ? 0x79797979 : 0x7a7a7a7a, scx = 0x7f7f7f7f; asm volatile("" : "+v"(scw), "+v"(scx));
    const char* cA = GATHER ? (const char*)g.A : (const char*)g.A + (size_t)cur.pm * tstepA; const char* cB = (const char*)g.Bt + (size_t)cur.pb * tstepB;
    const int R0 = Rl[0], R1 = Rl[1]; const unsigned C0 = (unsigned)Cl[0] * 2u, C1 = (unsigned)Cl[1] * 2u;
    if constexpr (GATHER) { gA00 = S.a_off(cur, R0) + C0; gA01 = S.a_off(cur, R1) + C1; gA10 = S.a_off(cur, HALF + R0) + C0; gA11 = S.a_off(cur, HALF + R1) + C1; }
#define PG8_STAGE_A(bufoff, koff, O0, O1, dense_ptr) do { if constexpr (GATHER) { \
        __builtin_amdgcn_global_load_lds((const unsigned*)((const char*)g.A + (koff) + (O0)), (PG8_LAS unsigned*)(lds + (bufoff) + ldsw), 16, 0, 0); \
        __builtin_amdgcn_global_load_lds((const unsigned*)((const char*)g.A + (koff) + (O1)), (PG8_LAS unsigned*)(lds + (bufoff) + ldsw + 8192), 16, 0, 0); \
    } else { PG8_STAGE(bufoff, dense_ptr, voffA); } } while (0)
    PG8_STAGE(PG8_SB(0, 0), cB, voffB); PG8_STAGE(PG8_SB(0, 1), cB + hstepB, voffB); PG8_STAGE_A(PG8_SA(0, 0), 0, gA00, gA01, cA); PG8_STAGE_A(PG8_SA(0, 1), 0, gA10, gA11, cA + hstepA);
    if (wr == 1) PG8_BAR;
    PG8_WAIT_V(2); PG8_BAR;
    PG8_STAGE(PG8_SB(1, 0), cB + kstep, voffB); PG8_STAGE_A(PG8_SA(1, 0), kstep, gA00, gA01, cA + kstep); PG8_STAGE(PG8_SB(1, 1), cB + hstepB + kstep, voffB);
    PG8_WAIT_V(6); PG8_BAR;
    for (;;) {
        const bool has_next = S.next(ui + 1, nxt);
        const char* nA = GATHER ? cA : (has_next ? (const char*)g.A + (size_t)nxt.pm * tstepA : cA); const char* nB = has_next ? (const char*)g.Bt + (size_t)nxt.pb * tstepB : cB;
        if constexpr (GATHER) {
            if (has_next) { gN00 = S.a_off(nxt, R0) + C0; gN01 = S.a_off(nxt, R1) + C1; gN10 = S.a_off(nxt, HALF + R0) + C0; gN11 = S.a_off(nxt, HALF + R1) + C1; }
            else { gN00 = gA00; gN01 = gA01; gN10 = gA10; gN11 = gA11; }
        }
        constexpr int KX = (FP8 && PROBE_KX2) ? 2 : 1;
        for (int t = 0; t < KX * nt; t += 2) {
            const bool last = (t == KX * nt - 2);
            const char* a1 = cA + (size_t)((t + 1) % nt) * kstep;
            const char* a2 = last ? nA : cA + (size_t)((t + 2) % nt) * kstep; const char* b2 = last ? nB : cB + (size_t)((t + 2) % nt) * kstep;
            const char* a3 = a2 + kstep; const char* b3 = b2 + kstep;
            const size_t k1 = (size_t)((t + 1) % nt) * kstep, k2 = last ? 0 : (size_t)((t + 2) % nt) * kstep;
            const unsigned gT00 = last ? gN00 : gA00, gT01 = last ? gN01 : gA01, gT10 = last ? gN10 : gA10, gT11 = last ? gN11 : gA11;
            PG8_LDB(B0, 0, 0); PG8_LDB(B1, 0, 1); PG8_SCHED; PG8_LDA(At, 0, 0); PG8_STAGE_A(PG8_SA(1, 1), k1, gA10, gA11, a1 + hstepA);
            PG8_WAIT_V(8); PG8_WAIT_L(0); PG8_BAR; PG8_MMA(0, 0, At, B0); PG8_MMA(0, 1, At, B1); PG8_BAR; PG8_SCHED;
            PG8_LDA(At, 0, 1); PG8_STAGE(PG8_SB(0, 0), b2, voffB); PG8_STAGE(PG8_SB(0, 1), b2 + hstepB, voffB); PG8_STAGE_A(PG8_SA(0, 0), k2, gT00, gT01, a2);
            PG8_WAIT_V(8); PG8_WAIT_L(0); PG8_BAR; PG8_MMA(1, 0, At, B0); PG8_MMA(1, 1, At, B1); PG8_BAR; PG8_SCHED;
            PG8_LDB(B0, 1, 0); PG8_LDB(B1, 1, 1); PG8_SCHED; PG8_LDA(At, 1, 0); PG8_STAGE_A(PG8_SA(0, 1), k2, gT10, gT11, a2 + hstepA);
            PG8_WAIT_V(8); PG8_WAIT_L(0); PG8_BAR; PG8_MMA(0, 0, At, B0); PG8_MMA(0, 1, At, B1); PG8_BAR; PG8_SCHED;
            PG8_LDA(At, 1, 1); PG8_STAGE(PG8_SB(1, 0), b3, voffB); PG8_STAGE(PG8_SB(1, 1), b3 + hstepB, voffB); PG8_STAGE_A(PG8_SA(1, 0), k2 + kstep, gT00, gT01, a3);
            PG8_WAIT_V(8); PG8_WAIT_L(0); PG8_BAR; PG8_MMA(1, 0, At, B0); PG8_MMA(1, 1, At, B1); PG8_BAR; PG8_SCHED;
        }
        const auto ectx = E.pre(cur, wr, wc, fr, fq);
        if (wr == 0) PG8_BAR;
        asm volatile("s_nop 15\n\ts_nop 15" ::: "memory");
        E(acc, ectx, cur, wr, wc, fr, fq, lds + STAGE_BYTES, tid);
        if constexpr (FP8 && PROBE_EPI2) { asm volatile("" ::: "memory"); E(acc, ectx, cur, wr, wc, fr, fq, lds + STAGE_BYTES, tid); }
        if (!has_next) break;
#pragma unroll
        for (int a = 0; a < 2; ++a)
#pragma unroll
            for (int b = 0; b < 2; ++b)
#pragma unroll
                for (int m = 0; m < 4; ++m)
#pragma unroll
                    for (int n = 0; n < 2; ++n) acc[a][b][m][n] = (f32x4){0.f, 0.f, 0.f, 0.f};
        cur = nxt; cA = nA; cB = nB; ++ui;
        if constexpr (GATHER) { gA00 = gN00; gA01 = gN01; gA10 = gN10; gA11 = gN11; }
        if (wr == 1) PG8_BAR;
    }
    PG8_WAIT_V(0);
    PG8_BAR;
#undef PG8_SA
#undef PG8_SB
#undef PG8_STAGE
#undef PG8_STAGE_A
#undef PG8_LDA
#undef PG8_LDB
#undef PG8_MMA
#undef PG8_WAIT_V
#undef PG8_WAIT_L
#undef PG8_BAR
#undef PG8_SCHED
}
struct GridOrder {
    int nM, nN, nwg, G, c;
    __device__ __forceinline__ void init(int nM_, int nN_, int G_, int c_) { nM = nM_; nN = nN_; nwg = nM * nN; G = G_; c = c_; }
    __device__ __forceinline__ bool tile(int i, int& pm, int& pn) const {
        const long L = (long)i * G + c; if (L >= nwg) return false;
        int wgid = (int)L; { const int q = nwg / 8, r = nwg % 8, xcd = wgid % 8, off = wgid / 8; wgid = (xcd < r ? xcd * (q + 1) : r * (q + 1) + (xcd - r) * q) + off; }
        const int nig = 8 * nN, gid = wgid / nig, fm = gid * 8, gsz = (nM - fm) < 8 ? (nM - fm) : 8;
        pm = fm + ((wgid % nig) % gsz); pn = (wgid % nig) / gsz; return true;
    }
};
}


struct DenseOrder { pg8::GridOrder go;
    __device__ __forceinline__ bool next(int i, pg8::Unit& u) const { int pm, pn; if (!go.tile(i, pm, pn)) return false; u.pm = pm; u.pb = pn; u.pn = pn; u.aux = 0; return true; } };
struct MoeOrder { pg8::GridOrder go; const int* pst; const int* el_slot; int NT, ebase;
    __device__ __forceinline__ unsigned a_off(const pg8::Unit& u, int R) const { const int ro = u.pm * 256 - pst[u.aux] + R; const int tok = (ro < pst[64 + u.aux]) ? (el_slot[(size_t)u.aux * T + ro] >> 2) : 0; return (unsigned)tok * 1024u; }
    __device__ __forceinline__ bool next(int i, pg8::Unit& u) const { int pm, pn; if (!go.tile(i, pm, pn)) return false; int e = 0;
#pragma unroll
        for (int q = 1; q < 32; ++q) e = (pm * 256 >= pst[q]) ? q : e;
        e = __builtin_amdgcn_readfirstlane(e);
        u.pm = pm; u.pn = pn; u.pb = (ebase + e) * NT + pn; u.aux = e; return true; } };
struct S5Order { int G, c;
    __device__ __forceinline__ bool next(int i, pg8::Unit& u) const { const int L = i * G + c; if (L >= 256) return false; const int g = L >> 3, pmL = (L >> 2) & 1, pnL = L & 3;
        u.pm = g * 2 + pmL; u.pb = g * 4 + pnL; u.pn = pnL; u.aux = g; return true; } };

__device__ __forceinline__ void transpose_item(const float* W, int K, int N, bf16_t* WT, int ldt, float* scr, int item, int lane, int mode) {
    const int nblk = N / 32, kb = item / nblk, nb = item % nblk, k0 = 64 * kb, n0 = 32 * nb;
#pragma unroll 8
    for (int i = 0; i < 32; ++i) { const int kk = 2 * i + (lane >> 5); scr[kk * 33 + (lane & 31)] = W[(size_t)(k0 + kk) * N + n0 + (lane & 31)]; }
    __builtin_amdgcn_s_waitcnt(0xC07F); asm volatile("" ::: "memory");
    const int c = lane & 7;
#pragma unroll
    for (int j = 0; j < 4; ++j) {
        const int n = (lane >> 3) + 8 * j; const float* s = scr + (8 * c) * 33 + n;
        u32x4 o; o.x = pk2(s[0 * 33], s[1 * 33]); o.y = pk2(s[2 * 33], s[3 * 33]); o.z = pk2(s[4 * 33], s[5 * 33]); o.w = pk2(s[6 * 33], s[7 * 33]);
        int nn = n0 + n;
        if (mode == 1) { const int half = nn >= 1024; const int jj = nn - half * 1024; nn = 32 * (jj >> 4) + 16 * half + (jj & 15); }
        *(u32x4*)(WT + (size_t)nn * ldt + k0 + 8 * c) = o;
    }
    __builtin_amdgcn_s_waitcnt(0xC07F); asm volatile("" ::: "memory");
}
__device__ __forceinline__ void transpose_item_fp8(const float* W, int K, int N, unsigned char* WT, float* scr, int item, int lane, int mode, float scale) {
    const int nblk = N / 32, kb = item / nblk, nb = item % nblk, k0 = 128 * kb, n0 = 32 * nb;
#pragma unroll 8
    for (int i = 0; i < 64; ++i) { const int kk = 2 * i + (lane >> 5); scr[kk * 33 + (lane & 31)] = W[(size_t)(k0 + kk) * N + n0 + (lane & 31)] * scale; }
    __builtin_amdgcn_s_waitcnt(0xC07F); asm volatile("" ::: "memory");
    const int c = lane & 7;
#pragma unroll
    for (int j = 0; j < 4; ++j) {
        const int n = (lane >> 3) + 8 * j; const float* s = scr + (16 * c) * 33 + n;
        u32x4 o; o.x = pk4_fp8(s[0 * 33], s[1 * 33], s[2 * 33], s[3 * 33]); o.y = pk4_fp8(s[4 * 33], s[5 * 33], s[6 * 33], s[7 * 33]);
        o.z = pk4_fp8(s[8 * 33], s[9 * 33], s[10 * 33], s[11 * 33]); o.w = pk4_fp8(s[12 * 33], s[13 * 33], s[14 * 33], s[15 * 33]);
        int nn = n0 + n;
        if (mode == 1) { const int half = nn >= 1024; const int jj = nn - half * 1024; nn = 32 * (jj >> 4) + 16 * half + (jj & 15); }
        *(u32x4*)(WT + (size_t)nn * K + k0 + 16 * c) = o;
    }
    __builtin_amdgcn_s_waitcnt(0xC07F); asm volatile("" ::: "memory");
}
__device__ __forceinline__ void transpose_many_fp8(const float* W, int nmat, int K, int N, unsigned char* WT, size_t dst_stride, float* scr, int gw, int NGW, int lane, int mode, float scale) {
    const int per = (K / 128) * (N / 32); const long tot = (long)nmat * per;
    for (long it = gw; it < tot; it += NGW) {
        const int mt = (int)(it / per), r = (int)(it % per);
        transpose_item_fp8(W + (size_t)mt * K * N, K, N, WT + (size_t)mt * dst_stride, scr, r, lane, mode, scale);
    }
}
__device__ __forceinline__ void transpose_many(const float* W, int nmat, int K, int N, bf16_t* WT, size_t dst_stride, float* scr, int gw, int NGW, int lane, int mode, int ldt = 0) {
    if (ldt == 0) ldt = K;
    const int per = (K / 64) * (N / 32); const long tot = (long)nmat * per;
    for (long it = gw; it < tot; it += NGW) {
        const int mt = (int)(it / per), r = (int)(it % per);
        transpose_item(W + (size_t)mt * K * N, K, N, WT + (size_t)mt * dst_stride, ldt, scr, r, lane, mode);
    }
}

__device__ __forceinline__ void norm_mod_store(f32x4 (&v)[4], const float* g, const float* sc, const float* sh, bf16_t* orow, unsigned char* orow8, int lane) {
    float s = 0.f;
#pragma unroll
    for (int j = 0; j < 4; ++j) s += (v[j].x * v[j].x + v[j].y * v[j].y) + (v[j].z * v[j].z + v[j].w * v[j].w);
    const float r = rsqrtf(wave_sum(s) * (1.0f / D) + 1e-6f);
#pragma unroll
    for (int j = 0; j < 4; ++j) {
        const int c = 4 * lane + 256 * j;
        const f32x4 gg = *(const f32x4*)(g + c), s1 = *(const f32x4*)(sc + c), s0 = *(const f32x4*)(sh + c);
        const float a = v[j].x * r * gg.x * (1.f + s1.x) + s0.x, b = v[j].y * r * gg.y * (1.f + s1.y) + s0.y,
                    cc = v[j].z * r * gg.z * (1.f + s1.z) + s0.z, d = v[j].w * r * gg.w * (1.f + s1.w) + s0.w;
        u32x2 o; o.x = pk2(a, b); o.y = pk2(cc, d);
        *(u32x2*)(orow + c) = o;
        if (orow8) *(unsigned*)(orow8 + c) = pk4_fp8(a, b, cc, d);
    }
}

template <int ph> __device__ __forceinline__ void phase_body() {
    extern __shared__ __attribute__((aligned(16))) unsigned char lds[];
    {
        int tid = threadIdx.x; asm volatile("" : "+v"(tid));
        int vb = blockIdx.x, G = gridDim.x; asm volatile("" : "+s"(vb), "+s"(G));
        const int lane = tid & 63, wave = tid >> 6;
        const int gw = vb * NWAVE + wave, NGW = G * NWAVE;
        const __attribute__((address_space(4))) Params* kp = (const __attribute__((address_space(4))) Params*)__builtin_amdgcn_kernarg_segment_ptr();
        asm volatile("" : "+s"(kp));
        unsigned char* ws = kp->ws;
        unsigned* ctl = (unsigned*)(ws + WS_CTL);
        float* MOD = (float*)(ws + WS_MOD);
        float* S5AB = (float*)(ws + WS_S5AB); float* S5BB = (float*)(ws + WS_S5AB + 65536);
        float* PW = (float*)(ws + WS_PW); float* KTAB = (float*)(ws + WS_KTAB);
                int* EL_SLOT = (int*)(ws + WS_EL); float* EL_GATE = (float*)(ws + WS_EL + 4 * MiB);
            bf16_t* W_IN_E = (bf16_t*)(ws + WS_W_IN_E); bf16_t* W_UP = (bf16_t*)(ws + WS_W_UP); bf16_t* W_GLU = (bf16_t*)(ws + WS_W_GLU);
        bf16_t* W_OUT_E = (bf16_t*)(ws + WS_W_OUT_E); bf16_t* W_IN_O = (bf16_t*)(ws + WS_W_IN_O); bf16_t* W_OUT_O = (bf16_t*)(ws + WS_W_OUT_O);
        bf16_t* W_POOL = (bf16_t*)(ws + WS_W_POOL); bf16_t* W_SGU = (bf16_t*)(ws + WS_W_SGU); bf16_t* W_RT = (bf16_t*)(ws + WS_W_RT);
        bf16_t* BT_END = (bf16_t*)(ws + WS_BT_END); bf16_t* BT_MAIN = (bf16_t*)(ws + WS_BT_MAIN);
        unsigned char* W_GU = ws + WS_W_GU; unsigned char* W_DN = ws + WS_W_DN; unsigned char* HB8 = ws + WS_HB8;
        bf16_t* HB = (bf16_t*)(ws + WS_HB); bf16_t* MIXIN = (bf16_t*)(ws + WS_MIXIN); bf16_t* Y = (bf16_t*)(ws + WS_Y);
        unsigned char* ACT = ws + WS_ACT;
        bf16_t* Z = (bf16_t*)(ws + WS_Z); bf16_t* QKN = (bf16_t*)(ws + WS_QKN); bf16_t* QKVRAW = (bf16_t*)(ws + WS_QKVRAW);
        bf16_t* Qb = (bf16_t*)(ws + WS_Q); bf16_t* Kb = (bf16_t*)(ws + WS_K); bf16_t* VT = (bf16_t*)(ws + WS_VT);
        bf16_t* AS5 = (bf16_t*)(ws + WS_AS5); float* LEND = (float*)(ws + WS_LEND); bf16_t* GACT = (bf16_t*)(ws + WS_GACT);
        bf16_t* POOLED = (bf16_t*)(ws + WS_POOLED); bf16_t* VTS = (bf16_t*)(ws + WS_VTS);
        float* OUT = kp->out; const float* XIN = kp->x;
        const float* s5d = kp->s5_d; const float* glub = kp->s5_glu_b; const float* poolsc = kp->pool_scale; const float* sgub = kp->sgu_b;
        const float* bgu_all = kp->moe_b_gu; const float* bdn_all = kp->moe_b_dn; const float* rtb_all = kp->router_b;

        const int layer = (ph >= 17) ? 1 : 0;
        const int mph = (ph >= 17 && ph <= 19) ? ph - 8 : ph;
        const float* mod_l = MOD + (size_t)layer * NB * 6144;

        if (ph == 0) {
            const int gt = vb * NTHR + tid;
            if (gt < 2048) {
                const int g = gt >> 6, pp = gt & 63;
                const float dt = expf(kp->s5_log_dt[g]);
                const float lre = fminf(kp->s5_a_re[g * 64 + pp], -1e-4f), lim = kp->s5_a_im[g * 64 + pp];
                const float mag = expf(lre * dt);
                const float abr = mag * cosf(lim * dt), abi = mag * sinf(lim * dt);
                const float den = lre * lre + lim * lim, nr = abr - 1.0f;
                const float fre = (nr * lre + abi * lim) / den, fim = (abi * lre - nr * lim) / den;
                S5AB[(g * 64 + pp) * 2 + 0] = abr; S5AB[(g * 64 + pp) * 2 + 1] = abi;
                for (int j = 0; j < 16; ++j) {
                    const float br = kp->s5_b_re[(g * 64 + pp) * 16 + j], bi = kp->s5_b_im[(g * 64 + pp) * 16 + j];
                    S5BB[((g * 64 + pp) * 16 + j) * 2 + 0] = fre * br - fim * bi;
                    S5BB[((g * 64 + pp) * 16 + j) * 2 + 1] = fre * bi + fim * br;
                }
                float pr = 1.f, pi = 0.f;
                for (int tau = 0; tau <= 64; ++tau) {
                    PW[((g * 64 + pp) * 65 + tau) * 2 + 0] = pr; PW[((g * 64 + pp) * 65 + tau) * 2 + 1] = pi;
                    const float nr2 = pr * abr - pi * abi, ni2 = pr * abi + pi * abr; pr = nr2; pi = ni2;
                }
            }
            {
                float* ca = (float*)lds;
                for (int i = tid; i < NB * D; i += NTHR) { const float cv = kp->c[i]; ca[i] = cv * sigmoidf_(cv); }
                __syncthreads();
                for (int task = gw; task < 2 * 96; task += NGW) {
                    const int l = task / 96, cb = task % 96, col = cb * 64 + lane;
                    const float* W = kp->ada_w + (size_t)l * D * 6144 + col;
                    float acc[8];
#pragma unroll
                    for (int b = 0; b < 8; ++b) acc[b] = 0.f;
                    for (int k = 0; k < D; k += 8) {
                        float w[8];
#pragma unroll
                        for (int u = 0; u < 8; ++u) w[u] = W[(size_t)(k + u) * 6144];
#pragma unroll
                        for (int u = 0; u < 8; ++u)
#pragma unroll
                            for (int b = 0; b < 8; ++b) acc[b] += ca[b * D + k + u] * w[u];
                    }
                    const float bias = kp->ada_b[l * 6144 + col];
#pragma unroll
                    for (int b = 0; b < 8; ++b) MOD[((size_t)l * NB + b) * 6144 + col] = acc[b] + bias;
                }
                __syncthreads();
            }
            {
                float* scr = (float*)(lds + wave * 16384);
                transpose_many(kp->even_w_in, 1, 1024, 928, W_IN_E, 0, scr, gw, NGW, lane, 0);
                transpose_many(kp->w_uq, 1, 256, 768, W_UP, 0, scr, gw, NGW, lane, 0, 384);
                transpose_many(kp->w_ukv, 1, 128, 1024, W_UP + (size_t)768 * 384 + 256, 0, scr, gw, NGW, lane, 0, 384);
                for (int i = vb * NTHR + tid; i < 768 * 16 + 1024 * 32; i += G * NTHR) {
                    const u32x4 z = {0u, 0u, 0u, 0u};
                    if (i < 768 * 16) *(u32x4*)(W_UP + (size_t)(i >> 4) * 384 + 256 + (i & 15) * 8) = z;
                    else { const int q = i - 768 * 16; *(u32x4*)(W_UP + (size_t)(768 + (q >> 5)) * 384 + (q & 31) * 8) = z; }
                }
                transpose_many(kp->s5_glu_w, 1, 512, 512, W_GLU, 0, scr, gw, NGW, lane, 0);
                transpose_many(kp->even_w_out, 1, 1024, 1024, W_OUT_E, 0, scr, gw, NGW, lane, 0);
                transpose_many(kp->odd_w_in, 1, 1024, 1536, W_IN_O, 0, scr, gw, NGW, lane, 0);
                transpose_many(kp->odd_w_out, 1, 1024, 1024, W_OUT_O, 0, scr, gw, NGW, lane, 0);
                transpose_many(kp->pool_w, 4, 128, 128, W_POOL, 128 * 128, scr, gw, NGW, lane, 0);
                transpose_many(kp->router_w, 2, 1024, 32, W_RT, 128 * 1024, scr, gw, NGW, lane, 0);
                {
                    float* scr8 = (float*)(lds + wave * 16896);
                    transpose_many_fp8(kp->moe_w_gu, 64, 1024, 2048, W_GU, (size_t)2048 * 1024, scr8, gw, NGW, lane, 1, 32.0f);
                    transpose_many_fp8(kp->moe_w_dn, 64, 1024, 1024, W_DN, (size_t)1024 * 1024, scr8, gw, NGW, lane, 0, 32.0f);
                }
                for (int i = vb * NTHR + tid; i < 4 * 128 * 128; i += G * NTHR) {
                    const int t = (i >> 7) & 127, s_ = i & 127;
                    W_SGU[i] = (s_ <= t) ? f2bf(kp->sgu_w[i]) : (bf16_t)0;
                }
            }
        }
        else if (ph == 1 || ph == 12 || ph == 20) {
            const int lyr = (ph == 1) ? 0 : 1;
            const bool combine = (ph == 12 || ph == 20), donorm = (ph != 20);
            const int comb_layer = (ph == 12) ? 0 : 1;
            const bool ffn = false;
            const float* src = (ph == 1) ? kp->x : kp->out;
            const float* ng = (ffn ? kp->norm_ffn_g : kp->norm_mix_g) + lyr * D;
            for (int row = gw; row < T; row += NGW) {
                const int b = row / S;
                f32x4 v[4];
#pragma unroll
                for (int j = 0; j < 4; ++j) v[j] = *(const f32x4*)(src + (size_t)row * D + 4 * lane + 256 * j);
                if (combine) {
                    const float* gf = MOD + ((size_t)comb_layer * NB + b) * 6144 + 5 * D;
#pragma unroll
                    for (int j = 0; j < 4; ++j) {
                        const int c = 4 * lane + 256 * j;
                        float a0 = 0.f, a1 = 0.f, a2 = 0.f, a3 = 0.f;
#pragma unroll
                        for (int k = 0; k < 4; ++k) {
                            const u32x2 yy = *(const u32x2*)(Y + ((size_t)row * 4 + k) * D + c);
                            a0 += __uint_as_float(yy.x << 16); a1 += __uint_as_float(yy.x & 0xffff0000u);
                            a2 += __uint_as_float(yy.y << 16); a3 += __uint_as_float(yy.y & 0xffff0000u);
                        }
                        const f32x4 g4 = *(const f32x4*)(gf + c);
                        v[j].x += g4.x * a0; v[j].y += g4.y * a1; v[j].z += g4.z * a2; v[j].w += g4.w * a3;
                        *(f32x4*)(kp->out + (size_t)row * D + c) = v[j];
                    }
                }
                if (donorm) {
                    const float* mm = MOD + ((size_t)lyr * NB + b) * 6144 + (ffn ? 3 * D : 0);
                    norm_mod_store(v, ng, mm + D, mm, HB + (size_t)row * D, ffn ? HB8 + (size_t)row * D : (unsigned char*)nullptr, lane);
                }
            }
            if (ph == 1) {
                for (int idx = vb * NTHR + tid; idx < 32 * 64 * 256; idx += G * NTHR) {
                    const int j = idx & 15, i = (idx >> 4) & 15, tau = (idx >> 8) & 63, g = idx >> 14;
                    float acc = 0.f;
                    for (int pp = 0; pp < 64; ++pp) {
                        const float cr = kp->s5_c_re[(g * 16 + i) * 64 + pp], ci = kp->s5_c_im[(g * 16 + i) * 64 + pp];
                        const float pr = PW[((g * 64 + pp) * 65 + tau) * 2], pi = PW[((g * 64 + pp) * 65 + tau) * 2 + 1];
                        const float br = S5BB[((g * 64 + pp) * 16 + j) * 2], bi = S5BB[((g * 64 + pp) * 16 + j) * 2 + 1];
                        const float qr = pr * br - pi * bi, qi = pr * bi + pi * br;
                        acc += cr * qr - ci * qi;
                    }
                    KTAB[idx] = acc;
                }
            }
        }
        else if (ph == 2) {
            {
                DenseOrder so; so.go.init(T / 256, 4, G, vb);
                auto f = [=](const pg8::Unit& u, const pg8::NoCtx&, int ai, int m, int bj, int r, int c, f32x4 v0, f32x4 v1) {
                        const int row = u.pm * 256 + r;
#pragma unroll
                        for (int h = 0; h < 2; ++h) {
                            const int col = u.pn * 256 + c + 16 * h; const f32x4 v = h ? v1 : v0;
                            u32x2 o; o.x = pk2(v.x, v.y); o.y = pk2(v.z, v.w);
                            if (col < 416) *(u32x2*)(Z + (size_t)row * 1024 + col) = o;
                            else if (col < 928) {
                                const int ch = col - 416, g = ch >> 4, j = ch & 15, b = row / S, t = row % S;
                                *(u32x2*)(AS5 + ((size_t)g * 512 + b * 64 + (t >> 6)) * 1152 + 128 + (t & 63) * 16 + j) = o;
                            }
                        }
                    };
                pg8::gemm_phase(tid, (PG8_LAS unsigned char*)lds, pg8::Gemm{HB, W_IN_E, D, D, D}, so, pg8::make_epi(pg8::NoPre{}, f));
            }
            for (int idx = vb * NTHR + tid; idx < 32 * 128 * 128; idx += G * NTHR) {
                const int k8 = idx & 127, n = (idx >> 7) & 127, g = idx >> 14;
                const int ri = n >> 6, pp = n & 63, s_ = k8 >> 1, j0 = (k8 & 1) * 8;
                const float pr = PW[((g * 64 + pp) * 65 + (63 - s_)) * 2], pi = PW[((g * 64 + pp) * 65 + (63 - s_)) * 2 + 1];
                float o[8];
#pragma unroll
                for (int j = 0; j < 8; ++j) {
                    const float br = S5BB[((g * 64 + pp) * 16 + j0 + j) * 2], bi = S5BB[((g * 64 + pp) * 16 + j0 + j) * 2 + 1];
                    o[j] = ri ? (pr * bi + pi * br) : (pr * br - pi * bi);
                }
                u32x4 w; w.x = pk2(o[0], o[1]); w.y = pk2(o[2], o[3]); w.z = pk2(o[4], o[5]); w.w = pk2(o[6], o[7]);
                *(u32x4*)(BT_END + ((size_t)g * 128 + n) * 1024 + k8 * 8) = w;
            }
            for (int idx = vb * NTHR + tid; idx < 32 * 1024 * 144; idx += G * NTHR) {
                const int k8 = idx % 144, n = (idx / 144) & 1023, g = idx / (144 * 1024);
                const int t = n >> 4, i = n & 15;
                float o[8];
                if (k8 < 16) {
                    const int ri = k8 >> 3, p0 = (k8 & 7) * 8;
#pragma unroll
                    for (int j = 0; j < 8; ++j) {
                        const int pp = p0 + j;
                        const float cr = kp->s5_c_re[(g * 16 + i) * 64 + pp], ci = kp->s5_c_im[(g * 16 + i) * 64 + pp];
                        const float pr = PW[((g * 64 + pp) * 65 + t + 1) * 2], pi = PW[((g * 64 + pp) * 65 + t + 1) * 2 + 1];
                        o[j] = ri ? -(cr * pi + ci * pr) : (cr * pr - ci * pi);
                    }
                } else {
                    const int kk = (k8 - 16) * 8, s_ = kk >> 4, j0 = kk & 15;
#pragma unroll
                    for (int j = 0; j < 8; ++j) o[j] = (s_ <= t) ? KTAB[((g * 64 + (t - s_)) * 16 + i) * 16 + j0 + j] : 0.f;
                }
                u32x4 w; w.x = pk2(o[0], o[1]); w.y = pk2(o[2], o[3]); w.z = pk2(o[4], o[5]); w.w = pk2(o[6], o[7]);
                *(u32x4*)(BT_MAIN + ((size_t)g * 1024 + n) * 1152 + k8 * 8) = w;
            }
        }
        else if (ph == 3) {
            for (int row = gw; row < T; row += NGW) {
                const u32x2 qv = *(const u32x2*)(Z + (size_t)row * 1024 + lane * 4);
                const unsigned kv = *(const unsigned*)(Z + (size_t)row * 1024 + 256 + lane * 2);
                const float q0 = __uint_as_float(qv.x << 16), q1 = __uint_as_float(qv.x & 0xffff0000u), q2 = __uint_as_float(qv.y << 16), q3 = __uint_as_float(qv.y & 0xffff0000u);
                const float k0 = __uint_as_float(kv << 16), k1 = __uint_as_float(kv & 0xffff0000u);
                const float rq = rsqrtf(wave_sum(q0 * q0 + q1 * q1 + q2 * q2 + q3 * q3) * (1.f / 256.f) + 1e-6f);
                const float rk = rsqrtf(wave_sum(k0 * k0 + k1 * k1) * (1.f / 128.f) + 1e-6f);
                const f32x4 gq = *(const f32x4*)(kp->q_norm_g + lane * 4);
                u32x2 o; o.x = pk2(q0 * rq * gq.x, q1 * rq * gq.y); o.y = pk2(q2 * rq * gq.z, q3 * rq * gq.w);
                *(u32x2*)(QKN + (size_t)row * 384 + lane * 4) = o;
                *(unsigned*)(QKN + (size_t)row * 384 + 256 + lane * 2) = pk2(k0 * rk * kp->kv_norm_g[lane * 2], k1 * rk * kp->kv_norm_g[lane * 2 + 1]);
            }
            for (int u = vb; u < 128; u += G) {
                const int g = u >> 2, pm = u & 3;
                sg_tile(tid, lds, AS5 + ((size_t)g * 512 + pm * 128) * 1152 + 128, 1152, BT_END + (size_t)g * 128 * 1024, 1024, 1024,
                    [=](int r, int c, f32x4 v0, f32x4 v1) {
                        float* o = LEND + ((size_t)g * 512 + pm * 128 + r) * 128 + c;
                        *(f32x4*)o = v0; *(f32x4*)(o + 16) = v1;
                    });
            }
        }
        else if (ph == 4) {
            {
                DenseOrder so; so.go.init(T / 256, 7, G, vb);
                auto f = [=](const pg8::Unit& u, const pg8::NoCtx&, int ai, int m, int bj, int r, int c, f32x4 v0, f32x4 v1) {
                            bf16_t* o = QKVRAW + (size_t)(u.pm * 256 + r) * 1792 + u.pn * 256 + c;
                            u32x2 a; a.x = pk2(v0.x, v0.y); a.y = pk2(v0.z, v0.w); *(u32x2*)o = a;
                            u32x2 b; b.x = pk2(v1.x, v1.y); b.y = pk2(v1.z, v1.w); *(u32x2*)(o + 16) = b;
                        };
                pg8::gemm_phase(tid, (PG8_LAS unsigned char*)lds, pg8::Gemm{QKN, W_UP, 384, 384, 384}, so, pg8::make_epi(pg8::NoPre{}, f));
            }
        }
        else if (ph == 5) {
            bf16_t* stq = (bf16_t*)(lds + 65536) + wave * 1536;
            bf16_t* vts = (bf16_t*)lds;
            const float qscale = 0.10206207261596577f * 1.4426950408889634f;
            for (int tile = vb; tile < T / 64; tile += G) {
                const int hh = lane >> 3, pp = lane & 7;
                for (int tt = 0; tt < 8; ++tt) {
                    const int tl = wave * 8 + tt, row = tile * 64 + tl, b = row / S, t = row % S;
                    float qv[12], kv[12];
#pragma unroll
                    for (int j = 0; j < 12; ++j) {
                        const int d = pp + 8 * j;
                        qv[j] = bf2f(QKVRAW[(size_t)row * 1792 + hh * 96 + d]);
                        kv[j] = (j < 8) ? bf2f(QKVRAW[(size_t)row * 1792 + 768 + hh * 128 + d]) : bf2f(Z[(size_t)row * 1024 + 384 + d - 64]);
                    }
                    float sq = 0.f, sk = 0.f;
#pragma unroll
                    for (int j = 0; j < 12; ++j) { sq += qv[j] * qv[j]; sk += kv[j] * kv[j]; }
                    sq += __shfl_xor(sq, 1); sq += __shfl_xor(sq, 2); sq += __shfl_xor(sq, 4);
                    sk += __shfl_xor(sk, 1); sk += __shfl_xor(sk, 2); sk += __shfl_xor(sk, 4);
                    const float rq = rsqrtf(sq * (1.f / 96.f) + 1e-6f), rk = rsqrtf(sk * (1.f / 96.f) + 1e-6f);
#pragma unroll
                    for (int j = 0; j < 12; ++j) { const int d = pp + 8 * j; qv[j] *= rq * kp->q_head_g[d]; kv[j] *= rk * kp->k_head_g[d]; }
                    const float posf = (float)kp->pos[row];
#pragma unroll
                    for (int e = 0; e < 2; ++e) {
                        const int i = pp + 8 * e;
                        const float invf = exp2f(-(float)i * (13.287712379549449f / 16.0f));
                        const float ang = posf * invf;
                        const float kq = rintf(ang * 0.15915494309189535f);
                        float rr = __builtin_fmaf(-kq, 6.28318548202514648f, ang); rr = __builtin_fmaf(-kq, -1.7484556e-7f, rr);
                        const float cs = __cosf(rr), sn = __sinf(rr);
                        const float q1 = qv[8 + e], q2 = qv[10 + e], k1 = kv[8 + e], k2 = kv[10 + e];
                        qv[8 + e] = q1 * cs - q2 * sn; qv[10 + e] = q1 * sn + q2 * cs;
                        kv[8 + e] = k1 * cs - k2 * sn; kv[10 + e] = k1 * sn + k2 * cs;
                    }
#pragma unroll
                    for (int j = 0; j < 12; ++j) { const int d = pp + 8 * j; stq[hh * 96 + d] = f2bf(qv[j] * qscale); stq[768 + hh * 96 + d] = f2bf(kv[j]); }
#pragma unroll
                    for (int j = 0; j < 8; ++j) { const int dv = pp + 8 * j; vts[(hh * 64 + dv) * 64 + tl] = QKVRAW[(size_t)row * 1792 + 768 + hh * 128 + 64 + dv]; }
                    __builtin_amdgcn_s_waitcnt(0xC07F); asm volatile("" ::: "memory");
                    for (int ch = lane; ch < 192; ch += 64) {
                        const int isk = ch >= 96, c2 = ch - 96 * isk, h2 = c2 / 12, part = c2 % 12;
                        const u32x4 vv = *(const u32x4*)(stq + isk * 768 + h2 * 96 + part * 8);
                        bf16_t* dst = (isk ? Kb : Qb) + (((size_t)b * 8 + h2) * S + t) * 96 + part * 8;
                        *(u32x4*)dst = vv;
                    }
                    __builtin_amdgcn_s_waitcnt(0xC07F); asm volatile("" ::: "memory");
                }
                __syncthreads();
                {
                    const int hd = tid, b = (tile * 64) / S, t0 = (tile * 64) % S;
                    bf16_t* dst = VT + (((size_t)b * 8 + (hd >> 6)) * 64 + (hd & 63)) * S + t0;
#pragma unroll
                    for (int i = 0; i < 8; ++i) *(u32x4*)(dst + i * 8) = *(const u32x4*)(vts + hd * 64 + i * 8);
                }
                __syncthreads();
            }
            for (int ch = vb * NTHR + tid; ch < NB * 32 * 64; ch += G * NTHR) {
                const int pp = ch & 63, g = (ch >> 6) & 31, b = ch >> 11;
                const float ar = PW[((g * 64 + pp) * 65 + 64) * 2], ai = PW[((g * 64 + pp) * 65 + 64) * 2 + 1];
                float cr = 0.f, ci = 0.f;
                for (int c = 0; c < 64; ++c) {
                    bf16_t* dst = AS5 + ((size_t)g * 512 + b * 64 + c) * 1152;
                    dst[pp] = f2bf(cr); dst[64 + pp] = f2bf(ci);
                    const float* le = LEND + ((size_t)g * 512 + b * 64 + c) * 128;
                    const float nr = ar * cr - ai * ci + le[pp], ni = ar * ci + ai * cr + le[64 + pp];
                    cr = nr; ci = ni;
                }
            }
        }
        else if (ph == 6) {
            unsigned char* Ks = lds;
            unsigned char* Vs = lds + 64 * 208;
            const int r32 = lane & 31, hi = lane >> 5;
            for (int ui = 0; ui < 4; ++ui) {
                if (vb >= 256) break;
                const int bh = vb & 63, kq = vb >> 6;
                const int qb = (ui == 0) ? 15 - kq : (ui == 1) ? 8 + kq : (ui == 2) ? 7 - kq : kq;
                const int q0 = qb * 256 + wave * 32;
                const bf16_t* Qg = Qb + ((size_t)bh * S + q0 + r32) * 96;
                const bf16_t* Kg = Kb + (size_t)bh * S * 96;
                const bf16_t* Vg = VT + (size_t)bh * 64 * S;
                bf16x8 qf[6];
#pragma unroll
                for (int d0 = 0; d0 < 6; ++d0) qf[d0] = *(const bf16x8*)(Qg + d0 * 16 + hi * 8);
                f32x16 o0, o1;
#pragma unroll
                for (int r = 0; r < 16; ++r) { o0[r] = 0.f; o1[r] = 0.f; }
                float m_run = -1e30f, l_run = 0.f;
                const int ntile = 4 * (qb + 1);
                u32x4 rk0, rk1, rv;
                const int kr0 = tid / 12, kc0 = tid % 12, kr1 = (tid + 512) / 12, kc1 = (tid + 512) % 12;
                const int vr = tid >> 3, vc = tid & 7;
                rk0 = *(const u32x4*)(Kg + (size_t)kr0 * 96 + kc0 * 8);
                if (tid < 256) rk1 = *(const u32x4*)(Kg + (size_t)kr1 * 96 + kc1 * 8);
                rv = *(const u32x4*)(Vg + (size_t)vr * S + vc * 8);
                for (int t = 0; t < ntile; ++t) {
                    __syncthreads();
                    *(u32x4*)(Ks + kr0 * 208 + kc0 * 16) = rk0;
                    if (tid < 256) *(u32x4*)(Ks + kr1 * 208 + kc1 * 16) = rk1;
                    { u32x2 a; a.x = rv.x; a.y = rv.y; u32x2 b2; b2.x = rv.z; b2.y = rv.w;
                      *(u32x2*)(Vs + vr * 136 + vc * 16) = a; *(u32x2*)(Vs + vr * 136 + vc * 16 + 8) = b2; }
                    __syncthreads();
                    if (t + 1 < ntile) {
                        rk0 = *(const u32x4*)(Kg + (size_t)((t + 1) * 64 + kr0) * 96 + kc0 * 8);
                        if (tid < 256) rk1 = *(const u32x4*)(Kg + (size_t)((t + 1) * 64 + kr1) * 96 + kc1 * 8);
                        rv = *(const u32x4*)(Vg + (size_t)vr * S + (t + 1) * 64 + vc * 8);
                    }
                    if (t * 64 > q0 + 31) continue;
                    f32x16 s0, s1;
#pragma unroll
                    for (int r = 0; r < 16; ++r) { s0[r] = 0.f; s1[r] = 0.f; }
#pragma unroll
                    for (int d0 = 0; d0 < 6; ++d0) {
                        const bf16x8 k0 = *(const bf16x8*)(Ks + r32 * 208 + d0 * 32 + hi * 16);
                        const bf16x8 k1 = *(const bf16x8*)(Ks + (32 + r32) * 208 + d0 * 32 + hi * 16);
                        s0 = __builtin_amdgcn_mfma_f32_32x32x16_bf16(k0, qf[d0], s0, 0, 0, 0);
                        s1 = __builtin_amdgcn_mfma_f32_32x32x16_bf16(k1, qf[d0], s1, 0, 0, 0);
                    }
                    if (t * 64 + 63 > q0) {
                        const int qi = q0 + r32;
#pragma unroll
                        for (int r = 0; r < 16; ++r) {
                            const int key = t * 64 + crow(r, hi);
                            if (key > qi) s0[r] = -INFINITY;
                            if (key + 32 > qi) s1[r] = -INFINITY;
                        }
                    }
                    float mx = s0[0];
#pragma unroll
                    for (int r = 1; r < 16; ++r) mx = fmaxf(mx, s0[r]);
#pragma unroll
                    for (int r = 0; r < 16; ++r) mx = fmaxf(mx, s1[r]);
                    mx = fmaxf(mx, __shfl_xor(mx, 32));
                    const float m_new = fmaxf(m_run, mx);
                    const float alpha = __builtin_amdgcn_exp2f(m_run - m_new);
                    m_run = m_new;
                    float ls = 0.f;
#pragma unroll
                    for (int r = 0; r < 16; ++r) { s0[r] = __builtin_amdgcn_exp2f(s0[r] - m_new); s1[r] = __builtin_amdgcn_exp2f(s1[r] - m_new); ls += s0[r] + s1[r]; }
                    l_run = l_run * alpha + ls;
#pragma unroll
                    for (int r = 0; r < 16; ++r) { o0[r] *= alpha; o1[r] *= alpha; }
                    bf16x8 pf[2][2];
#pragma unroll
                    for (int ks = 0; ks < 2; ++ks) {
                        u32x4 w0, w1;
                        w0.x = pk2(s0[8 * ks + 0], s0[8 * ks + 1]); w0.y = pk2(s0[8 * ks + 2], s0[8 * ks + 3]); w0.z = pk2(s0[8 * ks + 4], s0[8 * ks + 5]); w0.w = pk2(s0[8 * ks + 6], s0[8 * ks + 7]);
                        w1.x = pk2(s1[8 * ks + 0], s1[8 * ks + 1]); w1.y = pk2(s1[8 * ks + 2], s1[8 * ks + 3]); w1.z = pk2(s1[8 * ks + 4], s1[8 * ks + 5]); w1.w = pk2(s1[8 * ks + 6], s1[8 * ks + 7]);
                        pf[0][ks] = __builtin_bit_cast(bf16x8, w0); pf[1][ks] = __builtin_bit_cast(bf16x8, w1);
                    }
#pragma unroll
                    for (int kb = 0; kb < 2; ++kb)
#pragma unroll
                        for (int ks = 0; ks < 2; ++ks) {
                            const int koff = (kb * 32 + 16 * ks + 4 * hi) * 2;
#pragma unroll
                            for (int dvb = 0; dvb < 2; ++dvb) {
                                const unsigned char* vp = Vs + (dvb * 32 + r32) * 136 + koff;
                                const u32x2 lo = *(const u32x2*)vp, hi2 = *(const u32x2*)(vp + 16);
                                u32x4 w; w.x = lo.x; w.y = lo.y; w.z = hi2.x; w.w = hi2.y;
                                const bf16x8 vf = __builtin_bit_cast(bf16x8, w);
                                if (dvb == 0) o0 = __builtin_amdgcn_mfma_f32_32x32x16_bf16(vf, pf[kb][ks], o0, 0, 0, 0);
                                else o1 = __builtin_amdgcn_mfma_f32_32x32x16_bf16(vf, pf[kb][ks], o1, 0, 0, 0);
                            }
                        }
                }
                l_run += __shfl_xor(l_run, 32);
                const float rl = 1.0f / l_run;
                const int b = bh >> 3, h = bh & 7;
                bf16_t* orow = MIXIN + ((size_t)b * S + q0 + r32) * 1024 + h * 64;
#pragma unroll
                for (int rg = 0; rg < 4; ++rg) {
                    u32x2 a; a.x = pk2(o0[4 * rg] * rl, o0[4 * rg + 1] * rl); a.y = pk2(o0[4 * rg + 2] * rl, o0[4 * rg + 3] * rl);
                    *(u32x2*)(orow + 8 * rg + 4 * hi) = a;
                    u32x2 c2; c2.x = pk2(o1[4 * rg] * rl, o1[4 * rg + 1] * rl); c2.y = pk2(o1[4 * rg + 2] * rl, o1[4 * rg + 3] * rl);
                    *(u32x2*)(orow + 32 + 8 * rg + 4 * hi) = c2;
                }
            }
            __syncthreads();
            {
                S5Order so; so.G = G; so.c = vb;
                auto f = [=](const pg8::Unit& u, const pg8::NoCtx&, int ai, int m, int bj, int r, int c, f32x4 v0, f32x4 v1) {
                        const int g = u.aux, mr = (u.pm & 1) * 256 + r, b = mr >> 6, ck = mr & 63;
#pragma unroll
                        for (int h = 0; h < 2; ++h) {
                            const int n = u.pn * 256 + c + 16 * h; const f32x4 v = h ? v1 : v0;
                            const int tq = n >> 4, i = n & 15;
                            const u32x2 uu = *(const u32x2*)(AS5 + ((size_t)g * 512 + mr) * 1152 + 128 + n);
                            const f32x4 dd = *(const f32x4*)(s5d + g * 16 + i);
                            const float y0 = v.x + dd.x * __uint_as_float(uu.x << 16), y1 = v.y + dd.y * __uint_as_float(uu.x & 0xffff0000u),
                                        y2 = v.z + dd.z * __uint_as_float(uu.y << 16), y3 = v.w + dd.w * __uint_as_float(uu.y & 0xffff0000u);
                            u32x2 o; o.x = pk2(gelu_tanh(y0), gelu_tanh(y1)); o.y = pk2(gelu_tanh(y2), gelu_tanh(y3));
                            *(u32x2*)(GACT + ((size_t)b * S + ck * 64 + tq) * 512 + g * 16 + i) = o;
                        }
                    };
                pg8::gemm_phase(tid, (PG8_LAS unsigned char*)lds, pg8::Gemm{AS5, BT_MAIN, 1152, 1152, 1152}, so, pg8::make_epi(pg8::NoPre{}, f));
            }
        }
        else if (ph == 7) {
            {
                DenseOrder so; so.go.init(T / 256, 2, G, vb);
                auto f = [=](const pg8::Unit& u, const pg8::NoCtx&, int ai, int m, int bj, int r, int c, f32x4 v0, f32x4 v1) {
                        const int row = u.pm * 256 + r;
#pragma unroll
                        for (int h = 0; h < 2; ++h) {
                            const int col = u.pn * 256 + c + 16 * h; const f32x4 v = h ? v1 : v0;
                            const u32x2 gg = *(const u32x2*)(GACT + (size_t)row * 512 + col);
                            const f32x4 bb = *(const f32x4*)(glub + col);
                            const float g0 = __uint_as_float(gg.x << 16), g1 = __uint_as_float(gg.x & 0xffff0000u), g2 = __uint_as_float(gg.y << 16), g3 = __uint_as_float(gg.y & 0xffff0000u);
                            u32x2 o; o.x = pk2(g0 * sigmoidf_(v.x + bb.x), g1 * sigmoidf_(v.y + bb.y)); o.y = pk2(g2 * sigmoidf_(v.z + bb.z), g3 * sigmoidf_(v.w + bb.w));
                            *(u32x2*)(MIXIN + (size_t)row * 1024 + 512 + col) = o;
                        }
                    };
                pg8::gemm_phase(tid, (PG8_LAS unsigned char*)lds, pg8::Gemm{GACT, W_GLU, 512, 512, 512}, so, pg8::make_epi(pg8::NoPre{}, f));
            }
        }
        else if (ph == 8 || ph == 16) {
            const int lyr = (ph == 8) ? 0 : 1;
            const bf16_t* W = lyr ? W_OUT_O : W_OUT_E;
            const float* src = lyr ? OUT : XIN;
            {
                DenseOrder so; so.go.init(T / 256, 4, G, vb);
                auto f = [=](const pg8::Unit& u, const pg8::NoCtx&, int ai, int m, int bj, int r, int c, f32x4 v0, f32x4 v1) {
                        const int row = u.pm * 256 + r, b = row / S;
                        const float* gm = MOD + ((size_t)lyr * NB + b) * 6144 + 2 * D;
#pragma unroll
                        for (int h = 0; h < 2; ++h) {
                            const int col = u.pn * 256 + c + 16 * h; const f32x4 v = h ? v1 : v0;
                            const f32x4 xs = *(const f32x4*)(src + (size_t)row * D + col), g4 = *(const f32x4*)(gm + col);
                            f32x4 o; o.x = xs.x + g4.x * v.x; o.y = xs.y + g4.y * v.y; o.z = xs.z + g4.z * v.z; o.w = xs.w + g4.w * v.w;
                            *(f32x4*)(OUT + (size_t)row * D + col) = o;
                        }
                    };
                pg8::gemm_phase(tid, (PG8_LAS unsigned char*)lds, pg8::Gemm{MIXIN, W, D, D, D}, so, pg8::make_epi(pg8::NoPre{}, f));
            }
        }
        else if (mph == 9) {
            const bf16_t* W = W_RT + (size_t)layer * 128 * 1024;
            const float* rb = rtb_all + layer * 32;
            float* lgs = (float*)(lds + 40960);
            unsigned* hist = (unsigned*)(lds + 40960 + 128 * 33 * 4);
            unsigned* gcnt = ctl + CW_CNT + layer * 64;
            const float* ng = kp->norm_ffn_g + layer * D;
            for (int tile = vb; tile < T / 128; tile += G) {
                for (int i = 0; i < 16; ++i) {
                    const int row = tile * 128 + wave * 16 + i, b = row / S;
                    f32x4 v[4];
#pragma unroll
                    for (int j = 0; j < 4; ++j) v[j] = *(const f32x4*)(OUT + (size_t)row * D + 4 * lane + 256 * j);
                    const float* mm = MOD + ((size_t)layer * NB + b) * 6144 + 3 * D;
                    norm_mod_store(v, ng, mm + D, mm, HB + (size_t)row * D, HB8 + (size_t)row * D, lane);
                }
                if (tid < 64) hist[tid] = 0u;
                asm volatile("s_waitcnt vmcnt(0)" ::: "memory");
                __syncthreads();
                sg_tile(tid, lds, HB + (size_t)tile * 128 * D, D, W, D, D,
                    [=](int r, int c, f32x4 v0, f32x4 v1) {
                        if (c < 32) {
#pragma unroll
                            for (int i = 0; i < 4; ++i) { lgs[r * 33 + c + i] = v0[i] + rb[c + i]; lgs[r * 33 + c + 16 + i] = v1[i] + rb[c + 16 + i]; }
                        }
                    });
                __syncthreads();
                const bool act = tid < 128; const int rr = tid & 127;
                float lg[32];
#pragma unroll
                for (int e = 0; e < 32; ++e) lg[e] = lgs[rr * 33 + e];
                int e0 = 0, e1 = 0, e2 = 0, e3 = 0; float v0_ = 0.f, v1_ = 0.f, v2_ = 0.f, v3_ = 0.f;
#pragma unroll
                for (int k = 0; k < 4; ++k) {
                    float best = -INFINITY; int bi = 0;
#pragma unroll
                    for (int e = 0; e < 32; ++e) { const bool tk = lg[e] > best; best = tk ? lg[e] : best; bi = tk ? e : bi; }
                    if (k == 0) { e0 = bi; v0_ = best; } else if (k == 1) { e1 = bi; v1_ = best; } else if (k == 2) { e2 = bi; v2_ = best; } else { e3 = bi; v3_ = best; }
#pragma unroll
                    for (int e = 0; e < 32; ++e) lg[e] = (e == bi) ? -INFINITY : lg[e];
                }
                const float x1_ = __expf(v1_ - v0_), x2_ = __expf(v2_ - v0_), x3_ = __expf(v3_ - v0_);
                const float rden = 1.0f / (1.0f + x1_ + x2_ + x3_);
                unsigned l0 = 0, l1 = 0, l2 = 0, l3 = 0;
                if (act) { l0 = atomicAdd(hist + e0, 1u); l1 = atomicAdd(hist + e1, 1u); l2 = atomicAdd(hist + e2, 1u); l3 = atomicAdd(hist + e3, 1u); }
                __syncthreads();
                if (tid < 32) hist[32 + tid] = atomicAdd(gcnt + tid, (unsigned)hist[tid]);
                __syncthreads();
                if (act) {
                    const int tok = tile * 128 + tid;
                    size_t idx = (size_t)e0 * T + hist[32 + e0] + l0; EL_SLOT[idx] = tok * 4 + 0; EL_GATE[idx] = rden;
                    idx = (size_t)e1 * T + hist[32 + e1] + l1; EL_SLOT[idx] = tok * 4 + 1; EL_GATE[idx] = x1_ * rden;
                    idx = (size_t)e2 * T + hist[32 + e2] + l2; EL_SLOT[idx] = tok * 4 + 2; EL_GATE[idx] = x2_ * rden;
                    idx = (size_t)e3 * T + hist[32 + e3] + l3; EL_SLOT[idx] = tok * 4 + 3; EL_GATE[idx] = x3_ * rden;
                }
                __syncthreads();
            }
        }
        else if (mph == 10 || mph == 11) {
            int* pst = (int*)(lds + LDS_MISC + 1024);
            if (tid == 0) {
                const unsigned* gcnt = ctl + CW_CNT + layer * 64; int acc = 0;
                for (int e = 0; e < 32; ++e) { const int c = (int)gcnt[e]; pst[e] = acc; pst[64 + e] = c; acc += (c + 255) & ~255; }
                pst[32] = acc;
            }
            __syncthreads();
            const int total_rows = pst[32];
            if (mph == 10) {
                {
                    MoeOrder so; so.go.init(total_rows >> 8, 8, G, vb); so.pst = pst; so.NT = 8; so.ebase = layer * 32; so.el_slot = EL_SLOT;
                    struct G1Ctx { f32x4 b0[2], b1[2]; };
                    auto pre = [=](const pg8::Unit& u, int wr, int wc, int fr, int fq) {
                            G1Ctx cx; const float* bg = bgu_all + (size_t)(layer * 32 + u.aux) * 2048;
#pragma unroll
                            for (int bj = 0; bj < 2; ++bj) { const int cc = u.pn * 256 + bj * 128 + wc * 32 + 4 * fq, j = (cc >> 5) * 16 + (cc & 15);
                                cx.b0[bj] = *(const f32x4*)(bg + j); cx.b1[bj] = *(const f32x4*)(bg + 1024 + j); }
                            return cx; };
                    auto f = [=](const pg8::Unit& u, const G1Ctx& cx, int ai, int m, int bj, int tr, int c, f32x4 v0, f32x4 v1, PG8_LAS unsigned char* tile) {
                            const int jl = (c >> 5) * 16 + (c & 15);
                            const f32x4 b0 = cx.b0[bj], b1 = cx.b1[bj];
                            float o[4];
#pragma unroll
                            for (int i = 0; i < 4; ++i) {
                                const float gt = fminf(v0[i] + b0[i], 7.0f), ln = fminf(fmaxf(v1[i] + b1[i], -7.0f), 7.0f);
                                o[i] = gt * sigmoidf_(1.702f * gt) * (ln + 1.0f);
                            }
                            *(PG8_LAS unsigned*)(tile + tr * 144 + jl) = pk4_fp8(o[0], o[1], o[2], o[3]);
                        };
                    auto fl = [=](const pg8::Unit& u, int ai, int m0, int tid_, PG8_LAS unsigned char* tile) {
                            const int tr = tid_ >> 3, piece = tid_ & 7;
                            const u32x4 v = *(const PG8_LAS u32x4*)(tile + tr * 144 + piece * 16);
                            asm volatile("s_waitcnt lgkmcnt(0)" ::: "memory"); __builtin_amdgcn_s_barrier(); asm volatile("" ::: "memory");
                            const int row = u.pm * 256 + ai * 128 + ((tr >> 4) & 1) * 64 + (m0 + (tr >> 5)) * 16 + (tr & 15);
                            *(u32x4*)(ACT + (size_t)row * D + u.pn * 128 + piece * 16) = v;
                        };
                    pg8::gemm_phase<true, true>(tid, (PG8_LAS unsigned char*)lds, pg8::Gemm{(const bf16_t*)HB8, (const bf16_t*)W_GU, 512, 512, 512}, so, pg8::make_epi_staged<2>(pre, f, fl));
                }
            } else {
                {
                    MoeOrder so; so.go.init(total_rows >> 8, 4, G, vb); so.pst = pst; so.NT = 4; so.ebase = layer * 32; so.el_slot = EL_SLOT;
                    struct G2Ctx { float gate[8]; f32x4 bb[2][2]; };
                    auto pre = [=](const pg8::Unit& u, int wr, int wc, int fr, int fq) {
                            G2Ctx cx; const float* bd = bdn_all + (size_t)(layer * 32 + u.aux) * 1024;
#pragma unroll
                            for (int q = 0; q < 8; ++q) { const int ro = u.pm * 256 - pst[u.aux] + (q >> 2) * 128 + wr * 64 + (q & 3) * 16 + fr; cx.gate[q] = (ro < pst[64 + u.aux]) ? EL_GATE[(size_t)u.aux * T + ro] : 0.f; }
#pragma unroll
                            for (int bj = 0; bj < 2; ++bj)
#pragma unroll
                                for (int h = 0; h < 2; ++h) cx.bb[bj][h] = *(const f32x4*)(bd + u.pn * 256 + bj * 128 + wc * 32 + 4 * fq + 16 * h);
                            return cx; };
                    auto f = [=](const pg8::Unit& u, const G2Ctx& cx, int ai, int m, int bj, int tr, int c, f32x4 v0, f32x4 v1, PG8_LAS unsigned char* tile) {
                            const float gt = cx.gate[ai * 4 + m];
#pragma unroll
                            for (int h = 0; h < 2; ++h) {
                                const f32x4 v = h ? v1 : v0; const f32x4 bb = cx.bb[bj][h];
                                u32x2 o; o.x = pk2((v.x + bb.x) * gt, (v.y + bb.y) * gt); o.y = pk2((v.z + bb.z) * gt, (v.w + bb.w) * gt);
                                *(PG8_LAS u32x2*)(tile + tr * 528 + (c + 16 * h) * 2) = o;
                            }
                        };
                    auto fl = [=](const pg8::Unit& u, int ai, int m0, int tid_, PG8_LAS unsigned char* tile) {
                            const int tr = tid_ >> 4, piece = tid_ & 15;
                            const u32x4 va = *(const PG8_LAS u32x4*)(tile + tr * 528 + piece * 16), vb2 = *(const PG8_LAS u32x4*)(tile + tr * 528 + 256 + piece * 16);
                            const int ro = u.pm * 256 - pst[u.aux] + ai * 128 + (tr >> 4) * 64 + m0 * 16 + (tr & 15);
                            const int slot = (ro < pst[64 + u.aux]) ? EL_SLOT[(size_t)u.aux * T + ro] : -1;
                            asm volatile("s_waitcnt lgkmcnt(0)" ::: "memory"); __builtin_amdgcn_s_barrier(); asm volatile("" ::: "memory");
                            if (slot >= 0) { bf16_t* dst = Y + (size_t)slot * D + u.pn * 256 + piece * 8; *(u32x4*)dst = va; *(u32x4*)(dst + 128) = vb2; }
                        };
                    pg8::gemm_phase<true>(tid, (PG8_LAS unsigned char*)lds, pg8::Gemm{(const bf16_t*)ACT, (const bf16_t*)W_DN, 512, 512, 512}, so, pg8::make_epi_staged<1>(pre, f, fl));
                }
            }
        }
        else if (ph == 13) {
            {
                DenseOrder so; so.go.init(T / 256, 6, G, vb);
                auto f = [=](const pg8::Unit& u, const pg8::NoCtx&, int ai, int m, int bj, int r, int c, f32x4 v0, f32x4 v1) {
                        const int row = u.pm * 256 + r;
#pragma unroll
                        for (int h = 0; h < 2; ++h) {
                            const int col = u.pn * 256 + c + 16 * h; f32x4 v = h ? v1 : v0;
                            if (col >= 512) { v.x = gelu_tanh(v.x); v.y = gelu_tanh(v.y); v.z = gelu_tanh(v.z); v.w = gelu_tanh(v.w); }
                            u32x2 o; o.x = pk2(v.x, v.y); o.y = pk2(v.z, v.w);
                            *(u32x2*)(Z + (size_t)row * 1536 + col) = o;
                        }
                    };
                pg8::gemm_phase(tid, (PG8_LAS unsigned char*)lds, pg8::Gemm{HB, W_IN_O, D, D, D}, so, pg8::make_epi(pg8::NoPre{}, f));
            }
        }
        else if (ph == 14) {
            for (int ck = vb; ck < T / 128; ck += G) {
                bf16_t* tile = (bf16_t*)lds;
                for (int tt = 0; tt < 16; ++tt) {
                    const int sl = wave * 16 + tt, row = ck * 128 + sl, t = row % S;
                    {
                        const int ch0 = lane * 8, w = 2 << (ch0 >> 7);
                        float acc[8], own[8];
#pragma unroll
                        for (int i = 0; i < 8; ++i) acc[i] = 0.f;
                        const int n = (t + 1 < w) ? t + 1 : w;
                        for (int q = 0; q < n; ++q) {
                            const u32x4 uv = *(const u32x4*)(Z + (size_t)(row - q) * 1536 + ch0);
                            const float f[8] = {__uint_as_float(uv.x << 16), __uint_as_float(uv.x & 0xffff0000u), __uint_as_float(uv.y << 16), __uint_as_float(uv.y & 0xffff0000u),
                                                __uint_as_float(uv.z << 16), __uint_as_float(uv.z & 0xffff0000u), __uint_as_float(uv.w << 16), __uint_as_float(uv.w & 0xffff0000u)};
#pragma unroll
                            for (int i = 0; i < 8; ++i) { acc[i] += f[i]; if (q == 0) own[i] = f[i]; }
                        }
                        const float inv = 1.0f / (float)n;
                        u32x4 o; o.x = pk2(acc[0] * inv - own[0], acc[1] * inv - own[1]); o.y = pk2(acc[2] * inv - own[2], acc[3] * inv - own[3]);
                        o.z = pk2(acc[4] * inv - own[4], acc[5] * inv - own[5]); o.w = pk2(acc[6] * inv - own[6], acc[7] * inv - own[7]);
                        *(u32x4*)(POOLED + (size_t)row * 512 + ch0) = o;
                    }
                    {
                        const u32x4 uv = *(const u32x4*)(Z + (size_t)row * 1536 + 1024 + lane * 8);
                        float f[8] = {__uint_as_float(uv.x << 16), __uint_as_float(uv.x & 0xffff0000u), __uint_as_float(uv.y << 16), __uint_as_float(uv.y & 0xffff0000u),
                                      __uint_as_float(uv.z << 16), __uint_as_float(uv.z & 0xffff0000u), __uint_as_float(uv.w << 16), __uint_as_float(uv.w & 0xffff0000u)};
                        float ss = 0.f;
#pragma unroll
                        for (int i = 0; i < 8; ++i) ss += f[i] * f[i];
                        const float rr = rsqrtf(wave_sum(ss) * (1.f / 512.f) + 1e-6f);
                        u32x4 o;
                        const float* gg = kp->sgu_norm_g + lane * 8;
                        o.x = pk2(f[0] * rr * gg[0], f[1] * rr * gg[1]); o.y = pk2(f[2] * rr * gg[2], f[3] * rr * gg[3]);
                        o.z = pk2(f[4] * rr * gg[4], f[5] * rr * gg[5]); o.w = pk2(f[6] * rr * gg[6], f[7] * rr * gg[7]);
                        *(u32x4*)(tile + sl * 520 + lane * 8) = o;
                    }
                }
                __syncthreads();
                {
                    const int ch = tid;
                    bf16_t* dst = VTS + ((size_t)ck * 512 + ch) * 128;
                    for (int s8 = 0; s8 < 16; ++s8) {
                        unsigned w[4];
#pragma unroll
                        for (int i = 0; i < 4; ++i) w[i] = (unsigned)tile[(s8 * 8 + 2 * i) * 520 + ch] | ((unsigned)tile[(s8 * 8 + 2 * i + 1) * 520 + ch] << 16);
                        u32x4 o; o.x = w[0]; o.y = w[1]; o.z = w[2]; o.w = w[3];
                        *(u32x4*)(dst + s8 * 8) = o;
                    }
                }
                __syncthreads();
            }
        }
        else if (ph == 15) {
            for (int u = vb; u < 2048; u += G) {
                if (u < 1024) {
                    const int pm = u >> 2, gi = u & 3;
                    sg_tile(tid, lds, POOLED + (size_t)pm * 128 * 512 + gi * 128, 512, W_POOL + (size_t)gi * 128 * 128, 128, 128,
                        [=](int r, int c, f32x4 v0, f32x4 v1) {
                            const int row = pm * 128 + r;
#pragma unroll
                            for (int h = 0; h < 2; ++h) {
                                const int col = gi * 128 + c + 16 * h; const f32x4 v = h ? v1 : v0;
                                const f32x4 sc = *(const f32x4*)(poolsc + col);
                                u32x2 o; o.x = pk2(v.x * sc.x, v.y * sc.y); o.y = pk2(v.z * sc.z, v.w * sc.w);
                                *(u32x2*)(MIXIN + (size_t)row * 1024 + col) = o;
                            }
                        });
                } else {
                    const int uu = u - 1024, ck = uu >> 2, h4 = uu & 3;
                    sg_tile(tid, lds, W_SGU + (size_t)h4 * 128 * 128, 128, VTS + ((size_t)ck * 512 + h4 * 128) * 128, 128, 128,
                        [=](int r, int c, f32x4 v0, f32x4 v1) {
                            const int row = ck * 128 + r;
                            const float bias = sgub[h4 * 128 + r];
#pragma unroll
                            for (int h = 0; h < 2; ++h) {
                                const int dcol = c + 16 * h; const f32x4 v = h ? v1 : v0;
                                const u32x2 ug = *(const u32x2*)(Z + (size_t)row * 1536 + 512 + h4 * 128 + dcol);
                                u32x2 o; o.x = pk2((v.x + bias) * __uint_as_float(ug.x << 16), (v.y + bias) * __uint_as_float(ug.x & 0xffff0000u));
                                o.y = pk2((v.z + bias) * __uint_as_float(ug.y << 16), (v.w + bias) * __uint_as_float(ug.y & 0xffff0000u));
                                *(u32x2*)(MIXIN + (size_t)row * 1024 + 512 + h4 * 128 + dcol) = o;
                            }
                        });
                }
            }
        }

    }
}
template <int PH> struct PhaseSeq {
    static __device__ __forceinline__ void run(const XcdBarrier& bar) { PhaseSeq<PH - 1>::run(bar); phase_body<PH>();
        if constexpr (((PROBE_DUP_MASK >> PH) & 1ull) != 0) { xcd_barrier(bar); phase_body<PH>(); }
        if (PH + 1 < NPHASE) xcd_barrier(bar); }
};
template <> struct PhaseSeq<-1> { static __device__ __forceinline__ void run(const XcdBarrier&) {} };

template <int PHSEL> __global__ void __launch_bounds__(NTHR, 2) hybrid_fwd(Params p) {
    extern __shared__ __attribute__((aligned(16))) unsigned char lds[];
    const int tid0 = threadIdx.x;
    for (int u = tid0; u < (LDS_BYTES - LDS_MISC) / 4; u += NTHR) ((unsigned*)(lds + LDS_MISC))[u] = 0u;
    __syncthreads();
    if constexpr (PHSEL >= 0) { phase_body<PHSEL>(); }
    else {
        volatile LAS unsigned* MISC = (volatile LAS unsigned*)((LAS unsigned char*)lds + LDS_MISC);
        unsigned* ctl0 = (unsigned*)(p.ws + WS_CTL);
        XcdBarrier bar = xcd_barrier_post(ctl0 + CW_BAR, MISC + 8);
        PhaseSeq<NPHASE - 1>::run(bar);
    }
}

typedef void (*kfn_t)(Params);
template <int PH> struct Tab { static void fill(kfn_t* t) { t[PH] = hybrid_fwd<PH>; Tab<PH - 1>::fill(t); } };
template <> struct Tab<-1> { static void fill(kfn_t*) {} };
static kfn_t g_tab[NPHASE];
static void set_attrs() {
#if MK_ONE_LAUNCH
    (void)hipFuncSetAttribute((const void*)hybrid_fwd<-1>, hipFuncAttributeMaxDynamicSharedMemorySize, LDS_BYTES);
#else
    Tab<NPHASE - 1>::fill(g_tab);
    for (int i = 0; i < NPHASE; ++i) (void)hipFuncSetAttribute((const void*)g_tab[i], hipFuncAttributeMaxDynamicSharedMemorySize, LDS_BYTES);
#endif
}
#if !MK_ONE_LAUNCH
static void launch_all(const Params& p, int grid, hipStream_t stream) {
    for (int ph = 0; ph < NPHASE; ++ph) hipLaunchKernelGGL(g_tab[ph], dim3(grid), dim3(NTHR), LDS_BYTES, stream, p);
}
#endif
extern "C" void kernel_launch(void* const* d_in, const int* in_sizes, int n_in, void* d_out, int out_size, void* d_ws, size_t ws_size, hipStream_t stream) {
    static int ready = 0;
    if (ready == 0) {
        if (n_in != 38 || ws_size < WS_END) { fprintf(stderr, "kernel_launch: unexpected n_in %d / ws %zu\n", n_in, ws_size); ready = -1; return; }
        set_attrs();
        ready = 1;
    }
    if (ready < 0) return;
    (void)hipMemsetAsync((char*)d_ws + WS_CTL, 0, CTL_ZERO_BYTES, stream);
    Params p{};
    const float** fp = (const float**)&p.x;
    (void)fp;
    p.x = (const float*)d_in[0]; p.c = (const float*)d_in[1]; p.pos = (const int*)d_in[2];
    p.ada_w = (const float*)d_in[3]; p.ada_b = (const float*)d_in[4]; p.norm_mix_g = (const float*)d_in[5]; p.norm_ffn_g = (const float*)d_in[6];
    p.router_w = (const float*)d_in[7]; p.router_b = (const float*)d_in[8]; p.moe_w_gu = (const float*)d_in[9]; p.moe_b_gu = (const float*)d_in[10];
    p.moe_w_dn = (const float*)d_in[11]; p.moe_b_dn = (const float*)d_in[12];
    p.even_w_in = (const float*)d_in[13]; p.q_norm_g = (const float*)d_in[14]; p.w_uq = (const float*)d_in[15]; p.kv_norm_g = (const float*)d_in[16];
    p.w_ukv = (const float*)d_in[17]; p.q_head_g = (const float*)d_in[18]; p.k_head_g = (const float*)d_in[19];
    p.s5_a_re = (const float*)d_in[20]; p.s5_a_im = (const float*)d_in[21]; p.s5_log_dt = (const float*)d_in[22]; p.s5_b_re = (const float*)d_in[23];
    p.s5_b_im = (const float*)d_in[24]; p.s5_c_re = (const float*)d_in[25]; p.s5_c_im = (const float*)d_in[26]; p.s5_d = (const float*)d_in[27];
    p.s5_glu_w = (const float*)d_in[28]; p.s5_glu_b = (const float*)d_in[29]; p.even_w_out = (const float*)d_in[30];
    p.odd_w_in = (const float*)d_in[31]; p.pool_w = (const float*)d_in[32]; p.pool_scale = (const float*)d_in[33]; p.sgu_norm_g = (const float*)d_in[34];
    p.sgu_w = (const float*)d_in[35]; p.sgu_b = (const float*)d_in[36]; p.odd_w_out = (const float*)d_in[37];
    p.out = (float*)d_out; p.ws = (unsigned char*)d_ws;
    const int grid = 256;
#if MK_ONE_LAUNCH
    p.ph_lo = 0; p.ph_hi = NPHASE;
    hipLaunchKernelGGL(hybrid_fwd<-1>, dim3(grid), dim3(NTHR), LDS_BYTES, stream, p);
#else
    p.ph_lo = 0; p.ph_hi = 1;
    launch_all(p, grid, stream);
#endif
}
```

```cpp
#include <hip/hip_runtime.h>
#include <cstdio>
#include <cstdint>

#ifndef PROBE_DUP_MASK
#define PROBE_DUP_MASK 0x0ull
#endif
#ifndef PROBE_ATT2
#define PROBE_ATT2 0
#endif
#ifndef PROBE_RT2
#define PROBE_RT2 0
#endif
#ifndef PROBE_TPH
#define PROBE_TPH -1
#endif
#ifndef PROBE_SEG
#define PROBE_SEG 0
#endif
#ifndef PROBE_BAR2
#define PROBE_BAR2 0
#endif
#ifndef PROBE_EPI2
#define PROBE_EPI2 0
#endif
#ifndef PROBE_KX2
#define PROBE_KX2 0
#endif
#ifndef MK_ONE_LAUNCH
#define MK_ONE_LAUNCH 1
#endif

typedef unsigned short bf16_t;
typedef short bf16x8 __attribute__((ext_vector_type(8)));
typedef short s16x4 __attribute__((ext_vector_type(4)));
typedef float f32x4 __attribute__((ext_vector_type(4)));
typedef float f32x16 __attribute__((ext_vector_type(16)));
typedef unsigned u32x4 __attribute__((ext_vector_type(4)));
typedef unsigned u32x2 __attribute__((ext_vector_type(2)));

constexpr int D = 1024, NB = 8, S = 4096, T = NB * S;
constexpr int NTHR = 512, NWAVE = 8;
constexpr int MOE_ROWS = 139264;
constexpr int NPHASE = 21;

constexpr size_t MiB = 1u << 20;
constexpr size_t WS_CTL = 0, CTL_ZERO_BYTES = 1 * MiB;
constexpr size_t WS_MOD = 1 * MiB;
constexpr size_t WS_S5AB = 2 * MiB;
constexpr size_t WS_PW = 3 * MiB;
constexpr size_t WS_KTAB = 5 * MiB;
constexpr size_t WS_TOK = 7 * MiB;
constexpr size_t WS_ROW = 9 * MiB;
constexpr size_t WS_LOGIT = 11 * MiB;
constexpr size_t WS_W_IN_E = 16 * MiB, WS_W_UP = 18 * MiB  , WS_W_GLU = 20 * MiB, WS_W_OUT_E = 21 * MiB, WS_W_IN_O = 23 * MiB,
                 WS_W_OUT_O = 26 * MiB, WS_W_POOL = 28 * MiB, WS_W_SGU = 29 * MiB, WS_W_RT = 30 * MiB;
constexpr size_t WS_BT_END = 32 * MiB;
constexpr size_t WS_BT_MAIN = 40 * MiB;
constexpr size_t WS_W_GU = 112 * MiB;
constexpr size_t WS_W_DN = 240 * MiB;
constexpr size_t WS_HB8 = 304 * MiB;
constexpr size_t WS_XR = 336 * MiB;
constexpr size_t WS_HB = 496 * MiB;
constexpr size_t WS_MIXIN = 560 * MiB;
constexpr size_t WS_Y = 624 * MiB;
constexpr size_t WS_EL = 880 * MiB;
constexpr size_t WS_ACT = 1152 * MiB;
constexpr size_t WS_END = 1424 * MiB;
constexpr size_t WS_Z = 880 * MiB;
constexpr size_t WS_RSP = 976 * MiB  , WS_QKVRAW = 1000 * MiB  , WS_Q = 1112 * MiB, WS_K = 1160 * MiB, WS_VT = 1208 * MiB,
                 WS_AS5 = 1240 * MiB, WS_LEND = 1276 * MiB, WS_GACT = 1284 * MiB;
constexpr size_t WS_POOLED = 976 * MiB, WS_VTS = 1008 * MiB;
constexpr int CW_BAR = 4096, CW_CNT = 16384;

constexpr int LDS_BYTES = 160 * 1024;
constexpr int LDS_CTX_OFF = 18432;
constexpr int LDS_MISC = 158 * 1024;

struct Params {
    const float *x, *c; const int* pos;
    const float *ada_w, *ada_b, *norm_mix_g, *norm_ffn_g, *router_w, *router_b, *moe_w_gu, *moe_b_gu, *moe_w_dn, *moe_b_dn;
    const float *even_w_in, *q_norm_g, *w_uq, *kv_norm_g, *w_ukv, *q_head_g, *k_head_g;
    const float *s5_a_re, *s5_a_im, *s5_log_dt, *s5_b_re, *s5_b_im, *s5_c_re, *s5_c_im, *s5_d, *s5_glu_w, *s5_glu_b, *even_w_out;
    const float *odd_w_in, *pool_w, *pool_scale, *sgu_norm_g, *sgu_w, *sgu_b, *odd_w_out;
    float* out; unsigned char* ws; int ph_lo, ph_hi;
};

__device__ __forceinline__ float bf2f(unsigned short b) { return __uint_as_float(((unsigned)b) << 16); }
__device__ __forceinline__ unsigned pk2(float lo, float hi) {
    typedef float f2 __attribute__((ext_vector_type(2))); typedef __bf16 b2 __attribute__((ext_vector_type(2)));
    f2 v = {lo, hi}; b2 b = __builtin_convertvector(v, b2); return __builtin_bit_cast(unsigned, b);
}
__device__ __forceinline__ unsigned short f2bf(float f) { return (unsigned short)(pk2(f, 0.f) & 0xffffu); }
__device__ __forceinline__ float wave_sum(float v) {
#pragma unroll
    for (int o = 1; o < 64; o <<= 1) v += __shfl_xor(v, o);
    return v;
}
__device__ __forceinline__ float sigmoidf_(float x) { return __builtin_amdgcn_rcpf(1.0f + __builtin_amdgcn_exp2f(-1.4426950408889634f * x)); }
__device__ __forceinline__ float gelu_tanh(float x) {
    const float u = 0.7978845608028654f * (x + 0.044715f * x * x * x);
    return x * sigmoidf_(2.0f * u);
}
__device__ __forceinline__ unsigned pk4_fp8(float a, float b, float c, float d) {
    int w = 0; w = __builtin_amdgcn_cvt_pk_fp8_f32(a, b, w, false); w = __builtin_amdgcn_cvt_pk_fp8_f32(c, d, w, true); return (unsigned)w;
}
__device__ __forceinline__ int crow(int r, int hi) { return (r & 3) + 8 * (r >> 2) + 4 * hi; }

#define LAS __attribute__((address_space(3)))
#define XB_TMO      128
#define XB_XCNT(j)  (256  + 64 * (j))
#define XB_XSUB(j)  (1280 + 64 * (j))
#define XB_XGEN(j)  (2304 + 64 * (j))
#define XB_TOP      3328
#define XB_TOPGEN   3392
#define XCD_BAR_WORDS 3456
#define XB_SPIN_CAP (1u << 20)
__device__ __forceinline__ unsigned xb_ld(unsigned* p)              { return __hip_atomic_load(p, __ATOMIC_RELAXED, __HIP_MEMORY_SCOPE_AGENT); }
__device__ __forceinline__ unsigned xb_add(unsigned* p, unsigned v) { return __hip_atomic_fetch_add(p, v, __ATOMIC_RELAXED, __HIP_MEMORY_SCOPE_AGENT); }
__device__ __forceinline__ unsigned xb_xcc_id() { return (unsigned)__builtin_amdgcn_s_getreg((3 << 11) | 20) & 0xFu; }
#define XB_SPIN(cond, bar) do { unsigned _sp = 0; while (cond) { __builtin_amdgcn_s_sleep(1); \
    if ((++_sp & 255u) == 0u) { if (xb_ld(&(bar)[XB_TMO])) break; if (_sp > XB_SPIN_CAP) { atomicAdd(&(bar)[XB_TMO], 1u); break; } } } } while (0)
struct XcdBarrier { unsigned* bar; unsigned x; volatile LAS unsigned* st; int wbase; };
__device__ __forceinline__ int lane_id() { int l; asm volatile("v_mbcnt_lo_u32_b32 %0, -1, 0\n\tv_mbcnt_hi_u32_b32 %0, -1, %0" : "=v"(l)); return l; }
__device__ __forceinline__ XcdBarrier xcd_barrier_post(unsigned* bar, volatile LAS unsigned* st) {
    XcdBarrier b; b.bar = bar; b.x = xb_xcc_id(); b.st = st; b.wbase = __builtin_amdgcn_readfirstlane((int)threadIdx.x & ~63);
    if (threadIdx.x == 0) (void)xb_add(&bar[XB_XCNT(b.x)], 1u);
    return b;
}
__device__ __forceinline__ void xcd_barrier_complete(unsigned* bar, unsigned x, unsigned& nloc, unsigned& nx) {
    const unsigned G = gridDim.x * gridDim.y * gridDim.z;
    unsigned sum, cnt, mine, sp = 0u;
    for (;;) {
        sum = 0u; cnt = 0u; mine = 0u;
#pragma unroll
        for (unsigned j = 0; j < 16; ++j) { const unsigned c = xb_ld(&bar[XB_XCNT(j)]); sum += c; cnt += (c > 0u) ? 1u : 0u; mine = (j == x) ? c : mine; }
        if (sum == G) break;
        __builtin_amdgcn_s_sleep(1);
        if ((++sp & 255u) == 0u) { if (xb_ld(&bar[XB_TMO])) break; if (sp > XB_SPIN_CAP) { atomicAdd(&bar[XB_TMO], 1u); break; } }
    }
    nloc = mine > 0u ? mine : 1u; nx = cnt > 0u ? cnt : 1u;
}
__device__ __forceinline__ void xcd_barrier(const XcdBarrier& b) {
    asm volatile("s_waitcnt vmcnt(0)" ::: "memory");
    __syncthreads();
    if (b.wbase == 0 && lane_id() == 0) {
        unsigned* bar = b.bar;
        __builtin_amdgcn_s_waitcnt(0);
        unsigned nloc = b.st[0], nx = b.st[1];
        if (nloc == 0u) { xcd_barrier_complete(bar, b.x, nloc, nx); b.st[0] = nloc; b.st[1] = nx; }
        const unsigned old = xb_add(&bar[XB_XSUB(b.x)], 1u);
        const unsigned gen = old / nloc;
        if (old + 1u == (gen + 1u) * nloc) {
            __builtin_amdgcn_fence(__ATOMIC_RELEASE, "agent");
            asm volatile("s_waitcnt vmcnt(0)" ::: "memory");
            const unsigned og = xb_add(&bar[XB_TOP], 1u);
            const unsigned tg = og / nx;
            if (og + 1u == (tg + 1u) * nx) xb_add(&bar[XB_TOPGEN], 1u);
            else XB_SPIN(xb_ld(&bar[XB_TOPGEN]) == tg, bar);
            __builtin_amdgcn_fence(__ATOMIC_ACQUIRE, "agent");
            xb_add(&bar[XB_XGEN(b.x)], 1u);
            asm volatile("s_waitcnt vmcnt(0)" ::: "memory");
        } else {
            XB_SPIN(xb_ld(&bar[XB_XGEN(b.x)]) == gen, bar);
            __builtin_amdgcn_fence(__ATOMIC_ACQUIRE, "agent");
            asm volatile("s_waitcnt vmcnt(0)" ::: "memory");
        }
    }
    __syncthreads();
}

constexpr int SG_LDS = 2 * 128 * 144;
template <class Epi>
__device__ __forceinline__ void sg_tile(int tid, unsigned char* lds, const bf16_t* A, int lda, const bf16_t* Bt, int ldb, int K, Epi epi) {
    const int lane = tid & 63, wid = tid >> 6, wr = wid >> 2, wc = wid & 3, fr = lane & 15, fq = lane >> 4;
    unsigned char* As = lds; unsigned char* Bs = lds + 128 * 144;
    f32x4 acc[4][2];
#pragma unroll
    for (int m = 0; m < 4; ++m)
#pragma unroll
        for (int n = 0; n < 2; ++n) acc[m][n] = (f32x4){0.f, 0.f, 0.f, 0.f};
    const int nt = K / 64;
    u32x4 ra[2], rb[2];
    const int r0 = tid >> 3, cc = tid & 7;
#pragma unroll
    for (int i = 0; i < 2; ++i) {
        ra[i] = *(const u32x4*)(A + (size_t)(r0 + 64 * i) * lda + cc * 8);
        rb[i] = *(const u32x4*)(Bt + (size_t)(r0 + 64 * i) * ldb + cc * 8);
    }
    for (int kt = 0; kt < nt; ++kt) {
        __syncthreads();
#pragma unroll
        for (int i = 0; i < 2; ++i) {
            *(u32x4*)(As + (r0 + 64 * i) * 144 + cc * 16) = ra[i];
            *(u32x4*)(Bs + (r0 + 64 * i) * 144 + cc * 16) = rb[i];
        }
        __syncthreads();
        if (kt + 1 < nt) {
#pragma unroll
            for (int i = 0; i < 2; ++i) {
                ra[i] = *(const u32x4*)(A + (size_t)(r0 + 64 * i) * lda + (kt + 1) * 64 + cc * 8);
                rb[i] = *(const u32x4*)(Bt + (size_t)(r0 + 64 * i) * ldb + (kt + 1) * 64 + cc * 8);
            }
        }
#pragma unroll
        for (int kk = 0; kk < 2; ++kk) {
            bf16x8 a[4], b[2];
#pragma unroll
            for (int m = 0; m < 4; ++m) a[m] = *(const bf16x8*)(As + (wr * 64 + m * 16 + fr) * 144 + kk * 64 + fq * 16);
#pragma unroll
            for (int n = 0; n < 2; ++n) b[n] = *(const bf16x8*)(Bs + (wc * 32 + n * 16 + fr) * 144 + kk * 64 + fq * 16);
#pragma unroll
            for (int m = 0; m < 4; ++m)
#pragma unroll
                for (int n = 0; n < 2; ++n) acc[m][n] = __builtin_amdgcn_mfma_f32_16x16x32_bf16(b[n], a[m], acc[m][n], 0, 0, 0);
        }
    }
#pragma unroll
    for (int m = 0; m < 4; ++m) epi(wr * 64 + m * 16 + fr, wc * 32 + fq * 4, acc[m][0], acc[m][1]);
}


namespace pg8 {
#define PG8_LAS __attribute__((address_space(3)))
constexpr int BM = 256, BK = 64, HALF = 128, HTB = HALF * BK * 2, STAGE_BYTES = 8 * HTB;
__device__ __forceinline__ int lds_byte(int r, int c) { const int st = (r >> 4) * 2 + (c >> 5), rr = r & 15, cc = c & 31, ob = rr * 64 + cc * 2; return st * 1024 + (ob ^ (((ob >> 9) & 1) << 5)); }
__device__ __forceinline__ void stage_rc(int b, int& R, int& C) { const int st = b / 1024, sb = b % 1024, swz = sb ^ (((sb >> 9) & 1) << 5); R = (st >> 1) * 16 + swz / 64; C = (st & 1) * 32 + (swz % 64) / 2; }
typedef int v8i_t __attribute__((ext_vector_type(8)));
typedef int v4i_t __attribute__((ext_vector_type(4)));
struct FragT { union { v8i_t v; struct { v4i_t lo, hi; }; }; };
struct Unit { int pm, pb, pn, aux; };
struct Gemm { const bf16_t* A; const bf16_t* Bt; int lda, ldb, K; };
struct NoCtx {};
struct NoPre { __device__ __forceinline__ NoCtx operator()(const Unit&, int, int, int, int, const PG8_LAS unsigned char*) const { return NoCtx{}; } };
struct NoStage { __device__ __forceinline__ void operator()(const Unit&, PG8_LAS unsigned char*, int, int) const {} };
template <class PF, class F> struct Epi {
    PF pre; F f;
    template <class Ctx>
    __device__ __forceinline__ void operator()(const f32x4 (&acc)[2][2][4][2], const Ctx& ctx, const Unit& u, int wr, int wc, int fr, int fq, PG8_LAS unsigned char*, int) const {
#pragma unroll
        for (int ai = 0; ai < 2; ++ai)
#pragma unroll
            for (int m = 0; m < 4; ++m)
#pragma unroll
                for (int bj = 0; bj < 2; ++bj) {
                    f32x4 v0, v1;
                    asm volatile("v_accvgpr_read_b32 %0, %8\n\tv_accvgpr_read_b32 %1, %9\n\tv_accvgpr_read_b32 %2, %10\n\tv_accvgpr_read_b32 %3, %11\n\t"
                                 "v_accvgpr_read_b32 %4, %12\n\tv_accvgpr_read_b32 %5, %13\n\tv_accvgpr_read_b32 %6, %14\n\tv_accvgpr_read_b32 %7, %15"
                                 : "=v"(v0.x), "=v"(v0.y), "=v"(v0.z), "=v"(v0.w), "=v"(v1.x), "=v"(v1.y), "=v"(v1.z), "=v"(v1.w)
                                 : "a"(acc[ai][bj][m][0].x), "a"(acc[ai][bj][m][0].y), "a"(acc[ai][bj][m][0].z), "a"(acc[ai][bj][m][0].w),
                                   "a"(acc[ai][bj][m][1].x), "a"(acc[ai][bj][m][1].y), "a"(acc[ai][bj][m][1].z), "a"(acc[ai][bj][m][1].w));
                    f(u, ctx, ai, m, bj, ai * HALF + wr * 64 + m * 16 + fr, bj * HALF + wc * 32 + 4 * fq, v0, v1);
                }
    }
};
template <class PF, class F> __device__ __forceinline__ Epi<PF, F> make_epi(PF p, F f) { return Epi<PF, F>{p, f}; }
template <class PF, class F> struct EpiPerm {
    PF pre; F f;
    template <class Ctx>
    __device__ __forceinline__ void operator()(const f32x4 (&acc)[2][2][4][2], const Ctx& ctx, const Unit& u, int wr, int wc, int fr, int fq, PG8_LAS unsigned char*, int) const {
#pragma unroll
        for (int ai = 0; ai < 2; ++ai)
#pragma unroll
            for (int m = 0; m < 4; ++m)
#pragma unroll
                for (int bj = 0; bj < 2; ++bj) {
                    f32x4 v0, v1;
                    asm volatile("v_accvgpr_read_b32 %0, %8\n\tv_accvgpr_read_b32 %1, %9\n\tv_accvgpr_read_b32 %2, %10\n\tv_accvgpr_read_b32 %3, %11\n\t"
                                 "v_accvgpr_read_b32 %4, %12\n\tv_accvgpr_read_b32 %5, %13\n\tv_accvgpr_read_b32 %6, %14\n\tv_accvgpr_read_b32 %7, %15"
                                 : "=v"(v0.x), "=v"(v0.y), "=v"(v0.z), "=v"(v0.w), "=v"(v1.x), "=v"(v1.y), "=v"(v1.z), "=v"(v1.w)
                                 : "a"(acc[ai][bj][m][0].x), "a"(acc[ai][bj][m][0].y), "a"(acc[ai][bj][m][0].z), "a"(acc[ai][bj][m][0].w),
                                   "a"(acc[ai][bj][m][1].x), "a"(acc[ai][bj][m][1].y), "a"(acc[ai][bj][m][1].z), "a"(acc[ai][bj][m][1].w));
                    f(u, ctx, ai, m, bj, ai * HALF + wr * 64 + m * 16 + fr, bj * HALF + wc * 32 + 8 * fq, v0, v1);
                }
    }
};
template <class PF, class F> __device__ __forceinline__ EpiPerm<PF, F> make_epi_perm(PF p, F f) { return EpiPerm<PF, F>{p, f}; }
template <class PF, class F, class RE> struct EpiRow {
    PF pre; F f; RE re;
    template <class Ctx>
    __device__ __forceinline__ void operator()(const f32x4 (&acc)[2][2][4][2], const Ctx& ctx, const Unit& u, int wr, int wc, int fr, int fq, PG8_LAS unsigned char*, int) const {
#pragma unroll
        for (int ai = 0; ai < 2; ++ai)
#pragma unroll
            for (int m = 0; m < 4; ++m) {
                float part = 0.f;
#pragma unroll
                for (int bj = 0; bj < 2; ++bj) {
                    f32x4 v0, v1;
                    asm volatile("v_accvgpr_read_b32 %0, %8\n\tv_accvgpr_read_b32 %1, %9\n\tv_accvgpr_read_b32 %2, %10\n\tv_accvgpr_read_b32 %3, %11\n\t"
                                 "v_accvgpr_read_b32 %4, %12\n\tv_accvgpr_read_b32 %5, %13\n\tv_accvgpr_read_b32 %6, %14\n\tv_accvgpr_read_b32 %7, %15"
                                 : "=v"(v0.x), "=v"(v0.y), "=v"(v0.z), "=v"(v0.w), "=v"(v1.x), "=v"(v1.y), "=v"(v1.z), "=v"(v1.w)
                                 : "a"(acc[ai][bj][m][0].x), "a"(acc[ai][bj][m][0].y), "a"(acc[ai][bj][m][0].z), "a"(acc[ai][bj][m][0].w),
                                   "a"(acc[ai][bj][m][1].x), "a"(acc[ai][bj][m][1].y), "a"(acc[ai][bj][m][1].z), "a"(acc[ai][bj][m][1].w));
                    part += f(u, ctx, ai, m, bj, ai * HALF + wr * 64 + m * 16 + fr, bj * HALF + wc * 32 + 4 * fq, v0, v1);
                }
                re(u, ai, m, ai * HALF + wr * 64 + m * 16 + fr, wc, fq, part);
            }
    }
};
template <class PF, class F, class RE> __device__ __forceinline__ EpiRow<PF, F, RE> make_epi_row(PF p, F f, RE r) { return EpiRow<PF, F, RE>{p, f, r}; }
template <class PF, class GP, class F> struct EpiG {
    PF pre; GP gp; F f;
    template <class Ctx>
    __device__ __forceinline__ void operator()(const f32x4 (&acc)[2][2][4][2], const Ctx& ctx, const Unit& u, int wr, int wc, int fr, int fq, PG8_LAS unsigned char*, int) const {
        auto gcur = gp(u, ctx, wr * 64 + fr, wc, fq);
#pragma unroll
        for (int ai = 0; ai < 2; ++ai)
#pragma unroll
            for (int m = 0; m < 4; ++m) {
                const int gn = ai * 4 + m + 1;
                auto gnxt = gcur;
                if (gn < 8) gnxt = gp(u, ctx, (gn >> 2) * HALF + wr * 64 + (gn & 3) * 16 + fr, wc, fq);
#pragma unroll
                for (int bj = 0; bj < 2; ++bj) {
                    f32x4 v0, v1;
                    asm volatile("v_accvgpr_read_b32 %0, %8\n\tv_accvgpr_read_b32 %1, %9\n\tv_accvgpr_read_b32 %2, %10\n\tv_accvgpr_read_b32 %3, %11\n\t"
                                 "v_accvgpr_read_b32 %4, %12\n\tv_accvgpr_read_b32 %5, %13\n\tv_accvgpr_read_b32 %6, %14\n\tv_accvgpr_read_b32 %7, %15"
                                 : "=v"(v0.x), "=v"(v0.y), "=v"(v0.z), "=v"(v0.w), "=v"(v1.x), "=v"(v1.y), "=v"(v1.z), "=v"(v1.w)
                                 : "a"(acc[ai][bj][m][0].x), "a"(acc[ai][bj][m][0].y), "a"(acc[ai][bj][m][0].z), "a"(acc[ai][bj][m][0].w),
                                   "a"(acc[ai][bj][m][1].x), "a"(acc[ai][bj][m][1].y), "a"(acc[ai][bj][m][1].z), "a"(acc[ai][bj][m][1].w));
                    f(u, ctx, gcur, ai, m, bj, ai * HALF + wr * 64 + m * 16 + fr, bj * HALF + wc * 32 + 4 * fq, v0, v1);
                }
                gcur = gnxt;
            }
    }
};
template <class PF, class GP, class F> __device__ __forceinline__ EpiG<PF, GP, F> make_epi_g(PF p, GP g, F f) { return EpiG<PF, GP, F>{p, g, f}; }
template <int MG, int TILE_BYTES, class PF, class F, class FL> struct EpiStaged {
    PF pre; F f; FL flush;
    template <class Ctx>
    __device__ __forceinline__ void operator()(const f32x4 (&acc)[2][2][4][2], const Ctx& ctx, const Unit& u, int wr, int wc, int fr, int fq, PG8_LAS unsigned char* tile, int tid) const {
#pragma unroll
        for (int ai = 0; ai < 2; ++ai)
#pragma unroll
            for (int m = 0; m < 4; ++m) {
#pragma unroll
                for (int bj = 0; bj < 2; ++bj) {
                    f32x4 v0, v1;
                    asm volatile("v_accvgpr_read_b32 %0, %8\n\tv_accvgpr_read_b32 %1, %9\n\tv_accvgpr_read_b32 %2, %10\n\tv_accvgpr_read_b32 %3, %11\n\t"
                                 "v_accvgpr_read_b32 %4, %12\n\tv_accvgpr_read_b32 %5, %13\n\tv_accvgpr_read_b32 %6, %14\n\tv_accvgpr_read_b32 %7, %15"
                                 : "=v"(v0.x), "=v"(v0.y), "=v"(v0.z), "=v"(v0.w), "=v"(v1.x), "=v"(v1.y), "=v"(v1.z), "=v"(v1.w)
                                 : "a"(acc[ai][bj][m][0].x), "a"(acc[ai][bj][m][0].y), "a"(acc[ai][bj][m][0].z), "a"(acc[ai][bj][m][0].w),
                                   "a"(acc[ai][bj][m][1].x), "a"(acc[ai][bj][m][1].y), "a"(acc[ai][bj][m][1].z), "a"(acc[ai][bj][m][1].w));
                    f(u, ctx, ai, m, bj, (m % MG) * 32 + wr * 16 + fr, bj * HALF + wc * 32 + 4 * fq, v0, v1, tile + (((ai * 4 + m) / MG) & 1) * TILE_BYTES);
                }
                if ((m % MG) == MG - 1) {
                    asm volatile("s_waitcnt lgkmcnt(0)" ::: "memory"); __builtin_amdgcn_s_barrier(); asm volatile("" ::: "memory");
                    flush(u, ctx, ai, m - (MG - 1), tid, tile + (((ai * 4 + m) / MG) & 1) * TILE_BYTES);
                }
            }
    }
};
template <int MG, int TILE_BYTES, class PF, class F, class FL> __device__ __forceinline__ EpiStaged<MG, TILE_BYTES, PF, F, FL> make_epi_staged(PF p, F f, FL fl) { return EpiStaged<MG, TILE_BYTES, PF, F, FL>{p, f, fl}; }
__host__ __device__ __forceinline__ int perm32(int rho) { const int n = rho >> 4, i = rho & 15; return 8 * (i >> 2) + 4 * n + (i & 3); }
template <bool FP8 = false, bool GATHER = false, bool PERM = false, class EpiT, class Sched, class StageT = NoStage>
__device__ __forceinline__ void gemm_phase(int tid, PG8_LAS unsigned char* lds, const Gemm g, const Sched& S, const EpiT& E, const StageT& SC = NoStage{}, int ctx_off = 0) {
    const int wid = __builtin_amdgcn_readfirstlane(tid >> 6), lane = tid & 63, wr = wid >> 2, wc = wid & 3, fr = lane & 15, fq = lane >> 4;
    int K = g.K; asm volatile("" : "+s"(K));
    const int nt = K / BK;
    unsigned voffA[2], voffB[2];
    int Rl[2], Cl[2];
#pragma unroll
    for (int i = 0; i < 2; ++i) { int R, C; stage_rc(tid * 16 + i * 8192, R, C); Rl[i] = R; Cl[i] = C; voffA[i] = (unsigned)(R * g.lda + C) * 2u; const int Rb = PERM ? ((R & ~31) + perm32(R & 31)) : R; voffB[i] = (unsigned)(Rb * g.ldb + C) * 2u; }
    unsigned gA00 = 0, gA01 = 0, gA10 = 0, gA11 = 0, gN00 = 0, gN01 = 0, gN10 = 0, gN11 = 0;
    const size_t kstep = (size_t)(BK * 2);
    const size_t hstepA = (size_t)HALF * g.lda * 2, hstepB = (size_t)HALF * g.ldb * 2;
    const size_t tstepA = 2 * hstepA, tstepB = 2 * hstepB;
    const unsigned ldsw = (unsigned)wid * 1024u;
    const int aoff = lds_byte(wr * 64 + fr, fq * 8), boff = lds_byte(wc * 32 + fr, fq * 8);
#define PG8_SA(b, h) (((b) * 2 + (h)) * HTB)
#define PG8_SB(b, h) ((4 + (b) * 2 + (h)) * HTB)
#define PG8_STAGE(bufoff, gbase, voff) do { _Pragma("unroll") for (int _i = 0; _i < 2; ++_i) \
        __builtin_amdgcn_global_load_lds((const unsigned*)((const char*)(gbase) + (voff)[_i]), (PG8_LAS unsigned*)(lds + (bufoff) + ldsw + _i * 8192), 16, 0, 0); } while (0)
#define PG8_LDA(dst, b, h) do { _Pragma("unroll") for (int m = 0; m < 4; ++m) { dst[m].lo = *(const PG8_LAS v4i_t*)(lds + PG8_SA(b, h) + aoff + m * 2048); dst[m].hi = *(const PG8_LAS v4i_t*)(lds + PG8_SA(b, h) + aoff + m * 2048 + 1024); } } while (0)
#define PG8_LDB(dst, b, h) do { _Pragma("unroll") for (int n = 0; n < 2; ++n) { dst[n].lo = *(const PG8_LAS v4i_t*)(lds + PG8_SB(b, h) + boff + n * 2048); dst[n].hi = *(const PG8_LAS v4i_t*)(lds + PG8_SB(b, h) + boff + n * 2048 + 1024); } } while (0)
#define PG8_MMA(ai, bj, At, Bt) do { __builtin_amdgcn_s_setprio(1); _Pragma("unroll") for (int m = 0; m < 4; ++m) _Pragma("unroll") for (int n = 0; n < 2; ++n) { \
        if constexpr (FP8) { asm volatile("s_nop 1\n\tv_mfma_scale_f32_16x16x128_f8f6f4 %0, %1, %2, %0, %3, %4 op_sel_hi:[0,0,0]" : "+a"(acc[ai][bj][m][n]) : "v"(Bt[n].v), "v"(At[m].v), "v"(scw), "v"(scx)); } \
        else { asm volatile("s_nop 1\n\tv_mfma_f32_16x16x32_bf16 %0, %1, %2, %0\n\tv_mfma_f32_16x16x32_bf16 %0, %3, %4, %0" : "+a"(acc[ai][bj][m][n]) : "v"(Bt[n].lo), "v"(At[m].lo), "v"(Bt[n].hi), "v"(At[m].hi)); } } \
        __builtin_amdgcn_s_setprio(0); } while (0)
#define PG8_WAIT_V(n) asm volatile("s_waitcnt vmcnt(" #n ")" ::: "memory")
#define PG8_WAIT_L(n) asm volatile("s_waitcnt lgkmcnt(" #n ")" ::: "memory")
#define PG8_BAR __builtin_amdgcn_s_barrier()
#define PG8_SCHED __builtin_amdgcn_sched_barrier(0)
    Unit cur, nxt; int ui = 0;
    if (!S.next(0, cur)) return;
    f32x4 acc[2][2][4][2];
#pragma unroll
    for (int a = 0; a < 2; ++a)
#pragma unroll
        for (int b = 0; b < 2; ++b)
#pragma unroll
            for (int m = 0; m < 4; ++m)
#pragma unroll
                for (int n = 0; n < 2; ++n) acc[a][b][m][n] = (f32x4){0.f, 0.f, 0.f, 0.f};
    FragT At[4], B0[2], B1[2];
    int scw = (FP8 && PROBE_KX2) ? 0x79797979 : 0x7a7a7a7a, scx = 0x7f7f7f7f; asm volatile("" : "+v"(scw), "+v"(scx));
    const char* cA = GATHER ? (const char*)g.A : (const char*)g.A + (size_t)cur.pm * tstepA; const char* cB = (const char*)g.Bt + (size_t)cur.pb * tstepB;
    SC(cur, lds + STAGE_BYTES + ctx_off, wid, lane);
    const int R0 = Rl[0], R1 = Rl[1]; const unsigned C0 = (unsigned)Cl[0] * 2u, C1 = (unsigned)Cl[1] * 2u;
    if constexpr (GATHER) { gA00 = S.a_off(cur, R0) + C0; gA01 = S.a_off(cur, R1) + C1; gA10 = S.a_off(cur, HALF + R0) + C0; gA11 = S.a_off(cur, HALF + R1) + C1; }
#define PG8_STAGE_A(bufoff, koff, O0, O1, dense_ptr) do { if constexpr (GATHER) { \
        __builtin_amdgcn_global_load_lds((const unsigned*)((const char*)g.A + (koff) + (O0)), (PG8_LAS unsigned*)(lds + (bufoff) + ldsw), 16, 0, 0); \
        __builtin_amdgcn_global_load_lds((const unsigned*)((const char*)g.A + (koff) + (O1)), (PG8_LAS unsigned*)(lds + (bufoff) + ldsw + 8192), 16, 0, 0); \
    } else { PG8_STAGE(bufoff, dense_ptr, voffA); } } while (0)
    PG8_STAGE(PG8_SB(0, 0), cB, voffB); PG8_STAGE(PG8_SB(0, 1), cB + hstepB, voffB); PG8_STAGE_A(PG8_SA(0, 0), 0, gA00, gA01, cA); PG8_STAGE_A(PG8_SA(0, 1), 0, gA10, gA11, cA + hstepA);
    if (wr == 1) PG8_BAR;
    PG8_WAIT_V(2); PG8_BAR;
    PG8_STAGE(PG8_SB(1, 0), cB + kstep, voffB); PG8_STAGE_A(PG8_SA(1, 0), kstep, gA00, gA01, cA + kstep); PG8_STAGE(PG8_SB(1, 1), cB + hstepB + kstep, voffB);
    PG8_WAIT_V(6); PG8_BAR;
    for (;;) {
        const bool has_next = S.next(ui + 1, nxt);
        const char* nA = GATHER ? cA : (has_next ? (const char*)g.A + (size_t)nxt.pm * tstepA : cA); const char* nB = has_next ? (const char*)g.Bt + (size_t)nxt.pb * tstepB : cB;
        if (has_next) SC(nxt, lds + STAGE_BYTES + ctx_off + ((ui + 1) % 3) * 4096, wid, lane);
        if constexpr (GATHER) {
            if (has_next) { gN00 = S.a_off(nxt, R0) + C0; gN01 = S.a_off(nxt, R1) + C1; gN10 = S.a_off(nxt, HALF + R0) + C0; gN11 = S.a_off(nxt, HALF + R1) + C1; }
            else { gN00 = gA00; gN01 = gA01; gN10 = gA10; gN11 = gA11; }
        }
        constexpr int KX = (FP8 && PROBE_KX2) ? 2 : 1;
        for (int t = 0; t < KX * nt; t += 2) {
            const bool last = (t == KX * nt - 2);
            const char* a1 = cA + (size_t)((t + 1) % nt) * kstep;
            const char* a2 = last ? nA : cA + (size_t)((t + 2) % nt) * kstep; const char* b2 = last ? nB : cB + (size_t)((t + 2) % nt) * kstep;
            const char* a3 = a2 + kstep; const char* b3 = b2 + kstep;
            const size_t k1 = (size_t)((t + 1) % nt) * kstep, k2 = last ? 0 : (size_t)((t + 2) % nt) * kstep;
            const unsigned gT00 = last ? gN00 : gA00, gT01 = last ? gN01 : gA01, gT10 = last ? gN10 : gA10, gT11 = last ? gN11 : gA11;
            PG8_LDB(B0, 0, 0); PG8_LDB(B1, 0, 1); PG8_SCHED; PG8_LDA(At, 0, 0); PG8_STAGE_A(PG8_SA(1, 1), k1, gA10, gA11, a1 + hstepA);
            PG8_WAIT_V(8); PG8_WAIT_L(0); PG8_BAR; PG8_MMA(0, 0, At, B0); PG8_MMA(0, 1, At, B1); PG8_BAR; PG8_SCHED;
            PG8_LDA(At, 0, 1); PG8_STAGE(PG8_SB(0, 0), b2, voffB); PG8_STAGE(PG8_SB(0, 1), b2 + hstepB, voffB); PG8_STAGE_A(PG8_SA(0, 0), k2, gT00, gT01, a2);
            PG8_WAIT_V(8); PG8_WAIT_L(0); PG8_BAR; PG8_MMA(1, 0, At, B0); PG8_MMA(1, 1, At, B1); PG8_BAR; PG8_SCHED;
            PG8_LDB(B0, 1, 0); PG8_LDB(B1, 1, 1); PG8_SCHED; PG8_LDA(At, 1, 0); PG8_STAGE_A(PG8_SA(0, 1), k2, gT10, gT11, a2 + hstepA);
            PG8_WAIT_V(8); PG8_WAIT_L(0); PG8_BAR; PG8_MMA(0, 0, At, B0); PG8_MMA(0, 1, At, B1); PG8_BAR; PG8_SCHED;
            PG8_LDA(At, 1, 1); PG8_STAGE(PG8_SB(1, 0), b3, voffB); PG8_STAGE(PG8_SB(1, 1), b3 + hstepB, voffB); PG8_STAGE_A(PG8_SA(1, 0), k2 + kstep, gT00, gT01, a3);
            PG8_WAIT_V(8); PG8_WAIT_L(0); PG8_BAR; PG8_MMA(1, 0, At, B0); PG8_MMA(1, 1, At, B1); PG8_BAR; PG8_SCHED;
        }
        unsigned long long tp0_ = 0; if constexpr (PROBE_SEG != 0 && PROBE_SEG == (FP8 ? (GATHER ? 2 : 1) : 3)) tp0_ = __builtin_amdgcn_s_memrealtime();
        const auto ectx = E.pre(cur, wr, wc, fr, fq, lds + STAGE_BYTES + ctx_off + (ui % 3) * 4096);
        if (wr == 0) PG8_BAR;
        asm volatile("s_nop 15\n\ts_nop 15" ::: "memory");
        E(acc, ectx, cur, wr, wc, fr, fq, lds + STAGE_BYTES, tid);
        if constexpr (FP8 && PROBE_EPI2) { asm volatile("" ::: "memory"); E(acc, ectx, cur, wr, wc, fr, fq, lds + STAGE_BYTES, tid); }
        if constexpr (PROBE_SEG != 0 && PROBE_SEG == (FP8 ? (GATHER ? 2 : 1) : 3)) { if (tid == 0) { PG8_LAS unsigned* acc_t = (PG8_LAS unsigned*)(lds + LDS_MISC + 48); *acc_t += (unsigned)(__builtin_amdgcn_s_memrealtime() - tp0_); } }
        if (!has_next) break;
#pragma unroll
        for (int a = 0; a < 2; ++a)
#pragma unroll
            for (int b = 0; b < 2; ++b)
#pragma unroll
                for (int m = 0; m < 4; ++m)
#pragma unroll
                    for (int n = 0; n < 2; ++n) acc[a][b][m][n] = (f32x4){0.f, 0.f, 0.f, 0.f};
        cur = nxt; cA = nA; cB = nB; ++ui;
        if constexpr (GATHER) { gA00 = gN00; gA01 = gN01; gA10 = gN10; gA11 = gN11; }
        if (wr == 1) PG8_BAR;
    }
    PG8_WAIT_V(0);
    PG8_BAR;
#undef PG8_SA
#undef PG8_SB
#undef PG8_STAGE
#undef PG8_STAGE_A
#undef PG8_LDA
#undef PG8_LDB
#undef PG8_MMA
#undef PG8_WAIT_V
#undef PG8_WAIT_L
#undef PG8_BAR
#undef PG8_SCHED
}
struct GridOrder {
    int nM, nN, nwg, G, c;
    __device__ __forceinline__ void init(int nM_, int nN_, int G_, int c_) { nM = nM_; nN = nN_; nwg = nM * nN; G = G_; c = c_; }
    __device__ __forceinline__ bool tile(int i, int& pm, int& pn) const {
        const long L = (long)i * G + c; if (L >= nwg) return false;
        int wgid = (int)L; { const int q = nwg / 8, r = nwg % 8, xcd = wgid % 8, off = wgid / 8; wgid = (xcd < r ? xcd * (q + 1) : r * (q + 1) + (xcd - r) * q) + off; }
        const int nig = 8 * nN, gid = wgid / nig, fm = gid * 8, gsz = (nM - fm) < 8 ? (nM - fm) : 8;
        pm = fm + ((wgid % nig) % gsz); pn = (wgid % nig) / gsz; return true;
    }
};
}


struct DenseOrder { pg8::GridOrder go;
    __device__ __forceinline__ bool next(int i, pg8::Unit& u) const { int pm, pn; if (!go.tile(i, pm, pn)) return false; u.pm = pm; u.pb = pn; u.pn = pn; u.aux = 0; return true; } };
struct MoeOrder { pg8::GridOrder go; const int* pst; const int* el_slot; int NT, ebase;
    __device__ __forceinline__ unsigned a_off(const pg8::Unit& u, int R) const { const int ro = u.pm * 256 - pst[u.aux] + R; const int tok = (ro < pst[64 + u.aux]) ? (el_slot[(size_t)u.aux * T + ro] >> 2) : 0; return (unsigned)tok * 1024u; }
    __device__ __forceinline__ bool next(int i, pg8::Unit& u) const { int pm, pn; if (!go.tile(i, pm, pn)) return false; int e = 0;
#pragma unroll
        for (int q = 1; q < 32; ++q) e = (pm * 256 >= pst[q]) ? q : e;
        e = __builtin_amdgcn_readfirstlane(e);
        u.pm = pm; u.pn = pn; u.pb = (ebase + e) * NT + pn; u.aux = e; return true; } };
struct S5Order { int G, c;
    __device__ __forceinline__ bool next(int i, pg8::Unit& u) const { const int L = i * G + c; if (L >= 256) return false; const int g = L >> 3, pmL = (L >> 2) & 1, pnL = L & 3;
        u.pm = g * 2 + pmL; u.pb = g * 4 + pnL; u.pn = pnL; u.aux = g; return true; } };

__device__ __forceinline__ void transpose_item(const float* W, int K, int N, bf16_t* WT, int ldt, float* scr, int item, int lane, int mode, const float* kscale = nullptr) {
    const int nblk = N / 32, kb = item / nblk, nb = item % nblk, k0 = 64 * kb, n0 = 32 * nb;
#pragma unroll 8
    for (int i = 0; i < 32; ++i) { const int kk = 2 * i + (lane >> 5); scr[kk * 33 + (lane & 31)] = W[(size_t)(k0 + kk) * N + n0 + (lane & 31)] * (kscale ? kscale[k0 + kk] : 1.0f); }
    __builtin_amdgcn_s_waitcnt(0xC07F); asm volatile("" ::: "memory");
    const int c = lane & 7;
#pragma unroll
    for (int j = 0; j < 4; ++j) {
        const int n = (lane >> 3) + 8 * j; const float* s = scr + (8 * c) * 33 + n;
        u32x4 o; o.x = pk2(s[0 * 33], s[1 * 33]); o.y = pk2(s[2 * 33], s[3 * 33]); o.z = pk2(s[4 * 33], s[5 * 33]); o.w = pk2(s[6 * 33], s[7 * 33]);
        int nn = n0 + n;
        if (mode == 1) { const int half = nn >= 1024; const int jj = nn - half * 1024; nn = 32 * (jj >> 4) + 16 * half + (jj & 15); }
        *(u32x4*)(WT + (size_t)nn * ldt + k0 + 8 * c) = o;
    }
    __builtin_amdgcn_s_waitcnt(0xC07F); asm volatile("" ::: "memory");
}
__device__ __forceinline__ void transpose_item_fp8(const float* W, int K, int N, unsigned char* WT, float* scr, int item, int lane, int mode, float scale) {
    const int nblk = N / 32, kb = item / nblk, nb = item % nblk, k0 = 128 * kb, n0 = 32 * nb;
#pragma unroll 8
    for (int i = 0; i < 64; ++i) { const int kk = 2 * i + (lane >> 5); scr[kk * 33 + (lane & 31)] = W[(size_t)(k0 + kk) * N + n0 + (lane & 31)] * scale; }
    __builtin_amdgcn_s_waitcnt(0xC07F); asm volatile("" ::: "memory");
    const int c = lane & 7;
#pragma unroll
    for (int j = 0; j < 4; ++j) {
        const int n = (lane >> 3) + 8 * j; const float* s = scr + (16 * c) * 33 + n;
        u32x4 o; o.x = pk4_fp8(s[0 * 33], s[1 * 33], s[2 * 33], s[3 * 33]); o.y = pk4_fp8(s[4 * 33], s[5 * 33], s[6 * 33], s[7 * 33]);
        o.z = pk4_fp8(s[8 * 33], s[9 * 33], s[10 * 33], s[11 * 33]); o.w = pk4_fp8(s[12 * 33], s[13 * 33], s[14 * 33], s[15 * 33]);
        int nn = n0 + n;
        if (mode == 1) { const int half = nn >= 1024; const int jj = nn - half * 1024; nn = 32 * (jj >> 4) + 16 * half + (jj & 15); }
        *(u32x4*)(WT + (size_t)nn * K + k0 + 16 * c) = o;
    }
    __builtin_amdgcn_s_waitcnt(0xC07F); asm volatile("" ::: "memory");
}
__device__ __forceinline__ void transpose_many_fp8(const float* W, int nmat, int K, int N, unsigned char* WT, size_t dst_stride, float* scr, int gw, int NGW, int lane, int mode, float scale) {
    const int per = (K / 128) * (N / 32); const long tot = (long)nmat * per;
    for (long it = gw; it < tot; it += NGW) {
        const int mt = (int)(it / per), r = (int)(it % per);
        transpose_item_fp8(W + (size_t)mt * K * N, K, N, WT + (size_t)mt * dst_stride, scr, r, lane, mode, scale);
    }
}
__device__ __forceinline__ void convert_fp8_block(const float* W, int nmat, int K, int N, unsigned char* WT, size_t dst_stride, float* tile, int vb, int G, int tid, int mode, float scale) {
    const int per = (K / 128) * (N / 256), tot = nmat * per, wave = tid >> 6, lane = tid & 63;
    f32x4 v[16];
    int it = vb;
    auto src = [&](int item, int i) { const int mt = item / per, r = item % per, nblk = N / 256, kb = r / nblk, nb = r % nblk;
        return (const f32x4*)(W + (size_t)mt * K * N + (size_t)(128 * kb + wave + 8 * i) * N + 256 * nb + lane * 4); };
    if (it < tot) {
#pragma unroll
        for (int i = 0; i < 16; ++i) v[i] = *src(it, i);
    }
    while (it < tot) {
#pragma unroll
        for (int i = 0; i < 16; ++i) { float* d = tile + (wave + 8 * i) * 257 + lane * 4; d[0] = v[i].x * scale; d[1] = v[i].y * scale; d[2] = v[i].z * scale; d[3] = v[i].w * scale; }
        __syncthreads();
        const int nx = it + G;
        if (nx < tot) {
#pragma unroll
            for (int i = 0; i < 16; ++i) v[i] = *src(nx, i);
        }
        {
            const int mt = it / per, r = it % per, nblk = N / 256, kb = r / nblk, nb = r % nblk, k0 = 128 * kb, n0 = 256 * nb;
            const int c = tid & 7;
#pragma unroll 1
            for (int ps = 0; ps < 4; ++ps) {
                const int n = ps * 64 + (tid >> 3); const float* sp = tile + (16 * c) * 257 + n;
                u32x4 o; o.x = pk4_fp8(sp[0 * 257], sp[1 * 257], sp[2 * 257], sp[3 * 257]); o.y = pk4_fp8(sp[4 * 257], sp[5 * 257], sp[6 * 257], sp[7 * 257]);
                o.z = pk4_fp8(sp[8 * 257], sp[9 * 257], sp[10 * 257], sp[11 * 257]); o.w = pk4_fp8(sp[12 * 257], sp[13 * 257], sp[14 * 257], sp[15 * 257]);
                int nn = n0 + n;
                if (mode == 1) { const int half = nn >= 1024; const int jj = nn - half * 1024; nn = 32 * (jj >> 4) + 16 * half + (jj & 15); }
                *(u32x4*)(WT + (size_t)mt * dst_stride + (size_t)nn * K + k0 + 16 * c) = o;
            }
        }
        __syncthreads();
        it = nx;
    }
}
__device__ __forceinline__ void transpose_many(const float* W, int nmat, int K, int N, bf16_t* WT, size_t dst_stride, float* scr, int gw, int NGW, int lane, int mode, int ldt = 0, const float* kscale = nullptr) {
    if (ldt == 0) ldt = K;
    const int per = (K / 64) * (N / 32); const long tot = (long)nmat * per;
    for (long it = gw; it < tot; it += NGW) {
        const int mt = (int)(it / per), r = (int)(it % per);
        transpose_item(W + (size_t)mt * K * N, K, N, WT + (size_t)mt * dst_stride, ldt, scr, r, lane, mode, kscale);
    }
}

__device__ __forceinline__ void norm_mod_store(f32x4 (&v)[4], const float* g, const float* sc, const float* sh, bf16_t* orow, unsigned char* orow8, int lane) {
    float s = 0.f;
#pragma unroll
    for (int j = 0; j < 4; ++j) s += (v[j].x * v[j].x + v[j].y * v[j].y) + (v[j].z * v[j].z + v[j].w * v[j].w);
    const float r = rsqrtf(wave_sum(s) * (1.0f / D) + 1e-6f);
#pragma unroll
    for (int j = 0; j < 4; ++j) {
        const int c = 4 * lane + 256 * j;
        const f32x4 gg = *(const f32x4*)(g + c), s1 = *(const f32x4*)(sc + c), s0 = *(const f32x4*)(sh + c);
        const float a = v[j].x * r * gg.x * (1.f + s1.x) + s0.x, b = v[j].y * r * gg.y * (1.f + s1.y) + s0.y,
                    cc = v[j].z * r * gg.z * (1.f + s1.z) + s0.z, d = v[j].w * r * gg.w * (1.f + s1.w) + s0.w;
        u32x2 o; o.x = pk2(a, b); o.y = pk2(cc, d);
        *(u32x2*)(orow + c) = o;
        if (orow8) *(unsigned*)(orow8 + c) = pk4_fp8(a, b, cc, d);
    }
}

__device__ __forceinline__ void unpack8(const u32x4 w, float (&f)[8]) {
    f[0] = __uint_as_float(w.x << 16); f[1] = __uint_as_float(w.x & 0xffff0000u); f[2] = __uint_as_float(w.y << 16); f[3] = __uint_as_float(w.y & 0xffff0000u);
    f[4] = __uint_as_float(w.z << 16); f[5] = __uint_as_float(w.z & 0xffff0000u); f[6] = __uint_as_float(w.w << 16); f[7] = __uint_as_float(w.w & 0xffff0000u);
}
__device__ __forceinline__ u32x4 pack8(const float (&f)[8]) { u32x4 o; o.x = pk2(f[0], f[1]); o.y = pk2(f[2], f[3]); o.z = pk2(f[4], f[5]); o.w = pk2(f[6], f[7]); return o; }
__device__ __forceinline__ void norm_mod_store8(float (&v)[2][8], const float* g, const float* sc, const float* sh, bf16_t* orow, unsigned char* orow8, int lane) {
    float s = 0.f;
#pragma unroll
    for (int j = 0; j < 2; ++j)
#pragma unroll
        for (int i = 0; i < 8; ++i) s += v[j][i] * v[j][i];
    const float r = rsqrtf(wave_sum(s) * (1.0f / D) + 1e-6f);
#pragma unroll
    for (int j = 0; j < 2; ++j) {
        const int c = 8 * lane + 512 * j; float o[8];
#pragma unroll
        for (int q = 0; q < 2; ++q) {
            const f32x4 gg = *(const f32x4*)(g + c + 4 * q), s1 = *(const f32x4*)(sc + c + 4 * q), s0 = *(const f32x4*)(sh + c + 4 * q);
            o[4 * q + 0] = v[j][4 * q + 0] * r * gg.x * (1.f + s1.x) + s0.x; o[4 * q + 1] = v[j][4 * q + 1] * r * gg.y * (1.f + s1.y) + s0.y;
            o[4 * q + 2] = v[j][4 * q + 2] * r * gg.z * (1.f + s1.z) + s0.z; o[4 * q + 3] = v[j][4 * q + 3] * r * gg.w * (1.f + s1.w) + s0.w;
        }
        *(u32x4*)(orow + c) = pack8(o);
        if (orow8) { u32x2 w8; w8.x = pk4_fp8(o[0], o[1], o[2], o[3]); w8.y = pk4_fp8(o[4], o[5], o[6], o[7]); *(u32x2*)(orow8 + c) = w8; }
    }
}

template <int ph> __device__ __forceinline__ void phase_body(int wbase) {
    extern __shared__ __attribute__((aligned(16))) unsigned char lds[];
    {
        int tid = wbase + lane_id(); asm volatile("" : "+v"(tid));
        int vb = blockIdx.x, G = gridDim.x; asm volatile("" : "+s"(vb), "+s"(G));
        const int lane = tid & 63, wave = tid >> 6;
        const int gw = vb * NWAVE + wave, NGW = G * NWAVE;
        const __attribute__((address_space(4))) Params* kp = (const __attribute__((address_space(4))) Params*)__builtin_amdgcn_kernarg_segment_ptr();
        asm volatile("" : "+s"(kp));
        unsigned char* ws = kp->ws;
        unsigned* ctl = (unsigned*)(ws + WS_CTL);
        float* MOD = (float*)(ws + WS_MOD);
        float* S5AB = (float*)(ws + WS_S5AB); float* S5BB = (float*)(ws + WS_S5AB + 65536);
        float* PW = (float*)(ws + WS_PW); float* KTAB = (float*)(ws + WS_KTAB);
                int* EL_SLOT = (int*)(ws + WS_EL); float* EL_GATE = (float*)(ws + WS_EL + 4 * MiB);
            bf16_t* W_IN_E = (bf16_t*)(ws + WS_W_IN_E); bf16_t* W_UP = (bf16_t*)(ws + WS_W_UP); bf16_t* W_GLU = (bf16_t*)(ws + WS_W_GLU);
        bf16_t* W_OUT_E = (bf16_t*)(ws + WS_W_OUT_E); bf16_t* W_IN_O = (bf16_t*)(ws + WS_W_IN_O); bf16_t* W_OUT_O = (bf16_t*)(ws + WS_W_OUT_O);
        bf16_t* W_POOL = (bf16_t*)(ws + WS_W_POOL); bf16_t* W_SGU = (bf16_t*)(ws + WS_W_SGU); bf16_t* W_RT = (bf16_t*)(ws + WS_W_RT);
        bf16_t* BT_END = (bf16_t*)(ws + WS_BT_END); bf16_t* BT_MAIN = (bf16_t*)(ws + WS_BT_MAIN);
        unsigned char* W_GU = ws + WS_W_GU; unsigned char* W_DN = ws + WS_W_DN; unsigned char* HB8 = ws + WS_HB8;
        bf16_t* HB = (bf16_t*)(ws + WS_HB); bf16_t* MIXIN = (bf16_t*)(ws + WS_MIXIN); bf16_t* Y = (bf16_t*)(ws + WS_Y);
        unsigned char* ACT = ws + WS_ACT;
        bf16_t* Z = (bf16_t*)(ws + WS_Z); float* RSP = (float*)(ws + WS_RSP); bf16_t* QKVRAW = (bf16_t*)(ws + WS_QKVRAW);
        bf16_t* Qb = (bf16_t*)(ws + WS_Q); bf16_t* Kb = (bf16_t*)(ws + WS_K); bf16_t* VT = (bf16_t*)(ws + WS_VT);
        bf16_t* AS5 = (bf16_t*)(ws + WS_AS5); float* LEND = (float*)(ws + WS_LEND); bf16_t* GACT = (bf16_t*)(ws + WS_GACT);
        bf16_t* POOLED = (bf16_t*)(ws + WS_POOLED); bf16_t* VTS = (bf16_t*)(ws + WS_VTS);
        float* OUT = kp->out; const float* XIN = kp->x; bf16_t* XR = (bf16_t*)(ws + WS_XR);
        const float* s5d = kp->s5_d; const float* glub = kp->s5_glu_b; const float* poolsc = kp->pool_scale; const float* sgub = kp->sgu_b;
        const float* bgu_all = kp->moe_b_gu; const float* bdn_all = kp->moe_b_dn; const float* rtb_all = kp->router_b;

        const int layer = (ph >= 17) ? 1 : 0;
        const int mph = (ph >= 17 && ph <= 19) ? ph - 8 : ph;
        const float* mod_l = MOD + (size_t)layer * NB * 6144;

        if (ph == 0) {
            const int gt = vb * NTHR + tid;
            if (gt < 2048) {
                const int g = gt >> 6, pp = gt & 63;
                const float dt = expf(kp->s5_log_dt[g]);
                const float lre = fminf(kp->s5_a_re[g * 64 + pp], -1e-4f), lim = kp->s5_a_im[g * 64 + pp];
                const float mag = expf(lre * dt);
                const float abr = mag * cosf(lim * dt), abi = mag * sinf(lim * dt);
                const float den = lre * lre + lim * lim, nr = abr - 1.0f;
                const float fre = (nr * lre + abi * lim) / den, fim = (abi * lre - nr * lim) / den;
                S5AB[(g * 64 + pp) * 2 + 0] = abr; S5AB[(g * 64 + pp) * 2 + 1] = abi;
                for (int j = 0; j < 16; ++j) {
                    const float br = kp->s5_b_re[(g * 64 + pp) * 16 + j], bi = kp->s5_b_im[(g * 64 + pp) * 16 + j];
                    S5BB[((g * 64 + pp) * 16 + j) * 2 + 0] = fre * br - fim * bi;
                    S5BB[((g * 64 + pp) * 16 + j) * 2 + 1] = fre * bi + fim * br;
                }
                float pr = 1.f, pi = 0.f;
                for (int tau = 0; tau <= 64; ++tau) {
                    PW[((g * 64 + pp) * 65 + tau) * 2 + 0] = pr; PW[((g * 64 + pp) * 65 + tau) * 2 + 1] = pi;
                    const float nr2 = pr * abr - pi * abi, ni2 = pr * abi + pi * abr; pr = nr2; pi = ni2;
                }
            }
            {
                float* ca = (float*)lds;
                for (int i = tid; i < NB * D; i += NTHR) { const float cv = kp->c[i]; ca[i] = cv * sigmoidf_(cv); }
                __syncthreads();
                float* part = (float*)(lds + 32768);
                for (int task = vb; task < 2 * 96; task += G) {
                    const int l = task / 96, cb = task % 96, col = cb * 64 + lane;
                    const float* W = kp->ada_w + (size_t)l * D * 6144 + col;
                    float acc[8];
#pragma unroll
                    for (int b = 0; b < 8; ++b) acc[b] = 0.f;
                    const int kb = wave * 128;
                    for (int k = kb; k < kb + 128; k += 8) {
                        float w[8];
#pragma unroll
                        for (int u = 0; u < 8; ++u) w[u] = W[(size_t)(k + u) * 6144];
#pragma unroll
                        for (int u = 0; u < 8; ++u)
#pragma unroll
                            for (int b = 0; b < 8; ++b) acc[b] += ca[b * D + k + u] * w[u];
                    }
#pragma unroll
                    for (int b = 0; b < 8; ++b) part[(wave * 8 + b) * 64 + lane] = acc[b];
                    __syncthreads();
                    {
                        const int b = tid >> 6;
                        float sum = kp->ada_b[l * 6144 + col];
#pragma unroll
                        for (int w8 = 0; w8 < 8; ++w8) sum += part[(w8 * 8 + b) * 64 + lane];
                        MOD[((size_t)l * NB + b) * 6144 + col] = sum;
                    }
                    __syncthreads();
                }
                __syncthreads();
            }
            {
                float* scr = (float*)(lds + wave * 16384);
                transpose_many(kp->even_w_in, 1, 1024, 928, W_IN_E, 0, scr, gw, NGW, lane, 0);
                transpose_many(kp->w_uq, 1, 256, 768, W_UP, 0, scr, gw, NGW, lane, 0, 384, kp->q_norm_g);
                transpose_many(kp->w_ukv, 1, 128, 1024, W_UP + (size_t)768 * 384 + 256, 0, scr, gw, NGW, lane, 0, 384, kp->kv_norm_g);
                for (int i = vb * NTHR + tid; i < 768 * 16 + 1024 * 32; i += G * NTHR) {
                    const u32x4 z = {0u, 0u, 0u, 0u};
                    if (i < 768 * 16) *(u32x4*)(W_UP + (size_t)(i >> 4) * 384 + 256 + (i & 15) * 8) = z;
                    else { const int q = i - 768 * 16; *(u32x4*)(W_UP + (size_t)(768 + (q >> 5)) * 384 + (q & 31) * 8) = z; }
                }
                transpose_many(kp->s5_glu_w, 1, 512, 512, W_GLU, 0, scr, gw, NGW, lane, 0);
                transpose_many(kp->even_w_out, 1, 1024, 1024, W_OUT_E, 0, scr, gw, NGW, lane, 0);
                transpose_many(kp->odd_w_in, 1, 1024, 1536, W_IN_O, 0, scr, gw, NGW, lane, 0);
                transpose_many(kp->odd_w_out, 1, 1024, 1024, W_OUT_O, 0, scr, gw, NGW, lane, 0);
                transpose_many(kp->pool_w, 4, 128, 128, W_POOL, 128 * 128, scr, gw, NGW, lane, 0);
                transpose_many(kp->router_w, 2, 1024, 32, W_RT, 128 * 1024, scr, gw, NGW, lane, 0);
                __syncthreads();
                convert_fp8_block(kp->moe_w_gu, 64, 1024, 2048, W_GU, (size_t)2048 * 1024, (float*)lds, vb, G, tid, 1, 32.0f);
                convert_fp8_block(kp->moe_w_dn, 64, 1024, 1024, W_DN, (size_t)1024 * 1024, (float*)lds, vb, G, tid, 0, 32.0f);
                for (int i = vb * NTHR + tid; i < 4 * 128 * 128; i += G * NTHR) {
                    const int t = (i >> 7) & 127, s_ = i & 127;
                    W_SGU[i] = (s_ <= t) ? f2bf(kp->sgu_w[i]) : (bf16_t)0;
                }
            }
        }
        else if (ph == 1 || ph == 12 || ph == 20) {
            const int lyr = (ph == 1) ? 0 : 1;
            const bool combine = (ph == 12 || ph == 20), donorm = (ph != 20);
            const int comb_layer = (ph == 12) ? 0 : 1;
            const bool ffn = false;
            const float* ng = (ffn ? kp->norm_ffn_g : kp->norm_mix_g) + lyr * D;
            if (ph == 1) {
                for (int rb = gw * 16; rb < T; rb += NGW * 16) {
                    const int b = rb / S;
                    const float* mm = MOD + ((size_t)lyr * NB + b) * 6144;
                    f32x4 pg[4], ps[4], ph_[4];
#pragma unroll
                    for (int j = 0; j < 4; ++j) { const int c = 4 * lane + 256 * j; pg[j] = *(const f32x4*)(ng + c); const f32x4 s1 = *(const f32x4*)(mm + D + c); ph_[j] = *(const f32x4*)(mm + c);
                        pg[j].x *= (1.f + s1.x); pg[j].y *= (1.f + s1.y); pg[j].z *= (1.f + s1.z); pg[j].w *= (1.f + s1.w); ps[j] = s1; }
                    f32x4 cur[4], nxt[4];
#pragma unroll
                    for (int j = 0; j < 4; ++j) cur[j] = *(const f32x4*)(XIN + (size_t)rb * D + 4 * lane + 256 * j);
                    for (int i = 0; i < 16; ++i) {
                        const int row = rb + i;
                        if (i + 1 < 16) {
#pragma unroll
                            for (int j = 0; j < 4; ++j) nxt[j] = *(const f32x4*)(XIN + (size_t)(row + 1) * D + 4 * lane + 256 * j);
                        }
                        float ss = 0.f;
#pragma unroll
                        for (int j = 0; j < 4; ++j) ss += (cur[j].x * cur[j].x + cur[j].y * cur[j].y) + (cur[j].z * cur[j].z + cur[j].w * cur[j].w);
                        const float r = rsqrtf(wave_sum(ss) * (1.0f / D) + 1e-6f);
#pragma unroll
                        for (int j = 0; j < 4; ++j) {
                            u32x2 o; o.x = pk2(cur[j].x * r * pg[j].x + ph_[j].x, cur[j].y * r * pg[j].y + ph_[j].y); o.y = pk2(cur[j].z * r * pg[j].z + ph_[j].z, cur[j].w * r * pg[j].w + ph_[j].w);
                            *(u32x2*)(HB + (size_t)row * D + 4 * lane + 256 * j) = o;
                        }
#pragma unroll
                        for (int j = 0; j < 4; ++j) cur[j] = nxt[j];
                    }
                }
            } else {
                for (int row0 = gw; row0 < T; row0 += 2 * NGW) {
                    float v[2][2][8];
#pragma unroll
                    for (int j = 0; j < 2; ++j) {
                        const int c = 8 * lane + 512 * j;
                        u32x4 xr[2], yr[2][4];
#pragma unroll
                        for (int q = 0; q < 2; ++q) {
                            const int row = row0 + q * NGW;
                            xr[q] = *(const u32x4*)(XR + (size_t)row * D + c);
#pragma unroll
                            for (int k = 0; k < 4; ++k) yr[q][k] = *(const u32x4*)(Y + ((size_t)row * 4 + k) * D + c);
                        }
#pragma unroll
                        for (int q = 0; q < 2; ++q) {
                            const int row = row0 + q * NGW, b = row / S;
                            const float* gf = MOD + ((size_t)comb_layer * NB + b) * 6144 + 5 * D;
                            float xf[8], acc[8];
                            unpack8(xr[q], xf);
#pragma unroll
                            for (int i = 0; i < 8; ++i) acc[i] = 0.f;
#pragma unroll
                            for (int k = 0; k < 4; ++k) { float yf[8]; unpack8(yr[q][k], yf);
#pragma unroll
                                for (int i = 0; i < 8; ++i) acc[i] += yf[i]; }
                            const f32x4 g0 = *(const f32x4*)(gf + c), g1 = *(const f32x4*)(gf + c + 4);
                            float (&vv)[8] = v[q][j];
                            vv[0] = xf[0] + g0.x * acc[0]; vv[1] = xf[1] + g0.y * acc[1]; vv[2] = xf[2] + g0.z * acc[2]; vv[3] = xf[3] + g0.w * acc[3];
                            vv[4] = xf[4] + g1.x * acc[4]; vv[5] = xf[5] + g1.y * acc[5]; vv[6] = xf[6] + g1.z * acc[6]; vv[7] = xf[7] + g1.w * acc[7];
                            if (ph == 20) { *(f32x4*)(OUT + (size_t)row * D + c) = (f32x4){vv[0], vv[1], vv[2], vv[3]}; *(f32x4*)(OUT + (size_t)row * D + c + 4) = (f32x4){vv[4], vv[5], vv[6], vv[7]}; }
                            else *(u32x4*)(XR + (size_t)row * D + c) = pack8(vv);
                        }
                    }
                    if (donorm) {
#pragma unroll
                        for (int q = 0; q < 2; ++q) {
                            const int row = row0 + q * NGW, b = row / S;
                            const float* mm = MOD + ((size_t)lyr * NB + b) * 6144;
                            norm_mod_store8(v[q], ng, mm + D, mm, HB + (size_t)row * D, (unsigned char*)nullptr, lane);
                        }
                    }
                }
            }
            if (ph == 1) {
                __syncthreads();
                float* Cs = (float*)lds;
                float* Bs = Cs + 2048;
                float* As = Bs + 2048;
                for (int item = vb; item < 256; item += G) {
                    const int g = item >> 3, tq = item & 7;
                    for (int idx = tid; idx < 1024; idx += NTHR) {
                        const int i = idx >> 6, pp = idx & 63;
                        Cs[idx * 2] = kp->s5_c_re[(g * 16 + i) * 64 + pp]; Cs[idx * 2 + 1] = kp->s5_c_im[(g * 16 + i) * 64 + pp];
                        Bs[idx * 2] = S5BB[((size_t)g * 1024 + idx) * 2]; Bs[idx * 2 + 1] = S5BB[((size_t)g * 1024 + idx) * 2 + 1];
                    }
                    { const int pp = tid >> 3, tl = tid & 7; As[tid * 2] = PW[((g * 64 + pp) * 65 + tq * 8 + tl) * 2]; As[tid * 2 + 1] = PW[((g * 64 + pp) * 65 + tq * 8 + tl) * 2 + 1]; }
                    __syncthreads();
                    const int v0 = tid * 4, tl = v0 >> 8, i = (v0 >> 4) & 15, j0 = v0 & 15;
                    float acc[4] = {0.f, 0.f, 0.f, 0.f};
                    for (int pp = 0; pp < 64; ++pp) {
                        const float cr = Cs[(i * 64 + pp) * 2], ci = Cs[(i * 64 + pp) * 2 + 1];
                        const float ar = As[(pp * 8 + tl) * 2], ai = As[(pp * 8 + tl) * 2 + 1];
                        const f32x4 b01 = *(const f32x4*)(Bs + (pp * 16 + j0) * 2), b23 = *(const f32x4*)(Bs + (pp * 16 + j0) * 2 + 4);
                        const float wr_ = cr * ar - ci * ai, wi_ = cr * ai + ci * ar;
                        acc[0] += wr_ * b01.x - wi_ * b01.y; acc[1] += wr_ * b01.z - wi_ * b01.w; acc[2] += wr_ * b23.x - wi_ * b23.y; acc[3] += wr_ * b23.z - wi_ * b23.w;
                    }
                    *(f32x4*)(KTAB + (((size_t)g * 64 + tq * 8 + tl) * 16 + i) * 16 + j0) = (f32x4){acc[0], acc[1], acc[2], acc[3]};
                    __syncthreads();
                }
            }
        }
        else if (ph == 2) {
            {
                DenseOrder so; so.go.init(T / 256, 4, G, vb);
                auto f = [=](const pg8::Unit& u, const pg8::NoCtx&, int ai, int m, int bj, int r, int c, f32x4 v0, f32x4 v1) -> float {
                        const int row = u.pm * 256 + r; float ss = 0.f;
#pragma unroll
                        for (int h = 0; h < 2; ++h) {
                            const int col = u.pn * 256 + c + 16 * h; const f32x4 v = h ? v1 : v0;
                            u32x2 o; o.x = pk2(v.x, v.y); o.y = pk2(v.z, v.w);
                            if (col < 384) ss += (v.x * v.x + v.y * v.y) + (v.z * v.z + v.w * v.w);
                            if (col < 416) *(u32x2*)(Z + (size_t)row * 1024 + col) = o;
                            else if (col < 928) {
                                const int ch = col - 416, g = ch >> 4, j = ch & 15, b = row / S, t = row % S;
                                *(u32x2*)(AS5 + ((size_t)g * 512 + b * 64 + (t >> 6)) * 1152 + 128 + (t & 63) * 16 + j) = o;
                            }
                        }
                        return ss;
                    };
                auto re = [=](const pg8::Unit& u, int ai, int m, int r, int wc, int fq, float part) {
                        if (u.pn < 2) {
                            part += __shfl_xor(part, 16); part += __shfl_xor(part, 32);
                            if (fq == 0) RSP[((size_t)(u.pm * 256 + r) * 2 + u.pn) * 4 + wc] = part;
                        }
                    };
                pg8::gemm_phase(tid, (PG8_LAS unsigned char*)lds, pg8::Gemm{HB, W_IN_E, D, D, D}, so, pg8::make_epi_row(pg8::NoPre{}, f, re));
            }
            {
                float* KT = (float*)lds;
                float* Cs = KT + 64 * 256;
                float* PWt = Cs + 2048;
                float* PWe = PWt + 1024;
                float* BBe = PWe + 2048;
                for (int item = vb; item < 256; item += G) {
                    const int g = item >> 3, tq = item & 7;
                    __syncthreads();
                    const int ntau = 8 * tq + 8;
                    for (int idx = tid; idx < ntau * 64; idx += NTHR) *(f32x4*)(KT + idx * 4) = *(const f32x4*)(KTAB + (size_t)g * 64 * 256 + idx * 4);
                    for (int idx = tid; idx < 1024; idx += NTHR) { const int i = idx >> 6, pp = idx & 63;
                        Cs[idx * 2] = kp->s5_c_re[(g * 16 + i) * 64 + pp]; Cs[idx * 2 + 1] = kp->s5_c_im[(g * 16 + i) * 64 + pp]; }
                    { const int pp = tid >> 3, tl = tid & 7; PWt[tid * 2] = PW[((g * 64 + pp) * 65 + tq * 8 + tl + 1) * 2]; PWt[tid * 2 + 1] = PW[((g * 64 + pp) * 65 + tq * 8 + tl + 1) * 2 + 1]; }
                    const int ri_e = tq >> 2, p0_e = (tq & 3) * 16;
                    for (int idx = tid; idx < 1024; idx += NTHR) { const int pl = idx >> 6, tau = idx & 63;
                        PWe[idx * 2] = PW[((g * 64 + p0_e + pl) * 65 + tau) * 2]; PWe[idx * 2 + 1] = PW[((g * 64 + p0_e + pl) * 65 + tau) * 2 + 1]; }
                    if (tid < 256) { const int pl = tid >> 4, j = tid & 15; BBe[tid * 2] = S5BB[((g * 64 + p0_e + pl) * 16 + j) * 2]; BBe[tid * 2 + 1] = S5BB[((g * 64 + p0_e + pl) * 16 + j) * 2 + 1]; }
                    __syncthreads();
                    for (int it = tid; it < 16 * 128; it += NTHR) {
                        const int pl = it >> 7, k8 = it & 127, s_ = k8 >> 1, j0 = (k8 & 1) * 8;
                        const float pr = PWe[(pl * 64 + 63 - s_) * 2], pi = PWe[(pl * 64 + 63 - s_) * 2 + 1];
                        float o[8];
#pragma unroll
                        for (int j = 0; j < 8; ++j) { const float br = BBe[(pl * 16 + j0 + j) * 2], bi = BBe[(pl * 16 + j0 + j) * 2 + 1]; o[j] = ri_e ? (pr * bi + pi * br) : (pr * br - pi * bi); }
                        u32x4 w; w.x = pk2(o[0], o[1]); w.y = pk2(o[2], o[3]); w.z = pk2(o[4], o[5]); w.w = pk2(o[6], o[7]);
                        *(u32x4*)(BT_END + ((size_t)g * 128 + ri_e * 64 + p0_e + pl) * 1024 + k8 * 8) = w;
                    }
                    for (int it = tid; it < 128 * 144; it += NTHR) {
                        const int rl = it / 144, k8 = it % 144, tl = rl >> 4, i = rl & 15, t = 8 * tq + tl;
                        float o[8];
                        if (k8 < 16) {
                            const int ri = k8 >> 3, p0 = (k8 & 7) * 8;
#pragma unroll
                            for (int j = 0; j < 8; ++j) {
                                const float cr = Cs[(i * 64 + p0 + j) * 2], ci = Cs[(i * 64 + p0 + j) * 2 + 1];
                                const float pr = PWt[((p0 + j) * 8 + tl) * 2], pi = PWt[((p0 + j) * 8 + tl) * 2 + 1];
                                o[j] = ri ? -(cr * pi + ci * pr) : (cr * pr - ci * pi);
                            }
                        } else {
                            const int kk = (k8 - 16) * 8, s_ = kk >> 4, j0 = kk & 15;
                            if (s_ <= t) { const f32x4 a = *(const f32x4*)(KT + (t - s_) * 256 + i * 16 + j0), c4 = *(const f32x4*)(KT + (t - s_) * 256 + i * 16 + j0 + 4);
                                o[0] = a.x; o[1] = a.y; o[2] = a.z; o[3] = a.w; o[4] = c4.x; o[5] = c4.y; o[6] = c4.z; o[7] = c4.w; }
                            else {
#pragma unroll
                                for (int j = 0; j < 8; ++j) o[j] = 0.f; }
                        }
                        u32x4 w; w.x = pk2(o[0], o[1]); w.y = pk2(o[2], o[3]); w.z = pk2(o[4], o[5]); w.w = pk2(o[6], o[7]);
                        *(u32x4*)(BT_MAIN + ((size_t)g * 1024 + 8 * tq * 16 + rl) * 1152 + k8 * 8) = w;
                    }
                }
                __syncthreads();
            }
        }
        else if (ph == 4) {
            {
                DenseOrder so; so.go.init(T / 256, 7, G, vb);
                struct UpCtx { float rs[8]; };
                auto pre = [=](const pg8::Unit& u, int wr, int wc, int fr, int fq, const PG8_LAS unsigned char* cxl) {
                        UpCtx cx; const int st = (u.pn >= 3) ? 1 : 0; const float inv = st ? (1.f / 128.f) : (1.f / 256.f);
#pragma unroll
                        for (int q = 0; q < 8; ++q) { const int row = u.pm * 256 + (q >> 2) * 128 + wr * 64 + (q & 3) * 16 + fr;
                            const f32x4 pp = *(const f32x4*)(RSP + ((size_t)row * 2 + st) * 4);
                            cx.rs[q] = rsqrtf(((pp.x + pp.y) + (pp.z + pp.w)) * inv + 1e-6f); }
                        return cx; };
                auto f = [=](const pg8::Unit& u, const UpCtx& cx, int ai, int m, int bj, int r, int c, f32x4 v0, f32x4 v1) {
                            const float rs = cx.rs[ai * 4 + m];
                            bf16_t* o = QKVRAW + (size_t)(u.pm * 256 + r) * 1792 + u.pn * 256 + c;
                            u32x2 a; a.x = pk2(v0.x * rs, v0.y * rs); a.y = pk2(v0.z * rs, v0.w * rs); *(u32x2*)o = a;
                            u32x2 b; b.x = pk2(v1.x * rs, v1.y * rs); b.y = pk2(v1.z * rs, v1.w * rs); *(u32x2*)(o + 16) = b;
                        };
                pg8::gemm_phase(tid, (PG8_LAS unsigned char*)lds, pg8::Gemm{Z, W_UP, 1024, 384, 384}, so, pg8::make_epi(pre, f));
            }
            for (int u = (vb >= 128 ? vb - 128 : vb + 128); u < 128; u += G) {
                const int g = u >> 2, pm = u & 3;
                sg_tile(tid, lds, AS5 + ((size_t)g * 512 + pm * 128) * 1152 + 128, 1152, BT_END + (size_t)g * 128 * 1024, 1024, 1024,
                    [=](int r, int c, f32x4 v0, f32x4 v1) {
                        float* o = LEND + ((size_t)g * 512 + pm * 128 + r) * 128 + c;
                        *(f32x4*)o = v0; *(f32x4*)(o + 16) = v1;
                    });
            }
        }
        else if (ph == 5) {
            bf16_t* stq = (bf16_t*)(lds + 65536) + wave * 1536;
            bf16_t* vts = (bf16_t*)lds;
            const float qscale = 0.10206207261596577f * 1.4426950408889634f;
            for (int tile = vb; tile < T / 64; tile += G) {
                const int hh = lane >> 3, pp = lane & 7;
                for (int tt = 0; tt < 8; ++tt) {
                    const int tl = wave * 8 + tt, row = tile * 64 + tl, b = row / S, t = row % S;
                    float qv[12], kv[12];
#pragma unroll
                    for (int j = 0; j < 12; ++j) {
                        const int d = pp + 8 * j;
                        qv[j] = bf2f(QKVRAW[(size_t)row * 1792 + hh * 96 + d]);
                        kv[j] = (j < 8) ? bf2f(QKVRAW[(size_t)row * 1792 + 768 + hh * 128 + d]) : bf2f(Z[(size_t)row * 1024 + 384 + d - 64]);
                    }
                    float sq = 0.f, sk = 0.f;
#pragma unroll
                    for (int j = 0; j < 12; ++j) { sq += qv[j] * qv[j]; sk += kv[j] * kv[j]; }
                    sq += __shfl_xor(sq, 1); sq += __shfl_xor(sq, 2); sq += __shfl_xor(sq, 4);
                    sk += __shfl_xor(sk, 1); sk += __shfl_xor(sk, 2); sk += __shfl_xor(sk, 4);
                    const float rq = rsqrtf(sq * (1.f / 96.f) + 1e-6f), rk = rsqrtf(sk * (1.f / 96.f) + 1e-6f);
#pragma unroll
                    for (int j = 0; j < 12; ++j) { const int d = pp + 8 * j; qv[j] *= rq * kp->q_head_g[d]; kv[j] *= rk * kp->k_head_g[d]; }
                    const float posf = (float)kp->pos[row];
#pragma unroll
                    for (int e = 0; e < 2; ++e) {
                        const int i = pp + 8 * e;
                        const float invf = exp2f(-(float)i * (13.287712379549449f / 16.0f));
                        const float ang = posf * invf;
                        const float kq = rintf(ang * 0.15915494309189535f);
                        float rr = __builtin_fmaf(-kq, 6.28318548202514648f, ang); rr = __builtin_fmaf(-kq, -1.7484556e-7f, rr);
                        const float cs = __cosf(rr), sn = __sinf(rr);
                        const float q1 = qv[8 + e], q2 = qv[10 + e], k1 = kv[8 + e], k2 = kv[10 + e];
                        qv[8 + e] = q1 * cs - q2 * sn; qv[10 + e] = q1 * sn + q2 * cs;
                        kv[8 + e] = k1 * cs - k2 * sn; kv[10 + e] = k1 * sn + k2 * cs;
                    }
#pragma unroll
                    for (int j = 0; j < 12; ++j) { const int d = pp + 8 * j; stq[hh * 96 + d] = f2bf(qv[j] * qscale); stq[768 + hh * 96 + d] = f2bf(kv[j]); }
#pragma unroll
                    for (int j = 0; j < 8; ++j) { const int dv = pp + 8 * j; vts[(hh * 64 + dv) * 64 + tl] = QKVRAW[(size_t)row * 1792 + 768 + hh * 128 + 64 + dv]; }
                    __builtin_amdgcn_s_waitcnt(0xC07F); asm volatile("" ::: "memory");
                    for (int ch = lane; ch < 192; ch += 64) {
                        const int isk = ch >= 96, c2 = ch - 96 * isk, h2 = c2 / 12, part = c2 % 12;
                        const u32x4 vv = *(const u32x4*)(stq + isk * 768 + h2 * 96 + part * 8);
                        bf16_t* dst = (isk ? Kb : Qb) + (((size_t)b * 8 + h2) * S + t) * 96 + part * 8;
                        *(u32x4*)dst = vv;
                    }
                    __builtin_amdgcn_s_waitcnt(0xC07F); asm volatile("" ::: "memory");
                }
                __syncthreads();
                {
                    const int hd = tid, b = (tile * 64) / S, t0 = (tile * 64) % S;
                    bf16_t* dst = VT + (((size_t)b * 8 + (hd >> 6)) * 64 + (hd & 63)) * S + t0;
#pragma unroll
                    for (int i = 0; i < 8; ++i) *(u32x4*)(dst + i * 8) = *(const u32x4*)(vts + hd * 64 + i * 8);
                }
                __syncthreads();
            }
            if (wave == 0) {
                for (int ch = vb * 64 + lane; ch < NB * 32 * 64; ch += G * 64) {
                    const int pp = ch & 63, g = (ch >> 6) & 31, b = ch >> 11;
                    const float ar = PW[((g * 64 + pp) * 65 + 64) * 2], ai = PW[((g * 64 + pp) * 65 + 64) * 2 + 1];
                    float cr = 0.f, ci = 0.f;
                    for (int c0 = 0; c0 < 64; c0 += 16) {
                        float lr[16], li[16];
#pragma unroll
                        for (int u = 0; u < 16; ++u) { const float* le = LEND + ((size_t)g * 512 + b * 64 + c0 + u) * 128; lr[u] = le[pp]; li[u] = le[64 + pp]; }
#pragma unroll
                        for (int u = 0; u < 16; ++u) {
                            bf16_t* dst = AS5 + ((size_t)g * 512 + b * 64 + c0 + u) * 1152;
                            dst[pp] = f2bf(cr); dst[64 + pp] = f2bf(ci);
                            const float nr = ar * cr - ai * ci + lr[u], ni = ar * ci + ai * cr + li[u];
                            cr = nr; ci = ni;
                        }
                    }
                }
            }
        }
        else if (ph == 6) {
            unsigned char* Ks = lds;
            unsigned char* Vs = lds + 64 * 208;
            const int r32 = lane & 31, hi = lane >> 5;
            for (int ui_ = 0; ui_ < 4 * (1 + PROBE_ATT2); ++ui_) { const int ui = ui_ & 3;
                if (vb >= 256) break;
                const int bh = vb & 63, kq = vb >> 6;
                const int qb = (ui == 0) ? 15 - kq : (ui == 1) ? 8 + kq : (ui == 2) ? 7 - kq : kq;
                const int q0 = qb * 256 + wave * 32;
                const bf16_t* Qg = Qb + ((size_t)bh * S + q0 + r32) * 96;
                const bf16_t* Kg = Kb + (size_t)bh * S * 96;
                const bf16_t* Vg = VT + (size_t)bh * 64 * S;
                f32x16 o0, o1;
#pragma unroll
                for (int r = 0; r < 16; ++r) { o0[r] = 0.f; o1[r] = 0.f; }
                float m_run = -1e30f, l_run = 0.f;
                const int ntile = 4 * (qb + 1);
                u32x4 rk0, rk1, rv;
                const int kr0 = tid / 12, kc0 = tid % 12, kr1 = (tid + 512) / 12, kc1 = (tid + 512) % 12;
                const int vr = tid >> 3, vc = tid & 7;
                rk0 = *(const u32x4*)(Kg + (size_t)kr0 * 96 + kc0 * 8);
                if (tid < 256) rk1 = *(const u32x4*)(Kg + (size_t)kr1 * 96 + kc1 * 8);
                rv = *(const u32x4*)(Vg + (size_t)vr * S + vc * 8);
                for (int t = 0; t < ntile; ++t) {
                    __syncthreads();
                    *(u32x4*)(Ks + kr0 * 208 + kc0 * 16) = rk0;
                    if (tid < 256) *(u32x4*)(Ks + kr1 * 208 + kc1 * 16) = rk1;
                    { u32x2 a; a.x = rv.x; a.y = rv.y; u32x2 b2; b2.x = rv.z; b2.y = rv.w;
                      *(u32x2*)(Vs + vr * 136 + vc * 16) = a; *(u32x2*)(Vs + vr * 136 + vc * 16 + 8) = b2; }
                    __syncthreads();
                    if (t + 1 < ntile) {
                        rk0 = *(const u32x4*)(Kg + (size_t)((t + 1) * 64 + kr0) * 96 + kc0 * 8);
                        if (tid < 256) rk1 = *(const u32x4*)(Kg + (size_t)((t + 1) * 64 + kr1) * 96 + kc1 * 8);
                        rv = *(const u32x4*)(Vg + (size_t)vr * S + (t + 1) * 64 + vc * 8);
                    }
                    if (t * 64 > q0 + 31) continue;
                    bf16x8 qf[6];
#pragma unroll
                    for (int d0 = 0; d0 < 6; ++d0) qf[d0] = *(const bf16x8*)(Qg + d0 * 16 + hi * 8);
                    f32x16 s0, s1;
#pragma unroll
                    for (int r = 0; r < 16; ++r) { s0[r] = 0.f; s1[r] = 0.f; }
#pragma unroll
                    for (int d0 = 0; d0 < 6; ++d0) {
                        const bf16x8 k0 = *(const bf16x8*)(Ks + r32 * 208 + d0 * 32 + hi * 16);
                        const bf16x8 k1 = *(const bf16x8*)(Ks + (32 + r32) * 208 + d0 * 32 + hi * 16);
                        s0 = __builtin_amdgcn_mfma_f32_32x32x16_bf16(k0, qf[d0], s0, 0, 0, 0);
                        s1 = __builtin_amdgcn_mfma_f32_32x32x16_bf16(k1, qf[d0], s1, 0, 0, 0);
                    }
                    if (t * 64 + 63 > q0) {
                        const int qi = q0 + r32;
#pragma unroll
                        for (int r = 0; r < 16; ++r) {
                            const int key = t * 64 + crow(r, hi);
                            if (key > qi) s0[r] = -INFINITY;
                            if (key + 32 > qi) s1[r] = -INFINITY;
                        }
                    }
                    float mx = s0[0];
#pragma unroll
                    for (int r = 1; r < 16; ++r) mx = fmaxf(mx, s0[r]);
#pragma unroll
                    for (int r = 0; r < 16; ++r) mx = fmaxf(mx, s1[r]);
                    mx = fmaxf(mx, __shfl_xor(mx, 32));
                    const float m_new = fmaxf(m_run, mx);
                    const float alpha = __builtin_amdgcn_exp2f(m_run - m_new);
                    m_run = m_new;
                    float ls = 0.f;
#pragma unroll
                    for (int r = 0; r < 16; ++r) { s0[r] = __builtin_amdgcn_exp2f(s0[r] - m_new); s1[r] = __builtin_amdgcn_exp2f(s1[r] - m_new); ls += s0[r] + s1[r]; }
                    l_run = l_run * alpha + ls;
#pragma unroll
                    for (int r = 0; r < 16; ++r) { o0[r] *= alpha; o1[r] *= alpha; }
                    bf16x8 pf[2][2];
#pragma unroll
                    for (int ks = 0; ks < 2; ++ks) {
                        u32x4 w0, w1;
                        w0.x = pk2(s0[8 * ks + 0], s0[8 * ks + 1]); w0.y = pk2(s0[8 * ks + 2], s0[8 * ks + 3]); w0.z = pk2(s0[8 * ks + 4], s0[8 * ks + 5]); w0.w = pk2(s0[8 * ks + 6], s0[8 * ks + 7]);
                        w1.x = pk2(s1[8 * ks + 0], s1[8 * ks + 1]); w1.y = pk2(s1[8 * ks + 2], s1[8 * ks + 3]); w1.z = pk2(s1[8 * ks + 4], s1[8 * ks + 5]); w1.w = pk2(s1[8 * ks + 6], s1[8 * ks + 7]);
                        pf[0][ks] = __builtin_bit_cast(bf16x8, w0); pf[1][ks] = __builtin_bit_cast(bf16x8, w1);
                    }
#pragma unroll
                    for (int kb = 0; kb < 2; ++kb)
#pragma unroll
                        for (int ks = 0; ks < 2; ++ks) {
                            const int koff = (kb * 32 + 16 * ks + 4 * hi) * 2;
#pragma unroll
                            for (int dvb = 0; dvb < 2; ++dvb) {
                                const unsigned char* vp = Vs + (dvb * 32 + r32) * 136 + koff;
                                const u32x2 lo = *(const u32x2*)vp, hi2 = *(const u32x2*)(vp + 16);
                                u32x4 w; w.x = lo.x; w.y = lo.y; w.z = hi2.x; w.w = hi2.y;
                                const bf16x8 vf = __builtin_bit_cast(bf16x8, w);
                                if (dvb == 0) o0 = __builtin_amdgcn_mfma_f32_32x32x16_bf16(vf, pf[kb][ks], o0, 0, 0, 0);
                                else o1 = __builtin_amdgcn_mfma_f32_32x32x16_bf16(vf, pf[kb][ks], o1, 0, 0, 0);
                            }
                        }
                }
                l_run += __shfl_xor(l_run, 32);
                const float rl = 1.0f / l_run;
                const int b = bh >> 3, h = bh & 7;
                bf16_t* orow = MIXIN + ((size_t)b * S + q0 + r32) * 1024 + h * 64;
#pragma unroll
                for (int rg = 0; rg < 4; ++rg) {
                    u32x2 a; a.x = pk2(o0[4 * rg] * rl, o0[4 * rg + 1] * rl); a.y = pk2(o0[4 * rg + 2] * rl, o0[4 * rg + 3] * rl);
                    *(u32x2*)(orow + 8 * rg + 4 * hi) = a;
                    u32x2 c2; c2.x = pk2(o1[4 * rg] * rl, o1[4 * rg + 1] * rl); c2.y = pk2(o1[4 * rg + 2] * rl, o1[4 * rg + 3] * rl);
                    *(u32x2*)(orow + 32 + 8 * rg + 4 * hi) = c2;
                }
            }
            __syncthreads();
            {
                S5Order so; so.G = G; so.c = vb;
                auto f = [=](const pg8::Unit& u, const pg8::NoCtx&, int ai, int m, int bj, int r, int c, f32x4 v0, f32x4 v1) {
                        const int g = u.aux, mr = (u.pm & 1) * 256 + r, b = mr >> 6, ck = mr & 63;
#pragma unroll
                        for (int h = 0; h < 2; ++h) {
                            const int n = u.pn * 256 + c + 16 * h; const f32x4 v = h ? v1 : v0;
                            const int tq = n >> 4, i = n & 15;
                            const u32x2 uu = *(const u32x2*)(AS5 + ((size_t)g * 512 + mr) * 1152 + 128 + n);
                            const f32x4 dd = *(const f32x4*)(s5d + g * 16 + i);
                            const float y0 = v.x + dd.x * __uint_as_float(uu.x << 16), y1 = v.y + dd.y * __uint_as_float(uu.x & 0xffff0000u),
                                        y2 = v.z + dd.z * __uint_as_float(uu.y << 16), y3 = v.w + dd.w * __uint_as_float(uu.y & 0xffff0000u);
                            u32x2 o; o.x = pk2(gelu_tanh(y0), gelu_tanh(y1)); o.y = pk2(gelu_tanh(y2), gelu_tanh(y3));
                            *(u32x2*)(GACT + ((size_t)b * S + ck * 64 + tq) * 512 + g * 16 + i) = o;
                        }
                    };
                pg8::gemm_phase(tid, (PG8_LAS unsigned char*)lds, pg8::Gemm{AS5, BT_MAIN, 1152, 1152, 1152}, so, pg8::make_epi(pg8::NoPre{}, f));
            }
        }
        else if (ph == 7) {
            {
                DenseOrder so; so.go.init(T / 256, 2, G, vb);
                auto f = [=](const pg8::Unit& u, const pg8::NoCtx&, int ai, int m, int bj, int r, int c, f32x4 v0, f32x4 v1) {
                        const int row = u.pm * 256 + r;
#pragma unroll
                        for (int h = 0; h < 2; ++h) {
                            const int col = u.pn * 256 + c + 16 * h; const f32x4 v = h ? v1 : v0;
                            const u32x2 gg = *(const u32x2*)(GACT + (size_t)row * 512 + col);
                            const f32x4 bb = *(const f32x4*)(glub + col);
                            const float g0 = __uint_as_float(gg.x << 16), g1 = __uint_as_float(gg.x & 0xffff0000u), g2 = __uint_as_float(gg.y << 16), g3 = __uint_as_float(gg.y & 0xffff0000u);
                            u32x2 o; o.x = pk2(g0 * sigmoidf_(v.x + bb.x), g1 * sigmoidf_(v.y + bb.y)); o.y = pk2(g2 * sigmoidf_(v.z + bb.z), g3 * sigmoidf_(v.w + bb.w));
                            *(u32x2*)(MIXIN + (size_t)row * 1024 + 512 + col) = o;
                        }
                    };
                pg8::gemm_phase(tid, (PG8_LAS unsigned char*)lds, pg8::Gemm{GACT, W_GLU, 512, 512, 512}, so, pg8::make_epi(pg8::NoPre{}, f));
            }
        }
        else if (ph == 8 || ph == 16) {
            const int lyr = (ph == 8) ? 0 : 1;
            const bf16_t* W = lyr ? W_OUT_O : W_OUT_E;

            {
                DenseOrder so; so.go.init(T / 256, 4, G, vb);
                struct OCtx { f32x4 gm[2][2]; };
                struct OG { u32x4 x[2][2]; };
                auto pre = [=](const pg8::Unit& u, int wr, int wc, int fr, int fq, const PG8_LAS unsigned char* cxl) {
                        OCtx cx; const int b = (u.pm * 256) / S; const float* gm = MOD + ((size_t)lyr * NB + b) * 6144 + 2 * D;
#pragma unroll
                        for (int bj = 0; bj < 2; ++bj)
#pragma unroll
                            for (int h = 0; h < 2; ++h) cx.gm[bj][h] = *(const f32x4*)(gm + u.pn * 256 + bj * 128 + wc * 32 + 4 * fq + 16 * h);
                        return cx; };
                auto gp = [=](const pg8::Unit& u, const OCtx&, int r, int wc, int fq) {
                        OG g; const int row = u.pm * 256 + r;
#pragma unroll
                        for (int bj = 0; bj < 2; ++bj)
#pragma unroll
                            for (int h = 0; h < 2; ++h) { const int col = u.pn * 256 + bj * 128 + wc * 32 + 4 * fq + 16 * h;
                                if (lyr == 0) g.x[bj][h] = *(const u32x4*)(XIN + (size_t)row * D + col);
                                else { const u32x2 xx = *(const u32x2*)(XR + (size_t)row * D + col); g.x[bj][h] = (u32x4){xx.x, xx.y, 0u, 0u}; } }
                        return g; };
                auto f = [=](const pg8::Unit& u, const OCtx& cx, const OG& g, int ai, int m, int bj, int r, int c, f32x4 v0, f32x4 v1) {
                        const int row = u.pm * 256 + r;
#pragma unroll
                        for (int h = 0; h < 2; ++h) {
                            const int col = u.pn * 256 + c + 16 * h; const f32x4 v = h ? v1 : v0;
                            const f32x4 g4 = cx.gm[bj][h]; const u32x4 xx = g.x[bj][h]; f32x4 xs;
                            if (lyr == 0) { xs.x = __uint_as_float(xx.x); xs.y = __uint_as_float(xx.y); xs.z = __uint_as_float(xx.z); xs.w = __uint_as_float(xx.w); }
                            else { xs.x = __uint_as_float(xx.x << 16); xs.y = __uint_as_float(xx.x & 0xffff0000u); xs.z = __uint_as_float(xx.y << 16); xs.w = __uint_as_float(xx.y & 0xffff0000u); }
                            u32x2 o; o.x = pk2(xs.x + g4.x * v.x, xs.y + g4.y * v.y); o.y = pk2(xs.z + g4.z * v.z, xs.w + g4.w * v.w);
                            *(u32x2*)(XR + (size_t)row * D + col) = o;
                        }
                    };
                pg8::gemm_phase(tid, (PG8_LAS unsigned char*)lds, pg8::Gemm{MIXIN, W, D, D, D}, so, pg8::make_epi_g(pre, gp, f));
            }
        }
        else if (mph == 9) {
            const bf16_t* W = W_RT + (size_t)layer * 128 * 1024;
            const float* rb = rtb_all + layer * 32;
            float* lgs = (float*)(lds + 40960);
            unsigned* hist = (unsigned*)(lds + 40960 + 128 * 33 * 4);
            unsigned* gcnt = ctl + CW_CNT + layer * 64;
            const float* ng = kp->norm_ffn_g + layer * D;
            for (int tile = vb; tile < T / 128; tile += G) {
              for (int rep_ = 0; rep_ <= PROBE_RT2; ++rep_) {
                if (rep_) __syncthreads();
                for (int i = 0; i < 16; i += 2) {
                    u32x4 xr[2][2];
#pragma unroll
                    for (int q = 0; q < 2; ++q)
#pragma unroll
                        for (int j = 0; j < 2; ++j) xr[q][j] = *(const u32x4*)(XR + (size_t)(tile * 128 + wave * 16 + i + q) * D + 8 * lane + 512 * j);
#pragma unroll
                    for (int q = 0; q < 2; ++q) {
                        const int row = tile * 128 + wave * 16 + i + q, b = row / S;
                        float v[2][8]; unpack8(xr[q][0], v[0]); unpack8(xr[q][1], v[1]);
                        const float* mm = MOD + ((size_t)layer * NB + b) * 6144 + 3 * D;
                        norm_mod_store8(v, ng, mm + D, mm, HB + (size_t)row * D, HB8 + (size_t)row * D, lane);
                    }
                }
                if (tid < 64) hist[tid] = 0u;
                asm volatile("s_waitcnt vmcnt(0)" ::: "memory");
                __syncthreads();
                sg_tile(tid, lds, HB + (size_t)tile * 128 * D, D, W, D, D,
                    [=](int r, int c, f32x4 v0, f32x4 v1) {
                        if (c < 32) {
#pragma unroll
                            for (int i = 0; i < 4; ++i) { lgs[r * 33 + c + i] = v0[i] + rb[c + i]; lgs[r * 33 + c + 16 + i] = v1[i] + rb[c + 16 + i]; }
                        }
                    });
              }
                __syncthreads();
                const bool act = tid < 128; const int rr = tid & 127;
                float lg[32];
#pragma unroll
                for (int e = 0; e < 32; ++e) lg[e] = lgs[rr * 33 + e];
                int e0 = 0, e1 = 0, e2 = 0, e3 = 0; float v0_ = 0.f, v1_ = 0.f, v2_ = 0.f, v3_ = 0.f;
#pragma unroll
                for (int k = 0; k < 4; ++k) {
                    float best = -INFINITY; int bi = 0;
#pragma unroll
                    for (int e = 0; e < 32; ++e) { const bool tk = lg[e] > best; best = tk ? lg[e] : best; bi = tk ? e : bi; }
                    if (k == 0) { e0 = bi; v0_ = best; } else if (k == 1) { e1 = bi; v1_ = best; } else if (k == 2) { e2 = bi; v2_ = best; } else { e3 = bi; v3_ = best; }
#pragma unroll
                    for (int e = 0; e < 32; ++e) lg[e] = (e == bi) ? -INFINITY : lg[e];
                }
                const float x1_ = __expf(v1_ - v0_), x2_ = __expf(v2_ - v0_), x3_ = __expf(v3_ - v0_);
                const float rden = 1.0f / (1.0f + x1_ + x2_ + x3_);
                unsigned l0 = 0, l1 = 0, l2 = 0, l3 = 0;
                if (act) { l0 = atomicAdd(hist + e0, 1u); l1 = atomicAdd(hist + e1, 1u); l2 = atomicAdd(hist + e2, 1u); l3 = atomicAdd(hist + e3, 1u); }
                __syncthreads();
                if (tid < 32) hist[32 + tid] = atomicAdd(gcnt + tid, (unsigned)hist[tid]);
                __syncthreads();
                if (act) {
                    const int tok = tile * 128 + tid;
                    size_t idx = (size_t)e0 * T + hist[32 + e0] + l0; EL_SLOT[idx] = tok * 4 + 0; EL_GATE[idx] = rden;
                    idx = (size_t)e1 * T + hist[32 + e1] + l1; EL_SLOT[idx] = tok * 4 + 1; EL_GATE[idx] = x1_ * rden;
                    idx = (size_t)e2 * T + hist[32 + e2] + l2; EL_SLOT[idx] = tok * 4 + 2; EL_GATE[idx] = x2_ * rden;
                    idx = (size_t)e3 * T + hist[32 + e3] + l3; EL_SLOT[idx] = tok * 4 + 3; EL_GATE[idx] = x3_ * rden;
                }
                __syncthreads();
            }
        }
        else if (mph == 10 || mph == 11) {
            int* pst = (int*)(lds + LDS_MISC + 1024);
            if (tid == 0) {
                const unsigned* gcnt = ctl + CW_CNT + layer * 64; int acc = 0;
                for (int e = 0; e < 32; ++e) { const int c = (int)gcnt[e]; pst[e] = acc; pst[64 + e] = c; acc += (c + 255) & ~255; }
                pst[32] = acc;
            }
            __syncthreads();
            const int total_rows = pst[32];
            if (mph == 10) {
                {
                    MoeOrder so; so.go.init(total_rows >> 8, 8, G, vb); so.pst = pst; so.NT = 8; so.ebase = layer * 32; so.el_slot = EL_SLOT;
                    struct G1Ctx { f32x4 b0[2], b1[2]; };
                    auto pre = [=](const pg8::Unit& u, int wr, int wc, int fr, int fq, const PG8_LAS unsigned char* cxl) {
                            G1Ctx cx;
#pragma unroll
                            for (int bj = 0; bj < 2; ++bj) { const int jl = (bj * 4 + wc) * 16 + 4 * fq;
                                cx.b0[bj] = *(const PG8_LAS f32x4*)(cxl + jl * 4); cx.b1[bj] = *(const PG8_LAS f32x4*)(cxl + 512 + jl * 4); }
                            return cx; };
                    auto stg = [=](const pg8::Unit& u, PG8_LAS unsigned char* cb, int wid, int lane) {
                            if (wid == 0) { const float* src = bgu_all + (size_t)(layer * 32 + u.aux) * 2048 + (lane >> 5) * 1024 + u.pn * 128 + (lane & 31) * 4;
                                __builtin_amdgcn_global_load_lds((const unsigned*)src, (PG8_LAS unsigned*)cb, 16, 0, 0); } };
                    auto f = [=](const pg8::Unit& u, const G1Ctx& cx, int ai, int m, int bj, int tr, int c, f32x4 v0, f32x4 v1, PG8_LAS unsigned char* tile) {
                            const int jl = (c >> 5) * 16 + (c & 15);
                            const f32x4 b0 = cx.b0[bj], b1 = cx.b1[bj];
                            typedef float f32x2 __attribute__((ext_vector_type(2)));
                            float o[4];
#pragma unroll
                            for (int q = 0; q < 2; ++q) {
                                f32x2 gt = (f32x2){v0[2 * q], v0[2 * q + 1]} + (f32x2){b0[2 * q], b0[2 * q + 1]};
                                f32x2 ln = (f32x2){v1[2 * q], v1[2 * q + 1]} + (f32x2){b1[2 * q], b1[2 * q + 1]};
                                gt.x = __builtin_amdgcn_fmed3f(gt.x, -INFINITY, 7.0f); gt.y = __builtin_amdgcn_fmed3f(gt.y, -INFINITY, 7.0f);
                                ln.x = __builtin_amdgcn_fmed3f(ln.x, -7.0f, 7.0f); ln.y = __builtin_amdgcn_fmed3f(ln.y, -7.0f, 7.0f);
                                const f32x2 t = gt * (-1.702f * 1.4426950408889634f);
                                f32x2 e; e.x = __builtin_amdgcn_exp2f(t.x); e.y = __builtin_amdgcn_exp2f(t.y);
                                const f32x2 d = e + 1.0f;
                                f32x2 r; r.x = __builtin_amdgcn_rcpf(d.x); r.y = __builtin_amdgcn_rcpf(d.y);
                                const f32x2 ov = (gt * r) * (ln + 1.0f);
                                o[2 * q] = ov.x; o[2 * q + 1] = ov.y;
                            }
                            *(PG8_LAS unsigned*)(tile + tr * 144 + jl) = pk4_fp8(o[0], o[1], o[2], o[3]);
                        };
                    auto fl = [=](const pg8::Unit& u, const G1Ctx&, int ai, int m0, int tid_, PG8_LAS unsigned char* tile) {
                            const int tr = tid_ >> 3, piece = tid_ & 7;
                            const u32x4 v = *(const PG8_LAS u32x4*)(tile + tr * 144 + piece * 16);
                            const int row = u.pm * 256 + ai * 128 + ((tr >> 4) & 1) * 64 + (m0 + (tr >> 5)) * 16 + (tr & 15);
                            *(u32x4*)(ACT + (size_t)row * D + u.pn * 128 + piece * 16) = v;
                        };
                    pg8::gemm_phase<true, true>(tid, (PG8_LAS unsigned char*)lds, pg8::Gemm{(const bf16_t*)HB8, (const bf16_t*)W_GU, 512, 512, 512}, so, pg8::make_epi_staged<2, 9216>(pre, f, fl), stg, LDS_CTX_OFF);
                }
            } else {
                {
                    MoeOrder so; so.go.init(total_rows >> 8, 4, G, vb); so.pst = pst; so.NT = 4; so.ebase = layer * 32; so.el_slot = EL_SLOT;
                    struct G2Ctx { float gate[8]; int slot[8]; f32x4 bb[2][2]; };
                    auto pre = [=](const pg8::Unit& u, int wr, int wc, int fr, int fq, const PG8_LAS unsigned char* cxl) {
                            G2Ctx cx;
                            const int ro0 = u.pm * 256 - pst[u.aux], cnt = pst[64 + u.aux];
#pragma unroll
                            for (int q = 0; q < 8; ++q) { const int rl = (q >> 2) * 128 + wr * 64 + (q & 3) * 16 + fr; const bool ok = ro0 + rl < cnt;
                                const float gv = *(const PG8_LAS float*)(cxl + 1024 + rl * 4); const int sv = *(const PG8_LAS int*)(cxl + 2048 + rl * 4);
                                cx.gate[q] = ok ? gv : 0.f; cx.slot[q] = ok ? sv : -1; }
#pragma unroll
                            for (int bj = 0; bj < 2; ++bj)
#pragma unroll
                                for (int h = 0; h < 2; ++h) cx.bb[bj][h] = *(const PG8_LAS f32x4*)(cxl + (bj * 128 + wc * 32 + 8 * fq + 4 * h) * 4);
                            return cx; };
                    auto stg = [=](const pg8::Unit& u, PG8_LAS unsigned char* cb, int wid, int lane) {
                            const size_t eo = (size_t)u.aux * T + (u.pm * 256 - pst[u.aux]) + lane * 4;
                            if (wid == 0) __builtin_amdgcn_global_load_lds((const unsigned*)(bdn_all + (size_t)(layer * 32 + u.aux) * 1024 + u.pn * 256 + lane * 4), (PG8_LAS unsigned*)cb, 16, 0, 0);
                            else if (wid == 1) __builtin_amdgcn_global_load_lds((const unsigned*)(EL_GATE + eo), (PG8_LAS unsigned*)(cb + 1024), 16, 0, 0);
                            else if (wid == 2) __builtin_amdgcn_global_load_lds((const unsigned*)(EL_SLOT + eo), (PG8_LAS unsigned*)(cb + 2048), 16, 0, 0); };
                    auto f = [=](const pg8::Unit& u, const G2Ctx& cx, int ai, int m, int bj, int r, int c8, f32x4 v0, f32x4 v1) {
                            const int slot = cx.slot[ai * 4 + m];
                            if (slot >= 0) {
                                const float gt = cx.gate[ai * 4 + m]; const f32x4 b0 = cx.bb[bj][0], b1 = cx.bb[bj][1];
                                u32x4 o; o.x = pk2((v0.x + b0.x) * gt, (v0.y + b0.y) * gt); o.y = pk2((v0.z + b0.z) * gt, (v0.w + b0.w) * gt);
                                o.z = pk2((v1.x + b1.x) * gt, (v1.y + b1.y) * gt); o.w = pk2((v1.z + b1.z) * gt, (v1.w + b1.w) * gt);
                                *(u32x4*)(Y + (size_t)slot * D + u.pn * 256 + c8) = o;
                            }
                        };
                    pg8::gemm_phase<true, false, true>(tid, (PG8_LAS unsigned char*)lds, pg8::Gemm{(const bf16_t*)ACT, (const bf16_t*)W_DN, 512, 512, 512}, so, pg8::make_epi_perm(pre, f), stg, LDS_CTX_OFF);
                }
            }
        }
        else if (ph == 13) {
            {
                DenseOrder so; so.go.init(T / 256, 6, G, vb);
                auto f = [=](const pg8::Unit& u, const pg8::NoCtx&, int ai, int m, int bj, int r, int c, f32x4 v0, f32x4 v1) {
                        const int row = u.pm * 256 + r;
#pragma unroll
                        for (int h = 0; h < 2; ++h) {
                            const int col = u.pn * 256 + c + 16 * h; f32x4 v = h ? v1 : v0;
                            if (col >= 512) { v.x = gelu_tanh(v.x); v.y = gelu_tanh(v.y); v.z = gelu_tanh(v.z); v.w = gelu_tanh(v.w); }
                            u32x2 o; o.x = pk2(v.x, v.y); o.y = pk2(v.z, v.w);
                            *(u32x2*)(Z + (size_t)row * 1536 + col) = o;
                        }
                    };
                pg8::gemm_phase(tid, (PG8_LAS unsigned char*)lds, pg8::Gemm{HB, W_IN_O, D, D, D}, so, pg8::make_epi(pg8::NoPre{}, f));
            }
        }
        else if (ph == 14) {
            for (int ck = vb; ck < T / 128; ck += G) {
                bf16_t* tile = (bf16_t*)lds;
                for (int tt = 0; tt < 16; ++tt) {
                    const int sl = wave * 16 + tt, row = ck * 128 + sl, t = row % S;
                    {
                        const int ch0 = lane * 8, w = 2 << (ch0 >> 7);
                        float acc[8], own[8];
#pragma unroll
                        for (int i = 0; i < 8; ++i) acc[i] = 0.f;
                        const int n = (t + 1 < w) ? t + 1 : w;
                        for (int q = 0; q < n; ++q) {
                            const u32x4 uv = *(const u32x4*)(Z + (size_t)(row - q) * 1536 + ch0);
                            const float f[8] = {__uint_as_float(uv.x << 16), __uint_as_float(uv.x & 0xffff0000u), __uint_as_float(uv.y << 16), __uint_as_float(uv.y & 0xffff0000u),
                                                __uint_as_float(uv.z << 16), __uint_as_float(uv.z & 0xffff0000u), __uint_as_float(uv.w << 16), __uint_as_float(uv.w & 0xffff0000u)};
#pragma unroll
                            for (int i = 0; i < 8; ++i) { acc[i] += f[i]; if (q == 0) own[i] = f[i]; }
                        }
                        const float inv = 1.0f / (float)n;
                        u32x4 o; o.x = pk2(acc[0] * inv - own[0], acc[1] * inv - own[1]); o.y = pk2(acc[2] * inv - own[2], acc[3] * inv - own[3]);
                        o.z = pk2(acc[4] * inv - own[4], acc[5] * inv - own[5]); o.w = pk2(acc[6] * inv - own[6], acc[7] * inv - own[7]);
                        *(u32x4*)(POOLED + (size_t)row * 512 + ch0) = o;
                    }
                    {
                        const u32x4 uv = *(const u32x4*)(Z + (size_t)row * 1536 + 1024 + lane * 8);
                        float f[8] = {__uint_as_float(uv.x << 16), __uint_as_float(uv.x & 0xffff0000u), __uint_as_float(uv.y << 16), __uint_as_float(uv.y & 0xffff0000u),
                                      __uint_as_float(uv.z << 16), __uint_as_float(uv.z & 0xffff0000u), __uint_as_float(uv.w << 16), __uint_as_float(uv.w & 0xffff0000u)};
                        float ss = 0.f;
#pragma unroll
                        for (int i = 0; i < 8; ++i) ss += f[i] * f[i];
                        const float rr = rsqrtf(wave_sum(ss) * (1.f / 512.f) + 1e-6f);
                        u32x4 o;
                        const float* gg = kp->sgu_norm_g + lane * 8;
                        o.x = pk2(f[0] * rr * gg[0], f[1] * rr * gg[1]); o.y = pk2(f[2] * rr * gg[2], f[3] * rr * gg[3]);
                        o.z = pk2(f[4] * rr * gg[4], f[5] * rr * gg[5]); o.w = pk2(f[6] * rr * gg[6], f[7] * rr * gg[7]);
                        *(u32x4*)(tile + sl * 520 + lane * 8) = o;
                    }
                }
                __syncthreads();
                {
                    const int ch = tid;
                    bf16_t* dst = VTS + ((size_t)ck * 512 + ch) * 128;
                    for (int s8 = 0; s8 < 16; ++s8) {
                        unsigned w[4];
#pragma unroll
                        for (int i = 0; i < 4; ++i) w[i] = (unsigned)tile[(s8 * 8 + 2 * i) * 520 + ch] | ((unsigned)tile[(s8 * 8 + 2 * i + 1) * 520 + ch] << 16);
                        u32x4 o; o.x = w[0]; o.y = w[1]; o.z = w[2]; o.w = w[3];
                        *(u32x4*)(dst + s8 * 8) = o;
                    }
                }
                __syncthreads();
            }
        }
        else if (ph == 15) {
            for (int u = vb; u < 2048; u += G) {
                if (u < 1024) {
                    const int pm = u >> 2, gi = u & 3;
                    sg_tile(tid, lds, POOLED + (size_t)pm * 128 * 512 + gi * 128, 512, W_POOL + (size_t)gi * 128 * 128, 128, 128,
                        [=](int r, int c, f32x4 v0, f32x4 v1) {
                            const int row = pm * 128 + r;
#pragma unroll
                            for (int h = 0; h < 2; ++h) {
                                const int col = gi * 128 + c + 16 * h; const f32x4 v = h ? v1 : v0;
                                const f32x4 sc = *(const f32x4*)(poolsc + col);
                                u32x2 o; o.x = pk2(v.x * sc.x, v.y * sc.y); o.y = pk2(v.z * sc.z, v.w * sc.w);
                                *(u32x2*)(MIXIN + (size_t)row * 1024 + col) = o;
                            }
                        });
                } else {
                    const int uu = u - 1024, ck = uu >> 2, h4 = uu & 3;
                    sg_tile(tid, lds, W_SGU + (size_t)h4 * 128 * 128, 128, VTS + ((size_t)ck * 512 + h4 * 128) * 128, 128, 128,
                        [=](int r, int c, f32x4 v0, f32x4 v1) {
                            const int row = ck * 128 + r;
                            const float bias = sgub[h4 * 128 + r];
#pragma unroll
                            for (int h = 0; h < 2; ++h) {
                                const int dcol = c + 16 * h; const f32x4 v = h ? v1 : v0;
                                const u32x2 ug = *(const u32x2*)(Z + (size_t)row * 1536 + 512 + h4 * 128 + dcol);
                                u32x2 o; o.x = pk2((v.x + bias) * __uint_as_float(ug.x << 16), (v.y + bias) * __uint_as_float(ug.x & 0xffff0000u));
                                o.y = pk2((v.z + bias) * __uint_as_float(ug.y << 16), (v.w + bias) * __uint_as_float(ug.y & 0xffff0000u));
                                *(u32x2*)(MIXIN + (size_t)row * 1024 + 512 + h4 * 128 + dcol) = o;
                            }
                        });
                }
            }
        }

    }
}
template <int PH> struct PhaseSeq {
    static __device__ __forceinline__ void run(const XcdBarrier& bar) { PhaseSeq<PH - 1>::run(bar); if constexpr (PH == 3) return;
        unsigned long long t0_ = 0; if constexpr (PH == PROBE_TPH) t0_ = __builtin_amdgcn_s_memrealtime();
        phase_body<PH>(bar.wbase);
        if constexpr (((PROBE_DUP_MASK >> PH) & 1ull) != 0) { xcd_barrier(bar); phase_body<PH>(bar.wbase); }
        if (PH + 1 < NPHASE) { xcd_barrier(bar); if constexpr (PROBE_BAR2) xcd_barrier(bar); }
        if constexpr (PH == PROBE_TPH) { if (bar.wbase == 0 && lane_id() == 0) { const unsigned dt = (unsigned)(__builtin_amdgcn_s_memrealtime() - t0_); bar.st[4] = dt; } }
    }
};
template <> struct PhaseSeq<-1> { static __device__ __forceinline__ void run(const XcdBarrier&) {} };

template <int PHSEL> __global__ void __launch_bounds__(NTHR, 2) hybrid_fwd(Params p) {
    extern __shared__ __attribute__((aligned(16))) unsigned char lds[];
    const int tid0 = threadIdx.x;
    for (int u = tid0; u < (LDS_BYTES - LDS_MISC) / 4; u += NTHR) ((unsigned*)(lds + LDS_MISC))[u] = 0u;
    __syncthreads();
    if constexpr (PHSEL >= 0) { phase_body<PHSEL>(__builtin_amdgcn_readfirstlane((int)threadIdx.x & ~63)); }
    else {
        volatile LAS unsigned* MISC = (volatile LAS unsigned*)((LAS unsigned char*)lds + LDS_MISC);
        unsigned* ctl0 = (unsigned*)(p.ws + WS_CTL);
        XcdBarrier bar = xcd_barrier_post(ctl0 + CW_BAR, MISC + 8);
        PhaseSeq<NPHASE - 1>::run(bar);
        if constexpr (PROBE_TPH >= 0 || PROBE_SEG != 0) { if (blockIdx.x == 0 && bar.wbase == 0 && lane_id() == 0) { const unsigned dt = MISC[12]; const unsigned long long te = __builtin_amdgcn_s_memrealtime(); while (__builtin_amdgcn_s_memrealtime() - te < 4ull * dt) __builtin_amdgcn_s_sleep(8); } }
    }
}

typedef void (*kfn_t)(Params);
template <int PH> struct Tab { static void fill(kfn_t* t) { t[PH] = hybrid_fwd<PH>; Tab<PH - 1>::fill(t); } };
template <> struct Tab<-1> { static void fill(kfn_t*) {} };
static kfn_t g_tab[NPHASE];
static void set_attrs() {
#if MK_ONE_LAUNCH
    (void)hipFuncSetAttribute((const void*)hybrid_fwd<-1>, hipFuncAttributeMaxDynamicSharedMemorySize, LDS_BYTES);
#else
    Tab<NPHASE - 1>::fill(g_tab);
    for (int i = 0; i < NPHASE; ++i) (void)hipFuncSetAttribute((const void*)g_tab[i], hipFuncAttributeMaxDynamicSharedMemorySize, LDS_BYTES);
#endif
}
#if !MK_ONE_LAUNCH
static void launch_all(const Params& p, int grid, hipStream_t stream) {
    for (int ph = 0; ph < NPHASE; ++ph) hipLaunchKernelGGL(g_tab[ph], dim3(grid), dim3(NTHR), LDS_BYTES, stream, p);
}
#endif
extern "C" void kernel_launch(void* const* d_in, const int* in_sizes, int n_in, void* d_out, int out_size, void* d_ws, size_t ws_size, hipStream_t stream) {
    static int ready = 0;
    if (ready == 0) {
        if (n_in != 38 || ws_size < WS_END) { fprintf(stderr, "kernel_launch: unexpected n_in %d / ws %zu\n", n_in, ws_size); ready = -1; return; }
        set_attrs();
        ready = 1;
    }
    if (ready < 0) return;
    (void)hipMemsetAsync((char*)d_ws + WS_CTL, 0, CTL_ZERO_BYTES, stream);
    Params p{};
    const float** fp = (const float**)&p.x;
    (void)fp;
    p.x = (const float*)d_in[0]; p.c = (const float*)d_in[1]; p.pos = (const int*)d_in[2];
    p.ada_w = (const float*)d_in[3]; p.ada_b = (const float*)d_in[4]; p.norm_mix_g = (const float*)d_in[5]; p.norm_ffn_g = (const float*)d_in[6];
    p.router_w = (const float*)d_in[7]; p.router_b = (const float*)d_in[8]; p.moe_w_gu = (const float*)d_in[9]; p.moe_b_gu = (const float*)d_in[10];
    p.moe_w_dn = (const float*)d_in[11]; p.moe_b_dn = (const float*)d_in[12];
    p.even_w_in = (const float*)d_in[13]; p.q_norm_g = (const float*)d_in[14]; p.w_uq = (const float*)d_in[15]; p.kv_norm_g = (const float*)d_in[16];
    p.w_ukv = (const float*)d_in[17]; p.q_head_g = (const float*)d_in[18]; p.k_head_g = (const float*)d_in[19];
    p.s5_a_re = (const float*)d_in[20]; p.s5_a_im = (const float*)d_in[21]; p.s5_log_dt = (const float*)d_in[22]; p.s5_b_re = (const float*)d_in[23];
    p.s5_b_im = (const float*)d_in[24]; p.s5_c_re = (const float*)d_in[25]; p.s5_c_im = (const float*)d_in[26]; p.s5_d = (const float*)d_in[27];
    p.s5_glu_w = (const float*)d_in[28]; p.s5_glu_b = (const float*)d_in[29]; p.even_w_out = (const float*)d_in[30];
    p.odd_w_in = (const float*)d_in[31]; p.pool_w = (const float*)d_in[32]; p.pool_scale = (const float*)d_in[33]; p.sgu_norm_g = (const float*)d_in[34];
    p.sgu_w = (const float*)d_in[35]; p.sgu_b = (const float*)d_in[36]; p.odd_w_out = (const float*)d_in[37];
    p.out = (float*)d_out; p.ws = (unsigned char*)d_ws;
    const int grid = 256;
#if MK_ONE_LAUNCH
    p.ph_lo = 0; p.ph_hi = NPHASE;
    hipLaunchKernelGGL(hybrid_fwd<-1>, dim3(grid), dim3(NTHR), LDS_BYTES, stream, p);
#else
    p.ph_lo = 0; p.ph_hi = 1;
    launch_all(p, grid, stream);
#endif
}
```

```cpp
#include <hip/hip_runtime.h>
#include <cstdio>
#include <cstdint>

#ifndef PROBE_DUP_MASK
#define PROBE_DUP_MASK 0x0ull
#endif
#ifndef PROBE_ATT2
#define PROBE_ATT2 0
#endif
#ifndef PROBE_RT2
#define PROBE_RT2 0
#endif
#ifndef PROBE_TPH
#define PROBE_TPH -1
#endif
#ifndef PROBE_SEG
#define PROBE_SEG 0
#endif
#ifndef PROBE_BAR2
#define PROBE_BAR2 0
#endif
#ifndef PROBE_EPI2
#define PROBE_EPI2 0
#endif
#ifndef PROBE_KX2
#define PROBE_KX2 0
#endif
#ifndef MK_ONE_LAUNCH
#define MK_ONE_LAUNCH 1
#endif

typedef unsigned short bf16_t;
typedef short bf16x8 __attribute__((ext_vector_type(8)));
typedef short s16x4 __attribute__((ext_vector_type(4)));
typedef float f32x4 __attribute__((ext_vector_type(4)));
typedef float f32x16 __attribute__((ext_vector_type(16)));
typedef unsigned u32x4 __attribute__((ext_vector_type(4)));
typedef unsigned u32x2 __attribute__((ext_vector_type(2)));

constexpr int D = 1024, NB = 8, S = 4096, T = NB * S;
constexpr int NTHR = 512, NWAVE = 8;
constexpr int MOE_ROWS = 139264;
constexpr int NPHASE = 21;

constexpr size_t MiB = 1u << 20;
constexpr size_t WS_CTL = 0, CTL_ZERO_BYTES = 1 * MiB;
constexpr size_t WS_MOD = 1 * MiB;
constexpr size_t WS_S5AB = 2 * MiB;
constexpr size_t WS_PW = 3 * MiB;
constexpr size_t WS_KTAB = 5 * MiB;
constexpr size_t WS_TOK = 7 * MiB;
constexpr size_t WS_ROW = 9 * MiB;
constexpr size_t WS_LOGIT = 11 * MiB;
constexpr size_t WS_W_IN_E = 16 * MiB, WS_W_UP = 18 * MiB  , WS_W_GLU = 20 * MiB, WS_W_OUT_E = 21 * MiB, WS_W_IN_O = 23 * MiB,
                 WS_W_OUT_O = 26 * MiB, WS_W_POOL = 28 * MiB, WS_W_SGU = 29 * MiB, WS_W_RT = 30 * MiB;
constexpr size_t WS_BT_END = 32 * MiB;
constexpr size_t WS_BT_MAIN = 40 * MiB;
constexpr size_t WS_W_GU = 112 * MiB;
constexpr size_t WS_W_DN = 240 * MiB;
constexpr size_t WS_HB8 = 304 * MiB;
constexpr size_t WS_XR = 336 * MiB;
constexpr size_t WS_HB = 496 * MiB;
constexpr size_t WS_MIXIN = 560 * MiB;
constexpr size_t WS_Y = 624 * MiB;
constexpr size_t WS_EL = 880 * MiB;
constexpr size_t WS_ACT = 1152 * MiB;
constexpr size_t WS_END = 1424 * MiB;
constexpr size_t WS_Z = 880 * MiB;
constexpr size_t WS_RSP = 976 * MiB  , WS_QKVRAW = 1000 * MiB  , WS_Q = 1112 * MiB, WS_K = 1160 * MiB, WS_VT = 1208 * MiB,
                 WS_AS5 = 1240 * MiB, WS_LEND = 1276 * MiB, WS_GACT = 1284 * MiB;
constexpr size_t WS_POOLED = 976 * MiB, WS_VTS = 1008 * MiB;
constexpr int CW_BAR = 4096, CW_CNT = 16384;

constexpr int LDS_BYTES = 160 * 1024;
constexpr int LDS_CTX_OFF = 18432;
constexpr int LDS_MISC = 158 * 1024;

struct Params {
    const float *x, *c; const int* pos;
    const float *ada_w, *ada_b, *norm_mix_g, *norm_ffn_g, *router_w, *router_b, *moe_w_gu, *moe_b_gu, *moe_w_dn, *moe_b_dn;
    const float *even_w_in, *q_norm_g, *w_uq, *kv_norm_g, *w_ukv, *q_head_g, *k_head_g;
    const float *s5_a_re, *s5_a_im, *s5_log_dt, *s5_b_re, *s5_b_im, *s5_c_re, *s5_c_im, *s5_d, *s5_glu_w, *s5_glu_b, *even_w_out;
    const float *odd_w_in, *pool_w, *pool_scale, *sgu_norm_g, *sgu_w, *sgu_b, *odd_w_out;
    float* out; unsigned char* ws; int ph_lo, ph_hi;
};

__device__ __forceinline__ float bf2f(unsigned short b) { return __uint_as_float(((unsigned)b) << 16); }
__device__ __forceinline__ unsigned pk2(float lo, float hi) {
    typedef float f2 __attribute__((ext_vector_type(2))); typedef __bf16 b2 __attribute__((ext_vector_type(2)));
    f2 v = {lo, hi}; b2 b = __builtin_convertvector(v, b2); return __builtin_bit_cast(unsigned, b);
}
__device__ __forceinline__ unsigned short f2bf(float f) { return (unsigned short)(pk2(f, 0.f) & 0xffffu); }
__device__ __forceinline__ float wave_sum(float v) {
#pragma unroll
    for (int o = 1; o < 64; o <<= 1) v += __shfl_xor(v, o);
    return v;
}
__device__ __forceinline__ float sigmoidf_(float x) { return __builtin_amdgcn_rcpf(1.0f + __builtin_amdgcn_exp2f(-1.4426950408889634f * x)); }
__device__ __forceinline__ float gelu_tanh(float x) {
    const float u = 0.7978845608028654f * (x + 0.044715f * x * x * x);
    return x * sigmoidf_(2.0f * u);
}
__device__ __forceinline__ unsigned pk4_fp8(float a, float b, float c, float d) {
    int w = 0; w = __builtin_amdgcn_cvt_pk_fp8_f32(a, b, w, false); w = __builtin_amdgcn_cvt_pk_fp8_f32(c, d, w, true); return (unsigned)w;
}
__device__ __forceinline__ int crow(int r, int hi) { return (r & 3) + 8 * (r >> 2) + 4 * hi; }

#define LAS __attribute__((address_space(3)))
#define XB_TMO      128
#define XB_XCNT(j)  (256  + 64 * (j))
#define XB_XSUB(j)  (1280 + 64 * (j))
#define XB_XGEN(j)  (2304 + 64 * (j))
#define XB_TOP      3328
#define XB_TOPGEN   3392
#define XCD_BAR_WORDS 3456
#define XB_SPIN_CAP (1u << 20)
__device__ __forceinline__ unsigned xb_ld(unsigned* p)              { return __hip_atomic_load(p, __ATOMIC_RELAXED, __HIP_MEMORY_SCOPE_AGENT); }
__device__ __forceinline__ unsigned xb_add(unsigned* p, unsigned v) { return __hip_atomic_fetch_add(p, v, __ATOMIC_RELAXED, __HIP_MEMORY_SCOPE_AGENT); }
__device__ __forceinline__ unsigned xb_xcc_id() { return (unsigned)__builtin_amdgcn_s_getreg((3 << 11) | 20) & 0xFu; }
#define XB_SPIN(cond, bar) do { unsigned _sp = 0; while (cond) { __builtin_amdgcn_s_sleep(1); \
    if ((++_sp & 255u) == 0u) { if (xb_ld(&(bar)[XB_TMO])) break; if (_sp > XB_SPIN_CAP) { atomicAdd(&(bar)[XB_TMO], 1u); break; } } } } while (0)
struct XcdBarrier { unsigned* bar; unsigned x; volatile LAS unsigned* st; int wbase; };
__device__ __forceinline__ int lane_id() { int l; asm volatile("v_mbcnt_lo_u32_b32 %0, -1, 0\n\tv_mbcnt_hi_u32_b32 %0, -1, %0" : "=v"(l)); return l; }
__device__ __forceinline__ XcdBarrier xcd_barrier_post(unsigned* bar, volatile LAS unsigned* st) {
    XcdBarrier b; b.bar = bar; b.x = xb_xcc_id(); b.st = st; b.wbase = __builtin_amdgcn_readfirstlane((int)threadIdx.x & ~63);
    if (threadIdx.x == 0) (void)xb_add(&bar[XB_XCNT(b.x)], 1u);
    return b;
}
__device__ __forceinline__ void xcd_barrier_complete(unsigned* bar, unsigned x, unsigned& nloc, unsigned& nx) {
    const unsigned G = gridDim.x * gridDim.y * gridDim.z;
    unsigned sum, cnt, mine, sp = 0u;
    for (;;) {
        sum = 0u; cnt = 0u; mine = 0u;
#pragma unroll
        for (unsigned j = 0; j < 16; ++j) { const unsigned c = xb_ld(&bar[XB_XCNT(j)]); sum += c; cnt += (c > 0u) ? 1u : 0u; mine = (j == x) ? c : mine; }
        if (sum == G) break;
        __builtin_amdgcn_s_sleep(1);
        if ((++sp & 255u) == 0u) { if (xb_ld(&bar[XB_TMO])) break; if (sp > XB_SPIN_CAP) { atomicAdd(&bar[XB_TMO], 1u); break; } }
    }
    nloc = mine > 0u ? mine : 1u; nx = cnt > 0u ? cnt : 1u;
}
__device__ __forceinline__ void xcd_barrier(const XcdBarrier& b) {
    asm volatile("s_waitcnt vmcnt(0)" ::: "memory");
    __syncthreads();
    if (b.wbase == 0 && lane_id() == 0) {
        unsigned* bar = b.bar;
        __builtin_amdgcn_s_waitcnt(0);
        unsigned nloc = b.st[0], nx = b.st[1];
        if (nloc == 0u) { xcd_barrier_complete(bar, b.x, nloc, nx); b.st[0] = nloc; b.st[1] = nx; }
        const unsigned old = xb_add(&bar[XB_XSUB(b.x)], 1u);
        const unsigned gen = old / nloc;
        if (old + 1u == (gen + 1u) * nloc) {
            __builtin_amdgcn_fence(__ATOMIC_RELEASE, "agent");
            asm volatile("s_waitcnt vmcnt(0)" ::: "memory");
            const unsigned og = xb_add(&bar[XB_TOP], 1u);
            const unsigned tg = og / nx;
            if (og + 1u == (tg + 1u) * nx) xb_add(&bar[XB_TOPGEN], 1u);
            else XB_SPIN(xb_ld(&bar[XB_TOPGEN]) == tg, bar);
            __builtin_amdgcn_fence(__ATOMIC_ACQUIRE, "agent");
            xb_add(&bar[XB_XGEN(b.x)], 1u);
            asm volatile("s_waitcnt vmcnt(0)" ::: "memory");
        } else {
            XB_SPIN(xb_ld(&bar[XB_XGEN(b.x)]) == gen, bar);
            __builtin_amdgcn_fence(__ATOMIC_ACQUIRE, "agent");
            asm volatile("s_waitcnt vmcnt(0)" ::: "memory");
        }
    }
    __syncthreads();
}

constexpr int SG_LDS = 2 * 128 * 144;
template <class Epi>
__device__ __forceinline__ void sg_tile(int tid, unsigned char* lds, const bf16_t* A, int lda, const bf16_t* Bt, int ldb, int K, Epi epi) {
    const int lane = tid & 63, wid = tid >> 6, wr = wid >> 2, wc = wid & 3, fr = lane & 15, fq = lane >> 4;
    unsigned char* As = lds; unsigned char* Bs = lds + 128 * 144;
    f32x4 acc[4][2];
#pragma unroll
    for (int m = 0; m < 4; ++m)
#pragma unroll
        for (int n = 0; n < 2; ++n) acc[m][n] = (f32x4){0.f, 0.f, 0.f, 0.f};
    const int nt = K / 64;
    u32x4 ra[2], rb[2];
    const int r0 = tid >> 3, cc = tid & 7;
#pragma unroll
    for (int i = 0; i < 2; ++i) {
        ra[i] = *(const u32x4*)(A + (size_t)(r0 + 64 * i) * lda + cc * 8);
        rb[i] = *(const u32x4*)(Bt + (size_t)(r0 + 64 * i) * ldb + cc * 8);
    }
    for (int kt = 0; kt < nt; ++kt) {
        __syncthreads();
#pragma unroll
        for (int i = 0; i < 2; ++i) {
            *(u32x4*)(As + (r0 + 64 * i) * 144 + cc * 16) = ra[i];
            *(u32x4*)(Bs + (r0 + 64 * i) * 144 + cc * 16) = rb[i];
        }
        __syncthreads();
        if (kt + 1 < nt) {
#pragma unroll
            for (int i = 0; i < 2; ++i) {
                ra[i] = *(const u32x4*)(A + (size_t)(r0 + 64 * i) * lda + (kt + 1) * 64 + cc * 8);
                rb[i] = *(const u32x4*)(Bt + (size_t)(r0 + 64 * i) * ldb + (kt + 1) * 64 + cc * 8);
            }
        }
#pragma unroll
        for (int kk = 0; kk < 2; ++kk) {
            bf16x8 a[4], b[2];
#pragma unroll
            for (int m = 0; m < 4; ++m) a[m] = *(const bf16x8*)(As + (wr * 64 + m * 16 + fr) * 144 + kk * 64 + fq * 16);
#pragma unroll
            for (int n = 0; n < 2; ++n) b[n] = *(const bf16x8*)(Bs + (wc * 32 + n * 16 + fr) * 144 + kk * 64 + fq * 16);
#pragma unroll
            for (int m = 0; m < 4; ++m)
#pragma unroll
                for (int n = 0; n < 2; ++n) acc[m][n] = __builtin_amdgcn_mfma_f32_16x16x32_bf16(b[n], a[m], acc[m][n], 0, 0, 0);
        }
    }
#pragma unroll
    for (int m = 0; m < 4; ++m) epi(wr * 64 + m * 16 + fr, wc * 32 + fq * 4, acc[m][0], acc[m][1]);
}


namespace pg8 {
#define PG8_LAS __attribute__((address_space(3)))
constexpr int BM = 256, BK = 64, HALF = 128, HTB = HALF * BK * 2, STAGE_BYTES = 8 * HTB;
__device__ __forceinline__ int lds_byte(int r, int c) { const int st = (r >> 4) * 2 + (c >> 5), rr = r & 15, cc = c & 31, ob = rr * 64 + cc * 2; return st * 1024 + (ob ^ (((ob >> 9) & 1) << 5)); }
__device__ __forceinline__ void stage_rc(int b, int& R, int& C) { const int st = b / 1024, sb = b % 1024, swz = sb ^ (((sb >> 9) & 1) << 5); R = (st >> 1) * 16 + swz / 64; C = (st & 1) * 32 + (swz % 64) / 2; }
typedef int v8i_t __attribute__((ext_vector_type(8)));
typedef int v4i_t __attribute__((ext_vector_type(4)));
struct FragT { union { v8i_t v; struct { v4i_t lo, hi; }; }; };
struct Unit { int pm, pb, pn, aux; };
struct Gemm { const bf16_t* A; const bf16_t* Bt; int lda, ldb, K; };
struct NoCtx {};
struct NoPre { __device__ __forceinline__ NoCtx operator()(const Unit&, int, int, int, int, const PG8_LAS unsigned char*) const { return NoCtx{}; } };
struct NoStage { __device__ __forceinline__ void operator()(const Unit&, PG8_LAS unsigned char*, int, int) const {} };
template <class PF, class F> struct Epi {
    PF pre; F f;
    template <class Ctx>
    __device__ __forceinline__ void operator()(const f32x4 (&acc)[2][2][4][2], const Ctx& ctx, const Unit& u, int wr, int wc, int fr, int fq, PG8_LAS unsigned char*, int) const {
#pragma unroll
        for (int ai = 0; ai < 2; ++ai)
#pragma unroll
            for (int m = 0; m < 4; ++m)
#pragma unroll
                for (int bj = 0; bj < 2; ++bj) {
                    f32x4 v0, v1;
                    asm volatile("v_accvgpr_read_b32 %0, %8\n\tv_accvgpr_read_b32 %1, %9\n\tv_accvgpr_read_b32 %2, %10\n\tv_accvgpr_read_b32 %3, %11\n\t"
                                 "v_accvgpr_read_b32 %4, %12\n\tv_accvgpr_read_b32 %5, %13\n\tv_accvgpr_read_b32 %6, %14\n\tv_accvgpr_read_b32 %7, %15"
                                 : "=v"(v0.x), "=v"(v0.y), "=v"(v0.z), "=v"(v0.w), "=v"(v1.x), "=v"(v1.y), "=v"(v1.z), "=v"(v1.w)
                                 : "a"(acc[ai][bj][m][0].x), "a"(acc[ai][bj][m][0].y), "a"(acc[ai][bj][m][0].z), "a"(acc[ai][bj][m][0].w),
                                   "a"(acc[ai][bj][m][1].x), "a"(acc[ai][bj][m][1].y), "a"(acc[ai][bj][m][1].z), "a"(acc[ai][bj][m][1].w));
                    f(u, ctx, ai, m, bj, ai * HALF + wr * 64 + m * 16 + fr, bj * HALF + wc * 32 + 4 * fq, v0, v1);
                }
    }
};
template <class PF, class F> __device__ __forceinline__ Epi<PF, F> make_epi(PF p, F f) { return Epi<PF, F>{p, f}; }
template <class PF, class F> struct EpiPerm {
    PF pre; F f;
    template <class Ctx>
    __device__ __forceinline__ void operator()(const f32x4 (&acc)[2][2][4][2], const Ctx& ctx, const Unit& u, int wr, int wc, int fr, int fq, PG8_LAS unsigned char*, int) const {
#pragma unroll
        for (int ai = 0; ai < 2; ++ai)
#pragma unroll
            for (int m = 0; m < 4; ++m)
#pragma unroll
                for (int bj = 0; bj < 2; ++bj) {
                    f32x4 v0, v1;
                    asm volatile("v_accvgpr_read_b32 %0, %8\n\tv_accvgpr_read_b32 %1, %9\n\tv_accvgpr_read_b32 %2, %10\n\tv_accvgpr_read_b32 %3, %11\n\t"
                                 "v_accvgpr_read_b32 %4, %12\n\tv_accvgpr_read_b32 %5, %13\n\tv_accvgpr_read_b32 %6, %14\n\tv_accvgpr_read_b32 %7, %15"
                                 : "=v"(v0.x), "=v"(v0.y), "=v"(v0.z), "=v"(v0.w), "=v"(v1.x), "=v"(v1.y), "=v"(v1.z), "=v"(v1.w)
                                 : "a"(acc[ai][bj][m][0].x), "a"(acc[ai][bj][m][0].y), "a"(acc[ai][bj][m][0].z), "a"(acc[ai][bj][m][0].w),
                                   "a"(acc[ai][bj][m][1].x), "a"(acc[ai][bj][m][1].y), "a"(acc[ai][bj][m][1].z), "a"(acc[ai][bj][m][1].w));
                    f(u, ctx, ai, m, bj, ai * HALF + wr * 64 + m * 16 + fr, bj * HALF + wc * 32 + 8 * fq, v0, v1);
                }
    }
};
template <class PF, class F> __device__ __forceinline__ EpiPerm<PF, F> make_epi_perm(PF p, F f) { return EpiPerm<PF, F>{p, f}; }
template <bool PERMC, class PF, class F, class RE> struct EpiRow {
    PF pre; F f; RE re;
    template <class Ctx>
    __device__ __forceinline__ void operator()(const f32x4 (&acc)[2][2][4][2], const Ctx& ctx, const Unit& u, int wr, int wc, int fr, int fq, PG8_LAS unsigned char*, int) const {
#pragma unroll
        for (int ai = 0; ai < 2; ++ai)
#pragma unroll
            for (int m = 0; m < 4; ++m) {
                float part = 0.f;
#pragma unroll
                for (int bj = 0; bj < 2; ++bj) {
                    f32x4 v0, v1;
                    asm volatile("v_accvgpr_read_b32 %0, %8\n\tv_accvgpr_read_b32 %1, %9\n\tv_accvgpr_read_b32 %2, %10\n\tv_accvgpr_read_b32 %3, %11\n\t"
                                 "v_accvgpr_read_b32 %4, %12\n\tv_accvgpr_read_b32 %5, %13\n\tv_accvgpr_read_b32 %6, %14\n\tv_accvgpr_read_b32 %7, %15"
                                 : "=v"(v0.x), "=v"(v0.y), "=v"(v0.z), "=v"(v0.w), "=v"(v1.x), "=v"(v1.y), "=v"(v1.z), "=v"(v1.w)
                                 : "a"(acc[ai][bj][m][0].x), "a"(acc[ai][bj][m][0].y), "a"(acc[ai][bj][m][0].z), "a"(acc[ai][bj][m][0].w),
                                   "a"(acc[ai][bj][m][1].x), "a"(acc[ai][bj][m][1].y), "a"(acc[ai][bj][m][1].z), "a"(acc[ai][bj][m][1].w));
                    part += f(u, ctx, ai, m, bj, ai * HALF + wr * 64 + m * 16 + fr, bj * HALF + wc * 32 + (PERMC ? 8 : 4) * fq, v0, v1);
                }
                re(u, ai, m, ai * HALF + wr * 64 + m * 16 + fr, wc, fq, part);
            }
    }
};
template <bool PERMC, class PF, class F, class RE> __device__ __forceinline__ EpiRow<PERMC, PF, F, RE> make_epi_row(PF p, F f, RE r) { return EpiRow<PERMC, PF, F, RE>{p, f, r}; }
template <class PF, class GP, class F> struct EpiG {
    PF pre; GP gp; F f;
    template <class Ctx>
    __device__ __forceinline__ void operator()(const f32x4 (&acc)[2][2][4][2], const Ctx& ctx, const Unit& u, int wr, int wc, int fr, int fq, PG8_LAS unsigned char*, int) const {
        auto gcur = gp(u, ctx, wr * 64 + fr, wc, fq);
#pragma unroll
        for (int ai = 0; ai < 2; ++ai)
#pragma unroll
            for (int m = 0; m < 4; ++m) {
                const int gn = ai * 4 + m + 1;
                auto gnxt = gcur;
                if (gn < 8) gnxt = gp(u, ctx, (gn >> 2) * HALF + wr * 64 + (gn & 3) * 16 + fr, wc, fq);
#pragma unroll
                for (int bj = 0; bj < 2; ++bj) {
                    f32x4 v0, v1;
                    asm volatile("v_accvgpr_read_b32 %0, %8\n\tv_accvgpr_read_b32 %1, %9\n\tv_accvgpr_read_b32 %2, %10\n\tv_accvgpr_read_b32 %3, %11\n\t"
                                 "v_accvgpr_read_b32 %4, %12\n\tv_accvgpr_read_b32 %5, %13\n\tv_accvgpr_read_b32 %6, %14\n\tv_accvgpr_read_b32 %7, %15"
                                 : "=v"(v0.x), "=v"(v0.y), "=v"(v0.z), "=v"(v0.w), "=v"(v1.x), "=v"(v1.y), "=v"(v1.z), "=v"(v1.w)
                                 : "a"(acc[ai][bj][m][0].x), "a"(acc[ai][bj][m][0].y), "a"(acc[ai][bj][m][0].z), "a"(acc[ai][bj][m][0].w),
                                   "a"(acc[ai][bj][m][1].x), "a"(acc[ai][bj][m][1].y), "a"(acc[ai][bj][m][1].z), "a"(acc[ai][bj][m][1].w));
                    f(u, ctx, gcur, ai, m, bj, ai * HALF + wr * 64 + m * 16 + fr, bj * HALF + wc * 32 + 4 * fq, v0, v1);
                }
                gcur = gnxt;
            }
    }
};
template <class PF, class GP, class F> __device__ __forceinline__ EpiG<PF, GP, F> make_epi_g(PF p, GP g, F f) { return EpiG<PF, GP, F>{p, g, f}; }
template <int MG, int TILE_BYTES, class PF, class F, class FL> struct EpiStaged {
    PF pre; F f; FL flush;
    template <class Ctx>
    __device__ __forceinline__ void operator()(const f32x4 (&acc)[2][2][4][2], const Ctx& ctx, const Unit& u, int wr, int wc, int fr, int fq, PG8_LAS unsigned char* tile, int tid) const {
#pragma unroll
        for (int ai = 0; ai < 2; ++ai)
#pragma unroll
            for (int m = 0; m < 4; ++m) {
#pragma unroll
                for (int bj = 0; bj < 2; ++bj) {
                    f32x4 v0, v1;
                    asm volatile("v_accvgpr_read_b32 %0, %8\n\tv_accvgpr_read_b32 %1, %9\n\tv_accvgpr_read_b32 %2, %10\n\tv_accvgpr_read_b32 %3, %11\n\t"
                                 "v_accvgpr_read_b32 %4, %12\n\tv_accvgpr_read_b32 %5, %13\n\tv_accvgpr_read_b32 %6, %14\n\tv_accvgpr_read_b32 %7, %15"
                                 : "=v"(v0.x), "=v"(v0.y), "=v"(v0.z), "=v"(v0.w), "=v"(v1.x), "=v"(v1.y), "=v"(v1.z), "=v"(v1.w)
                                 : "a"(acc[ai][bj][m][0].x), "a"(acc[ai][bj][m][0].y), "a"(acc[ai][bj][m][0].z), "a"(acc[ai][bj][m][0].w),
                                   "a"(acc[ai][bj][m][1].x), "a"(acc[ai][bj][m][1].y), "a"(acc[ai][bj][m][1].z), "a"(acc[ai][bj][m][1].w));
                    f(u, ctx, ai, m, bj, (m % MG) * 32 + wr * 16 + fr, bj * HALF + wc * 32 + 4 * fq, v0, v1, tile + (((ai * 4 + m) / MG) & 1) * TILE_BYTES);
                }
                if ((m % MG) == MG - 1) {
                    asm volatile("s_waitcnt lgkmcnt(0)" ::: "memory"); __builtin_amdgcn_s_barrier(); asm volatile("" ::: "memory");
                    flush(u, ctx, ai, m - (MG - 1), tid, tile + (((ai * 4 + m) / MG) & 1) * TILE_BYTES);
                }
            }
    }
};
template <int MG, int TILE_BYTES, class PF, class F, class FL> __device__ __forceinline__ EpiStaged<MG, TILE_BYTES, PF, F, FL> make_epi_staged(PF p, F f, FL fl) { return EpiStaged<MG, TILE_BYTES, PF, F, FL>{p, f, fl}; }
__host__ __device__ __forceinline__ int perm32(int rho) { const int n = rho >> 4, i = rho & 15; return 8 * (i >> 2) + 4 * n + (i & 3); }
template <bool FP8 = false, bool GATHER = false, bool PERM = false, class EpiT, class Sched, class StageT = NoStage>
__device__ __forceinline__ void gemm_phase(int tid, PG8_LAS unsigned char* lds, const Gemm g, const Sched& S, const EpiT& E, const StageT& SC = NoStage{}, int ctx_off = 0) {
    const int wid = __builtin_amdgcn_readfirstlane(tid >> 6), lane = tid & 63, wr = wid >> 2, wc = wid & 3, fr = lane & 15, fq = lane >> 4;
    int K = g.K; asm volatile("" : "+s"(K));
    const int nt = K / BK;
    unsigned voffA[2], voffB[2];
    int Rl[2], Cl[2];
#pragma unroll
    for (int i = 0; i < 2; ++i) { int R, C; stage_rc(tid * 16 + i * 8192, R, C); Rl[i] = R; Cl[i] = C; voffA[i] = (unsigned)(R * g.lda + C) * 2u; const int Rb = PERM ? ((R & ~31) + perm32(R & 31)) : R; voffB[i] = (unsigned)(Rb * g.ldb + C) * 2u; }
    unsigned gA00 = 0, gA01 = 0, gA10 = 0, gA11 = 0, gN00 = 0, gN01 = 0, gN10 = 0, gN11 = 0;
    const size_t kstep = (size_t)(BK * 2);
    const size_t hstepA = (size_t)HALF * g.lda * 2, hstepB = (size_t)HALF * g.ldb * 2;
    const size_t tstepA = 2 * hstepA, tstepB = 2 * hstepB;
    const unsigned ldsw = (unsigned)wid * 1024u;
    const int aoff = lds_byte(wr * 64 + fr, fq * 8), boff = lds_byte(wc * 32 + fr, fq * 8);
#define PG8_SA(b, h) (((b) * 2 + (h)) * HTB)
#define PG8_SB(b, h) ((4 + (b) * 2 + (h)) * HTB)
#define PG8_STAGE(bufoff, gbase, voff) do { _Pragma("unroll") for (int _i = 0; _i < 2; ++_i) \
        __builtin_amdgcn_global_load_lds((const unsigned*)((const char*)(gbase) + (voff)[_i]), (PG8_LAS unsigned*)(lds + (bufoff) + ldsw + _i * 8192), 16, 0, 0); } while (0)
#define PG8_LDA(dst, b, h) do { _Pragma("unroll") for (int m = 0; m < 4; ++m) { dst[m].lo = *(const PG8_LAS v4i_t*)(lds + PG8_SA(b, h) + aoff + m * 2048); dst[m].hi = *(const PG8_LAS v4i_t*)(lds + PG8_SA(b, h) + aoff + m * 2048 + 1024); } } while (0)
#define PG8_LDB(dst, b, h) do { _Pragma("unroll") for (int n = 0; n < 2; ++n) { dst[n].lo = *(const PG8_LAS v4i_t*)(lds + PG8_SB(b, h) + boff + n * 2048); dst[n].hi = *(const PG8_LAS v4i_t*)(lds + PG8_SB(b, h) + boff + n * 2048 + 1024); } } while (0)
#define PG8_MMA(ai, bj, At, Bt) do { __builtin_amdgcn_s_setprio(1); asm volatile("s_nop 1" ::: "memory");     \
        _Pragma("unroll") for (int m = 0; m < 4; ++m) _Pragma("unroll") for (int n = 0; n < 2; ++n) { \
        if constexpr (FP8) { asm volatile("v_mfma_scale_f32_16x16x128_f8f6f4 %0, %1, %2, %0, %3, %4 op_sel_hi:[0,0,0]" : "+a"(acc[ai][bj][m][n]) : "v"(Bt[n].v), "v"(At[m].v), "v"(scw), "v"(scx)); } \
        else { asm volatile("v_mfma_f32_16x16x32_bf16 %0, %1, %2, %0\n\tv_mfma_f32_16x16x32_bf16 %0, %3, %4, %0" : "+a"(acc[ai][bj][m][n]) : "v"(Bt[n].lo), "v"(At[m].lo), "v"(Bt[n].hi), "v"(At[m].hi)); } } \
        __builtin_amdgcn_s_setprio(0); } while (0)
#define PG8_WAIT_V(n) asm volatile("s_waitcnt vmcnt(" #n ")" ::: "memory")
#define PG8_WAIT_L(n) asm volatile("s_waitcnt lgkmcnt(" #n ")" ::: "memory")
#define PG8_BAR __builtin_amdgcn_s_barrier()
#define PG8_SCHED __builtin_amdgcn_sched_barrier(0)
    Unit cur, nxt; int ui = 0;
    if (!S.next(0, cur)) return;
    f32x4 acc[2][2][4][2];
#pragma unroll
    for (int a = 0; a < 2; ++a)
#pragma unroll
        for (int b = 0; b < 2; ++b)
#pragma unroll
            for (int m = 0; m < 4; ++m)
#pragma unroll
                for (int n = 0; n < 2; ++n) acc[a][b][m][n] = (f32x4){0.f, 0.f, 0.f, 0.f};
    FragT At[4], B0[2], B1[2];
    int scw = (FP8 && PROBE_KX2) ? 0x79797979 : 0x7a7a7a7a, scx = 0x7f7f7f7f; asm volatile("" : "+v"(scw), "+v"(scx));
    const char* cA = GATHER ? (const char*)g.A : (const char*)g.A + (size_t)cur.pm * tstepA; const char* cB = (const char*)g.Bt + (size_t)cur.pb * tstepB;
    SC(cur, lds + STAGE_BYTES + ctx_off, wid, lane);
    const int R0 = Rl[0], R1 = Rl[1]; const unsigned C0 = (unsigned)Cl[0] * 2u, C1 = (unsigned)Cl[1] * 2u;
    if constexpr (GATHER) { gA00 = S.a_off(cur, R0) + C0; gA01 = S.a_off(cur, R1) + C1; gA10 = S.a_off(cur, HALF + R0) + C0; gA11 = S.a_off(cur, HALF + R1) + C1; }
#define PG8_STAGE_A(bufoff, koff, O0, O1, dense_ptr) do { if constexpr (GATHER) { \
        __builtin_amdgcn_global_load_lds((const unsigned*)((const char*)g.A + (koff) + (O0)), (PG8_LAS unsigned*)(lds + (bufoff) + ldsw), 16, 0, 0); \
        __builtin_amdgcn_global_load_lds((const unsigned*)((const char*)g.A + (koff) + (O1)), (PG8_LAS unsigned*)(lds + (bufoff) + ldsw + 8192), 16, 0, 0); \
    } else { PG8_STAGE(bufoff, dense_ptr, voffA); } } while (0)
    PG8_STAGE(PG8_SB(0, 0), cB, voffB); PG8_STAGE(PG8_SB(0, 1), cB + hstepB, voffB); PG8_STAGE_A(PG8_SA(0, 0), 0, gA00, gA01, cA); PG8_STAGE_A(PG8_SA(0, 1), 0, gA10, gA11, cA + hstepA);
    if (wr == 1) PG8_BAR;
    PG8_WAIT_V(2); PG8_BAR;
    PG8_STAGE(PG8_SB(1, 0), cB + kstep, voffB); PG8_STAGE_A(PG8_SA(1, 0), kstep, gA00, gA01, cA + kstep); PG8_STAGE(PG8_SB(1, 1), cB + hstepB + kstep, voffB);
    PG8_WAIT_V(6); PG8_BAR;
    for (;;) {
        const bool has_next = S.next(ui + 1, nxt);
        const char* nA = GATHER ? cA : (has_next ? (const char*)g.A + (size_t)nxt.pm * tstepA : cA); const char* nB = has_next ? (const char*)g.Bt + (size_t)nxt.pb * tstepB : cB;
        if (has_next) SC(nxt, lds + STAGE_BYTES + ctx_off + ((ui + 1) % 3) * 4096, wid, lane);
        if constexpr (GATHER) {
            if (has_next) { gN00 = S.a_off(nxt, R0) + C0; gN01 = S.a_off(nxt, R1) + C1; gN10 = S.a_off(nxt, HALF + R0) + C0; gN11 = S.a_off(nxt, HALF + R1) + C1; }
            else { gN00 = gA00; gN01 = gA01; gN10 = gA10; gN11 = gA11; }
        }
        constexpr int KX = (FP8 && PROBE_KX2) ? 2 : 1;
        for (int t = 0; t < KX * nt; t += 2) {
            const bool last = (t == KX * nt - 2);
            const char* a1 = cA + (size_t)((t + 1) % nt) * kstep;
            const char* a2 = last ? nA : cA + (size_t)((t + 2) % nt) * kstep; const char* b2 = last ? nB : cB + (size_t)((t + 2) % nt) * kstep;
            const char* a3 = a2 + kstep; const char* b3 = b2 + kstep;
            const size_t k1 = (size_t)((t + 1) % nt) * kstep, k2 = last ? 0 : (size_t)((t + 2) % nt) * kstep;
            const unsigned gT00 = last ? gN00 : gA00, gT01 = last ? gN01 : gA01, gT10 = last ? gN10 : gA10, gT11 = last ? gN11 : gA11;
            PG8_LDB(B0, 0, 0); PG8_LDB(B1, 0, 1); PG8_SCHED; PG8_LDA(At, 0, 0); PG8_STAGE_A(PG8_SA(1, 1), k1, gA10, gA11, a1 + hstepA);
            PG8_WAIT_V(8); PG8_WAIT_L(0); PG8_BAR; PG8_MMA(0, 0, At, B0); PG8_MMA(0, 1, At, B1); PG8_BAR; PG8_SCHED;
            PG8_LDA(At, 0, 1); PG8_STAGE(PG8_SB(0, 0), b2, voffB); PG8_STAGE(PG8_SB(0, 1), b2 + hstepB, voffB); PG8_STAGE_A(PG8_SA(0, 0), k2, gT00, gT01, a2);
            PG8_WAIT_V(8); PG8_WAIT_L(0); PG8_BAR; PG8_MMA(1, 0, At, B0); PG8_MMA(1, 1, At, B1); PG8_BAR; PG8_SCHED;
            PG8_LDB(B0, 1, 0); PG8_LDB(B1, 1, 1); PG8_SCHED; PG8_LDA(At, 1, 0); PG8_STAGE_A(PG8_SA(0, 1), k2, gT10, gT11, a2 + hstepA);
            PG8_WAIT_V(8); PG8_WAIT_L(0); PG8_BAR; PG8_MMA(0, 0, At, B0); PG8_MMA(0, 1, At, B1); PG8_BAR; PG8_SCHED;
            PG8_LDA(At, 1, 1); PG8_STAGE(PG8_SB(1, 0), b3, voffB); PG8_STAGE(PG8_SB(1, 1), b3 + hstepB, voffB); PG8_STAGE_A(PG8_SA(1, 0), k2 + kstep, gT00, gT01, a3);
            PG8_WAIT_V(8); PG8_WAIT_L(0); PG8_BAR; PG8_MMA(1, 0, At, B0); PG8_MMA(1, 1, At, B1); PG8_BAR; PG8_SCHED;
        }
        unsigned long long tp0_ = 0; if constexpr (PROBE_SEG != 0 && PROBE_SEG == (FP8 ? (GATHER ? 2 : 1) : 3)) tp0_ = __builtin_amdgcn_s_memrealtime();
        const auto ectx = E.pre(cur, wr, wc, fr, fq, lds + STAGE_BYTES + ctx_off + (ui % 3) * 4096);
        if (wr == 0) PG8_BAR;
        asm volatile("s_nop 15\n\ts_nop 15" ::: "memory");
        E(acc, ectx, cur, wr, wc, fr, fq, lds + STAGE_BYTES, tid);
        if constexpr (FP8 && PROBE_EPI2) { asm volatile("" ::: "memory"); E(acc, ectx, cur, wr, wc, fr, fq, lds + STAGE_BYTES, tid); }
        if constexpr (PROBE_SEG != 0 && PROBE_SEG == (FP8 ? (GATHER ? 2 : 1) : 3)) { if (tid == 0) { PG8_LAS unsigned* acc_t = (PG8_LAS unsigned*)(lds + LDS_MISC + 48); *acc_t += (unsigned)(__builtin_amdgcn_s_memrealtime() - tp0_); } }
        if (!has_next) break;
#pragma unroll
        for (int a = 0; a < 2; ++a)
#pragma unroll
            for (int b = 0; b < 2; ++b)
#pragma unroll
                for (int m = 0; m < 4; ++m)
#pragma unroll
                    for (int n = 0; n < 2; ++n) acc[a][b][m][n] = (f32x4){0.f, 0.f, 0.f, 0.f};
        cur = nxt; cA = nA; cB = nB; ++ui;
        if constexpr (GATHER) { gA00 = gN00; gA01 = gN01; gA10 = gN10; gA11 = gN11; }
        if (wr == 1) PG8_BAR;
    }
    PG8_WAIT_V(0);
    PG8_BAR;
#undef PG8_SA
#undef PG8_SB
#undef PG8_STAGE
#undef PG8_STAGE_A
#undef PG8_LDA
#undef PG8_LDB
#undef PG8_MMA
#undef PG8_WAIT_V
#undef PG8_WAIT_L
#undef PG8_BAR
#undef PG8_SCHED
}
struct GridOrder {
    int nM, nN, nwg, G, c;
    __device__ __forceinline__ void init(int nM_, int nN_, int G_, int c_) { nM = nM_; nN = nN_; nwg = nM * nN; G = G_; c = c_; }
    __device__ __forceinline__ bool tile(int i, int& pm, int& pn) const {
        const long L = (long)i * G + c; if (L >= nwg) return false;
        int wgid = (int)L; { const int q = nwg / 8, r = nwg % 8, xcd = wgid % 8, off = wgid / 8; wgid = (xcd < r ? xcd * (q + 1) : r * (q + 1) + (xcd - r) * q) + off; }
        const int nig = 8 * nN, gid = wgid / nig, fm = gid * 8, gsz = (nM - fm) < 8 ? (nM - fm) : 8;
        pm = fm + ((wgid % nig) % gsz); pn = (wgid % nig) / gsz; return true;
    }
};
}


struct DenseOrder { pg8::GridOrder go;
    __device__ __forceinline__ bool next(int i, pg8::Unit& u) const { int pm, pn; if (!go.tile(i, pm, pn)) return false; u.pm = pm; u.pb = pn; u.pn = pn; u.aux = 0; return true; } };
struct MoeOrder { pg8::GridOrder go; const int* pst; const int* el_slot; int NT, ebase;
    __device__ __forceinline__ unsigned a_off(const pg8::Unit& u, int R) const { const int ro = u.pm * 256 - pst[u.aux] + R; const int tok = (ro < pst[64 + u.aux]) ? (el_slot[(size_t)u.aux * T + ro] >> 2) : 0; return (unsigned)tok * 1024u; }
    __device__ __forceinline__ bool next(int i, pg8::Unit& u) const { int pm, pn; if (!go.tile(i, pm, pn)) return false; int e = 0;
#pragma unroll
        for (int q = 1; q < 32; ++q) e = (pm * 256 >= pst[q]) ? q : e;
        e = __builtin_amdgcn_readfirstlane(e);
        u.pm = pm; u.pn = pn; u.pb = (ebase + e) * NT + pn; u.aux = e; return true; } };
struct S5Order { int G, c;
    __device__ __forceinline__ bool next(int i, pg8::Unit& u) const { const int L = i * G + c; if (L >= 256) return false; const int g = L >> 3, pmL = (L >> 2) & 1, pnL = L & 3;
        u.pm = g * 2 + pmL; u.pb = g * 4 + pnL; u.pn = pnL; u.aux = g; return true; } };

__device__ __forceinline__ void transpose_item(const float* W, int K, int N, bf16_t* WT, int ldt, float* scr, int item, int lane, int mode, const float* kscale = nullptr) {
    const int nblk = N / 32, kb = item / nblk, nb = item % nblk, k0 = 64 * kb, n0 = 32 * nb;
#pragma unroll 8
    for (int i = 0; i < 32; ++i) { const int kk = 2 * i + (lane >> 5); scr[kk * 33 + (lane & 31)] = W[(size_t)(k0 + kk) * N + n0 + (lane & 31)] * (kscale ? kscale[k0 + kk] : 1.0f); }
    __builtin_amdgcn_s_waitcnt(0xC07F); asm volatile("" ::: "memory");
    const int c = lane & 7;
#pragma unroll
    for (int j = 0; j < 4; ++j) {
        const int n = (lane >> 3) + 8 * j; const float* s = scr + (8 * c) * 33 + n;
        u32x4 o; o.x = pk2(s[0 * 33], s[1 * 33]); o.y = pk2(s[2 * 33], s[3 * 33]); o.z = pk2(s[4 * 33], s[5 * 33]); o.w = pk2(s[6 * 33], s[7 * 33]);
        int nn = n0 + n;
        if (mode == 1) { const int half = nn >= 1024; const int jj = nn - half * 1024; nn = 32 * (jj >> 4) + 16 * half + (jj & 15); }
        *(u32x4*)(WT + (size_t)nn * ldt + k0 + 8 * c) = o;
    }
    __builtin_amdgcn_s_waitcnt(0xC07F); asm volatile("" ::: "memory");
}
__device__ __forceinline__ void transpose_item_fp8(const float* W, int K, int N, unsigned char* WT, float* scr, int item, int lane, int mode, float scale) {
    const int nblk = N / 32, kb = item / nblk, nb = item % nblk, k0 = 128 * kb, n0 = 32 * nb;
#pragma unroll 8
    for (int i = 0; i < 64; ++i) { const int kk = 2 * i + (lane >> 5); scr[kk * 33 + (lane & 31)] = W[(size_t)(k0 + kk) * N + n0 + (lane & 31)] * scale; }
    __builtin_amdgcn_s_waitcnt(0xC07F); asm volatile("" ::: "memory");
    const int c = lane & 7;
#pragma unroll
    for (int j = 0; j < 4; ++j) {
        const int n = (lane >> 3) + 8 * j; const float* s = scr + (16 * c) * 33 + n;
        u32x4 o; o.x = pk4_fp8(s[0 * 33], s[1 * 33], s[2 * 33], s[3 * 33]); o.y = pk4_fp8(s[4 * 33], s[5 * 33], s[6 * 33], s[7 * 33]);
        o.z = pk4_fp8(s[8 * 33], s[9 * 33], s[10 * 33], s[11 * 33]); o.w = pk4_fp8(s[12 * 33], s[13 * 33], s[14 * 33], s[15 * 33]);
        int nn = n0 + n;
        if (mode == 1) { const int half = nn >= 1024; const int jj = nn - half * 1024; nn = 32 * (jj >> 4) + 16 * half + (jj & 15); }
        *(u32x4*)(WT + (size_t)nn * K + k0 + 16 * c) = o;
    }
    __builtin_amdgcn_s_waitcnt(0xC07F); asm volatile("" ::: "memory");
}
__device__ __forceinline__ void transpose_many_fp8(const float* W, int nmat, int K, int N, unsigned char* WT, size_t dst_stride, float* scr, int gw, int NGW, int lane, int mode, float scale) {
    const int per = (K / 128) * (N / 32); const long tot = (long)nmat * per;
    for (long it = gw; it < tot; it += NGW) {
        const int mt = (int)(it / per), r = (int)(it % per);
        transpose_item_fp8(W + (size_t)mt * K * N, K, N, WT + (size_t)mt * dst_stride, scr, r, lane, mode, scale);
    }
}
__device__ __forceinline__ void convert_fp8_block(const float* W, int nmat, int K, int N, unsigned char* WT, size_t dst_stride, float* tile, int vb, int G, int tid, int mode, float scale) {
    const int per = (K / 128) * (N / 256), tot = nmat * per, wave = tid >> 6, lane = tid & 63;
    f32x4 v[16];
    int it = vb;
    auto src = [&](int item, int i) { const int mt = item / per, r = item % per, nblk = N / 256, kb = r / nblk, nb = r % nblk;
        return (const f32x4*)(W + (size_t)mt * K * N + (size_t)(128 * kb + wave + 8 * i) * N + 256 * nb + lane * 4); };
    if (it < tot) {
#pragma unroll
        for (int i = 0; i < 16; ++i) v[i] = *src(it, i);
    }
    while (it < tot) {
#pragma unroll
        for (int i = 0; i < 16; ++i) { float* d = tile + (wave + 8 * i) * 257 + lane * 4; d[0] = v[i].x * scale; d[1] = v[i].y * scale; d[2] = v[i].z * scale; d[3] = v[i].w * scale; }
        __syncthreads();
        const int nx = it + G;
        if (nx < tot) {
#pragma unroll
            for (int i = 0; i < 16; ++i) v[i] = *src(nx, i);
        }
        {
            const int mt = it / per, r = it % per, nblk = N / 256, kb = r / nblk, nb = r % nblk, k0 = 128 * kb, n0 = 256 * nb;
            const int c = tid & 7;
#pragma unroll 1
            for (int ps = 0; ps < 4; ++ps) {
                const int n = ps * 64 + (tid >> 3); const float* sp = tile + (16 * c) * 257 + n;
                u32x4 o; o.x = pk4_fp8(sp[0 * 257], sp[1 * 257], sp[2 * 257], sp[3 * 257]); o.y = pk4_fp8(sp[4 * 257], sp[5 * 257], sp[6 * 257], sp[7 * 257]);
                o.z = pk4_fp8(sp[8 * 257], sp[9 * 257], sp[10 * 257], sp[11 * 257]); o.w = pk4_fp8(sp[12 * 257], sp[13 * 257], sp[14 * 257], sp[15 * 257]);
                int nn = n0 + n;
                if (mode == 1) { const int half = nn >= 1024; const int jj = nn - half * 1024; nn = 32 * (jj >> 4) + 16 * half + (jj & 15); }
                *(u32x4*)(WT + (size_t)mt * dst_stride + (size_t)nn * K + k0 + 16 * c) = o;
            }
        }
        __syncthreads();
        it = nx;
    }
}
__device__ __forceinline__ void transpose_many(const float* W, int nmat, int K, int N, bf16_t* WT, size_t dst_stride, float* scr, int gw, int NGW, int lane, int mode, int ldt = 0, const float* kscale = nullptr) {
    if (ldt == 0) ldt = K;
    const int per = (K / 64) * (N / 32); const long tot = (long)nmat * per;
    for (long it = gw; it < tot; it += NGW) {
        const int mt = (int)(it / per), r = (int)(it % per);
        transpose_item(W + (size_t)mt * K * N, K, N, WT + (size_t)mt * dst_stride, ldt, scr, r, lane, mode, kscale);
    }
}

__device__ __forceinline__ void norm_mod_store(f32x4 (&v)[4], const float* g, const float* sc, const float* sh, bf16_t* orow, unsigned char* orow8, int lane) {
    float s = 0.f;
#pragma unroll
    for (int j = 0; j < 4; ++j) s += (v[j].x * v[j].x + v[j].y * v[j].y) + (v[j].z * v[j].z + v[j].w * v[j].w);
    const float r = rsqrtf(wave_sum(s) * (1.0f / D) + 1e-6f);
#pragma unroll
    for (int j = 0; j < 4; ++j) {
        const int c = 4 * lane + 256 * j;
        const f32x4 gg = *(const f32x4*)(g + c), s1 = *(const f32x4*)(sc + c), s0 = *(const f32x4*)(sh + c);
        const float a = v[j].x * r * gg.x * (1.f + s1.x) + s0.x, b = v[j].y * r * gg.y * (1.f + s1.y) + s0.y,
                    cc = v[j].z * r * gg.z * (1.f + s1.z) + s0.z, d = v[j].w * r * gg.w * (1.f + s1.w) + s0.w;
        u32x2 o; o.x = pk2(a, b); o.y = pk2(cc, d);
        *(u32x2*)(orow + c) = o;
        if (orow8) *(unsigned*)(orow8 + c) = pk4_fp8(a, b, cc, d);
    }
}

__device__ __forceinline__ void unpack8(const u32x4 w, float (&f)[8]) {
    f[0] = __uint_as_float(w.x << 16); f[1] = __uint_as_float(w.x & 0xffff0000u); f[2] = __uint_as_float(w.y << 16); f[3] = __uint_as_float(w.y & 0xffff0000u);
    f[4] = __uint_as_float(w.z << 16); f[5] = __uint_as_float(w.z & 0xffff0000u); f[6] = __uint_as_float(w.w << 16); f[7] = __uint_as_float(w.w & 0xffff0000u);
}
__device__ __forceinline__ u32x4 pack8(const float (&f)[8]) { u32x4 o; o.x = pk2(f[0], f[1]); o.y = pk2(f[2], f[3]); o.z = pk2(f[4], f[5]); o.w = pk2(f[6], f[7]); return o; }
__device__ __forceinline__ void norm_mod_store8(float (&v)[2][8], const float* g, const float* sc, const float* sh, bf16_t* orow, unsigned char* orow8, int lane) {
    float s = 0.f;
#pragma unroll
    for (int j = 0; j < 2; ++j)
#pragma unroll
        for (int i = 0; i < 8; ++i) s += v[j][i] * v[j][i];
    const float r = rsqrtf(wave_sum(s) * (1.0f / D) + 1e-6f);
#pragma unroll
    for (int j = 0; j < 2; ++j) {
        const int c = 8 * lane + 512 * j; float o[8];
#pragma unroll
        for (int q = 0; q < 2; ++q) {
            const f32x4 gg = *(const f32x4*)(g + c + 4 * q), s1 = *(const f32x4*)(sc + c + 4 * q), s0 = *(const f32x4*)(sh + c + 4 * q);
            o[4 * q + 0] = v[j][4 * q + 0] * r * gg.x * (1.f + s1.x) + s0.x; o[4 * q + 1] = v[j][4 * q + 1] * r * gg.y * (1.f + s1.y) + s0.y;
            o[4 * q + 2] = v[j][4 * q + 2] * r * gg.z * (1.f + s1.z) + s0.z; o[4 * q + 3] = v[j][4 * q + 3] * r * gg.w * (1.f + s1.w) + s0.w;
        }
        *(u32x4*)(orow + c) = pack8(o);
        if (orow8) { u32x2 w8; w8.x = pk4_fp8(o[0], o[1], o[2], o[3]); w8.y = pk4_fp8(o[4], o[5], o[6], o[7]); *(u32x2*)(orow8 + c) = w8; }
    }
}

template <int ph> __device__ __forceinline__ void phase_body(int wbase) {
    extern __shared__ __attribute__((aligned(16))) unsigned char lds[];
    {
        int tid = wbase + lane_id(); asm volatile("" : "+v"(tid));
        int vb = blockIdx.x, G = gridDim.x; asm volatile("" : "+s"(vb), "+s"(G));
        const int lane = tid & 63, wave = tid >> 6;
        const int gw = vb * NWAVE + wave, NGW = G * NWAVE;
        const __attribute__((address_space(4))) Params* kp = (const __attribute__((address_space(4))) Params*)__builtin_amdgcn_kernarg_segment_ptr();
        asm volatile("" : "+s"(kp));
        unsigned char* ws = kp->ws;
        unsigned* ctl = (unsigned*)(ws + WS_CTL);
        float* MOD = (float*)(ws + WS_MOD);
        float* S5AB = (float*)(ws + WS_S5AB); float* S5BB = (float*)(ws + WS_S5AB + 65536);
        float* PW = (float*)(ws + WS_PW); float* KTAB = (float*)(ws + WS_KTAB);
                int* EL_SLOT = (int*)(ws + WS_EL); float* EL_GATE = (float*)(ws + WS_EL + 4 * MiB);
            bf16_t* W_IN_E = (bf16_t*)(ws + WS_W_IN_E); bf16_t* W_UP = (bf16_t*)(ws + WS_W_UP); bf16_t* W_GLU = (bf16_t*)(ws + WS_W_GLU);
        bf16_t* W_OUT_E = (bf16_t*)(ws + WS_W_OUT_E); bf16_t* W_IN_O = (bf16_t*)(ws + WS_W_IN_O); bf16_t* W_OUT_O = (bf16_t*)(ws + WS_W_OUT_O);
        bf16_t* W_POOL = (bf16_t*)(ws + WS_W_POOL); bf16_t* W_SGU = (bf16_t*)(ws + WS_W_SGU); bf16_t* W_RT = (bf16_t*)(ws + WS_W_RT);
        bf16_t* BT_END = (bf16_t*)(ws + WS_BT_END); bf16_t* BT_MAIN = (bf16_t*)(ws + WS_BT_MAIN);
        unsigned char* W_GU = ws + WS_W_GU; unsigned char* W_DN = ws + WS_W_DN; unsigned char* HB8 = ws + WS_HB8;
        bf16_t* HB = (bf16_t*)(ws + WS_HB); bf16_t* MIXIN = (bf16_t*)(ws + WS_MIXIN); bf16_t* Y = (bf16_t*)(ws + WS_Y);
        unsigned char* ACT = ws + WS_ACT;
        bf16_t* Z = (bf16_t*)(ws + WS_Z); float* RSP = (float*)(ws + WS_RSP); bf16_t* QKVRAW = (bf16_t*)(ws + WS_QKVRAW);
        bf16_t* Qb = (bf16_t*)(ws + WS_Q); bf16_t* Kb = (bf16_t*)(ws + WS_K); bf16_t* VT = (bf16_t*)(ws + WS_VT);
        bf16_t* AS5 = (bf16_t*)(ws + WS_AS5); float* LEND = (float*)(ws + WS_LEND); bf16_t* GACT = (bf16_t*)(ws + WS_GACT);
        bf16_t* POOLED = (bf16_t*)(ws + WS_POOLED); bf16_t* VTS = (bf16_t*)(ws + WS_VTS);
        float* OUT = kp->out; const float* XIN = kp->x; bf16_t* XR = (bf16_t*)(ws + WS_XR);
        const float* s5d = kp->s5_d; const float* glub = kp->s5_glu_b; const float* poolsc = kp->pool_scale; const float* sgub = kp->sgu_b;
        const float* bgu_all = kp->moe_b_gu; const float* bdn_all = kp->moe_b_dn; const float* rtb_all = kp->router_b;

        const int layer = (ph >= 17) ? 1 : 0;
        const int mph = (ph >= 17 && ph <= 19) ? ph - 8 : ph;
        const float* mod_l = MOD + (size_t)layer * NB * 6144;

        if (ph == 0) {
            const int gt = vb * NTHR + tid;
            if (gt < 2048) {
                const int g = gt >> 6, pp = gt & 63;
                const float dt = expf(kp->s5_log_dt[g]);
                const float lre = fminf(kp->s5_a_re[g * 64 + pp], -1e-4f), lim = kp->s5_a_im[g * 64 + pp];
                const float mag = expf(lre * dt);
                const float abr = mag * cosf(lim * dt), abi = mag * sinf(lim * dt);
                const float den = lre * lre + lim * lim, nr = abr - 1.0f;
                const float fre = (nr * lre + abi * lim) / den, fim = (abi * lre - nr * lim) / den;
                S5AB[(g * 64 + pp) * 2 + 0] = abr; S5AB[(g * 64 + pp) * 2 + 1] = abi;
                for (int j = 0; j < 16; ++j) {
                    const float br = kp->s5_b_re[(g * 64 + pp) * 16 + j], bi = kp->s5_b_im[(g * 64 + pp) * 16 + j];
                    S5BB[((g * 64 + pp) * 16 + j) * 2 + 0] = fre * br - fim * bi;
                    S5BB[((g * 64 + pp) * 16 + j) * 2 + 1] = fre * bi + fim * br;
                }
                float pr = 1.f, pi = 0.f;
                for (int tau = 0; tau <= 64; ++tau) {
                    PW[((g * 64 + pp) * 65 + tau) * 2 + 0] = pr; PW[((g * 64 + pp) * 65 + tau) * 2 + 1] = pi;
                    const float nr2 = pr * abr - pi * abi, ni2 = pr * abi + pi * abr; pr = nr2; pi = ni2;
                }
            }
            {
                float* ca = (float*)lds;
                for (int i = tid; i < NB * D; i += NTHR) { const float cv = kp->c[i]; ca[i] = cv * sigmoidf_(cv); }
                __syncthreads();
                float* part = (float*)(lds + 32768);
                for (int task = vb; task < 2 * 96; task += G) {
                    const int l = task / 96, cb = task % 96, col = cb * 64 + lane;
                    const float* W = kp->ada_w + (size_t)l * D * 6144 + col;
                    float acc[8];
#pragma unroll
                    for (int b = 0; b < 8; ++b) acc[b] = 0.f;
                    const int kb = wave * 128;
                    for (int k = kb; k < kb + 128; k += 8) {
                        float w[8];
#pragma unroll
                        for (int u = 0; u < 8; ++u) w[u] = W[(size_t)(k + u) * 6144];
#pragma unroll
                        for (int u = 0; u < 8; ++u)
#pragma unroll
                            for (int b = 0; b < 8; ++b) acc[b] += ca[b * D + k + u] * w[u];
                    }
#pragma unroll
                    for (int b = 0; b < 8; ++b) part[(wave * 8 + b) * 64 + lane] = acc[b];
                    __syncthreads();
                    {
                        const int b = tid >> 6;
                        float sum = kp->ada_b[l * 6144 + col];
#pragma unroll
                        for (int w8 = 0; w8 < 8; ++w8) sum += part[(w8 * 8 + b) * 64 + lane];
                        MOD[((size_t)l * NB + b) * 6144 + col] = sum;
                    }
                    __syncthreads();
                }
                __syncthreads();
            }
            {
                float* scr = (float*)(lds + wave * 16384);
                transpose_many(kp->even_w_in, 1, 1024, 928, W_IN_E, 0, scr, gw, NGW, lane, 0);
                transpose_many(kp->w_uq, 1, 256, 768, W_UP, 0, scr, gw, NGW, lane, 0, 384, kp->q_norm_g);
                transpose_many(kp->w_ukv, 1, 128, 1024, W_UP + (size_t)768 * 384 + 256, 0, scr, gw, NGW, lane, 0, 384, kp->kv_norm_g);
                for (int i = vb * NTHR + tid; i < 768 * 16 + 1024 * 32; i += G * NTHR) {
                    const u32x4 z = {0u, 0u, 0u, 0u};
                    if (i < 768 * 16) *(u32x4*)(W_UP + (size_t)(i >> 4) * 384 + 256 + (i & 15) * 8) = z;
                    else { const int q = i - 768 * 16; *(u32x4*)(W_UP + (size_t)(768 + (q >> 5)) * 384 + (q & 31) * 8) = z; }
                }
                transpose_many(kp->s5_glu_w, 1, 512, 512, W_GLU, 0, scr, gw, NGW, lane, 0);
                transpose_many(kp->even_w_out, 1, 1024, 1024, W_OUT_E, 0, scr, gw, NGW, lane, 0);
                transpose_many(kp->odd_w_in, 1, 1024, 1536, W_IN_O, 0, scr, gw, NGW, lane, 0);
                transpose_many(kp->odd_w_out, 1, 1024, 1024, W_OUT_O, 0, scr, gw, NGW, lane, 0);
                transpose_many(kp->pool_w, 4, 128, 128, W_POOL, 128 * 128, scr, gw, NGW, lane, 0);
                transpose_many(kp->router_w, 2, 1024, 32, W_RT, 128 * 1024, scr, gw, NGW, lane, 0);
                __syncthreads();
                convert_fp8_block(kp->moe_w_gu, 64, 1024, 2048, W_GU, (size_t)2048 * 1024, (float*)lds, vb, G, tid, 1, 32.0f);
                convert_fp8_block(kp->moe_w_dn, 64, 1024, 1024, W_DN, (size_t)1024 * 1024, (float*)lds, vb, G, tid, 0, 32.0f);
                for (int i = vb * NTHR + tid; i < 4 * 128 * 128; i += G * NTHR) {
                    const int t = (i >> 7) & 127, s_ = i & 127;
                    W_SGU[i] = (s_ <= t) ? f2bf(kp->sgu_w[i]) : (bf16_t)0;
                }
            }
        }
        else if (ph == 1 || ph == 12 || ph == 20) {
            const int lyr = (ph == 1) ? 0 : 1;
            const bool combine = (ph == 12 || ph == 20), donorm = (ph != 20);
            const int comb_layer = (ph == 12) ? 0 : 1;
            const bool ffn = false;
            const float* ng = (ffn ? kp->norm_ffn_g : kp->norm_mix_g) + lyr * D;
            if (ph == 1) {
                for (int rb = gw * 16; rb < T; rb += NGW * 16) {
                    const int b = rb / S;
                    const float* mm = MOD + ((size_t)lyr * NB + b) * 6144;
                    f32x4 pg[4], ps[4], ph_[4];
#pragma unroll
                    for (int j = 0; j < 4; ++j) { const int c = 4 * lane + 256 * j; pg[j] = *(const f32x4*)(ng + c); const f32x4 s1 = *(const f32x4*)(mm + D + c); ph_[j] = *(const f32x4*)(mm + c);
                        pg[j].x *= (1.f + s1.x); pg[j].y *= (1.f + s1.y); pg[j].z *= (1.f + s1.z); pg[j].w *= (1.f + s1.w); ps[j] = s1; }
                    f32x4 cur[4], nxt[4];
#pragma unroll
                    for (int j = 0; j < 4; ++j) cur[j] = *(const f32x4*)(XIN + (size_t)rb * D + 4 * lane + 256 * j);
                    for (int i = 0; i < 16; ++i) {
                        const int row = rb + i;
                        if (i + 1 < 16) {
#pragma unroll
                            for (int j = 0; j < 4; ++j) nxt[j] = *(const f32x4*)(XIN + (size_t)(row + 1) * D + 4 * lane + 256 * j);
                        }
                        float ss = 0.f;
#pragma unroll
                        for (int j = 0; j < 4; ++j) ss += (cur[j].x * cur[j].x + cur[j].y * cur[j].y) + (cur[j].z * cur[j].z + cur[j].w * cur[j].w);
                        const float r = rsqrtf(wave_sum(ss) * (1.0f / D) + 1e-6f);
#pragma unroll
                        for (int j = 0; j < 4; ++j) {
                            u32x2 o; o.x = pk2(cur[j].x * r * pg[j].x + ph_[j].x, cur[j].y * r * pg[j].y + ph_[j].y); o.y = pk2(cur[j].z * r * pg[j].z + ph_[j].z, cur[j].w * r * pg[j].w + ph_[j].w);
                            *(u32x2*)(HB + (size_t)row * D + 4 * lane + 256 * j) = o;
                        }
#pragma unroll
                        for (int j = 0; j < 4; ++j) cur[j] = nxt[j];
                    }
                }
            } else {
                for (int row0 = gw; row0 < T; row0 += 2 * NGW) {
                    float v[2][2][8];
#pragma unroll
                    for (int j = 0; j < 2; ++j) {
                        const int c = 8 * lane + 512 * j;
                        u32x4 xr[2], yr[2][4];
#pragma unroll
                        for (int q = 0; q < 2; ++q) {
                            const int row = row0 + q * NGW;
                            xr[q] = *(const u32x4*)(XR + (size_t)row * D + c);
#pragma unroll
                            for (int k = 0; k < 4; ++k) yr[q][k] = *(const u32x4*)(Y + ((size_t)row * 4 + k) * D + c);
                        }
#pragma unroll
                        for (int q = 0; q < 2; ++q) {
                            const int row = row0 + q * NGW, b = row / S;
                            const float* gf = MOD + ((size_t)comb_layer * NB + b) * 6144 + 5 * D;
                            float xf[8], acc[8];
                            unpack8(xr[q], xf);
#pragma unroll
                            for (int i = 0; i < 8; ++i) acc[i] = 0.f;
#pragma unroll
                            for (int k = 0; k < 4; ++k) { float yf[8]; unpack8(yr[q][k], yf);
#pragma unroll
                                for (int i = 0; i < 8; ++i) acc[i] += yf[i]; }
                            const f32x4 g0 = *(const f32x4*)(gf + c), g1 = *(const f32x4*)(gf + c + 4);
                            float (&vv)[8] = v[q][j];
                            vv[0] = xf[0] + g0.x * acc[0]; vv[1] = xf[1] + g0.y * acc[1]; vv[2] = xf[2] + g0.z * acc[2]; vv[3] = xf[3] + g0.w * acc[3];
                            vv[4] = xf[4] + g1.x * acc[4]; vv[5] = xf[5] + g1.y * acc[5]; vv[6] = xf[6] + g1.z * acc[6]; vv[7] = xf[7] + g1.w * acc[7];
                            if (ph == 20) { *(f32x4*)(OUT + (size_t)row * D + c) = (f32x4){vv[0], vv[1], vv[2], vv[3]}; *(f32x4*)(OUT + (size_t)row * D + c + 4) = (f32x4){vv[4], vv[5], vv[6], vv[7]}; }
                            else *(u32x4*)(XR + (size_t)row * D + c) = pack8(vv);
                        }
                    }
                    if (donorm) {
#pragma unroll
                        for (int q = 0; q < 2; ++q) {
                            const int row = row0 + q * NGW, b = row / S;
                            const float* mm = MOD + ((size_t)lyr * NB + b) * 6144;
                            norm_mod_store8(v[q], ng, mm + D, mm, HB + (size_t)row * D, (unsigned char*)nullptr, lane);
                        }
                    }
                }
            }
            if (ph == 1) {
                __syncthreads();
                float* Cs = (float*)lds;
                float* Bs = Cs + 2048;
                float* As = Bs + 2048;
                for (int item = vb; item < 256; item += G) {
                    const int g = item >> 3, tq = item & 7;
                    for (int idx = tid; idx < 1024; idx += NTHR) {
                        const int i = idx >> 6, pp = idx & 63;
                        Cs[idx * 2] = kp->s5_c_re[(g * 16 + i) * 64 + pp]; Cs[idx * 2 + 1] = kp->s5_c_im[(g * 16 + i) * 64 + pp];
                        Bs[idx * 2] = S5BB[((size_t)g * 1024 + idx) * 2]; Bs[idx * 2 + 1] = S5BB[((size_t)g * 1024 + idx) * 2 + 1];
                    }
                    { const int pp = tid >> 3, tl = tid & 7; As[tid * 2] = PW[((g * 64 + pp) * 65 + tq * 8 + tl) * 2]; As[tid * 2 + 1] = PW[((g * 64 + pp) * 65 + tq * 8 + tl) * 2 + 1]; }
                    __syncthreads();
                    const int v0 = tid * 4, tl = v0 >> 8, i = (v0 >> 4) & 15, j0 = v0 & 15;
                    float acc[4] = {0.f, 0.f, 0.f, 0.f};
                    for (int pp = 0; pp < 64; ++pp) {
                        const float cr = Cs[(i * 64 + pp) * 2], ci = Cs[(i * 64 + pp) * 2 + 1];
                        const float ar = As[(pp * 8 + tl) * 2], ai = As[(pp * 8 + tl) * 2 + 1];
                        const f32x4 b01 = *(const f32x4*)(Bs + (pp * 16 + j0) * 2), b23 = *(const f32x4*)(Bs + (pp * 16 + j0) * 2 + 4);
                        const float wr_ = cr * ar - ci * ai, wi_ = cr * ai + ci * ar;
                        acc[0] += wr_ * b01.x - wi_ * b01.y; acc[1] += wr_ * b01.z - wi_ * b01.w; acc[2] += wr_ * b23.x - wi_ * b23.y; acc[3] += wr_ * b23.z - wi_ * b23.w;
                    }
                    *(f32x4*)(KTAB + (((size_t)g * 64 + tq * 8 + tl) * 16 + i) * 16 + j0) = (f32x4){acc[0], acc[1], acc[2], acc[3]};
                    __syncthreads();
                }
            }
        }
        else if (ph == 2) {
            {
                DenseOrder so; so.go.init(T / 256, 4, G, vb);
                auto f = [=](const pg8::Unit& u, const pg8::NoCtx&, int ai, int m, int bj, int r, int c, f32x4 v0, f32x4 v1) -> float {
                        const int row = u.pm * 256 + r, col = u.pn * 256 + c; float ss = 0.f;
                        u32x4 o; o.x = pk2(v0.x, v0.y); o.y = pk2(v0.z, v0.w); o.z = pk2(v1.x, v1.y); o.w = pk2(v1.z, v1.w);
                        if (col < 384) ss = ((v0.x * v0.x + v0.y * v0.y) + (v0.z * v0.z + v0.w * v0.w)) + ((v1.x * v1.x + v1.y * v1.y) + (v1.z * v1.z + v1.w * v1.w));
                        if (col < 416) *(u32x4*)(Z + (size_t)row * 1024 + col) = o;
                        else if (col < 928) {
                            const int ch = col - 416, g = ch >> 4, j = ch & 15, b = row / S, t = row % S;
                            *(u32x4*)(AS5 + ((size_t)g * 512 + b * 64 + (t >> 6)) * 1152 + 128 + (t & 63) * 16 + j) = o;
                        }
                        return ss;
                    };
                auto re = [=](const pg8::Unit& u, int ai, int m, int r, int wc, int fq, float part) {
                        if (u.pn < 2) {
                            part += __shfl_xor(part, 16); part += __shfl_xor(part, 32);
                            if (fq == 0) RSP[((size_t)(u.pm * 256 + r) * 2 + u.pn) * 4 + wc] = part;
                        }
                    };
                pg8::gemm_phase<false, false, true>(tid, (PG8_LAS unsigned char*)lds, pg8::Gemm{HB, W_IN_E, D, D, D}, so, pg8::make_epi_row<true>(pg8::NoPre{}, f, re));
            }
            {
                float* KT = (float*)lds;
                float* Cs = KT + 64 * 256;
                float* PWt = Cs + 2048;
                float* PWe = PWt + 1024;
                float* BBe = PWe + 2048;
                for (int item = vb; item < 256; item += G) {
                    const int g = item >> 3, tq = item & 7;
                    __syncthreads();
                    const int ntau = 8 * tq + 8;
                    for (int idx = tid; idx < ntau * 64; idx += NTHR) *(f32x4*)(KT + idx * 4) = *(const f32x4*)(KTAB + (size_t)g * 64 * 256 + idx * 4);
                    for (int idx = tid; idx < 1024; idx += NTHR) { const int i = idx >> 6, pp = idx & 63;
                        Cs[idx * 2] = kp->s5_c_re[(g * 16 + i) * 64 + pp]; Cs[idx * 2 + 1] = kp->s5_c_im[(g * 16 + i) * 64 + pp]; }
                    { const int pp = tid >> 3, tl = tid & 7; PWt[tid * 2] = PW[((g * 64 + pp) * 65 + tq * 8 + tl + 1) * 2]; PWt[tid * 2 + 1] = PW[((g * 64 + pp) * 65 + tq * 8 + tl + 1) * 2 + 1]; }
                    const int ri_e = tq >> 2, p0_e = (tq & 3) * 16;
                    for (int idx = tid; idx < 1024; idx += NTHR) { const int pl = idx >> 6, tau = idx & 63;
                        PWe[idx * 2] = PW[((g * 64 + p0_e + pl) * 65 + tau) * 2]; PWe[idx * 2 + 1] = PW[((g * 64 + p0_e + pl) * 65 + tau) * 2 + 1]; }
                    if (tid < 256) { const int pl = tid >> 4, j = tid & 15; BBe[tid * 2] = S5BB[((g * 64 + p0_e + pl) * 16 + j) * 2]; BBe[tid * 2 + 1] = S5BB[((g * 64 + p0_e + pl) * 16 + j) * 2 + 1]; }
                    __syncthreads();
                    for (int it = tid; it < 16 * 128; it += NTHR) {
                        const int pl = it >> 7, k8 = it & 127, s_ = k8 >> 1, j0 = (k8 & 1) * 8;
                        const float pr = PWe[(pl * 64 + 63 - s_) * 2], pi = PWe[(pl * 64 + 63 - s_) * 2 + 1];
                        float o[8];
#pragma unroll
                        for (int j = 0; j < 8; ++j) { const float br = BBe[(pl * 16 + j0 + j) * 2], bi = BBe[(pl * 16 + j0 + j) * 2 + 1]; o[j] = ri_e ? (pr * bi + pi * br) : (pr * br - pi * bi); }
                        u32x4 w; w.x = pk2(o[0], o[1]); w.y = pk2(o[2], o[3]); w.z = pk2(o[4], o[5]); w.w = pk2(o[6], o[7]);
                        *(u32x4*)(BT_END + ((size_t)g * 128 + ri_e * 64 + p0_e + pl) * 1024 + k8 * 8) = w;
                    }
                    for (int it = tid; it < 128 * 144; it += NTHR) {
                        const int rl = it / 144, k8 = it % 144, tl = rl >> 4, i = rl & 15, t = 8 * tq + tl;
                        float o[8];
                        if (k8 < 16) {
                            const int ri = k8 >> 3, p0 = (k8 & 7) * 8;
#pragma unroll
                            for (int j = 0; j < 8; ++j) {
                                const float cr = Cs[(i * 64 + p0 + j) * 2], ci = Cs[(i * 64 + p0 + j) * 2 + 1];
                                const float pr = PWt[((p0 + j) * 8 + tl) * 2], pi = PWt[((p0 + j) * 8 + tl) * 2 + 1];
                                o[j] = ri ? -(cr * pi + ci * pr) : (cr * pr - ci * pi);
                            }
                        } else {
                            const int kk = (k8 - 16) * 8, s_ = kk >> 4, j0 = kk & 15;
                            if (s_ <= t) { const f32x4 a = *(const f32x4*)(KT + (t - s_) * 256 + i * 16 + j0), c4 = *(const f32x4*)(KT + (t - s_) * 256 + i * 16 + j0 + 4);
                                o[0] = a.x; o[1] = a.y; o[2] = a.z; o[3] = a.w; o[4] = c4.x; o[5] = c4.y; o[6] = c4.z; o[7] = c4.w; }
                            else {
#pragma unroll
                                for (int j = 0; j < 8; ++j) o[j] = 0.f; }
                        }
                        u32x4 w; w.x = pk2(o[0], o[1]); w.y = pk2(o[2], o[3]); w.z = pk2(o[4], o[5]); w.w = pk2(o[6], o[7]);
                        *(u32x4*)(BT_MAIN + ((size_t)g * 1024 + 8 * tq * 16 + rl) * 1152 + k8 * 8) = w;
                    }
                }
                __syncthreads();
            }
        }
        else if (ph == 4) {
            {
                DenseOrder so; so.go.init(T / 256, 7, G, vb);
                struct UpCtx { float rs[8]; };
                auto pre = [=](const pg8::Unit& u, int wr, int wc, int fr, int fq, const PG8_LAS unsigned char* cxl) {
                        UpCtx cx; const int st = (u.pn >= 3) ? 1 : 0; const float inv = st ? (1.f / 128.f) : (1.f / 256.f);
#pragma unroll
                        for (int q = 0; q < 8; ++q) { const int row = u.pm * 256 + (q >> 2) * 128 + wr * 64 + (q & 3) * 16 + fr;
                            const f32x4 pp = *(const f32x4*)(RSP + ((size_t)row * 2 + st) * 4);
                            cx.rs[q] = rsqrtf(((pp.x + pp.y) + (pp.z + pp.w)) * inv + 1e-6f); }
                        return cx; };
                auto f = [=](const pg8::Unit& u, const UpCtx& cx, int ai, int m, int bj, int r, int c, f32x4 v0, f32x4 v1) {
                            const float rs = cx.rs[ai * 4 + m];
                            bf16_t* o = QKVRAW + (size_t)(u.pm * 256 + r) * 1792 + u.pn * 256 + c;
                            u32x4 a; a.x = pk2(v0.x * rs, v0.y * rs); a.y = pk2(v0.z * rs, v0.w * rs); a.z = pk2(v1.x * rs, v1.y * rs); a.w = pk2(v1.z * rs, v1.w * rs); *(u32x4*)o = a;
                        };
                pg8::gemm_phase<false, false, true>(tid, (PG8_LAS unsigned char*)lds, pg8::Gemm{Z, W_UP, 1024, 384, 384}, so, pg8::make_epi_perm(pre, f));
            }
            for (int u = (vb >= 128 ? vb - 128 : vb + 128); u < 128; u += G) {
                const int g = u >> 2, pm = u & 3;
                sg_tile(tid, lds, AS5 + ((size_t)g * 512 + pm * 128) * 1152 + 128, 1152, BT_END + (size_t)g * 128 * 1024, 1024, 1024,
                    [=](int r, int c, f32x4 v0, f32x4 v1) {
                        float* o = LEND + ((size_t)g * 512 + pm * 128 + r) * 128 + c;
                        *(f32x4*)o = v0; *(f32x4*)(o + 16) = v1;
                    });
            }
        }
        else if (ph == 5) {
            bf16_t* vts = (bf16_t*)lds;
            const float qscale = 0.10206207261596577f * 1.4426950408889634f;
            const int hh = lane >> 3, pp = lane & 7;
            float gq[12], gk[12];
#pragma unroll
            for (int g3 = 0; g3 < 3; ++g3)
#pragma unroll
                for (int e = 0; e < 4; ++e) { gq[g3 * 4 + e] = kp->q_head_g[32 * g3 + 4 * pp + e] * qscale; gk[g3 * 4 + e] = kp->k_head_g[32 * g3 + 4 * pp + e]; }
            float invf[4];
#pragma unroll
            for (int e = 0; e < 4; ++e) invf[e] = exp2f(-(float)(4 * (pp & 3) + e) * (13.287712379549449f / 16.0f));
            for (int tile = vb; tile < T / 64; tile += G) {
                u32x2 cq[3], ck[3], nq[3], nk[3]; u32x4 cv, nv; int cpos, npos;
#define P5_LOAD(row_, Q_, K_, V_, P_) do { const bf16_t* base_ = QKVRAW + (size_t)(row_) * 1792; \
                    _Pragma("unroll") for (int g3 = 0; g3 < 3; ++g3) Q_[g3] = *(const u32x2*)(base_ + hh * 96 + 32 * g3 + 4 * pp); \
                    K_[0] = *(const u32x2*)(base_ + 768 + hh * 128 + 4 * pp); K_[1] = *(const u32x2*)(base_ + 768 + hh * 128 + 32 + 4 * pp); K_[2] = *(const u32x2*)(Z + (size_t)(row_) * 1024 + 384 + 4 * pp); \
                    V_ = *(const u32x4*)(base_ + 768 + hh * 128 + 64 + 8 * pp); P_ = kp->pos[row_]; } while (0)
                P5_LOAD(tile * 64 + wave * 8, cq, ck, cv, cpos);
                for (int tt = 0; tt < 8; ++tt) {
                    const int tl = wave * 8 + tt, row = tile * 64 + tl, b = row / S, t = row % S;
                    if (tt + 1 < 8) P5_LOAD(row + 1, nq, nk, nv, npos);
                    float qv[12], kv[12];
#pragma unroll
                    for (int g3 = 0; g3 < 3; ++g3) {
                        qv[4 * g3 + 0] = __uint_as_float(cq[g3].x << 16); qv[4 * g3 + 1] = __uint_as_float(cq[g3].x & 0xffff0000u); qv[4 * g3 + 2] = __uint_as_float(cq[g3].y << 16); qv[4 * g3 + 3] = __uint_as_float(cq[g3].y & 0xffff0000u);
                        kv[4 * g3 + 0] = __uint_as_float(ck[g3].x << 16); kv[4 * g3 + 1] = __uint_as_float(ck[g3].x & 0xffff0000u); kv[4 * g3 + 2] = __uint_as_float(ck[g3].y << 16); kv[4 * g3 + 3] = __uint_as_float(ck[g3].y & 0xffff0000u);
                    }
                    float sq = 0.f, sk = 0.f;
#pragma unroll
                    for (int j = 0; j < 12; ++j) { sq += qv[j] * qv[j]; sk += kv[j] * kv[j]; }
                    sq += __shfl_xor(sq, 1); sq += __shfl_xor(sq, 2); sq += __shfl_xor(sq, 4);
                    sk += __shfl_xor(sk, 1); sk += __shfl_xor(sk, 2); sk += __shfl_xor(sk, 4);
                    const float rq = rsqrtf(sq * (1.f / 96.f) + 1e-6f), rk = rsqrtf(sk * (1.f / 96.f) + 1e-6f);
#pragma unroll
                    for (int j = 0; j < 12; ++j) { qv[j] *= rq * gq[j]; kv[j] *= rk * gk[j]; }
                    const float posf = (float)cpos; const bool lo = pp < 4;
#pragma unroll
                    for (int e = 0; e < 4; ++e) {
                        const float ang = posf * invf[e];
                        const float kq = rintf(ang * 0.15915494309189535f);
                        float rr = __builtin_fmaf(-kq, 6.28318548202514648f, ang); rr = __builtin_fmaf(-kq, -1.7484556e-7f, rr);
                        const float cs = __cosf(rr), sn = __sinf(rr);
                        const float qo = __shfl_xor(qv[8 + e], 4), ko = __shfl_xor(kv[8 + e], 4);
                        qv[8 + e] = lo ? (qv[8 + e] * cs - qo * sn) : (qo * sn + qv[8 + e] * cs);
                        kv[8 + e] = lo ? (kv[8 + e] * cs - ko * sn) : (ko * sn + kv[8 + e] * cs);
                    }
                    bf16_t* qd = Qb + (((size_t)b * 8 + hh) * S + t) * 96 + 4 * pp; bf16_t* kd = Kb + (((size_t)b * 8 + hh) * S + t) * 96 + 4 * pp;
#pragma unroll
                    for (int g3 = 0; g3 < 3; ++g3) {
                        u32x2 o; o.x = pk2(qv[4 * g3], qv[4 * g3 + 1]); o.y = pk2(qv[4 * g3 + 2], qv[4 * g3 + 3]); *(u32x2*)(qd + 32 * g3) = o;
                        u32x2 o2; o2.x = pk2(kv[4 * g3], kv[4 * g3 + 1]); o2.y = pk2(kv[4 * g3 + 2], kv[4 * g3 + 3]); *(u32x2*)(kd + 32 * g3) = o2;
                    }
                    { const unsigned w4[4] = {cv.x, cv.y, cv.z, cv.w};
#pragma unroll
                      for (int j = 0; j < 8; ++j) vts[(hh * 64 + 8 * pp + j) * 64 + tl] = (bf16_t)((j & 1) ? (w4[j >> 1] >> 16) : (w4[j >> 1] & 0xffffu)); }
#pragma unroll
                    for (int g3 = 0; g3 < 3; ++g3) { cq[g3] = nq[g3]; ck[g3] = nk[g3]; }
                    cv = nv; cpos = npos;
                }
#undef P5_LOAD
                __syncthreads();
                {
                    const int hd = tid, b = (tile * 64) / S, t0 = (tile * 64) % S;
                    bf16_t* dst = VT + (((size_t)b * 8 + (hd >> 6)) * 64 + (hd & 63)) * S + t0;
#pragma unroll
                    for (int i = 0; i < 8; ++i) *(u32x4*)(dst + i * 8) = *(const u32x4*)(vts + hd * 64 + i * 8);
                }
                __syncthreads();
            }
            if (wave == 0) {
                for (int ch = vb * 64 + lane; ch < NB * 32 * 64; ch += G * 64) {
                    const int pp = ch & 63, g = (ch >> 6) & 31, b = ch >> 11;
                    const float ar = PW[((g * 64 + pp) * 65 + 64) * 2], ai = PW[((g * 64 + pp) * 65 + 64) * 2 + 1];
                    float cr = 0.f, ci = 0.f;
                    for (int c0 = 0; c0 < 64; c0 += 16) {
                        float lr[16], li[16];
#pragma unroll
                        for (int u = 0; u < 16; ++u) { const float* le = LEND + ((size_t)g * 512 + b * 64 + c0 + u) * 128; lr[u] = le[pp]; li[u] = le[64 + pp]; }
#pragma unroll
                        for (int u = 0; u < 16; ++u) {
                            bf16_t* dst = AS5 + ((size_t)g * 512 + b * 64 + c0 + u) * 1152;
                            dst[pp] = f2bf(cr); dst[64 + pp] = f2bf(ci);
                            const float nr = ar * cr - ai * ci + lr[u], ni = ar * ci + ai * cr + li[u];
                            cr = nr; ci = ni;
                        }
                    }
                }
            }
        }
        else if (ph == 6) {
            unsigned char* Kr = lds;
            unsigned char* Vr = lds + 3 * 64 * 208;
            const int r32 = lane & 31, hi = lane >> 5;
#define ATT_MFMA_C(D, A, B, C) asm volatile("s_nop 1\n\tv_mfma_f32_32x32x16_bf16 %0, %1, %2, %3" : "=a"(D) : "v"(A), "v"(B), "a"(C))
#define ATT_MFMA(D, A, B)      asm volatile("s_nop 1\n\tv_mfma_f32_32x32x16_bf16 %0, %1, %2, %0" : "+a"(D) : "v"(A), "v"(B))
            for (int ui_ = 0; ui_ < 4 * (1 + PROBE_ATT2); ++ui_) { const int ui = ui_ & 3;
                if (vb >= 256) break;
                const int bh = vb & 63, kq = vb >> 6;
                const int qb = (ui == 0) ? 15 - kq : (ui == 1) ? 8 + kq : (ui == 2) ? 7 - kq : kq;
                const int q0 = qb * 256 + wave * 32;
                const bf16_t* Qg = Qb + ((size_t)bh * S + q0 + r32) * 96;
                const bf16_t* Kg = Kb + (size_t)bh * S * 96;
                const bf16_t* Vg = VT + (size_t)bh * 64 * S;
                unsigned char* Qs = lds + 3 * 64 * (208 + 136) + (wave * 32 + r32) * 208;
                __syncthreads();
#pragma unroll
                for (int d0 = 0; d0 < 6; ++d0) *(bf16x8*)(Qs + d0 * 32 + hi * 16) = *(const bf16x8*)(Qg + d0 * 16 + hi * 8);
                const int ntile = 4 * (qb + 1);
                const int ntw = (q0 + 31) / 64 + 1;
                const int kr0 = tid / 12, kc0 = tid % 12, kr1 = (tid + 512) / 12, kc1 = (tid + 512) % 12;
                const int vr = tid >> 3, vc = tid & 7;
                u32x4 rk0, rk1, rv;
#define ATT_LOAD(t_) do { rk0 = *(const u32x4*)(Kg + (size_t)((t_) * 64 + kr0) * 96 + kc0 * 8); if (tid < 256) rk1 = *(const u32x4*)(Kg + (size_t)((t_) * 64 + kr1) * 96 + kc1 * 8); \
                    rv = *(const u32x4*)(Vg + (size_t)vr * S + (t_) * 64 + vc * 8); } while (0)
#define ATT_WRITE(t_) do { unsigned char* Ks_ = Kr + ((t_) % 3) * (64 * 208); unsigned char* Vs_ = Vr + ((t_) % 3) * (64 * 136); \
                    *(u32x4*)(Ks_ + kr0 * 208 + kc0 * 16) = rk0; if (tid < 256) *(u32x4*)(Ks_ + kr1 * 208 + kc1 * 16) = rk1; \
                    { u32x2 a_; a_.x = rv.x; a_.y = rv.y; u32x2 b_; b_.x = rv.z; b_.y = rv.w; *(u32x2*)(Vs_ + vr * 136 + vc * 16) = a_; *(u32x2*)(Vs_ + vr * 136 + vc * 16 + 8) = b_; } } while (0)
#define ATT_QK(t_) do { const unsigned char* Ks_ = Kr + ((t_) % 3) * (64 * 208); \
                    _Pragma("unroll") for (int d0 = 0; d0 < 6; ++d0) { \
                        const bf16x8 k0_ = *(const bf16x8*)(Ks_ + r32 * 208 + d0 * 32 + hi * 16); const bf16x8 k1_ = *(const bf16x8*)(Ks_ + (32 + r32) * 208 + d0 * 32 + hi * 16); \
                        const bf16x8 q_ = *(const bf16x8*)(Qs + d0 * 32 + hi * 16); \
                        if (d0 == 0) { ATT_MFMA_C(sA0, k0_, q_, negm); ATT_MFMA_C(sA1, k1_, q_, negm); } else { ATT_MFMA(sA0, k0_, q_); ATT_MFMA(sA1, k1_, q_); } } } while (0)
                f32x16 o0, o1, sA0, sA1, negm;
#pragma unroll
                for (int r = 0; r < 16; ++r) { o0[r] = 0.f; o1[r] = 0.f; negm[r] = 0.f; }
                float m_ref = 0.f, l_run = 0.f;
                ATT_LOAD(0); ATT_WRITE(0);
                if (ntile > 1) { ATT_LOAD(1); ATT_WRITE(1); }
                __syncthreads();
                ATT_QK(0);
                for (int t = 0; t < ntile; ++t) {
                    __syncthreads();
                    if (t + 2 < ntile) ATT_LOAD(t + 2);
                    if (t < ntw) {
                        asm volatile("s_nop 15\n\ts_nop 7" ::: "memory");
                        f32x16 s0 = sA0, s1 = sA1;
                        asm volatile("" : "+v"(s0), "+v"(s1));
                        if (t + 1 < ntw) ATT_QK(t + 1);
                        if (t * 64 + 63 > q0) {
                            const int qi = q0 + r32;
#pragma unroll
                            for (int r = 0; r < 16; ++r) { const int key = t * 64 + crow(r, hi); if (key > qi) s0[r] = -INFINITY; if (key + 32 > qi) s1[r] = -INFINITY; }
                        }
                        float mx = fmaxf(s0[0], s1[0]);
#pragma unroll
                        for (int r = 1; r < 16; ++r) mx = fmaxf(mx, fmaxf(s0[r], s1[r]));
                        mx = fmaxf(mx, __shfl_xor(mx, 32));
                        if (__any(mx > 8.0f) || t == 0) {
                            const float dl = (t == 0) ? mx : fmaxf(mx, 0.f);
                            const float alpha = __builtin_amdgcn_exp2f(-dl);
                            m_ref += dl; l_run *= alpha;
#pragma unroll
                            for (int r = 0; r < 16; ++r) { s0[r] -= dl; s1[r] -= dl; }
                            if (t > 0) {
#pragma unroll
                                for (int r = 0; r < 16; ++r) { o0[r] *= alpha; o1[r] *= alpha; }
                            }
#pragma unroll
                            for (int r = 0; r < 16; ++r) negm[r] = -m_ref;
                            if (t + 1 < ntw) ATT_QK(t + 1);
                        }
                        float ls = 0.f;
#pragma unroll
                        for (int r = 0; r < 16; ++r) { s0[r] = __builtin_amdgcn_exp2f(s0[r]); s1[r] = __builtin_amdgcn_exp2f(s1[r]); ls += s0[r] + s1[r]; }
                        l_run += ls;
                        bf16x8 pf[2][2];
#pragma unroll
                        for (int ks = 0; ks < 2; ++ks) {
                            u32x4 w0, w1;
                            w0.x = pk2(s0[8 * ks + 0], s0[8 * ks + 1]); w0.y = pk2(s0[8 * ks + 2], s0[8 * ks + 3]); w0.z = pk2(s0[8 * ks + 4], s0[8 * ks + 5]); w0.w = pk2(s0[8 * ks + 6], s0[8 * ks + 7]);
                            w1.x = pk2(s1[8 * ks + 0], s1[8 * ks + 1]); w1.y = pk2(s1[8 * ks + 2], s1[8 * ks + 3]); w1.z = pk2(s1[8 * ks + 4], s1[8 * ks + 5]); w1.w = pk2(s1[8 * ks + 6], s1[8 * ks + 7]);
                            pf[0][ks] = __builtin_bit_cast(bf16x8, w0); pf[1][ks] = __builtin_bit_cast(bf16x8, w1);
                        }
                        const unsigned char* Vs_ = Vr + (t % 3) * (64 * 136);
#pragma unroll
                        for (int kb = 0; kb < 2; ++kb)
#pragma unroll
                            for (int ks = 0; ks < 2; ++ks) {
                                const int koff = (kb * 32 + 16 * ks + 4 * hi) * 2;
#pragma unroll
                                for (int dvb = 0; dvb < 2; ++dvb) {
                                    const unsigned char* vp = Vs_ + (dvb * 32 + r32) * 136 + koff;
                                    const u32x2 lo = *(const u32x2*)vp, hi2 = *(const u32x2*)(vp + 16);
                                    u32x4 w; w.x = lo.x; w.y = lo.y; w.z = hi2.x; w.w = hi2.y;
                                    const bf16x8 vf = __builtin_bit_cast(bf16x8, w);
                                    if (dvb == 0) ATT_MFMA(o0, vf, pf[kb][ks]); else ATT_MFMA(o1, vf, pf[kb][ks]);
                                }
                            }
                    }
                    if (t + 2 < ntile) ATT_WRITE(t + 2);
                }
                asm volatile("s_nop 15\n\ts_nop 7" ::: "memory");
                l_run += __shfl_xor(l_run, 32);
                const float rl = __builtin_amdgcn_rcpf(l_run);
                const int b = bh >> 3, h = bh & 7;
                bf16_t* orow = MIXIN + ((size_t)b * S + q0 + r32) * 1024 + h * 64;
#pragma unroll
                for (int rg = 0; rg < 4; ++rg) {
                    u32x2 a; a.x = pk2(o0[4 * rg] * rl, o0[4 * rg + 1] * rl); a.y = pk2(o0[4 * rg + 2] * rl, o0[4 * rg + 3] * rl);
                    *(u32x2*)(orow + 8 * rg + 4 * hi) = a;
                    u32x2 c2; c2.x = pk2(o1[4 * rg] * rl, o1[4 * rg + 1] * rl); c2.y = pk2(o1[4 * rg + 2] * rl, o1[4 * rg + 3] * rl);
                    *(u32x2*)(orow + 32 + 8 * rg + 4 * hi) = c2;
                }
            }
#undef ATT_MFMA_C
#undef ATT_MFMA
#undef ATT_LOAD
#undef ATT_WRITE
#undef ATT_QK
            __syncthreads();
            {
                S5Order so; so.G = G; so.c = vb;
                auto f = [=](const pg8::Unit& u, const pg8::NoCtx&, int ai, int m, int bj, int r, int c, f32x4 v0, f32x4 v1) {
                        const int g = u.aux, mr = (u.pm & 1) * 256 + r, b = mr >> 6, ck = mr & 63;
#pragma unroll
                        for (int h = 0; h < 2; ++h) {
                            const int n = u.pn * 256 + c + 16 * h; const f32x4 v = h ? v1 : v0;
                            const int tq = n >> 4, i = n & 15;
                            const u32x2 uu = *(const u32x2*)(AS5 + ((size_t)g * 512 + mr) * 1152 + 128 + n);
                            const f32x4 dd = *(const f32x4*)(s5d + g * 16 + i);
                            const float y0 = v.x + dd.x * __uint_as_float(uu.x << 16), y1 = v.y + dd.y * __uint_as_float(uu.x & 0xffff0000u),
                                        y2 = v.z + dd.z * __uint_as_float(uu.y << 16), y3 = v.w + dd.w * __uint_as_float(uu.y & 0xffff0000u);
                            u32x2 o; o.x = pk2(gelu_tanh(y0), gelu_tanh(y1)); o.y = pk2(gelu_tanh(y2), gelu_tanh(y3));
                            *(u32x2*)(GACT + ((size_t)b * S + ck * 64 + tq) * 512 + g * 16 + i) = o;
                        }
                    };
                pg8::gemm_phase(tid, (PG8_LAS unsigned char*)lds, pg8::Gemm{AS5, BT_MAIN, 1152, 1152, 1152}, so, pg8::make_epi(pg8::NoPre{}, f));
            }
        }
        else if (ph == 7) {
            {
                DenseOrder so; so.go.init(T / 256, 2, G, vb);
                auto f = [=](const pg8::Unit& u, const pg8::NoCtx&, int ai, int m, int bj, int r, int c, f32x4 v0, f32x4 v1) {
                        const int row = u.pm * 256 + r, col = u.pn * 256 + c;
                        float gv[8]; unpack8(*(const u32x4*)(GACT + (size_t)row * 512 + col), gv);
                        const f32x4 b0 = *(const f32x4*)(glub + col), b1 = *(const f32x4*)(glub + col + 4);
                        u32x4 o; o.x = pk2(gv[0] * sigmoidf_(v0.x + b0.x), gv[1] * sigmoidf_(v0.y + b0.y)); o.y = pk2(gv[2] * sigmoidf_(v0.z + b0.z), gv[3] * sigmoidf_(v0.w + b0.w));
                        o.z = pk2(gv[4] * sigmoidf_(v1.x + b1.x), gv[5] * sigmoidf_(v1.y + b1.y)); o.w = pk2(gv[6] * sigmoidf_(v1.z + b1.z), gv[7] * sigmoidf_(v1.w + b1.w));
                        *(u32x4*)(MIXIN + (size_t)row * 1024 + 512 + col) = o;
                    };
                pg8::gemm_phase<false, false, true>(tid, (PG8_LAS unsigned char*)lds, pg8::Gemm{GACT, W_GLU, 512, 512, 512}, so, pg8::make_epi_perm(pg8::NoPre{}, f));
            }
        }
        else if (ph == 8 || ph == 16) {
            const int lyr = (ph == 8) ? 0 : 1;
            const bf16_t* W = lyr ? W_OUT_O : W_OUT_E;

            {
                DenseOrder so; so.go.init(T / 256, 4, G, vb);
                struct OCtx { f32x4 gm[2][2]; };
                struct OG { u32x4 x[2][2]; };
                auto pre = [=](const pg8::Unit& u, int wr, int wc, int fr, int fq, const PG8_LAS unsigned char* cxl) {
                        OCtx cx; const int b = (u.pm * 256) / S; const float* gm = MOD + ((size_t)lyr * NB + b) * 6144 + 2 * D;
#pragma unroll
                        for (int bj = 0; bj < 2; ++bj)
#pragma unroll
                            for (int h = 0; h < 2; ++h) cx.gm[bj][h] = *(const f32x4*)(gm + u.pn * 256 + bj * 128 + wc * 32 + 4 * fq + 16 * h);
                        return cx; };
                auto gp = [=](const pg8::Unit& u, const OCtx&, int r, int wc, int fq) {
                        OG g; const int row = u.pm * 256 + r;
#pragma unroll
                        for (int bj = 0; bj < 2; ++bj)
#pragma unroll
                            for (int h = 0; h < 2; ++h) { const int col = u.pn * 256 + bj * 128 + wc * 32 + 4 * fq + 16 * h;
                                if (lyr == 0) g.x[bj][h] = *(const u32x4*)(XIN + (size_t)row * D + col);
                                else { const u32x2 xx = *(const u32x2*)(XR + (size_t)row * D + col); g.x[bj][h] = (u32x4){xx.x, xx.y, 0u, 0u}; } }
                        return g; };
                auto f = [=](const pg8::Unit& u, const OCtx& cx, const OG& g, int ai, int m, int bj, int r, int c, f32x4 v0, f32x4 v1) {
                        const int row = u.pm * 256 + r;
#pragma unroll
                        for (int h = 0; h < 2; ++h) {
                            const int col = u.pn * 256 + c + 16 * h; const f32x4 v = h ? v1 : v0;
                            const f32x4 g4 = cx.gm[bj][h]; const u32x4 xx = g.x[bj][h]; f32x4 xs;
                            if (lyr == 0) { xs.x = __uint_as_float(xx.x); xs.y = __uint_as_float(xx.y); xs.z = __uint_as_float(xx.z); xs.w = __uint_as_float(xx.w); }
                            else { xs.x = __uint_as_float(xx.x << 16); xs.y = __uint_as_float(xx.x & 0xffff0000u); xs.z = __uint_as_float(xx.y << 16); xs.w = __uint_as_float(xx.y & 0xffff0000u); }
                            u32x2 o; o.x = pk2(xs.x + g4.x * v.x, xs.y + g4.y * v.y); o.y = pk2(xs.z + g4.z * v.z, xs.w + g4.w * v.w);
                            *(u32x2*)(XR + (size_t)row * D + col) = o;
                        }
                    };
                pg8::gemm_phase(tid, (PG8_LAS unsigned char*)lds, pg8::Gemm{MIXIN, W, D, D, D}, so, pg8::make_epi_g(pre, gp, f));
            }
        }
        else if (mph == 9) {
            const bf16_t* W = W_RT + (size_t)layer * 128 * 1024;
            const float* rb = rtb_all + layer * 32;
            float* lgs = (float*)(lds + 40960);
            unsigned* hist = (unsigned*)(lds + 40960 + 128 * 33 * 4);
            unsigned* gcnt = ctl + CW_CNT + layer * 64;
            const float* ng = kp->norm_ffn_g + layer * D;
            for (int tile = vb; tile < T / 128; tile += G) {
              for (int rep_ = 0; rep_ <= PROBE_RT2; ++rep_) {
                if (rep_) __syncthreads();
                for (int i = 0; i < 16; i += 2) {
                    u32x4 xr[2][2];
#pragma unroll
                    for (int q = 0; q < 2; ++q)
#pragma unroll
                        for (int j = 0; j < 2; ++j) xr[q][j] = *(const u32x4*)(XR + (size_t)(tile * 128 + wave * 16 + i + q) * D + 8 * lane + 512 * j);
#pragma unroll
                    for (int q = 0; q < 2; ++q) {
                        const int row = tile * 128 + wave * 16 + i + q, b = row / S;
                        float v[2][8]; unpack8(xr[q][0], v[0]); unpack8(xr[q][1], v[1]);
                        const float* mm = MOD + ((size_t)layer * NB + b) * 6144 + 3 * D;
                        norm_mod_store8(v, ng, mm + D, mm, HB + (size_t)row * D, HB8 + (size_t)row * D, lane);
                    }
                }
                if (tid < 64) hist[tid] = 0u;
                asm volatile("s_waitcnt vmcnt(0)" ::: "memory");
                __syncthreads();
                sg_tile(tid, lds, HB + (size_t)tile * 128 * D, D, W, D, D,
                    [=](int r, int c, f32x4 v0, f32x4 v1) {
                        if (c < 32) {
#pragma unroll
                            for (int i = 0; i < 4; ++i) { lgs[r * 33 + c + i] = v0[i] + rb[c + i]; lgs[r * 33 + c + 16 + i] = v1[i] + rb[c + 16 + i]; }
                        }
                    });
              }
                __syncthreads();
                const bool act = tid < 128; const int rr = tid & 127;
                float lg[32];
#pragma unroll
                for (int e = 0; e < 32; ++e) lg[e] = lgs[rr * 33 + e];
                int e0 = 0, e1 = 0, e2 = 0, e3 = 0; float v0_ = 0.f, v1_ = 0.f, v2_ = 0.f, v3_ = 0.f;
#pragma unroll
                for (int k = 0; k < 4; ++k) {
                    float best = -INFINITY; int bi = 0;
#pragma unroll
                    for (int e = 0; e < 32; ++e) { const bool tk = lg[e] > best; best = tk ? lg[e] : best; bi = tk ? e : bi; }
                    if (k == 0) { e0 = bi; v0_ = best; } else if (k == 1) { e1 = bi; v1_ = best; } else if (k == 2) { e2 = bi; v2_ = best; } else { e3 = bi; v3_ = best; }
#pragma unroll
                    for (int e = 0; e < 32; ++e) lg[e] = (e == bi) ? -INFINITY : lg[e];
                }
                const float x1_ = __expf(v1_ - v0_), x2_ = __expf(v2_ - v0_), x3_ = __expf(v3_ - v0_);
                const float rden = 1.0f / (1.0f + x1_ + x2_ + x3_);
                unsigned l0 = 0, l1 = 0, l2 = 0, l3 = 0;
                if (act) { l0 = atomicAdd(hist + e0, 1u); l1 = atomicAdd(hist + e1, 1u); l2 = atomicAdd(hist + e2, 1u); l3 = atomicAdd(hist + e3, 1u); }
                __syncthreads();
                if (tid < 32) hist[32 + tid] = atomicAdd(gcnt + tid, (unsigned)hist[tid]);
                __syncthreads();
                if (act) {
                    const int tok = tile * 128 + tid;
                    size_t idx = (size_t)e0 * T + hist[32 + e0] + l0; EL_SLOT[idx] = tok * 4 + 0; EL_GATE[idx] = rden;
                    idx = (size_t)e1 * T + hist[32 + e1] + l1; EL_SLOT[idx] = tok * 4 + 1; EL_GATE[idx] = x1_ * rden;
                    idx = (size_t)e2 * T + hist[32 + e2] + l2; EL_SLOT[idx] = tok * 4 + 2; EL_GATE[idx] = x2_ * rden;
                    idx = (size_t)e3 * T + hist[32 + e3] + l3; EL_SLOT[idx] = tok * 4 + 3; EL_GATE[idx] = x3_ * rden;
                }
                __syncthreads();
            }
        }
        else if (mph == 10 || mph == 11) {
            int* pst = (int*)(lds + LDS_MISC + 1024);
            if (tid == 0) {
                const unsigned* gcnt = ctl + CW_CNT + layer * 64; int acc = 0;
                for (int e = 0; e < 32; ++e) { const int c = (int)gcnt[e]; pst[e] = acc; pst[64 + e] = c; acc += (c + 255) & ~255; }
                pst[32] = acc;
            }
            __syncthreads();
            const int total_rows = pst[32];
            if (mph == 10) {
                {
                    MoeOrder so; so.go.init(total_rows >> 8, 8, G, vb); so.pst = pst; so.NT = 8; so.ebase = layer * 32; so.el_slot = EL_SLOT;
                    struct G1Ctx { f32x4 b0[2], b1[2]; };
                    auto pre = [=](const pg8::Unit& u, int wr, int wc, int fr, int fq, const PG8_LAS unsigned char* cxl) {
                            G1Ctx cx;
#pragma unroll
                            for (int bj = 0; bj < 2; ++bj) { const int jl = (bj * 4 + wc) * 16 + 4 * fq;
                                cx.b0[bj] = *(const PG8_LAS f32x4*)(cxl + jl * 4); cx.b1[bj] = *(const PG8_LAS f32x4*)(cxl + 512 + jl * 4); }
                            return cx; };
                    auto stg = [=](const pg8::Unit& u, PG8_LAS unsigned char* cb, int wid, int lane) {
                            if (wid == 0) { const float* src = bgu_all + (size_t)(layer * 32 + u.aux) * 2048 + (lane >> 5) * 1024 + u.pn * 128 + (lane & 31) * 4;
                                __builtin_amdgcn_global_load_lds((const unsigned*)src, (PG8_LAS unsigned*)cb, 16, 0, 0); } };
                    auto f = [=](const pg8::Unit& u, const G1Ctx& cx, int ai, int m, int bj, int tr, int c, f32x4 v0, f32x4 v1, PG8_LAS unsigned char* tile) {
                            const int jl = (c >> 5) * 16 + (c & 15);
                            const f32x4 b0 = cx.b0[bj], b1 = cx.b1[bj];
                            typedef float f32x2 __attribute__((ext_vector_type(2)));
                            float o[4];
#pragma unroll
                            for (int q = 0; q < 2; ++q) {
                                f32x2 gt = (f32x2){v0[2 * q], v0[2 * q + 1]} + (f32x2){b0[2 * q], b0[2 * q + 1]};
                                f32x2 ln = (f32x2){v1[2 * q], v1[2 * q + 1]} + (f32x2){b1[2 * q], b1[2 * q + 1]};
                                gt.x = __builtin_amdgcn_fmed3f(gt.x, -INFINITY, 7.0f); gt.y = __builtin_amdgcn_fmed3f(gt.y, -INFINITY, 7.0f);
                                ln.x = __builtin_amdgcn_fmed3f(ln.x, -7.0f, 7.0f); ln.y = __builtin_amdgcn_fmed3f(ln.y, -7.0f, 7.0f);
                                const f32x2 t = gt * (-1.702f * 1.4426950408889634f);
                                f32x2 e; e.x = __builtin_amdgcn_exp2f(t.x); e.y = __builtin_amdgcn_exp2f(t.y);
                                const f32x2 d = e + 1.0f;
                                f32x2 r; r.x = __builtin_amdgcn_rcpf(d.x); r.y = __builtin_amdgcn_rcpf(d.y);
                                const f32x2 ov = (gt * r) * (ln + 1.0f);
                                o[2 * q] = ov.x; o[2 * q + 1] = ov.y;
                            }
                            *(PG8_LAS unsigned*)(tile + tr * 144 + jl) = pk4_fp8(o[0], o[1], o[2], o[3]);
                        };
                    auto fl = [=](const pg8::Unit& u, const G1Ctx&, int ai, int m0, int tid_, PG8_LAS unsigned char* tile) {
                            const int tr = tid_ >> 3, piece = tid_ & 7;
                            const u32x4 v = *(const PG8_LAS u32x4*)(tile + tr * 144 + piece * 16);
                            const int row = u.pm * 256 + ai * 128 + ((tr >> 4) & 1) * 64 + (m0 + (tr >> 5)) * 16 + (tr & 15);
                            *(u32x4*)(ACT + (size_t)row * D + u.pn * 128 + piece * 16) = v;
                        };
                    pg8::gemm_phase<true, true>(tid, (PG8_LAS unsigned char*)lds, pg8::Gemm{(const bf16_t*)HB8, (const bf16_t*)W_GU, 512, 512, 512}, so, pg8::make_epi_staged<2, 9216>(pre, f, fl), stg, LDS_CTX_OFF);
                }
            } else {
                {
                    MoeOrder so; so.go.init(total_rows >> 8, 4, G, vb); so.pst = pst; so.NT = 4; so.ebase = layer * 32; so.el_slot = EL_SLOT;
                    struct G2Ctx { float gate[8]; int slot[8]; f32x4 bb[2][2]; };
                    auto pre = [=](const pg8::Unit& u, int wr, int wc, int fr, int fq, const PG8_LAS unsigned char* cxl) {
                            G2Ctx cx;
                            const int ro0 = u.pm * 256 - pst[u.aux], cnt = pst[64 + u.aux];
#pragma unroll
                            for (int q = 0; q < 8; ++q) { const int rl = (q >> 2) * 128 + wr * 64 + (q & 3) * 16 + fr; const bool ok = ro0 + rl < cnt;
                                const float gv = *(const PG8_LAS float*)(cxl + 1024 + rl * 4); const int sv = *(const PG8_LAS int*)(cxl + 2048 + rl * 4);
                                cx.gate[q] = ok ? gv : 0.f; cx.slot[q] = ok ? sv : -1; }
#pragma unroll
                            for (int bj = 0; bj < 2; ++bj)
#pragma unroll
                                for (int h = 0; h < 2; ++h) cx.bb[bj][h] = *(const PG8_LAS f32x4*)(cxl + (bj * 128 + wc * 32 + 8 * fq + 4 * h) * 4);
                            return cx; };
                    auto stg = [=](const pg8::Unit& u, PG8_LAS unsigned char* cb, int wid, int lane) {
                            const size_t eo = (size_t)u.aux * T + (u.pm * 256 - pst[u.aux]) + lane * 4;
                            if (wid == 0) __builtin_amdgcn_global_load_lds((const unsigned*)(bdn_all + (size_t)(layer * 32 + u.aux) * 1024 + u.pn * 256 + lane * 4), (PG8_LAS unsigned*)cb, 16, 0, 0);
                            else if (wid == 1) __builtin_amdgcn_global_load_lds((const unsigned*)(EL_GATE + eo), (PG8_LAS unsigned*)(cb + 1024), 16, 0, 0);
                            else if (wid == 2) __builtin_amdgcn_global_load_lds((const unsigned*)(EL_SLOT + eo), (PG8_LAS unsigned*)(cb + 2048), 16, 0, 0); };
                    auto f = [=](const pg8::Unit& u, const G2Ctx& cx, int ai, int m, int bj, int r, int c8, f32x4 v0, f32x4 v1) {
                            const int slot = cx.slot[ai * 4 + m];
                            if (slot >= 0) {
                                const float gt = cx.gate[ai * 4 + m]; const f32x4 b0 = cx.bb[bj][0], b1 = cx.bb[bj][1];
                                u32x4 o; o.x = pk2((v0.x + b0.x) * gt, (v0.y + b0.y) * gt); o.y = pk2((v0.z + b0.z) * gt, (v0.w + b0.w) * gt);
                                o.z = pk2((v1.x + b1.x) * gt, (v1.y + b1.y) * gt); o.w = pk2((v1.z + b1.z) * gt, (v1.w + b1.w) * gt);
                                *(u32x4*)(Y + (size_t)slot * D + u.pn * 256 + c8) = o;
                            }
                        };
                    pg8::gemm_phase<true, false, true>(tid, (PG8_LAS unsigned char*)lds, pg8::Gemm{(const bf16_t*)ACT, (const bf16_t*)W_DN, 512, 512, 512}, so, pg8::make_epi_perm(pre, f), stg, LDS_CTX_OFF);
                }
            }
        }
        else if (ph == 13) {
            {
                DenseOrder so; so.go.init(T / 256, 6, G, vb);
                auto f = [=](const pg8::Unit& u, const pg8::NoCtx&, int ai, int m, int bj, int r, int c, f32x4 v0, f32x4 v1) {
                        const int row = u.pm * 256 + r, col = u.pn * 256 + c;
                        if (col >= 512) { v0.x = gelu_tanh(v0.x); v0.y = gelu_tanh(v0.y); v0.z = gelu_tanh(v0.z); v0.w = gelu_tanh(v0.w); v1.x = gelu_tanh(v1.x); v1.y = gelu_tanh(v1.y); v1.z = gelu_tanh(v1.z); v1.w = gelu_tanh(v1.w); }
                        u32x4 o; o.x = pk2(v0.x, v0.y); o.y = pk2(v0.z, v0.w); o.z = pk2(v1.x, v1.y); o.w = pk2(v1.z, v1.w);
                        *(u32x4*)(Z + (size_t)row * 1536 + col) = o;
                    };
                pg8::gemm_phase<false, false, true>(tid, (PG8_LAS unsigned char*)lds, pg8::Gemm{HB, W_IN_O, D, D, D}, so, pg8::make_epi_perm(pg8::NoPre{}, f));
            }
        }
        else if (ph == 14) {
            for (int ck = vb; ck < T / 128; ck += G) {
                bf16_t* tile = (bf16_t*)lds;
                {
                    const int ch0 = lane * 8, w = 2 << (ch0 >> 7);
                    const int row0 = ck * 128 + wave * 16, t0 = row0 % S;
                    float gsg[8];
#pragma unroll
                    for (int i = 0; i < 8; ++i) gsg[i] = kp->sgu_norm_g[lane * 8 + i];
                    float run[8];
#pragma unroll
                    for (int i = 0; i < 8; ++i) run[i] = 0.f;
                    for (int q = 1; q <= w; ++q) {
                        if (t0 - q >= 0) { float f[8]; unpack8(*(const u32x4*)(Z + (size_t)(row0 - q) * 1536 + ch0), f);
#pragma unroll
                            for (int i = 0; i < 8; ++i) run[i] += f[i]; }
                    }
                    u32x4 cu, cl, cz, nu, nl, nz;
#define P14_LOAD(r_, t_, U_, L_, Z_) do { U_ = *(const u32x4*)(Z + (size_t)(r_) * 1536 + ch0); L_ = ((t_) - w >= 0) ? *(const u32x4*)(Z + (size_t)((r_) - w) * 1536 + ch0) : (u32x4){0u, 0u, 0u, 0u}; \
                        Z_ = *(const u32x4*)(Z + (size_t)(r_) * 1536 + 1024 + lane * 8); } while (0)
                    P14_LOAD(row0, t0, cu, cl, cz);
                    for (int tt = 0; tt < 16; ++tt) {
                        const int sl = wave * 16 + tt, row = row0 + tt, t = t0 + tt;
                        if (tt + 1 < 16) P14_LOAD(row + 1, t + 1, nu, nl, nz);
                        float own[8], old[8];
                        unpack8(cu, own); unpack8(cl, old);
#pragma unroll
                        for (int i = 0; i < 8; ++i) run[i] += own[i] - old[i];
                        const int n = (t + 1 < w) ? t + 1 : w;
                        const float inv = 1.0f / (float)n;
                        float po[8];
#pragma unroll
                        for (int i = 0; i < 8; ++i) po[i] = run[i] * inv - own[i];
                        *(u32x4*)(POOLED + (size_t)row * 512 + ch0) = pack8(po);
                        float f[8]; unpack8(cz, f);
                        float ss = 0.f;
#pragma unroll
                        for (int i = 0; i < 8; ++i) ss += f[i] * f[i];
                        const float rr = rsqrtf(wave_sum(ss) * (1.f / 512.f) + 1e-6f);
#pragma unroll
                        for (int i = 0; i < 8; ++i) f[i] *= rr * gsg[i];
                        *(u32x4*)(tile + sl * 520 + lane * 8) = pack8(f);
                        cu = nu; cl = nl; cz = nz;
                    }
#undef P14_LOAD
                }
                __syncthreads();
                {
                    const int ch = tid;
                    bf16_t* dst = VTS + ((size_t)ck * 512 + ch) * 128;
                    for (int s8 = 0; s8 < 16; ++s8) {
                        unsigned w[4];
#pragma unroll
                        for (int i = 0; i < 4; ++i) w[i] = (unsigned)tile[(s8 * 8 + 2 * i) * 520 + ch] | ((unsigned)tile[(s8 * 8 + 2 * i + 1) * 520 + ch] << 16);
                        u32x4 o; o.x = w[0]; o.y = w[1]; o.z = w[2]; o.w = w[3];
                        *(u32x4*)(dst + s8 * 8) = o;
                    }
                }
                __syncthreads();
            }
        }
        else if (ph == 15) {
            for (int u = vb; u < 2048; u += G) {
                if (u < 1024) {
                    const int pm = u >> 2, gi = u & 3;
                    sg_tile(tid, lds, POOLED + (size_t)pm * 128 * 512 + gi * 128, 512, W_POOL + (size_t)gi * 128 * 128, 128, 128,
                        [=](int r, int c, f32x4 v0, f32x4 v1) {
                            const int row = pm * 128 + r;
#pragma unroll
                            for (int h = 0; h < 2; ++h) {
                                const int col = gi * 128 + c + 16 * h; const f32x4 v = h ? v1 : v0;
                                const f32x4 sc = *(const f32x4*)(poolsc + col);
                                u32x2 o; o.x = pk2(v.x * sc.x, v.y * sc.y); o.y = pk2(v.z * sc.z, v.w * sc.w);
                                *(u32x2*)(MIXIN + (size_t)row * 1024 + col) = o;
                            }
                        });
                } else {
                    const int uu = u - 1024, ck = uu >> 2, h4 = uu & 3;
                    sg_tile(tid, lds, W_SGU + (size_t)h4 * 128 * 128, 128, VTS + ((size_t)ck * 512 + h4 * 128) * 128, 128, 128,
                        [=](int r, int c, f32x4 v0, f32x4 v1) {
                            const int row = ck * 128 + r;
                            const float bias = sgub[h4 * 128 + r];
#pragma unroll
                            for (int h = 0; h < 2; ++h) {
                                const int dcol = c + 16 * h; const f32x4 v = h ? v1 : v0;
                                const u32x2 ug = *(const u32x2*)(Z + (size_t)row * 1536 + 512 + h4 * 128 + dcol);
                                u32x2 o; o.x = pk2((v.x + bias) * __uint_as_float(ug.x << 16), (v.y + bias) * __uint_as_float(ug.x & 0xffff0000u));
                                o.y = pk2((v.z + bias) * __uint_as_float(ug.y << 16), (v.w + bias) * __uint_as_float(ug.y & 0xffff0000u));
                                *(u32x2*)(MIXIN + (size_t)row * 1024 + 512 + h4 * 128 + dcol) = o;
                            }
                        });
                }
            }
        }

    }
}
template <int PH> struct PhaseSeq {
    static __device__ __forceinline__ void run(const XcdBarrier& bar) { PhaseSeq<PH - 1>::run(bar); if constexpr (PH == 3) return;
        unsigned long long t0_ = 0; if constexpr (PH == PROBE_TPH) t0_ = __builtin_amdgcn_s_memrealtime();
        phase_body<PH>(bar.wbase);
        if constexpr (((PROBE_DUP_MASK >> PH) & 1ull) != 0) { xcd_barrier(bar); phase_body<PH>(bar.wbase); }
        if (PH + 1 < NPHASE) { xcd_barrier(bar); if constexpr (PROBE_BAR2) xcd_barrier(bar); }
        if constexpr (PH == PROBE_TPH) { if (bar.wbase == 0 && lane_id() == 0) { const unsigned dt = (unsigned)(__builtin_amdgcn_s_memrealtime() - t0_); bar.st[4] = dt; } }
    }
};
template <> struct PhaseSeq<-1> { static __device__ __forceinline__ void run(const XcdBarrier&) {} };

template <int PHSEL> __global__ void __launch_bounds__(NTHR, 2) hybrid_fwd(Params p) {
    extern __shared__ __attribute__((aligned(16))) unsigned char lds[];
    const int tid0 = threadIdx.x;
    for (int u = tid0; u < (LDS_BYTES - LDS_MISC) / 4; u += NTHR) ((unsigned*)(lds + LDS_MISC))[u] = 0u;
    __syncthreads();
    if constexpr (PHSEL >= 0) { phase_body<PHSEL>(__builtin_amdgcn_readfirstlane((int)threadIdx.x & ~63)); }
    else {
        volatile LAS unsigned* MISC = (volatile LAS unsigned*)((LAS unsigned char*)lds + LDS_MISC);
        unsigned* ctl0 = (unsigned*)(p.ws + WS_CTL);
        XcdBarrier bar = xcd_barrier_post(ctl0 + CW_BAR, MISC + 8);
        PhaseSeq<NPHASE - 1>::run(bar);
        if constexpr (PROBE_TPH >= 0 || PROBE_SEG != 0) { if (blockIdx.x == 0 && bar.wbase == 0 && lane_id() == 0) { const unsigned dt = MISC[12]; const unsigned long long te = __builtin_amdgcn_s_memrealtime(); while (__builtin_amdgcn_s_memrealtime() - te < 4ull * dt) __builtin_amdgcn_s_sleep(8); } }
    }
}

typedef void (*kfn_t)(Params);
template <int PH> struct Tab { static void fill(kfn_t* t) { t[PH] = hybrid_fwd<PH>; Tab<PH - 1>::fill(t); } };
template <> struct Tab<-1> { static void fill(kfn_t*) {} };
static kfn_t g_tab[NPHASE];
static void set_attrs() {
#if MK_ONE_LAUNCH
    (void)hipFuncSetAttribute((const void*)hybrid_fwd<-1>, hipFuncAttributeMaxDynamicSharedMemorySize, LDS_BYTES);
#else
    Tab<NPHASE - 1>::fill(g_tab);
    for (int i = 0; i < NPHASE; ++i) (void)hipFuncSetAttribute((const void*)g_tab[i], hipFuncAttributeMaxDynamicSharedMemorySize, LDS_BYTES);
#endif
}
#if !MK_ONE_LAUNCH
static void launch_all(const Params& p, int grid, hipStream_t stream) {
    for (int ph = 0; ph < NPHASE; ++ph) hipLaunchKernelGGL(g_tab[ph], dim3(grid), dim3(NTHR), LDS_BYTES, stream, p);
}
#endif
extern "C" void kernel_launch(void* const* d_in, const int* in_sizes, int n_in, void* d_out, int out_size, void* d_ws, size_t ws_size, hipStream_t stream) {
    static int ready = 0;
    if (ready == 0) {
        if (n_in != 38 || ws_size < WS_END) { fprintf(stderr, "kernel_launch: unexpected n_in %d / ws %zu\n", n_in, ws_size); ready = -1; return; }
        set_attrs();
        ready = 1;
    }
    if (ready < 0) return;
    (void)hipMemsetAsync((char*)d_ws + WS_CTL, 0, CTL_ZERO_BYTES, stream);
    Params p{};
    const float** fp = (const float**)&p.x;
    (void)fp;
    p.x = (const float*)d_in[0]; p.c = (const float*)d_in[1]; p.pos = (const int*)d_in[2];
    p.ada_w = (const float*)d_in[3]; p.ada_b = (const float*)d_in[4]; p.norm_mix_g = (const float*)d_in[5]; p.norm_ffn_g = (const float*)d_in[6];
    p.router_w = (const float*)d_in[7]; p.router_b = (const float*)d_in[8]; p.moe_w_gu = (const float*)d_in[9]; p.moe_b_gu = (const float*)d_in[10];
    p.moe_w_dn = (const float*)d_in[11]; p.moe_b_dn = (const float*)d_in[12];
    p.even_w_in = (const float*)d_in[13]; p.q_norm_g = (const float*)d_in[14]; p.w_uq = (const float*)d_in[15]; p.kv_norm_g = (const float*)d_in[16];
    p.w_ukv = (const float*)d_in[17]; p.q_head_g = (const float*)d_in[18]; p.k_head_g = (const float*)d_in[19];
    p.s5_a_re = (const float*)d_in[20]; p.s5_a_im = (const float*)d_in[21]; p.s5_log_dt = (const float*)d_in[22]; p.s5_b_re = (const float*)d_in[23];
    p.s5_b_im = (const float*)d_in[24]; p.s5_c_re = (const float*)d_in[25]; p.s5_c_im = (const float*)d_in[26]; p.s5_d = (const float*)d_in[27];
    p.s5_glu_w = (const float*)d_in[28]; p.s5_glu_b = (const float*)d_in[29]; p.even_w_out = (const float*)d_in[30];
    p.odd_w_in = (const float*)d_in[31]; p.pool_w = (const float*)d_in[32]; p.pool_scale = (const float*)d_in[33]; p.sgu_norm_g = (const float*)d_in[34];
    p.sgu_w = (const float*)d_in[35]; p.sgu_b = (const float*)d_in[36]; p.odd_w_out = (const float*)d_in[37];
    p.out = (float*)d_out; p.ws = (unsigned char*)d_ws;
    const int grid = 256;
#if MK_ONE_LAUNCH
    p.ph_lo = 0; p.ph_hi = NPHASE;
    hipLaunchKernelGGL(hybrid_fwd<-1>, dim3(grid), dim3(NTHR), LDS_BYTES, stream, p);
#else
    p.ph_lo = 0; p.ph_hi = 1;
    launch_all(p, grid, stream);
#endif
}
```

```cpp
#include <hip/hip_runtime.h>
#include <cstdio>
#include <cstdint>

#ifndef PROBE_DUP_MASK
#define PROBE_DUP_MASK 0x0ull
#endif
#ifndef PROBE_ATT2
#define PROBE_ATT2 0
#endif
#ifndef PROBE_RT2
#define PROBE_RT2 0
#endif
#ifndef PROBE_TPH
#define PROBE_TPH -1
#endif
#ifndef PROBE_SEG
#define PROBE_SEG 0
#endif
#ifndef PROBE_BAR2
#define PROBE_BAR2 0
#endif
#ifndef PROBE_EPI2
#define PROBE_EPI2 0
#endif
#ifndef PROBE_KX2
#define PROBE_KX2 0
#endif
#ifndef MK_ONE_LAUNCH
#define MK_ONE_LAUNCH 1
#endif

typedef unsigned short bf16_t;
typedef short bf16x8 __attribute__((ext_vector_type(8)));
typedef short s16x4 __attribute__((ext_vector_type(4)));
typedef float f32x4 __attribute__((ext_vector_type(4)));
typedef float f32x16 __attribute__((ext_vector_type(16)));
typedef unsigned u32x4 __attribute__((ext_vector_type(4)));
typedef unsigned u32x2 __attribute__((ext_vector_type(2)));

constexpr int D = 1024, NB = 8, S = 4096, T = NB * S;
constexpr int NTHR = 512, NWAVE = 8;
constexpr int MOE_ROWS = 139264;
constexpr int NPHASE = 21;

constexpr size_t MiB = 1u << 20;
constexpr size_t WS_CTL = 0, CTL_ZERO_BYTES = 1 * MiB;
constexpr size_t WS_MOD = 1 * MiB;
constexpr size_t WS_S5AB = 2 * MiB;
constexpr size_t WS_PW = 3 * MiB;
constexpr size_t WS_KTAB = 5 * MiB;
constexpr size_t WS_TOK = 7 * MiB;
constexpr size_t WS_ROW = 9 * MiB;
constexpr size_t WS_LOGIT = 11 * MiB;
constexpr size_t WS_W_IN_E = 16 * MiB, WS_W_UP = 18 * MiB  , WS_W_GLU = 20 * MiB, WS_W_OUT_E = 21 * MiB, WS_W_IN_O = 23 * MiB,
                 WS_W_OUT_O = 26 * MiB, WS_W_POOL = 28 * MiB, WS_W_SGU = 29 * MiB, WS_W_RT = 30 * MiB;
constexpr size_t WS_BT_END = 32 * MiB;
constexpr size_t WS_BT_MAIN = 40 * MiB;
constexpr size_t WS_W_GU = 112 * MiB;
constexpr size_t WS_W_DN = 240 * MiB;
constexpr size_t WS_HB8 = 304 * MiB;
constexpr size_t WS_XR = 336 * MiB;
constexpr size_t WS_HB = 496 * MiB;
constexpr size_t WS_MIXIN = 560 * MiB;
constexpr size_t WS_Y = 624 * MiB;
constexpr size_t WS_EL = 880 * MiB;
constexpr size_t WS_ACT = 1152 * MiB;
constexpr size_t WS_END = 1424 * MiB;
constexpr size_t WS_Z = 880 * MiB;
constexpr size_t WS_RSP = 976 * MiB  , WS_QKVRAW = 1000 * MiB  , WS_Q = 1112 * MiB, WS_K = 1160 * MiB, WS_VT = 1208 * MiB,
                 WS_AS5 = 1240 * MiB, WS_LEND = 1276 * MiB, WS_GACT = 1284 * MiB;
constexpr size_t WS_POOLED = 976 * MiB, WS_VTS = 1008 * MiB;
constexpr int CW_BAR = 4096, CW_CNT = 16384;

constexpr int LDS_BYTES = 160 * 1024;
constexpr int LDS_CTX_OFF = 18432;
constexpr int LDS_MISC = 158 * 1024;

struct Params {
    const float *x, *c; const int* pos;
    const float *ada_w, *ada_b, *norm_mix_g, *norm_ffn_g, *router_w, *router_b, *moe_w_gu, *moe_b_gu, *moe_w_dn, *moe_b_dn;
    const float *even_w_in, *q_norm_g, *w_uq, *kv_norm_g, *w_ukv, *q_head_g, *k_head_g;
    const float *s5_a_re, *s5_a_im, *s5_log_dt, *s5_b_re, *s5_b_im, *s5_c_re, *s5_c_im, *s5_d, *s5_glu_w, *s5_glu_b, *even_w_out;
    const float *odd_w_in, *pool_w, *pool_scale, *sgu_norm_g, *sgu_w, *sgu_b, *odd_w_out;
    float* out; unsigned char* ws; int ph_lo, ph_hi;
};

__device__ __forceinline__ float bf2f(unsigned short b) { return __uint_as_float(((unsigned)b) << 16); }
__device__ __forceinline__ unsigned pk2(float lo, float hi) {
    typedef float f2 __attribute__((ext_vector_type(2))); typedef __bf16 b2 __attribute__((ext_vector_type(2)));
    f2 v = {lo, hi}; b2 b = __builtin_convertvector(v, b2); return __builtin_bit_cast(unsigned, b);
}
__device__ __forceinline__ unsigned short f2bf(float f) { return (unsigned short)(pk2(f, 0.f) & 0xffffu); }
__device__ __forceinline__ float wave_sum(float v) {
#pragma unroll
    for (int o = 1; o < 64; o <<= 1) v += __shfl_xor(v, o);
    return v;
}
__device__ __forceinline__ float sigmoidf_(float x) { return __builtin_amdgcn_rcpf(1.0f + __builtin_amdgcn_exp2f(-1.4426950408889634f * x)); }
__device__ __forceinline__ float gelu_tanh(float x) {
    const float u = 0.7978845608028654f * (x + 0.044715f * x * x * x);
    return x * sigmoidf_(2.0f * u);
}
__device__ __forceinline__ unsigned pk4_fp8(float a, float b, float c, float d) {
    int w = 0; w = __builtin_amdgcn_cvt_pk_fp8_f32(a, b, w, false); w = __builtin_amdgcn_cvt_pk_fp8_f32(c, d, w, true); return (unsigned)w;
}
__device__ __forceinline__ int crow(int r, int hi) { return (r & 3) + 8 * (r >> 2) + 4 * hi; }

#define LAS __attribute__((address_space(3)))
#define XB_TMO      128
#define XB_XCNT(j)  (256  + 64 * (j))
#define XB_XSUB(j)  (1280 + 64 * (j))
#define XB_XGEN(j)  (2304 + 64 * (j))
#define XB_TOP      3328
#define XB_TOPGEN   3392
#define XCD_BAR_WORDS 3456
#define XB_SPIN_CAP (1u << 20)
__device__ __forceinline__ unsigned xb_ld(unsigned* p)              { return __hip_atomic_load(p, __ATOMIC_RELAXED, __HIP_MEMORY_SCOPE_AGENT); }
__device__ __forceinline__ unsigned xb_add(unsigned* p, unsigned v) { return __hip_atomic_fetch_add(p, v, __ATOMIC_RELAXED, __HIP_MEMORY_SCOPE_AGENT); }
__device__ __forceinline__ unsigned xb_xcc_id() { return (unsigned)__builtin_amdgcn_s_getreg((3 << 11) | 20) & 0xFu; }
#define XB_SPIN(cond, bar) do { unsigned _sp = 0; while (cond) { __builtin_amdgcn_s_sleep(1); \
    if ((++_sp & 255u) == 0u) { if (xb_ld(&(bar)[XB_TMO])) break; if (_sp > XB_SPIN_CAP) { atomicAdd(&(bar)[XB_TMO], 1u); break; } } } } while (0)
struct XcdBarrier { unsigned* bar; unsigned x; volatile LAS unsigned* st; int wbase; };
__device__ __forceinline__ int lane_id() { int l; asm volatile("v_mbcnt_lo_u32_b32 %0, -1, 0\n\tv_mbcnt_hi_u32_b32 %0, -1, %0" : "=v"(l)); return l; }
__device__ __forceinline__ XcdBarrier xcd_barrier_post(unsigned* bar, volatile LAS unsigned* st) {
    XcdBarrier b; b.bar = bar; b.x = xb_xcc_id(); b.st = st; b.wbase = __builtin_amdgcn_readfirstlane((int)threadIdx.x & ~63);
    if (threadIdx.x == 0) (void)xb_add(&bar[XB_XCNT(b.x)], 1u);
    return b;
}
__device__ __forceinline__ void xcd_barrier_complete(unsigned* bar, unsigned x, unsigned& nloc, unsigned& nx) {
    const unsigned G = gridDim.x * gridDim.y * gridDim.z;
    unsigned sum, cnt, mine, sp = 0u;
    for (;;) {
        sum = 0u; cnt = 0u; mine = 0u;
#pragma unroll
        for (unsigned j = 0; j < 16; ++j) { const unsigned c = xb_ld(&bar[XB_XCNT(j)]); sum += c; cnt += (c > 0u) ? 1u : 0u; mine = (j == x) ? c : mine; }
        if (sum == G) break;
        __builtin_amdgcn_s_sleep(1);
        if ((++sp & 255u) == 0u) { if (xb_ld(&bar[XB_TMO])) break; if (sp > XB_SPIN_CAP) { atomicAdd(&bar[XB_TMO], 1u); break; } }
    }
    nloc = mine > 0u ? mine : 1u; nx = cnt > 0u ? cnt : 1u;
}
__device__ __forceinline__ void xcd_barrier(const XcdBarrier& b) {
    asm volatile("s_waitcnt vmcnt(0)" ::: "memory");
    __syncthreads();
    if (b.wbase == 0 && lane_id() == 0) {
        unsigned* bar = b.bar;
        __builtin_amdgcn_s_waitcnt(0);
        unsigned nloc = b.st[0], nx = b.st[1];
        if (nloc == 0u) { xcd_barrier_complete(bar, b.x, nloc, nx); b.st[0] = nloc; b.st[1] = nx; }
        const unsigned old = xb_add(&bar[XB_XSUB(b.x)], 1u);
        const unsigned gen = old / nloc;
        if (old + 1u == (gen + 1u) * nloc) {
            __builtin_amdgcn_fence(__ATOMIC_RELEASE, "agent");
            asm volatile("s_waitcnt vmcnt(0)" ::: "memory");
            const unsigned og = xb_add(&bar[XB_TOP], 1u);
            const unsigned tg = og / nx;
            if (og + 1u == (tg + 1u) * nx) xb_add(&bar[XB_TOPGEN], 1u);
            else XB_SPIN(xb_ld(&bar[XB_TOPGEN]) == tg, bar);
            __builtin_amdgcn_fence(__ATOMIC_ACQUIRE, "agent");
            xb_add(&bar[XB_XGEN(b.x)], 1u);
            asm volatile("s_waitcnt vmcnt(0)" ::: "memory");
        } else {
            XB_SPIN(xb_ld(&bar[XB_XGEN(b.x)]) == gen, bar);
            __builtin_amdgcn_fence(__ATOMIC_ACQUIRE, "agent");
            asm volatile("s_waitcnt vmcnt(0)" ::: "memory");
        }
    }
    __syncthreads();
}

constexpr int SG_LDS = 2 * 128 * 144;
template <class Epi>
__device__ __forceinline__ void sg_tile(int tid, unsigned char* lds, const bf16_t* A, int lda, const bf16_t* Bt, int ldb, int K, Epi epi) {
    const int lane = tid & 63, wid = tid >> 6, wr = wid >> 2, wc = wid & 3, fr = lane & 15, fq = lane >> 4;
    unsigned char* As = lds; unsigned char* Bs = lds + 128 * 144;
    f32x4 acc[4][2];
#pragma unroll
    for (int m = 0; m < 4; ++m)
#pragma unroll
        for (int n = 0; n < 2; ++n) acc[m][n] = (f32x4){0.f, 0.f, 0.f, 0.f};
    const int nt = K / 64;
    u32x4 ra[2], rb[2];
    const int r0 = tid >> 3, cc = tid & 7;
#pragma unroll
    for (int i = 0; i < 2; ++i) {
        ra[i] = *(const u32x4*)(A + (size_t)(r0 + 64 * i) * lda + cc * 8);
        rb[i] = *(const u32x4*)(Bt + (size_t)(r0 + 64 * i) * ldb + cc * 8);
    }
    for (int kt = 0; kt < nt; ++kt) {
        __syncthreads();
#pragma unroll
        for (int i = 0; i < 2; ++i) {
            *(u32x4*)(As + (r0 + 64 * i) * 144 + cc * 16) = ra[i];
            *(u32x4*)(Bs + (r0 + 64 * i) * 144 + cc * 16) = rb[i];
        }
        __syncthreads();
        if (kt + 1 < nt) {
#pragma unroll
            for (int i = 0; i < 2; ++i) {
                ra[i] = *(const u32x4*)(A + (size_t)(r0 + 64 * i) * lda + (kt + 1) * 64 + cc * 8);
                rb[i] = *(const u32x4*)(Bt + (size_t)(r0 + 64 * i) * ldb + (kt + 1) * 64 + cc * 8);
            }
        }
#pragma unroll
        for (int kk = 0; kk < 2; ++kk) {
            bf16x8 a[4], b[2];
#pragma unroll
            for (int m = 0; m < 4; ++m) a[m] = *(const bf16x8*)(As + (wr * 64 + m * 16 + fr) * 144 + kk * 64 + fq * 16);
#pragma unroll
            for (int n = 0; n < 2; ++n) b[n] = *(const bf16x8*)(Bs + (wc * 32 + n * 16 + fr) * 144 + kk * 64 + fq * 16);
#pragma unroll
            for (int m = 0; m < 4; ++m)
#pragma unroll
                for (int n = 0; n < 2; ++n) acc[m][n] = __builtin_amdgcn_mfma_f32_16x16x32_bf16(b[n], a[m], acc[m][n], 0, 0, 0);
        }
    }
#pragma unroll
    for (int m = 0; m < 4; ++m) epi(wr * 64 + m * 16 + fr, wc * 32 + fq * 4, acc[m][0], acc[m][1]);
}


namespace pg8 {
#define PG8_LAS __attribute__((address_space(3)))
constexpr int BM = 256, BK = 64, HALF = 128, HTB = HALF * BK * 2, STAGE_BYTES = 8 * HTB;
__device__ __forceinline__ int lds_byte(int r, int c) { const int st = (r >> 4) * 2 + (c >> 5), rr = r & 15, cc = c & 31, ob = rr * 64 + cc * 2; return st * 1024 + (ob ^ (((ob >> 9) & 1) << 5)); }
__device__ __forceinline__ void stage_rc(int b, int& R, int& C) { const int st = b / 1024, sb = b % 1024, swz = sb ^ (((sb >> 9) & 1) << 5); R = (st >> 1) * 16 + swz / 64; C = (st & 1) * 32 + (swz % 64) / 2; }
typedef int v8i_t __attribute__((ext_vector_type(8)));
typedef int v4i_t __attribute__((ext_vector_type(4)));
struct FragT { union { v8i_t v; struct { v4i_t lo, hi; }; }; };
struct Unit { int pm, pb, pn, aux; };
struct Gemm { const bf16_t* A; const bf16_t* Bt; int lda, ldb, K; };
struct NoCtx {};
struct NoPre { __device__ __forceinline__ NoCtx operator()(const Unit&, int, int, int, int, const PG8_LAS unsigned char*) const { return NoCtx{}; } };
struct NoStage { __device__ __forceinline__ void operator()(const Unit&, PG8_LAS unsigned char*, int, int) const {} };
template <class PF, class F> struct Epi {
    PF pre; F f;
    template <class Ctx>
    __device__ __forceinline__ void operator()(const f32x4 (&acc)[2][2][4][2], const Ctx& ctx, const Unit& u, int wr, int wc, int fr, int fq, PG8_LAS unsigned char*, int) const {
#pragma unroll
        for (int ai = 0; ai < 2; ++ai)
#pragma unroll
            for (int m = 0; m < 4; ++m)
#pragma unroll
                for (int bj = 0; bj < 2; ++bj) {
                    f32x4 v0, v1;
                    asm volatile("v_accvgpr_read_b32 %0, %8\n\tv_accvgpr_read_b32 %1, %9\n\tv_accvgpr_read_b32 %2, %10\n\tv_accvgpr_read_b32 %3, %11\n\t"
                                 "v_accvgpr_read_b32 %4, %12\n\tv_accvgpr_read_b32 %5, %13\n\tv_accvgpr_read_b32 %6, %14\n\tv_accvgpr_read_b32 %7, %15"
                                 : "=v"(v0.x), "=v"(v0.y), "=v"(v0.z), "=v"(v0.w), "=v"(v1.x), "=v"(v1.y), "=v"(v1.z), "=v"(v1.w)
                                 : "a"(acc[ai][bj][m][0].x), "a"(acc[ai][bj][m][0].y), "a"(acc[ai][bj][m][0].z), "a"(acc[ai][bj][m][0].w),
                                   "a"(acc[ai][bj][m][1].x), "a"(acc[ai][bj][m][1].y), "a"(acc[ai][bj][m][1].z), "a"(acc[ai][bj][m][1].w));
                    f(u, ctx, ai, m, bj, ai * HALF + wr * 64 + m * 16 + fr, bj * HALF + wc * 32 + 4 * fq, v0, v1);
                }
    }
};
template <class PF, class F> __device__ __forceinline__ Epi<PF, F> make_epi(PF p, F f) { return Epi<PF, F>{p, f}; }
template <class PF, class F> struct EpiPerm {
    PF pre; F f;
    template <class Ctx>
    __device__ __forceinline__ void operator()(const f32x4 (&acc)[2][2][4][2], const Ctx& ctx, const Unit& u, int wr, int wc, int fr, int fq, PG8_LAS unsigned char*, int) const {
#pragma unroll
        for (int ai = 0; ai < 2; ++ai)
#pragma unroll
            for (int m = 0; m < 4; ++m)
#pragma unroll
                for (int bj = 0; bj < 2; ++bj) {
                    f32x4 v0, v1;
                    asm volatile("v_accvgpr_read_b32 %0, %8\n\tv_accvgpr_read_b32 %1, %9\n\tv_accvgpr_read_b32 %2, %10\n\tv_accvgpr_read_b32 %3, %11\n\t"
                                 "v_accvgpr_read_b32 %4, %12\n\tv_accvgpr_read_b32 %5, %13\n\tv_accvgpr_read_b32 %6, %14\n\tv_accvgpr_read_b32 %7, %15"
                                 : "=v"(v0.x), "=v"(v0.y), "=v"(v0.z), "=v"(v0.w), "=v"(v1.x), "=v"(v1.y), "=v"(v1.z), "=v"(v1.w)
                                 : "a"(acc[ai][bj][m][0].x), "a"(acc[ai][bj][m][0].y), "a"(acc[ai][bj][m][0].z), "a"(acc[ai][bj][m][0].w),
                                   "a"(acc[ai][bj][m][1].x), "a"(acc[ai][bj][m][1].y), "a"(acc[ai][bj][m][1].z), "a"(acc[ai][bj][m][1].w));
                    f(u, ctx, ai, m, bj, ai * HALF + wr * 64 + m * 16 + fr, bj * HALF + wc * 32 + 8 * fq, v0, v1);
                }
    }
};
template <class PF, class F> __device__ __forceinline__ EpiPerm<PF, F> make_epi_perm(PF p, F f) { return EpiPerm<PF, F>{p, f}; }
template <bool PERMC, class PF, class F, class RE> struct EpiRow {
    PF pre; F f; RE re;
    template <class Ctx>
    __device__ __forceinline__ void operator()(const f32x4 (&acc)[2][2][4][2], const Ctx& ctx, const Unit& u, int wr, int wc, int fr, int fq, PG8_LAS unsigned char*, int) const {
#pragma unroll
        for (int ai = 0; ai < 2; ++ai)
#pragma unroll
            for (int m = 0; m < 4; ++m) {
                float part = 0.f;
#pragma unroll
                for (int bj = 0; bj < 2; ++bj) {
                    f32x4 v0, v1;
                    asm volatile("v_accvgpr_read_b32 %0, %8\n\tv_accvgpr_read_b32 %1, %9\n\tv_accvgpr_read_b32 %2, %10\n\tv_accvgpr_read_b32 %3, %11\n\t"
                                 "v_accvgpr_read_b32 %4, %12\n\tv_accvgpr_read_b32 %5, %13\n\tv_accvgpr_read_b32 %6, %14\n\tv_accvgpr_read_b32 %7, %15"
                                 : "=v"(v0.x), "=v"(v0.y), "=v"(v0.z), "=v"(v0.w), "=v"(v1.x), "=v"(v1.y), "=v"(v1.z), "=v"(v1.w)
                                 : "a"(acc[ai][bj][m][0].x), "a"(acc[ai][bj][m][0].y), "a"(acc[ai][bj][m][0].z), "a"(acc[ai][bj][m][0].w),
                                   "a"(acc[ai][bj][m][1].x), "a"(acc[ai][bj][m][1].y), "a"(acc[ai][bj][m][1].z), "a"(acc[ai][bj][m][1].w));
                    part += f(u, ctx, ai, m, bj, ai * HALF + wr * 64 + m * 16 + fr, bj * HALF + wc * 32 + (PERMC ? 8 : 4) * fq, v0, v1);
                }
                re(u, ai, m, ai * HALF + wr * 64 + m * 16 + fr, wc, fq, part);
            }
    }
};
template <bool PERMC, class PF, class F, class RE> __device__ __forceinline__ EpiRow<PERMC, PF, F, RE> make_epi_row(PF p, F f, RE r) { return EpiRow<PERMC, PF, F, RE>{p, f, r}; }
template <class PF, class GP, class F> struct EpiG {
    PF pre; GP gp; F f;
    template <class Ctx>
    __device__ __forceinline__ void operator()(const f32x4 (&acc)[2][2][4][2], const Ctx& ctx, const Unit& u, int wr, int wc, int fr, int fq, PG8_LAS unsigned char*, int) const {
        auto gcur = gp(u, ctx, wr * 64 + fr, wc, fq);
#pragma unroll
        for (int ai = 0; ai < 2; ++ai)
#pragma unroll
            for (int m = 0; m < 4; ++m) {
                const int gn = ai * 4 + m + 1;
                auto gnxt = gcur;
                if (gn < 8) gnxt = gp(u, ctx, (gn >> 2) * HALF + wr * 64 + (gn & 3) * 16 + fr, wc, fq);
#pragma unroll
                for (int bj = 0; bj < 2; ++bj) {
                    f32x4 v0, v1;
                    asm volatile("v_accvgpr_read_b32 %0, %8\n\tv_accvgpr_read_b32 %1, %9\n\tv_accvgpr_read_b32 %2, %10\n\tv_accvgpr_read_b32 %3, %11\n\t"
                                 "v_accvgpr_read_b32 %4, %12\n\tv_accvgpr_read_b32 %5, %13\n\tv_accvgpr_read_b32 %6, %14\n\tv_accvgpr_read_b32 %7, %15"
                                 : "=v"(v0.x), "=v"(v0.y), "=v"(v0.z), "=v"(v0.w), "=v"(v1.x), "=v"(v1.y), "=v"(v1.z), "=v"(v1.w)
                                 : "a"(acc[ai][bj][m][0].x), "a"(acc[ai][bj][m][0].y), "a"(acc[ai][bj][m][0].z), "a"(acc[ai][bj][m][0].w),
                                   "a"(acc[ai][bj][m][1].x), "a"(acc[ai][bj][m][1].y), "a"(acc[ai][bj][m][1].z), "a"(acc[ai][bj][m][1].w));
                    f(u, ctx, gcur, ai, m, bj, ai * HALF + wr * 64 + m * 16 + fr, bj * HALF + wc * 32 + 4 * fq, v0, v1);
                }
                gcur = gnxt;
            }
    }
};
template <class PF, class GP, class F> __device__ __forceinline__ EpiG<PF, GP, F> make_epi_g(PF p, GP g, F f) { return EpiG<PF, GP, F>{p, g, f}; }
template <int MG, int TILE_BYTES, class PF, class F, class FL> struct EpiStaged {
    PF pre; F f; FL flush;
    template <class Ctx>
    __device__ __forceinline__ void operator()(const f32x4 (&acc)[2][2][4][2], const Ctx& ctx, const Unit& u, int wr, int wc, int fr, int fq, PG8_LAS unsigned char* tile, int tid) const {
#pragma unroll
        for (int ai = 0; ai < 2; ++ai)
#pragma unroll
            for (int m = 0; m < 4; ++m) {
#pragma unroll
                for (int bj = 0; bj < 2; ++bj) {
                    f32x4 v0, v1;
                    asm volatile("v_accvgpr_read_b32 %0, %8\n\tv_accvgpr_read_b32 %1, %9\n\tv_accvgpr_read_b32 %2, %10\n\tv_accvgpr_read_b32 %3, %11\n\t"
                                 "v_accvgpr_read_b32 %4, %12\n\tv_accvgpr_read_b32 %5, %13\n\tv_accvgpr_read_b32 %6, %14\n\tv_accvgpr_read_b32 %7, %15"
                                 : "=v"(v0.x), "=v"(v0.y), "=v"(v0.z), "=v"(v0.w), "=v"(v1.x), "=v"(v1.y), "=v"(v1.z), "=v"(v1.w)
                                 : "a"(acc[ai][bj][m][0].x), "a"(acc[ai][bj][m][0].y), "a"(acc[ai][bj][m][0].z), "a"(acc[ai][bj][m][0].w),
                                   "a"(acc[ai][bj][m][1].x), "a"(acc[ai][bj][m][1].y), "a"(acc[ai][bj][m][1].z), "a"(acc[ai][bj][m][1].w));
                    f(u, ctx, ai, m, bj, (m % MG) * 32 + wr * 16 + fr, bj * HALF + wc * 32 + 4 * fq, v0, v1, tile + (((ai * 4 + m) / MG) & 1) * TILE_BYTES);
                }
                if ((m % MG) == MG - 1) {
                    asm volatile("s_waitcnt lgkmcnt(0)" ::: "memory"); __builtin_amdgcn_s_barrier(); asm volatile("" ::: "memory");
                    flush(u, ctx, ai, m - (MG - 1), tid, tile + (((ai * 4 + m) / MG) & 1) * TILE_BYTES);
                }
            }
    }
};
template <int MG, int TILE_BYTES, class PF, class F, class FL> __device__ __forceinline__ EpiStaged<MG, TILE_BYTES, PF, F, FL> make_epi_staged(PF p, F f, FL fl) { return EpiStaged<MG, TILE_BYTES, PF, F, FL>{p, f, fl}; }
__host__ __device__ __forceinline__ int perm32(int rho) { const int n = rho >> 4, i = rho & 15; return 8 * (i >> 2) + 4 * n + (i & 3); }
template <bool FP8 = false, bool GATHER = false, bool PERM = false, class EpiT, class Sched, class StageT = NoStage>
__device__ __forceinline__ void gemm_phase(int tid, PG8_LAS unsigned char* lds, const Gemm g, const Sched& S, const EpiT& E, const StageT& SC = NoStage{}, int ctx_off = 0) {
    const int wid = __builtin_amdgcn_readfirstlane(tid >> 6), lane = tid & 63, wr = wid >> 2, wc = wid & 3, fr = lane & 15, fq = lane >> 4;
    int K = g.K; asm volatile("" : "+s"(K));
    const int nt = K / BK;
    unsigned voffA[2], voffB[2];
    int Rl[2], Cl[2];
#pragma unroll
    for (int i = 0; i < 2; ++i) { int R, C; stage_rc(tid * 16 + i * 8192, R, C); Rl[i] = R; Cl[i] = C; voffA[i] = (unsigned)(R * g.lda + C) * 2u; const int Rb = PERM ? ((R & ~31) + perm32(R & 31)) : R; voffB[i] = (unsigned)(Rb * g.ldb + C) * 2u; }
    unsigned gA00 = 0, gA01 = 0, gA10 = 0, gA11 = 0, gN00 = 0, gN01 = 0, gN10 = 0, gN11 = 0;
    const size_t kstep = (size_t)(BK * 2);
    const size_t hstepA = (size_t)HALF * g.lda * 2, hstepB = (size_t)HALF * g.ldb * 2;
    const size_t tstepA = 2 * hstepA, tstepB = 2 * hstepB;
    const unsigned ldsw = (unsigned)wid * 1024u;
    const int aoff = lds_byte(wr * 64 + fr, fq * 8), boff = lds_byte(wc * 32 + fr, fq * 8);
#define PG8_SA(b, h) (((b) * 2 + (h)) * HTB)
#define PG8_SB(b, h) ((4 + (b) * 2 + (h)) * HTB)
#define PG8_STAGE(bufoff, gbase, voff) do { _Pragma("unroll") for (int _i = 0; _i < 2; ++_i) \
        __builtin_amdgcn_global_load_lds((const unsigned*)((const char*)(gbase) + (voff)[_i]), (PG8_LAS unsigned*)(lds + (bufoff) + ldsw + _i * 8192), 16, 0, 0); } while (0)
#define PG8_LDA(dst, b, h) do { _Pragma("unroll") for (int m = 0; m < 4; ++m) { dst[m].lo = *(const PG8_LAS v4i_t*)(lds + PG8_SA(b, h) + aoff + m * 2048); dst[m].hi = *(const PG8_LAS v4i_t*)(lds + PG8_SA(b, h) + aoff + m * 2048 + 1024); } } while (0)
#define PG8_LDB(dst, b, h) do { _Pragma("unroll") for (int n = 0; n < 2; ++n) { dst[n].lo = *(const PG8_LAS v4i_t*)(lds + PG8_SB(b, h) + boff + n * 2048); dst[n].hi = *(const PG8_LAS v4i_t*)(lds + PG8_SB(b, h) + boff + n * 2048 + 1024); } } while (0)
#define PG8_MMA(ai, bj, At, Bt) do { __builtin_amdgcn_s_setprio(1); asm volatile("s_nop 1" ::: "memory");     \
        _Pragma("unroll") for (int m = 0; m < 4; ++m) _Pragma("unroll") for (int n = 0; n < 2; ++n) { \
        if constexpr (FP8) { asm volatile("v_mfma_scale_f32_16x16x128_f8f6f4 %0, %1, %2, %0, %3, %4 op_sel_hi:[0,0,0]" : "+a"(acc[ai][bj][m][n]) : "v"(Bt[n].v), "v"(At[m].v), "v"(scw), "v"(scx)); } \
        else { asm volatile("v_mfma_f32_16x16x32_bf16 %0, %1, %2, %0\n\tv_mfma_f32_16x16x32_bf16 %0, %3, %4, %0" : "+a"(acc[ai][bj][m][n]) : "v"(Bt[n].lo), "v"(At[m].lo), "v"(Bt[n].hi), "v"(At[m].hi)); } } \
        __builtin_amdgcn_s_setprio(0); } while (0)
#define PG8_WAIT_V(n) asm volatile("s_waitcnt vmcnt(" #n ")" ::: "memory")
#define PG8_WAIT_L(n) asm volatile("s_waitcnt lgkmcnt(" #n ")" ::: "memory")
#define PG8_BAR __builtin_amdgcn_s_barrier()
#define PG8_SCHED __builtin_amdgcn_sched_barrier(0)
    Unit cur, nxt; int ui = 0;
    if (!S.next(0, cur)) return;
    f32x4 acc[2][2][4][2];
#pragma unroll
    for (int a = 0; a < 2; ++a)
#pragma unroll
        for (int b = 0; b < 2; ++b)
#pragma unroll
            for (int m = 0; m < 4; ++m)
#pragma unroll
                for (int n = 0; n < 2; ++n) acc[a][b][m][n] = (f32x4){0.f, 0.f, 0.f, 0.f};
    FragT At[4], B0[2], B1[2];
    int scw = (FP8 && PROBE_KX2) ? 0x79797979 : 0x7a7a7a7a, scx = 0x7f7f7f7f; asm volatile("" : "+v"(scw), "+v"(scx));
    const char* cA = GATHER ? (const char*)g.A : (const char*)g.A + (size_t)cur.pm * tstepA; const char* cB = (const char*)g.Bt + (size_t)cur.pb * tstepB;
    SC(cur, lds + STAGE_BYTES + ctx_off, wid, lane);
    const int R0 = Rl[0], R1 = Rl[1]; const unsigned C0 = (unsigned)Cl[0] * 2u, C1 = (unsigned)Cl[1] * 2u;
    if constexpr (GATHER) { gA00 = S.a_off(cur, R0) + C0; gA01 = S.a_off(cur, R1) + C1; gA10 = S.a_off(cur, HALF + R0) + C0; gA11 = S.a_off(cur, HALF + R1) + C1; }
#define PG8_STAGE_A(bufoff, koff, O0, O1, dense_ptr) do { if constexpr (GATHER) { \
        __builtin_amdgcn_global_load_lds((const unsigned*)((const char*)g.A + (koff) + (O0)), (PG8_LAS unsigned*)(lds + (bufoff) + ldsw), 16, 0, 0); \
        __builtin_amdgcn_global_load_lds((const unsigned*)((const char*)g.A + (koff) + (O1)), (PG8_LAS unsigned*)(lds + (bufoff) + ldsw + 8192), 16, 0, 0); \
    } else { PG8_STAGE(bufoff, dense_ptr, voffA); } } while (0)
    PG8_STAGE(PG8_SB(0, 0), cB, voffB); PG8_STAGE(PG8_SB(0, 1), cB + hstepB, voffB); PG8_STAGE_A(PG8_SA(0, 0), 0, gA00, gA01, cA); PG8_STAGE_A(PG8_SA(0, 1), 0, gA10, gA11, cA + hstepA);
    if (wr == 1) PG8_BAR;
    PG8_WAIT_V(2); PG8_BAR;
    PG8_STAGE(PG8_SB(1, 0), cB + kstep, voffB); PG8_STAGE_A(PG8_SA(1, 0), kstep, gA00, gA01, cA + kstep); PG8_STAGE(PG8_SB(1, 1), cB + hstepB + kstep, voffB);
    PG8_WAIT_V(6); PG8_BAR;
    for (;;) {
        const bool has_next = S.next(ui + 1, nxt);
        const char* nA = GATHER ? cA : (has_next ? (const char*)g.A + (size_t)nxt.pm * tstepA : cA); const char* nB = has_next ? (const char*)g.Bt + (size_t)nxt.pb * tstepB : cB;
        if (has_next) SC(nxt, lds + STAGE_BYTES + ctx_off + ((ui + 1) % 3) * 4096, wid, lane);
        if constexpr (GATHER) {
            if (has_next) { gN00 = S.a_off(nxt, R0) + C0; gN01 = S.a_off(nxt, R1) + C1; gN10 = S.a_off(nxt, HALF + R0) + C0; gN11 = S.a_off(nxt, HALF + R1) + C1; }
            else { gN00 = gA00; gN01 = gA01; gN10 = gA10; gN11 = gA11; }
        }
        constexpr int KX = (FP8 && PROBE_KX2) ? 2 : 1;
        for (int t = 0; t < KX * nt; t += 2) {
            const bool last = (t == KX * nt - 2);
            const char* a1 = cA + (size_t)((t + 1) % nt) * kstep;
            const char* a2 = last ? nA : cA + (size_t)((t + 2) % nt) * kstep; const char* b2 = last ? nB : cB + (size_t)((t + 2) % nt) * kstep;
            const char* a3 = a2 + kstep; const char* b3 = b2 + kstep;
            const size_t k1 = (size_t)((t + 1) % nt) * kstep, k2 = last ? 0 : (size_t)((t + 2) % nt) * kstep;
            const unsigned gT00 = last ? gN00 : gA00, gT01 = last ? gN01 : gA01, gT10 = last ? gN10 : gA10, gT11 = last ? gN11 : gA11;
            PG8_LDB(B0, 0, 0); PG8_LDB(B1, 0, 1); PG8_SCHED; PG8_LDA(At, 0, 0); PG8_STAGE_A(PG8_SA(1, 1), k1, gA10, gA11, a1 + hstepA);
            PG8_WAIT_V(8); PG8_WAIT_L(0); PG8_BAR; PG8_MMA(0, 0, At, B0); PG8_MMA(0, 1, At, B1); PG8_BAR; PG8_SCHED;
            PG8_LDA(At, 0, 1); PG8_STAGE(PG8_SB(0, 0), b2, voffB); PG8_STAGE(PG8_SB(0, 1), b2 + hstepB, voffB); PG8_STAGE_A(PG8_SA(0, 0), k2, gT00, gT01, a2);
            PG8_WAIT_V(8); PG8_WAIT_L(0); PG8_BAR; PG8_MMA(1, 0, At, B0); PG8_MMA(1, 1, At, B1); PG8_BAR; PG8_SCHED;
            PG8_LDB(B0, 1, 0); PG8_LDB(B1, 1, 1); PG8_SCHED; PG8_LDA(At, 1, 0); PG8_STAGE_A(PG8_SA(0, 1), k2, gT10, gT11, a2 + hstepA);
            PG8_WAIT_V(8); PG8_WAIT_L(0); PG8_BAR; PG8_MMA(0, 0, At, B0); PG8_MMA(0, 1, At, B1); PG8_BAR; PG8_SCHED;
            PG8_LDA(At, 1, 1); PG8_STAGE(PG8_SB(1, 0), b3, voffB); PG8_STAGE(PG8_SB(1, 1), b3 + hstepB, voffB); PG8_STAGE_A(PG8_SA(1, 0), k2 + kstep, gT00, gT01, a3);
            PG8_WAIT_V(8); PG8_WAIT_L(0); PG8_BAR; PG8_MMA(1, 0, At, B0); PG8_MMA(1, 1, At, B1); PG8_BAR; PG8_SCHED;
        }
        unsigned long long tp0_ = 0; if constexpr (PROBE_SEG != 0 && PROBE_SEG == (FP8 ? (GATHER ? 2 : 1) : 3)) tp0_ = __builtin_amdgcn_s_memrealtime();
        const auto ectx = E.pre(cur, wr, wc, fr, fq, lds + STAGE_BYTES + ctx_off + (ui % 3) * 4096);
        if (wr == 0) PG8_BAR;
        asm volatile("s_nop 15\n\ts_nop 15" ::: "memory");
        E(acc, ectx, cur, wr, wc, fr, fq, lds + STAGE_BYTES, tid);
        if constexpr (FP8 && PROBE_EPI2) { asm volatile("" ::: "memory"); E(acc, ectx, cur, wr, wc, fr, fq, lds + STAGE_BYTES, tid); }
        if constexpr (PROBE_SEG != 0 && PROBE_SEG == (FP8 ? (GATHER ? 2 : 1) : 3)) { if (tid == 0) { PG8_LAS unsigned* acc_t = (PG8_LAS unsigned*)(lds + LDS_MISC + 48); *acc_t += (unsigned)(__builtin_amdgcn_s_memrealtime() - tp0_); } }
        if (!has_next) break;
#pragma unroll
        for (int a = 0; a < 2; ++a)
#pragma unroll
            for (int b = 0; b < 2; ++b)
#pragma unroll
                for (int m = 0; m < 4; ++m)
#pragma unroll
                    for (int n = 0; n < 2; ++n) acc[a][b][m][n] = (f32x4){0.f, 0.f, 0.f, 0.f};
        cur = nxt; cA = nA; cB = nB; ++ui;
        if constexpr (GATHER) { gA00 = gN00; gA01 = gN01; gA10 = gN10; gA11 = gN11; }
        if (wr == 1) PG8_BAR;
    }
    PG8_WAIT_V(0);
    PG8_BAR;
#undef PG8_SA
#undef PG8_SB
#undef PG8_STAGE
#undef PG8_STAGE_A
#undef PG8_LDA
#undef PG8_LDB
#undef PG8_MMA
#undef PG8_WAIT_V
#undef PG8_WAIT_L
#undef PG8_BAR
#undef PG8_SCHED
}
struct GridOrder {
    int nM, nN, nwg, G, c;
    __device__ __forceinline__ void init(int nM_, int nN_, int G_, int c_) { nM = nM_; nN = nN_; nwg = nM * nN; G = G_; c = c_; }
    __device__ __forceinline__ bool tile(int i, int& pm, int& pn) const {
        const long L = (long)i * G + c; if (L >= nwg) return false;
        int wgid = (int)L; { const int q = nwg / 8, r = nwg % 8, xcd = wgid % 8, off = wgid / 8; wgid = (xcd < r ? xcd * (q + 1) : r * (q + 1) + (xcd - r) * q) + off; }
        const int nig = 8 * nN, gid = wgid / nig, fm = gid * 8, gsz = (nM - fm) < 8 ? (nM - fm) : 8;
        pm = fm + ((wgid % nig) % gsz); pn = (wgid % nig) / gsz; return true;
    }
};
}


struct DenseOrder { pg8::GridOrder go;
    __device__ __forceinline__ bool next(int i, pg8::Unit& u) const { int pm, pn; if (!go.tile(i, pm, pn)) return false; u.pm = pm; u.pb = pn; u.pn = pn; u.aux = 0; return true; } };
struct MoeOrder { pg8::GridOrder go; const int* pst; const int* el_slot; int NT, ebase;
    __device__ __forceinline__ unsigned a_off(const pg8::Unit& u, int R) const { const int ro = u.pm * 256 - pst[u.aux] + R; const int tok = (ro < pst[64 + u.aux]) ? (el_slot[(size_t)u.aux * T + ro] >> 2) : 0; return (unsigned)tok * 1024u; }
    __device__ __forceinline__ bool next(int i, pg8::Unit& u) const { int pm, pn; if (!go.tile(i, pm, pn)) return false; int e = 0;
#pragma unroll
        for (int q = 1; q < 32; ++q) e = (pm * 256 >= pst[q]) ? q : e;
        e = __builtin_amdgcn_readfirstlane(e);
        u.pm = pm; u.pn = pn; u.pb = (ebase + e) * NT + pn; u.aux = e; return true; } };
struct S5Order { int G, c;
    __device__ __forceinline__ bool next(int i, pg8::Unit& u) const { const int L = i * G + c; if (L >= 256) return false; const int g = L >> 3, pmL = (L >> 2) & 1, pnL = L & 3;
        u.pm = g * 2 + pmL; u.pb = g * 4 + pnL; u.pn = pnL; u.aux = g; return true; } };

__device__ __forceinline__ void transpose_item(const float* W, int K, int N, bf16_t* WT, int ldt, float* scr, int item, int lane, int mode, const float* kscale = nullptr) {
    const int nblk = N / 32, kb = item / nblk, nb = item % nblk, k0 = 64 * kb, n0 = 32 * nb;
#pragma unroll 8
    for (int i = 0; i < 32; ++i) { const int kk = 2 * i + (lane >> 5); scr[kk * 33 + (lane & 31)] = W[(size_t)(k0 + kk) * N + n0 + (lane & 31)] * (kscale ? kscale[k0 + kk] : 1.0f); }
    __builtin_amdgcn_s_waitcnt(0xC07F); asm volatile("" ::: "memory");
    const int c = lane & 7;
#pragma unroll
    for (int j = 0; j < 4; ++j) {
        const int n = (lane >> 3) + 8 * j; const float* s = scr + (8 * c) * 33 + n;
        u32x4 o; o.x = pk2(s[0 * 33], s[1 * 33]); o.y = pk2(s[2 * 33], s[3 * 33]); o.z = pk2(s[4 * 33], s[5 * 33]); o.w = pk2(s[6 * 33], s[7 * 33]);
        int nn = n0 + n;
        if (mode == 1) { const int half = nn >= 1024; const int jj = nn - half * 1024; nn = 32 * (jj >> 4) + 16 * half + (jj & 15); }
        *(u32x4*)(WT + (size_t)nn * ldt + k0 + 8 * c) = o;
    }
    __builtin_amdgcn_s_waitcnt(0xC07F); asm volatile("" ::: "memory");
}
__device__ __forceinline__ void transpose_item_fp8(const float* W, int K, int N, unsigned char* WT, float* scr, int item, int lane, int mode, float scale) {
    const int nblk = N / 32, kb = item / nblk, nb = item % nblk, k0 = 128 * kb, n0 = 32 * nb;
#pragma unroll 8
    for (int i = 0; i < 64; ++i) { const int kk = 2 * i + (lane >> 5); scr[kk * 33 + (lane & 31)] = W[(size_t)(k0 + kk) * N + n0 + (lane & 31)] * scale; }
    __builtin_amdgcn_s_waitcnt(0xC07F); asm volatile("" ::: "memory");
    const int c = lane & 7;
#pragma unroll
    for (int j = 0; j < 4; ++j) {
        const int n = (lane >> 3) + 8 * j; const float* s = scr + (16 * c) * 33 + n;
        u32x4 o; o.x = pk4_fp8(s[0 * 33], s[1 * 33], s[2 * 33], s[3 * 33]); o.y = pk4_fp8(s[4 * 33], s[5 * 33], s[6 * 33], s[7 * 33]);
        o.z = pk4_fp8(s[8 * 33], s[9 * 33], s[10 * 33], s[11 * 33]); o.w = pk4_fp8(s[12 * 33], s[13 * 33], s[14 * 33], s[15 * 33]);
        int nn = n0 + n;
        if (mode == 1) { const int half = nn >= 1024; const int jj = nn - half * 1024; nn = 32 * (jj >> 4) + 16 * half + (jj & 15); }
        *(u32x4*)(WT + (size_t)nn * K + k0 + 16 * c) = o;
    }
    __builtin_amdgcn_s_waitcnt(0xC07F); asm volatile("" ::: "memory");
}
__device__ __forceinline__ void transpose_many_fp8(const float* W, int nmat, int K, int N, unsigned char* WT, size_t dst_stride, float* scr, int gw, int NGW, int lane, int mode, float scale) {
    const int per = (K / 128) * (N / 32); const long tot = (long)nmat * per;
    for (long it = gw; it < tot; it += NGW) {
        const int mt = (int)(it / per), r = (int)(it % per);
        transpose_item_fp8(W + (size_t)mt * K * N, K, N, WT + (size_t)mt * dst_stride, scr, r, lane, mode, scale);
    }
}
__device__ __forceinline__ void convert_fp8_block(const float* W, int nmat, int K, int N, unsigned char* WT, size_t dst_stride, float* tile, int vb, int G, int tid, int mode, float scale) {
    const int per = (K / 128) * (N / 256), tot = nmat * per, wave = tid >> 6, lane = tid & 63;
    f32x4 v[16];
    int it = vb;
    auto src = [&](int item, int i) { const int mt = item / per, r = item % per, nblk = N / 256, kb = r / nblk, nb = r % nblk;
        return (const f32x4*)(W + (size_t)mt * K * N + (size_t)(128 * kb + wave + 8 * i) * N + 256 * nb + lane * 4); };
    if (it < tot) {
#pragma unroll
        for (int i = 0; i < 16; ++i) v[i] = *src(it, i);
    }
    while (it < tot) {
#pragma unroll
        for (int i = 0; i < 16; ++i) { float* d = tile + (wave + 8 * i) * 257 + lane * 4; d[0] = v[i].x * scale; d[1] = v[i].y * scale; d[2] = v[i].z * scale; d[3] = v[i].w * scale; }
        __syncthreads();
        const int nx = it + G;
        if (nx < tot) {
#pragma unroll
            for (int i = 0; i < 16; ++i) v[i] = *src(nx, i);
        }
        {
            const int mt = it / per, r = it % per, nblk = N / 256, kb = r / nblk, nb = r % nblk, k0 = 128 * kb, n0 = 256 * nb;
            const int c = tid & 7;
#pragma unroll 1
            for (int ps = 0; ps < 4; ++ps) {
                const int n = ps * 64 + (tid >> 3); const float* sp = tile + (16 * c) * 257 + n;
                u32x4 o; o.x = pk4_fp8(sp[0 * 257], sp[1 * 257], sp[2 * 257], sp[3 * 257]); o.y = pk4_fp8(sp[4 * 257], sp[5 * 257], sp[6 * 257], sp[7 * 257]);
                o.z = pk4_fp8(sp[8 * 257], sp[9 * 257], sp[10 * 257], sp[11 * 257]); o.w = pk4_fp8(sp[12 * 257], sp[13 * 257], sp[14 * 257], sp[15 * 257]);
                int nn = n0 + n;
                if (mode == 1) { const int half = nn >= 1024; const int jj = nn - half * 1024; nn = 32 * (jj >> 4) + 16 * half + (jj & 15); }
                *(u32x4*)(WT + (size_t)mt * dst_stride + (size_t)nn * K + k0 + 16 * c) = o;
            }
        }
        __syncthreads();
        it = nx;
    }
}
__device__ __forceinline__ void transpose_many(const float* W, int nmat, int K, int N, bf16_t* WT, size_t dst_stride, float* scr, int gw, int NGW, int lane, int mode, int ldt = 0, const float* kscale = nullptr) {
    if (ldt == 0) ldt = K;
    const int per = (K / 64) * (N / 32); const long tot = (long)nmat * per;
    for (long it = gw; it < tot; it += NGW) {
        const int mt = (int)(it / per), r = (int)(it % per);
        transpose_item(W + (size_t)mt * K * N, K, N, WT + (size_t)mt * dst_stride, ldt, scr, r, lane, mode, kscale);
    }
}

__device__ __forceinline__ void norm_mod_store(f32x4 (&v)[4], const float* g, const float* sc, const float* sh, bf16_t* orow, unsigned char* orow8, int lane) {
    float s = 0.f;
#pragma unroll
    for (int j = 0; j < 4; ++j) s += (v[j].x * v[j].x + v[j].y * v[j].y) + (v[j].z * v[j].z + v[j].w * v[j].w);
    const float r = rsqrtf(wave_sum(s) * (1.0f / D) + 1e-6f);
#pragma unroll
    for (int j = 0; j < 4; ++j) {
        const int c = 4 * lane + 256 * j;
        const f32x4 gg = *(const f32x4*)(g + c), s1 = *(const f32x4*)(sc + c), s0 = *(const f32x4*)(sh + c);
        const float a = v[j].x * r * gg.x * (1.f + s1.x) + s0.x, b = v[j].y * r * gg.y * (1.f + s1.y) + s0.y,
                    cc = v[j].z * r * gg.z * (1.f + s1.z) + s0.z, d = v[j].w * r * gg.w * (1.f + s1.w) + s0.w;
        u32x2 o; o.x = pk2(a, b); o.y = pk2(cc, d);
        *(u32x2*)(orow + c) = o;
        if (orow8) *(unsigned*)(orow8 + c) = pk4_fp8(a, b, cc, d);
    }
}

__device__ __forceinline__ void unpack8(const u32x4 w, float (&f)[8]) {
    f[0] = __uint_as_float(w.x << 16); f[1] = __uint_as_float(w.x & 0xffff0000u); f[2] = __uint_as_float(w.y << 16); f[3] = __uint_as_float(w.y & 0xffff0000u);
    f[4] = __uint_as_float(w.z << 16); f[5] = __uint_as_float(w.z & 0xffff0000u); f[6] = __uint_as_float(w.w << 16); f[7] = __uint_as_float(w.w & 0xffff0000u);
}
__device__ __forceinline__ u32x4 pack8(const float (&f)[8]) { u32x4 o; o.x = pk2(f[0], f[1]); o.y = pk2(f[2], f[3]); o.z = pk2(f[4], f[5]); o.w = pk2(f[6], f[7]); return o; }
__device__ __forceinline__ void norm_mod_store8(float (&v)[2][8], const float* g, const float* sc, const float* sh, bf16_t* orow, unsigned char* orow8, int lane) {
    float s = 0.f;
#pragma unroll
    for (int j = 0; j < 2; ++j)
#pragma unroll
        for (int i = 0; i < 8; ++i) s += v[j][i] * v[j][i];
    const float r = rsqrtf(wave_sum(s) * (1.0f / D) + 1e-6f);
#pragma unroll
    for (int j = 0; j < 2; ++j) {
        const int c = 8 * lane + 512 * j; float o[8];
#pragma unroll
        for (int q = 0; q < 2; ++q) {
            const f32x4 gg = *(const f32x4*)(g + c + 4 * q), s1 = *(const f32x4*)(sc + c + 4 * q), s0 = *(const f32x4*)(sh + c + 4 * q);
            o[4 * q + 0] = v[j][4 * q + 0] * r * gg.x * (1.f + s1.x) + s0.x; o[4 * q + 1] = v[j][4 * q + 1] * r * gg.y * (1.f + s1.y) + s0.y;
            o[4 * q + 2] = v[j][4 * q + 2] * r * gg.z * (1.f + s1.z) + s0.z; o[4 * q + 3] = v[j][4 * q + 3] * r * gg.w * (1.f + s1.w) + s0.w;
        }
        *(u32x4*)(orow + c) = pack8(o);
        if (orow8) { u32x2 w8; w8.x = pk4_fp8(o[0], o[1], o[2], o[3]); w8.y = pk4_fp8(o[4], o[5], o[6], o[7]); *(u32x2*)(orow8 + c) = w8; }
    }
}

template <int ph> __device__ __forceinline__ void phase_body(int wbase) {
    extern __shared__ __attribute__((aligned(16))) unsigned char lds[];
    {
        int tid = wbase + lane_id(); asm volatile("" : "+v"(tid));
        int vb = blockIdx.x, G = gridDim.x; asm volatile("" : "+s"(vb), "+s"(G));
        const int lane = tid & 63, wave = tid >> 6;
        const int gw = vb * NWAVE + wave, NGW = G * NWAVE;
        const __attribute__((address_space(4))) Params* kp = (const __attribute__((address_space(4))) Params*)__builtin_amdgcn_kernarg_segment_ptr();
        asm volatile("" : "+s"(kp));
        unsigned char* ws = kp->ws;
        unsigned* ctl = (unsigned*)(ws + WS_CTL);
        float* MOD = (float*)(ws + WS_MOD);
        float* S5AB = (float*)(ws + WS_S5AB); float* S5BB = (float*)(ws + WS_S5AB + 65536);
        float* PW = (float*)(ws + WS_PW); float* KTAB = (float*)(ws + WS_KTAB);
                int* EL_SLOT = (int*)(ws + WS_EL); float* EL_GATE = (float*)(ws + WS_EL + 4 * MiB);
            bf16_t* W_IN_E = (bf16_t*)(ws + WS_W_IN_E); bf16_t* W_UP = (bf16_t*)(ws + WS_W_UP); bf16_t* W_GLU = (bf16_t*)(ws + WS_W_GLU);
        bf16_t* W_OUT_E = (bf16_t*)(ws + WS_W_OUT_E); bf16_t* W_IN_O = (bf16_t*)(ws + WS_W_IN_O); bf16_t* W_OUT_O = (bf16_t*)(ws + WS_W_OUT_O);
        bf16_t* W_POOL = (bf16_t*)(ws + WS_W_POOL); bf16_t* W_SGU = (bf16_t*)(ws + WS_W_SGU); bf16_t* W_RT = (bf16_t*)(ws + WS_W_RT);
        bf16_t* BT_END = (bf16_t*)(ws + WS_BT_END); bf16_t* BT_MAIN = (bf16_t*)(ws + WS_BT_MAIN);
        unsigned char* W_GU = ws + WS_W_GU; unsigned char* W_DN = ws + WS_W_DN; unsigned char* HB8 = ws + WS_HB8;
        bf16_t* HB = (bf16_t*)(ws + WS_HB); bf16_t* MIXIN = (bf16_t*)(ws + WS_MIXIN); bf16_t* Y = (bf16_t*)(ws + WS_Y);
        unsigned char* ACT = ws + WS_ACT;
        bf16_t* Z = (bf16_t*)(ws + WS_Z); float* RSP = (float*)(ws + WS_RSP); bf16_t* QKVRAW = (bf16_t*)(ws + WS_QKVRAW);
        bf16_t* Qb = (bf16_t*)(ws + WS_Q); bf16_t* Kb = (bf16_t*)(ws + WS_K); bf16_t* VT = (bf16_t*)(ws + WS_VT);
        bf16_t* AS5 = (bf16_t*)(ws + WS_AS5); float* LEND = (float*)(ws + WS_LEND); bf16_t* GACT = (bf16_t*)(ws + WS_GACT);
        bf16_t* POOLED = (bf16_t*)(ws + WS_POOLED); bf16_t* VTS = (bf16_t*)(ws + WS_VTS);
        float* OUT = kp->out; const float* XIN = kp->x; bf16_t* XR = (bf16_t*)(ws + WS_XR);
        const float* s5d = kp->s5_d; const float* glub = kp->s5_glu_b; const float* poolsc = kp->pool_scale; const float* sgub = kp->sgu_b;
        const float* bgu_all = kp->moe_b_gu; const float* bdn_all = kp->moe_b_dn; const float* rtb_all = kp->router_b;

        const int layer = (ph >= 17) ? 1 : 0;
        const int mph = (ph >= 17 && ph <= 19) ? ph - 8 : ph;
        const float* mod_l = MOD + (size_t)layer * NB * 6144;

        if (ph == 0) {
            const int gt = vb * NTHR + tid;
            if (gt < 2048) {
                const int g = gt >> 6, pp = gt & 63;
                const float dt = expf(kp->s5_log_dt[g]);
                const float lre = fminf(kp->s5_a_re[g * 64 + pp], -1e-4f), lim = kp->s5_a_im[g * 64 + pp];
                const float mag = expf(lre * dt);
                const float abr = mag * cosf(lim * dt), abi = mag * sinf(lim * dt);
                const float den = lre * lre + lim * lim, nr = abr - 1.0f;
                const float fre = (nr * lre + abi * lim) / den, fim = (abi * lre - nr * lim) / den;
                S5AB[(g * 64 + pp) * 2 + 0] = abr; S5AB[(g * 64 + pp) * 2 + 1] = abi;
                for (int j = 0; j < 16; ++j) {
                    const float br = kp->s5_b_re[(g * 64 + pp) * 16 + j], bi = kp->s5_b_im[(g * 64 + pp) * 16 + j];
                    S5BB[((g * 64 + pp) * 16 + j) * 2 + 0] = fre * br - fim * bi;
                    S5BB[((g * 64 + pp) * 16 + j) * 2 + 1] = fre * bi + fim * br;
                }
                float pr = 1.f, pi = 0.f;
                for (int tau = 0; tau <= 64; ++tau) {
                    PW[((g * 64 + pp) * 65 + tau) * 2 + 0] = pr; PW[((g * 64 + pp) * 65 + tau) * 2 + 1] = pi;
                    const float nr2 = pr * abr - pi * abi, ni2 = pr * abi + pi * abr; pr = nr2; pi = ni2;
                }
            }
            {
                float* ca = (float*)lds;
                for (int i = tid; i < NB * D; i += NTHR) { const float cv = kp->c[i]; ca[i] = cv * sigmoidf_(cv); }
                __syncthreads();
                float* part = (float*)(lds + 32768);
                for (int task = vb; task < 2 * 96; task += G) {
                    const int l = task / 96, cb = task % 96, col = cb * 64 + lane;
                    const float* W = kp->ada_w + (size_t)l * D * 6144 + col;
                    float acc[8];
#pragma unroll
                    for (int b = 0; b < 8; ++b) acc[b] = 0.f;
                    const int kb = wave * 128;
                    for (int k = kb; k < kb + 128; k += 16) {
                        float w[16];
#pragma unroll
                        for (int u = 0; u < 16; ++u) w[u] = W[(size_t)(k + u) * 6144];
#pragma unroll
                        for (int u = 0; u < 16; ++u)
#pragma unroll
                            for (int b = 0; b < 8; ++b) acc[b] += ca[b * D + k + u] * w[u];
                    }
#pragma unroll
                    for (int b = 0; b < 8; ++b) part[(wave * 8 + b) * 64 + lane] = acc[b];
                    __syncthreads();
                    {
                        const int b = tid >> 6;
                        float sum = kp->ada_b[l * 6144 + col];
#pragma unroll
                        for (int w8 = 0; w8 < 8; ++w8) sum += part[(w8 * 8 + b) * 64 + lane];
                        MOD[((size_t)l * NB + b) * 6144 + col] = sum;
                    }
                    __syncthreads();
                }
                __syncthreads();
            }
            {
                float* scr = (float*)(lds + wave * 16384);
                transpose_many(kp->even_w_in, 1, 1024, 928, W_IN_E, 0, scr, gw, NGW, lane, 0);
                transpose_many(kp->w_uq, 1, 256, 768, W_UP, 0, scr, gw, NGW, lane, 0, 384, kp->q_norm_g);
                transpose_many(kp->w_ukv, 1, 128, 1024, W_UP + (size_t)768 * 384 + 256, 0, scr, gw, NGW, lane, 0, 384, kp->kv_norm_g);
                for (int i = vb * NTHR + tid; i < 768 * 16 + 1024 * 32; i += G * NTHR) {
                    const u32x4 z = {0u, 0u, 0u, 0u};
                    if (i < 768 * 16) *(u32x4*)(W_UP + (size_t)(i >> 4) * 384 + 256 + (i & 15) * 8) = z;
                    else { const int q = i - 768 * 16; *(u32x4*)(W_UP + (size_t)(768 + (q >> 5)) * 384 + (q & 31) * 8) = z; }
                }
                transpose_many(kp->s5_glu_w, 1, 512, 512, W_GLU, 0, scr, gw, NGW, lane, 0);
                transpose_many(kp->even_w_out, 1, 1024, 1024, W_OUT_E, 0, scr, gw, NGW, lane, 0);
                transpose_many(kp->odd_w_in, 1, 1024, 1536, W_IN_O, 0, scr, gw, NGW, lane, 0);
                transpose_many(kp->odd_w_out, 1, 1024, 1024, W_OUT_O, 0, scr, gw, NGW, lane, 0);
                transpose_many(kp->pool_w, 4, 128, 128, W_POOL, 128 * 128, scr, gw, NGW, lane, 0);
                transpose_many(kp->router_w, 2, 1024, 32, W_RT, 128 * 1024, scr, gw, NGW, lane, 0);
                __syncthreads();
                convert_fp8_block(kp->moe_w_gu, 64, 1024, 2048, W_GU, (size_t)2048 * 1024, (float*)lds, vb, G, tid, 1, 32.0f);
                convert_fp8_block(kp->moe_w_dn, 64, 1024, 1024, W_DN, (size_t)1024 * 1024, (float*)lds, vb, G, tid, 0, 32.0f);
                for (int i = vb * NTHR + tid; i < 4 * 128 * 128; i += G * NTHR) {
                    const int t = (i >> 7) & 127, s_ = i & 127;
                    W_SGU[i] = (s_ <= t) ? f2bf(kp->sgu_w[i]) : (bf16_t)0;
                }
            }
        }
        else if (ph == 1 || ph == 12 || ph == 20) {
            const int lyr = (ph == 1) ? 0 : 1;
            const bool combine = (ph == 12 || ph == 20), donorm = (ph != 20);
            const int comb_layer = (ph == 12) ? 0 : 1;
            const bool ffn = false;
            const float* ng = (ffn ? kp->norm_ffn_g : kp->norm_mix_g) + lyr * D;
            if (ph == 1) {
                for (int rb = gw * 16; rb < T; rb += NGW * 16) {
                    const int b = rb / S;
                    const float* mm = MOD + ((size_t)lyr * NB + b) * 6144;
                    f32x4 pg[4], ps[4], ph_[4];
#pragma unroll
                    for (int j = 0; j < 4; ++j) { const int c = 4 * lane + 256 * j; pg[j] = *(const f32x4*)(ng + c); const f32x4 s1 = *(const f32x4*)(mm + D + c); ph_[j] = *(const f32x4*)(mm + c);
                        pg[j].x *= (1.f + s1.x); pg[j].y *= (1.f + s1.y); pg[j].z *= (1.f + s1.z); pg[j].w *= (1.f + s1.w); ps[j] = s1; }
                    f32x4 cur[4], nxt[4];
#pragma unroll
                    for (int j = 0; j < 4; ++j) cur[j] = *(const f32x4*)(XIN + (size_t)rb * D + 4 * lane + 256 * j);
                    for (int i = 0; i < 16; ++i) {
                        const int row = rb + i;
                        if (i + 1 < 16) {
#pragma unroll
                            for (int j = 0; j < 4; ++j) nxt[j] = *(const f32x4*)(XIN + (size_t)(row + 1) * D + 4 * lane + 256 * j);
                        }
                        float ss = 0.f;
#pragma unroll
                        for (int j = 0; j < 4; ++j) ss += (cur[j].x * cur[j].x + cur[j].y * cur[j].y) + (cur[j].z * cur[j].z + cur[j].w * cur[j].w);
                        const float r = rsqrtf(wave_sum(ss) * (1.0f / D) + 1e-6f);
#pragma unroll
                        for (int j = 0; j < 4; ++j) {
                            u32x2 o; o.x = pk2(cur[j].x * r * pg[j].x + ph_[j].x, cur[j].y * r * pg[j].y + ph_[j].y); o.y = pk2(cur[j].z * r * pg[j].z + ph_[j].z, cur[j].w * r * pg[j].w + ph_[j].w);
                            *(u32x2*)(HB + (size_t)row * D + 4 * lane + 256 * j) = o;
                        }
#pragma unroll
                        for (int j = 0; j < 4; ++j) cur[j] = nxt[j];
                    }
                }
            } else {
                for (int row0 = gw; row0 < T; row0 += 2 * NGW) {
                    float v[2][2][8];
#pragma unroll
                    for (int j = 0; j < 2; ++j) {
                        const int c = 8 * lane + 512 * j;
                        u32x4 xr[2], yr[2][4];
#pragma unroll
                        for (int q = 0; q < 2; ++q) {
                            const int row = row0 + q * NGW;
                            xr[q] = *(const u32x4*)(XR + (size_t)row * D + c);
#pragma unroll
                            for (int k = 0; k < 4; ++k) yr[q][k] = *(const u32x4*)(Y + ((size_t)row * 4 + k) * D + c);
                        }
#pragma unroll
                        for (int q = 0; q < 2; ++q) {
                            const int row = row0 + q * NGW, b = row / S;
                            const float* gf = MOD + ((size_t)comb_layer * NB + b) * 6144 + 5 * D;
                            float xf[8], acc[8];
                            unpack8(xr[q], xf);
#pragma unroll
                            for (int i = 0; i < 8; ++i) acc[i] = 0.f;
#pragma unroll
                            for (int k = 0; k < 4; ++k) { float yf[8]; unpack8(yr[q][k], yf);
#pragma unroll
                                for (int i = 0; i < 8; ++i) acc[i] += yf[i]; }
                            const f32x4 g0 = *(const f32x4*)(gf + c), g1 = *(const f32x4*)(gf + c + 4);
                            float (&vv)[8] = v[q][j];
                            vv[0] = xf[0] + g0.x * acc[0]; vv[1] = xf[1] + g0.y * acc[1]; vv[2] = xf[2] + g0.z * acc[2]; vv[3] = xf[3] + g0.w * acc[3];
                            vv[4] = xf[4] + g1.x * acc[4]; vv[5] = xf[5] + g1.y * acc[5]; vv[6] = xf[6] + g1.z * acc[6]; vv[7] = xf[7] + g1.w * acc[7];
                            if (ph == 20) { *(f32x4*)(OUT + (size_t)row * D + c) = (f32x4){vv[0], vv[1], vv[2], vv[3]}; *(f32x4*)(OUT + (size_t)row * D + c + 4) = (f32x4){vv[4], vv[5], vv[6], vv[7]}; }
                            else *(u32x4*)(XR + (size_t)row * D + c) = pack8(vv);
                        }
                    }
                    if (donorm) {
#pragma unroll
                        for (int q = 0; q < 2; ++q) {
                            const int row = row0 + q * NGW, b = row / S;
                            const float* mm = MOD + ((size_t)lyr * NB + b) * 6144;
                            norm_mod_store8(v[q], ng, mm + D, mm, HB + (size_t)row * D, (unsigned char*)nullptr, lane);
                        }
                    }
                }
            }
            if (ph == 1) {
                __syncthreads();
                float* Cs = (float*)lds;
                float* Bs = Cs + 2048;
                float* As = Bs + 2048;
                for (int item = vb; item < 256; item += G) {
                    const int g = item >> 3, tq = item & 7;
                    for (int idx = tid; idx < 1024; idx += NTHR) {
                        const int i = idx >> 6, pp = idx & 63;
                        Cs[idx * 2] = kp->s5_c_re[(g * 16 + i) * 64 + pp]; Cs[idx * 2 + 1] = kp->s5_c_im[(g * 16 + i) * 64 + pp];
                        Bs[idx * 2] = S5BB[((size_t)g * 1024 + idx) * 2]; Bs[idx * 2 + 1] = S5BB[((size_t)g * 1024 + idx) * 2 + 1];
                    }
                    { const int pp = tid >> 3, tl = tid & 7; As[tid * 2] = PW[((g * 64 + pp) * 65 + tq * 8 + tl) * 2]; As[tid * 2 + 1] = PW[((g * 64 + pp) * 65 + tq * 8 + tl) * 2 + 1]; }
                    __syncthreads();
                    const int v0 = tid * 4, tl = v0 >> 8, i = (v0 >> 4) & 15, j0 = v0 & 15;
                    float acc[4] = {0.f, 0.f, 0.f, 0.f};
                    for (int pp = 0; pp < 64; ++pp) {
                        const float cr = Cs[(i * 64 + pp) * 2], ci = Cs[(i * 64 + pp) * 2 + 1];
                        const float ar = As[(pp * 8 + tl) * 2], ai = As[(pp * 8 + tl) * 2 + 1];
                        const f32x4 b01 = *(const f32x4*)(Bs + (pp * 16 + j0) * 2), b23 = *(const f32x4*)(Bs + (pp * 16 + j0) * 2 + 4);
                        const float wr_ = cr * ar - ci * ai, wi_ = cr * ai + ci * ar;
                        acc[0] += wr_ * b01.x - wi_ * b01.y; acc[1] += wr_ * b01.z - wi_ * b01.w; acc[2] += wr_ * b23.x - wi_ * b23.y; acc[3] += wr_ * b23.z - wi_ * b23.w;
                    }
                    *(f32x4*)(KTAB + (((size_t)g * 64 + tq * 8 + tl) * 16 + i) * 16 + j0) = (f32x4){acc[0], acc[1], acc[2], acc[3]};
                    __syncthreads();
                }
            }
        }
        else if (ph == 2) {
            {
                DenseOrder so; so.go.init(T / 256, 4, G, vb);
                auto f = [=](const pg8::Unit& u, const pg8::NoCtx&, int ai, int m, int bj, int r, int c, f32x4 v0, f32x4 v1) -> float {
                        const int row = u.pm * 256 + r, col = u.pn * 256 + c; float ss = 0.f;
                        u32x4 o; o.x = pk2(v0.x, v0.y); o.y = pk2(v0.z, v0.w); o.z = pk2(v1.x, v1.y); o.w = pk2(v1.z, v1.w);
                        if (col < 384) ss = ((v0.x * v0.x + v0.y * v0.y) + (v0.z * v0.z + v0.w * v0.w)) + ((v1.x * v1.x + v1.y * v1.y) + (v1.z * v1.z + v1.w * v1.w));
                        if (col < 416) *(u32x4*)(Z + (size_t)row * 1024 + col) = o;
                        else if (col < 928) {
                            const int ch = col - 416, g = ch >> 4, j = ch & 15, b = row / S, t = row % S;
                            *(u32x4*)(AS5 + ((size_t)g * 512 + b * 64 + (t >> 6)) * 1152 + 128 + (t & 63) * 16 + j) = o;
                        }
                        return ss;
                    };
                auto re = [=](const pg8::Unit& u, int ai, int m, int r, int wc, int fq, float part) {
                        if (u.pn < 2) {
                            part += __shfl_xor(part, 16); part += __shfl_xor(part, 32);
                            if (fq == 0) RSP[((size_t)(u.pm * 256 + r) * 2 + u.pn) * 4 + wc] = part;
                        }
                    };
                pg8::gemm_phase<false, false, true>(tid, (PG8_LAS unsigned char*)lds, pg8::Gemm{HB, W_IN_E, D, D, D}, so, pg8::make_epi_row<true>(pg8::NoPre{}, f, re));
            }
            {
                float* KT = (float*)lds;
                float* Cs = KT + 64 * 256;
                float* PWt = Cs + 2048;
                float* PWe = PWt + 1024;
                float* BBe = PWe + 2048;
                for (int item = vb; item < 256; item += G) {
                    const int g = item >> 3, tq = item & 7;
                    __syncthreads();
                    const int ntau = 8 * tq + 8;
                    for (int idx = tid; idx < ntau * 64; idx += NTHR) *(f32x4*)(KT + idx * 4) = *(const f32x4*)(KTAB + (size_t)g * 64 * 256 + idx * 4);
                    for (int idx = tid; idx < 1024; idx += NTHR) { const int i = idx >> 6, pp = idx & 63;
                        Cs[idx * 2] = kp->s5_c_re[(g * 16 + i) * 64 + pp]; Cs[idx * 2 + 1] = kp->s5_c_im[(g * 16 + i) * 64 + pp]; }
                    { const int pp = tid >> 3, tl = tid & 7; PWt[tid * 2] = PW[((g * 64 + pp) * 65 + tq * 8 + tl + 1) * 2]; PWt[tid * 2 + 1] = PW[((g * 64 + pp) * 65 + tq * 8 + tl + 1) * 2 + 1]; }
                    const int ri_e = tq >> 2, p0_e = (tq & 3) * 16;
                    for (int idx = tid; idx < 1024; idx += NTHR) { const int pl = idx >> 6, tau = idx & 63;
                        PWe[idx * 2] = PW[((g * 64 + p0_e + pl) * 65 + tau) * 2]; PWe[idx * 2 + 1] = PW[((g * 64 + p0_e + pl) * 65 + tau) * 2 + 1]; }
                    if (tid < 256) { const int pl = tid >> 4, j = tid & 15; BBe[tid * 2] = S5BB[((g * 64 + p0_e + pl) * 16 + j) * 2]; BBe[tid * 2 + 1] = S5BB[((g * 64 + p0_e + pl) * 16 + j) * 2 + 1]; }
                    __syncthreads();
                    for (int it = tid; it < 16 * 128; it += NTHR) {
                        const int pl = it >> 7, k8 = it & 127, s_ = k8 >> 1, j0 = (k8 & 1) * 8;
                        const float pr = PWe[(pl * 64 + 63 - s_) * 2], pi = PWe[(pl * 64 + 63 - s_) * 2 + 1];
                        float o[8];
#pragma unroll
                        for (int j = 0; j < 8; ++j) { const float br = BBe[(pl * 16 + j0 + j) * 2], bi = BBe[(pl * 16 + j0 + j) * 2 + 1]; o[j] = ri_e ? (pr * bi + pi * br) : (pr * br - pi * bi); }
                        u32x4 w; w.x = pk2(o[0], o[1]); w.y = pk2(o[2], o[3]); w.z = pk2(o[4], o[5]); w.w = pk2(o[6], o[7]);
                        *(u32x4*)(BT_END + ((size_t)g * 128 + ri_e * 64 + p0_e + pl) * 1024 + k8 * 8) = w;
                    }
                    for (int it = tid; it < 128 * 144; it += NTHR) {
                        const int rl = it / 144, k8 = it % 144, tl = rl >> 4, i = rl & 15, t = 8 * tq + tl;
                        float o[8];
                        if (k8 < 16) {
                            const int ri = k8 >> 3, p0 = (k8 & 7) * 8;
#pragma unroll
                            for (int j = 0; j < 8; ++j) {
                                const float cr = Cs[(i * 64 + p0 + j) * 2], ci = Cs[(i * 64 + p0 + j) * 2 + 1];
                                const float pr = PWt[((p0 + j) * 8 + tl) * 2], pi = PWt[((p0 + j) * 8 + tl) * 2 + 1];
                                o[j] = ri ? -(cr * pi + ci * pr) : (cr * pr - ci * pi);
                            }
                        } else {
                            const int kk = (k8 - 16) * 8, s_ = kk >> 4, j0 = kk & 15;
                            if (s_ <= t) { const f32x4 a = *(const f32x4*)(KT + (t - s_) * 256 + i * 16 + j0), c4 = *(const f32x4*)(KT + (t - s_) * 256 + i * 16 + j0 + 4);
                                o[0] = a.x; o[1] = a.y; o[2] = a.z; o[3] = a.w; o[4] = c4.x; o[5] = c4.y; o[6] = c4.z; o[7] = c4.w; }
                            else {
#pragma unroll
                                for (int j = 0; j < 8; ++j) o[j] = 0.f; }
                        }
                        u32x4 w; w.x = pk2(o[0], o[1]); w.y = pk2(o[2], o[3]); w.z = pk2(o[4], o[5]); w.w = pk2(o[6], o[7]);
                        *(u32x4*)(BT_MAIN + ((size_t)g * 1024 + 8 * tq * 16 + rl) * 1152 + k8 * 8) = w;
                    }
                }
                __syncthreads();
            }
        }
        else if (ph == 4) {
            {
                DenseOrder so; so.go.init(T / 256, 7, G, vb);
                struct UpCtx { float rs[8]; };
                auto pre = [=](const pg8::Unit& u, int wr, int wc, int fr, int fq, const PG8_LAS unsigned char* cxl) {
                        UpCtx cx; const int st = (u.pn >= 3) ? 1 : 0; const float inv = st ? (1.f / 128.f) : (1.f / 256.f);
#pragma unroll
                        for (int q = 0; q < 8; ++q) { const int row = u.pm * 256 + (q >> 2) * 128 + wr * 64 + (q & 3) * 16 + fr;
                            const f32x4 pp = *(const f32x4*)(RSP + ((size_t)row * 2 + st) * 4);
                            cx.rs[q] = rsqrtf(((pp.x + pp.y) + (pp.z + pp.w)) * inv + 1e-6f); }
                        return cx; };
                auto f = [=](const pg8::Unit& u, const UpCtx& cx, int ai, int m, int bj, int r, int c, f32x4 v0, f32x4 v1) {
                            const float rs = cx.rs[ai * 4 + m];
                            bf16_t* o = QKVRAW + (size_t)(u.pm * 256 + r) * 1792 + u.pn * 256 + c;
                            u32x4 a; a.x = pk2(v0.x * rs, v0.y * rs); a.y = pk2(v0.z * rs, v0.w * rs); a.z = pk2(v1.x * rs, v1.y * rs); a.w = pk2(v1.z * rs, v1.w * rs); *(u32x4*)o = a;
                        };
                pg8::gemm_phase<false, false, true>(tid, (PG8_LAS unsigned char*)lds, pg8::Gemm{Z, W_UP, 1024, 384, 384}, so, pg8::make_epi_perm(pre, f));
            }
            for (int u = (vb >= 128 ? vb - 128 : vb + 128); u < 128; u += G) {
                const int g = u >> 2, pm = u & 3;
                sg_tile(tid, lds, AS5 + ((size_t)g * 512 + pm * 128) * 1152 + 128, 1152, BT_END + (size_t)g * 128 * 1024, 1024, 1024,
                    [=](int r, int c, f32x4 v0, f32x4 v1) {
                        float* o = LEND + ((size_t)g * 512 + pm * 128 + r) * 128 + c;
                        *(f32x4*)o = v0; *(f32x4*)(o + 16) = v1;
                    });
            }
        }
        else if (ph == 5) {
            bf16_t* vts = (bf16_t*)lds;
            const float qscale = 0.10206207261596577f * 1.4426950408889634f;
            const int hh = lane >> 3, pp = lane & 7;
            float gq[12], gk[12];
#pragma unroll
            for (int g3 = 0; g3 < 3; ++g3)
#pragma unroll
                for (int e = 0; e < 4; ++e) { gq[g3 * 4 + e] = kp->q_head_g[32 * g3 + 4 * pp + e] * qscale; gk[g3 * 4 + e] = kp->k_head_g[32 * g3 + 4 * pp + e]; }
            float invf[4];
#pragma unroll
            for (int e = 0; e < 4; ++e) invf[e] = exp2f(-(float)(4 * (pp & 3) + e) * (13.287712379549449f / 16.0f));
            for (int tile = vb; tile < T / 64; tile += G) {
                u32x2 cq[3], ck[3], nq[3], nk[3]; u32x4 cv, nv; int cpos, npos;
#define P5_LOAD(row_, Q_, K_, V_, P_) do { const bf16_t* base_ = QKVRAW + (size_t)(row_) * 1792; \
                    _Pragma("unroll") for (int g3 = 0; g3 < 3; ++g3) Q_[g3] = *(const u32x2*)(base_ + hh * 96 + 32 * g3 + 4 * pp); \
                    K_[0] = *(const u32x2*)(base_ + 768 + hh * 128 + 4 * pp); K_[1] = *(const u32x2*)(base_ + 768 + hh * 128 + 32 + 4 * pp); K_[2] = *(const u32x2*)(Z + (size_t)(row_) * 1024 + 384 + 4 * pp); \
                    V_ = *(const u32x4*)(base_ + 768 + hh * 128 + 64 + 8 * pp); P_ = kp->pos[row_]; } while (0)
                P5_LOAD(tile * 64 + wave * 8, cq, ck, cv, cpos);
                for (int tt = 0; tt < 8; ++tt) {
                    const int tl = wave * 8 + tt, row = tile * 64 + tl, b = row / S, t = row % S;
                    if (tt + 1 < 8) P5_LOAD(row + 1, nq, nk, nv, npos);
                    float qv[12], kv[12];
#pragma unroll
                    for (int g3 = 0; g3 < 3; ++g3) {
                        qv[4 * g3 + 0] = __uint_as_float(cq[g3].x << 16); qv[4 * g3 + 1] = __uint_as_float(cq[g3].x & 0xffff0000u); qv[4 * g3 + 2] = __uint_as_float(cq[g3].y << 16); qv[4 * g3 + 3] = __uint_as_float(cq[g3].y & 0xffff0000u);
                        kv[4 * g3 + 0] = __uint_as_float(ck[g3].x << 16); kv[4 * g3 + 1] = __uint_as_float(ck[g3].x & 0xffff0000u); kv[4 * g3 + 2] = __uint_as_float(ck[g3].y << 16); kv[4 * g3 + 3] = __uint_as_float(ck[g3].y & 0xffff0000u);
                    }
                    float sq = 0.f, sk = 0.f;
#pragma unroll
                    for (int j = 0; j < 12; ++j) { sq += qv[j] * qv[j]; sk += kv[j] * kv[j]; }
                    sq += __shfl_xor(sq, 1); sq += __shfl_xor(sq, 2); sq += __shfl_xor(sq, 4);
                    sk += __shfl_xor(sk, 1); sk += __shfl_xor(sk, 2); sk += __shfl_xor(sk, 4);
                    const float rq = rsqrtf(sq * (1.f / 96.f) + 1e-6f), rk = rsqrtf(sk * (1.f / 96.f) + 1e-6f);
#pragma unroll
                    for (int j = 0; j < 12; ++j) { qv[j] *= rq * gq[j]; kv[j] *= rk * gk[j]; }
                    const float posf = (float)cpos; const bool lo = pp < 4;
#pragma unroll
                    for (int e = 0; e < 4; ++e) {
                        const float ang = posf * invf[e];
                        const float kq = rintf(ang * 0.15915494309189535f);
                        float rr = __builtin_fmaf(-kq, 6.28318548202514648f, ang); rr = __builtin_fmaf(-kq, -1.7484556e-7f, rr);
                        const float cs = __cosf(rr), sn = __sinf(rr);
                        const float qo = __shfl_xor(qv[8 + e], 4), ko = __shfl_xor(kv[8 + e], 4);
                        qv[8 + e] = lo ? (qv[8 + e] * cs - qo * sn) : (qo * sn + qv[8 + e] * cs);
                        kv[8 + e] = lo ? (kv[8 + e] * cs - ko * sn) : (ko * sn + kv[8 + e] * cs);
                    }
                    bf16_t* qd = Qb + (((size_t)b * 8 + hh) * S + t) * 96 + 4 * pp; bf16_t* kd = Kb + (((size_t)b * 8 + hh) * S + t) * 96 + 4 * pp;
#pragma unroll
                    for (int g3 = 0; g3 < 3; ++g3) {
                        u32x2 o; o.x = pk2(qv[4 * g3], qv[4 * g3 + 1]); o.y = pk2(qv[4 * g3 + 2], qv[4 * g3 + 3]); *(u32x2*)(qd + 32 * g3) = o;
                        u32x2 o2; o2.x = pk2(kv[4 * g3], kv[4 * g3 + 1]); o2.y = pk2(kv[4 * g3 + 2], kv[4 * g3 + 3]); *(u32x2*)(kd + 32 * g3) = o2;
                    }
                    { const unsigned w4[4] = {cv.x, cv.y, cv.z, cv.w};
#pragma unroll
                      for (int j = 0; j < 8; ++j) vts[(hh * 64 + 8 * pp + j) * 64 + tl] = (bf16_t)((j & 1) ? (w4[j >> 1] >> 16) : (w4[j >> 1] & 0xffffu)); }
#pragma unroll
                    for (int g3 = 0; g3 < 3; ++g3) { cq[g3] = nq[g3]; ck[g3] = nk[g3]; }
                    cv = nv; cpos = npos;
                }
#undef P5_LOAD
                __syncthreads();
                {
                    const int hd = tid, b = (tile * 64) / S, t0 = (tile * 64) % S;
                    bf16_t* dst = VT + (((size_t)b * 8 + (hd >> 6)) * 64 + (hd & 63)) * S + t0;
#pragma unroll
                    for (int i = 0; i < 8; ++i) *(u32x4*)(dst + i * 8) = *(const u32x4*)(vts + hd * 64 + i * 8);
                }
                __syncthreads();
            }
            if (wave == 0) {
                for (int ch = vb * 64 + lane; ch < NB * 32 * 64; ch += G * 64) {
                    const int pp = ch & 63, g = (ch >> 6) & 31, b = ch >> 11;
                    const float ar = PW[((g * 64 + pp) * 65 + 64) * 2], ai = PW[((g * 64 + pp) * 65 + 64) * 2 + 1];
                    float cr = 0.f, ci = 0.f;
                    for (int c0 = 0; c0 < 64; c0 += 16) {
                        float lr[16], li[16];
#pragma unroll
                        for (int u = 0; u < 16; ++u) { const float* le = LEND + ((size_t)g * 512 + b * 64 + c0 + u) * 128; lr[u] = le[pp]; li[u] = le[64 + pp]; }
#pragma unroll
                        for (int u = 0; u < 16; ++u) {
                            bf16_t* dst = AS5 + ((size_t)g * 512 + b * 64 + c0 + u) * 1152;
                            dst[pp] = f2bf(cr); dst[64 + pp] = f2bf(ci);
                            const float nr = ar * cr - ai * ci + lr[u], ni = ar * ci + ai * cr + li[u];
                            cr = nr; ci = ni;
                        }
                    }
                }
            }
        }
        else if (ph == 6) {
            unsigned char* Kr = lds;
            unsigned char* Vr = lds + 3 * 64 * 208;
            const int r32 = lane & 31, hi = lane >> 5;
#define ATT_MFMA_C(D, A, B, C) asm volatile("s_nop 1\n\tv_mfma_f32_32x32x16_bf16 %0, %1, %2, %3" : "+a"(D) : "v"(A), "v"(B), "a"(C))
#define ATT_MFMA(D, A, B)      asm volatile("s_nop 1\n\tv_mfma_f32_32x32x16_bf16 %0, %1, %2, %0" : "+a"(D) : "v"(A), "v"(B))
            for (int ui_ = 0; ui_ < 4 * (1 + PROBE_ATT2); ++ui_) { const int ui = ui_ & 3;
                if (vb >= 256) break;
                const int bh = vb & 63, kq = vb >> 6;
                const int qb = (ui == 0) ? 15 - kq : (ui == 1) ? 8 + kq : (ui == 2) ? 7 - kq : kq;
                const int q0 = qb * 256 + wave * 32;
                const bf16_t* Qg = Qb + ((size_t)bh * S + q0 + r32) * 96;
                const bf16_t* Kg = Kb + (size_t)bh * S * 96;
                const bf16_t* Vg = VT + (size_t)bh * 64 * S;
                unsigned char* Qs = lds + 3 * 64 * (208 + 136) + (wave * 32 + r32) * 208;
                __syncthreads();
#pragma unroll
                for (int d0 = 0; d0 < 6; ++d0) *(bf16x8*)(Qs + d0 * 32 + hi * 16) = *(const bf16x8*)(Qg + d0 * 16 + hi * 8);
                const int ntile = 4 * (qb + 1);
                const int ntw = (q0 + 31) / 64 + 1;
                const int kr0 = tid >> 3, kc0 = tid & 7;
                const int vr = tid >> 3, vc = tid & 7;
                u32x2 rk0, rk1, rk2; u32x4 rv;
#define ATT_LOAD(t_) do { { const u32x2* kp_ = (const u32x2*)(Kg + (size_t)((t_) * 64 + kr0) * 96 + kc0 * 12); rk0 = kp_[0]; rk1 = kp_[1]; rk2 = kp_[2]; } \
                    rv = *(const u32x4*)(Vg + (size_t)vr * S + (t_) * 64 + vc * 8); } while (0)
#define ATT_WRITE(t_) do { unsigned char* Ks_ = Kr + ((t_) % 3) * (64 * 208); unsigned char* Vs_ = Vr + ((t_) % 3) * (64 * 136); \
                    { u32x2* kd_ = (u32x2*)(Ks_ + kr0 * 208 + kc0 * 24); kd_[0] = rk0; kd_[1] = rk1; kd_[2] = rk2; } \
                    { u32x2 a_; a_.x = rv.x; a_.y = rv.y; u32x2 b_; b_.x = rv.z; b_.y = rv.w; *(u32x2*)(Vs_ + vr * 136 + vc * 16) = a_; *(u32x2*)(Vs_ + vr * 136 + vc * 16 + 8) = b_; } } while (0)
#define ATT_QK(t_) do { const unsigned char* Ks_ = Kr + ((t_) % 3) * (64 * 208); \
                    _Pragma("unroll") for (int d0 = 0; d0 < 6; ++d0) { \
                        const bf16x8 k0_ = *(const bf16x8*)(Ks_ + r32 * 208 + d0 * 32 + hi * 16); const bf16x8 k1_ = *(const bf16x8*)(Ks_ + (32 + r32) * 208 + d0 * 32 + hi * 16); \
                        const bf16x8 q_ = *(const bf16x8*)(Qs + d0 * 32 + hi * 16); \
                        if (d0 == 0) { ATT_MFMA_C(sA0, k0_, q_, negm); ATT_MFMA_C(sA1, k1_, q_, negm); } else { ATT_MFMA(sA0, k0_, q_); ATT_MFMA(sA1, k1_, q_); } } } while (0)
                f32x16 o0, o1, sA0, sA1, negm;
#pragma unroll
                for (int r = 0; r < 16; ++r) { o0[r] = 0.f; o1[r] = 0.f; negm[r] = 0.f; }
                float m_ref = 0.f, l_run = 0.f;
                ATT_LOAD(0); ATT_WRITE(0);
                if (ntile > 1) { ATT_LOAD(1); ATT_WRITE(1); }
                __syncthreads();
                ATT_QK(0);
                for (int t = 0; t < ntile; ++t) {
                    __syncthreads();
                    if (t + 2 < ntile) ATT_LOAD(t + 2);
                    if (t < ntw) {
                        asm volatile("s_nop 15\n\ts_nop 7" ::: "memory");
                        f32x16 s0 = sA0, s1 = sA1;
                        asm volatile("" : "+v"(s0), "+v"(s1));
                        if (t * 64 + 63 > q0) {
                            const int qi = q0 + r32;
#pragma unroll
                            for (int r = 0; r < 16; ++r) { const int key = t * 64 + crow(r, hi); if (key > qi) s0[r] = -INFINITY; if (key + 32 > qi) s1[r] = -INFINITY; }
                        }
                        float mx;
                        { auto max3 = [](float a_, float b_, float c_) { float r_; asm("v_max3_f32 %0, %1, %2, %3" : "=v"(r_) : "v"(a_), "v"(b_), "v"(c_)); return r_; };
                          float ma = max3(s0[0], s0[1], s1[0]), mb = max3(s0[2], s0[3], s1[1]); ma = max3(ma, s1[2], s1[3]);
#pragma unroll
                          for (int r = 4; r < 16; r += 4) { ma = max3(ma, s0[r], s0[r + 1]); mb = max3(mb, s0[r + 2], s0[r + 3]); ma = max3(ma, s1[r], s1[r + 1]); mb = max3(mb, s1[r + 2], s1[r + 3]); }
                          mx = max3(ma, mb, ma); mx = max3(mx, __shfl_xor(mx, 32), mx); }
                        if (__any(mx > 8.0f) || t == 0) {
                            const float dl = (t == 0) ? mx : fmaxf(mx, 0.f);
                            const float alpha = __builtin_amdgcn_exp2f(-dl);
                            m_ref += dl; l_run *= alpha;
#pragma unroll
                            for (int r = 0; r < 16; ++r) { s0[r] -= dl; s1[r] -= dl; }
                            if (t > 0) {
#pragma unroll
                                for (int r = 0; r < 16; ++r) { o0[r] *= alpha; o1[r] *= alpha; }
                            }
#pragma unroll
                            for (int r = 0; r < 16; ++r) negm[r] = -m_ref;
                        }
                        const bool doqk = t + 1 < ntw;
                        const unsigned char* Vs_ = Vr + (t % 3) * (64 * 136);
                        const unsigned char* Ks_ = Kr + ((t + 1) % 3) * (64 * 208);
                        typedef float f32x2_ __attribute__((ext_vector_type(2)));
                        f32x2_ ls2 = {0.f, 0.f};
#pragma unroll
                        for (int g4 = 0; g4 < 4; ++g4) {
                            const int kb = g4 >> 1, ks = g4 & 1;
                            u32x4 w;
                            if (kb == 0) {
#pragma unroll
                                for (int r = 0; r < 8; ++r) s0[8 * ks + r] = __builtin_amdgcn_exp2f(s0[8 * ks + r]);
#pragma unroll
                                for (int r = 0; r < 8; r += 2) ls2 += (f32x2_){s0[8 * ks + r], s0[8 * ks + r + 1]};
                                w.x = pk2(s0[8 * ks + 0], s0[8 * ks + 1]); w.y = pk2(s0[8 * ks + 2], s0[8 * ks + 3]); w.z = pk2(s0[8 * ks + 4], s0[8 * ks + 5]); w.w = pk2(s0[8 * ks + 6], s0[8 * ks + 7]);
                            } else {
#pragma unroll
                                for (int r = 0; r < 8; ++r) s1[8 * ks + r] = __builtin_amdgcn_exp2f(s1[8 * ks + r]);
#pragma unroll
                                for (int r = 0; r < 8; r += 2) ls2 += (f32x2_){s1[8 * ks + r], s1[8 * ks + r + 1]};
                                w.x = pk2(s1[8 * ks + 0], s1[8 * ks + 1]); w.y = pk2(s1[8 * ks + 2], s1[8 * ks + 3]); w.z = pk2(s1[8 * ks + 4], s1[8 * ks + 5]); w.w = pk2(s1[8 * ks + 6], s1[8 * ks + 7]);
                            }
                            const bf16x8 pfg = __builtin_bit_cast(bf16x8, w);
                            const int koff = (kb * 32 + 16 * ks + 4 * hi) * 2;
#pragma unroll
                            for (int dvb = 0; dvb < 2; ++dvb) {
                                const unsigned char* vp = Vs_ + (dvb * 32 + r32) * 136 + koff;
                                const u32x2 lo = *(const u32x2*)vp, hi2 = *(const u32x2*)(vp + 16);
                                u32x4 wv; wv.x = lo.x; wv.y = lo.y; wv.z = hi2.x; wv.w = hi2.y;
                                const bf16x8 vf = __builtin_bit_cast(bf16x8, wv);
                                if (dvb == 0) ATT_MFMA(o0, vf, pfg); else ATT_MFMA(o1, vf, pfg);
                                __builtin_amdgcn_sched_barrier(0);
                            }
                            if (doqk) {
#pragma unroll
                                for (int q3 = 0; q3 < 3; ++q3) {
                                    const int qi3 = g4 * 3 + q3, d0 = qi3 >> 1, kq = qi3 & 1;
                                    const bf16x8 k_ = *(const bf16x8*)(Ks_ + (kq * 32 + r32) * 208 + d0 * 32 + hi * 16);
                                    const bf16x8 q_ = *(const bf16x8*)(Qs + d0 * 32 + hi * 16);
                                    if (kq == 0) { if (d0 == 0) ATT_MFMA_C(sA0, k_, q_, negm); else ATT_MFMA(sA0, k_, q_); }
                                    else         { if (d0 == 0) ATT_MFMA_C(sA1, k_, q_, negm); else ATT_MFMA(sA1, k_, q_); }
                                    __builtin_amdgcn_sched_barrier(0);
                                }
                            }
                            __builtin_amdgcn_sched_barrier(0);
                        }
                        l_run += ls2.x + ls2.y;
                    }
                    if (t + 2 < ntile) ATT_WRITE(t + 2);
                }
                asm volatile("s_nop 15\n\ts_nop 7" ::: "memory");
                l_run += __shfl_xor(l_run, 32);
                const float rl = __builtin_amdgcn_rcpf(l_run);
                const int b = bh >> 3, h = bh & 7;
                bf16_t* orow = MIXIN + ((size_t)b * S + q0 + r32) * 1024 + h * 64;
#pragma unroll
                for (int rg = 0; rg < 4; ++rg) {
                    u32x2 a; a.x = pk2(o0[4 * rg] * rl, o0[4 * rg + 1] * rl); a.y = pk2(o0[4 * rg + 2] * rl, o0[4 * rg + 3] * rl);
                    *(u32x2*)(orow + 8 * rg + 4 * hi) = a;
                    u32x2 c2; c2.x = pk2(o1[4 * rg] * rl, o1[4 * rg + 1] * rl); c2.y = pk2(o1[4 * rg + 2] * rl, o1[4 * rg + 3] * rl);
                    *(u32x2*)(orow + 32 + 8 * rg + 4 * hi) = c2;
                }
            }
#undef ATT_MFMA_C
#undef ATT_MFMA
#undef ATT_LOAD
#undef ATT_WRITE
#undef ATT_QK
            __syncthreads();
            {
                S5Order so; so.G = G; so.c = vb;
                auto f = [=](const pg8::Unit& u, const pg8::NoCtx&, int ai, int m, int bj, int r, int c, f32x4 v0, f32x4 v1) {
                        const int g = u.aux, mr = (u.pm & 1) * 256 + r, b = mr >> 6, ck = mr & 63;
#pragma unroll
                        for (int h = 0; h < 2; ++h) {
                            const int n = u.pn * 256 + c + 16 * h; const f32x4 v = h ? v1 : v0;
                            const int tq = n >> 4, i = n & 15;
                            const u32x2 uu = *(const u32x2*)(AS5 + ((size_t)g * 512 + mr) * 1152 + 128 + n);
                            const f32x4 dd = *(const f32x4*)(s5d + g * 16 + i);
                            const float y0 = v.x + dd.x * __uint_as_float(uu.x << 16), y1 = v.y + dd.y * __uint_as_float(uu.x & 0xffff0000u),
                                        y2 = v.z + dd.z * __uint_as_float(uu.y << 16), y3 = v.w + dd.w * __uint_as_float(uu.y & 0xffff0000u);
                            u32x2 o; o.x = pk2(gelu_tanh(y0), gelu_tanh(y1)); o.y = pk2(gelu_tanh(y2), gelu_tanh(y3));
                            *(u32x2*)(GACT + ((size_t)b * S + ck * 64 + tq) * 512 + g * 16 + i) = o;
                        }
                    };
                const int tid2 = wbase + lane_id();
                pg8::gemm_phase(tid2, (PG8_LAS unsigned char*)lds, pg8::Gemm{AS5, BT_MAIN, 1152, 1152, 1152}, so, pg8::make_epi(pg8::NoPre{}, f));
            }
        }
        else if (ph == 7) {
            {
                DenseOrder so; so.go.init(T / 256, 2, G, vb);
                auto f = [=](const pg8::Unit& u, const pg8::NoCtx&, int ai, int m, int bj, int r, int c, f32x4 v0, f32x4 v1) {
                        const int row = u.pm * 256 + r, col = u.pn * 256 + c;
                        float gv[8]; unpack8(*(const u32x4*)(GACT + (size_t)row * 512 + col), gv);
                        const f32x4 b0 = *(const f32x4*)(glub + col), b1 = *(const f32x4*)(glub + col + 4);
                        u32x4 o; o.x = pk2(gv[0] * sigmoidf_(v0.x + b0.x), gv[1] * sigmoidf_(v0.y + b0.y)); o.y = pk2(gv[2] * sigmoidf_(v0.z + b0.z), gv[3] * sigmoidf_(v0.w + b0.w));
                        o.z = pk2(gv[4] * sigmoidf_(v1.x + b1.x), gv[5] * sigmoidf_(v1.y + b1.y)); o.w = pk2(gv[6] * sigmoidf_(v1.z + b1.z), gv[7] * sigmoidf_(v1.w + b1.w));
                        *(u32x4*)(MIXIN + (size_t)row * 1024 + 512 + col) = o;
                    };
                pg8::gemm_phase<false, false, true>(tid, (PG8_LAS unsigned char*)lds, pg8::Gemm{GACT, W_GLU, 512, 512, 512}, so, pg8::make_epi_perm(pg8::NoPre{}, f));
            }
        }
        else if (ph == 8 || ph == 16) {
            const int lyr = (ph == 8) ? 0 : 1;
            const bf16_t* W = lyr ? W_OUT_O : W_OUT_E;

            {
                DenseOrder so; so.go.init(T / 256, 4, G, vb);
                struct OCtx { f32x4 gm[2][2]; };
                struct OG { u32x4 x[2][2]; };
                auto pre = [=](const pg8::Unit& u, int wr, int wc, int fr, int fq, const PG8_LAS unsigned char* cxl) {
                        OCtx cx; const int b = (u.pm * 256) / S; const float* gm = MOD + ((size_t)lyr * NB + b) * 6144 + 2 * D;
#pragma unroll
                        for (int bj = 0; bj < 2; ++bj)
#pragma unroll
                            for (int h = 0; h < 2; ++h) cx.gm[bj][h] = *(const f32x4*)(gm + u.pn * 256 + bj * 128 + wc * 32 + 4 * fq + 16 * h);
                        return cx; };
                auto gp = [=](const pg8::Unit& u, const OCtx&, int r, int wc, int fq) {
                        OG g; const int row = u.pm * 256 + r;
#pragma unroll
                        for (int bj = 0; bj < 2; ++bj)
#pragma unroll
                            for (int h = 0; h < 2; ++h) { const int col = u.pn * 256 + bj * 128 + wc * 32 + 4 * fq + 16 * h;
                                if (lyr == 0) g.x[bj][h] = *(const u32x4*)(XIN + (size_t)row * D + col);
                                else { const u32x2 xx = *(const u32x2*)(XR + (size_t)row * D + col); g.x[bj][h] = (u32x4){xx.x, xx.y, 0u, 0u}; } }
                        return g; };
                auto f = [=](const pg8::Unit& u, const OCtx& cx, const OG& g, int ai, int m, int bj, int r, int c, f32x4 v0, f32x4 v1) {
                        const int row = u.pm * 256 + r;
#pragma unroll
                        for (int h = 0; h < 2; ++h) {
                            const int col = u.pn * 256 + c + 16 * h; const f32x4 v = h ? v1 : v0;
                            const f32x4 g4 = cx.gm[bj][h]; const u32x4 xx = g.x[bj][h]; f32x4 xs;
                            if (lyr == 0) { xs.x = __uint_as_float(xx.x); xs.y = __uint_as_float(xx.y); xs.z = __uint_as_float(xx.z); xs.w = __uint_as_float(xx.w); }
                            else { xs.x = __uint_as_float(xx.x << 16); xs.y = __uint_as_float(xx.x & 0xffff0000u); xs.z = __uint_as_float(xx.y << 16); xs.w = __uint_as_float(xx.y & 0xffff0000u); }
                            u32x2 o; o.x = pk2(xs.x + g4.x * v.x, xs.y + g4.y * v.y); o.y = pk2(xs.z + g4.z * v.z, xs.w + g4.w * v.w);
                            *(u32x2*)(XR + (size_t)row * D + col) = o;
                        }
                    };
                pg8::gemm_phase(tid, (PG8_LAS unsigned char*)lds, pg8::Gemm{MIXIN, W, D, D, D}, so, pg8::make_epi_g(pre, gp, f));
            }
        }
        else if (mph == 9) {
            const bf16_t* W = W_RT + (size_t)layer * 128 * 1024;
            const float* rb = rtb_all + layer * 32;
            float* lgs = (float*)(lds + 40960);
            unsigned* hist = (unsigned*)(lds + 40960 + 128 * 33 * 4);
            unsigned* gcnt = ctl + CW_CNT + layer * 64;
            const float* ng = kp->norm_ffn_g + layer * D;
            for (int tile = vb; tile < T / 128; tile += G) {
              for (int rep_ = 0; rep_ <= PROBE_RT2; ++rep_) {
                if (rep_) __syncthreads();
                for (int i = 0; i < 16; i += 2) {
                    u32x4 xr[2][2];
#pragma unroll
                    for (int q = 0; q < 2; ++q)
#pragma unroll
                        for (int j = 0; j < 2; ++j) xr[q][j] = *(const u32x4*)(XR + (size_t)(tile * 128 + wave * 16 + i + q) * D + 8 * lane + 512 * j);
#pragma unroll
                    for (int q = 0; q < 2; ++q) {
                        const int row = tile * 128 + wave * 16 + i + q, b = row / S;
                        float v[2][8]; unpack8(xr[q][0], v[0]); unpack8(xr[q][1], v[1]);
                        const float* mm = MOD + ((size_t)layer * NB + b) * 6144 + 3 * D;
                        norm_mod_store8(v, ng, mm + D, mm, HB + (size_t)row * D, HB8 + (size_t)row * D, lane);
                    }
                }
                if (tid < 64) hist[tid] = 0u;
                asm volatile("s_waitcnt vmcnt(0)" ::: "memory");
                __syncthreads();
                sg_tile(tid, lds, HB + (size_t)tile * 128 * D, D, W, D, D,
                    [=](int r, int c, f32x4 v0, f32x4 v1) {
                        if (c < 32) {
#pragma unroll
                            for (int i = 0; i < 4; ++i) { lgs[r * 33 + c + i] = v0[i] + rb[c + i]; lgs[r * 33 + c + 16 + i] = v1[i] + rb[c + 16 + i]; }
                        }
                    });
              }
                __syncthreads();
                const bool act = tid < 128; const int rr = tid & 127;
                float lg[32];
#pragma unroll
                for (int e = 0; e < 32; ++e) lg[e] = lgs[rr * 33 + e];
                int e0 = 0, e1 = 0, e2 = 0, e3 = 0; float v0_ = 0.f, v1_ = 0.f, v2_ = 0.f, v3_ = 0.f;
#pragma unroll
                for (int k = 0; k < 4; ++k) {
                    float best = -INFINITY; int bi = 0;
#pragma unroll
                    for (int e = 0; e < 32; ++e) { const bool tk = lg[e] > best; best = tk ? lg[e] : best; bi = tk ? e : bi; }
                    if (k == 0) { e0 = bi; v0_ = best; } else if (k == 1) { e1 = bi; v1_ = best; } else if (k == 2) { e2 = bi; v2_ = best; } else { e3 = bi; v3_ = best; }
#pragma unroll
                    for (int e = 0; e < 32; ++e) lg[e] = (e == bi) ? -INFINITY : lg[e];
                }
                const float x1_ = __expf(v1_ - v0_), x2_ = __expf(v2_ - v0_), x3_ = __expf(v3_ - v0_);
                const float rden = 1.0f / (1.0f + x1_ + x2_ + x3_);
                unsigned l0 = 0, l1 = 0, l2 = 0, l3 = 0;
                if (act) { l0 = atomicAdd(hist + e0, 1u); l1 = atomicAdd(hist + e1, 1u); l2 = atomicAdd(hist + e2, 1u); l3 = atomicAdd(hist + e3, 1u); }
                __syncthreads();
                if (tid < 32) hist[32 + tid] = atomicAdd(gcnt + tid, (unsigned)hist[tid]);
                __syncthreads();
                if (act) {
                    const int tok = tile * 128 + tid;
                    size_t idx = (size_t)e0 * T + hist[32 + e0] + l0; EL_SLOT[idx] = tok * 4 + 0; EL_GATE[idx] = rden;
                    idx = (size_t)e1 * T + hist[32 + e1] + l1; EL_SLOT[idx] = tok * 4 + 1; EL_GATE[idx] = x1_ * rden;
                    idx = (size_t)e2 * T + hist[32 + e2] + l2; EL_SLOT[idx] = tok * 4 + 2; EL_GATE[idx] = x2_ * rden;
                    idx = (size_t)e3 * T + hist[32 + e3] + l3; EL_SLOT[idx] = tok * 4 + 3; EL_GATE[idx] = x3_ * rden;
                }
                __syncthreads();
            }
        }
        else if (mph == 10 || mph == 11) {
            int* pst = (int*)(lds + LDS_MISC + 1024);
            if (tid == 0) {
                const unsigned* gcnt = ctl + CW_CNT + layer * 64; int acc = 0;
                for (int e = 0; e < 32; ++e) { const int c = (int)gcnt[e]; pst[e] = acc; pst[64 + e] = c; acc += (c + 255) & ~255; }
                pst[32] = acc;
            }
            __syncthreads();
            const int total_rows = pst[32];
            if (mph == 10) {
                {
                    MoeOrder so; so.go.init(total_rows >> 8, 8, G, vb); so.pst = pst; so.NT = 8; so.ebase = layer * 32; so.el_slot = EL_SLOT;
                    struct G1Ctx { f32x4 b0[2], b1[2]; };
                    auto pre = [=](const pg8::Unit& u, int wr, int wc, int fr, int fq, const PG8_LAS unsigned char* cxl) {
                            G1Ctx cx;
#pragma unroll
                            for (int bj = 0; bj < 2; ++bj) { const int jl = (bj * 4 + wc) * 16 + 4 * fq;
                                cx.b0[bj] = *(const PG8_LAS f32x4*)(cxl + jl * 4); cx.b1[bj] = *(const PG8_LAS f32x4*)(cxl + 512 + jl * 4); }
                            return cx; };
                    auto stg = [=](const pg8::Unit& u, PG8_LAS unsigned char* cb, int wid, int lane) {
                            if (wid == 0) { const float* src = bgu_all + (size_t)(layer * 32 + u.aux) * 2048 + (lane >> 5) * 1024 + u.pn * 128 + (lane & 31) * 4;
                                __builtin_amdgcn_global_load_lds((const unsigned*)src, (PG8_LAS unsigned*)cb, 16, 0, 0); } };
                    auto f = [=](const pg8::Unit& u, const G1Ctx& cx, int ai, int m, int bj, int tr, int c, f32x4 v0, f32x4 v1, PG8_LAS unsigned char* tile) {
                            const int jl = (c >> 5) * 16 + (c & 15);
                            const f32x4 b0 = cx.b0[bj], b1 = cx.b1[bj];
                            typedef float f32x2 __attribute__((ext_vector_type(2)));
                            float o[4];
#pragma unroll
                            for (int q = 0; q < 2; ++q) {
                                f32x2 gt = (f32x2){v0[2 * q], v0[2 * q + 1]} + (f32x2){b0[2 * q], b0[2 * q + 1]};
                                f32x2 ln = (f32x2){v1[2 * q], v1[2 * q + 1]} + (f32x2){b1[2 * q], b1[2 * q + 1]};
                                gt.x = __builtin_amdgcn_fmed3f(gt.x, -INFINITY, 7.0f); gt.y = __builtin_amdgcn_fmed3f(gt.y, -INFINITY, 7.0f);
                                ln.x = __builtin_amdgcn_fmed3f(ln.x, -7.0f, 7.0f); ln.y = __builtin_amdgcn_fmed3f(ln.y, -7.0f, 7.0f);
                                const f32x2 t = gt * (-1.702f * 1.4426950408889634f);
                                f32x2 e; e.x = __builtin_amdgcn_exp2f(t.x); e.y = __builtin_amdgcn_exp2f(t.y);
                                const f32x2 d = e + 1.0f;
                                f32x2 r; r.x = __builtin_amdgcn_rcpf(d.x); r.y = __builtin_amdgcn_rcpf(d.y);
                                const f32x2 ov = (gt * r) * (ln + 1.0f);
                                o[2 * q] = ov.x; o[2 * q + 1] = ov.y;
                            }
                            *(PG8_LAS unsigned*)(tile + tr * 144 + jl) = pk4_fp8(o[0], o[1], o[2], o[3]);
                        };
                    auto fl = [=](const pg8::Unit& u, const G1Ctx&, int ai, int m0, int tid_, PG8_LAS unsigned char* tile) {
                            const int tr = tid_ >> 3, piece = tid_ & 7;
                            const u32x4 v = *(const PG8_LAS u32x4*)(tile + tr * 144 + piece * 16);
                            const int row = u.pm * 256 + ai * 128 + ((tr >> 4) & 1) * 64 + (m0 + (tr >> 5)) * 16 + (tr & 15);
                            *(u32x4*)(ACT + (size_t)row * D + u.pn * 128 + piece * 16) = v;
                        };
                    pg8::gemm_phase<true, true>(tid, (PG8_LAS unsigned char*)lds, pg8::Gemm{(const bf16_t*)HB8, (const bf16_t*)W_GU, 512, 512, 512}, so, pg8::make_epi_staged<2, 9216>(pre, f, fl), stg, LDS_CTX_OFF);
                }
            } else {
                {
                    MoeOrder so; so.go.init(total_rows >> 8, 4, G, vb); so.pst = pst; so.NT = 4; so.ebase = layer * 32; so.el_slot = EL_SLOT;
                    struct G2Ctx { float gate[8]; int slot[8]; f32x4 bb[2][2]; };
                    auto pre = [=](const pg8::Unit& u, int wr, int wc, int fr, int fq, const PG8_LAS unsigned char* cxl) {
                            G2Ctx cx;
                            const int ro0 = u.pm * 256 - pst[u.aux], cnt = pst[64 + u.aux];
#pragma unroll
                            for (int q = 0; q < 8; ++q) { const int rl = (q >> 2) * 128 + wr * 64 + (q & 3) * 16 + fr; const bool ok = ro0 + rl < cnt;
                                const float gv = *(const PG8_LAS float*)(cxl + 1024 + rl * 4); const int sv = *(const PG8_LAS int*)(cxl + 2048 + rl * 4);
                                cx.gate[q] = ok ? gv : 0.f; cx.slot[q] = ok ? sv : -1; }
#pragma unroll
                            for (int bj = 0; bj < 2; ++bj)
#pragma unroll
                                for (int h = 0; h < 2; ++h) cx.bb[bj][h] = *(const PG8_LAS f32x4*)(cxl + (bj * 128 + wc * 32 + 8 * fq + 4 * h) * 4);
                            return cx; };
                    auto stg = [=](const pg8::Unit& u, PG8_LAS unsigned char* cb, int wid, int lane) {
                            const size_t eo = (size_t)u.aux * T + (u.pm * 256 - pst[u.aux]) + lane * 4;
                            if (wid == 0) __builtin_amdgcn_global_load_lds((const unsigned*)(bdn_all + (size_t)(layer * 32 + u.aux) * 1024 + u.pn * 256 + lane * 4), (PG8_LAS unsigned*)cb, 16, 0, 0);
                            else if (wid == 1) __builtin_amdgcn_global_load_lds((const unsigned*)(EL_GATE + eo), (PG8_LAS unsigned*)(cb + 1024), 16, 0, 0);
                            else if (wid == 2) __builtin_amdgcn_global_load_lds((const unsigned*)(EL_SLOT + eo), (PG8_LAS unsigned*)(cb + 2048), 16, 0, 0); };
                    auto f = [=](const pg8::Unit& u, const G2Ctx& cx, int ai, int m, int bj, int r, int c8, f32x4 v0, f32x4 v1) {
                            const int slot = cx.slot[ai * 4 + m];
                            if (slot >= 0) {
                                const float gt = cx.gate[ai * 4 + m]; const f32x4 b0 = cx.bb[bj][0], b1 = cx.bb[bj][1];
                                u32x4 o; o.x = pk2((v0.x + b0.x) * gt, (v0.y + b0.y) * gt); o.y = pk2((v0.z + b0.z) * gt, (v0.w + b0.w) * gt);
                                o.z = pk2((v1.x + b1.x) * gt, (v1.y + b1.y) * gt); o.w = pk2((v1.z + b1.z) * gt, (v1.w + b1.w) * gt);
                                *(u32x4*)(Y + (size_t)slot * D + u.pn * 256 + c8) = o;
                            }
                        };
                    pg8::gemm_phase<true, false, true>(tid, (PG8_LAS unsigned char*)lds, pg8::Gemm{(const bf16_t*)ACT, (const bf16_t*)W_DN, 512, 512, 512}, so, pg8::make_epi_perm(pre, f), stg, LDS_CTX_OFF);
                }
            }
        }
        else if (ph == 13) {
            {
                DenseOrder so; so.go.init(T / 256, 6, G, vb);
                auto f = [=](const pg8::Unit& u, const pg8::NoCtx&, int ai, int m, int bj, int r, int c, f32x4 v0, f32x4 v1) {
                        const int row = u.pm * 256 + r, col = u.pn * 256 + c;
                        if (col >= 512) { v0.x = gelu_tanh(v0.x); v0.y = gelu_tanh(v0.y); v0.z = gelu_tanh(v0.z); v0.w = gelu_tanh(v0.w); v1.x = gelu_tanh(v1.x); v1.y = gelu_tanh(v1.y); v1.z = gelu_tanh(v1.z); v1.w = gelu_tanh(v1.w); }
                        u32x4 o; o.x = pk2(v0.x, v0.y); o.y = pk2(v0.z, v0.w); o.z = pk2(v1.x, v1.y); o.w = pk2(v1.z, v1.w);
                        *(u32x4*)(Z + (size_t)row * 1536 + col) = o;
                    };
                pg8::gemm_phase<false, false, true>(tid, (PG8_LAS unsigned char*)lds, pg8::Gemm{HB, W_IN_O, D, D, D}, so, pg8::make_epi_perm(pg8::NoPre{}, f));
            }
        }
        else if (ph == 14) {
            for (int ck = vb; ck < T / 128; ck += G) {
                bf16_t* tile = (bf16_t*)lds;
                {
                    const int ch0 = lane * 8, w = 2 << (ch0 >> 7);
                    const int row0 = ck * 128 + wave * 16, t0 = row0 % S;
                    float gsg[8];
#pragma unroll
                    for (int i = 0; i < 8; ++i) gsg[i] = kp->sgu_norm_g[lane * 8 + i];
                    float run[8];
#pragma unroll
                    for (int i = 0; i < 8; ++i) run[i] = 0.f;
                    for (int q = 1; q <= w; ++q) {
                        if (t0 - q >= 0) { float f[8]; unpack8(*(const u32x4*)(Z + (size_t)(row0 - q) * 1536 + ch0), f);
#pragma unroll
                            for (int i = 0; i < 8; ++i) run[i] += f[i]; }
                    }
                    u32x4 cu, cl, cz, nu, nl, nz;
#define P14_LOAD(r_, t_, U_, L_, Z_) do { U_ = *(const u32x4*)(Z + (size_t)(r_) * 1536 + ch0); L_ = ((t_) - w >= 0) ? *(const u32x4*)(Z + (size_t)((r_) - w) * 1536 + ch0) : (u32x4){0u, 0u, 0u, 0u}; \
                        Z_ = *(const u32x4*)(Z + (size_t)(r_) * 1536 + 1024 + lane * 8); } while (0)
                    P14_LOAD(row0, t0, cu, cl, cz);
                    for (int tt = 0; tt < 16; ++tt) {
                        const int sl = wave * 16 + tt, row = row0 + tt, t = t0 + tt;
                        if (tt + 1 < 16) P14_LOAD(row + 1, t + 1, nu, nl, nz);
                        float own[8], old[8];
                        unpack8(cu, own); unpack8(cl, old);
#pragma unroll
                        for (int i = 0; i < 8; ++i) run[i] += own[i] - old[i];
                        const int n = (t + 1 < w) ? t + 1 : w;
                        const float inv = 1.0f / (float)n;
                        float po[8];
#pragma unroll
                        for (int i = 0; i < 8; ++i) po[i] = run[i] * inv - own[i];
                        *(u32x4*)(POOLED + (size_t)row * 512 + ch0) = pack8(po);
                        float f[8]; unpack8(cz, f);
                        float ss = 0.f;
#pragma unroll
                        for (int i = 0; i < 8; ++i) ss += f[i] * f[i];
                        const float rr = rsqrtf(wave_sum(ss) * (1.f / 512.f) + 1e-6f);
#pragma unroll
                        for (int i = 0; i < 8; ++i) f[i] *= rr * gsg[i];
                        *(u32x4*)(tile + sl * 520 + lane * 8) = pack8(f);
                        cu = nu; cl = nl; cz = nz;
                    }
#undef P14_LOAD
                }
                __syncthreads();
                {
                    const int ch = tid;
                    bf16_t* dst = VTS + ((size_t)ck * 512 + ch) * 128;
                    for (int s8 = 0; s8 < 16; ++s8) {
                        unsigned w[4];
#pragma unroll
                        for (int i = 0; i < 4; ++i) w[i] = (unsigned)tile[(s8 * 8 + 2 * i) * 520 + ch] | ((unsigned)tile[(s8 * 8 + 2 * i + 1) * 520 + ch] << 16);
                        u32x4 o; o.x = w[0]; o.y = w[1]; o.z = w[2]; o.w = w[3];
                        *(u32x4*)(dst + s8 * 8) = o;
                    }
                }
                __syncthreads();
            }
        }
        else if (ph == 15) {
            for (int u = vb; u < 2048; u += G) {
                if (u < 1024) {
                    const int pm = u >> 2, gi = u & 3;
                    sg_tile(tid, lds, POOLED + (size_t)pm * 128 * 512 + gi * 128, 512, W_POOL + (size_t)gi * 128 * 128, 128, 128,
                        [=](int r, int c, f32x4 v0, f32x4 v1) {
                            const int row = pm * 128 + r;
#pragma unroll
                            for (int h = 0; h < 2; ++h) {
                                const int col = gi * 128 + c + 16 * h; const f32x4 v = h ? v1 : v0;
                                const f32x4 sc = *(const f32x4*)(poolsc + col);
                                u32x2 o; o.x = pk2(v.x * sc.x, v.y * sc.y); o.y = pk2(v.z * sc.z, v.w * sc.w);
                                *(u32x2*)(MIXIN + (size_t)row * 1024 + col) = o;
                            }
                        });
                } else {
                    const int uu = u - 1024, ck = uu >> 2, h4 = uu & 3;
                    sg_tile(tid, lds, W_SGU + (size_t)h4 * 128 * 128, 128, VTS + ((size_t)ck * 512 + h4 * 128) * 128, 128, 128,
                        [=](int r, int c, f32x4 v0, f32x4 v1) {
                            const int row = ck * 128 + r;
                            const float bias = sgub[h4 * 128 + r];
#pragma unroll
                            for (int h = 0; h < 2; ++h) {
                                const int dcol = c + 16 * h; const f32x4 v = h ? v1 : v0;
                                const u32x2 ug = *(const u32x2*)(Z + (size_t)row * 1536 + 512 + h4 * 128 + dcol);
                                u32x2 o; o.x = pk2((v.x + bias) * __uint_as_float(ug.x << 16), (v.y + bias) * __uint_as_float(ug.x & 0xffff0000u));
                                o.y = pk2((v.z + bias) * __uint_as_float(ug.y << 16), (v.w + bias) * __uint_as_float(ug.y & 0xffff0000u));
                                *(u32x2*)(MIXIN + (size_t)row * 1024 + 512 + h4 * 128 + dcol) = o;
                            }
                        });
                }
            }
        }

    }
}
template <int PH> struct PhaseSeq {
    static __device__ __forceinline__ void run(const XcdBarrier& bar) { PhaseSeq<PH - 1>::run(bar); if constexpr (PH == 3) return;
        unsigned long long t0_ = 0; if constexpr (PH == PROBE_TPH) t0_ = __builtin_amdgcn_s_memrealtime();
        phase_body<PH>(bar.wbase);
        if constexpr (((PROBE_DUP_MASK >> PH) & 1ull) != 0) { xcd_barrier(bar); phase_body<PH>(bar.wbase); }
        if (PH + 1 < NPHASE) { xcd_barrier(bar); if constexpr (PROBE_BAR2) xcd_barrier(bar); }
        if constexpr (PH == PROBE_TPH) { if (bar.wbase == 0 && lane_id() == 0) { const unsigned dt = (unsigned)(__builtin_amdgcn_s_memrealtime() - t0_); bar.st[4] = dt; } }
    }
};
template <> struct PhaseSeq<-1> { static __device__ __forceinline__ void run(const XcdBarrier&) {} };

template <int PHSEL> __global__ void __launch_bounds__(NTHR, 2) hybrid_fwd(Params p) {
    extern __shared__ __attribute__((aligned(16))) unsigned char lds[];
    const int tid0 = threadIdx.x;
    for (int u = tid0; u < (LDS_BYTES - LDS_MISC) / 4; u += NTHR) ((unsigned*)(lds + LDS_MISC))[u] = 0u;
    __syncthreads();
    if constexpr (PHSEL >= 0) { phase_body<PHSEL>(__builtin_amdgcn_readfirstlane((int)threadIdx.x & ~63)); }
    else {
        volatile LAS unsigned* MISC = (volatile LAS unsigned*)((LAS unsigned char*)lds + LDS_MISC);
        unsigned* ctl0 = (unsigned*)(p.ws + WS_CTL);
        XcdBarrier bar = xcd_barrier_post(ctl0 + CW_BAR, MISC + 8);
        PhaseSeq<NPHASE - 1>::run(bar);
        if constexpr (PROBE_TPH >= 0 || PROBE_SEG != 0) { if (blockIdx.x == 0 && bar.wbase == 0 && lane_id() == 0) { const unsigned dt = MISC[12]; const unsigned long long te = __builtin_amdgcn_s_memrealtime(); while (__builtin_amdgcn_s_memrealtime() - te < 4ull * dt) __builtin_amdgcn_s_sleep(8); } }
    }
}

typedef void (*kfn_t)(Params);
template <int PH> struct Tab { static void fill(kfn_t* t) { t[PH] = hybrid_fwd<PH>; Tab<PH - 1>::fill(t); } };
template <> struct Tab<-1> { static void fill(kfn_t*) {} };
static kfn_t g_tab[NPHASE];
static void set_attrs() {
#if MK_ONE_LAUNCH
    (void)hipFuncSetAttribute((const void*)hybrid_fwd<-1>, hipFuncAttributeMaxDynamicSharedMemorySize, LDS_BYTES);
#else
    Tab<NPHASE - 1>::fill(g_tab);
    for (int i = 0; i < NPHASE; ++i) (void)hipFuncSetAttribute((const void*)g_tab[i], hipFuncAttributeMaxDynamicSharedMemorySize, LDS_BYTES);
#endif
}
#if !MK_ONE_LAUNCH
static void launch_all(const Params& p, int grid, hipStream_t stream) {
    for (int ph = 0; ph < NPHASE; ++ph) hipLaunchKernelGGL(g_tab[ph], dim3(grid), dim3(NTHR), LDS_BYTES, stream, p);
}
#endif
extern "C" void kernel_launch(void* const* d_in, const int* in_sizes, int n_in, void* d_out, int out_size, void* d_ws, size_t ws_size, hipStream_t stream) {
    static int ready = 0;
    if (ready == 0) {
        if (n_in != 38 || ws_size < WS_END) { fprintf(stderr, "kernel_launch: unexpected n_in %d / ws %zu\n", n_in, ws_size); ready = -1; return; }
        set_attrs();
        ready = 1;
    }
    if (ready < 0) return;
    (void)hipMemsetAsync((char*)d_ws + WS_CTL, 0, CTL_ZERO_BYTES, stream);
    Params p{};
    const float** fp = (const float**)&p.x;
    (void)fp;
    p.x = (const float*)d_in[0]; p.c = (const float*)d_in[1]; p.pos = (const int*)d_in[2];
    p.ada_w = (const float*)d_in[3]; p.ada_b = (const float*)d_in[4]; p.norm_mix_g = (const float*)d_in[5]; p.norm_ffn_g = (const float*)d_in[6];
    p.router_w = (const float*)d_in[7]; p.router_b = (const float*)d_in[8]; p.moe_w_gu = (const float*)d_in[9]; p.moe_b_gu = (const float*)d_in[10];
    p.moe_w_dn = (const float*)d_in[11]; p.moe_b_dn = (const float*)d_in[12];
    p.even_w_in = (const float*)d_in[13]; p.q_norm_g = (const float*)d_in[14]; p.w_uq = (const float*)d_in[15]; p.kv_norm_g = (const float*)d_in[16];
    p.w_ukv = (const float*)d_in[17]; p.q_head_g = (const float*)d_in[18]; p.k_head_g = (const float*)d_in[19];
    p.s5_a_re = (const float*)d_in[20]; p.s5_a_im = (const float*)d_in[21]; p.s5_log_dt = (const float*)d_in[22]; p.s5_b_re = (const float*)d_in[23];
    p.s5_b_im = (const float*)d_in[24]; p.s5_c_re = (const float*)d_in[25]; p.s5_c_im = (const float*)d_in[26]; p.s5_d = (const float*)d_in[27];
    p.s5_glu_w = (const float*)d_in[28]; p.s5_glu_b = (const float*)d_in[29]; p.even_w_out = (const float*)d_in[30];
    p.odd_w_in = (const float*)d_in[31]; p.pool_w = (const float*)d_in[32]; p.pool_scale = (const float*)d_in[33]; p.sgu_norm_g = (const float*)d_in[34];
    p.sgu_w = (const float*)d_in[35]; p.sgu_b = (const float*)d_in[36]; p.odd_w_out = (const float*)d_in[37];
    p.out = (float*)d_out; p.ws = (unsigned char*)d_ws;
    const int grid = 256;
#if MK_ONE_LAUNCH
    p.ph_lo = 0; p.ph_hi = NPHASE;
    hipLaunchKernelGGL(hybrid_fwd<-1>, dim3(grid), dim3(NTHR), LDS_BYTES, stream, p);
#else
    p.ph_lo = 0; p.ph_hi = 1;
    launch_all(p, grid, stream);
#endif
}
```

```cpp
#include <hip/hip_runtime.h>
#include <cstdio>
#include <cstdint>

#ifndef PROBE_DUP_MASK
#define PROBE_DUP_MASK 0x0ull
#endif
#ifndef PROBE_ATT2
#define PROBE_ATT2 0
#endif
#ifndef PROBE_RT2
#define PROBE_RT2 0
#endif
#ifndef PROBE_TPH
#define PROBE_TPH -1
#endif
#ifndef PROBE_SEG
#define PROBE_SEG 0
#endif
#ifndef PROBE_CONV2
#define PROBE_CONV2 0
#endif
#ifndef PROBE_BAR2
#define PROBE_BAR2 0
#endif
#ifndef PROBE_EPI2
#define PROBE_EPI2 0
#endif
#ifndef PROBE_KX2
#define PROBE_KX2 0
#endif
#ifndef MK_ONE_LAUNCH
#define MK_ONE_LAUNCH 1
#endif

typedef unsigned short bf16_t;
typedef short bf16x8 __attribute__((ext_vector_type(8)));
typedef short s16x4 __attribute__((ext_vector_type(4)));
typedef float f32x4 __attribute__((ext_vector_type(4)));
typedef float f32x16 __attribute__((ext_vector_type(16)));
typedef unsigned u32x4 __attribute__((ext_vector_type(4)));
typedef unsigned u32x2 __attribute__((ext_vector_type(2)));

constexpr int D = 1024, NB = 8, S = 4096, T = NB * S;
constexpr int NTHR = 512, NWAVE = 8;
constexpr int MOE_ROWS = 139264;
constexpr int NPHASE = 21;

constexpr size_t MiB = 1u << 20;
constexpr size_t WS_CTL = 0, CTL_ZERO_BYTES = 1 * MiB;
constexpr size_t WS_MOD = 1 * MiB;
constexpr size_t WS_S5AB = 2 * MiB;
constexpr size_t WS_PW = 3 * MiB;
constexpr size_t WS_KTAB = 5 * MiB;
constexpr size_t WS_TOK = 7 * MiB;
constexpr size_t WS_ROW = 9 * MiB;
constexpr size_t WS_LOGIT = 11 * MiB;
constexpr size_t WS_W_IN_E = 16 * MiB, WS_W_UP = 18 * MiB  , WS_W_GLU = 20 * MiB, WS_W_OUT_E = 21 * MiB, WS_W_IN_O = 23 * MiB,
                 WS_W_OUT_O = 26 * MiB, WS_W_POOL = 28 * MiB, WS_W_SGU = 29 * MiB, WS_W_RT = 30 * MiB;
constexpr size_t WS_BT_END = 32 * MiB;
constexpr size_t WS_BT_MAIN = 40 * MiB;
constexpr size_t WS_W_GU = 112 * MiB;
constexpr size_t WS_W_DN = 240 * MiB;
constexpr size_t WS_HB8 = 304 * MiB;
constexpr size_t WS_XR = 336 * MiB;
constexpr size_t WS_HB = 496 * MiB;
constexpr size_t WS_MIXIN = 560 * MiB;
constexpr size_t WS_Y = 624 * MiB;
constexpr size_t WS_EL = 880 * MiB;
constexpr size_t WS_ACT = 1152 * MiB;
constexpr size_t WS_END = 1424 * MiB;
constexpr size_t WS_Z = 880 * MiB;
constexpr size_t WS_RSP = 976 * MiB  , WS_QKVRAW = 1000 * MiB  , WS_Q = 1112 * MiB, WS_K = 1160 * MiB, WS_VT = 1208 * MiB,
                 WS_AS5 = 1240 * MiB, WS_LEND = 1276 * MiB, WS_GACT = 1284 * MiB;
constexpr size_t WS_POOLED = 976 * MiB, WS_VTS = 1008 * MiB;
constexpr int CW_BAR = 4096, CW_CNT = 16384, CW_Q = 16640  ;

constexpr int LDS_BYTES = 160 * 1024;
constexpr int LDS_CTX_OFF = 18432;
constexpr int LDS_MISC = 158 * 1024;

struct Params {
    const float *x, *c; const int* pos;
    const float *ada_w, *ada_b, *norm_mix_g, *norm_ffn_g, *router_w, *router_b, *moe_w_gu, *moe_b_gu, *moe_w_dn, *moe_b_dn;
    const float *even_w_in, *q_norm_g, *w_uq, *kv_norm_g, *w_ukv, *q_head_g, *k_head_g;
    const float *s5_a_re, *s5_a_im, *s5_log_dt, *s5_b_re, *s5_b_im, *s5_c_re, *s5_c_im, *s5_d, *s5_glu_w, *s5_glu_b, *even_w_out;
    const float *odd_w_in, *pool_w, *pool_scale, *sgu_norm_g, *sgu_w, *sgu_b, *odd_w_out;
    float* out; unsigned char* ws; int ph_lo, ph_hi;
};

__device__ __forceinline__ float bf2f(unsigned short b) { return __uint_as_float(((unsigned)b) << 16); }
__device__ __forceinline__ unsigned pk2(float lo, float hi) {
    typedef float f2 __attribute__((ext_vector_type(2))); typedef __bf16 b2 __attribute__((ext_vector_type(2)));
    f2 v = {lo, hi}; b2 b = __builtin_convertvector(v, b2); return __builtin_bit_cast(unsigned, b);
}
__device__ __forceinline__ unsigned short f2bf(float f) { return (unsigned short)(pk2(f, 0.f) & 0xffffu); }
__device__ __forceinline__ float wave_sum(float v) {
#pragma unroll
    for (int o = 1; o < 64; o <<= 1) v += __shfl_xor(v, o);
    return v;
}
__device__ __forceinline__ float sigmoidf_(float x) { return __builtin_amdgcn_rcpf(1.0f + __builtin_amdgcn_exp2f(-1.4426950408889634f * x)); }
__device__ __forceinline__ float gelu_tanh(float x) {
    const float u = 0.7978845608028654f * (x + 0.044715f * x * x * x);
    return x * sigmoidf_(2.0f * u);
}
__device__ __forceinline__ unsigned pk4_fp8(float a, float b, float c, float d) {
    int w = 0; w = __builtin_amdgcn_cvt_pk_fp8_f32(a, b, w, false); w = __builtin_amdgcn_cvt_pk_fp8_f32(c, d, w, true); return (unsigned)w;
}
__device__ __forceinline__ int crow(int r, int hi) { return (r & 3) + 8 * (r >> 2) + 4 * hi; }

#define LAS __attribute__((address_space(3)))
#define XB_TMO      128
#define XB_XCNT(j)  (256  + 64 * (j))
#define XB_XSUB(j)  (1280 + 64 * (j))
#define XB_XGEN(j)  (2304 + 64 * (j))
#define XB_TOP      3328
#define XB_TOPGEN   3392
#define XCD_BAR_WORDS 3456
#define XB_SPIN_CAP (1u << 20)
__device__ __forceinline__ unsigned xb_ld(unsigned* p)              { return __hip_atomic_load(p, __ATOMIC_RELAXED, __HIP_MEMORY_SCOPE_AGENT); }
__device__ __forceinline__ unsigned xb_add(unsigned* p, unsigned v) { return __hip_atomic_fetch_add(p, v, __ATOMIC_RELAXED, __HIP_MEMORY_SCOPE_AGENT); }
__device__ __forceinline__ unsigned xb_xcc_id() { return (unsigned)__builtin_amdgcn_s_getreg((3 << 11) | 20) & 0xFu; }
#define XB_SPIN(cond, bar) do { unsigned _sp = 0; while (cond) { __builtin_amdgcn_s_sleep(1); \
    if ((++_sp & 255u) == 0u) { if (xb_ld(&(bar)[XB_TMO])) break; if (_sp > XB_SPIN_CAP) { atomicAdd(&(bar)[XB_TMO], 1u); break; } } } } while (0)
struct XcdBarrier { unsigned* bar; unsigned x; volatile LAS unsigned* st; int wbase; };
__device__ __forceinline__ int lane_id() { int l; asm volatile("v_mbcnt_lo_u32_b32 %0, -1, 0\n\tv_mbcnt_hi_u32_b32 %0, -1, %0" : "=v"(l)); return l; }
__device__ __forceinline__ XcdBarrier xcd_barrier_post(unsigned* bar, volatile LAS unsigned* st) {
    XcdBarrier b; b.bar = bar; b.x = xb_xcc_id(); b.st = st; b.wbase = __builtin_amdgcn_readfirstlane((int)threadIdx.x & ~63);
    if (threadIdx.x == 0) (void)xb_add(&bar[XB_XCNT(b.x)], 1u);
    return b;
}
__device__ __forceinline__ void xcd_barrier_complete(unsigned* bar, unsigned x, unsigned& nloc, unsigned& nx) {
    const unsigned G = gridDim.x * gridDim.y * gridDim.z;
    unsigned sum, cnt, mine, sp = 0u;
    for (;;) {
        sum = 0u; cnt = 0u; mine = 0u;
#pragma unroll
        for (unsigned j = 0; j < 16; ++j) { const unsigned c = xb_ld(&bar[XB_XCNT(j)]); sum += c; cnt += (c > 0u) ? 1u : 0u; mine = (j == x) ? c : mine; }
        if (sum == G) break;
        __builtin_amdgcn_s_sleep(1);
        if ((++sp & 255u) == 0u) { if (xb_ld(&bar[XB_TMO])) break; if (sp > XB_SPIN_CAP) { atomicAdd(&bar[XB_TMO], 1u); break; } }
    }
    nloc = mine > 0u ? mine : 1u; nx = cnt > 0u ? cnt : 1u;
}
__device__ __forceinline__ void xcd_barrier(const XcdBarrier& b) {
    asm volatile("s_waitcnt vmcnt(0)" ::: "memory");
    __syncthreads();
    if (b.wbase == 0 && lane_id() == 0) {
        unsigned* bar = b.bar;
        __builtin_amdgcn_s_waitcnt(0);
        unsigned nloc = b.st[0], nx = b.st[1];
        if (nloc == 0u) { xcd_barrier_complete(bar, b.x, nloc, nx); b.st[0] = nloc; b.st[1] = nx; }
        const unsigned old = xb_add(&bar[XB_XSUB(b.x)], 1u);
        const unsigned gen = old / nloc;
        if (old + 1u == (gen + 1u) * nloc) {
            __builtin_amdgcn_fence(__ATOMIC_RELEASE, "agent");
            asm volatile("s_waitcnt vmcnt(0)" ::: "memory");
            const unsigned og = xb_add(&bar[XB_TOP], 1u);
            const unsigned tg = og / nx;
            if (og + 1u == (tg + 1u) * nx) xb_add(&bar[XB_TOPGEN], 1u);
            else XB_SPIN(xb_ld(&bar[XB_TOPGEN]) == tg, bar);
            __builtin_amdgcn_fence(__ATOMIC_ACQUIRE, "agent");
            xb_add(&bar[XB_XGEN(b.x)], 1u);
            asm volatile("s_waitcnt vmcnt(0)" ::: "memory");
        } else {
            XB_SPIN(xb_ld(&bar[XB_XGEN(b.x)]) == gen, bar);
            __builtin_amdgcn_fence(__ATOMIC_ACQUIRE, "agent");
            asm volatile("s_waitcnt vmcnt(0)" ::: "memory");
        }
    }
    __syncthreads();
}

constexpr int SG_LDS = 2 * 128 * 144;
template <class Epi>
__device__ __forceinline__ void sg_tile(int tid, unsigned char* lds, const bf16_t* A, int lda, const bf16_t* Bt, int ldb, int K, Epi epi) {
    const int lane = tid & 63, wid = tid >> 6, wr = wid >> 2, wc = wid & 3, fr = lane & 15, fq = lane >> 4;
    unsigned char* As = lds; unsigned char* Bs = lds + 128 * 144;
    f32x4 acc[4][2];
#pragma unroll
    for (int m = 0; m < 4; ++m)
#pragma unroll
        for (int n = 0; n < 2; ++n) acc[m][n] = (f32x4){0.f, 0.f, 0.f, 0.f};
    const int nt = K / 64;
    u32x4 ra[2], rb[2];
    const int r0 = tid >> 3, cc = tid & 7;
#pragma unroll
    for (int i = 0; i < 2; ++i) {
        ra[i] = *(const u32x4*)(A + (size_t)(r0 + 64 * i) * lda + cc * 8);
        rb[i] = *(const u32x4*)(Bt + (size_t)(r0 + 64 * i) * ldb + cc * 8);
    }
    for (int kt = 0; kt < nt; ++kt) {
        __syncthreads();
#pragma unroll
        for (int i = 0; i < 2; ++i) {
            *(u32x4*)(As + (r0 + 64 * i) * 144 + cc * 16) = ra[i];
            *(u32x4*)(Bs + (r0 + 64 * i) * 144 + cc * 16) = rb[i];
        }
        __syncthreads();
        if (kt + 1 < nt) {
#pragma unroll
            for (int i = 0; i < 2; ++i) {
                ra[i] = *(const u32x4*)(A + (size_t)(r0 + 64 * i) * lda + (kt + 1) * 64 + cc * 8);
                rb[i] = *(const u32x4*)(Bt + (size_t)(r0 + 64 * i) * ldb + (kt + 1) * 64 + cc * 8);
            }
        }
#pragma unroll
        for (int kk = 0; kk < 2; ++kk) {
            bf16x8 a[4], b[2];
#pragma unroll
            for (int m = 0; m < 4; ++m) a[m] = *(const bf16x8*)(As + (wr * 64 + m * 16 + fr) * 144 + kk * 64 + fq * 16);
#pragma unroll
            for (int n = 0; n < 2; ++n) b[n] = *(const bf16x8*)(Bs + (wc * 32 + n * 16 + fr) * 144 + kk * 64 + fq * 16);
#pragma unroll
            for (int m = 0; m < 4; ++m)
#pragma unroll
                for (int n = 0; n < 2; ++n) acc[m][n] = __builtin_amdgcn_mfma_f32_16x16x32_bf16(b[n], a[m], acc[m][n], 0, 0, 0);
        }
    }
#pragma unroll
    for (int m = 0; m < 4; ++m) epi(wr * 64 + m * 16 + fr, wc * 32 + fq * 4, acc[m][0], acc[m][1]);
}


namespace pg8 {
#define PG8_LAS __attribute__((address_space(3)))
constexpr int BM = 256, BK = 64, HALF = 128, HTB = HALF * BK * 2, STAGE_BYTES = 8 * HTB;
__device__ __forceinline__ int lds_byte(int r, int c) { const int st = (r >> 4) * 2 + (c >> 5), rr = r & 15, cc = c & 31, ob = rr * 64 + cc * 2; return st * 1024 + (ob ^ (((ob >> 9) & 1) << 5)); }
__device__ __forceinline__ void stage_rc(int b, int& R, int& C) { const int st = b / 1024, sb = b % 1024, swz = sb ^ (((sb >> 9) & 1) << 5); R = (st >> 1) * 16 + swz / 64; C = (st & 1) * 32 + (swz % 64) / 2; }
typedef int v8i_t __attribute__((ext_vector_type(8)));
typedef int v4i_t __attribute__((ext_vector_type(4)));
struct FragT { union { v8i_t v; struct { v4i_t lo, hi; }; }; };
struct Unit { int pm, pb, pn, aux; };
struct Gemm { const bf16_t* A; const bf16_t* Bt; int lda, ldb, K; };
struct NoCtx {};
struct NoPre { __device__ __forceinline__ NoCtx operator()(const Unit&, int, int, int, int, const PG8_LAS unsigned char*) const { return NoCtx{}; } };
struct NoStage { __device__ __forceinline__ void operator()(const Unit&, PG8_LAS unsigned char*, int, int) const {} };
template <class PF, class F> struct Epi {
    PF pre; F f;
    template <class Ctx>
    __device__ __forceinline__ void operator()(const f32x4 (&acc)[2][2][4][2], const Ctx& ctx, const Unit& u, int wr, int wc, int fr, int fq, PG8_LAS unsigned char*, int) const {
#pragma unroll
        for (int ai = 0; ai < 2; ++ai)
#pragma unroll
            for (int m = 0; m < 4; ++m)
#pragma unroll
                for (int bj = 0; bj < 2; ++bj) {
                    f32x4 v0, v1;
                    asm volatile("v_accvgpr_read_b32 %0, %8\n\tv_accvgpr_read_b32 %1, %9\n\tv_accvgpr_read_b32 %2, %10\n\tv_accvgpr_read_b32 %3, %11\n\t"
                                 "v_accvgpr_read_b32 %4, %12\n\tv_accvgpr_read_b32 %5, %13\n\tv_accvgpr_read_b32 %6, %14\n\tv_accvgpr_read_b32 %7, %15"
                                 : "=v"(v0.x), "=v"(v0.y), "=v"(v0.z), "=v"(v0.w), "=v"(v1.x), "=v"(v1.y), "=v"(v1.z), "=v"(v1.w)
                                 : "a"(acc[ai][bj][m][0].x), "a"(acc[ai][bj][m][0].y), "a"(acc[ai][bj][m][0].z), "a"(acc[ai][bj][m][0].w),
                                   "a"(acc[ai][bj][m][1].x), "a"(acc[ai][bj][m][1].y), "a"(acc[ai][bj][m][1].z), "a"(acc[ai][bj][m][1].w));
                    f(u, ctx, ai, m, bj, ai * HALF + wr * 64 + m * 16 + fr, bj * HALF + wc * 32 + 4 * fq, v0, v1);
                }
    }
};
template <class PF, class F> __device__ __forceinline__ Epi<PF, F> make_epi(PF p, F f) { return Epi<PF, F>{p, f}; }
template <class PF, class F> struct EpiPerm {
    PF pre; F f;
    template <class Ctx>
    __device__ __forceinline__ void operator()(const f32x4 (&acc)[2][2][4][2], const Ctx& ctx, const Unit& u, int wr, int wc, int fr, int fq, PG8_LAS unsigned char*, int) const {
#pragma unroll
        for (int ai = 0; ai < 2; ++ai)
#pragma unroll
            for (int m = 0; m < 4; ++m)
#pragma unroll
                for (int bj = 0; bj < 2; ++bj) {
                    f32x4 v0, v1;
                    asm volatile("v_accvgpr_read_b32 %0, %8\n\tv_accvgpr_read_b32 %1, %9\n\tv_accvgpr_read_b32 %2, %10\n\tv_accvgpr_read_b32 %3, %11\n\t"
                                 "v_accvgpr_read_b32 %4, %12\n\tv_accvgpr_read_b32 %5, %13\n\tv_accvgpr_read_b32 %6, %14\n\tv_accvgpr_read_b32 %7, %15"
                                 : "=v"(v0.x), "=v"(v0.y), "=v"(v0.z), "=v"(v0.w), "=v"(v1.x), "=v"(v1.y), "=v"(v1.z), "=v"(v1.w)
                                 : "a"(acc[ai][bj][m][0].x), "a"(acc[ai][bj][m][0].y), "a"(acc[ai][bj][m][0].z), "a"(acc[ai][bj][m][0].w),
                                   "a"(acc[ai][bj][m][1].x), "a"(acc[ai][bj][m][1].y), "a"(acc[ai][bj][m][1].z), "a"(acc[ai][bj][m][1].w));
                    f(u, ctx, ai, m, bj, ai * HALF + wr * 64 + m * 16 + fr, bj * HALF + wc * 32 + 8 * fq, v0, v1);
                }
    }
};
template <class PF, class F> __device__ __forceinline__ EpiPerm<PF, F> make_epi_perm(PF p, F f) { return EpiPerm<PF, F>{p, f}; }
template <bool PERMC, class PF, class F, class RE> struct EpiRow {
    PF pre; F f; RE re;
    template <class Ctx>
    __device__ __forceinline__ void operator()(const f32x4 (&acc)[2][2][4][2], const Ctx& ctx, const Unit& u, int wr, int wc, int fr, int fq, PG8_LAS unsigned char*, int) const {
#pragma unroll
        for (int ai = 0; ai < 2; ++ai)
#pragma unroll
            for (int m = 0; m < 4; ++m) {
                float part = 0.f;
#pragma unroll
                for (int bj = 0; bj < 2; ++bj) {
                    f32x4 v0, v1;
                    asm volatile("v_accvgpr_read_b32 %0, %8\n\tv_accvgpr_read_b32 %1, %9\n\tv_accvgpr_read_b32 %2, %10\n\tv_accvgpr_read_b32 %3, %11\n\t"
                                 "v_accvgpr_read_b32 %4, %12\n\tv_accvgpr_read_b32 %5, %13\n\tv_accvgpr_read_b32 %6, %14\n\tv_accvgpr_read_b32 %7, %15"
                                 : "=v"(v0.x), "=v"(v0.y), "=v"(v0.z), "=v"(v0.w), "=v"(v1.x), "=v"(v1.y), "=v"(v1.z), "=v"(v1.w)
                                 : "a"(acc[ai][bj][m][0].x), "a"(acc[ai][bj][m][0].y), "a"(acc[ai][bj][m][0].z), "a"(acc[ai][bj][m][0].w),
                                   "a"(acc[ai][bj][m][1].x), "a"(acc[ai][bj][m][1].y), "a"(acc[ai][bj][m][1].z), "a"(acc[ai][bj][m][1].w));
                    part += f(u, ctx, ai, m, bj, ai * HALF + wr * 64 + m * 16 + fr, bj * HALF + wc * 32 + (PERMC ? 8 : 4) * fq, v0, v1);
                }
                re(u, ai, m, ai * HALF + wr * 64 + m * 16 + fr, wc, fq, part);
            }
    }
};
template <bool PERMC, class PF, class F, class RE> __device__ __forceinline__ EpiRow<PERMC, PF, F, RE> make_epi_row(PF p, F f, RE r) { return EpiRow<PERMC, PF, F, RE>{p, f, r}; }
template <class PF, class GP, class F> struct EpiG {
    PF pre; GP gp; F f;
    template <class Ctx>
    __device__ __forceinline__ void operator()(const f32x4 (&acc)[2][2][4][2], const Ctx& ctx, const Unit& u, int wr, int wc, int fr, int fq, PG8_LAS unsigned char*, int) const {
        auto gcur = gp(u, ctx, wr * 64 + fr, wc, fq);
#pragma unroll
        for (int ai = 0; ai < 2; ++ai)
#pragma unroll
            for (int m = 0; m < 4; ++m) {
                const int gn = ai * 4 + m + 1;
                auto gnxt = gcur;
                if (gn < 8) gnxt = gp(u, ctx, (gn >> 2) * HALF + wr * 64 + (gn & 3) * 16 + fr, wc, fq);
#pragma unroll
                for (int bj = 0; bj < 2; ++bj) {
                    f32x4 v0, v1;
                    asm volatile("v_accvgpr_read_b32 %0, %8\n\tv_accvgpr_read_b32 %1, %9\n\tv_accvgpr_read_b32 %2, %10\n\tv_accvgpr_read_b32 %3, %11\n\t"
                                 "v_accvgpr_read_b32 %4, %12\n\tv_accvgpr_read_b32 %5, %13\n\tv_accvgpr_read_b32 %6, %14\n\tv_accvgpr_read_b32 %7, %15"
                                 : "=v"(v0.x), "=v"(v0.y), "=v"(v0.z), "=v"(v0.w), "=v"(v1.x), "=v"(v1.y), "=v"(v1.z), "=v"(v1.w)
                                 : "a"(acc[ai][bj][m][0].x), "a"(acc[ai][bj][m][0].y), "a"(acc[ai][bj][m][0].z), "a"(acc[ai][bj][m][0].w),
                                   "a"(acc[ai][bj][m][1].x), "a"(acc[ai][bj][m][1].y), "a"(acc[ai][bj][m][1].z), "a"(acc[ai][bj][m][1].w));
                    f(u, ctx, gcur, ai, m, bj, ai * HALF + wr * 64 + m * 16 + fr, bj * HALF + wc * 32 + 4 * fq, v0, v1);
                }
                gcur = gnxt;
            }
    }
};
template <class PF, class GP, class F> __device__ __forceinline__ EpiG<PF, GP, F> make_epi_g(PF p, GP g, F f) { return EpiG<PF, GP, F>{p, g, f}; }
template <int MG, int TILE_BYTES, class PF, class F, class FL> struct EpiStaged {
    PF pre; F f; FL flush;
    template <class Ctx>
    __device__ __forceinline__ void operator()(const f32x4 (&acc)[2][2][4][2], const Ctx& ctx, const Unit& u, int wr, int wc, int fr, int fq, PG8_LAS unsigned char* tile, int tid) const {
#pragma unroll
        for (int ai = 0; ai < 2; ++ai)
#pragma unroll
            for (int m = 0; m < 4; ++m) {
#pragma unroll
                for (int bj = 0; bj < 2; ++bj) {
                    f32x4 v0, v1;
                    asm volatile("v_accvgpr_read_b32 %0, %8\n\tv_accvgpr_read_b32 %1, %9\n\tv_accvgpr_read_b32 %2, %10\n\tv_accvgpr_read_b32 %3, %11\n\t"
                                 "v_accvgpr_read_b32 %4, %12\n\tv_accvgpr_read_b32 %5, %13\n\tv_accvgpr_read_b32 %6, %14\n\tv_accvgpr_read_b32 %7, %15"
                                 : "=v"(v0.x), "=v"(v0.y), "=v"(v0.z), "=v"(v0.w), "=v"(v1.x), "=v"(v1.y), "=v"(v1.z), "=v"(v1.w)
                                 : "a"(acc[ai][bj][m][0].x), "a"(acc[ai][bj][m][0].y), "a"(acc[ai][bj][m][0].z), "a"(acc[ai][bj][m][0].w),
                                   "a"(acc[ai][bj][m][1].x), "a"(acc[ai][bj][m][1].y), "a"(acc[ai][bj][m][1].z), "a"(acc[ai][bj][m][1].w));
                    f(u, ctx, ai, m, bj, (m % MG) * 32 + wr * 16 + fr, bj * HALF + wc * 32 + 4 * fq, v0, v1, tile + (((ai * 4 + m) / MG) & 1) * TILE_BYTES);
                }
                if ((m % MG) == MG - 1) {
                    asm volatile("s_waitcnt lgkmcnt(0)" ::: "memory"); __builtin_amdgcn_s_barrier(); asm volatile("" ::: "memory");
                    flush(u, ctx, ai, m - (MG - 1), tid, tile + (((ai * 4 + m) / MG) & 1) * TILE_BYTES);
                }
            }
    }
};
template <int MG, int TILE_BYTES, class PF, class F, class FL> __device__ __forceinline__ EpiStaged<MG, TILE_BYTES, PF, F, FL> make_epi_staged(PF p, F f, FL fl) { return EpiStaged<MG, TILE_BYTES, PF, F, FL>{p, f, fl}; }
__host__ __device__ __forceinline__ int perm32(int rho) { const int n = rho >> 4, i = rho & 15; return 8 * (i >> 2) + 4 * n + (i & 3); }
template <bool FP8 = false, bool GATHER = false, bool PERM = false, class EpiT, class Sched, class StageT = NoStage>
__device__ __forceinline__ void gemm_phase(int tid, PG8_LAS unsigned char* lds, const Gemm g, const Sched& S, const EpiT& E, const StageT& SC = NoStage{}, int ctx_off = 0) {
    const int wid = __builtin_amdgcn_readfirstlane(tid >> 6), lane = tid & 63, wr = wid >> 2, wc = wid & 3, fr = lane & 15, fq = lane >> 4;
    int K = g.K; asm volatile("" : "+s"(K));
    const int nt = K / BK;
    unsigned voffA[2], voffB[2];
    int Rl[2], Cl[2];
#pragma unroll
    for (int i = 0; i < 2; ++i) { int R, C; stage_rc(tid * 16 + i * 8192, R, C); Rl[i] = R; Cl[i] = C; voffA[i] = (unsigned)(R * g.lda + C) * 2u; const int Rb = PERM ? ((R & ~31) + perm32(R & 31)) : R; voffB[i] = (unsigned)(Rb * g.ldb + C) * 2u; }
    unsigned gA00 = 0, gA01 = 0, gA10 = 0, gA11 = 0, gN00 = 0, gN01 = 0, gN10 = 0, gN11 = 0;
    const size_t kstep = (size_t)(BK * 2);
    const size_t hstepA = (size_t)HALF * g.lda * 2, hstepB = (size_t)HALF * g.ldb * 2;
    const size_t tstepA = 2 * hstepA, tstepB = 2 * hstepB;
    const unsigned ldsw = (unsigned)wid * 1024u;
    const int aoff = lds_byte(wr * 64 + fr, fq * 8), boff = lds_byte(wc * 32 + fr, fq * 8);
#define PG8_SA(b, h) (((b) * 2 + (h)) * HTB)
#define PG8_SB(b, h) ((4 + (b) * 2 + (h)) * HTB)
#define PG8_STAGE(bufoff, gbase, voff) do { _Pragma("unroll") for (int _i = 0; _i < 2; ++_i) \
        __builtin_amdgcn_global_load_lds((const unsigned*)((const char*)(gbase) + (voff)[_i]), (PG8_LAS unsigned*)(lds + (bufoff) + ldsw + _i * 8192), 16, 0, 0); } while (0)
#define PG8_LDA(dst, b, h) do { _Pragma("unroll") for (int m = 0; m < 4; ++m) { dst[m].lo = *(const PG8_LAS v4i_t*)(lds + PG8_SA(b, h) + aoff + m * 2048); dst[m].hi = *(const PG8_LAS v4i_t*)(lds + PG8_SA(b, h) + aoff + m * 2048 + 1024); } } while (0)
#define PG8_LDB(dst, b, h) do { _Pragma("unroll") for (int n = 0; n < 2; ++n) { dst[n].lo = *(const PG8_LAS v4i_t*)(lds + PG8_SB(b, h) + boff + n * 2048); dst[n].hi = *(const PG8_LAS v4i_t*)(lds + PG8_SB(b, h) + boff + n * 2048 + 1024); } } while (0)
#define PG8_MMA(ai, bj, At, Bt) do { __builtin_amdgcn_s_setprio(1); asm volatile("s_nop 1" ::: "memory");     \
        _Pragma("unroll") for (int m = 0; m < 4; ++m) _Pragma("unroll") for (int n = 0; n < 2; ++n) { \
        if constexpr (FP8) { asm volatile("v_mfma_scale_f32_16x16x128_f8f6f4 %0, %1, %2, %0, %3, %4 op_sel_hi:[0,0,0]" : "+a"(acc[ai][bj][m][n]) : "v"(Bt[n].v), "v"(At[m].v), "v"(scw), "v"(scx)); } \
        else { asm volatile("v_mfma_f32_16x16x32_bf16 %0, %1, %2, %0\n\tv_mfma_f32_16x16x32_bf16 %0, %3, %4, %0" : "+a"(acc[ai][bj][m][n]) : "v"(Bt[n].lo), "v"(At[m].lo), "v"(Bt[n].hi), "v"(At[m].hi)); } } \
        __builtin_amdgcn_s_setprio(0); } while (0)
#define PG8_WAIT_V(n) asm volatile("s_waitcnt vmcnt(" #n ")" ::: "memory")
#define PG8_WAIT_L(n) asm volatile("s_waitcnt lgkmcnt(" #n ")" ::: "memory")
#define PG8_BAR __builtin_amdgcn_s_barrier()
#define PG8_SCHED __builtin_amdgcn_sched_barrier(0)
    Unit cur, nxt; int ui = 0;
    if (!S.next(0, cur)) return;
    f32x4 acc[2][2][4][2];
#pragma unroll
    for (int a = 0; a < 2; ++a)
#pragma unroll
        for (int b = 0; b < 2; ++b)
#pragma unroll
            for (int m = 0; m < 4; ++m)
#pragma unroll
                for (int n = 0; n < 2; ++n) acc[a][b][m][n] = (f32x4){0.f, 0.f, 0.f, 0.f};
    FragT At[4], B0[2], B1[2];
    int scw = (FP8 && PROBE_KX2) ? 0x79797979 : 0x7a7a7a7a, scx = 0x7f7f7f7f; asm volatile("" : "+v"(scw), "+v"(scx));
    const char* cA = GATHER ? (const char*)g.A : (const char*)g.A + (size_t)cur.pm * tstepA; const char* cB = (const char*)g.Bt + (size_t)cur.pb * tstepB;
    SC(cur, lds + STAGE_BYTES + ctx_off, wid, lane);
    const int R0 = Rl[0], R1 = Rl[1]; const unsigned C0 = (unsigned)Cl[0] * 2u, C1 = (unsigned)Cl[1] * 2u;
    if constexpr (GATHER) { gA00 = S.a_off(cur, R0) + C0; gA01 = S.a_off(cur, R1) + C1; gA10 = S.a_off(cur, HALF + R0) + C0; gA11 = S.a_off(cur, HALF + R1) + C1; }
#define PG8_STAGE_A(bufoff, koff, O0, O1, dense_ptr) do { if constexpr (GATHER) { \
        __builtin_amdgcn_global_load_lds((const unsigned*)((const char*)g.A + (koff) + (O0)), (PG8_LAS unsigned*)(lds + (bufoff) + ldsw), 16, 0, 0); \
        __builtin_amdgcn_global_load_lds((const unsigned*)((const char*)g.A + (koff) + (O1)), (PG8_LAS unsigned*)(lds + (bufoff) + ldsw + 8192), 16, 0, 0); \
    } else { PG8_STAGE(bufoff, dense_ptr, voffA); } } while (0)
    PG8_STAGE(PG8_SB(0, 0), cB, voffB); PG8_STAGE(PG8_SB(0, 1), cB + hstepB, voffB); PG8_STAGE_A(PG8_SA(0, 0), 0, gA00, gA01, cA); PG8_STAGE_A(PG8_SA(0, 1), 0, gA10, gA11, cA + hstepA);
    if (wr == 1) PG8_BAR;
    PG8_WAIT_V(2); PG8_BAR;
    PG8_STAGE(PG8_SB(1, 0), cB + kstep, voffB); PG8_STAGE_A(PG8_SA(1, 0), kstep, gA00, gA01, cA + kstep); PG8_STAGE(PG8_SB(1, 1), cB + hstepB + kstep, voffB);
    PG8_WAIT_V(6); PG8_BAR;
    for (;;) {
        const bool has_next = S.next(ui + 1, nxt);
        const char* nA = GATHER ? cA : (has_next ? (const char*)g.A + (size_t)nxt.pm * tstepA : cA); const char* nB = has_next ? (const char*)g.Bt + (size_t)nxt.pb * tstepB : cB;
        if (has_next) SC(nxt, lds + STAGE_BYTES + ctx_off + ((ui + 1) % 3) * 4096, wid, lane);
        if constexpr (GATHER) {
            if (has_next) { gN00 = S.a_off(nxt, R0) + C0; gN01 = S.a_off(nxt, R1) + C1; gN10 = S.a_off(nxt, HALF + R0) + C0; gN11 = S.a_off(nxt, HALF + R1) + C1; }
            else { gN00 = gA00; gN01 = gA01; gN10 = gA10; gN11 = gA11; }
        }
        constexpr int KX = (FP8 && PROBE_KX2) ? 2 : 1;
        for (int t = 0; t < KX * nt; t += 2) {
            const bool last = (t == KX * nt - 2);
            const char* a1 = cA + (size_t)((t + 1) % nt) * kstep;
            const char* a2 = last ? nA : cA + (size_t)((t + 2) % nt) * kstep; const char* b2 = last ? nB : cB + (size_t)((t + 2) % nt) * kstep;
            const char* a3 = a2 + kstep; const char* b3 = b2 + kstep;
            const size_t k1 = (size_t)((t + 1) % nt) * kstep, k2 = last ? 0 : (size_t)((t + 2) % nt) * kstep;
            const unsigned gT00 = last ? gN00 : gA00, gT01 = last ? gN01 : gA01, gT10 = last ? gN10 : gA10, gT11 = last ? gN11 : gA11;
            PG8_LDB(B0, 0, 0); PG8_LDB(B1, 0, 1); PG8_SCHED; PG8_LDA(At, 0, 0); PG8_STAGE_A(PG8_SA(1, 1), k1, gA10, gA11, a1 + hstepA);
            PG8_WAIT_V(8); PG8_WAIT_L(0); PG8_BAR; PG8_MMA(0, 0, At, B0); PG8_MMA(0, 1, At, B1); PG8_BAR; PG8_SCHED;
            PG8_LDA(At, 0, 1); PG8_STAGE(PG8_SB(0, 0), b2, voffB); PG8_STAGE(PG8_SB(0, 1), b2 + hstepB, voffB); PG8_STAGE_A(PG8_SA(0, 0), k2, gT00, gT01, a2);
            PG8_WAIT_V(8); PG8_WAIT_L(0); PG8_BAR; PG8_MMA(1, 0, At, B0); PG8_MMA(1, 1, At, B1); PG8_BAR; PG8_SCHED;
            PG8_LDB(B0, 1, 0); PG8_LDB(B1, 1, 1); PG8_SCHED; PG8_LDA(At, 1, 0); PG8_STAGE_A(PG8_SA(0, 1), k2, gT10, gT11, a2 + hstepA);
            PG8_WAIT_V(8); PG8_WAIT_L(0); PG8_BAR; PG8_MMA(0, 0, At, B0); PG8_MMA(0, 1, At, B1); PG8_BAR; PG8_SCHED;
            PG8_LDA(At, 1, 1); PG8_STAGE(PG8_SB(1, 0), b3, voffB); PG8_STAGE(PG8_SB(1, 1), b3 + hstepB, voffB); PG8_STAGE_A(PG8_SA(1, 0), k2 + kstep, gT00, gT01, a3);
            PG8_WAIT_V(8); PG8_WAIT_L(0); PG8_BAR; PG8_MMA(1, 0, At, B0); PG8_MMA(1, 1, At, B1); PG8_BAR; PG8_SCHED;
        }
        unsigned long long tp0_ = 0; if constexpr (PROBE_SEG != 0 && PROBE_SEG == (FP8 ? (GATHER ? 2 : 1) : 3)) tp0_ = __builtin_amdgcn_s_memrealtime();
        const auto ectx = E.pre(cur, wr, wc, fr, fq, lds + STAGE_BYTES + ctx_off + (ui % 3) * 4096);
        if (wr == 0) PG8_BAR;
        asm volatile("s_nop 15\n\ts_nop 15" ::: "memory");
        E(acc, ectx, cur, wr, wc, fr, fq, lds + STAGE_BYTES, tid);
        if constexpr (FP8 && PROBE_EPI2) { asm volatile("" ::: "memory"); E(acc, ectx, cur, wr, wc, fr, fq, lds + STAGE_BYTES, tid); }
        if constexpr (PROBE_SEG != 0 && PROBE_SEG == (FP8 ? (GATHER ? 2 : 1) : 3)) { if (tid == 0) { PG8_LAS unsigned* acc_t = (PG8_LAS unsigned*)(lds + LDS_MISC + 48); *acc_t += (unsigned)(__builtin_amdgcn_s_memrealtime() - tp0_); } }
        if (!has_next) break;
#pragma unroll
        for (int a = 0; a < 2; ++a)
#pragma unroll
            for (int b = 0; b < 2; ++b)
#pragma unroll
                for (int m = 0; m < 4; ++m)
#pragma unroll
                    for (int n = 0; n < 2; ++n) acc[a][b][m][n] = (f32x4){0.f, 0.f, 0.f, 0.f};
        cur = nxt; cA = nA; cB = nB; ++ui;
        if constexpr (GATHER) { gA00 = gN00; gA01 = gN01; gA10 = gN10; gA11 = gN11; }
        if (wr == 1) PG8_BAR;
    }
    PG8_WAIT_V(0);
    PG8_BAR;
#undef PG8_SA
#undef PG8_SB
#undef PG8_STAGE
#undef PG8_STAGE_A
#undef PG8_LDA
#undef PG8_LDB
#undef PG8_MMA
#undef PG8_WAIT_V
#undef PG8_WAIT_L
#undef PG8_BAR
#undef PG8_SCHED
}
struct GridOrder {
    int nM, nN, nwg, G, c;
    __device__ __forceinline__ void init(int nM_, int nN_, int G_, int c_) { nM = nM_; nN = nN_; nwg = nM * nN; G = G_; c = c_; }
    __device__ __forceinline__ bool tile(int i, int& pm, int& pn) const {
        const long L = (long)i * G + c; if (L >= nwg) return false;
        int wgid = (int)L; { const int q = nwg / 8, r = nwg % 8, xcd = wgid % 8, off = wgid / 8; wgid = (xcd < r ? xcd * (q + 1) : r * (q + 1) + (xcd - r) * q) + off; }
        const int nig = 8 * nN, gid = wgid / nig, fm = gid * 8, gsz = (nM - fm) < 8 ? (nM - fm) : 8;
        pm = fm + ((wgid % nig) % gsz); pn = (wgid % nig) / gsz; return true;
    }
};
}


struct DenseOrder { pg8::GridOrder go;
    __device__ __forceinline__ bool next(int i, pg8::Unit& u) const { int pm, pn; if (!go.tile(i, pm, pn)) return false; u.pm = pm; u.pb = pn; u.pn = pn; u.aux = 0; return true; } };
struct MoeOrder { pg8::GridOrder go; const int* pst; const int* el_slot; int NT, ebase;
    __device__ __forceinline__ unsigned a_off(const pg8::Unit& u, int R) const { const int ro = u.pm * 256 - pst[u.aux] + R; const int tok = (ro < pst[64 + u.aux]) ? (el_slot[(size_t)u.aux * T + ro] >> 2) : 0; return (unsigned)tok * 1024u; }
    __device__ __forceinline__ bool next(int i, pg8::Unit& u) const { int pm, pn; if (!go.tile(i, pm, pn)) return false; int e = 0;
#pragma unroll
        for (int q = 1; q < 32; ++q) e = (pm * 256 >= pst[q]) ? q : e;
        e = __builtin_amdgcn_readfirstlane(e);
        u.pm = pm; u.pn = pn; u.pb = (ebase + e) * NT + pn; u.aux = e; return true; } };
struct S5Order { int G, c;
    __device__ __forceinline__ bool next(int i, pg8::Unit& u) const { const int L = i * G + c; if (L >= 256) return false; const int g = L >> 3, pmL = (L >> 2) & 1, pnL = L & 3;
        u.pm = g * 2 + pmL; u.pb = g * 4 + pnL; u.pn = pnL; u.aux = g; return true; } };

__device__ __forceinline__ void transpose_item(const float* W, int K, int N, bf16_t* WT, int ldt, float* scr, int item, int lane, int mode, const float* kscale = nullptr) {
    const int nblk = N / 32, kb = item / nblk, nb = item % nblk, k0 = 64 * kb, n0 = 32 * nb;
#pragma unroll 8
    for (int i = 0; i < 32; ++i) { const int kk = 2 * i + (lane >> 5); scr[kk * 33 + (lane & 31)] = W[(size_t)(k0 + kk) * N + n0 + (lane & 31)] * (kscale ? kscale[k0 + kk] : 1.0f); }
    __builtin_amdgcn_s_waitcnt(0xC07F); asm volatile("" ::: "memory");
    const int c = lane & 7;
#pragma unroll
    for (int j = 0; j < 4; ++j) {
        const int n = (lane >> 3) + 8 * j; const float* s = scr + (8 * c) * 33 + n;
        u32x4 o; o.x = pk2(s[0 * 33], s[1 * 33]); o.y = pk2(s[2 * 33], s[3 * 33]); o.z = pk2(s[4 * 33], s[5 * 33]); o.w = pk2(s[6 * 33], s[7 * 33]);
        int nn = n0 + n;
        if (mode == 1) { const int half = nn >= 1024; const int jj = nn - half * 1024; nn = 32 * (jj >> 4) + 16 * half + (jj & 15); }
        *(u32x4*)(WT + (size_t)nn * ldt + k0 + 8 * c) = o;
    }
    __builtin_amdgcn_s_waitcnt(0xC07F); asm volatile("" ::: "memory");
}
__device__ __forceinline__ void transpose_item_fp8(const float* W, int K, int N, unsigned char* WT, float* scr, int item, int lane, int mode, float scale) {
    const int nblk = N / 32, kb = item / nblk, nb = item % nblk, k0 = 128 * kb, n0 = 32 * nb;
#pragma unroll 8
    for (int i = 0; i < 64; ++i) { const int kk = 2 * i + (lane >> 5); scr[kk * 33 + (lane & 31)] = W[(size_t)(k0 + kk) * N + n0 + (lane & 31)] * scale; }
    __builtin_amdgcn_s_waitcnt(0xC07F); asm volatile("" ::: "memory");
    const int c = lane & 7;
#pragma unroll
    for (int j = 0; j < 4; ++j) {
        const int n = (lane >> 3) + 8 * j; const float* s = scr + (16 * c) * 33 + n;
        u32x4 o; o.x = pk4_fp8(s[0 * 33], s[1 * 33], s[2 * 33], s[3 * 33]); o.y = pk4_fp8(s[4 * 33], s[5 * 33], s[6 * 33], s[7 * 33]);
        o.z = pk4_fp8(s[8 * 33], s[9 * 33], s[10 * 33], s[11 * 33]); o.w = pk4_fp8(s[12 * 33], s[13 * 33], s[14 * 33], s[15 * 33]);
        int nn = n0 + n;
        if (mode == 1) { const int half = nn >= 1024; const int jj = nn - half * 1024; nn = 32 * (jj >> 4) + 16 * half + (jj & 15); }
        *(u32x4*)(WT + (size_t)nn * K + k0 + 16 * c) = o;
    }
    __builtin_amdgcn_s_waitcnt(0xC07F); asm volatile("" ::: "memory");
}
__device__ __forceinline__ void transpose_many_fp8(const float* W, int nmat, int K, int N, unsigned char* WT, size_t dst_stride, float* scr, int gw, int NGW, int lane, int mode, float scale) {
    const int per = (K / 128) * (N / 32); const long tot = (long)nmat * per;
    for (long it = gw; it < tot; it += NGW) {
        const int mt = (int)(it / per), r = (int)(it % per);
        transpose_item_fp8(W + (size_t)mt * K * N, K, N, WT + (size_t)mt * dst_stride, scr, r, lane, mode, scale);
    }
}
__device__ __forceinline__ void convert_fp8_queue(const float* Wgu, const float* Wdn, unsigned char* WTgu, unsigned char* WTdn, float* tile, volatile int* qslot, unsigned* qctr, int tid, float scale) {
    const int wave = tid >> 6, lane = tid & 63;
    constexpr int TOT_GU = 64 * 64, TOT = TOT_GU + 64 * 32;
    f32x4 v[16];
    auto src = [&](int item, int i) {
        const bool gu = item < TOT_GU; const int it2 = gu ? item : item - TOT_GU; const int N = gu ? 2048 : 1024, per = gu ? 64 : 32, nblk = N / 256;
        const int mt = it2 / per, r = it2 % per, kb = r / nblk, nb = r % nblk;
        return (const f32x4*)((gu ? Wgu : Wdn) + (size_t)mt * 1024 * N + (size_t)(128 * kb + wave + 8 * i) * N + 256 * nb + lane * 4); };
    if (tid == 0) qslot[0] = (int)atomicAdd(qctr, 1u);
    __syncthreads();
    int it = qslot[0];
    if (it < TOT) {
#pragma unroll
        for (int i = 0; i < 16; ++i) v[i] = *src(it, i);
    }
    while (it < TOT) {
        if (tid == 0) qslot[1] = (int)atomicAdd(qctr, 1u);
#pragma unroll
        for (int i = 0; i < 16; ++i) { float* d = tile + (wave + 8 * i) * 257 + lane * 4; d[0] = v[i].x * scale; d[1] = v[i].y * scale; d[2] = v[i].z * scale; d[3] = v[i].w * scale; }
        __syncthreads();
        const int nx = qslot[1];
        if (nx < TOT) {
#pragma unroll
            for (int i = 0; i < 16; ++i) v[i] = *src(nx, i);
        }
        {
            const bool gu = it < TOT_GU; const int it2 = gu ? it : it - TOT_GU; const int N = gu ? 2048 : 1024, per = gu ? 64 : 32, nblk = N / 256;
            const int mt = it2 / per, r = it2 % per, kb = r / nblk, nb = r % nblk, k0 = 128 * kb, n0 = 256 * nb;
            unsigned char* WT = (gu ? WTgu : WTdn) + (size_t)mt * N * 1024;
            const int c = tid & 7;
#pragma unroll 1
            for (int ps = 0; ps < 4; ++ps) {
                const int n = ps * 64 + (tid >> 3); const float* sp = tile + (16 * c) * 257 + n;
                u32x4 o; o.x = pk4_fp8(sp[0 * 257], sp[1 * 257], sp[2 * 257], sp[3 * 257]); o.y = pk4_fp8(sp[4 * 257], sp[5 * 257], sp[6 * 257], sp[7 * 257]);
                o.z = pk4_fp8(sp[8 * 257], sp[9 * 257], sp[10 * 257], sp[11 * 257]); o.w = pk4_fp8(sp[12 * 257], sp[13 * 257], sp[14 * 257], sp[15 * 257]);
                int nn = n0 + n;
                if (gu) { const int half = nn >= 1024; const int jj = nn - half * 1024; nn = 32 * (jj >> 4) + 16 * half + (jj & 15); }
                *(u32x4*)(WT + (size_t)nn * 1024 + k0 + 16 * c) = o;
            }
        }
        __syncthreads();
        it = nx;
    }
}
__device__ __forceinline__ void transpose_many(const float* W, int nmat, int K, int N, bf16_t* WT, size_t dst_stride, float* scr, int gw, int NGW, int lane, int mode, int ldt = 0, const float* kscale = nullptr) {
    if (ldt == 0) ldt = K;
    const int per = (K / 64) * (N / 32); const long tot = (long)nmat * per;
    for (long it = gw; it < tot; it += NGW) {
        const int mt = (int)(it / per), r = (int)(it % per);
        transpose_item(W + (size_t)mt * K * N, K, N, WT + (size_t)mt * dst_stride, ldt, scr, r, lane, mode, kscale);
    }
}

__device__ __forceinline__ void norm_mod_store(f32x4 (&v)[4], const float* g, const float* sc, const float* sh, bf16_t* orow, unsigned char* orow8, int lane) {
    float s = 0.f;
#pragma unroll
    for (int j = 0; j < 4; ++j) s += (v[j].x * v[j].x + v[j].y * v[j].y) + (v[j].z * v[j].z + v[j].w * v[j].w);
    const float r = rsqrtf(wave_sum(s) * (1.0f / D) + 1e-6f);
#pragma unroll
    for (int j = 0; j < 4; ++j) {
        const int c = 4 * lane + 256 * j;
        const f32x4 gg = *(const f32x4*)(g + c), s1 = *(const f32x4*)(sc + c), s0 = *(const f32x4*)(sh + c);
        const float a = v[j].x * r * gg.x * (1.f + s1.x) + s0.x, b = v[j].y * r * gg.y * (1.f + s1.y) + s0.y,
                    cc = v[j].z * r * gg.z * (1.f + s1.z) + s0.z, d = v[j].w * r * gg.w * (1.f + s1.w) + s0.w;
        u32x2 o; o.x = pk2(a, b); o.y = pk2(cc, d);
        *(u32x2*)(orow + c) = o;
        if (orow8) *(unsigned*)(orow8 + c) = pk4_fp8(a, b, cc, d);
    }
}

__device__ __forceinline__ void unpack8(const u32x4 w, float (&f)[8]) {
    f[0] = __uint_as_float(w.x << 16); f[1] = __uint_as_float(w.x & 0xffff0000u); f[2] = __uint_as_float(w.y << 16); f[3] = __uint_as_float(w.y & 0xffff0000u);
    f[4] = __uint_as_float(w.z << 16); f[5] = __uint_as_float(w.z & 0xffff0000u); f[6] = __uint_as_float(w.w << 16); f[7] = __uint_as_float(w.w & 0xffff0000u);
}
__device__ __forceinline__ u32x4 pack8(const float (&f)[8]) { u32x4 o; o.x = pk2(f[0], f[1]); o.y = pk2(f[2], f[3]); o.z = pk2(f[4], f[5]); o.w = pk2(f[6], f[7]); return o; }
__device__ __forceinline__ void norm_mod_store8(float (&v)[2][8], const float* g, const float* sc, const float* sh, bf16_t* orow, unsigned char* orow8, int lane) {
    float s = 0.f;
#pragma unroll
    for (int j = 0; j < 2; ++j)
#pragma unroll
        for (int i = 0; i < 8; ++i) s += v[j][i] * v[j][i];
    const float r = rsqrtf(wave_sum(s) * (1.0f / D) + 1e-6f);
#pragma unroll
    for (int j = 0; j < 2; ++j) {
        const int c = 8 * lane + 512 * j; float o[8];
#pragma unroll
        for (int q = 0; q < 2; ++q) {
            const f32x4 gg = *(const f32x4*)(g + c + 4 * q), s1 = *(const f32x4*)(sc + c + 4 * q), s0 = *(const f32x4*)(sh + c + 4 * q);
            o[4 * q + 0] = v[j][4 * q + 0] * r * gg.x * (1.f + s1.x) + s0.x; o[4 * q + 1] = v[j][4 * q + 1] * r * gg.y * (1.f + s1.y) + s0.y;
            o[4 * q + 2] = v[j][4 * q + 2] * r * gg.z * (1.f + s1.z) + s0.z; o[4 * q + 3] = v[j][4 * q + 3] * r * gg.w * (1.f + s1.w) + s0.w;
        }
        *(u32x4*)(orow + c) = pack8(o);
        if (orow8) { u32x2 w8; w8.x = pk4_fp8(o[0], o[1], o[2], o[3]); w8.y = pk4_fp8(o[4], o[5], o[6], o[7]); *(u32x2*)(orow8 + c) = w8; }
    }
}

template <int ph> __device__ __forceinline__ void phase_body(int wbase) {
    extern __shared__ __attribute__((aligned(16))) unsigned char lds[];
    {
        int tid = wbase + lane_id(); asm volatile("" : "+v"(tid));
        int vb = blockIdx.x, G = gridDim.x; asm volatile("" : "+s"(vb), "+s"(G));
        const int lane = tid & 63, wave = tid >> 6;
        const int gw = vb * NWAVE + wave, NGW = G * NWAVE;
        const __attribute__((address_space(4))) Params* kp = (const __attribute__((address_space(4))) Params*)__builtin_amdgcn_kernarg_segment_ptr();
        asm volatile("" : "+s"(kp));
        unsigned char* ws = kp->ws;
        unsigned* ctl = (unsigned*)(ws + WS_CTL);
        float* MOD = (float*)(ws + WS_MOD);
        float* S5AB = (float*)(ws + WS_S5AB); float* S5BB = (float*)(ws + WS_S5AB + 65536);
        float* PW = (float*)(ws + WS_PW); float* KTAB = (float*)(ws + WS_KTAB);
                int* EL_SLOT = (int*)(ws + WS_EL); float* EL_GATE = (float*)(ws + WS_EL + 4 * MiB);
            bf16_t* W_IN_E = (bf16_t*)(ws + WS_W_IN_E); bf16_t* W_UP = (bf16_t*)(ws + WS_W_UP); bf16_t* W_GLU = (bf16_t*)(ws + WS_W_GLU);
        bf16_t* W_OUT_E = (bf16_t*)(ws + WS_W_OUT_E); bf16_t* W_IN_O = (bf16_t*)(ws + WS_W_IN_O); bf16_t* W_OUT_O = (bf16_t*)(ws + WS_W_OUT_O);
        bf16_t* W_POOL = (bf16_t*)(ws + WS_W_POOL); bf16_t* W_SGU = (bf16_t*)(ws + WS_W_SGU); bf16_t* W_RT = (bf16_t*)(ws + WS_W_RT);
        bf16_t* BT_END = (bf16_t*)(ws + WS_BT_END); bf16_t* BT_MAIN = (bf16_t*)(ws + WS_BT_MAIN);
        unsigned char* W_GU = ws + WS_W_GU; unsigned char* W_DN = ws + WS_W_DN; unsigned char* HB8 = ws + WS_HB8;
        bf16_t* HB = (bf16_t*)(ws + WS_HB); bf16_t* MIXIN = (bf16_t*)(ws + WS_MIXIN); bf16_t* Y = (bf16_t*)(ws + WS_Y);
        unsigned char* ACT = ws + WS_ACT;
        bf16_t* Z = (bf16_t*)(ws + WS_Z); float* RSP = (float*)(ws + WS_RSP); bf16_t* QKVRAW = (bf16_t*)(ws + WS_QKVRAW);
        bf16_t* Qb = (bf16_t*)(ws + WS_Q); bf16_t* Kb = (bf16_t*)(ws + WS_K); bf16_t* VT = (bf16_t*)(ws + WS_VT);
        bf16_t* AS5 = (bf16_t*)(ws + WS_AS5); float* LEND = (float*)(ws + WS_LEND); bf16_t* GACT = (bf16_t*)(ws + WS_GACT);
        bf16_t* POOLED = (bf16_t*)(ws + WS_POOLED); bf16_t* VTS = (bf16_t*)(ws + WS_VTS);
        float* OUT = kp->out; const float* XIN = kp->x; bf16_t* XR = (bf16_t*)(ws + WS_XR);
        const float* s5d = kp->s5_d; const float* glub = kp->s5_glu_b; const float* poolsc = kp->pool_scale; const float* sgub = kp->sgu_b;
        const float* bgu_all = kp->moe_b_gu; const float* bdn_all = kp->moe_b_dn; const float* rtb_all = kp->router_b;

        const int layer = (ph >= 17) ? 1 : 0;
        const int mph = (ph >= 17 && ph <= 19) ? ph - 8 : ph;
        const float* mod_l = MOD + (size_t)layer * NB * 6144;

        if (ph == 0) {
            const int gt = vb * NTHR + tid;
            if (gt < 2048) {
                const int g = gt >> 6, pp = gt & 63;
                const float dt = expf(kp->s5_log_dt[g]);
                const float lre = fminf(kp->s5_a_re[g * 64 + pp], -1e-4f), lim = kp->s5_a_im[g * 64 + pp];
                const float mag = expf(lre * dt);
                const float abr = mag * cosf(lim * dt), abi = mag * sinf(lim * dt);
                const float den = lre * lre + lim * lim, nr = abr - 1.0f;
                const float fre = (nr * lre + abi * lim) / den, fim = (abi * lre - nr * lim) / den;
                S5AB[(g * 64 + pp) * 2 + 0] = abr; S5AB[(g * 64 + pp) * 2 + 1] = abi;
                for (int j = 0; j < 16; ++j) {
                    const float br = kp->s5_b_re[(g * 64 + pp) * 16 + j], bi = kp->s5_b_im[(g * 64 + pp) * 16 + j];
                    S5BB[((g * 64 + pp) * 16 + j) * 2 + 0] = fre * br - fim * bi;
                    S5BB[((g * 64 + pp) * 16 + j) * 2 + 1] = fre * bi + fim * br;
                }
                float pr = 1.f, pi = 0.f;
                for (int tau = 0; tau <= 64; ++tau) {
                    PW[((g * 64 + pp) * 65 + tau) * 2 + 0] = pr; PW[((g * 64 + pp) * 65 + tau) * 2 + 1] = pi;
                    const float nr2 = pr * abr - pi * abi, ni2 = pr * abi + pi * abr; pr = nr2; pi = ni2;
                }
            }
            {
                float* ca = (float*)lds;
                for (int i = tid; i < NB * D; i += NTHR) { const float cv = kp->c[i]; ca[i] = cv * sigmoidf_(cv); }
                __syncthreads();
                float* part = (float*)(lds + 32768);
                for (int task = (vb >= 64 ? vb - 64 : vb + G - 64); task < 2 * 96; task += G) {
                    const int l = task / 96, cb = task % 96, col = cb * 64 + lane;
                    const float* W = kp->ada_w + (size_t)l * D * 6144 + col;
                    float acc[8];
#pragma unroll
                    for (int b = 0; b < 8; ++b) acc[b] = 0.f;
                    const int kb = wave * 128;
                    for (int k = kb; k < kb + 128; k += 16) {
                        float w[16];
#pragma unroll
                        for (int u = 0; u < 16; ++u) w[u] = W[(size_t)(k + u) * 6144];
#pragma unroll
                        for (int u = 0; u < 16; ++u)
#pragma unroll
                            for (int b = 0; b < 8; ++b) acc[b] += ca[b * D + k + u] * w[u];
                    }
#pragma unroll
                    for (int b = 0; b < 8; ++b) part[(wave * 8 + b) * 64 + lane] = acc[b];
                    __syncthreads();
                    {
                        const int b = tid >> 6;
                        float sum = kp->ada_b[l * 6144 + col];
#pragma unroll
                        for (int w8 = 0; w8 < 8; ++w8) sum += part[(w8 * 8 + b) * 64 + lane];
                        MOD[((size_t)l * NB + b) * 6144 + col] = sum;
                    }
                    __syncthreads();
                }
                __syncthreads();
            }
            {
                float* scr = (float*)(lds + wave * 16384);
                transpose_many(kp->even_w_in, 1, 1024, 928, W_IN_E, 0, scr, gw, NGW, lane, 0);
                transpose_many(kp->w_uq, 1, 256, 768, W_UP, 0, scr, gw, NGW, lane, 0, 384, kp->q_norm_g);
                transpose_many(kp->w_ukv, 1, 128, 1024, W_UP + (size_t)768 * 384 + 256, 0, scr, gw, NGW, lane, 0, 384, kp->kv_norm_g);
                for (int i = vb * NTHR + tid; i < 768 * 16 + 1024 * 32; i += G * NTHR) {
                    const u32x4 z = {0u, 0u, 0u, 0u};
                    if (i < 768 * 16) *(u32x4*)(W_UP + (size_t)(i >> 4) * 384 + 256 + (i & 15) * 8) = z;
                    else { const int q = i - 768 * 16; *(u32x4*)(W_UP + (size_t)(768 + (q >> 5)) * 384 + (q & 31) * 8) = z; }
                }
                transpose_many(kp->s5_glu_w, 1, 512, 512, W_GLU, 0, scr, gw, NGW, lane, 0);
                transpose_many(kp->even_w_out, 1, 1024, 1024, W_OUT_E, 0, scr, gw, NGW, lane, 0);
                transpose_many(kp->odd_w_in, 1, 1024, 1536, W_IN_O, 0, scr, gw, NGW, lane, 0);
                transpose_many(kp->odd_w_out, 1, 1024, 1024, W_OUT_O, 0, scr, gw, NGW, lane, 0);
                transpose_many(kp->pool_w, 4, 128, 128, W_POOL, 128 * 128, scr, gw, NGW, lane, 0);
                transpose_many(kp->router_w, 2, 1024, 32, W_RT, 128 * 1024, scr, gw, NGW, lane, 0);
                __syncthreads();
                convert_fp8_queue(kp->moe_w_gu, kp->moe_w_dn, W_GU, W_DN, (float*)lds, (volatile int*)(lds + LDS_MISC + 256), ctl + CW_Q, tid, 32.0f);
                for (int i = vb * NTHR + tid; i < 4 * 128 * 128; i += G * NTHR) {
                    const int t = (i >> 7) & 127, s_ = i & 127;
                    W_SGU[i] = (s_ <= t) ? f2bf(kp->sgu_w[i]) : (bf16_t)0;
                }
            }
        }
        else if (ph == 1 || ph == 12 || ph == 20) {
            const int lyr = (ph == 1) ? 0 : 1;
            const bool combine = (ph == 12 || ph == 20), donorm = (ph != 20);
            const int comb_layer = (ph == 12) ? 0 : 1;
            const bool ffn = false;
            const float* ng = (ffn ? kp->norm_ffn_g : kp->norm_mix_g) + lyr * D;
            if (ph == 1) {
                for (int rb = gw * 16; rb < T; rb += NGW * 16) {
                    const int b = rb / S;
                    const float* mm = MOD + ((size_t)lyr * NB + b) * 6144;
                    f32x4 pg[4], ps[4], ph_[4];
#pragma unroll
                    for (int j = 0; j < 4; ++j) { const int c = 4 * lane + 256 * j; pg[j] = *(const f32x4*)(ng + c); const f32x4 s1 = *(const f32x4*)(mm + D + c); ph_[j] = *(const f32x4*)(mm + c);
                        pg[j].x *= (1.f + s1.x); pg[j].y *= (1.f + s1.y); pg[j].z *= (1.f + s1.z); pg[j].w *= (1.f + s1.w); ps[j] = s1; }
                    f32x4 cur[4], nxt[4];
#pragma unroll
                    for (int j = 0; j < 4; ++j) cur[j] = *(const f32x4*)(XIN + (size_t)rb * D + 4 * lane + 256 * j);
                    for (int i = 0; i < 16; ++i) {
                        const int row = rb + i;
                        if (i + 1 < 16) {
#pragma unroll
                            for (int j = 0; j < 4; ++j) nxt[j] = *(const f32x4*)(XIN + (size_t)(row + 1) * D + 4 * lane + 256 * j);
                        }
                        float ss = 0.f;
#pragma unroll
                        for (int j = 0; j < 4; ++j) ss += (cur[j].x * cur[j].x + cur[j].y * cur[j].y) + (cur[j].z * cur[j].z + cur[j].w * cur[j].w);
                        const float r = rsqrtf(wave_sum(ss) * (1.0f / D) + 1e-6f);
#pragma unroll
                        for (int j = 0; j < 4; ++j) {
                            u32x2 o; o.x = pk2(cur[j].x * r * pg[j].x + ph_[j].x, cur[j].y * r * pg[j].y + ph_[j].y); o.y = pk2(cur[j].z * r * pg[j].z + ph_[j].z, cur[j].w * r * pg[j].w + ph_[j].w);
                            *(u32x2*)(HB + (size_t)row * D + 4 * lane + 256 * j) = o;
                        }
#pragma unroll
                        for (int j = 0; j < 4; ++j) cur[j] = nxt[j];
                    }
                }
            } else {
                for (int row0 = gw; row0 < T; row0 += 2 * NGW) {
                    float v[2][2][8];
#pragma unroll
                    for (int j = 0; j < 2; ++j) {
                        const int c = 8 * lane + 512 * j;
                        u32x4 xr[2], yr[2][4];
#pragma unroll
                        for (int q = 0; q < 2; ++q) {
                            const int row = row0 + q * NGW;
                            xr[q] = *(const u32x4*)(XR + (size_t)row * D + c);
#pragma unroll
                            for (int k = 0; k < 4; ++k) yr[q][k] = *(const u32x4*)(Y + ((size_t)row * 4 + k) * D + c);
                        }
#pragma unroll
                        for (int q = 0; q < 2; ++q) {
                            const int row = row0 + q * NGW, b = row / S;
                            const float* gf = MOD + ((size_t)comb_layer * NB + b) * 6144 + 5 * D;
                            float xf[8], acc[8];
                            unpack8(xr[q], xf);
#pragma unroll
                            for (int i = 0; i < 8; ++i) acc[i] = 0.f;
#pragma unroll
                            for (int k = 0; k < 4; ++k) { float yf[8]; unpack8(yr[q][k], yf);
#pragma unroll
                                for (int i = 0; i < 8; ++i) acc[i] += yf[i]; }
                            const f32x4 g0 = *(const f32x4*)(gf + c), g1 = *(const f32x4*)(gf + c + 4);
                            float (&vv)[8] = v[q][j];
                            vv[0] = xf[0] + g0.x * acc[0]; vv[1] = xf[1] + g0.y * acc[1]; vv[2] = xf[2] + g0.z * acc[2]; vv[3] = xf[3] + g0.w * acc[3];
                            vv[4] = xf[4] + g1.x * acc[4]; vv[5] = xf[5] + g1.y * acc[5]; vv[6] = xf[6] + g1.z * acc[6]; vv[7] = xf[7] + g1.w * acc[7];
                            if (ph == 20) { *(f32x4*)(OUT + (size_t)row * D + c) = (f32x4){vv[0], vv[1], vv[2], vv[3]}; *(f32x4*)(OUT + (size_t)row * D + c + 4) = (f32x4){vv[4], vv[5], vv[6], vv[7]}; }
                            else *(u32x4*)(XR + (size_t)row * D + c) = pack8(vv);
                        }
                    }
                    if (donorm) {
#pragma unroll
                        for (int q = 0; q < 2; ++q) {
                            const int row = row0 + q * NGW, b = row / S;
                            const float* mm = MOD + ((size_t)lyr * NB + b) * 6144;
                            norm_mod_store8(v[q], ng, mm + D, mm, HB + (size_t)row * D, (unsigned char*)nullptr, lane);
                        }
                    }
                }
            }
            if (ph == 1) {
                __syncthreads();
                float* Cs = (float*)lds;
                float* Bs = Cs + 2048;
                float* As = Bs + 2048;
                for (int item = vb; item < 256; item += G) {
                    const int g = item >> 3, tq = item & 7;
                    for (int idx = tid; idx < 1024; idx += NTHR) {
                        const int i = idx >> 6, pp = idx & 63;
                        Cs[idx * 2] = kp->s5_c_re[(g * 16 + i) * 64 + pp]; Cs[idx * 2 + 1] = kp->s5_c_im[(g * 16 + i) * 64 + pp];
                        Bs[idx * 2] = S5BB[((size_t)g * 1024 + idx) * 2]; Bs[idx * 2 + 1] = S5BB[((size_t)g * 1024 + idx) * 2 + 1];
                    }
                    { const int pp = tid >> 3, tl = tid & 7; As[tid * 2] = PW[((g * 64 + pp) * 65 + tq * 8 + tl) * 2]; As[tid * 2 + 1] = PW[((g * 64 + pp) * 65 + tq * 8 + tl) * 2 + 1]; }
                    __syncthreads();
                    const int v0 = tid * 4, tl = v0 >> 8, i = (v0 >> 4) & 15, j0 = v0 & 15;
                    float acc[4] = {0.f, 0.f, 0.f, 0.f};
                    for (int pp = 0; pp < 64; ++pp) {
                        const float cr = Cs[(i * 64 + pp) * 2], ci = Cs[(i * 64 + pp) * 2 + 1];
                        const float ar = As[(pp * 8 + tl) * 2], ai = As[(pp * 8 + tl) * 2 + 1];
                        const f32x4 b01 = *(const f32x4*)(Bs + (pp * 16 + j0) * 2), b23 = *(const f32x4*)(Bs + (pp * 16 + j0) * 2 + 4);
                        const float wr_ = cr * ar - ci * ai, wi_ = cr * ai + ci * ar;
                        acc[0] += wr_ * b01.x - wi_ * b01.y; acc[1] += wr_ * b01.z - wi_ * b01.w; acc[2] += wr_ * b23.x - wi_ * b23.y; acc[3] += wr_ * b23.z - wi_ * b23.w;
                    }
                    *(f32x4*)(KTAB + (((size_t)g * 64 + tq * 8 + tl) * 16 + i) * 16 + j0) = (f32x4){acc[0], acc[1], acc[2], acc[3]};
                    __syncthreads();
                }
            }
        }
        else if (ph == 2) {
            {
                DenseOrder so; so.go.init(T / 256, 4, G, vb);
                auto f = [=](const pg8::Unit& u, const pg8::NoCtx&, int ai, int m, int bj, int r, int c, f32x4 v0, f32x4 v1) -> float {
                        const int row = u.pm * 256 + r, col = u.pn * 256 + c; float ss = 0.f;
                        u32x4 o; o.x = pk2(v0.x, v0.y); o.y = pk2(v0.z, v0.w); o.z = pk2(v1.x, v1.y); o.w = pk2(v1.z, v1.w);
                        if (col < 384) ss = ((v0.x * v0.x + v0.y * v0.y) + (v0.z * v0.z + v0.w * v0.w)) + ((v1.x * v1.x + v1.y * v1.y) + (v1.z * v1.z + v1.w * v1.w));
                        if (col < 416) *(u32x4*)(Z + (size_t)row * 1024 + col) = o;
                        else if (col < 928) {
                            const int ch = col - 416, g = ch >> 4, j = ch & 15, b = row / S, t = row % S;
                            *(u32x4*)(AS5 + ((size_t)g * 512 + b * 64 + (t >> 6)) * 1152 + 128 + (t & 63) * 16 + j) = o;
                        }
                        return ss;
                    };
                auto re = [=](const pg8::Unit& u, int ai, int m, int r, int wc, int fq, float part) {
                        if (u.pn < 2) {
                            part += __shfl_xor(part, 16); part += __shfl_xor(part, 32);
                            if (fq == 0) RSP[((size_t)(u.pm * 256 + r) * 2 + u.pn) * 4 + wc] = part;
                        }
                    };
                pg8::gemm_phase<false, false, true>(tid, (PG8_LAS unsigned char*)lds, pg8::Gemm{HB, W_IN_E, D, D, D}, so, pg8::make_epi_row<true>(pg8::NoPre{}, f, re));
            }
            {
                float* KT = (float*)lds;
                float* Cs = KT + 64 * 256;
                float* PWt = Cs + 2048;
                float* PWe = PWt + 1024;
                float* BBe = PWe + 2048;
                for (int item = vb; item < 256; item += G) {
                    const int g = item >> 3, tq = item & 7;
                    __syncthreads();
                    const int ntau = 8 * tq + 8;
                    for (int idx = tid; idx < ntau * 64; idx += NTHR) *(f32x4*)(KT + idx * 4) = *(const f32x4*)(KTAB + (size_t)g * 64 * 256 + idx * 4);
                    for (int idx = tid; idx < 1024; idx += NTHR) { const int i = idx >> 6, pp = idx & 63;
                        Cs[idx * 2] = kp->s5_c_re[(g * 16 + i) * 64 + pp]; Cs[idx * 2 + 1] = kp->s5_c_im[(g * 16 + i) * 64 + pp]; }
                    { const int pp = tid >> 3, tl = tid & 7; PWt[tid * 2] = PW[((g * 64 + pp) * 65 + tq * 8 + tl + 1) * 2]; PWt[tid * 2 + 1] = PW[((g * 64 + pp) * 65 + tq * 8 + tl + 1) * 2 + 1]; }
                    const int ri_e = tq >> 2, p0_e = (tq & 3) * 16;
                    for (int idx = tid; idx < 1024; idx += NTHR) { const int pl = idx >> 6, tau = idx & 63;
                        PWe[idx * 2] = PW[((g * 64 + p0_e + pl) * 65 + tau) * 2]; PWe[idx * 2 + 1] = PW[((g * 64 + p0_e + pl) * 65 + tau) * 2 + 1]; }
                    if (tid < 256) { const int pl = tid >> 4, j = tid & 15; BBe[tid * 2] = S5BB[((g * 64 + p0_e + pl) * 16 + j) * 2]; BBe[tid * 2 + 1] = S5BB[((g * 64 + p0_e + pl) * 16 + j) * 2 + 1]; }
                    __syncthreads();
                    for (int it = tid; it < 16 * 128; it += NTHR) {
                        const int pl = it >> 7, k8 = it & 127, s_ = k8 >> 1, j0 = (k8 & 1) * 8;
                        const float pr = PWe[(pl * 64 + 63 - s_) * 2], pi = PWe[(pl * 64 + 63 - s_) * 2 + 1];
                        float o[8];
#pragma unroll
                        for (int j = 0; j < 8; ++j) { const float br = BBe[(pl * 16 + j0 + j) * 2], bi = BBe[(pl * 16 + j0 + j) * 2 + 1]; o[j] = ri_e ? (pr * bi + pi * br) : (pr * br - pi * bi); }
                        u32x4 w; w.x = pk2(o[0], o[1]); w.y = pk2(o[2], o[3]); w.z = pk2(o[4], o[5]); w.w = pk2(o[6], o[7]);
                        *(u32x4*)(BT_END + ((size_t)g * 128 + ri_e * 64 + p0_e + pl) * 1024 + k8 * 8) = w;
                    }
                    for (int it = tid; it < 128 * 144; it += NTHR) {
                        const int rl = it / 144, k8 = it % 144, tl = rl >> 4, i = rl & 15, t = 8 * tq + tl;
                        float o[8];
                        if (k8 < 16) {
                            const int ri = k8 >> 3, p0 = (k8 & 7) * 8;
#pragma unroll
                            for (int j = 0; j < 8; ++j) {
                                const float cr = Cs[(i * 64 + p0 + j) * 2], ci = Cs[(i * 64 + p0 + j) * 2 + 1];
                                const float pr = PWt[((p0 + j) * 8 + tl) * 2], pi = PWt[((p0 + j) * 8 + tl) * 2 + 1];
                                o[j] = ri ? -(cr * pi + ci * pr) : (cr * pr - ci * pi);
                            }
                        } else {
                            const int kk = (k8 - 16) * 8, s_ = kk >> 4, j0 = kk & 15;
                            if (s_ <= t) { const f32x4 a = *(const f32x4*)(KT + (t - s_) * 256 + i * 16 + j0), c4 = *(const f32x4*)(KT + (t - s_) * 256 + i * 16 + j0 + 4);
                                o[0] = a.x; o[1] = a.y; o[2] = a.z; o[3] = a.w; o[4] = c4.x; o[5] = c4.y; o[6] = c4.z; o[7] = c4.w; }
                            else {
#pragma unroll
                                for (int j = 0; j < 8; ++j) o[j] = 0.f; }
                        }
                        u32x4 w; w.x = pk2(o[0], o[1]); w.y = pk2(o[2], o[3]); w.z = pk2(o[4], o[5]); w.w = pk2(o[6], o[7]);
                        *(u32x4*)(BT_MAIN + ((size_t)g * 1024 + 8 * tq * 16 + rl) * 1152 + k8 * 8) = w;
                    }
                }
                __syncthreads();
            }
        }
        else if (ph == 4) {
            {
                DenseOrder so; so.go.init(T / 256, 7, G, vb);
                struct UpCtx { float rs[8]; };
                auto pre = [=](const pg8::Unit& u, int wr, int wc, int fr, int fq, const PG8_LAS unsigned char* cxl) {
                        UpCtx cx; const int st = (u.pn >= 3) ? 1 : 0; const float inv = st ? (1.f / 128.f) : (1.f / 256.f);
#pragma unroll
                        for (int q = 0; q < 8; ++q) { const int row = u.pm * 256 + (q >> 2) * 128 + wr * 64 + (q & 3) * 16 + fr;
                            const f32x4 pp = *(const f32x4*)(RSP + ((size_t)row * 2 + st) * 4);
                            cx.rs[q] = rsqrtf(((pp.x + pp.y) + (pp.z + pp.w)) * inv + 1e-6f); }
                        return cx; };
                auto f = [=](const pg8::Unit& u, const UpCtx& cx, int ai, int m, int bj, int r, int c, f32x4 v0, f32x4 v1) {
                            const float rs = cx.rs[ai * 4 + m];
                            bf16_t* o = QKVRAW + (size_t)(u.pm * 256 + r) * 1792 + u.pn * 256 + c;
                            u32x4 a; a.x = pk2(v0.x * rs, v0.y * rs); a.y = pk2(v0.z * rs, v0.w * rs); a.z = pk2(v1.x * rs, v1.y * rs); a.w = pk2(v1.z * rs, v1.w * rs); *(u32x4*)o = a;
                        };
                pg8::gemm_phase<false, false, true>(tid, (PG8_LAS unsigned char*)lds, pg8::Gemm{Z, W_UP, 1024, 384, 384}, so, pg8::make_epi_perm(pre, f));
            }
            for (int u = (vb >= 128 ? vb - 128 : vb + 128); u < 128; u += G) {
                const int g = u >> 2, pm = u & 3;
                sg_tile(tid, lds, AS5 + ((size_t)g * 512 + pm * 128) * 1152 + 128, 1152, BT_END + (size_t)g * 128 * 1024, 1024, 1024,
                    [=](int r, int c, f32x4 v0, f32x4 v1) {
                        float* o = LEND + ((size_t)g * 512 + pm * 128 + r) * 128 + c;
                        *(f32x4*)o = v0; *(f32x4*)(o + 16) = v1;
                    });
            }
        }
        else if (ph == 5) {
            bf16_t* vts = (bf16_t*)lds;
            const float qscale = 0.10206207261596577f * 1.4426950408889634f;
            const int hh = lane >> 3, pp = lane & 7;
            float gq[12], gk[12];
#pragma unroll
            for (int g3 = 0; g3 < 3; ++g3)
#pragma unroll
                for (int e = 0; e < 4; ++e) { gq[g3 * 4 + e] = kp->q_head_g[32 * g3 + 4 * pp + e] * qscale; gk[g3 * 4 + e] = kp->k_head_g[32 * g3 + 4 * pp + e]; }
            float invf[4];
#pragma unroll
            for (int e = 0; e < 4; ++e) invf[e] = exp2f(-(float)(4 * (pp & 3) + e) * (13.287712379549449f / 16.0f));
            for (int tile = vb; tile < T / 64; tile += G) {
                u32x2 cq[3], ck[3], nq[3], nk[3]; u32x4 cv, nv; int cpos, npos;
#define P5_LOAD(row_, Q_, K_, V_, P_) do { const bf16_t* base_ = QKVRAW + (size_t)(row_) * 1792; \
                    _Pragma("unroll") for (int g3 = 0; g3 < 3; ++g3) Q_[g3] = *(const u32x2*)(base_ + hh * 96 + 32 * g3 + 4 * pp); \
                    K_[0] = *(const u32x2*)(base_ + 768 + hh * 128 + 4 * pp); K_[1] = *(const u32x2*)(base_ + 768 + hh * 128 + 32 + 4 * pp); K_[2] = *(const u32x2*)(Z + (size_t)(row_) * 1024 + 384 + 4 * pp); \
                    V_ = *(const u32x4*)(base_ + 768 + hh * 128 + 64 + 8 * pp); P_ = kp->pos[row_]; } while (0)
                P5_LOAD(tile * 64 + wave * 8, cq, ck, cv, cpos);
                for (int tt = 0; tt < 8; ++tt) {
                    const int tl = wave * 8 + tt, row = tile * 64 + tl, b = row / S, t = row % S;
                    if (tt + 1 < 8) P5_LOAD(row + 1, nq, nk, nv, npos);
                    float qv[12], kv[12];
#pragma unroll
                    for (int g3 = 0; g3 < 3; ++g3) {
                        qv[4 * g3 + 0] = __uint_as_float(cq[g3].x << 16); qv[4 * g3 + 1] = __uint_as_float(cq[g3].x & 0xffff0000u); qv[4 * g3 + 2] = __uint_as_float(cq[g3].y << 16); qv[4 * g3 + 3] = __uint_as_float(cq[g3].y & 0xffff0000u);
                        kv[4 * g3 + 0] = __uint_as_float(ck[g3].x << 16); kv[4 * g3 + 1] = __uint_as_float(ck[g3].x & 0xffff0000u); kv[4 * g3 + 2] = __uint_as_float(ck[g3].y << 16); kv[4 * g3 + 3] = __uint_as_float(ck[g3].y & 0xffff0000u);
                    }
                    float sq = 0.f, sk = 0.f;
#pragma unroll
                    for (int j = 0; j < 12; ++j) { sq += qv[j] * qv[j]; sk += kv[j] * kv[j]; }
                    sq += __shfl_xor(sq, 1); sq += __shfl_xor(sq, 2); sq += __shfl_xor(sq, 4);
                    sk += __shfl_xor(sk, 1); sk += __shfl_xor(sk, 2); sk += __shfl_xor(sk, 4);
                    const float rq = rsqrtf(sq * (1.f / 96.f) + 1e-6f), rk = rsqrtf(sk * (1.f / 96.f) + 1e-6f);
#pragma unroll
                    for (int j = 0; j < 12; ++j) { qv[j] *= rq * gq[j]; kv[j] *= rk * gk[j]; }
                    const float posf = (float)cpos; const bool lo = pp < 4;
#pragma unroll
                    for (int e = 0; e < 4; ++e) {
                        const float ang = posf * invf[e];
                        const float kq = rintf(ang * 0.15915494309189535f);
                        float rr = __builtin_fmaf(-kq, 6.28318548202514648f, ang); rr = __builtin_fmaf(-kq, -1.7484556e-7f, rr);
                        const float cs = __cosf(rr), sn = __sinf(rr);
                        const float qo = __shfl_xor(qv[8 + e], 4), ko = __shfl_xor(kv[8 + e], 4);
                        qv[8 + e] = lo ? (qv[8 + e] * cs - qo * sn) : (qo * sn + qv[8 + e] * cs);
                        kv[8 + e] = lo ? (kv[8 + e] * cs - ko * sn) : (ko * sn + kv[8 + e] * cs);
                    }
                    bf16_t* qd = Qb + (((size_t)b * 8 + hh) * S + t) * 96 + 4 * pp; bf16_t* kd = Kb + (((size_t)b * 8 + hh) * S + t) * 96 + 4 * pp;
#pragma unroll
                    for (int g3 = 0; g3 < 3; ++g3) {
                        u32x2 o; o.x = pk2(qv[4 * g3], qv[4 * g3 + 1]); o.y = pk2(qv[4 * g3 + 2], qv[4 * g3 + 3]); *(u32x2*)(qd + 32 * g3) = o;
                        u32x2 o2; o2.x = pk2(kv[4 * g3], kv[4 * g3 + 1]); o2.y = pk2(kv[4 * g3 + 2], kv[4 * g3 + 3]); *(u32x2*)(kd + 32 * g3) = o2;
                    }
                    { const unsigned w4[4] = {cv.x, cv.y, cv.z, cv.w};
#pragma unroll
                      for (int j = 0; j < 8; ++j) vts[(hh * 64 + 8 * pp + j) * 64 + tl] = (bf16_t)((j & 1) ? (w4[j >> 1] >> 16) : (w4[j >> 1] & 0xffffu)); }
#pragma unroll
                    for (int g3 = 0; g3 < 3; ++g3) { cq[g3] = nq[g3]; ck[g3] = nk[g3]; }
                    cv = nv; cpos = npos;
                }
#undef P5_LOAD
                __syncthreads();
                {
                    const int hd = tid, b = (tile * 64) / S, t0 = (tile * 64) % S;
                    bf16_t* dst = VT + (((size_t)b * 8 + (hd >> 6)) * 64 + (hd & 63)) * S + t0;
#pragma unroll
                    for (int i = 0; i < 8; ++i) *(u32x4*)(dst + i * 8) = *(const u32x4*)(vts + hd * 64 + i * 8);
                }
                __syncthreads();
            }
            if (wave == 0) {
                for (int ch = vb * 64 + lane; ch < NB * 32 * 64; ch += G * 64) {
                    const int pp = ch & 63, g = (ch >> 6) & 31, b = ch >> 11;
                    const float ar = PW[((g * 64 + pp) * 65 + 64) * 2], ai = PW[((g * 64 + pp) * 65 + 64) * 2 + 1];
                    float cr = 0.f, ci = 0.f;
                    for (int c0 = 0; c0 < 64; c0 += 16) {
                        float lr[16], li[16];
#pragma unroll
                        for (int u = 0; u < 16; ++u) { const float* le = LEND + ((size_t)g * 512 + b * 64 + c0 + u) * 128; lr[u] = le[pp]; li[u] = le[64 + pp]; }
#pragma unroll
                        for (int u = 0; u < 16; ++u) {
                            bf16_t* dst = AS5 + ((size_t)g * 512 + b * 64 + c0 + u) * 1152;
                            dst[pp] = f2bf(cr); dst[64 + pp] = f2bf(ci);
                            const float nr = ar * cr - ai * ci + lr[u], ni = ar * ci + ai * cr + li[u];
                            cr = nr; ci = ni;
                        }
                    }
                }
            }
        }
        else if (ph == 6) {
            unsigned char* Kr = lds;
            unsigned char* Vr = lds + 3 * 64 * 208;
            const int r32 = lane & 31, hi = lane >> 5;
#define ATT_MFMA_C(D, A, B, C) asm volatile("s_nop 1\n\tv_mfma_f32_32x32x16_bf16 %0, %1, %2, %3" : "+a"(D) : "v"(A), "v"(B), "a"(C))
#define ATT_MFMA(D, A, B)      asm volatile("s_nop 1\n\tv_mfma_f32_32x32x16_bf16 %0, %1, %2, %0" : "+a"(D) : "v"(A), "v"(B))
            for (int ui_ = 0; ui_ < 4 * (1 + PROBE_ATT2); ++ui_) { const int ui = ui_ & 3;
                if (vb >= 256) break;
                const int bh = vb & 63, kq = vb >> 6;
                const int qb = (ui == 0) ? 15 - kq : (ui == 1) ? 8 + kq : (ui == 2) ? 7 - kq : kq;
                const int q0 = qb * 256 + wave * 32;
                const bf16_t* Qg = Qb + ((size_t)bh * S + q0 + r32) * 96;
                const bf16_t* Kg = Kb + (size_t)bh * S * 96;
                const bf16_t* Vg = VT + (size_t)bh * 64 * S;
                unsigned char* Qs = lds + 3 * 64 * (208 + 136) + (wave * 32 + r32) * 208;
                __syncthreads();
#pragma unroll
                for (int d0 = 0; d0 < 6; ++d0) *(bf16x8*)(Qs + d0 * 32 + hi * 16) = *(const bf16x8*)(Qg + d0 * 16 + hi * 8);
                const int ntile = 4 * (qb + 1);
                const int ntw = (q0 + 31) / 64 + 1;
                const int kr0 = tid >> 3, kc0 = tid & 7;
                const int vr = tid >> 3, vc = tid & 7;
                u32x2 rk0, rk1, rk2; u32x4 rv;
#define ATT_LOAD(t_) do { { const u32x2* kp_ = (const u32x2*)(Kg + (size_t)((t_) * 64 + kr0) * 96 + kc0 * 12); rk0 = kp_[0]; rk1 = kp_[1]; rk2 = kp_[2]; } \
                    rv = *(const u32x4*)(Vg + (size_t)vr * S + (t_) * 64 + vc * 8); } while (0)
#define ATT_WRITE(t_) do { unsigned char* Ks_ = Kr + ((t_) % 3) * (64 * 208); unsigned char* Vs_ = Vr + ((t_) % 3) * (64 * 136); \
                    { u32x2* kd_ = (u32x2*)(Ks_ + kr0 * 208 + kc0 * 24); kd_[0] = rk0; kd_[1] = rk1; kd_[2] = rk2; } \
                    { u32x2 a_; a_.x = rv.x; a_.y = rv.y; u32x2 b_; b_.x = rv.z; b_.y = rv.w; *(u32x2*)(Vs_ + vr * 136 + vc * 16) = a_; *(u32x2*)(Vs_ + vr * 136 + vc * 16 + 8) = b_; } } while (0)
#define ATT_QK(t_) do { const unsigned char* Ks_ = Kr + ((t_) % 3) * (64 * 208); \
                    _Pragma("unroll") for (int d0 = 0; d0 < 6; ++d0) { \
                        const bf16x8 k0_ = *(const bf16x8*)(Ks_ + r32 * 208 + d0 * 32 + hi * 16); const bf16x8 k1_ = *(const bf16x8*)(Ks_ + (32 + r32) * 208 + d0 * 32 + hi * 16); \
                        const bf16x8 q_ = *(const bf16x8*)(Qs + d0 * 32 + hi * 16); \
                        if (d0 == 0) { ATT_MFMA_C(sA0, k0_, q_, negm); ATT_MFMA_C(sA1, k1_, q_, negm); } else { ATT_MFMA(sA0, k0_, q_); ATT_MFMA(sA1, k1_, q_); } } } while (0)
                f32x16 o0, o1, sA0, sA1, negm;
#pragma unroll
                for (int r = 0; r < 16; ++r) { o0[r] = 0.f; o1[r] = 0.f; negm[r] = 0.f; }
                float m_ref = 0.f, l_run = 0.f;
                ATT_LOAD(0); ATT_WRITE(0);
                if (ntile > 1) { ATT_LOAD(1); ATT_WRITE(1); }
                __syncthreads();
                ATT_QK(0);
                for (int t = 0; t < ntile; ++t) {
                    __syncthreads();
                    if (t + 2 < ntile) ATT_LOAD(t + 2);
                    if (t < ntw) {
                        asm volatile("s_nop 15\n\ts_nop 7" ::: "memory");
                        f32x16 s0 = sA0, s1 = sA1;
                        asm volatile("" : "+v"(s0), "+v"(s1));
                        if (t * 64 + 63 > q0) {
                            const int qi = q0 + r32;
#pragma unroll
                            for (int r = 0; r < 16; ++r) { const int key = t * 64 + crow(r, hi); if (key > qi) s0[r] = -INFINITY; if (key + 32 > qi) s1[r] = -INFINITY; }
                        }
                        float mx;
                        { auto max3 = [](float a_, float b_, float c_) { float r_; asm("v_max3_f32 %0, %1, %2, %3" : "=v"(r_) : "v"(a_), "v"(b_), "v"(c_)); return r_; };
                          float ma = max3(s0[0], s0[1], s1[0]), mb = max3(s0[2], s0[3], s1[1]); ma = max3(ma, s1[2], s1[3]);
#pragma unroll
                          for (int r = 4; r < 16; r += 4) { ma = max3(ma, s0[r], s0[r + 1]); mb = max3(mb, s0[r + 2], s0[r + 3]); ma = max3(ma, s1[r], s1[r + 1]); mb = max3(mb, s1[r + 2], s1[r + 3]); }
                          mx = max3(ma, mb, ma); mx = max3(mx, __shfl_xor(mx, 32), mx); }
                        if (__any(mx > 8.0f) || t == 0) {
                            const float dl = (t == 0) ? mx : fmaxf(mx, 0.f);
                            const float alpha = __builtin_amdgcn_exp2f(-dl);
                            m_ref += dl; l_run *= alpha;
#pragma unroll
                            for (int r = 0; r < 16; ++r) { s0[r] -= dl; s1[r] -= dl; }
                            if (t > 0) {
#pragma unroll
                                for (int r = 0; r < 16; ++r) { o0[r] *= alpha; o1[r] *= alpha; }
                            }
#pragma unroll
                            for (int r = 0; r < 16; ++r) negm[r] = -m_ref;
                        }
                        const bool doqk = t + 1 < ntw;
                        const unsigned char* Vs_ = Vr + (t % 3) * (64 * 136);
                        const unsigned char* Ks_ = Kr + ((t + 1) % 3) * (64 * 208);
                        typedef float f32x2_ __attribute__((ext_vector_type(2)));
                        f32x2_ ls2 = {0.f, 0.f};
#pragma unroll
                        for (int g4 = 0; g4 < 4; ++g4) {
                            const int kb = g4 >> 1, ks = g4 & 1;
                            u32x4 w;
                            if (kb == 0) {
#pragma unroll
                                for (int r = 0; r < 8; ++r) s0[8 * ks + r] = __builtin_amdgcn_exp2f(s0[8 * ks + r]);
#pragma unroll
                                for (int r = 0; r < 8; r += 2) ls2 += (f32x2_){s0[8 * ks + r], s0[8 * ks + r + 1]};
                                w.x = pk2(s0[8 * ks + 0], s0[8 * ks + 1]); w.y = pk2(s0[8 * ks + 2], s0[8 * ks + 3]); w.z = pk2(s0[8 * ks + 4], s0[8 * ks + 5]); w.w = pk2(s0[8 * ks + 6], s0[8 * ks + 7]);
                            } else {
#pragma unroll
                                for (int r = 0; r < 8; ++r) s1[8 * ks + r] = __builtin_amdgcn_exp2f(s1[8 * ks + r]);
#pragma unroll
                                for (int r = 0; r < 8; r += 2) ls2 += (f32x2_){s1[8 * ks + r], s1[8 * ks + r + 1]};
                                w.x = pk2(s1[8 * ks + 0], s1[8 * ks + 1]); w.y = pk2(s1[8 * ks + 2], s1[8 * ks + 3]); w.z = pk2(s1[8 * ks + 4], s1[8 * ks + 5]); w.w = pk2(s1[8 * ks + 6], s1[8 * ks + 7]);
                            }
                            const bf16x8 pfg = __builtin_bit_cast(bf16x8, w);
                            const int koff = (kb * 32 + 16 * ks + 4 * hi) * 2;
#pragma unroll
                            for (int dvb = 0; dvb < 2; ++dvb) {
                                const unsigned char* vp = Vs_ + (dvb * 32 + r32) * 136 + koff;
                                const u32x2 lo = *(const u32x2*)vp, hi2 = *(const u32x2*)(vp + 16);
                                u32x4 wv; wv.x = lo.x; wv.y = lo.y; wv.z = hi2.x; wv.w = hi2.y;
                                const bf16x8 vf = __builtin_bit_cast(bf16x8, wv);
                                if (dvb == 0) ATT_MFMA(o0, vf, pfg); else ATT_MFMA(o1, vf, pfg);
                                __builtin_amdgcn_sched_barrier(0);
                            }
                            if (doqk) {
#pragma unroll
                                for (int q3 = 0; q3 < 3; ++q3) {
                                    const int qi3 = g4 * 3 + q3, d0 = qi3 >> 1, kq = qi3 & 1;
                                    const bf16x8 k_ = *(const bf16x8*)(Ks_ + (kq * 32 + r32) * 208 + d0 * 32 + hi * 16);
                                    const bf16x8 q_ = *(const bf16x8*)(Qs + d0 * 32 + hi * 16);
                                    if (kq == 0) { if (d0 == 0) ATT_MFMA_C(sA0, k_, q_, negm); else ATT_MFMA(sA0, k_, q_); }
                                    else         { if (d0 == 0) ATT_MFMA_C(sA1, k_, q_, negm); else ATT_MFMA(sA1, k_, q_); }
                                    __builtin_amdgcn_sched_barrier(0);
                                }
                            }
                            __builtin_amdgcn_sched_barrier(0);
                        }
                        l_run += ls2.x + ls2.y;
                    }
                    if (t + 2 < ntile) ATT_WRITE(t + 2);
                }
                asm volatile("s_nop 15\n\ts_nop 7" ::: "memory");
                l_run += __shfl_xor(l_run, 32);
                const float rl = __builtin_amdgcn_rcpf(l_run);
                const int b = bh >> 3, h = bh & 7;
                bf16_t* orow = MIXIN + ((size_t)b * S + q0 + r32) * 1024 + h * 64;
#pragma unroll
                for (int rg = 0; rg < 4; ++rg) {
                    u32x2 a; a.x = pk2(o0[4 * rg] * rl, o0[4 * rg + 1] * rl); a.y = pk2(o0[4 * rg + 2] * rl, o0[4 * rg + 3] * rl);
                    *(u32x2*)(orow + 8 * rg + 4 * hi) = a;
                    u32x2 c2; c2.x = pk2(o1[4 * rg] * rl, o1[4 * rg + 1] * rl); c2.y = pk2(o1[4 * rg + 2] * rl, o1[4 * rg + 3] * rl);
                    *(u32x2*)(orow + 32 + 8 * rg + 4 * hi) = c2;
                }
            }
#undef ATT_MFMA_C
#undef ATT_MFMA
#undef ATT_LOAD
#undef ATT_WRITE
#undef ATT_QK
            __syncthreads();
            {
                S5Order so; so.G = G; so.c = vb;
                auto f = [=](const pg8::Unit& u, const pg8::NoCtx&, int ai, int m, int bj, int r, int c, f32x4 v0, f32x4 v1) {
                        const int g = u.aux, mr = (u.pm & 1) * 256 + r, b = mr >> 6, ck = mr & 63;
#pragma unroll
                        for (int h = 0; h < 2; ++h) {
                            const int n = u.pn * 256 + c + 16 * h; const f32x4 v = h ? v1 : v0;
                            const int tq = n >> 4, i = n & 15;
                            const u32x2 uu = *(const u32x2*)(AS5 + ((size_t)g * 512 + mr) * 1152 + 128 + n);
                            const f32x4 dd = *(const f32x4*)(s5d + g * 16 + i);
                            const float y0 = v.x + dd.x * __uint_as_float(uu.x << 16), y1 = v.y + dd.y * __uint_as_float(uu.x & 0xffff0000u),
                                        y2 = v.z + dd.z * __uint_as_float(uu.y << 16), y3 = v.w + dd.w * __uint_as_float(uu.y & 0xffff0000u);
                            u32x2 o; o.x = pk2(gelu_tanh(y0), gelu_tanh(y1)); o.y = pk2(gelu_tanh(y2), gelu_tanh(y3));
                            *(u32x2*)(GACT + ((size_t)b * S + ck * 64 + tq) * 512 + g * 16 + i) = o;
                        }
                    };
                const int tid2 = wbase + lane_id();
                pg8::gemm_phase(tid2, (PG8_LAS unsigned char*)lds, pg8::Gemm{AS5, BT_MAIN, 1152, 1152, 1152}, so, pg8::make_epi(pg8::NoPre{}, f));
            }
        }
        else if (ph == 7) {
            {
                DenseOrder so; so.go.init(T / 256, 2, G, vb);
                auto f = [=](const pg8::Unit& u, const pg8::NoCtx&, int ai, int m, int bj, int r, int c, f32x4 v0, f32x4 v1) {
                        const int row = u.pm * 256 + r, col = u.pn * 256 + c;
                        float gv[8]; unpack8(*(const u32x4*)(GACT + (size_t)row * 512 + col), gv);
                        const f32x4 b0 = *(const f32x4*)(glub + col), b1 = *(const f32x4*)(glub + col + 4);
                        u32x4 o; o.x = pk2(gv[0] * sigmoidf_(v0.x + b0.x), gv[1] * sigmoidf_(v0.y + b0.y)); o.y = pk2(gv[2] * sigmoidf_(v0.z + b0.z), gv[3] * sigmoidf_(v0.w + b0.w));
                        o.z = pk2(gv[4] * sigmoidf_(v1.x + b1.x), gv[5] * sigmoidf_(v1.y + b1.y)); o.w = pk2(gv[6] * sigmoidf_(v1.z + b1.z), gv[7] * sigmoidf_(v1.w + b1.w));
                        *(u32x4*)(MIXIN + (size_t)row * 1024 + 512 + col) = o;
                    };
                pg8::gemm_phase<false, false, true>(tid, (PG8_LAS unsigned char*)lds, pg8::Gemm{GACT, W_GLU, 512, 512, 512}, so, pg8::make_epi_perm(pg8::NoPre{}, f));
            }
        }
        else if (ph == 8 || ph == 16) {
            const int lyr = (ph == 8) ? 0 : 1;
            const bf16_t* W = lyr ? W_OUT_O : W_OUT_E;

            {
                DenseOrder so; so.go.init(T / 256, 4, G, vb);
                struct OCtx { f32x4 gm[2][2]; };
                struct OG { u32x4 x[2][2]; };
                auto pre = [=](const pg8::Unit& u, int wr, int wc, int fr, int fq, const PG8_LAS unsigned char* cxl) {
                        OCtx cx; const int b = (u.pm * 256) / S; const float* gm = MOD + ((size_t)lyr * NB + b) * 6144 + 2 * D;
#pragma unroll
                        for (int bj = 0; bj < 2; ++bj)
#pragma unroll
                            for (int h = 0; h < 2; ++h) cx.gm[bj][h] = *(const f32x4*)(gm + u.pn * 256 + bj * 128 + wc * 32 + 4 * fq + 16 * h);
                        return cx; };
                auto gp = [=](const pg8::Unit& u, const OCtx&, int r, int wc, int fq) {
                        OG g; const int row = u.pm * 256 + r;
#pragma unroll
                        for (int bj = 0; bj < 2; ++bj)
#pragma unroll
                            for (int h = 0; h < 2; ++h) { const int col = u.pn * 256 + bj * 128 + wc * 32 + 4 * fq + 16 * h;
                                if (lyr == 0) g.x[bj][h] = *(const u32x4*)(XIN + (size_t)row * D + col);
                                else { const u32x2 xx = *(const u32x2*)(XR + (size_t)row * D + col); g.x[bj][h] = (u32x4){xx.x, xx.y, 0u, 0u}; } }
                        return g; };
                auto f = [=](const pg8::Unit& u, const OCtx& cx, const OG& g, int ai, int m, int bj, int r, int c, f32x4 v0, f32x4 v1) {
                        const int row = u.pm * 256 + r;
#pragma unroll
                        for (int h = 0; h < 2; ++h) {
                            const int col = u.pn * 256 + c + 16 * h; const f32x4 v = h ? v1 : v0;
                            const f32x4 g4 = cx.gm[bj][h]; const u32x4 xx = g.x[bj][h]; f32x4 xs;
                            if (lyr == 0) { xs.x = __uint_as_float(xx.x); xs.y = __uint_as_float(xx.y); xs.z = __uint_as_float(xx.z); xs.w = __uint_as_float(xx.w); }
                            else { xs.x = __uint_as_float(xx.x << 16); xs.y = __uint_as_float(xx.x & 0xffff0000u); xs.z = __uint_as_float(xx.y << 16); xs.w = __uint_as_float(xx.y & 0xffff0000u); }
                            u32x2 o; o.x = pk2(xs.x + g4.x * v.x, xs.y + g4.y * v.y); o.y = pk2(xs.z + g4.z * v.z, xs.w + g4.w * v.w);
                            *(u32x2*)(XR + (size_t)row * D + col) = o;
                        }
                    };
                pg8::gemm_phase(tid, (PG8_LAS unsigned char*)lds, pg8::Gemm{MIXIN, W, D, D, D}, so, pg8::make_epi_g(pre, gp, f));
            }
        }
        else if (mph == 9) {
            const bf16_t* W = W_RT + (size_t)layer * 128 * 1024;
            const float* rb = rtb_all + layer * 32;
            float* lgs = (float*)(lds + 40960);
            unsigned* hist = (unsigned*)(lds + 40960 + 128 * 33 * 4);
            unsigned* gcnt = ctl + CW_CNT + layer * 64;
            const float* ng = kp->norm_ffn_g + layer * D;
            for (int tile = vb; tile < T / 128; tile += G) {
              for (int rep_ = 0; rep_ <= PROBE_RT2; ++rep_) {
                if (rep_) __syncthreads();
                for (int i = 0; i < 16; i += 2) {
                    u32x4 xr[2][2];
#pragma unroll
                    for (int q = 0; q < 2; ++q)
#pragma unroll
                        for (int j = 0; j < 2; ++j) xr[q][j] = *(const u32x4*)(XR + (size_t)(tile * 128 + wave * 16 + i + q) * D + 8 * lane + 512 * j);
#pragma unroll
                    for (int q = 0; q < 2; ++q) {
                        const int row = tile * 128 + wave * 16 + i + q, b = row / S;
                        float v[2][8]; unpack8(xr[q][0], v[0]); unpack8(xr[q][1], v[1]);
                        const float* mm = MOD + ((size_t)layer * NB + b) * 6144 + 3 * D;
                        norm_mod_store8(v, ng, mm + D, mm, HB + (size_t)row * D, HB8 + (size_t)row * D, lane);
                    }
                }
                if (tid < 64) hist[tid] = 0u;
                asm volatile("s_waitcnt vmcnt(0)" ::: "memory");
                __syncthreads();
                sg_tile(tid, lds, HB + (size_t)tile * 128 * D, D, W, D, D,
                    [=](int r, int c, f32x4 v0, f32x4 v1) {
                        if (c < 32) {
#pragma unroll
                            for (int i = 0; i < 4; ++i) { lgs[r * 33 + c + i] = v0[i] + rb[c + i]; lgs[r * 33 + c + 16 + i] = v1[i] + rb[c + 16 + i]; }
                        }
                    });
              }
                __syncthreads();
                const bool act = tid < 128; const int rr = tid & 127;
                float lg[32];
#pragma unroll
                for (int e = 0; e < 32; ++e) lg[e] = lgs[rr * 33 + e];
                int e0 = 0, e1 = 0, e2 = 0, e3 = 0; float v0_ = 0.f, v1_ = 0.f, v2_ = 0.f, v3_ = 0.f;
#pragma unroll
                for (int k = 0; k < 4; ++k) {
                    float best = -INFINITY; int bi = 0;
#pragma unroll
                    for (int e = 0; e < 32; ++e) { const bool tk = lg[e] > best; best = tk ? lg[e] : best; bi = tk ? e : bi; }
                    if (k == 0) { e0 = bi; v0_ = best; } else if (k == 1) { e1 = bi; v1_ = best; } else if (k == 2) { e2 = bi; v2_ = best; } else { e3 = bi; v3_ = best; }
#pragma unroll
                    for (int e = 0; e < 32; ++e) lg[e] = (e == bi) ? -INFINITY : lg[e];
                }
                const float x1_ = __expf(v1_ - v0_), x2_ = __expf(v2_ - v0_), x3_ = __expf(v3_ - v0_);
                const float rden = 1.0f / (1.0f + x1_ + x2_ + x3_);
                unsigned l0 = 0, l1 = 0, l2 = 0, l3 = 0;
                if (act) { l0 = atomicAdd(hist + e0, 1u); l1 = atomicAdd(hist + e1, 1u); l2 = atomicAdd(hist + e2, 1u); l3 = atomicAdd(hist + e3, 1u); }
                __syncthreads();
                if (tid < 32) hist[32 + tid] = atomicAdd(gcnt + tid, (unsigned)hist[tid]);
                __syncthreads();
                if (act) {
                    const int tok = tile * 128 + tid;
                    size_t idx = (size_t)e0 * T + hist[32 + e0] + l0; EL_SLOT[idx] = tok * 4 + 0; EL_GATE[idx] = rden;
                    idx = (size_t)e1 * T + hist[32 + e1] + l1; EL_SLOT[idx] = tok * 4 + 1; EL_GATE[idx] = x1_ * rden;
                    idx = (size_t)e2 * T + hist[32 + e2] + l2; EL_SLOT[idx] = tok * 4 + 2; EL_GATE[idx] = x2_ * rden;
                    idx = (size_t)e3 * T + hist[32 + e3] + l3; EL_SLOT[idx] = tok * 4 + 3; EL_GATE[idx] = x3_ * rden;
                }
                __syncthreads();
            }
        }
        else if (mph == 10 || mph == 11) {
            int* pst = (int*)(lds + LDS_MISC + 1024);
            if (tid == 0) {
                const unsigned* gcnt = ctl + CW_CNT + layer * 64; int acc = 0;
                for (int e = 0; e < 32; ++e) { const int c = (int)gcnt[e]; pst[e] = acc; pst[64 + e] = c; acc += (c + 255) & ~255; }
                pst[32] = acc;
            }
            __syncthreads();
            const int total_rows = pst[32];
            if (mph == 10) {
                {
                    MoeOrder so; so.go.init(total_rows >> 8, 8, G, vb); so.pst = pst; so.NT = 8; so.ebase = layer * 32; so.el_slot = EL_SLOT;
                    struct G1Ctx { f32x4 b0[2], b1[2]; };
                    auto pre = [=](const pg8::Unit& u, int wr, int wc, int fr, int fq, const PG8_LAS unsigned char* cxl) {
                            G1Ctx cx;
#pragma unroll
                            for (int bj = 0; bj < 2; ++bj) { const int jl = (bj * 4 + wc) * 16 + 4 * fq;
                                cx.b0[bj] = *(const PG8_LAS f32x4*)(cxl + jl * 4); cx.b1[bj] = *(const PG8_LAS f32x4*)(cxl + 512 + jl * 4); }
                            return cx; };
                    auto stg = [=](const pg8::Unit& u, PG8_LAS unsigned char* cb, int wid, int lane) {
                            if (wid == 0) { const float* src = bgu_all + (size_t)(layer * 32 + u.aux) * 2048 + (lane >> 5) * 1024 + u.pn * 128 + (lane & 31) * 4;
                                __builtin_amdgcn_global_load_lds((const unsigned*)src, (PG8_LAS unsigned*)cb, 16, 0, 0); } };
                    auto f = [=](const pg8::Unit& u, const G1Ctx& cx, int ai, int m, int bj, int tr, int c, f32x4 v0, f32x4 v1, PG8_LAS unsigned char* tile) {
                            const int jl = (c >> 5) * 16 + (c & 15);
                            const f32x4 b0 = cx.b0[bj], b1 = cx.b1[bj];
                            typedef float f32x2 __attribute__((ext_vector_type(2)));
                            float o[4];
#pragma unroll
                            for (int q = 0; q < 2; ++q) {
                                f32x2 gt = (f32x2){v0[2 * q], v0[2 * q + 1]} + (f32x2){b0[2 * q], b0[2 * q + 1]};
                                f32x2 ln = (f32x2){v1[2 * q], v1[2 * q + 1]} + (f32x2){b1[2 * q], b1[2 * q + 1]};
                                gt.x = __builtin_amdgcn_fmed3f(gt.x, -INFINITY, 7.0f); gt.y = __builtin_amdgcn_fmed3f(gt.y, -INFINITY, 7.0f);
                                ln.x = __builtin_amdgcn_fmed3f(ln.x, -7.0f, 7.0f); ln.y = __builtin_amdgcn_fmed3f(ln.y, -7.0f, 7.0f);
                                const f32x2 t = gt * (-1.702f * 1.4426950408889634f);
                                f32x2 e; e.x = __builtin_amdgcn_exp2f(t.x); e.y = __builtin_amdgcn_exp2f(t.y);
                                const f32x2 d = e + 1.0f;
                                f32x2 r; r.x = __builtin_amdgcn_rcpf(d.x); r.y = __builtin_amdgcn_rcpf(d.y);
                                const f32x2 ov = (gt * r) * (ln + 1.0f);
                                o[2 * q] = ov.x; o[2 * q + 1] = ov.y;
                            }
                            *(PG8_LAS unsigned*)(tile + tr * 144 + jl) = pk4_fp8(o[0], o[1], o[2], o[3]);
                        };
                    auto fl = [=](const pg8::Unit& u, const G1Ctx&, int ai, int m0, int tid_, PG8_LAS unsigned char* tile) {
                            const int tr = tid_ >> 3, piece = tid_ & 7;
                            const u32x4 v = *(const PG8_LAS u32x4*)(tile + tr * 144 + piece * 16);
                            const int row = u.pm * 256 + ai * 128 + ((tr >> 4) & 1) * 64 + (m0 + (tr >> 5)) * 16 + (tr & 15);
                            *(u32x4*)(ACT + (size_t)row * D + u.pn * 128 + piece * 16) = v;
                        };
                    pg8::gemm_phase<true, true>(tid, (PG8_LAS unsigned char*)lds, pg8::Gemm{(const bf16_t*)HB8, (const bf16_t*)W_GU, 512, 512, 512}, so, pg8::make_epi_staged<2, 9216>(pre, f, fl), stg, LDS_CTX_OFF);
                }
            } else {
                {
                    MoeOrder so; so.go.init(total_rows >> 8, 4, G, vb); so.pst = pst; so.NT = 4; so.ebase = layer * 32; so.el_slot = EL_SLOT;
                    struct G2Ctx { float gate[8]; int slot[8]; f32x4 bb[2][2]; };
                    auto pre = [=](const pg8::Unit& u, int wr, int wc, int fr, int fq, const PG8_LAS unsigned char* cxl) {
                            G2Ctx cx;
                            const int ro0 = u.pm * 256 - pst[u.aux], cnt = pst[64 + u.aux];
#pragma unroll
                            for (int q = 0; q < 8; ++q) { const int rl = (q >> 2) * 128 + wr * 64 + (q & 3) * 16 + fr; const bool ok = ro0 + rl < cnt;
                                const float gv = *(const PG8_LAS float*)(cxl + 1024 + rl * 4); const int sv = *(const PG8_LAS int*)(cxl + 2048 + rl * 4);
                                cx.gate[q] = ok ? gv : 0.f; cx.slot[q] = ok ? sv : -1; }
#pragma unroll
                            for (int bj = 0; bj < 2; ++bj)
#pragma unroll
                                for (int h = 0; h < 2; ++h) cx.bb[bj][h] = *(const PG8_LAS f32x4*)(cxl + (bj * 128 + wc * 32 + 8 * fq + 4 * h) * 4);
                            return cx; };
                    auto stg = [=](const pg8::Unit& u, PG8_LAS unsigned char* cb, int wid, int lane) {
                            const size_t eo = (size_t)u.aux * T + (u.pm * 256 - pst[u.aux]) + lane * 4;
                            if (wid == 0) __builtin_amdgcn_global_load_lds((const unsigned*)(bdn_all + (size_t)(layer * 32 + u.aux) * 1024 + u.pn * 256 + lane * 4), (PG8_LAS unsigned*)cb, 16, 0, 0);
                            else if (wid == 1) __builtin_amdgcn_global_load_lds((const unsigned*)(EL_GATE + eo), (PG8_LAS unsigned*)(cb + 1024), 16, 0, 0);
                            else if (wid == 2) __builtin_amdgcn_global_load_lds((const unsigned*)(EL_SLOT + eo), (PG8_LAS unsigned*)(cb + 2048), 16, 0, 0); };
                    auto f = [=](const pg8::Unit& u, const G2Ctx& cx, int ai, int m, int bj, int r, int c8, f32x4 v0, f32x4 v1) {
                            const int slot = cx.slot[ai * 4 + m];
                            if (slot >= 0) {
                                const float gt = cx.gate[ai * 4 + m]; const f32x4 b0 = cx.bb[bj][0], b1 = cx.bb[bj][1];
                                u32x4 o; o.x = pk2((v0.x + b0.x) * gt, (v0.y + b0.y) * gt); o.y = pk2((v0.z + b0.z) * gt, (v0.w + b0.w) * gt);
                                o.z = pk2((v1.x + b1.x) * gt, (v1.y + b1.y) * gt); o.w = pk2((v1.z + b1.z) * gt, (v1.w + b1.w) * gt);
                                *(u32x4*)(Y + (size_t)slot * D + u.pn * 256 + c8) = o;
                            }
                        };
                    pg8::gemm_phase<true, false, true>(tid, (PG8_LAS unsigned char*)lds, pg8::Gemm{(const bf16_t*)ACT, (const bf16_t*)W_DN, 512, 512, 512}, so, pg8::make_epi_perm(pre, f), stg, LDS_CTX_OFF);
                }
            }
        }
        else if (ph == 13) {
            {
                DenseOrder so; so.go.init(T / 256, 6, G, vb);
                auto f = [=](const pg8::Unit& u, const pg8::NoCtx&, int ai, int m, int bj, int r, int c, f32x4 v0, f32x4 v1) {
                        const int row = u.pm * 256 + r, col = u.pn * 256 + c;
                        if (col >= 512) { v0.x = gelu_tanh(v0.x); v0.y = gelu_tanh(v0.y); v0.z = gelu_tanh(v0.z); v0.w = gelu_tanh(v0.w); v1.x = gelu_tanh(v1.x); v1.y = gelu_tanh(v1.y); v1.z = gelu_tanh(v1.z); v1.w = gelu_tanh(v1.w); }
                        u32x4 o; o.x = pk2(v0.x, v0.y); o.y = pk2(v0.z, v0.w); o.z = pk2(v1.x, v1.y); o.w = pk2(v1.z, v1.w);
                        *(u32x4*)(Z + (size_t)row * 1536 + col) = o;
                    };
                pg8::gemm_phase<false, false, true>(tid, (PG8_LAS unsigned char*)lds, pg8::Gemm{HB, W_IN_O, D, D, D}, so, pg8::make_epi_perm(pg8::NoPre{}, f));
            }
        }
        else if (ph == 14) {
            for (int ck = vb; ck < T / 128; ck += G) {
                bf16_t* tile = (bf16_t*)lds;
                {
                    const int ch0 = lane * 8, w = 2 << (ch0 >> 7);
                    const int row0 = ck * 128 + wave * 16, t0 = row0 % S;
                    float gsg[8];
#pragma unroll
                    for (int i = 0; i < 8; ++i) gsg[i] = kp->sgu_norm_g[lane * 8 + i];
                    float run[8];
#pragma unroll
                    for (int i = 0; i < 8; ++i) run[i] = 0.f;
                    for (int q = 1; q <= w; ++q) {
                        if (t0 - q >= 0) { float f[8]; unpack8(*(const u32x4*)(Z + (size_t)(row0 - q) * 1536 + ch0), f);
#pragma unroll
                            for (int i = 0; i < 8; ++i) run[i] += f[i]; }
                    }
                    u32x4 cu, cl, cz, nu, nl, nz;
#define P14_LOAD(r_, t_, U_, L_, Z_) do { U_ = *(const u32x4*)(Z + (size_t)(r_) * 1536 + ch0); L_ = ((t_) - w >= 0) ? *(const u32x4*)(Z + (size_t)((r_) - w) * 1536 + ch0) : (u32x4){0u, 0u, 0u, 0u}; \
                        Z_ = *(const u32x4*)(Z + (size_t)(r_) * 1536 + 1024 + lane * 8); } while (0)
                    P14_LOAD(row0, t0, cu, cl, cz);
                    for (int tt = 0; tt < 16; ++tt) {
                        const int sl = wave * 16 + tt, row = row0 + tt, t = t0 + tt;
                        if (tt + 1 < 16) P14_LOAD(row + 1, t + 1, nu, nl, nz);
                        float own[8], old[8];
                        unpack8(cu, own); unpack8(cl, old);
#pragma unroll
                        for (int i = 0; i < 8; ++i) run[i] += own[i] - old[i];
                        const int n = (t + 1 < w) ? t + 1 : w;
                        const float inv = 1.0f / (float)n;
                        float po[8];
#pragma unroll
                        for (int i = 0; i < 8; ++i) po[i] = run[i] * inv - own[i];
                        *(u32x4*)(POOLED + (size_t)row * 512 + ch0) = pack8(po);
                        float f[8]; unpack8(cz, f);
                        float ss = 0.f;
#pragma unroll
                        for (int i = 0; i < 8; ++i) ss += f[i] * f[i];
                        const float rr = rsqrtf(wave_sum(ss) * (1.f / 512.f) + 1e-6f);
#pragma unroll
                        for (int i = 0; i < 8; ++i) f[i] *= rr * gsg[i];
                        *(u32x4*)(tile + sl * 520 + lane * 8) = pack8(f);
                        cu = nu; cl = nl; cz = nz;
                    }
#undef P14_LOAD
                }
                __syncthreads();
                {
                    const int ch = tid;
                    bf16_t* dst = VTS + ((size_t)ck * 512 + ch) * 128;
                    for (int s8 = 0; s8 < 16; ++s8) {
                        unsigned w[4];
#pragma unroll
                        for (int i = 0; i < 4; ++i) w[i] = (unsigned)tile[(s8 * 8 + 2 * i) * 520 + ch] | ((unsigned)tile[(s8 * 8 + 2 * i + 1) * 520 + ch] << 16);
                        u32x4 o; o.x = w[0]; o.y = w[1]; o.z = w[2]; o.w = w[3];
                        *(u32x4*)(dst + s8 * 8) = o;
                    }
                }
                __syncthreads();
            }
        }
        else if (ph == 15) {
            for (int u = vb; u < 2048; u += G) {
                if (u < 1024) {
                    const int pm = u >> 2, gi = u & 3;
                    sg_tile(tid, lds, POOLED + (size_t)pm * 128 * 512 + gi * 128, 512, W_POOL + (size_t)gi * 128 * 128, 128, 128,
                        [=](int r, int c, f32x4 v0, f32x4 v1) {
                            const int row = pm * 128 + r;
#pragma unroll
                            for (int h = 0; h < 2; ++h) {
                                const int col = gi * 128 + c + 16 * h; const f32x4 v = h ? v1 : v0;
                                const f32x4 sc = *(const f32x4*)(poolsc + col);
                                u32x2 o; o.x = pk2(v.x * sc.x, v.y * sc.y); o.y = pk2(v.z * sc.z, v.w * sc.w);
                                *(u32x2*)(MIXIN + (size_t)row * 1024 + col) = o;
                            }
                        });
                } else {
                    const int uu = u - 1024, ck = uu >> 2, h4 = uu & 3;
                    sg_tile(tid, lds, W_SGU + (size_t)h4 * 128 * 128, 128, VTS + ((size_t)ck * 512 + h4 * 128) * 128, 128, 128,
                        [=](int r, int c, f32x4 v0, f32x4 v1) {
                            const int row = ck * 128 + r;
                            const float bias = sgub[h4 * 128 + r];
#pragma unroll
                            for (int h = 0; h < 2; ++h) {
                                const int dcol = c + 16 * h; const f32x4 v = h ? v1 : v0;
                                const u32x2 ug = *(const u32x2*)(Z + (size_t)row * 1536 + 512 + h4 * 128 + dcol);
                                u32x2 o; o.x = pk2((v.x + bias) * __uint_as_float(ug.x << 16), (v.y + bias) * __uint_as_float(ug.x & 0xffff0000u));
                                o.y = pk2((v.z + bias) * __uint_as_float(ug.y << 16), (v.w + bias) * __uint_as_float(ug.y & 0xffff0000u));
                                *(u32x2*)(MIXIN + (size_t)row * 1024 + 512 + h4 * 128 + dcol) = o;
                            }
                        });
                }
            }
        }

    }
}
template <int PH> struct PhaseSeq {
    static __device__ __forceinline__ void run(const XcdBarrier& bar) { PhaseSeq<PH - 1>::run(bar); if constexpr (PH == 3) return;
        unsigned long long t0_ = 0; if constexpr (PH == PROBE_TPH) t0_ = __builtin_amdgcn_s_memrealtime();
        phase_body<PH>(bar.wbase);
        if constexpr (((PROBE_DUP_MASK >> PH) & 1ull) != 0) { xcd_barrier(bar); phase_body<PH>(bar.wbase); }
        if (PH + 1 < NPHASE) { xcd_barrier(bar); if constexpr (PROBE_BAR2) xcd_barrier(bar); }
        if constexpr (PH == PROBE_TPH) { if (bar.wbase == 0 && lane_id() == 0) { const unsigned dt = (unsigned)(__builtin_amdgcn_s_memrealtime() - t0_); bar.st[4] = dt; } }
    }
};
template <> struct PhaseSeq<-1> { static __device__ __forceinline__ void run(const XcdBarrier&) {} };

template <int PHSEL> __global__ void __launch_bounds__(NTHR, 2) hybrid_fwd(Params p) {
    extern __shared__ __attribute__((aligned(16))) unsigned char lds[];
    const int tid0 = threadIdx.x;
    for (int u = tid0; u < (LDS_BYTES - LDS_MISC) / 4; u += NTHR) ((unsigned*)(lds + LDS_MISC))[u] = 0u;
    __syncthreads();
    if constexpr (PHSEL >= 0) { phase_body<PHSEL>(__builtin_amdgcn_readfirstlane((int)threadIdx.x & ~63)); }
    else {
        volatile LAS unsigned* MISC = (volatile LAS unsigned*)((LAS unsigned char*)lds + LDS_MISC);
        unsigned* ctl0 = (unsigned*)(p.ws + WS_CTL);
        XcdBarrier bar = xcd_barrier_post(ctl0 + CW_BAR, MISC + 8);
        PhaseSeq<NPHASE - 1>::run(bar);
        if constexpr (PROBE_TPH >= 0 || PROBE_SEG != 0) { if (blockIdx.x == 0 && bar.wbase == 0 && lane_id() == 0) { const unsigned dt = MISC[12]; const unsigned long long te = __builtin_amdgcn_s_memrealtime(); while (__builtin_amdgcn_s_memrealtime() - te < 4ull * dt) __builtin_amdgcn_s_sleep(8); } }
    }
}

typedef void (*kfn_t)(Params);
template <int PH> struct Tab { static void fill(kfn_t* t) { t[PH] = hybrid_fwd<PH>; Tab<PH - 1>::fill(t); } };
template <> struct Tab<-1> { static void fill(kfn_t*) {} };
static kfn_t g_tab[NPHASE];
static void set_attrs() {
#if MK_ONE_LAUNCH
    (void)hipFuncSetAttribute((const void*)hybrid_fwd<-1>, hipFuncAttributeMaxDynamicSharedMemorySize, LDS_BYTES);
#else
    Tab<NPHASE - 1>::fill(g_tab);
    for (int i = 0; i < NPHASE; ++i) (void)hipFuncSetAttribute((const void*)g_tab[i], hipFuncAttributeMaxDynamicSharedMemorySize, LDS_BYTES);
#endif
}
#if !MK_ONE_LAUNCH
static void launch_all(const Params& p, int grid, hipStream_t stream) {
    for (int ph = 0; ph < NPHASE; ++ph) hipLaunchKernelGGL(g_tab[ph], dim3(grid), dim3(NTHR), LDS_BYTES, stream, p);
}
#endif
extern "C" void kernel_launch(void* const* d_in, const int* in_sizes, int n_in, void* d_out, int out_size, void* d_ws, size_t ws_size, hipStream_t stream) {
    static int ready = 0;
    if (ready == 0) {
        if (n_in != 38 || ws_size < WS_END) { fprintf(stderr, "kernel_launch: unexpected n_in %d / ws %zu\n", n_in, ws_size); ready = -1; return; }
        set_attrs();
        ready = 1;
    }
    if (ready < 0) return;
    (void)hipMemsetAsync((char*)d_ws + WS_CTL, 0, CTL_ZERO_BYTES, stream);
    Params p{};
    const float** fp = (const float**)&p.x;
    (void)fp;
    p.x = (const float*)d_in[0]; p.c = (const float*)d_in[1]; p.pos = (const int*)d_in[2];
    p.ada_w = (const float*)d_in[3]; p.ada_b = (const float*)d_in[4]; p.norm_mix_g = (const float*)d_in[5]; p.norm_ffn_g = (const float*)d_in[6];
    p.router_w = (const float*)d_in[7]; p.router_b = (const float*)d_in[8]; p.moe_w_gu = (const float*)d_in[9]; p.moe_b_gu = (const float*)d_in[10];
    p.moe_w_dn = (const float*)d_in[11]; p.moe_b_dn = (const float*)d_in[12];
    p.even_w_in = (const float*)d_in[13]; p.q_norm_g = (const float*)d_in[14]; p.w_uq = (const float*)d_in[15]; p.kv_norm_g = (const float*)d_in[16];
    p.w_ukv = (const float*)d_in[17]; p.q_head_g = (const float*)d_in[18]; p.k_head_g = (const float*)d_in[19];
    p.s5_a_re = (const float*)d_in[20]; p.s5_a_im = (const float*)d_in[21]; p.s5_log_dt = (const float*)d_in[22]; p.s5_b_re = (const float*)d_in[23];
    p.s5_b_im = (const float*)d_in[24]; p.s5_c_re = (const float*)d_in[25]; p.s5_c_im = (const float*)d_in[26]; p.s5_d = (const float*)d_in[27];
    p.s5_glu_w = (const float*)d_in[28]; p.s5_glu_b = (const float*)d_in[29]; p.even_w_out = (const float*)d_in[30];
    p.odd_w_in = (const float*)d_in[31]; p.pool_w = (const float*)d_in[32]; p.pool_scale = (const float*)d_in[33]; p.sgu_norm_g = (const float*)d_in[34];
    p.sgu_w = (const float*)d_in[35]; p.sgu_b = (const float*)d_in[36]; p.odd_w_out = (const float*)d_in[37];
    p.out = (float*)d_out; p.ws = (unsigned char*)d_ws;
    const int grid = 256;
#if MK_ONE_LAUNCH
    p.ph_lo = 0; p.ph_hi = NPHASE;
    hipLaunchKernelGGL(hybrid_fwd<-1>, dim3(grid), dim3(NTHR), LDS_BYTES, stream, p);
#else
    p.ph_lo = 0; p.ph_hi = 1;
    launch_all(p, grid, stream);
#endif
}
```

```cpp
#include <hip/hip_runtime.h>
#include <cstdio>
#include <cstdint>

#ifndef PROBE_DUP_MASK
#define PROBE_DUP_MASK 0x0ull
#endif
#ifndef PROBE_ATT2
#define PROBE_ATT2 0
#endif
#ifndef PROBE_RT2
#define PROBE_RT2 0
#endif
#ifndef PROBE_TPH
#define PROBE_TPH -1
#endif
#ifndef PROBE_SEG
#define PROBE_SEG 0
#endif
#ifndef PROBE_CONV2
#define PROBE_CONV2 0
#endif
#ifndef PROBE_BAR2
#define PROBE_BAR2 0
#endif
#ifndef PROBE_EPI2
#define PROBE_EPI2 0
#endif
#ifndef PROBE_KX2
#define PROBE_KX2 0
#endif
#ifndef MK_ONE_LAUNCH
#define MK_ONE_LAUNCH 1
#endif

typedef unsigned short bf16_t;
typedef short bf16x8 __attribute__((ext_vector_type(8)));
typedef short s16x4 __attribute__((ext_vector_type(4)));
typedef float f32x4 __attribute__((ext_vector_type(4)));
typedef float f32x16 __attribute__((ext_vector_type(16)));
typedef unsigned u32x4 __attribute__((ext_vector_type(4)));
typedef unsigned u32x2 __attribute__((ext_vector_type(2)));

constexpr int D = 1024, NB = 8, S = 4096, T = NB * S;
constexpr int NTHR = 512, NWAVE = 8;
constexpr int MOE_ROWS = 139264;
constexpr int NPHASE = 21;

constexpr size_t MiB = 1u << 20;
constexpr size_t WS_CTL = 0, CTL_ZERO_BYTES = 1 * MiB;
constexpr size_t WS_MOD = 1 * MiB;
constexpr size_t WS_S5AB = 2 * MiB;
constexpr size_t WS_PW = 3 * MiB;
constexpr size_t WS_KTAB = 5 * MiB;
constexpr size_t WS_TOK = 7 * MiB;
constexpr size_t WS_ROW = 9 * MiB;
constexpr size_t WS_LOGIT = 11 * MiB;
constexpr size_t WS_W_IN_E = 16 * MiB, WS_W_UP = 18 * MiB  , WS_W_GLU = 20 * MiB, WS_W_OUT_E = 21 * MiB, WS_W_IN_O = 23 * MiB,
                 WS_W_OUT_O = 26 * MiB, WS_W_POOL = 28 * MiB, WS_W_SGU = 29 * MiB, WS_W_RT = 30 * MiB;
constexpr size_t WS_BT_END = 32 * MiB;
constexpr size_t WS_BT_MAIN = 40 * MiB;
constexpr size_t WS_W_GU = 112 * MiB;
constexpr size_t WS_W_DN = 240 * MiB;
constexpr size_t WS_HB8 = 304 * MiB;
constexpr size_t WS_XR = 336 * MiB;
constexpr size_t WS_HB = 496 * MiB;
constexpr size_t WS_MIXIN = 560 * MiB;
constexpr size_t WS_Y = 624 * MiB;
constexpr size_t WS_EL = 880 * MiB;
constexpr size_t WS_ACT = 1152 * MiB;
constexpr size_t WS_END = 1424 * MiB;
constexpr size_t WS_Z = 880 * MiB;
constexpr size_t WS_RSP = 976 * MiB  , WS_QKVRAW = 1000 * MiB  , WS_Q = 1112 * MiB, WS_K = 1160 * MiB, WS_VT = 1208 * MiB,
                 WS_AS5 = 1240 * MiB, WS_LEND = 1276 * MiB, WS_GACT = 1284 * MiB;
constexpr size_t WS_POOLED = 976 * MiB, WS_VTS = 1008 * MiB;
constexpr int CW_BAR = 4096, CW_CNT = 16384, CW_Q = 16640  ;

constexpr int LDS_BYTES = 160 * 1024;
constexpr int LDS_CTX_OFF = 18432;
constexpr int LDS_MISC = 158 * 1024;

struct Params {
    const float *x, *c; const int* pos;
    const float *ada_w, *ada_b, *norm_mix_g, *norm_ffn_g, *router_w, *router_b, *moe_w_gu, *moe_b_gu, *moe_w_dn, *moe_b_dn;
    const float *even_w_in, *q_norm_g, *w_uq, *kv_norm_g, *w_ukv, *q_head_g, *k_head_g;
    const float *s5_a_re, *s5_a_im, *s5_log_dt, *s5_b_re, *s5_b_im, *s5_c_re, *s5_c_im, *s5_d, *s5_glu_w, *s5_glu_b, *even_w_out;
    const float *odd_w_in, *pool_w, *pool_scale, *sgu_norm_g, *sgu_w, *sgu_b, *odd_w_out;
    float* out; unsigned char* ws; int ph_lo, ph_hi;
};

__device__ __forceinline__ float bf2f(unsigned short b) { return __uint_as_float(((unsigned)b) << 16); }
__device__ __forceinline__ unsigned pk2(float lo, float hi) {
    typedef float f2 __attribute__((ext_vector_type(2))); typedef __bf16 b2 __attribute__((ext_vector_type(2)));
    f2 v = {lo, hi}; b2 b = __builtin_convertvector(v, b2); return __builtin_bit_cast(unsigned, b);
}
__device__ __forceinline__ unsigned short f2bf(float f) { return (unsigned short)(pk2(f, 0.f) & 0xffffu); }
__device__ __forceinline__ float wave_sum(float v) {
#pragma unroll
    for (int o = 1; o < 64; o <<= 1) v += __shfl_xor(v, o);
    return v;
}
__device__ __forceinline__ float sigmoidf_(float x) { return __builtin_amdgcn_rcpf(1.0f + __builtin_amdgcn_exp2f(-1.4426950408889634f * x)); }
__device__ __forceinline__ float gelu_tanh(float x) {
    const float u = 0.7978845608028654f * (x + 0.044715f * x * x * x);
    return x * sigmoidf_(2.0f * u);
}
__device__ __forceinline__ unsigned pk4_fp8(float a, float b, float c, float d) {
    int w = 0; w = __builtin_amdgcn_cvt_pk_fp8_f32(a, b, w, false); w = __builtin_amdgcn_cvt_pk_fp8_f32(c, d, w, true); return (unsigned)w;
}
__device__ __forceinline__ int crow(int r, int hi) { return (r & 3) + 8 * (r >> 2) + 4 * hi; }

#define LAS __attribute__((address_space(3)))
#define XB_TMO      128
#define XB_XCNT(j)  (256  + 64 * (j))
#define XB_XSUB(j)  (1280 + 64 * (j))
#define XB_XGEN(j)  (2304 + 64 * (j))
#define XB_TOP      3328
#define XB_TOPGEN   3392
#define XCD_BAR_WORDS 3456
#define XB_SPIN_CAP (1u << 20)
__device__ __forceinline__ unsigned xb_ld(unsigned* p)              { return __hip_atomic_load(p, __ATOMIC_RELAXED, __HIP_MEMORY_SCOPE_AGENT); }
__device__ __forceinline__ unsigned xb_add(unsigned* p, unsigned v) { return __hip_atomic_fetch_add(p, v, __ATOMIC_RELAXED, __HIP_MEMORY_SCOPE_AGENT); }
__device__ __forceinline__ unsigned xb_xcc_id() { return (unsigned)__builtin_amdgcn_s_getreg((3 << 11) | 20) & 0xFu; }
#define XB_SPIN(cond, bar) do { unsigned _sp = 0; while (cond) { __builtin_amdgcn_s_sleep(1); \
    if ((++_sp & 255u) == 0u) { if (xb_ld(&(bar)[XB_TMO])) break; if (_sp > XB_SPIN_CAP) { atomicAdd(&(bar)[XB_TMO], 1u); break; } } } } while (0)
struct XcdBarrier { unsigned* bar; unsigned x; volatile LAS unsigned* st; int wbase; };
__device__ __forceinline__ int lane_id() { int l; asm volatile("v_mbcnt_lo_u32_b32 %0, -1, 0\n\tv_mbcnt_hi_u32_b32 %0, -1, %0" : "=v"(l)); return l; }
__device__ __forceinline__ XcdBarrier xcd_barrier_post(unsigned* bar, volatile LAS unsigned* st) {
    XcdBarrier b; b.bar = bar; b.x = xb_xcc_id(); b.st = st; b.wbase = __builtin_amdgcn_readfirstlane((int)threadIdx.x & ~63);
    if (threadIdx.x == 0) (void)xb_add(&bar[XB_XCNT(b.x)], 1u);
    return b;
}
__device__ __forceinline__ void xcd_barrier_complete(unsigned* bar, unsigned x, unsigned& nloc, unsigned& nx) {
    const unsigned G = gridDim.x * gridDim.y * gridDim.z;
    unsigned sum, cnt, mine, sp = 0u;
    for (;;) {
        sum = 0u; cnt = 0u; mine = 0u;
#pragma unroll
        for (unsigned j = 0; j < 16; ++j) { const unsigned c = xb_ld(&bar[XB_XCNT(j)]); sum += c; cnt += (c > 0u) ? 1u : 0u; mine = (j == x) ? c : mine; }
        if (sum == G) break;
        __builtin_amdgcn_s_sleep(1);
        if ((++sp & 255u) == 0u) { if (xb_ld(&bar[XB_TMO])) break; if (sp > XB_SPIN_CAP) { atomicAdd(&bar[XB_TMO], 1u); break; } }
    }
    nloc = mine > 0u ? mine : 1u; nx = cnt > 0u ? cnt : 1u;
}
__device__ __forceinline__ void xcd_barrier(const XcdBarrier& b) {
    asm volatile("s_waitcnt vmcnt(0)" ::: "memory");
    __syncthreads();
    if (b.wbase == 0 && lane_id() == 0) {
        unsigned* bar = b.bar;
        __builtin_amdgcn_s_waitcnt(0);
        unsigned nloc = b.st[0], nx = b.st[1];
        if (nloc == 0u) { xcd_barrier_complete(bar, b.x, nloc, nx); b.st[0] = nloc; b.st[1] = nx; }
        const unsigned old = xb_add(&bar[XB_XSUB(b.x)], 1u);
        const unsigned gen = old / nloc;
        if (old + 1u == (gen + 1u) * nloc) {
            __builtin_amdgcn_fence(__ATOMIC_RELEASE, "agent");
            asm volatile("s_waitcnt vmcnt(0)" ::: "memory");
            const unsigned og = xb_add(&bar[XB_TOP], 1u);
            const unsigned tg = og / nx;
            if (og + 1u == (tg + 1u) * nx) xb_add(&bar[XB_TOPGEN], 1u);
            else XB_SPIN(xb_ld(&bar[XB_TOPGEN]) == tg, bar);
            __builtin_amdgcn_fence(__ATOMIC_ACQUIRE, "agent");
            xb_add(&bar[XB_XGEN(b.x)], 1u);
            asm volatile("s_waitcnt vmcnt(0)" ::: "memory");
        } else {
            XB_SPIN(xb_ld(&bar[XB_XGEN(b.x)]) == gen, bar);
            __builtin_amdgcn_fence(__ATOMIC_ACQUIRE, "agent");
            asm volatile("s_waitcnt vmcnt(0)" ::: "memory");
        }
    }
    __syncthreads();
}

constexpr int SG_LDS = 2 * 128 * 144;
template <class Epi>
__device__ __forceinline__ void sg_tile(int tid, unsigned char* lds, const bf16_t* A, int lda, const bf16_t* Bt, int ldb, int K, Epi epi) {
    const int lane = tid & 63, wid = tid >> 6, wr = wid >> 2, wc = wid & 3, fr = lane & 15, fq = lane >> 4;
    unsigned char* As = lds; unsigned char* Bs = lds + 128 * 144;
    f32x4 acc[4][2];
#pragma unroll
    for (int m = 0; m < 4; ++m)
#pragma unroll
        for (int n = 0; n < 2; ++n) acc[m][n] = (f32x4){0.f, 0.f, 0.f, 0.f};
    const int nt = K / 64;
    u32x4 ra[2], rb[2];
    const int r0 = tid >> 3, cc = tid & 7;
#pragma unroll
    for (int i = 0; i < 2; ++i) {
        ra[i] = *(const u32x4*)(A + (size_t)(r0 + 64 * i) * lda + cc * 8);
        rb[i] = *(const u32x4*)(Bt + (size_t)(r0 + 64 * i) * ldb + cc * 8);
    }
    for (int kt = 0; kt < nt; ++kt) {
        __syncthreads();
#pragma unroll
        for (int i = 0; i < 2; ++i) {
            *(u32x4*)(As + (r0 + 64 * i) * 144 + cc * 16) = ra[i];
            *(u32x4*)(Bs + (r0 + 64 * i) * 144 + cc * 16) = rb[i];
        }
        __syncthreads();
        if (kt + 1 < nt) {
#pragma unroll
            for (int i = 0; i < 2; ++i) {
                ra[i] = *(const u32x4*)(A + (size_t)(r0 + 64 * i) * lda + (kt + 1) * 64 + cc * 8);
                rb[i] = *(const u32x4*)(Bt + (size_t)(r0 + 64 * i) * ldb + (kt + 1) * 64 + cc * 8);
            }
        }
#pragma unroll
        for (int kk = 0; kk < 2; ++kk) {
            bf16x8 a[4], b[2];
#pragma unroll
            for (int m = 0; m < 4; ++m) a[m] = *(const bf16x8*)(As + (wr * 64 + m * 16 + fr) * 144 + kk * 64 + fq * 16);
#pragma unroll
            for (int n = 0; n < 2; ++n) b[n] = *(const bf16x8*)(Bs + (wc * 32 + n * 16 + fr) * 144 + kk * 64 + fq * 16);
#pragma unroll
            for (int m = 0; m < 4; ++m)
#pragma unroll
                for (int n = 0; n < 2; ++n) acc[m][n] = __builtin_amdgcn_mfma_f32_16x16x32_bf16(b[n], a[m], acc[m][n], 0, 0, 0);
        }
    }
#pragma unroll
    for (int m = 0; m < 4; ++m) epi(wr * 64 + m * 16 + fr, wc * 32 + fq * 4, acc[m][0], acc[m][1]);
}


struct Sg128Side { u32x2 a[4][2]; float b[4]; };
template <class Ptrs, class SideF, class Epi>
__device__ __forceinline__ void sg128_stream(int tid, unsigned char* lds, int u0, int ustride, int uend, Ptrs ptrs, SideF side, Epi epi) {
    const int lane = tid & 63, wid = tid >> 6, wr = wid >> 2, wc = wid & 3, fr = lane & 15, fq = lane >> 4;
    unsigned char* As = lds; unsigned char* Bs = lds + 128 * 272;
    u32x4 ra[4], rb[4]; Sg128Side sc;
    const int r0 = tid >> 4, cc = tid & 15;
    auto load = [&](int u) { const bf16_t* A; const bf16_t* Bt; int lda, ldb; ptrs(u, A, lda, Bt, ldb);
#pragma unroll
        for (int i = 0; i < 4; ++i) { ra[i] = *(const u32x4*)(A + (size_t)(r0 + 32 * i) * lda + cc * 8); rb[i] = *(const u32x4*)(Bt + (size_t)(r0 + 32 * i) * ldb + cc * 8); }
        };
    if (u0 < uend) load(u0);
    for (int u = u0; u < uend; u += ustride) {
        __syncthreads();
#pragma unroll
        for (int i = 0; i < 4; ++i) { *(u32x4*)(As + (r0 + 32 * i) * 272 + cc * 16) = ra[i]; *(u32x4*)(Bs + (r0 + 32 * i) * 272 + cc * 16) = rb[i]; }
        side(u, wr * 64 + fr, wc * 32 + fq * 4, sc);
        __syncthreads();
        if (u + ustride < uend) load(u + ustride);
        f32x4 acc[4][2];
#pragma unroll
        for (int m = 0; m < 4; ++m)
#pragma unroll
            for (int n = 0; n < 2; ++n) acc[m][n] = (f32x4){0.f, 0.f, 0.f, 0.f};
#pragma unroll 1
        for (int kk = 0; kk < 4; ++kk) {
            bf16x8 a[4], b[2];
#pragma unroll
            for (int m = 0; m < 4; ++m) a[m] = *(const bf16x8*)(As + (wr * 64 + m * 16 + fr) * 272 + kk * 64 + fq * 16);
#pragma unroll
            for (int n = 0; n < 2; ++n) b[n] = *(const bf16x8*)(Bs + (wc * 32 + n * 16 + fr) * 272 + kk * 64 + fq * 16);
#pragma unroll
            for (int m = 0; m < 4; ++m)
#pragma unroll
                for (int n = 0; n < 2; ++n) acc[m][n] = __builtin_amdgcn_mfma_f32_16x16x32_bf16(b[n], a[m], acc[m][n], 0, 0, 0);
        }
#pragma unroll
        for (int m = 0; m < 4; ++m) epi(u, m, wr * 64 + m * 16 + fr, wc * 32 + fq * 4, acc[m][0], acc[m][1], sc);
    }
}

namespace pg8 {
#define PG8_LAS __attribute__((address_space(3)))
constexpr int BM = 256, BK = 64, HALF = 128, HTB = HALF * BK * 2, STAGE_BYTES = 8 * HTB;
__device__ __forceinline__ int lds_byte(int r, int c) { const int st = (r >> 4) * 2 + (c >> 5), rr = r & 15, cc = c & 31, ob = rr * 64 + cc * 2; return st * 1024 + (ob ^ (((ob >> 9) & 1) << 5)); }
__device__ __forceinline__ void stage_rc(int b, int& R, int& C) { const int st = b / 1024, sb = b % 1024, swz = sb ^ (((sb >> 9) & 1) << 5); R = (st >> 1) * 16 + swz / 64; C = (st & 1) * 32 + (swz % 64) / 2; }
typedef int v8i_t __attribute__((ext_vector_type(8)));
typedef int v4i_t __attribute__((ext_vector_type(4)));
struct FragT { union { v8i_t v; struct { v4i_t lo, hi; }; }; };
struct Unit { int pm, pb, pn, aux; };
struct Gemm { const bf16_t* A; const bf16_t* Bt; int lda, ldb, K; };
struct NoCtx {};
struct NoPre { __device__ __forceinline__ NoCtx operator()(const Unit&, int, int, int, int, const PG8_LAS unsigned char*) const { return NoCtx{}; } };
struct NoStage { __device__ __forceinline__ void operator()(const Unit&, PG8_LAS unsigned char*, int, int) const {} };
template <class PF, class F> struct Epi {
    PF pre; F f;
    template <class Ctx>
    __device__ __forceinline__ void operator()(const f32x4 (&acc)[2][2][4][2], const Ctx& ctx, const Unit& u, int wr, int wc, int fr, int fq, PG8_LAS unsigned char*, int) const {
#pragma unroll
        for (int ai = 0; ai < 2; ++ai)
#pragma unroll
            for (int m = 0; m < 4; ++m)
#pragma unroll
                for (int bj = 0; bj < 2; ++bj) {
                    f32x4 v0, v1;
                    asm volatile("v_accvgpr_read_b32 %0, %8\n\tv_accvgpr_read_b32 %1, %9\n\tv_accvgpr_read_b32 %2, %10\n\tv_accvgpr_read_b32 %3, %11\n\t"
                                 "v_accvgpr_read_b32 %4, %12\n\tv_accvgpr_read_b32 %5, %13\n\tv_accvgpr_read_b32 %6, %14\n\tv_accvgpr_read_b32 %7, %15"
                                 : "=v"(v0.x), "=v"(v0.y), "=v"(v0.z), "=v"(v0.w), "=v"(v1.x), "=v"(v1.y), "=v"(v1.z), "=v"(v1.w)
                                 : "a"(acc[ai][bj][m][0].x), "a"(acc[ai][bj][m][0].y), "a"(acc[ai][bj][m][0].z), "a"(acc[ai][bj][m][0].w),
                                   "a"(acc[ai][bj][m][1].x), "a"(acc[ai][bj][m][1].y), "a"(acc[ai][bj][m][1].z), "a"(acc[ai][bj][m][1].w));
                    f(u, ctx, ai, m, bj, ai * HALF + wr * 64 + m * 16 + fr, bj * HALF + wc * 32 + 4 * fq, v0, v1);
                }
    }
};
template <class PF, class F> __device__ __forceinline__ Epi<PF, F> make_epi(PF p, F f) { return Epi<PF, F>{p, f}; }
template <class PF, class F> struct EpiPerm {
    PF pre; F f;
    template <class Ctx>
    __device__ __forceinline__ void operator()(const f32x4 (&acc)[2][2][4][2], const Ctx& ctx, const Unit& u, int wr, int wc, int fr, int fq, PG8_LAS unsigned char*, int) const {
#pragma unroll
        for (int ai = 0; ai < 2; ++ai)
#pragma unroll
            for (int m = 0; m < 4; ++m)
#pragma unroll
                for (int bj = 0; bj < 2; ++bj) {
                    f32x4 v0, v1;
                    asm volatile("v_accvgpr_read_b32 %0, %8\n\tv_accvgpr_read_b32 %1, %9\n\tv_accvgpr_read_b32 %2, %10\n\tv_accvgpr_read_b32 %3, %11\n\t"
                                 "v_accvgpr_read_b32 %4, %12\n\tv_accvgpr_read_b32 %5, %13\n\tv_accvgpr_read_b32 %6, %14\n\tv_accvgpr_read_b32 %7, %15"
                                 : "=v"(v0.x), "=v"(v0.y), "=v"(v0.z), "=v"(v0.w), "=v"(v1.x), "=v"(v1.y), "=v"(v1.z), "=v"(v1.w)
                                 : "a"(acc[ai][bj][m][0].x), "a"(acc[ai][bj][m][0].y), "a"(acc[ai][bj][m][0].z), "a"(acc[ai][bj][m][0].w),
                                   "a"(acc[ai][bj][m][1].x), "a"(acc[ai][bj][m][1].y), "a"(acc[ai][bj][m][1].z), "a"(acc[ai][bj][m][1].w));
                    f(u, ctx, ai, m, bj, ai * HALF + wr * 64 + m * 16 + fr, bj * HALF + wc * 32 + 8 * fq, v0, v1);
                }
    }
};
template <class PF, class F> __device__ __forceinline__ EpiPerm<PF, F> make_epi_perm(PF p, F f) { return EpiPerm<PF, F>{p, f}; }
template <bool PERMC, class PF, class F, class RE> struct EpiRow {
    PF pre; F f; RE re;
    template <class Ctx>
    __device__ __forceinline__ void operator()(const f32x4 (&acc)[2][2][4][2], const Ctx& ctx, const Unit& u, int wr, int wc, int fr, int fq, PG8_LAS unsigned char*, int) const {
#pragma unroll
        for (int ai = 0; ai < 2; ++ai)
#pragma unroll
            for (int m = 0; m < 4; ++m) {
                float part = 0.f;
#pragma unroll
                for (int bj = 0; bj < 2; ++bj) {
                    f32x4 v0, v1;
                    asm volatile("v_accvgpr_read_b32 %0, %8\n\tv_accvgpr_read_b32 %1, %9\n\tv_accvgpr_read_b32 %2, %10\n\tv_accvgpr_read_b32 %3, %11\n\t"
                                 "v_accvgpr_read_b32 %4, %12\n\tv_accvgpr_read_b32 %5, %13\n\tv_accvgpr_read_b32 %6, %14\n\tv_accvgpr_read_b32 %7, %15"
                                 : "=v"(v0.x), "=v"(v0.y), "=v"(v0.z), "=v"(v0.w), "=v"(v1.x), "=v"(v1.y), "=v"(v1.z), "=v"(v1.w)
                                 : "a"(acc[ai][bj][m][0].x), "a"(acc[ai][bj][m][0].y), "a"(acc[ai][bj][m][0].z), "a"(acc[ai][bj][m][0].w),
                                   "a"(acc[ai][bj][m][1].x), "a"(acc[ai][bj][m][1].y), "a"(acc[ai][bj][m][1].z), "a"(acc[ai][bj][m][1].w));
                    part += f(u, ctx, ai, m, bj, ai * HALF + wr * 64 + m * 16 + fr, bj * HALF + wc * 32 + (PERMC ? 8 : 4) * fq, v0, v1);
                }
                re(u, ai, m, ai * HALF + wr * 64 + m * 16 + fr, wc, fq, part);
            }
    }
};
template <bool PERMC, class PF, class F, class RE> __device__ __forceinline__ EpiRow<PERMC, PF, F, RE> make_epi_row(PF p, F f, RE r) { return EpiRow<PERMC, PF, F, RE>{p, f, r}; }
template <class PF, class GP, class F> struct EpiG {
    PF pre; GP gp; F f;
    template <class Ctx>
    __device__ __forceinline__ void operator()(const f32x4 (&acc)[2][2][4][2], const Ctx& ctx, const Unit& u, int wr, int wc, int fr, int fq, PG8_LAS unsigned char*, int) const {
        auto gcur = gp(u, ctx, wr * 64 + fr, wc, fq);
#pragma unroll
        for (int ai = 0; ai < 2; ++ai)
#pragma unroll
            for (int m = 0; m < 4; ++m) {
                const int gn = ai * 4 + m + 1;
                auto gnxt = gcur;
                if (gn < 8) gnxt = gp(u, ctx, (gn >> 2) * HALF + wr * 64 + (gn & 3) * 16 + fr, wc, fq);
#pragma unroll
                for (int bj = 0; bj < 2; ++bj) {
                    f32x4 v0, v1;
                    asm volatile("v_accvgpr_read_b32 %0, %8\n\tv_accvgpr_read_b32 %1, %9\n\tv_accvgpr_read_b32 %2, %10\n\tv_accvgpr_read_b32 %3, %11\n\t"
                                 "v_accvgpr_read_b32 %4, %12\n\tv_accvgpr_read_b32 %5, %13\n\tv_accvgpr_read_b32 %6, %14\n\tv_accvgpr_read_b32 %7, %15"
                                 : "=v"(v0.x), "=v"(v0.y), "=v"(v0.z), "=v"(v0.w), "=v"(v1.x), "=v"(v1.y), "=v"(v1.z), "=v"(v1.w)
                                 : "a"(acc[ai][bj][m][0].x), "a"(acc[ai][bj][m][0].y), "a"(acc[ai][bj][m][0].z), "a"(acc[ai][bj][m][0].w),
                                   "a"(acc[ai][bj][m][1].x), "a"(acc[ai][bj][m][1].y), "a"(acc[ai][bj][m][1].z), "a"(acc[ai][bj][m][1].w));
                    f(u, ctx, gcur, ai, m, bj, ai * HALF + wr * 64 + m * 16 + fr, bj * HALF + wc * 32 + 4 * fq, v0, v1);
                }
                gcur = gnxt;
            }
    }
};
template <class PF, class GP, class F> __device__ __forceinline__ EpiG<PF, GP, F> make_epi_g(PF p, GP g, F f) { return EpiG<PF, GP, F>{p, g, f}; }
template <int MG, int TILE_BYTES, class PF, class F, class FL> struct EpiStaged {
    PF pre; F f; FL flush;
    template <class Ctx>
    __device__ __forceinline__ void operator()(const f32x4 (&acc)[2][2][4][2], const Ctx& ctx, const Unit& u, int wr, int wc, int fr, int fq, PG8_LAS unsigned char* tile, int tid) const {
#pragma unroll
        for (int ai = 0; ai < 2; ++ai)
#pragma unroll
            for (int m = 0; m < 4; ++m) {
#pragma unroll
                for (int bj = 0; bj < 2; ++bj) {
                    f32x4 v0, v1;
                    asm volatile("v_accvgpr_read_b32 %0, %8\n\tv_accvgpr_read_b32 %1, %9\n\tv_accvgpr_read_b32 %2, %10\n\tv_accvgpr_read_b32 %3, %11\n\t"
                                 "v_accvgpr_read_b32 %4, %12\n\tv_accvgpr_read_b32 %5, %13\n\tv_accvgpr_read_b32 %6, %14\n\tv_accvgpr_read_b32 %7, %15"
                                 : "=v"(v0.x), "=v"(v0.y), "=v"(v0.z), "=v"(v0.w), "=v"(v1.x), "=v"(v1.y), "=v"(v1.z), "=v"(v1.w)
                                 : "a"(acc[ai][bj][m][0].x), "a"(acc[ai][bj][m][0].y), "a"(acc[ai][bj][m][0].z), "a"(acc[ai][bj][m][0].w),
                                   "a"(acc[ai][bj][m][1].x), "a"(acc[ai][bj][m][1].y), "a"(acc[ai][bj][m][1].z), "a"(acc[ai][bj][m][1].w));
                    f(u, ctx, ai, m, bj, (m % MG) * 32 + wr * 16 + fr, bj * HALF + wc * 32 + 4 * fq, v0, v1, tile + (((ai * 4 + m) / MG) & 1) * TILE_BYTES);
                }
                if ((m % MG) == MG - 1) {
                    asm volatile("s_waitcnt lgkmcnt(0)" ::: "memory"); __builtin_amdgcn_s_barrier(); asm volatile("" ::: "memory");
                    flush(u, ctx, ai, m - (MG - 1), tid, tile + (((ai * 4 + m) / MG) & 1) * TILE_BYTES);
                }
            }
    }
};
template <int MG, int TILE_BYTES, class PF, class F, class FL> __device__ __forceinline__ EpiStaged<MG, TILE_BYTES, PF, F, FL> make_epi_staged(PF p, F f, FL fl) { return EpiStaged<MG, TILE_BYTES, PF, F, FL>{p, f, fl}; }
__host__ __device__ __forceinline__ int perm32(int rho) { const int n = rho >> 4, i = rho & 15; return 8 * (i >> 2) + 4 * n + (i & 3); }
template <bool FP8 = false, bool GATHER = false, bool PERM = false, class EpiT, class Sched, class StageT = NoStage>
__device__ __forceinline__ void gemm_phase(int tid, PG8_LAS unsigned char* lds, const Gemm g, const Sched& S, const EpiT& E, const StageT& SC = NoStage{}, int ctx_off = 0) {
    const int wid = __builtin_amdgcn_readfirstlane(tid >> 6), lane = tid & 63, wr = wid >> 2, wc = wid & 3, fr = lane & 15, fq = lane >> 4;
    int K = g.K; asm volatile("" : "+s"(K));
    const int nt = K / BK;
    unsigned voffA[2], voffB[2];
    int Rl[2], Cl[2];
#pragma unroll
    for (int i = 0; i < 2; ++i) { int R, C; stage_rc(tid * 16 + i * 8192, R, C); Rl[i] = R; Cl[i] = C; voffA[i] = (unsigned)(R * g.lda + C) * 2u; const int Rb = PERM ? ((R & ~31) + perm32(R & 31)) : R; voffB[i] = (unsigned)(Rb * g.ldb + C) * 2u; }
    unsigned gA00 = 0, gA01 = 0, gA10 = 0, gA11 = 0, gN00 = 0, gN01 = 0, gN10 = 0, gN11 = 0;
    const size_t kstep = (size_t)(BK * 2);
    const size_t hstepA = (size_t)HALF * g.lda * 2, hstepB = (size_t)HALF * g.ldb * 2;
    const size_t tstepA = 2 * hstepA, tstepB = 2 * hstepB;
    const unsigned ldsw = (unsigned)wid * 1024u;
    const int aoff = lds_byte(wr * 64 + fr, fq * 8), boff = lds_byte(wc * 32 + fr, fq * 8);
#define PG8_SA(b, h) (((b) * 2 + (h)) * HTB)
#define PG8_SB(b, h) ((4 + (b) * 2 + (h)) * HTB)
#define PG8_STAGE(bufoff, gbase, voff) do { _Pragma("unroll") for (int _i = 0; _i < 2; ++_i) \
        __builtin_amdgcn_global_load_lds((const unsigned*)((const char*)(gbase) + (voff)[_i]), (PG8_LAS unsigned*)(lds + (bufoff) + ldsw + _i * 8192), 16, 0, 0); } while (0)
#define PG8_LDA(dst, b, h) do { _Pragma("unroll") for (int m = 0; m < 4; ++m) { dst[m].lo = *(const PG8_LAS v4i_t*)(lds + PG8_SA(b, h) + aoff + m * 2048); dst[m].hi = *(const PG8_LAS v4i_t*)(lds + PG8_SA(b, h) + aoff + m * 2048 + 1024); } } while (0)
#define PG8_LDB(dst, b, h) do { _Pragma("unroll") for (int n = 0; n < 2; ++n) { dst[n].lo = *(const PG8_LAS v4i_t*)(lds + PG8_SB(b, h) + boff + n * 2048); dst[n].hi = *(const PG8_LAS v4i_t*)(lds + PG8_SB(b, h) + boff + n * 2048 + 1024); } } while (0)
#define PG8_MMA(ai, bj, At, Bt) do { __builtin_amdgcn_s_setprio(1); asm volatile("s_nop 1" ::: "memory");     \
        _Pragma("unroll") for (int m = 0; m < 4; ++m) _Pragma("unroll") for (int n = 0; n < 2; ++n) { \
        if constexpr (FP8) { asm volatile("v_mfma_scale_f32_16x16x128_f8f6f4 %0, %1, %2, %0, %3, %4 op_sel_hi:[0,0,0]" : "+a"(acc[ai][bj][m][n]) : "v"(Bt[n].v), "v"(At[m].v), "v"(scw), "v"(scx)); } \
        else { asm volatile("v_mfma_f32_16x16x32_bf16 %0, %1, %2, %0\n\tv_mfma_f32_16x16x32_bf16 %0, %3, %4, %0" : "+a"(acc[ai][bj][m][n]) : "v"(Bt[n].lo), "v"(At[m].lo), "v"(Bt[n].hi), "v"(At[m].hi)); } } \
        __builtin_amdgcn_s_setprio(0); } while (0)
#define PG8_WAIT_V(n) asm volatile("s_waitcnt vmcnt(" #n ")" ::: "memory")
#define PG8_WAIT_L(n) asm volatile("s_waitcnt lgkmcnt(" #n ")" ::: "memory")
#define PG8_BAR __builtin_amdgcn_s_barrier()
#define PG8_SCHED __builtin_amdgcn_sched_barrier(0)
    Unit cur, nxt; int ui = 0;
    if (!S.next(0, cur)) return;
    f32x4 acc[2][2][4][2];
#pragma unroll
    for (int a = 0; a < 2; ++a)
#pragma unroll
        for (int b = 0; b < 2; ++b)
#pragma unroll
            for (int m = 0; m < 4; ++m)
#pragma unroll
                for (int n = 0; n < 2; ++n) acc[a][b][m][n] = (f32x4){0.f, 0.f, 0.f, 0.f};
    FragT At[4], B0[2], B1[2];
    int scw = (FP8 && PROBE_KX2) ? 0x79797979 : 0x7a7a7a7a, scx = 0x7f7f7f7f; asm volatile("" : "+v"(scw), "+v"(scx));
    const char* cA = GATHER ? (const char*)g.A : (const char*)g.A + (size_t)cur.pm * tstepA; const char* cB = (const char*)g.Bt + (size_t)cur.pb * tstepB;
    SC(cur, lds + STAGE_BYTES + ctx_off, wid, lane);
    const int R0 = Rl[0], R1 = Rl[1]; const unsigned C0 = (unsigned)Cl[0] * 2u, C1 = (unsigned)Cl[1] * 2u;
    if constexpr (GATHER) { gA00 = S.a_off(cur, R0) + C0; gA01 = S.a_off(cur, R1) + C1; gA10 = S.a_off(cur, HALF + R0) + C0; gA11 = S.a_off(cur, HALF + R1) + C1; }
#define PG8_STAGE_A(bufoff, koff, O0, O1, dense_ptr) do { if constexpr (GATHER) { \
        __builtin_amdgcn_global_load_lds((const unsigned*)((const char*)g.A + (koff) + (O0)), (PG8_LAS unsigned*)(lds + (bufoff) + ldsw), 16, 0, 0); \
        __builtin_amdgcn_global_load_lds((const unsigned*)((const char*)g.A + (koff) + (O1)), (PG8_LAS unsigned*)(lds + (bufoff) + ldsw + 8192), 16, 0, 0); \
    } else { PG8_STAGE(bufoff, dense_ptr, voffA); } } while (0)
    PG8_STAGE(PG8_SB(0, 0), cB, voffB); PG8_STAGE(PG8_SB(0, 1), cB + hstepB, voffB); PG8_STAGE_A(PG8_SA(0, 0), 0, gA00, gA01, cA); PG8_STAGE_A(PG8_SA(0, 1), 0, gA10, gA11, cA + hstepA);
    if (wr == 1) PG8_BAR;
    PG8_WAIT_V(2); PG8_BAR;
    PG8_STAGE(PG8_SB(1, 0), cB + kstep, voffB); PG8_STAGE_A(PG8_SA(1, 0), kstep, gA00, gA01, cA + kstep); PG8_STAGE(PG8_SB(1, 1), cB + hstepB + kstep, voffB);
    PG8_WAIT_V(6); PG8_BAR;
    for (;;) {
        const bool has_next = S.next(ui + 1, nxt);
        const char* nA = GATHER ? cA : (has_next ? (const char*)g.A + (size_t)nxt.pm * tstepA : cA); const char* nB = has_next ? (const char*)g.Bt + (size_t)nxt.pb * tstepB : cB;
        if (has_next) SC(nxt, lds + STAGE_BYTES + ctx_off + ((ui + 1) % 3) * 4096, wid, lane);
        if constexpr (GATHER) {
            if (has_next) { gN00 = S.a_off(nxt, R0) + C0; gN01 = S.a_off(nxt, R1) + C1; gN10 = S.a_off(nxt, HALF + R0) + C0; gN11 = S.a_off(nxt, HALF + R1) + C1; }
            else { gN00 = gA00; gN01 = gA01; gN10 = gA10; gN11 = gA11; }
        }
        constexpr int KX = (FP8 && PROBE_KX2) ? 2 : 1;
        for (int t = 0; t < KX * nt; t += 2) {
            const bool last = (t == KX * nt - 2);
            const char* a1 = cA + (size_t)((t + 1) % nt) * kstep;
            const char* a2 = last ? nA : cA + (size_t)((t + 2) % nt) * kstep; const char* b2 = last ? nB : cB + (size_t)((t + 2) % nt) * kstep;
            const char* a3 = a2 + kstep; const char* b3 = b2 + kstep;
            const size_t k1 = (size_t)((t + 1) % nt) * kstep, k2 = last ? 0 : (size_t)((t + 2) % nt) * kstep;
            const unsigned gT00 = last ? gN00 : gA00, gT01 = last ? gN01 : gA01, gT10 = last ? gN10 : gA10, gT11 = last ? gN11 : gA11;
            PG8_LDB(B0, 0, 0); PG8_LDB(B1, 0, 1); PG8_SCHED; PG8_LDA(At, 0, 0); PG8_STAGE_A(PG8_SA(1, 1), k1, gA10, gA11, a1 + hstepA);
            PG8_WAIT_V(8); PG8_WAIT_L(0); PG8_BAR; PG8_MMA(0, 0, At, B0); PG8_MMA(0, 1, At, B1); PG8_BAR; PG8_SCHED;
            PG8_LDA(At, 0, 1); PG8_STAGE(PG8_SB(0, 0), b2, voffB); PG8_STAGE(PG8_SB(0, 1), b2 + hstepB, voffB); PG8_STAGE_A(PG8_SA(0, 0), k2, gT00, gT01, a2);
            PG8_WAIT_V(8); PG8_WAIT_L(0); PG8_BAR; PG8_MMA(1, 0, At, B0); PG8_MMA(1, 1, At, B1); PG8_BAR; PG8_SCHED;
            PG8_LDB(B0, 1, 0); PG8_LDB(B1, 1, 1); PG8_SCHED; PG8_LDA(At, 1, 0); PG8_STAGE_A(PG8_SA(0, 1), k2, gT10, gT11, a2 + hstepA);
            PG8_WAIT_V(8); PG8_WAIT_L(0); PG8_BAR; PG8_MMA(0, 0, At, B0); PG8_MMA(0, 1, At, B1); PG8_BAR; PG8_SCHED;
            PG8_LDA(At, 1, 1); PG8_STAGE(PG8_SB(1, 0), b3, voffB); PG8_STAGE(PG8_SB(1, 1), b3 + hstepB, voffB); PG8_STAGE_A(PG8_SA(1, 0), k2 + kstep, gT00, gT01, a3);
            PG8_WAIT_V(8); PG8_WAIT_L(0); PG8_BAR; PG8_MMA(1, 0, At, B0); PG8_MMA(1, 1, At, B1); PG8_BAR; PG8_SCHED;
        }
        unsigned long long tp0_ = 0; if constexpr (PROBE_SEG != 0 && PROBE_SEG == (FP8 ? (GATHER ? 2 : 1) : 3)) tp0_ = __builtin_amdgcn_s_memrealtime();
        const auto ectx = E.pre(cur, wr, wc, fr, fq, lds + STAGE_BYTES + ctx_off + (ui % 3) * 4096);
        if (wr == 0) PG8_BAR;
        asm volatile("s_nop 15\n\ts_nop 15" ::: "memory");
        E(acc, ectx, cur, wr, wc, fr, fq, lds + STAGE_BYTES, tid);
        if constexpr (FP8 && PROBE_EPI2) { asm volatile("" ::: "memory"); E(acc, ectx, cur, wr, wc, fr, fq, lds + STAGE_BYTES, tid); }
        if constexpr (PROBE_SEG != 0 && PROBE_SEG == (FP8 ? (GATHER ? 2 : 1) : 3)) { if (tid == 0) { PG8_LAS unsigned* acc_t = (PG8_LAS unsigned*)(lds + LDS_MISC + 48); *acc_t += (unsigned)(__builtin_amdgcn_s_memrealtime() - tp0_); } }
        if (!has_next) break;
#pragma unroll
        for (int a = 0; a < 2; ++a)
#pragma unroll
            for (int b = 0; b < 2; ++b)
#pragma unroll
                for (int m = 0; m < 4; ++m)
#pragma unroll
                    for (int n = 0; n < 2; ++n) acc[a][b][m][n] = (f32x4){0.f, 0.f, 0.f, 0.f};
        cur = nxt; cA = nA; cB = nB; ++ui;
        if constexpr (GATHER) { gA00 = gN00; gA01 = gN01; gA10 = gN10; gA11 = gN11; }
        if (wr == 1) PG8_BAR;
    }
    PG8_WAIT_V(0);
    PG8_BAR;
#undef PG8_SA
#undef PG8_SB
#undef PG8_STAGE
#undef PG8_STAGE_A
#undef PG8_LDA
#undef PG8_LDB
#undef PG8_MMA
#undef PG8_WAIT_V
#undef PG8_WAIT_L
#undef PG8_BAR
#undef PG8_SCHED
}
struct GridOrder {
    int nM, nN, nwg, G, c;
    __device__ __forceinline__ void init(int nM_, int nN_, int G_, int c_) { nM = nM_; nN = nN_; nwg = nM * nN; G = G_; c = c_; }
    __device__ __forceinline__ bool tile(int i, int& pm, int& pn) const {
        const long L = (long)i * G + c; if (L >= nwg) return false;
        int wgid = (int)L; { const int q = nwg / 8, r = nwg % 8, xcd = wgid % 8, off = wgid / 8; wgid = (xcd < r ? xcd * (q + 1) : r * (q + 1) + (xcd - r) * q) + off; }
        const int nig = 8 * nN, gid = wgid / nig, fm = gid * 8, gsz = (nM - fm) < 8 ? (nM - fm) : 8;
        pm = fm + ((wgid % nig) % gsz); pn = (wgid % nig) / gsz; return true;
    }
};
}


struct DenseOrder { pg8::GridOrder go;
    __device__ __forceinline__ bool next(int i, pg8::Unit& u) const { int pm, pn; if (!go.tile(i, pm, pn)) return false; u.pm = pm; u.pb = pn; u.pn = pn; u.aux = 0; return true; } };
struct MoeOrder { pg8::GridOrder go; const int* pst; const int* el_slot; int NT, ebase;
    __device__ __forceinline__ unsigned a_off(const pg8::Unit& u, int R) const { const int ro = u.pm * 256 - pst[u.aux] + R; const int tok = (ro < pst[64 + u.aux]) ? (el_slot[(size_t)u.aux * T + ro] >> 2) : 0; return (unsigned)tok * 1024u; }
    __device__ __forceinline__ bool next(int i, pg8::Unit& u) const { int pm, pn; if (!go.tile(i, pm, pn)) return false; int e = 0;
#pragma unroll
        for (int q = 1; q < 32; ++q) e = (pm * 256 >= pst[q]) ? q : e;
        e = __builtin_amdgcn_readfirstlane(e);
        u.pm = pm; u.pn = pn; u.pb = (ebase + e) * NT + pn; u.aux = e; return true; } };
struct S5Order { int G, c;
    __device__ __forceinline__ bool next(int i, pg8::Unit& u) const { const int L = i * G + c; if (L >= 256) return false; const int g = L >> 3, pmL = (L >> 2) & 1, pnL = L & 3;
        u.pm = g * 2 + pmL; u.pb = g * 4 + pnL; u.pn = pnL; u.aux = g; return true; } };

__device__ __forceinline__ void transpose_item(const float* W, int K, int N, bf16_t* WT, int ldt, float* scr, int item, int lane, int mode, const float* kscale = nullptr) {
    const int nblk = N / 32, kb = item / nblk, nb = item % nblk, k0 = 64 * kb, n0 = 32 * nb;
#pragma unroll 8
    for (int i = 0; i < 32; ++i) { const int kk = 2 * i + (lane >> 5); scr[kk * 33 + (lane & 31)] = W[(size_t)(k0 + kk) * N + n0 + (lane & 31)] * (kscale ? kscale[k0 + kk] : 1.0f); }
    __builtin_amdgcn_s_waitcnt(0xC07F); asm volatile("" ::: "memory");
    const int c = lane & 7;
#pragma unroll
    for (int j = 0; j < 4; ++j) {
        const int n = (lane >> 3) + 8 * j; const float* s = scr + (8 * c) * 33 + n;
        u32x4 o; o.x = pk2(s[0 * 33], s[1 * 33]); o.y = pk2(s[2 * 33], s[3 * 33]); o.z = pk2(s[4 * 33], s[5 * 33]); o.w = pk2(s[6 * 33], s[7 * 33]);
        int nn = n0 + n;
        if (mode == 1) { const int half = nn >= 1024; const int jj = nn - half * 1024; nn = 32 * (jj >> 4) + 16 * half + (jj & 15); }
        *(u32x4*)(WT + (size_t)nn * ldt + k0 + 8 * c) = o;
    }
    __builtin_amdgcn_s_waitcnt(0xC07F); asm volatile("" ::: "memory");
}
__device__ __forceinline__ void transpose_item_fp8(const float* W, int K, int N, unsigned char* WT, float* scr, int item, int lane, int mode, float scale) {
    const int nblk = N / 32, kb = item / nblk, nb = item % nblk, k0 = 128 * kb, n0 = 32 * nb;
#pragma unroll 8
    for (int i = 0; i < 64; ++i) { const int kk = 2 * i + (lane >> 5); scr[kk * 33 + (lane & 31)] = W[(size_t)(k0 + kk) * N + n0 + (lane & 31)] * scale; }
    __builtin_amdgcn_s_waitcnt(0xC07F); asm volatile("" ::: "memory");
    const int c = lane & 7;
#pragma unroll
    for (int j = 0; j < 4; ++j) {
        const int n = (lane >> 3) + 8 * j; const float* s = scr + (16 * c) * 33 + n;
        u32x4 o; o.x = pk4_fp8(s[0 * 33], s[1 * 33], s[2 * 33], s[3 * 33]); o.y = pk4_fp8(s[4 * 33], s[5 * 33], s[6 * 33], s[7 * 33]);
        o.z = pk4_fp8(s[8 * 33], s[9 * 33], s[10 * 33], s[11 * 33]); o.w = pk4_fp8(s[12 * 33], s[13 * 33], s[14 * 33], s[15 * 33]);
        int nn = n0 + n;
        if (mode == 1) { const int half = nn >= 1024; const int jj = nn - half * 1024; nn = 32 * (jj >> 4) + 16 * half + (jj & 15); }
        *(u32x4*)(WT + (size_t)nn * K + k0 + 16 * c) = o;
    }
    __builtin_amdgcn_s_waitcnt(0xC07F); asm volatile("" ::: "memory");
}
__device__ __forceinline__ void transpose_many_fp8(const float* W, int nmat, int K, int N, unsigned char* WT, size_t dst_stride, float* scr, int gw, int NGW, int lane, int mode, float scale) {
    const int per = (K / 128) * (N / 32); const long tot = (long)nmat * per;
    for (long it = gw; it < tot; it += NGW) {
        const int mt = (int)(it / per), r = (int)(it % per);
        transpose_item_fp8(W + (size_t)mt * K * N, K, N, WT + (size_t)mt * dst_stride, scr, r, lane, mode, scale);
    }
}
__device__ __forceinline__ void convert_fp8_queue(const float* Wgu, const float* Wdn, unsigned char* WTgu, unsigned char* WTdn, float* tile, volatile int* qslot, unsigned* qctr, int tid, float scale) {
    const int wave = tid >> 6, lane = tid & 63;
    constexpr int TOT_GU = 64 * 64, TOT = TOT_GU + 64 * 32;
    f32x4 v[16];
    auto src = [&](int item, int i) {
        const bool gu = item < TOT_GU; const int it2 = gu ? item : item - TOT_GU; const int N = gu ? 2048 : 1024, per = gu ? 64 : 32, nblk = N / 256;
        const int mt = it2 / per, r = it2 % per, kb = r / nblk, nb = r % nblk;
        return (const f32x4*)((gu ? Wgu : Wdn) + (size_t)mt * 1024 * N + (size_t)(128 * kb + wave + 8 * i) * N + 256 * nb + lane * 4); };
    if (tid == 0) qslot[0] = (int)atomicAdd(qctr, 1u);
    __syncthreads();
    int it = qslot[0];
    if (it < TOT) {
#pragma unroll
        for (int i = 0; i < 16; ++i) v[i] = *src(it, i);
    }
    while (it < TOT) {
        if (tid == 0) qslot[1] = (int)atomicAdd(qctr, 1u);
#pragma unroll
        for (int i = 0; i < 16; ++i) { float* d = tile + (wave + 8 * i) * 257 + lane * 4; d[0] = v[i].x * scale; d[1] = v[i].y * scale; d[2] = v[i].z * scale; d[3] = v[i].w * scale; }
        __syncthreads();
        const int nx = qslot[1];
        if (nx < TOT) {
#pragma unroll
            for (int i = 0; i < 16; ++i) v[i] = *src(nx, i);
        }
        {
            const bool gu = it < TOT_GU; const int it2 = gu ? it : it - TOT_GU; const int N = gu ? 2048 : 1024, per = gu ? 64 : 32, nblk = N / 256;
            const int mt = it2 / per, r = it2 % per, kb = r / nblk, nb = r % nblk, k0 = 128 * kb, n0 = 256 * nb;
            unsigned char* WT = (gu ? WTgu : WTdn) + (size_t)mt * N * 1024;
            const int c = tid & 7;
#pragma unroll 1
            for (int ps = 0; ps < 4; ++ps) {
                const int n = ps * 64 + (tid >> 3); const float* sp = tile + (16 * c) * 257 + n;
                u32x4 o; o.x = pk4_fp8(sp[0 * 257], sp[1 * 257], sp[2 * 257], sp[3 * 257]); o.y = pk4_fp8(sp[4 * 257], sp[5 * 257], sp[6 * 257], sp[7 * 257]);
                o.z = pk4_fp8(sp[8 * 257], sp[9 * 257], sp[10 * 257], sp[11 * 257]); o.w = pk4_fp8(sp[12 * 257], sp[13 * 257], sp[14 * 257], sp[15 * 257]);
                int nn = n0 + n;
                if (gu) { const int half = nn >= 1024; const int jj = nn - half * 1024; nn = 32 * (jj >> 4) + 16 * half + (jj & 15); }
                *(u32x4*)(WT + (size_t)nn * 1024 + k0 + 16 * c) = o;
            }
        }
        __syncthreads();
        it = nx;
    }
}
__device__ __forceinline__ void transpose_many(const float* W, int nmat, int K, int N, bf16_t* WT, size_t dst_stride, float* scr, int gw, int NGW, int lane, int mode, int ldt = 0, const float* kscale = nullptr) {
    if (ldt == 0) ldt = K;
    const int per = (K / 64) * (N / 32); const long tot = (long)nmat * per;
    for (long it = gw; it < tot; it += NGW) {
        const int mt = (int)(it / per), r = (int)(it % per);
        transpose_item(W + (size_t)mt * K * N, K, N, WT + (size_t)mt * dst_stride, ldt, scr, r, lane, mode, kscale);
    }
}

__device__ __forceinline__ void norm_mod_store(f32x4 (&v)[4], const float* g, const float* sc, const float* sh, bf16_t* orow, unsigned char* orow8, int lane) {
    float s = 0.f;
#pragma unroll
    for (int j = 0; j < 4; ++j) s += (v[j].x * v[j].x + v[j].y * v[j].y) + (v[j].z * v[j].z + v[j].w * v[j].w);
    const float r = rsqrtf(wave_sum(s) * (1.0f / D) + 1e-6f);
#pragma unroll
    for (int j = 0; j < 4; ++j) {
        const int c = 4 * lane + 256 * j;
        const f32x4 gg = *(const f32x4*)(g + c), s1 = *(const f32x4*)(sc + c), s0 = *(const f32x4*)(sh + c);
        const float a = v[j].x * r * gg.x * (1.f + s1.x) + s0.x, b = v[j].y * r * gg.y * (1.f + s1.y) + s0.y,
                    cc = v[j].z * r * gg.z * (1.f + s1.z) + s0.z, d = v[j].w * r * gg.w * (1.f + s1.w) + s0.w;
        u32x2 o; o.x = pk2(a, b); o.y = pk2(cc, d);
        *(u32x2*)(orow + c) = o;
        if (orow8) *(unsigned*)(orow8 + c) = pk4_fp8(a, b, cc, d);
    }
}

__device__ __forceinline__ void unpack8(const u32x4 w, float (&f)[8]) {
    f[0] = __uint_as_float(w.x << 16); f[1] = __uint_as_float(w.x & 0xffff0000u); f[2] = __uint_as_float(w.y << 16); f[3] = __uint_as_float(w.y & 0xffff0000u);
    f[4] = __uint_as_float(w.z << 16); f[5] = __uint_as_float(w.z & 0xffff0000u); f[6] = __uint_as_float(w.w << 16); f[7] = __uint_as_float(w.w & 0xffff0000u);
}
__device__ __forceinline__ u32x4 pack8(const float (&f)[8]) { u32x4 o; o.x = pk2(f[0], f[1]); o.y = pk2(f[2], f[3]); o.z = pk2(f[4], f[5]); o.w = pk2(f[6], f[7]); return o; }
__device__ __forceinline__ void norm_mod_store8(float (&v)[2][8], const float* g, const float* sc, const float* sh, bf16_t* orow, unsigned char* orow8, int lane) {
    float s = 0.f;
#pragma unroll
    for (int j = 0; j < 2; ++j)
#pragma unroll
        for (int i = 0; i < 8; ++i) s += v[j][i] * v[j][i];
    const float r = rsqrtf(wave_sum(s) * (1.0f / D) + 1e-6f);
#pragma unroll
    for (int j = 0; j < 2; ++j) {
        const int c = 8 * lane + 512 * j; float o[8];
#pragma unroll
        for (int q = 0; q < 2; ++q) {
            const f32x4 gg = *(const f32x4*)(g + c + 4 * q), s1 = *(const f32x4*)(sc + c + 4 * q), s0 = *(const f32x4*)(sh + c + 4 * q);
            o[4 * q + 0] = v[j][4 * q + 0] * r * gg.x * (1.f + s1.x) + s0.x; o[4 * q + 1] = v[j][4 * q + 1] * r * gg.y * (1.f + s1.y) + s0.y;
            o[4 * q + 2] = v[j][4 * q + 2] * r * gg.z * (1.f + s1.z) + s0.z; o[4 * q + 3] = v[j][4 * q + 3] * r * gg.w * (1.f + s1.w) + s0.w;
        }
        *(u32x4*)(orow + c) = pack8(o);
        if (orow8) { u32x2 w8; w8.x = pk4_fp8(o[0], o[1], o[2], o[3]); w8.y = pk4_fp8(o[4], o[5], o[6], o[7]); *(u32x2*)(orow8 + c) = w8; }
    }
}

template <int ph> __device__ __forceinline__ void phase_body(int wbase) {
    extern __shared__ __attribute__((aligned(16))) unsigned char lds[];
    {
        int tid = wbase + lane_id(); asm volatile("" : "+v"(tid));
        int vb = blockIdx.x, G = gridDim.x; asm volatile("" : "+s"(vb), "+s"(G));
        const int lane = tid & 63, wave = tid >> 6;
        const int gw = vb * NWAVE + wave, NGW = G * NWAVE;
        const __attribute__((address_space(4))) Params* kp = (const __attribute__((address_space(4))) Params*)__builtin_amdgcn_kernarg_segment_ptr();
        asm volatile("" : "+s"(kp));
        unsigned char* ws = kp->ws;
        unsigned* ctl = (unsigned*)(ws + WS_CTL);
        float* MOD = (float*)(ws + WS_MOD);
        float* S5AB = (float*)(ws + WS_S5AB); float* S5BB = (float*)(ws + WS_S5AB + 65536);
        float* PW = (float*)(ws + WS_PW); float* KTAB = (float*)(ws + WS_KTAB);
                int* EL_SLOT = (int*)(ws + WS_EL); float* EL_GATE = (float*)(ws + WS_EL + 4 * MiB);
            bf16_t* W_IN_E = (bf16_t*)(ws + WS_W_IN_E); bf16_t* W_UP = (bf16_t*)(ws + WS_W_UP); bf16_t* W_GLU = (bf16_t*)(ws + WS_W_GLU);
        bf16_t* W_OUT_E = (bf16_t*)(ws + WS_W_OUT_E); bf16_t* W_IN_O = (bf16_t*)(ws + WS_W_IN_O); bf16_t* W_OUT_O = (bf16_t*)(ws + WS_W_OUT_O);
        bf16_t* W_POOL = (bf16_t*)(ws + WS_W_POOL); bf16_t* W_SGU = (bf16_t*)(ws + WS_W_SGU); bf16_t* W_RT = (bf16_t*)(ws + WS_W_RT);
        bf16_t* BT_END = (bf16_t*)(ws + WS_BT_END); bf16_t* BT_MAIN = (bf16_t*)(ws + WS_BT_MAIN);
        unsigned char* W_GU = ws + WS_W_GU; unsigned char* W_DN = ws + WS_W_DN; unsigned char* HB8 = ws + WS_HB8;
        bf16_t* HB = (bf16_t*)(ws + WS_HB); bf16_t* MIXIN = (bf16_t*)(ws + WS_MIXIN); unsigned char* Y = ws + WS_Y;
        unsigned char* ACT = ws + WS_ACT;
        bf16_t* Z = (bf16_t*)(ws + WS_Z); float* RSP = (float*)(ws + WS_RSP); bf16_t* QKVRAW = (bf16_t*)(ws + WS_QKVRAW);
        bf16_t* Qb = (bf16_t*)(ws + WS_Q); bf16_t* Kb = (bf16_t*)(ws + WS_K); bf16_t* VT = (bf16_t*)(ws + WS_VT);
        bf16_t* AS5 = (bf16_t*)(ws + WS_AS5); float* LEND = (float*)(ws + WS_LEND); bf16_t* GACT = (bf16_t*)(ws + WS_GACT);
        bf16_t* POOLED = (bf16_t*)(ws + WS_POOLED); bf16_t* VTS = (bf16_t*)(ws + WS_VTS);
        float* OUT = kp->out; const float* XIN = kp->x; bf16_t* XR = (bf16_t*)(ws + WS_XR);
        const float* s5d = kp->s5_d; const float* glub = kp->s5_glu_b; const float* poolsc = kp->pool_scale; const float* sgub = kp->sgu_b;
        const float* bgu_all = kp->moe_b_gu; const float* bdn_all = kp->moe_b_dn; const float* rtb_all = kp->router_b;

        const int layer = (ph >= 17) ? 1 : 0;
        const int mph = (ph >= 17 && ph <= 19) ? ph - 8 : ph;
        const float* mod_l = MOD + (size_t)layer * NB * 6144;

        if (ph == 0) {
            const int gt = vb * NTHR + tid;
            if (gt < 2048) {
                const int g = gt >> 6, pp = gt & 63;
                const float dt = expf(kp->s5_log_dt[g]);
                const float lre = fminf(kp->s5_a_re[g * 64 + pp], -1e-4f), lim = kp->s5_a_im[g * 64 + pp];
                const float mag = expf(lre * dt);
                const float abr = mag * cosf(lim * dt), abi = mag * sinf(lim * dt);
                const float den = lre * lre + lim * lim, nr = abr - 1.0f;
                const float fre = (nr * lre + abi * lim) / den, fim = (abi * lre - nr * lim) / den;
                S5AB[(g * 64 + pp) * 2 + 0] = abr; S5AB[(g * 64 + pp) * 2 + 1] = abi;
                for (int j = 0; j < 16; ++j) {
                    const float br = kp->s5_b_re[(g * 64 + pp) * 16 + j], bi = kp->s5_b_im[(g * 64 + pp) * 16 + j];
                    S5BB[((g * 64 + pp) * 16 + j) * 2 + 0] = fre * br - fim * bi;
                    S5BB[((g * 64 + pp) * 16 + j) * 2 + 1] = fre * bi + fim * br;
                }
                float pr = 1.f, pi = 0.f;
                for (int tau = 0; tau <= 64; ++tau) {
                    PW[((g * 64 + pp) * 65 + tau) * 2 + 0] = pr; PW[((g * 64 + pp) * 65 + tau) * 2 + 1] = pi;
                    const float nr2 = pr * abr - pi * abi, ni2 = pr * abi + pi * abr; pr = nr2; pi = ni2;
                }
            }
            {
                float* ca = (float*)lds;
                for (int i = tid; i < NB * D; i += NTHR) { const float cv = kp->c[i]; ca[i] = cv * sigmoidf_(cv); }
                __syncthreads();
                float* part = (float*)(lds + 32768);
                for (int task = (vb >= 64 ? vb - 64 : vb + G - 64); task < 2 * 96; task += G) {
                    const int l = task / 96, cb = task % 96, col = cb * 64 + lane;
                    const float* W = kp->ada_w + (size_t)l * D * 6144 + col;
                    float acc[8];
#pragma unroll
                    for (int b = 0; b < 8; ++b) acc[b] = 0.f;
                    const int kb = wave * 128;
                    for (int k = kb; k < kb + 128; k += 16) {
                        float w[16];
#pragma unroll
                        for (int u = 0; u < 16; ++u) w[u] = W[(size_t)(k + u) * 6144];
#pragma unroll
                        for (int u = 0; u < 16; ++u)
#pragma unroll
                            for (int b = 0; b < 8; ++b) acc[b] += ca[b * D + k + u] * w[u];
                    }
#pragma unroll
                    for (int b = 0; b < 8; ++b) part[(wave * 8 + b) * 64 + lane] = acc[b];
                    __syncthreads();
                    {
                        const int b = tid >> 6;
                        float sum = kp->ada_b[l * 6144 + col];
#pragma unroll
                        for (int w8 = 0; w8 < 8; ++w8) sum += part[(w8 * 8 + b) * 64 + lane];
                        MOD[((size_t)l * NB + b) * 6144 + col] = sum;
                    }
                    __syncthreads();
                }
                __syncthreads();
            }
            {
                float* scr = (float*)(lds + wave * 16384);
                transpose_many(kp->even_w_in, 1, 1024, 928, W_IN_E, 0, scr, gw, NGW, lane, 0);
                transpose_many(kp->w_uq, 1, 256, 768, W_UP, 0, scr, gw, NGW, lane, 0, 384, kp->q_norm_g);
                transpose_many(kp->w_ukv, 1, 128, 1024, W_UP + (size_t)768 * 384 + 256, 0, scr, gw, NGW, lane, 0, 384, kp->kv_norm_g);
                for (int i = vb * NTHR + tid; i < 768 * 16 + 1024 * 32; i += G * NTHR) {
                    const u32x4 z = {0u, 0u, 0u, 0u};
                    if (i < 768 * 16) *(u32x4*)(W_UP + (size_t)(i >> 4) * 384 + 256 + (i & 15) * 8) = z;
                    else { const int q = i - 768 * 16; *(u32x4*)(W_UP + (size_t)(768 + (q >> 5)) * 384 + (q & 31) * 8) = z; }
                }
                transpose_many(kp->s5_glu_w, 1, 512, 512, W_GLU, 0, scr, gw, NGW, lane, 0);
                transpose_many(kp->even_w_out, 1, 1024, 1024, W_OUT_E, 0, scr, gw, NGW, lane, 0);
                transpose_many(kp->odd_w_in, 1, 1024, 1536, W_IN_O, 0, scr, gw, NGW, lane, 0);
                transpose_many(kp->odd_w_out, 1, 1024, 1024, W_OUT_O, 0, scr, gw, NGW, lane, 0);
                transpose_many(kp->pool_w, 4, 128, 128, W_POOL, 128 * 128, scr, gw, NGW, lane, 0);
                transpose_many(kp->router_w, 2, 1024, 32, W_RT, 128 * 1024, scr, gw, NGW, lane, 0);
                __syncthreads();
                convert_fp8_queue(kp->moe_w_gu, kp->moe_w_dn, W_GU, W_DN, (float*)lds, (volatile int*)(lds + LDS_MISC + 256), ctl + CW_Q, tid, 32.0f);
                for (int i = vb * NTHR + tid; i < 4 * 128 * 128; i += G * NTHR) {
                    const int t = (i >> 7) & 127, s_ = i & 127;
                    W_SGU[i] = (s_ <= t) ? f2bf(kp->sgu_w[i]) : (bf16_t)0;
                }
            }
        }
        else if (ph == 1 || ph == 12 || ph == 20) {
            const int lyr = (ph == 1) ? 0 : 1;
            const bool combine = (ph == 12 || ph == 20), donorm = (ph != 20);
            const int comb_layer = (ph == 12) ? 0 : 1;
            const bool ffn = false;
            const float* ng = (ffn ? kp->norm_ffn_g : kp->norm_mix_g) + lyr * D;
            if (ph == 1) {
                for (int rb = gw * 16; rb < T; rb += NGW * 16) {
                    const int b = rb / S;
                    const float* mm = MOD + ((size_t)lyr * NB + b) * 6144;
                    f32x4 pg[4], ps[4], ph_[4];
#pragma unroll
                    for (int j = 0; j < 4; ++j) { const int c = 4 * lane + 256 * j; pg[j] = *(const f32x4*)(ng + c); const f32x4 s1 = *(const f32x4*)(mm + D + c); ph_[j] = *(const f32x4*)(mm + c);
                        pg[j].x *= (1.f + s1.x); pg[j].y *= (1.f + s1.y); pg[j].z *= (1.f + s1.z); pg[j].w *= (1.f + s1.w); ps[j] = s1; }
                    f32x4 cur[4], nxt[4];
#pragma unroll
                    for (int j = 0; j < 4; ++j) cur[j] = *(const f32x4*)(XIN + (size_t)rb * D + 4 * lane + 256 * j);
                    for (int i = 0; i < 16; ++i) {
                        const int row = rb + i;
                        if (i + 1 < 16) {
#pragma unroll
                            for (int j = 0; j < 4; ++j) nxt[j] = *(const f32x4*)(XIN + (size_t)(row + 1) * D + 4 * lane + 256 * j);
                        }
                        float ss = 0.f;
#pragma unroll
                        for (int j = 0; j < 4; ++j) ss += (cur[j].x * cur[j].x + cur[j].y * cur[j].y) + (cur[j].z * cur[j].z + cur[j].w * cur[j].w);
                        const float r = rsqrtf(wave_sum(ss) * (1.0f / D) + 1e-6f);
#pragma unroll
                        for (int j = 0; j < 4; ++j) {
                            u32x2 o; o.x = pk2(cur[j].x * r * pg[j].x + ph_[j].x, cur[j].y * r * pg[j].y + ph_[j].y); o.y = pk2(cur[j].z * r * pg[j].z + ph_[j].z, cur[j].w * r * pg[j].w + ph_[j].w);
                            *(u32x2*)(HB + (size_t)row * D + 4 * lane + 256 * j) = o;
                        }
#pragma unroll
                        for (int j = 0; j < 4; ++j) cur[j] = nxt[j];
                    }
                }
            } else {
                for (int row0 = gw; row0 < T; row0 += 2 * NGW) {
                    float v[2][2][8];
#pragma unroll
                    for (int j = 0; j < 2; ++j) {
                        const int c = 8 * lane + 512 * j;
                        u32x4 xr[2]; u32x2 yr[2][4];
#pragma unroll
                        for (int q = 0; q < 2; ++q) {
                            const int row = row0 + q * NGW;
                            xr[q] = *(const u32x4*)(XR + (size_t)row * D + c);
#pragma unroll
                            for (int k = 0; k < 4; ++k) yr[q][k] = *(const u32x2*)(Y + ((size_t)row * 4 + k) * D + c);
                        }
#pragma unroll
                        for (int q = 0; q < 2; ++q) {
                            const int row = row0 + q * NGW, b = row / S;
                            const float* gf = MOD + ((size_t)comb_layer * NB + b) * 6144 + 5 * D;
                            float xf[8], acc[8];
                            unpack8(xr[q], xf);
#pragma unroll
                            for (int i = 0; i < 8; ++i) acc[i] = 0.f;
#pragma unroll
                            for (int k = 0; k < 4; ++k) {
                                typedef float f2_ __attribute__((ext_vector_type(2)));
                                const f2_ y01 = __builtin_amdgcn_cvt_pk_f32_fp8((int)yr[q][k].x, false), y23 = __builtin_amdgcn_cvt_pk_f32_fp8((int)yr[q][k].x, true);
                                const f2_ y45 = __builtin_amdgcn_cvt_pk_f32_fp8((int)yr[q][k].y, false), y67 = __builtin_amdgcn_cvt_pk_f32_fp8((int)yr[q][k].y, true);
                                acc[0] += y01.x; acc[1] += y01.y; acc[2] += y23.x; acc[3] += y23.y; acc[4] += y45.x; acc[5] += y45.y; acc[6] += y67.x; acc[7] += y67.y; }
                            f32x4 g0 = *(const f32x4*)(gf + c), g1 = *(const f32x4*)(gf + c + 4);
                            g0 = g0 * 0.0625f; g1 = g1 * 0.0625f;
                            float (&vv)[8] = v[q][j];
                            vv[0] = xf[0] + g0.x * acc[0]; vv[1] = xf[1] + g0.y * acc[1]; vv[2] = xf[2] + g0.z * acc[2]; vv[3] = xf[3] + g0.w * acc[3];
                            vv[4] = xf[4] + g1.x * acc[4]; vv[5] = xf[5] + g1.y * acc[5]; vv[6] = xf[6] + g1.z * acc[6]; vv[7] = xf[7] + g1.w * acc[7];
                            if (ph == 20) { *(f32x4*)(OUT + (size_t)row * D + c) = (f32x4){vv[0], vv[1], vv[2], vv[3]}; *(f32x4*)(OUT + (size_t)row * D + c + 4) = (f32x4){vv[4], vv[5], vv[6], vv[7]}; }
                            else *(u32x4*)(XR + (size_t)row * D + c) = pack8(vv);
                        }
                    }
                    if (donorm) {
#pragma unroll
                        for (int q = 0; q < 2; ++q) {
                            const int row = row0 + q * NGW, b = row / S;
                            const float* mm = MOD + ((size_t)lyr * NB + b) * 6144;
                            norm_mod_store8(v[q], ng, mm + D, mm, HB + (size_t)row * D, (unsigned char*)nullptr, lane);
                        }
                    }
                }
            }
            if (ph == 1) {
                __syncthreads();
                float* Cs = (float*)lds;
                float* Bs = Cs + 2048;
                float* As = Bs + 2048;
                for (int item = vb; item < 256; item += G) {
                    const int g = item >> 3, tq = item & 7;
                    for (int idx = tid; idx < 1024; idx += NTHR) {
                        const int i = idx >> 6, pp = idx & 63;
                        Cs[idx * 2] = kp->s5_c_re[(g * 16 + i) * 64 + pp]; Cs[idx * 2 + 1] = kp->s5_c_im[(g * 16 + i) * 64 + pp];
                        Bs[idx * 2] = S5BB[((size_t)g * 1024 + idx) * 2]; Bs[idx * 2 + 1] = S5BB[((size_t)g * 1024 + idx) * 2 + 1];
                    }
                    { const int pp = tid >> 3, tl = tid & 7; As[tid * 2] = PW[((g * 64 + pp) * 65 + tq * 8 + tl) * 2]; As[tid * 2 + 1] = PW[((g * 64 + pp) * 65 + tq * 8 + tl) * 2 + 1]; }
                    __syncthreads();
                    const int v0 = tid * 4, tl = v0 >> 8, i = (v0 >> 4) & 15, j0 = v0 & 15;
                    float acc[4] = {0.f, 0.f, 0.f, 0.f};
                    for (int pp = 0; pp < 64; ++pp) {
                        const float cr = Cs[(i * 64 + pp) * 2], ci = Cs[(i * 64 + pp) * 2 + 1];
                        const float ar = As[(pp * 8 + tl) * 2], ai = As[(pp * 8 + tl) * 2 + 1];
                        const f32x4 b01 = *(const f32x4*)(Bs + (pp * 16 + j0) * 2), b23 = *(const f32x4*)(Bs + (pp * 16 + j0) * 2 + 4);
                        const float wr_ = cr * ar - ci * ai, wi_ = cr * ai + ci * ar;
                        acc[0] += wr_ * b01.x - wi_ * b01.y; acc[1] += wr_ * b01.z - wi_ * b01.w; acc[2] += wr_ * b23.x - wi_ * b23.y; acc[3] += wr_ * b23.z - wi_ * b23.w;
                    }
                    *(f32x4*)(KTAB + (((size_t)g * 64 + tq * 8 + tl) * 16 + i) * 16 + j0) = (f32x4){acc[0], acc[1], acc[2], acc[3]};
                    __syncthreads();
                }
            }
        }
        else if (ph == 2) {
            {
                DenseOrder so; so.go.init(T / 256, 4, G, vb);
                auto f = [=](const pg8::Unit& u, const pg8::NoCtx&, int ai, int m, int bj, int r, int c, f32x4 v0, f32x4 v1) -> float {
                        const int row = u.pm * 256 + r, col = u.pn * 256 + c; float ss = 0.f;
                        u32x4 o; o.x = pk2(v0.x, v0.y); o.y = pk2(v0.z, v0.w); o.z = pk2(v1.x, v1.y); o.w = pk2(v1.z, v1.w);
                        if (col < 384) ss = ((v0.x * v0.x + v0.y * v0.y) + (v0.z * v0.z + v0.w * v0.w)) + ((v1.x * v1.x + v1.y * v1.y) + (v1.z * v1.z + v1.w * v1.w));
                        if (col < 416) *(u32x4*)(Z + (size_t)row * 1024 + col) = o;
                        else if (col < 928) {
                            const int ch = col - 416, g = ch >> 4, j = ch & 15, b = row / S, t = row % S;
                            *(u32x4*)(AS5 + ((size_t)g * 512 + b * 64 + (t >> 6)) * 1152 + 128 + (t & 63) * 16 + j) = o;
                        }
                        return ss;
                    };
                auto re = [=](const pg8::Unit& u, int ai, int m, int r, int wc, int fq, float part) {
                        if (u.pn < 2) {
                            part += __shfl_xor(part, 16); part += __shfl_xor(part, 32);
                            if (fq == 0) RSP[((size_t)(u.pm * 256 + r) * 2 + u.pn) * 4 + wc] = part;
                        }
                    };
                pg8::gemm_phase<false, false, true>(tid, (PG8_LAS unsigned char*)lds, pg8::Gemm{HB, W_IN_E, D, D, D}, so, pg8::make_epi_row<true>(pg8::NoPre{}, f, re));
            }
            {
                float* KT = (float*)lds;
                float* Cs = KT + 64 * 256;
                float* PWt = Cs + 2048;
                float* PWe = PWt + 1024;
                float* BBe = PWe + 2048;
                for (int item = vb; item < 256; item += G) {
                    const int g = item >> 3, tq = item & 7;
                    __syncthreads();
                    const int ntau = 8 * tq + 8;
                    for (int idx = tid; idx < ntau * 64; idx += NTHR) *(f32x4*)(KT + idx * 4) = *(const f32x4*)(KTAB + (size_t)g * 64 * 256 + idx * 4);
                    for (int idx = tid; idx < 1024; idx += NTHR) { const int i = idx >> 6, pp = idx & 63;
                        Cs[idx * 2] = kp->s5_c_re[(g * 16 + i) * 64 + pp]; Cs[idx * 2 + 1] = kp->s5_c_im[(g * 16 + i) * 64 + pp]; }
                    { const int pp = tid >> 3, tl = tid & 7; PWt[tid * 2] = PW[((g * 64 + pp) * 65 + tq * 8 + tl + 1) * 2]; PWt[tid * 2 + 1] = PW[((g * 64 + pp) * 65 + tq * 8 + tl + 1) * 2 + 1]; }
                    const int ri_e = tq >> 2, p0_e = (tq & 3) * 16;
                    for (int idx = tid; idx < 1024; idx += NTHR) { const int pl = idx >> 6, tau = idx & 63;
                        PWe[idx * 2] = PW[((g * 64 + p0_e + pl) * 65 + tau) * 2]; PWe[idx * 2 + 1] = PW[((g * 64 + p0_e + pl) * 65 + tau) * 2 + 1]; }
                    if (tid < 256) { const int pl = tid >> 4, j = tid & 15; BBe[tid * 2] = S5BB[((g * 64 + p0_e + pl) * 16 + j) * 2]; BBe[tid * 2 + 1] = S5BB[((g * 64 + p0_e + pl) * 16 + j) * 2 + 1]; }
                    __syncthreads();
                    for (int it = tid; it < 16 * 128; it += NTHR) {
                        const int pl = it >> 7, k8 = it & 127, s_ = k8 >> 1, j0 = (k8 & 1) * 8;
                        const float pr = PWe[(pl * 64 + 63 - s_) * 2], pi = PWe[(pl * 64 + 63 - s_) * 2 + 1];
                        float o[8];
#pragma unroll
                        for (int j = 0; j < 8; ++j) { const float br = BBe[(pl * 16 + j0 + j) * 2], bi = BBe[(pl * 16 + j0 + j) * 2 + 1]; o[j] = ri_e ? (pr * bi + pi * br) : (pr * br - pi * bi); }
                        u32x4 w; w.x = pk2(o[0], o[1]); w.y = pk2(o[2], o[3]); w.z = pk2(o[4], o[5]); w.w = pk2(o[6], o[7]);
                        *(u32x4*)(BT_END + ((size_t)g * 128 + ri_e * 64 + p0_e + pl) * 1024 + k8 * 8) = w;
                    }
                    for (int it = tid; it < 128 * 144; it += NTHR) {
                        const int rl = it / 144, k8 = it % 144, tl = rl >> 4, i = rl & 15, t = 8 * tq + tl;
                        float o[8];
                        if (k8 < 16) {
                            const int ri = k8 >> 3, p0 = (k8 & 7) * 8;
#pragma unroll
                            for (int j = 0; j < 8; ++j) {
                                const float cr = Cs[(i * 64 + p0 + j) * 2], ci = Cs[(i * 64 + p0 + j) * 2 + 1];
                                const float pr = PWt[((p0 + j) * 8 + tl) * 2], pi = PWt[((p0 + j) * 8 + tl) * 2 + 1];
                                o[j] = ri ? -(cr * pi + ci * pr) : (cr * pr - ci * pi);
                            }
                        } else {
                            const int kk = (k8 - 16) * 8, s_ = kk >> 4, j0 = kk & 15;
                            if (s_ <= t) { const f32x4 a = *(const f32x4*)(KT + (t - s_) * 256 + i * 16 + j0), c4 = *(const f32x4*)(KT + (t - s_) * 256 + i * 16 + j0 + 4);
                                o[0] = a.x; o[1] = a.y; o[2] = a.z; o[3] = a.w; o[4] = c4.x; o[5] = c4.y; o[6] = c4.z; o[7] = c4.w; }
                            else {
#pragma unroll
                                for (int j = 0; j < 8; ++j) o[j] = 0.f; }
                        }
                        u32x4 w; w.x = pk2(o[0], o[1]); w.y = pk2(o[2], o[3]); w.z = pk2(o[4], o[5]); w.w = pk2(o[6], o[7]);
                        *(u32x4*)(BT_MAIN + ((size_t)g * 1024 + 8 * tq * 16 + rl) * 1152 + k8 * 8) = w;
                    }
                }
                __syncthreads();
            }
        }
        else if (ph == 4) {
            {
                DenseOrder so; so.go.init(T / 256, 7, G, vb);
                struct UpCtx { float rs[8]; };
                auto pre = [=](const pg8::Unit& u, int wr, int wc, int fr, int fq, const PG8_LAS unsigned char* cxl) {
                        UpCtx cx; const int st = (u.pn >= 3) ? 1 : 0; const float inv = st ? (1.f / 128.f) : (1.f / 256.f);
#pragma unroll
                        for (int q = 0; q < 8; ++q) { const int row = u.pm * 256 + (q >> 2) * 128 + wr * 64 + (q & 3) * 16 + fr;
                            const f32x4 pp = *(const f32x4*)(RSP + ((size_t)row * 2 + st) * 4);
                            cx.rs[q] = rsqrtf(((pp.x + pp.y) + (pp.z + pp.w)) * inv + 1e-6f); }
                        return cx; };
                auto f = [=](const pg8::Unit& u, const UpCtx& cx, int ai, int m, int bj, int r, int c, f32x4 v0, f32x4 v1) {
                            const float rs = cx.rs[ai * 4 + m];
                            bf16_t* o = QKVRAW + (size_t)(u.pm * 256 + r) * 1792 + u.pn * 256 + c;
                            u32x4 a; a.x = pk2(v0.x * rs, v0.y * rs); a.y = pk2(v0.z * rs, v0.w * rs); a.z = pk2(v1.x * rs, v1.y * rs); a.w = pk2(v1.z * rs, v1.w * rs); *(u32x4*)o = a;
                        };
                pg8::gemm_phase<false, false, true>(tid, (PG8_LAS unsigned char*)lds, pg8::Gemm{Z, W_UP, 1024, 384, 384}, so, pg8::make_epi_perm(pre, f));
            }
            for (int u = (vb >= 128 ? vb - 128 : vb + 128); u < 128; u += G) {
                const int g = u >> 2, pm = u & 3;
                sg_tile(tid, lds, AS5 + ((size_t)g * 512 + pm * 128) * 1152 + 128, 1152, BT_END + (size_t)g * 128 * 1024, 1024, 1024,
                    [=](int r, int c, f32x4 v0, f32x4 v1) {
                        float* o = LEND + ((size_t)g * 512 + pm * 128 + r) * 128 + c;
                        *(f32x4*)o = v0; *(f32x4*)(o + 16) = v1;
                    });
            }
        }
        else if (ph == 5) {
            bf16_t* vts = (bf16_t*)lds;
            const float qscale = 0.10206207261596577f * 1.4426950408889634f;
            const int hh = lane >> 3, pp = lane & 7;
            float gq[12], gk[12];
#pragma unroll
            for (int g3 = 0; g3 < 3; ++g3)
#pragma unroll
                for (int e = 0; e < 4; ++e) { gq[g3 * 4 + e] = kp->q_head_g[32 * g3 + 4 * pp + e] * qscale; gk[g3 * 4 + e] = kp->k_head_g[32 * g3 + 4 * pp + e]; }
            float invf[4];
#pragma unroll
            for (int e = 0; e < 4; ++e) invf[e] = exp2f(-(float)(4 * (pp & 3) + e) * (13.287712379549449f / 16.0f));
            for (int tile = vb; tile < T / 64; tile += G) {
                u32x2 cq[3], ck[3], nq[3], nk[3]; u32x4 cv, nv; int cpos, npos;
#define P5_LOAD(row_, Q_, K_, V_, P_) do { const bf16_t* base_ = QKVRAW + (size_t)(row_) * 1792; \
                    _Pragma("unroll") for (int g3 = 0; g3 < 3; ++g3) Q_[g3] = *(const u32x2*)(base_ + hh * 96 + 32 * g3 + 4 * pp); \
                    K_[0] = *(const u32x2*)(base_ + 768 + hh * 128 + 4 * pp); K_[1] = *(const u32x2*)(base_ + 768 + hh * 128 + 32 + 4 * pp); K_[2] = *(const u32x2*)(Z + (size_t)(row_) * 1024 + 384 + 4 * pp); \
                    V_ = *(const u32x4*)(base_ + 768 + hh * 128 + 64 + 8 * pp); P_ = kp->pos[row_]; } while (0)
                P5_LOAD(tile * 64 + wave * 8, cq, ck, cv, cpos);
                for (int tt = 0; tt < 8; ++tt) {
                    const int tl = wave * 8 + tt, row = tile * 64 + tl, b = row / S, t = row % S;
                    if (tt + 1 < 8) P5_LOAD(row + 1, nq, nk, nv, npos);
                    float qv[12], kv[12];
#pragma unroll
                    for (int g3 = 0; g3 < 3; ++g3) {
                        qv[4 * g3 + 0] = __uint_as_float(cq[g3].x << 16); qv[4 * g3 + 1] = __uint_as_float(cq[g3].x & 0xffff0000u); qv[4 * g3 + 2] = __uint_as_float(cq[g3].y << 16); qv[4 * g3 + 3] = __uint_as_float(cq[g3].y & 0xffff0000u);
                        kv[4 * g3 + 0] = __uint_as_float(ck[g3].x << 16); kv[4 * g3 + 1] = __uint_as_float(ck[g3].x & 0xffff0000u); kv[4 * g3 + 2] = __uint_as_float(ck[g3].y << 16); kv[4 * g3 + 3] = __uint_as_float(ck[g3].y & 0xffff0000u);
                    }
                    float sq = 0.f, sk = 0.f;
#pragma unroll
                    for (int j = 0; j < 12; ++j) { sq += qv[j] * qv[j]; sk += kv[j] * kv[j]; }
                    sq += __shfl_xor(sq, 1); sq += __shfl_xor(sq, 2); sq += __shfl_xor(sq, 4);
                    sk += __shfl_xor(sk, 1); sk += __shfl_xor(sk, 2); sk += __shfl_xor(sk, 4);
                    const float rq = rsqrtf(sq * (1.f / 96.f) + 1e-6f), rk = rsqrtf(sk * (1.f / 96.f) + 1e-6f);
#pragma unroll
                    for (int j = 0; j < 12; ++j) { qv[j] *= rq * gq[j]; kv[j] *= rk * gk[j]; }
                    const float posf = (float)cpos; const bool lo = pp < 4;
#pragma unroll
                    for (int e = 0; e < 4; ++e) {
                        const float ang = posf * invf[e];
                        const float kq = rintf(ang * 0.15915494309189535f);
                        float rr = __builtin_fmaf(-kq, 6.28318548202514648f, ang); rr = __builtin_fmaf(-kq, -1.7484556e-7f, rr);
                        const float cs = __cosf(rr), sn = __sinf(rr);
                        const float qo = __shfl_xor(qv[8 + e], 4), ko = __shfl_xor(kv[8 + e], 4);
                        qv[8 + e] = lo ? (qv[8 + e] * cs - qo * sn) : (qo * sn + qv[8 + e] * cs);
                        kv[8 + e] = lo ? (kv[8 + e] * cs - ko * sn) : (ko * sn + kv[8 + e] * cs);
                    }
                    bf16_t* qd = Qb + (((size_t)b * 8 + hh) * S + t) * 96 + 4 * pp; bf16_t* kd = Kb + (((size_t)b * 8 + hh) * S + t) * 96 + 4 * pp;
#pragma unroll
                    for (int g3 = 0; g3 < 3; ++g3) {
                        u32x2 o; o.x = pk2(qv[4 * g3], qv[4 * g3 + 1]); o.y = pk2(qv[4 * g3 + 2], qv[4 * g3 + 3]); *(u32x2*)(qd + 32 * g3) = o;
                        u32x2 o2; o2.x = pk2(kv[4 * g3], kv[4 * g3 + 1]); o2.y = pk2(kv[4 * g3 + 2], kv[4 * g3 + 3]); *(u32x2*)(kd + 32 * g3) = o2;
                    }
                    { const unsigned w4[4] = {cv.x, cv.y, cv.z, cv.w};
#pragma unroll
                      for (int j = 0; j < 8; ++j) vts[(hh * 64 + 8 * pp + j) * 64 + tl] = (bf16_t)((j & 1) ? (w4[j >> 1] >> 16) : (w4[j >> 1] & 0xffffu)); }
#pragma unroll
                    for (int g3 = 0; g3 < 3; ++g3) { cq[g3] = nq[g3]; ck[g3] = nk[g3]; }
                    cv = nv; cpos = npos;
                }
#undef P5_LOAD
                __syncthreads();
                {
                    const int hd = tid, b = (tile * 64) / S, t0 = (tile * 64) % S;
                    bf16_t* dst = VT + (((size_t)b * 8 + (hd >> 6)) * 64 + (hd & 63)) * S + t0;
#pragma unroll
                    for (int i = 0; i < 8; ++i) *(u32x4*)(dst + i * 8) = *(const u32x4*)(vts + hd * 64 + i * 8);
                }
                __syncthreads();
            }
            if (wave == 0) {
                for (int ch = vb * 64 + lane; ch < NB * 32 * 64; ch += G * 64) {
                    const int pp = ch & 63, g = (ch >> 6) & 31, b = ch >> 11;
                    const float ar = PW[((g * 64 + pp) * 65 + 64) * 2], ai = PW[((g * 64 + pp) * 65 + 64) * 2 + 1];
                    float cr = 0.f, ci = 0.f;
                    for (int c0 = 0; c0 < 64; c0 += 16) {
                        float lr[16], li[16];
#pragma unroll
                        for (int u = 0; u < 16; ++u) { const float* le = LEND + ((size_t)g * 512 + b * 64 + c0 + u) * 128; lr[u] = le[pp]; li[u] = le[64 + pp]; }
#pragma unroll
                        for (int u = 0; u < 16; ++u) {
                            bf16_t* dst = AS5 + ((size_t)g * 512 + b * 64 + c0 + u) * 1152;
                            dst[pp] = f2bf(cr); dst[64 + pp] = f2bf(ci);
                            const float nr = ar * cr - ai * ci + lr[u], ni = ar * ci + ai * cr + li[u];
                            cr = nr; ci = ni;
                        }
                    }
                }
            }
        }
        else if (ph == 6) {
            unsigned char* Kr = lds;
            unsigned char* Vr = lds + 3 * 64 * 208;
            const int r32 = lane & 31, hi = lane >> 5;
#define ATT_MFMA_C(D, A, B, C) asm volatile("s_nop 1\n\tv_mfma_f32_32x32x16_bf16 %0, %1, %2, %3" : "+a"(D) : "v"(A), "v"(B), "a"(C))
#define ATT_MFMA(D, A, B)      asm volatile("s_nop 1\n\tv_mfma_f32_32x32x16_bf16 %0, %1, %2, %0" : "+a"(D) : "v"(A), "v"(B))
            for (int ui_ = 0; ui_ < 4 * (1 + PROBE_ATT2); ++ui_) { const int ui = ui_ & 3;
                if (vb >= 256) break;
                const int bh = vb & 63, kq = vb >> 6;
                const int qb = (ui == 0) ? 15 - kq : (ui == 1) ? 8 + kq : (ui == 2) ? 7 - kq : kq;
                const int q0 = qb * 256 + wave * 32;
                const bf16_t* Qg = Qb + ((size_t)bh * S + q0 + r32) * 96;
                const bf16_t* Kg = Kb + (size_t)bh * S * 96;
                const bf16_t* Vg = VT + (size_t)bh * 64 * S;
                unsigned char* Qs = lds + 3 * 64 * (208 + 136) + (wave * 32 + r32) * 208;
                __syncthreads();
#pragma unroll
                for (int d0 = 0; d0 < 6; ++d0) *(bf16x8*)(Qs + d0 * 32 + hi * 16) = *(const bf16x8*)(Qg + d0 * 16 + hi * 8);
                const int ntile = 4 * (qb + 1);
                const int ntw = (q0 + 31) / 64 + 1;
                const int kr0 = tid >> 3, kc0 = tid & 7;
                const int vr = tid >> 3, vc = tid & 7;
                u32x2 rk0, rk1, rk2; u32x4 rv;
#define ATT_LOAD(t_) do { { const u32x2* kp_ = (const u32x2*)(Kg + (size_t)((t_) * 64 + kr0) * 96 + kc0 * 12); rk0 = kp_[0]; rk1 = kp_[1]; rk2 = kp_[2]; } \
                    rv = *(const u32x4*)(Vg + (size_t)vr * S + (t_) * 64 + vc * 8); } while (0)
#define ATT_WRITE(t_) do { unsigned char* Ks_ = Kr + ((t_) % 3) * (64 * 208); unsigned char* Vs_ = Vr + ((t_) % 3) * (64 * 136); \
                    { u32x2* kd_ = (u32x2*)(Ks_ + kr0 * 208 + kc0 * 24); kd_[0] = rk0; kd_[1] = rk1; kd_[2] = rk2; } \
                    { u32x2 a_; a_.x = rv.x; a_.y = rv.y; u32x2 b_; b_.x = rv.z; b_.y = rv.w; *(u32x2*)(Vs_ + vr * 136 + vc * 16) = a_; *(u32x2*)(Vs_ + vr * 136 + vc * 16 + 8) = b_; } } while (0)
#define ATT_QK(t_) do { const unsigned char* Ks_ = Kr + ((t_) % 3) * (64 * 208); \
                    _Pragma("unroll") for (int d0 = 0; d0 < 6; ++d0) { \
                        const bf16x8 k0_ = *(const bf16x8*)(Ks_ + r32 * 208 + d0 * 32 + hi * 16); const bf16x8 k1_ = *(const bf16x8*)(Ks_ + (32 + r32) * 208 + d0 * 32 + hi * 16); \
                        const bf16x8 q_ = *(const bf16x8*)(Qs + d0 * 32 + hi * 16); \
                        if (d0 == 0) { ATT_MFMA_C(sA0, k0_, q_, negm); ATT_MFMA_C(sA1, k1_, q_, negm); } else { ATT_MFMA(sA0, k0_, q_); ATT_MFMA(sA1, k1_, q_); } } } while (0)
                f32x16 o0, o1, sA0, sA1, negm;
#pragma unroll
                for (int r = 0; r < 16; ++r) { o0[r] = 0.f; o1[r] = 0.f; negm[r] = 0.f; }
                float m_ref = 0.f, l_run = 0.f;
                ATT_LOAD(0); ATT_WRITE(0);
                if (ntile > 1) { ATT_LOAD(1); ATT_WRITE(1); }
                __syncthreads();
                ATT_QK(0);
                for (int t = 0; t < ntile; ++t) {
                    __syncthreads();
                    if (t + 2 < ntile) ATT_LOAD(t + 2);
                    if (t < ntw) {
                        asm volatile("s_nop 15\n\ts_nop 7" ::: "memory");
                        f32x16 s0 = sA0, s1 = sA1;
                        asm volatile("" : "+v"(s0), "+v"(s1));
                        if (t * 64 + 63 > q0) {
                            const int qi = q0 + r32;
#pragma unroll
                            for (int r = 0; r < 16; ++r) { const int key = t * 64 + crow(r, hi); if (key > qi) s0[r] = -INFINITY; if (key + 32 > qi) s1[r] = -INFINITY; }
                        }
                        float mx;
                        { auto max3 = [](float a_, float b_, float c_) { float r_; asm("v_max3_f32 %0, %1, %2, %3" : "=v"(r_) : "v"(a_), "v"(b_), "v"(c_)); return r_; };
                          float ma = max3(s0[0], s0[1], s1[0]), mb = max3(s0[2], s0[3], s1[1]); ma = max3(ma, s1[2], s1[3]);
#pragma unroll
                          for (int r = 4; r < 16; r += 4) { ma = max3(ma, s0[r], s0[r + 1]); mb = max3(mb, s0[r + 2], s0[r + 3]); ma = max3(ma, s1[r], s1[r + 1]); mb = max3(mb, s1[r + 2], s1[r + 3]); }
                          mx = max3(ma, mb, ma); mx = max3(mx, __shfl_xor(mx, 32), mx); }
                        if (__any(mx > 8.0f) || t == 0) {
                            const float dl = (t == 0) ? mx : fmaxf(mx, 0.f);
                            const float alpha = __builtin_amdgcn_exp2f(-dl);
                            m_ref += dl; l_run *= alpha;
#pragma unroll
                            for (int r = 0; r < 16; ++r) { s0[r] -= dl; s1[r] -= dl; }
                            if (t > 0) {
#pragma unroll
                                for (int r = 0; r < 16; ++r) { o0[r] *= alpha; o1[r] *= alpha; }
                            }
#pragma unroll
                            for (int r = 0; r < 16; ++r) negm[r] = -m_ref;
                        }
                        const bool doqk = t + 1 < ntw;
                        const unsigned char* Vs_ = Vr + (t % 3) * (64 * 136);
                        const unsigned char* Ks_ = Kr + ((t + 1) % 3) * (64 * 208);
                        typedef float f32x2_ __attribute__((ext_vector_type(2)));
                        f32x2_ ls2 = {0.f, 0.f};
#pragma unroll
                        for (int g4 = 0; g4 < 4; ++g4) {
                            const int kb = g4 >> 1, ks = g4 & 1;
                            u32x4 w;
                            if (kb == 0) {
#pragma unroll
                                for (int r = 0; r < 8; ++r) s0[8 * ks + r] = __builtin_amdgcn_exp2f(s0[8 * ks + r]);
#pragma unroll
                                for (int r = 0; r < 8; r += 2) ls2 += (f32x2_){s0[8 * ks + r], s0[8 * ks + r + 1]};
                                w.x = pk2(s0[8 * ks + 0], s0[8 * ks + 1]); w.y = pk2(s0[8 * ks + 2], s0[8 * ks + 3]); w.z = pk2(s0[8 * ks + 4], s0[8 * ks + 5]); w.w = pk2(s0[8 * ks + 6], s0[8 * ks + 7]);
                            } else {
#pragma unroll
                                for (int r = 0; r < 8; ++r) s1[8 * ks + r] = __builtin_amdgcn_exp2f(s1[8 * ks + r]);
#pragma unroll
                                for (int r = 0; r < 8; r += 2) ls2 += (f32x2_){s1[8 * ks + r], s1[8 * ks + r + 1]};
                                w.x = pk2(s1[8 * ks + 0], s1[8 * ks + 1]); w.y = pk2(s1[8 * ks + 2], s1[8 * ks + 3]); w.z = pk2(s1[8 * ks + 4], s1[8 * ks + 5]); w.w = pk2(s1[8 * ks + 6], s1[8 * ks + 7]);
                            }
                            const bf16x8 pfg = __builtin_bit_cast(bf16x8, w);
                            const int koff = (kb * 32 + 16 * ks + 4 * hi) * 2;
#pragma unroll
                            for (int dvb = 0; dvb < 2; ++dvb) {
                                const unsigned char* vp = Vs_ + (dvb * 32 + r32) * 136 + koff;
                                const u32x2 lo = *(const u32x2*)vp, hi2 = *(const u32x2*)(vp + 16);
                                u32x4 wv; wv.x = lo.x; wv.y = lo.y; wv.z = hi2.x; wv.w = hi2.y;
                                const bf16x8 vf = __builtin_bit_cast(bf16x8, wv);
                                if (dvb == 0) ATT_MFMA(o0, vf, pfg); else ATT_MFMA(o1, vf, pfg);
                                __builtin_amdgcn_sched_barrier(0);
                            }
                            if (doqk) {
#pragma unroll
                                for (int q3 = 0; q3 < 3; ++q3) {
                                    const int qi3 = g4 * 3 + q3, d0 = qi3 >> 1, kq = qi3 & 1;
                                    const bf16x8 k_ = *(const bf16x8*)(Ks_ + (kq * 32 + r32) * 208 + d0 * 32 + hi * 16);
                                    const bf16x8 q_ = *(const bf16x8*)(Qs + d0 * 32 + hi * 16);
                                    if (kq == 0) { if (d0 == 0) ATT_MFMA_C(sA0, k_, q_, negm); else ATT_MFMA(sA0, k_, q_); }
                                    else         { if (d0 == 0) ATT_MFMA_C(sA1, k_, q_, negm); else ATT_MFMA(sA1, k_, q_); }
                                    __builtin_amdgcn_sched_barrier(0);
                                }
                            }
                            __builtin_amdgcn_sched_barrier(0);
                        }
                        l_run += ls2.x + ls2.y;
                    }
                    if (t + 2 < ntile) ATT_WRITE(t + 2);
                }
                asm volatile("s_nop 15\n\ts_nop 7" ::: "memory");
                l_run += __shfl_xor(l_run, 32);
                const float rl = __builtin_amdgcn_rcpf(l_run);
                const int b = bh >> 3, h = bh & 7;
                bf16_t* orow = MIXIN + ((size_t)b * S + q0 + r32) * 1024 + h * 64;
#pragma unroll
                for (int rg = 0; rg < 4; ++rg) {
                    u32x2 a; a.x = pk2(o0[4 * rg] * rl, o0[4 * rg + 1] * rl); a.y = pk2(o0[4 * rg + 2] * rl, o0[4 * rg + 3] * rl);
                    *(u32x2*)(orow + 8 * rg + 4 * hi) = a;
                    u32x2 c2; c2.x = pk2(o1[4 * rg] * rl, o1[4 * rg + 1] * rl); c2.y = pk2(o1[4 * rg + 2] * rl, o1[4 * rg + 3] * rl);
                    *(u32x2*)(orow + 32 + 8 * rg + 4 * hi) = c2;
                }
            }
#undef ATT_MFMA_C
#undef ATT_MFMA
#undef ATT_LOAD
#undef ATT_WRITE
#undef ATT_QK
            __syncthreads();
            {
                S5Order so; so.G = G; so.c = vb;
                auto f = [=](const pg8::Unit& u, const pg8::NoCtx&, int ai, int m, int bj, int r, int c, f32x4 v0, f32x4 v1) {
                        const int g = u.aux, mr = (u.pm & 1) * 256 + r, b = mr >> 6, ck = mr & 63;
#pragma unroll
                        for (int h = 0; h < 2; ++h) {
                            const int n = u.pn * 256 + c + 16 * h; const f32x4 v = h ? v1 : v0;
                            const int tq = n >> 4, i = n & 15;
                            const u32x2 uu = *(const u32x2*)(AS5 + ((size_t)g * 512 + mr) * 1152 + 128 + n);
                            const f32x4 dd = *(const f32x4*)(s5d + g * 16 + i);
                            const float y0 = v.x + dd.x * __uint_as_float(uu.x << 16), y1 = v.y + dd.y * __uint_as_float(uu.x & 0xffff0000u),
                                        y2 = v.z + dd.z * __uint_as_float(uu.y << 16), y3 = v.w + dd.w * __uint_as_float(uu.y & 0xffff0000u);
                            u32x2 o; o.x = pk2(gelu_tanh(y0), gelu_tanh(y1)); o.y = pk2(gelu_tanh(y2), gelu_tanh(y3));
                            *(u32x2*)(GACT + ((size_t)b * S + ck * 64 + tq) * 512 + g * 16 + i) = o;
                        }
                    };
                const int tid2 = wbase + lane_id();
                pg8::gemm_phase(tid2, (PG8_LAS unsigned char*)lds, pg8::Gemm{AS5, BT_MAIN, 1152, 1152, 1152}, so, pg8::make_epi(pg8::NoPre{}, f));
            }
        }
        else if (ph == 7) {
            {
                DenseOrder so; so.go.init(T / 256, 2, G, vb);
                auto f = [=](const pg8::Unit& u, const pg8::NoCtx&, int ai, int m, int bj, int r, int c, f32x4 v0, f32x4 v1) {
                        const int row = u.pm * 256 + r, col = u.pn * 256 + c;
                        float gv[8]; unpack8(*(const u32x4*)(GACT + (size_t)row * 512 + col), gv);
                        const f32x4 b0 = *(const f32x4*)(glub + col), b1 = *(const f32x4*)(glub + col + 4);
                        u32x4 o; o.x = pk2(gv[0] * sigmoidf_(v0.x + b0.x), gv[1] * sigmoidf_(v0.y + b0.y)); o.y = pk2(gv[2] * sigmoidf_(v0.z + b0.z), gv[3] * sigmoidf_(v0.w + b0.w));
                        o.z = pk2(gv[4] * sigmoidf_(v1.x + b1.x), gv[5] * sigmoidf_(v1.y + b1.y)); o.w = pk2(gv[6] * sigmoidf_(v1.z + b1.z), gv[7] * sigmoidf_(v1.w + b1.w));
                        *(u32x4*)(MIXIN + (size_t)row * 1024 + 512 + col) = o;
                    };
                pg8::gemm_phase<false, false, true>(tid, (PG8_LAS unsigned char*)lds, pg8::Gemm{GACT, W_GLU, 512, 512, 512}, so, pg8::make_epi_perm(pg8::NoPre{}, f));
            }
        }
        else if (ph == 8 || ph == 16) {
            const int lyr = (ph == 8) ? 0 : 1;
            const bf16_t* W = lyr ? W_OUT_O : W_OUT_E;

            {
                DenseOrder so; so.go.init(T / 256, 4, G, vb);
                struct OCtx { f32x4 gm[2][2]; };
                struct OG { u32x4 x[2][2]; };
                auto pre = [=](const pg8::Unit& u, int wr, int wc, int fr, int fq, const PG8_LAS unsigned char* cxl) {
                        OCtx cx; const int b = (u.pm * 256) / S; const float* gm = MOD + ((size_t)lyr * NB + b) * 6144 + 2 * D;
#pragma unroll
                        for (int bj = 0; bj < 2; ++bj)
#pragma unroll
                            for (int h = 0; h < 2; ++h) cx.gm[bj][h] = *(const f32x4*)(gm + u.pn * 256 + bj * 128 + wc * 32 + 4 * fq + 16 * h);
                        return cx; };
                auto gp = [=](const pg8::Unit& u, const OCtx&, int r, int wc, int fq) {
                        OG g; const int row = u.pm * 256 + r;
#pragma unroll
                        for (int bj = 0; bj < 2; ++bj)
#pragma unroll
                            for (int h = 0; h < 2; ++h) { const int col = u.pn * 256 + bj * 128 + wc * 32 + 4 * fq + 16 * h;
                                if (lyr == 0) g.x[bj][h] = *(const u32x4*)(XIN + (size_t)row * D + col);
                                else { const u32x2 xx = *(const u32x2*)(XR + (size_t)row * D + col); g.x[bj][h] = (u32x4){xx.x, xx.y, 0u, 0u}; } }
                        return g; };
                auto f = [=](const pg8::Unit& u, const OCtx& cx, const OG& g, int ai, int m, int bj, int r, int c, f32x4 v0, f32x4 v1) {
                        const int row = u.pm * 256 + r;
#pragma unroll
                        for (int h = 0; h < 2; ++h) {
                            const int col = u.pn * 256 + c + 16 * h; const f32x4 v = h ? v1 : v0;
                            const f32x4 g4 = cx.gm[bj][h]; const u32x4 xx = g.x[bj][h]; f32x4 xs;
                            if (lyr == 0) { xs.x = __uint_as_float(xx.x); xs.y = __uint_as_float(xx.y); xs.z = __uint_as_float(xx.z); xs.w = __uint_as_float(xx.w); }
                            else { xs.x = __uint_as_float(xx.x << 16); xs.y = __uint_as_float(xx.x & 0xffff0000u); xs.z = __uint_as_float(xx.y << 16); xs.w = __uint_as_float(xx.y & 0xffff0000u); }
                            u32x2 o; o.x = pk2(xs.x + g4.x * v.x, xs.y + g4.y * v.y); o.y = pk2(xs.z + g4.z * v.z, xs.w + g4.w * v.w);
                            *(u32x2*)(XR + (size_t)row * D + col) = o;
                        }
                    };
                pg8::gemm_phase(tid, (PG8_LAS unsigned char*)lds, pg8::Gemm{MIXIN, W, D, D, D}, so, pg8::make_epi_g(pre, gp, f));
            }
        }
        else if (mph == 9) {
            const bf16_t* W = W_RT + (size_t)layer * 128 * 1024;
            const float* rb = rtb_all + layer * 32;
            float* lgs = (float*)(lds + 40960);
            unsigned* hist = (unsigned*)(lds + 40960 + 128 * 33 * 4);
            unsigned* gcnt = ctl + CW_CNT + layer * 64;
            const float* ng = kp->norm_ffn_g + layer * D;
            for (int tile = vb; tile < T / 128; tile += G) {
              for (int rep_ = 0; rep_ <= PROBE_RT2; ++rep_) {
                if (rep_) __syncthreads();
                for (int i = 0; i < 16; i += 2) {
                    u32x4 xr[2][2];
#pragma unroll
                    for (int q = 0; q < 2; ++q)
#pragma unroll
                        for (int j = 0; j < 2; ++j) xr[q][j] = *(const u32x4*)(XR + (size_t)(tile * 128 + wave * 16 + i + q) * D + 8 * lane + 512 * j);
#pragma unroll
                    for (int q = 0; q < 2; ++q) {
                        const int row = tile * 128 + wave * 16 + i + q, b = row / S;
                        float v[2][8]; unpack8(xr[q][0], v[0]); unpack8(xr[q][1], v[1]);
                        const float* mm = MOD + ((size_t)layer * NB + b) * 6144 + 3 * D;
                        norm_mod_store8(v, ng, mm + D, mm, HB + (size_t)row * D, HB8 + (size_t)row * D, lane);
                    }
                }
                if (tid < 64) hist[tid] = 0u;
                asm volatile("s_waitcnt vmcnt(0)" ::: "memory");
                __syncthreads();
                sg_tile(tid, lds, HB + (size_t)tile * 128 * D, D, W, D, D,
                    [=](int r, int c, f32x4 v0, f32x4 v1) {
                        if (c < 32) {
#pragma unroll
                            for (int i = 0; i < 4; ++i) { lgs[r * 33 + c + i] = v0[i] + rb[c + i]; lgs[r * 33 + c + 16 + i] = v1[i] + rb[c + 16 + i]; }
                        }
                    });
              }
                __syncthreads();
                const bool act = tid < 128; const int rr = tid & 127;
                float lg[32];
#pragma unroll
                for (int e = 0; e < 32; ++e) lg[e] = lgs[rr * 33 + e];
                int e0 = 0, e1 = 0, e2 = 0, e3 = 0; float v0_ = 0.f, v1_ = 0.f, v2_ = 0.f, v3_ = 0.f;
#pragma unroll
                for (int k = 0; k < 4; ++k) {
                    float best = -INFINITY; int bi = 0;
#pragma unroll
                    for (int e = 0; e < 32; ++e) { const bool tk = lg[e] > best; best = tk ? lg[e] : best; bi = tk ? e : bi; }
                    if (k == 0) { e0 = bi; v0_ = best; } else if (k == 1) { e1 = bi; v1_ = best; } else if (k == 2) { e2 = bi; v2_ = best; } else { e3 = bi; v3_ = best; }
#pragma unroll
                    for (int e = 0; e < 32; ++e) lg[e] = (e == bi) ? -INFINITY : lg[e];
                }
                const float x1_ = __expf(v1_ - v0_), x2_ = __expf(v2_ - v0_), x3_ = __expf(v3_ - v0_);
                const float rden = 1.0f / (1.0f + x1_ + x2_ + x3_);
                unsigned l0 = 0, l1 = 0, l2 = 0, l3 = 0;
                if (act) { l0 = atomicAdd(hist + e0, 1u); l1 = atomicAdd(hist + e1, 1u); l2 = atomicAdd(hist + e2, 1u); l3 = atomicAdd(hist + e3, 1u); }
                __syncthreads();
                if (tid < 32) hist[32 + tid] = atomicAdd(gcnt + tid, (unsigned)hist[tid]);
                __syncthreads();
                if (act) {
                    const int tok = tile * 128 + tid;
                    size_t idx = (size_t)e0 * T + hist[32 + e0] + l0; EL_SLOT[idx] = tok * 4 + 0; EL_GATE[idx] = rden;
                    idx = (size_t)e1 * T + hist[32 + e1] + l1; EL_SLOT[idx] = tok * 4 + 1; EL_GATE[idx] = x1_ * rden;
                    idx = (size_t)e2 * T + hist[32 + e2] + l2; EL_SLOT[idx] = tok * 4 + 2; EL_GATE[idx] = x2_ * rden;
                    idx = (size_t)e3 * T + hist[32 + e3] + l3; EL_SLOT[idx] = tok * 4 + 3; EL_GATE[idx] = x3_ * rden;
                }
                __syncthreads();
            }
        }
        else if (mph == 10 || mph == 11) {
            int* pst = (int*)(lds + LDS_MISC + 1024);
            if (tid == 0) {
                const unsigned* gcnt = ctl + CW_CNT + layer * 64; int acc = 0;
                for (int e = 0; e < 32; ++e) { const int c = (int)gcnt[e]; pst[e] = acc; pst[64 + e] = c; acc += (c + 255) & ~255; }
                pst[32] = acc;
            }
            __syncthreads();
            const int total_rows = pst[32];
            if (mph == 10) {
                {
                    MoeOrder so; so.go.init(total_rows >> 8, 8, G, vb); so.pst = pst; so.NT = 8; so.ebase = layer * 32; so.el_slot = EL_SLOT;
                    struct G1Ctx { f32x4 b0[2], b1[2]; };
                    auto pre = [=](const pg8::Unit& u, int wr, int wc, int fr, int fq, const PG8_LAS unsigned char* cxl) {
                            G1Ctx cx;
#pragma unroll
                            for (int bj = 0; bj < 2; ++bj) { const int jl = (bj * 4 + wc) * 16 + 4 * fq;
                                cx.b0[bj] = *(const PG8_LAS f32x4*)(cxl + jl * 4); cx.b1[bj] = *(const PG8_LAS f32x4*)(cxl + 512 + jl * 4); }
                            return cx; };
                    auto stg = [=](const pg8::Unit& u, PG8_LAS unsigned char* cb, int wid, int lane) {
                            if (wid == 0) { const float* src = bgu_all + (size_t)(layer * 32 + u.aux) * 2048 + (lane >> 5) * 1024 + u.pn * 128 + (lane & 31) * 4;
                                __builtin_amdgcn_global_load_lds((const unsigned*)src, (PG8_LAS unsigned*)cb, 16, 0, 0); } };
                    auto f = [=](const pg8::Unit& u, const G1Ctx& cx, int ai, int m, int bj, int tr, int c, f32x4 v0, f32x4 v1, PG8_LAS unsigned char* tile) {
                            const int jl = (c >> 5) * 16 + (c & 15);
                            const f32x4 b0 = cx.b0[bj], b1 = cx.b1[bj];
                            typedef float f32x2 __attribute__((ext_vector_type(2)));
                            float o[4];
#pragma unroll
                            for (int q = 0; q < 2; ++q) {
                                f32x2 gt = (f32x2){v0[2 * q], v0[2 * q + 1]} + (f32x2){b0[2 * q], b0[2 * q + 1]};
                                f32x2 ln = (f32x2){v1[2 * q], v1[2 * q + 1]} + (f32x2){b1[2 * q], b1[2 * q + 1]};
                                gt.x = __builtin_amdgcn_fmed3f(gt.x, -INFINITY, 7.0f); gt.y = __builtin_amdgcn_fmed3f(gt.y, -INFINITY, 7.0f);
                                ln.x = __builtin_amdgcn_fmed3f(ln.x, -7.0f, 7.0f); ln.y = __builtin_amdgcn_fmed3f(ln.y, -7.0f, 7.0f);
                                const f32x2 t = gt * (-1.702f * 1.4426950408889634f);
                                f32x2 e; e.x = __builtin_amdgcn_exp2f(t.x); e.y = __builtin_amdgcn_exp2f(t.y);
                                const f32x2 d = e + 1.0f;
                                f32x2 r; r.x = __builtin_amdgcn_rcpf(d.x); r.y = __builtin_amdgcn_rcpf(d.y);
                                const f32x2 ov = (gt * r) * (ln + 1.0f);
                                o[2 * q] = ov.x; o[2 * q + 1] = ov.y;
                            }
                            *(PG8_LAS unsigned*)(tile + tr * 144 + jl) = pk4_fp8(o[0], o[1], o[2], o[3]);
                        };
                    auto fl = [=](const pg8::Unit& u, const G1Ctx&, int ai, int m0, int tid_, PG8_LAS unsigned char* tile) {
                            const int tr = tid_ >> 3, piece = tid_ & 7;
                            const u32x4 v = *(const PG8_LAS u32x4*)(tile + tr * 144 + piece * 16);
                            const int row = u.pm * 256 + ai * 128 + ((tr >> 4) & 1) * 64 + (m0 + (tr >> 5)) * 16 + (tr & 15);
                            *(u32x4*)(ACT + (size_t)row * D + u.pn * 128 + piece * 16) = v;
                        };
                    pg8::gemm_phase<true, true>(tid, (PG8_LAS unsigned char*)lds, pg8::Gemm{(const bf16_t*)HB8, (const bf16_t*)W_GU, 512, 512, 512}, so, pg8::make_epi_staged<2, 9216>(pre, f, fl), stg, LDS_CTX_OFF);
                }
            } else {
                {
                    MoeOrder so; so.go.init(total_rows >> 8, 4, G, vb); so.pst = pst; so.NT = 4; so.ebase = layer * 32; so.el_slot = EL_SLOT;
                    struct G2Ctx { float gate[8]; int slot[8]; f32x4 bb[2][2]; };
                    auto pre = [=](const pg8::Unit& u, int wr, int wc, int fr, int fq, const PG8_LAS unsigned char* cxl) {
                            G2Ctx cx;
                            const int ro0 = u.pm * 256 - pst[u.aux], cnt = pst[64 + u.aux];
#pragma unroll
                            for (int q = 0; q < 8; ++q) { const int rl = (q >> 2) * 128 + wr * 64 + (q & 3) * 16 + fr; const bool ok = ro0 + rl < cnt;
                                const float gv = *(const PG8_LAS float*)(cxl + 1024 + rl * 4); const int sv = *(const PG8_LAS int*)(cxl + 2048 + rl * 4);
                                cx.gate[q] = ok ? gv : 0.f; cx.slot[q] = ok ? sv : -1; }
#pragma unroll
                            for (int bj = 0; bj < 2; ++bj)
#pragma unroll
                                for (int h = 0; h < 2; ++h) cx.bb[bj][h] = *(const PG8_LAS f32x4*)(cxl + (bj * 128 + wc * 32 + 8 * fq + 4 * h) * 4);
                            return cx; };
                    auto stg = [=](const pg8::Unit& u, PG8_LAS unsigned char* cb, int wid, int lane) {
                            const size_t eo = (size_t)u.aux * T + (u.pm * 256 - pst[u.aux]) + lane * 4;
                            if (wid == 0) __builtin_amdgcn_global_load_lds((const unsigned*)(bdn_all + (size_t)(layer * 32 + u.aux) * 1024 + u.pn * 256 + lane * 4), (PG8_LAS unsigned*)cb, 16, 0, 0);
                            else if (wid == 1) __builtin_amdgcn_global_load_lds((const unsigned*)(EL_GATE + eo), (PG8_LAS unsigned*)(cb + 1024), 16, 0, 0);
                            else if (wid == 2) __builtin_amdgcn_global_load_lds((const unsigned*)(EL_SLOT + eo), (PG8_LAS unsigned*)(cb + 2048), 16, 0, 0); };
                    auto f = [=](const pg8::Unit& u, const G2Ctx& cx, int ai, int m, int bj, int r, int c8, f32x4 v0, f32x4 v1) {
                            const int slot = cx.slot[ai * 4 + m];
                            if (slot >= 0) {
                                const float gt = cx.gate[ai * 4 + m] * 16.0f; const f32x4 b0 = cx.bb[bj][0], b1 = cx.bb[bj][1];
                                u32x2 o; o.x = pk4_fp8((v0.x + b0.x) * gt, (v0.y + b0.y) * gt, (v0.z + b0.z) * gt, (v0.w + b0.w) * gt);
                                o.y = pk4_fp8((v1.x + b1.x) * gt, (v1.y + b1.y) * gt, (v1.z + b1.z) * gt, (v1.w + b1.w) * gt);
                                *(u32x2*)(Y + (size_t)slot * D + u.pn * 256 + c8) = o;
                            }
                        };
                    pg8::gemm_phase<true, false, true>(tid, (PG8_LAS unsigned char*)lds, pg8::Gemm{(const bf16_t*)ACT, (const bf16_t*)W_DN, 512, 512, 512}, so, pg8::make_epi_perm(pre, f), stg, LDS_CTX_OFF);
                }
            }
        }
        else if (ph == 13) {
            {
                DenseOrder so; so.go.init(T / 256, 6, G, vb);
                auto f = [=](const pg8::Unit& u, const pg8::NoCtx&, int ai, int m, int bj, int r, int c, f32x4 v0, f32x4 v1) {
                        const int row = u.pm * 256 + r, col = u.pn * 256 + c;
                        if (col >= 512) { v0.x = gelu_tanh(v0.x); v0.y = gelu_tanh(v0.y); v0.z = gelu_tanh(v0.z); v0.w = gelu_tanh(v0.w); v1.x = gelu_tanh(v1.x); v1.y = gelu_tanh(v1.y); v1.z = gelu_tanh(v1.z); v1.w = gelu_tanh(v1.w); }
                        u32x4 o; o.x = pk2(v0.x, v0.y); o.y = pk2(v0.z, v0.w); o.z = pk2(v1.x, v1.y); o.w = pk2(v1.z, v1.w);
                        *(u32x4*)(Z + (size_t)row * 1536 + col) = o;
                    };
                pg8::gemm_phase<false, false, true>(tid, (PG8_LAS unsigned char*)lds, pg8::Gemm{HB, W_IN_O, D, D, D}, so, pg8::make_epi_perm(pg8::NoPre{}, f));
            }
        }
        else if (ph == 14) {
            for (int ck = vb; ck < T / 128; ck += G) {
                bf16_t* tile = (bf16_t*)lds;
                {
                    const int ch0 = lane * 8, w = 2 << (ch0 >> 7);
                    const int row0 = ck * 128 + wave * 16, t0 = row0 % S;
                    float gsg[8];
#pragma unroll
                    for (int i = 0; i < 8; ++i) gsg[i] = kp->sgu_norm_g[lane * 8 + i];
                    float run[8];
#pragma unroll
                    for (int i = 0; i < 8; ++i) run[i] = 0.f;
                    for (int q = 1; q <= w; ++q) {
                        if (t0 - q >= 0) { float f[8]; unpack8(*(const u32x4*)(Z + (size_t)(row0 - q) * 1536 + ch0), f);
#pragma unroll
                            for (int i = 0; i < 8; ++i) run[i] += f[i]; }
                    }
                    u32x4 cu, cl, cz, nu, nl, nz;
#define P14_LOAD(r_, t_, U_, L_, Z_) do { U_ = *(const u32x4*)(Z + (size_t)(r_) * 1536 + ch0); L_ = ((t_) - w >= 0) ? *(const u32x4*)(Z + (size_t)((r_) - w) * 1536 + ch0) : (u32x4){0u, 0u, 0u, 0u}; \
                        Z_ = *(const u32x4*)(Z + (size_t)(r_) * 1536 + 1024 + lane * 8); } while (0)
                    P14_LOAD(row0, t0, cu, cl, cz);
                    for (int tt = 0; tt < 16; ++tt) {
                        const int sl = wave * 16 + tt, row = row0 + tt, t = t0 + tt;
                        if (tt + 1 < 16) P14_LOAD(row + 1, t + 1, nu, nl, nz);
                        float own[8], old[8];
                        unpack8(cu, own); unpack8(cl, old);
#pragma unroll
                        for (int i = 0; i < 8; ++i) run[i] += own[i] - old[i];
                        const int n = (t + 1 < w) ? t + 1 : w;
                        const float inv = 1.0f / (float)n;
                        float po[8];
#pragma unroll
                        for (int i = 0; i < 8; ++i) po[i] = run[i] * inv - own[i];
                        *(u32x4*)(POOLED + (size_t)row * 512 + ch0) = pack8(po);
                        float f[8]; unpack8(cz, f);
                        float ss = 0.f;
#pragma unroll
                        for (int i = 0; i < 8; ++i) ss += f[i] * f[i];
                        const float rr = rsqrtf(wave_sum(ss) * (1.f / 512.f) + 1e-6f);
#pragma unroll
                        for (int i = 0; i < 8; ++i) f[i] *= rr * gsg[i];
                        *(u32x4*)(tile + sl * 520 + lane * 8) = pack8(f);
                        cu = nu; cl = nl; cz = nz;
                    }
#undef P14_LOAD
                }
                __syncthreads();
                {
                    const int ch = tid;
                    bf16_t* dst = VTS + ((size_t)ck * 512 + ch) * 128;
                    for (int s8 = 0; s8 < 16; ++s8) {
                        unsigned w[4];
#pragma unroll
                        for (int i = 0; i < 4; ++i) w[i] = (unsigned)tile[(s8 * 8 + 2 * i) * 520 + ch] | ((unsigned)tile[(s8 * 8 + 2 * i + 1) * 520 + ch] << 16);
                        u32x4 o; o.x = w[0]; o.y = w[1]; o.z = w[2]; o.w = w[3];
                        *(u32x4*)(dst + s8 * 8) = o;
                    }
                }
                asm volatile("s_waitcnt vmcnt(0)" ::: "memory");
                __syncthreads();
                sg128_stream(tid, lds, 0, 1, 8,
                    [=](int q8, const bf16_t*& A, int& lda, const bf16_t*& Bt, int& ldb) {
                        if (q8 < 4) { A = POOLED + (size_t)ck * 128 * 512 + q8 * 128; lda = 512; Bt = W_POOL + (size_t)q8 * 128 * 128; ldb = 128; }
                        else { const int h4 = q8 - 4; A = W_SGU + (size_t)h4 * 128 * 128; lda = 128; Bt = VTS + ((size_t)ck * 512 + h4 * 128) * 128; ldb = 128; } },
                    [=](int q8, int rb, int c, Sg128Side& sd) {
#pragma unroll
                        for (int m = 0; m < 4; ++m) {
                            if (q8 < 4) { sd.b[m] = 0.f; sd.a[m][0] = (u32x2){0u, 0u}; sd.a[m][1] = (u32x2){0u, 0u}; }
                            else { const int h4 = q8 - 4, r = rb + 16 * m; sd.b[m] = sgub[h4 * 128 + r];
                                sd.a[m][0] = *(const u32x2*)(Z + (size_t)(ck * 128 + r) * 1536 + 512 + h4 * 128 + c); sd.a[m][1] = *(const u32x2*)(Z + (size_t)(ck * 128 + r) * 1536 + 512 + h4 * 128 + c + 16); }
                        } },
                    [=](int q8, int m, int r, int c, f32x4 v0, f32x4 v1, const Sg128Side& sd) {
                        const int row = ck * 128 + r;
                        if (q8 < 4) {
                            const int gi = q8;
#pragma unroll
                            for (int h = 0; h < 2; ++h) {
                                const int col = gi * 128 + c + 16 * h; const f32x4 v = h ? v1 : v0;
                                const f32x4 sc = *(const f32x4*)(poolsc + col);
                                u32x2 o; o.x = pk2(v.x * sc.x, v.y * sc.y); o.y = pk2(v.z * sc.z, v.w * sc.w);
                                *(u32x2*)(MIXIN + (size_t)row * 1024 + col) = o;
                            }
                        } else {
                            const int h4 = q8 - 4; const float bias = sd.b[m];
#pragma unroll
                            for (int h = 0; h < 2; ++h) {
                                const int dcol = c + 16 * h; const f32x4 v = h ? v1 : v0; const u32x2 ug = sd.a[m][h];
                                u32x2 o; o.x = pk2((v.x + bias) * __uint_as_float(ug.x << 16), (v.y + bias) * __uint_as_float(ug.x & 0xffff0000u));
                                o.y = pk2((v.z + bias) * __uint_as_float(ug.y << 16), (v.w + bias) * __uint_as_float(ug.y & 0xffff0000u));
                                *(u32x2*)(MIXIN + (size_t)row * 1024 + 512 + h4 * 128 + dcol) = o;
                            }
                        } });
                __syncthreads();
            }
        }

    }
}
template <int PH> struct PhaseSeq {
    static __device__ __forceinline__ void run(const XcdBarrier& bar) { PhaseSeq<PH - 1>::run(bar); if constexpr (PH == 3 || PH == 15) return;
        unsigned long long t0_ = 0; if constexpr (PH == PROBE_TPH) t0_ = __builtin_amdgcn_s_memrealtime();
        phase_body<PH>(bar.wbase);
        if constexpr (((PROBE_DUP_MASK >> PH) & 1ull) != 0) { xcd_barrier(bar); phase_body<PH>(bar.wbase); }
        if (PH + 1 < NPHASE) { xcd_barrier(bar); if constexpr (PROBE_BAR2) xcd_barrier(bar); }
        if constexpr (PH == PROBE_TPH) { if (bar.wbase == 0 && lane_id() == 0) { const unsigned dt = (unsigned)(__builtin_amdgcn_s_memrealtime() - t0_); bar.st[4] = dt; } }
    }
};
template <> struct PhaseSeq<-1> { static __device__ __forceinline__ void run(const XcdBarrier&) {} };

template <int PHSEL> __global__ void __launch_bounds__(NTHR, 2) hybrid_fwd(Params p) {
    extern __shared__ __attribute__((aligned(16))) unsigned char lds[];
    const int tid0 = threadIdx.x;
    for (int u = tid0; u < (LDS_BYTES - LDS_MISC) / 4; u += NTHR) ((unsigned*)(lds + LDS_MISC))[u] = 0u;
    __syncthreads();
    if constexpr (PHSEL >= 0) { phase_body<PHSEL>(__builtin_amdgcn_readfirstlane((int)threadIdx.x & ~63)); }
    else {
        volatile LAS unsigned* MISC = (volatile LAS unsigned*)((LAS unsigned char*)lds + LDS_MISC);
        unsigned* ctl0 = (unsigned*)(p.ws + WS_CTL);
        XcdBarrier bar = xcd_barrier_post(ctl0 + CW_BAR, MISC + 8);
        PhaseSeq<NPHASE - 1>::run(bar);
        if constexpr (PROBE_TPH >= 0 || PROBE_SEG != 0) { if (blockIdx.x == 0 && bar.wbase == 0 && lane_id() == 0) { const unsigned dt = MISC[12]; const unsigned long long te = __builtin_amdgcn_s_memrealtime(); while (__builtin_amdgcn_s_memrealtime() - te < 4ull * dt) __builtin_amdgcn_s_sleep(8); } }
    }
}

typedef void (*kfn_t)(Params);
template <int PH> struct Tab { static void fill(kfn_t* t) { t[PH] = hybrid_fwd<PH>; Tab<PH - 1>::fill(t); } };
template <> struct Tab<-1> { static void fill(kfn_t*) {} };
static kfn_t g_tab[NPHASE];
static void set_attrs() {
#if MK_ONE_LAUNCH
    (void)hipFuncSetAttribute((const void*)hybrid_fwd<-1>, hipFuncAttributeMaxDynamicSharedMemorySize, LDS_BYTES);
#else
    Tab<NPHASE - 1>::fill(g_tab);
    for (int i = 0; i < NPHASE; ++i) (void)hipFuncSetAttribute((const void*)g_tab[i], hipFuncAttributeMaxDynamicSharedMemorySize, LDS_BYTES);
#endif
}
#if !MK_ONE_LAUNCH
static void launch_all(const Params& p, int grid, hipStream_t stream) {
    for (int ph = 0; ph < NPHASE; ++ph) hipLaunchKernelGGL(g_tab[ph], dim3(grid), dim3(NTHR), LDS_BYTES, stream, p);
}
#endif
extern "C" void kernel_launch(void* const* d_in, const int* in_sizes, int n_in, void* d_out, int out_size, void* d_ws, size_t ws_size, hipStream_t stream) {
    static int ready = 0;
    if (ready == 0) {
        if (n_in != 38 || ws_size < WS_END) { fprintf(stderr, "kernel_launch: unexpected n_in %d / ws %zu\n", n_in, ws_size); ready = -1; return; }
        set_attrs();
        ready = 1;
    }
    if (ready < 0) return;
    (void)hipMemsetAsync((char*)d_ws + WS_CTL, 0, CTL_ZERO_BYTES, stream);
    Params p{};
    const float** fp = (const float**)&p.x;
    (void)fp;
    p.x = (const float*)d_in[0]; p.c = (const float*)d_in[1]; p.pos = (const int*)d_in[2];
    p.ada_w = (const float*)d_in[3]; p.ada_b = (const float*)d_in[4]; p.norm_mix_g = (const float*)d_in[5]; p.norm_ffn_g = (const float*)d_in[6];
    p.router_w = (const float*)d_in[7]; p.router_b = (const float*)d_in[8]; p.moe_w_gu = (const float*)d_in[9]; p.moe_b_gu = (const float*)d_in[10];
    p.moe_w_dn = (const float*)d_in[11]; p.moe_b_dn = (const float*)d_in[12];
    p.even_w_in = (const float*)d_in[13]; p.q_norm_g = (const float*)d_in[14]; p.w_uq = (const float*)d_in[15]; p.kv_norm_g = (const float*)d_in[16];
    p.w_ukv = (const float*)d_in[17]; p.q_head_g = (const float*)d_in[18]; p.k_head_g = (const float*)d_in[19];
    p.s5_a_re = (const float*)d_in[20]; p.s5_a_im = (const float*)d_in[21]; p.s5_log_dt = (const float*)d_in[22]; p.s5_b_re = (const float*)d_in[23];
    p.s5_b_im = (const float*)d_in[24]; p.s5_c_re = (const float*)d_in[25]; p.s5_c_im = (const float*)d_in[26]; p.s5_d = (const float*)d_in[27];
    p.s5_glu_w = (const float*)d_in[28]; p.s5_glu_b = (const float*)d_in[29]; p.even_w_out = (const float*)d_in[30];
    p.odd_w_in = (const float*)d_in[31]; p.pool_w = (const float*)d_in[32]; p.pool_scale = (const float*)d_in[33]; p.sgu_norm_g = (const float*)d_in[34];
    p.sgu_w = (const float*)d_in[35]; p.sgu_b = (const float*)d_in[36]; p.odd_w_out = (const float*)d_in[37];
    p.out = (float*)d_out; p.ws = (unsigned char*)d_ws;
    const int grid = 256;
#if MK_ONE_LAUNCH
    p.ph_lo = 0; p.ph_hi = NPHASE;
    hipLaunchKernelGGL(hybrid_fwd<-1>, dim3(grid), dim3(NTHR), LDS_BYTES, stream, p);
#else
    p.ph_lo = 0; p.ph_hi = 1;
    launch_all(p, grid, stream);
#endif
}
```

```cpp
#include <hip/hip_runtime.h>
#include <cstdio>
#include <cstdint>

#ifndef PROBE_DUP_MASK
#define PROBE_DUP_MASK 0x0ull
#endif
#ifndef PROBE_ATT2
#define PROBE_ATT2 0
#endif
#ifndef PROBE_RT2
#define PROBE_RT2 0
#endif
#ifndef PROBE_TPH
#define PROBE_TPH -1
#endif
#ifndef PROBE_SEG
#define PROBE_SEG 0
#endif
#ifndef PROBE_CONV2
#define PROBE_CONV2 0
#endif
#ifndef PROBE_BAR2
#define PROBE_BAR2 0
#endif
#ifndef PROBE_EPI2
#define PROBE_EPI2 0
#endif
#ifndef PROBE_KX2
#define PROBE_KX2 0
#endif
#ifndef MK_ONE_LAUNCH
#define MK_ONE_LAUNCH 1
#endif

typedef unsigned short bf16_t;
typedef short bf16x8 __attribute__((ext_vector_type(8)));
typedef short s16x4 __attribute__((ext_vector_type(4)));
typedef float f32x4 __attribute__((ext_vector_type(4)));
typedef float f32x16 __attribute__((ext_vector_type(16)));
typedef unsigned u32x4 __attribute__((ext_vector_type(4)));
typedef unsigned u32x2 __attribute__((ext_vector_type(2)));

constexpr int D = 1024, NB = 8, S = 4096, T = NB * S;
constexpr int NTHR = 512, NWAVE = 8;
constexpr int MOE_ROWS = 139264;
constexpr int NPHASE = 21;

constexpr size_t MiB = 1u << 20;
constexpr size_t WS_CTL = 0, CTL_ZERO_BYTES = 1 * MiB;
constexpr size_t WS_MOD = 1 * MiB;
constexpr size_t WS_S5AB = 2 * MiB;
constexpr size_t WS_PW = 3 * MiB;
constexpr size_t WS_KTAB = 5 * MiB;
constexpr size_t WS_TOK = 7 * MiB;
constexpr size_t WS_ROW = 9 * MiB;
constexpr size_t WS_LOGIT = 11 * MiB;
constexpr size_t WS_W_IN_E = 16 * MiB, WS_W_UP = 18 * MiB  , WS_W_GLU = 20 * MiB, WS_W_OUT_E = 21 * MiB, WS_W_IN_O = 23 * MiB,
                 WS_W_OUT_O = 26 * MiB, WS_W_POOL = 28 * MiB, WS_W_SGU = 29 * MiB, WS_W_RT = 30 * MiB;
constexpr size_t WS_BT_END = 32 * MiB;
constexpr size_t WS_BT_MAIN = 40 * MiB;
constexpr size_t WS_W_GU = 112 * MiB;
constexpr size_t WS_W_DN = 240 * MiB;
constexpr size_t WS_HB8 = 304 * MiB;
constexpr size_t WS_XR = 336 * MiB;
constexpr size_t WS_HB = 496 * MiB;
constexpr size_t WS_MIXIN = 560 * MiB;
constexpr size_t WS_Y = 624 * MiB;
constexpr size_t WS_EL = 880 * MiB;
constexpr size_t WS_ACT = 1152 * MiB;
constexpr size_t WS_END = 1424 * MiB;
constexpr size_t WS_Z = 880 * MiB;
constexpr size_t WS_RSP = 976 * MiB  , WS_QKVRAW = 1000 * MiB  , WS_Q = 1112 * MiB, WS_K = 1160 * MiB, WS_VT = 1208 * MiB,
                 WS_AS5 = 1240 * MiB, WS_LEND = 1276 * MiB, WS_GACT = 1284 * MiB;
constexpr size_t WS_POOLED = 976 * MiB, WS_VTS = 1008 * MiB;
constexpr int CW_BAR = 4096, CW_CNT = 16384, CW_Q = 16640  ;

constexpr int LDS_BYTES = 160 * 1024;
constexpr int LDS_CTX_OFF = 18432;
constexpr int LDS_MISC = 158 * 1024;

struct Params {
    const float *x, *c; const int* pos;
    const float *ada_w, *ada_b, *norm_mix_g, *norm_ffn_g, *router_w, *router_b, *moe_w_gu, *moe_b_gu, *moe_w_dn, *moe_b_dn;
    const float *even_w_in, *q_norm_g, *w_uq, *kv_norm_g, *w_ukv, *q_head_g, *k_head_g;
    const float *s5_a_re, *s5_a_im, *s5_log_dt, *s5_b_re, *s5_b_im, *s5_c_re, *s5_c_im, *s5_d, *s5_glu_w, *s5_glu_b, *even_w_out;
    const float *odd_w_in, *pool_w, *pool_scale, *sgu_norm_g, *sgu_w, *sgu_b, *odd_w_out;
    float* out; unsigned char* ws; int ph_lo, ph_hi;
};

__device__ __forceinline__ float bf2f(unsigned short b) { return __uint_as_float(((unsigned)b) << 16); }
__device__ __forceinline__ unsigned pk2(float lo, float hi) {
    typedef float f2 __attribute__((ext_vector_type(2))); typedef __bf16 b2 __attribute__((ext_vector_type(2)));
    f2 v = {lo, hi}; b2 b = __builtin_convertvector(v, b2); return __builtin_bit_cast(unsigned, b);
}
__device__ __forceinline__ unsigned short f2bf(float f) { return (unsigned short)(pk2(f, 0.f) & 0xffffu); }
__device__ __forceinline__ float wave_sum(float v) {
#pragma unroll
    for (int o = 1; o < 64; o <<= 1) v += __shfl_xor(v, o);
    return v;
}
__device__ __forceinline__ float sigmoidf_(float x) { return __builtin_amdgcn_rcpf(1.0f + __builtin_amdgcn_exp2f(-1.4426950408889634f * x)); }
__device__ __forceinline__ float gelu_tanh(float x) {
    const float u = 0.7978845608028654f * (x + 0.044715f * x * x * x);
    return x * sigmoidf_(2.0f * u);
}
__device__ __forceinline__ unsigned pk4_fp8(float a, float b, float c, float d) {
    int w = 0; w = __builtin_amdgcn_cvt_pk_fp8_f32(a, b, w, false); w = __builtin_amdgcn_cvt_pk_fp8_f32(c, d, w, true); return (unsigned)w;
}
__device__ __forceinline__ int crow(int r, int hi) { return (r & 3) + 8 * (r >> 2) + 4 * hi; }

#define LAS __attribute__((address_space(3)))
#define XB_TMO      128
#define XB_XCNT(j)  (256  + 64 * (j))
#define XB_XSUB(j)  (1280 + 64 * (j))
#define XB_XGEN(j)  (2304 + 64 * (j))
#define XB_TOP      3328
#define XB_TOPGEN   3392
#define XCD_BAR_WORDS 3456
#define XB_SPIN_CAP (1u << 20)
__device__ __forceinline__ unsigned xb_ld(unsigned* p)              { return __hip_atomic_load(p, __ATOMIC_RELAXED, __HIP_MEMORY_SCOPE_AGENT); }
__device__ __forceinline__ unsigned xb_add(unsigned* p, unsigned v) { return __hip_atomic_fetch_add(p, v, __ATOMIC_RELAXED, __HIP_MEMORY_SCOPE_AGENT); }
__device__ __forceinline__ unsigned xb_xcc_id() { return (unsigned)__builtin_amdgcn_s_getreg((3 << 11) | 20) & 0xFu; }
#define XB_SPIN(cond, bar) do { unsigned _sp = 0; while (cond) { __builtin_amdgcn_s_sleep(1); \
    if ((++_sp & 255u) == 0u) { if (xb_ld(&(bar)[XB_TMO])) break; if (_sp > XB_SPIN_CAP) { atomicAdd(&(bar)[XB_TMO], 1u); break; } } } } while (0)
struct XcdBarrier { unsigned* bar; unsigned x; volatile LAS unsigned* st; int wbase; };
__device__ __forceinline__ int lane_id() { int l; asm volatile("v_mbcnt_lo_u32_b32 %0, -1, 0\n\tv_mbcnt_hi_u32_b32 %0, -1, %0" : "=v"(l)); return l; }
__device__ __forceinline__ XcdBarrier xcd_barrier_post(unsigned* bar, volatile LAS unsigned* st) {
    XcdBarrier b; b.bar = bar; b.x = xb_xcc_id(); b.st = st; b.wbase = __builtin_amdgcn_readfirstlane((int)threadIdx.x & ~63);
    if (threadIdx.x == 0) (void)xb_add(&bar[XB_XCNT(b.x)], 1u);
    return b;
}
__device__ __forceinline__ void xcd_barrier_complete(unsigned* bar, unsigned x, unsigned& nloc, unsigned& nx) {
    const unsigned G = gridDim.x * gridDim.y * gridDim.z;
    unsigned sum, cnt, mine, sp = 0u;
    for (;;) {
        sum = 0u; cnt = 0u; mine = 0u;
#pragma unroll
        for (unsigned j = 0; j < 16; ++j) { const unsigned c = xb_ld(&bar[XB_XCNT(j)]); sum += c; cnt += (c > 0u) ? 1u : 0u; mine = (j == x) ? c : mine; }
        if (sum == G) break;
        __builtin_amdgcn_s_sleep(1);
        if ((++sp & 255u) == 0u) { if (xb_ld(&bar[XB_TMO])) break; if (sp > XB_SPIN_CAP) { atomicAdd(&bar[XB_TMO], 1u); break; } }
    }
    nloc = mine > 0u ? mine : 1u; nx = cnt > 0u ? cnt : 1u;
}
__device__ __forceinline__ void xcd_barrier(const XcdBarrier& b) {
    asm volatile("s_waitcnt vmcnt(0)" ::: "memory");
    __syncthreads();
    if (b.wbase == 0 && lane_id() == 0) {
        unsigned* bar = b.bar;
        __builtin_amdgcn_s_waitcnt(0);
        unsigned nloc = b.st[0], nx = b.st[1];
        if (nloc == 0u) { xcd_barrier_complete(bar, b.x, nloc, nx); b.st[0] = nloc; b.st[1] = nx; }
        const unsigned old = xb_add(&bar[XB_XSUB(b.x)], 1u);
        const unsigned gen = old / nloc;
        if (old + 1u == (gen + 1u) * nloc) {
            __builtin_amdgcn_fence(__ATOMIC_RELEASE, "agent");
            asm volatile("s_waitcnt vmcnt(0)" ::: "memory");
            const unsigned og = xb_add(&bar[XB_TOP], 1u);
            const unsigned tg = og / nx;
            if (og + 1u == (tg + 1u) * nx) xb_add(&bar[XB_TOPGEN], 1u);
            else XB_SPIN(xb_ld(&bar[XB_TOPGEN]) == tg, bar);
            __builtin_amdgcn_fence(__ATOMIC_ACQUIRE, "agent");
            xb_add(&bar[XB_XGEN(b.x)], 1u);
            asm volatile("s_waitcnt vmcnt(0)" ::: "memory");
        } else {
            XB_SPIN(xb_ld(&bar[XB_XGEN(b.x)]) == gen, bar);
            __builtin_amdgcn_fence(__ATOMIC_ACQUIRE, "agent");
            asm volatile("s_waitcnt vmcnt(0)" ::: "memory");
        }
    }
    __syncthreads();
}

constexpr int SG_LDS = 2 * 128 * 144;
template <class Epi>
__device__ __forceinline__ void sg_tile(int tid, unsigned char* lds, const bf16_t* A, int lda, const bf16_t* Bt, int ldb, int K, Epi epi) {
    const int lane = tid & 63, wid = tid >> 6, wr = wid >> 2, wc = wid & 3, fr = lane & 15, fq = lane >> 4;
    unsigned char* As = lds; unsigned char* Bs = lds + 128 * 144;
    f32x4 acc[4][2];
#pragma unroll
    for (int m = 0; m < 4; ++m)
#pragma unroll
        for (int n = 0; n < 2; ++n) acc[m][n] = (f32x4){0.f, 0.f, 0.f, 0.f};
    const int nt = K / 64;
    u32x4 ra[2], rb[2];
    const int r0 = tid >> 3, cc = tid & 7;
#pragma unroll
    for (int i = 0; i < 2; ++i) {
        ra[i] = *(const u32x4*)(A + (size_t)(r0 + 64 * i) * lda + cc * 8);
        rb[i] = *(const u32x4*)(Bt + (size_t)(r0 + 64 * i) * ldb + cc * 8);
    }
    for (int kt = 0; kt < nt; ++kt) {
        __syncthreads();
#pragma unroll
        for (int i = 0; i < 2; ++i) {
            *(u32x4*)(As + (r0 + 64 * i) * 144 + cc * 16) = ra[i];
            *(u32x4*)(Bs + (r0 + 64 * i) * 144 + cc * 16) = rb[i];
        }
        __syncthreads();
        if (kt + 1 < nt) {
#pragma unroll
            for (int i = 0; i < 2; ++i) {
                ra[i] = *(const u32x4*)(A + (size_t)(r0 + 64 * i) * lda + (kt + 1) * 64 + cc * 8);
                rb[i] = *(const u32x4*)(Bt + (size_t)(r0 + 64 * i) * ldb + (kt + 1) * 64 + cc * 8);
            }
        }
#pragma unroll
        for (int kk = 0; kk < 2; ++kk) {
            bf16x8 a[4], b[2];
#pragma unroll
            for (int m = 0; m < 4; ++m) a[m] = *(const bf16x8*)(As + (wr * 64 + m * 16 + fr) * 144 + kk * 64 + fq * 16);
#pragma unroll
            for (int n = 0; n < 2; ++n) b[n] = *(const bf16x8*)(Bs + (wc * 32 + n * 16 + fr) * 144 + kk * 64 + fq * 16);
#pragma unroll
            for (int m = 0; m < 4; ++m)
#pragma unroll
                for (int n = 0; n < 2; ++n) acc[m][n] = __builtin_amdgcn_mfma_f32_16x16x32_bf16(b[n], a[m], acc[m][n], 0, 0, 0);
        }
    }
#pragma unroll
    for (int m = 0; m < 4; ++m) epi(wr * 64 + m * 16 + fr, wc * 32 + fq * 4, acc[m][0], acc[m][1]);
}


struct Sg128Side { u32x2 a[4][2]; float b[4]; };
template <class Ptrs, class SideF, class Epi>
__device__ __forceinline__ void sg128_stream(int tid, unsigned char* lds, int u0, int ustride, int uend, Ptrs ptrs, SideF side, Epi epi) {
    const int lane = tid & 63, wid = tid >> 6, wr = wid >> 2, wc = wid & 3, fr = lane & 15, fq = lane >> 4;
    unsigned char* As = lds; unsigned char* Bs = lds + 128 * 272;
    u32x4 ra[4], rb[4]; Sg128Side sc;
    const int r0 = tid >> 4, cc = tid & 15;
    auto load = [&](int u) { const bf16_t* A; const bf16_t* Bt; int lda, ldb; ptrs(u, A, lda, Bt, ldb);
#pragma unroll
        for (int i = 0; i < 4; ++i) { ra[i] = *(const u32x4*)(A + (size_t)(r0 + 32 * i) * lda + cc * 8); rb[i] = *(const u32x4*)(Bt + (size_t)(r0 + 32 * i) * ldb + cc * 8); }
        };
    if (u0 < uend) load(u0);
    for (int u = u0; u < uend; u += ustride) {
        __syncthreads();
#pragma unroll
        for (int i = 0; i < 4; ++i) { *(u32x4*)(As + (r0 + 32 * i) * 272 + cc * 16) = ra[i]; *(u32x4*)(Bs + (r0 + 32 * i) * 272 + cc * 16) = rb[i]; }
        side(u, wr * 64 + fr, wc * 32 + fq * 4, sc);
        __syncthreads();
        if (u + ustride < uend) load(u + ustride);
        f32x4 acc[4][2];
#pragma unroll
        for (int m = 0; m < 4; ++m)
#pragma unroll
            for (int n = 0; n < 2; ++n) acc[m][n] = (f32x4){0.f, 0.f, 0.f, 0.f};
#pragma unroll 1
        for (int kk = 0; kk < 4; ++kk) {
            bf16x8 a[4], b[2];
#pragma unroll
            for (int m = 0; m < 4; ++m) a[m] = *(const bf16x8*)(As + (wr * 64 + m * 16 + fr) * 272 + kk * 64 + fq * 16);
#pragma unroll
            for (int n = 0; n < 2; ++n) b[n] = *(const bf16x8*)(Bs + (wc * 32 + n * 16 + fr) * 272 + kk * 64 + fq * 16);
#pragma unroll
            for (int m = 0; m < 4; ++m)
#pragma unroll
                for (int n = 0; n < 2; ++n) acc[m][n] = __builtin_amdgcn_mfma_f32_16x16x32_bf16(b[n], a[m], acc[m][n], 0, 0, 0);
        }
#pragma unroll
        for (int m = 0; m < 4; ++m) epi(u, m, wr * 64 + m * 16 + fr, wc * 32 + fq * 4, acc[m][0], acc[m][1], sc);
    }
}

namespace pg8 {
#define PG8_LAS __attribute__((address_space(3)))
constexpr int BM = 256, BK = 64, HALF = 128, HTB = HALF * BK * 2, STAGE_BYTES = 8 * HTB;
__device__ __forceinline__ int lds_byte(int r, int c) { const int st = (r >> 4) * 2 + (c >> 5), rr = r & 15, cc = c & 31, ob = rr * 64 + cc * 2; return st * 1024 + (ob ^ (((ob >> 9) & 1) << 5)); }
__device__ __forceinline__ void stage_rc(int b, int& R, int& C) { const int st = b / 1024, sb = b % 1024, swz = sb ^ (((sb >> 9) & 1) << 5); R = (st >> 1) * 16 + swz / 64; C = (st & 1) * 32 + (swz % 64) / 2; }
typedef int v8i_t __attribute__((ext_vector_type(8)));
typedef int v4i_t __attribute__((ext_vector_type(4)));
struct FragT { union { v8i_t v; struct { v4i_t lo, hi; }; }; };
struct Unit { int pm, pb, pn, aux; };
struct Gemm { const bf16_t* A; const bf16_t* Bt; int lda, ldb, K; };
struct NoCtx {};
struct NoPre { __device__ __forceinline__ NoCtx operator()(const Unit&, int, int, int, int, const PG8_LAS unsigned char*) const { return NoCtx{}; } };
struct NoStage { __device__ __forceinline__ void operator()(const Unit&, PG8_LAS unsigned char*, int, int) const {} };
template <class PF, class F> struct Epi {
    PF pre; F f;
    template <class Ctx>
    __device__ __forceinline__ void operator()(const f32x4 (&acc)[2][2][4][2], const Ctx& ctx, const Unit& u, int wr, int wc, int fr, int fq, PG8_LAS unsigned char*, int) const {
#pragma unroll
        for (int ai = 0; ai < 2; ++ai)
#pragma unroll
            for (int m = 0; m < 4; ++m)
#pragma unroll
                for (int bj = 0; bj < 2; ++bj) {
                    f32x4 v0, v1;
                    asm volatile("v_accvgpr_read_b32 %0, %8\n\tv_accvgpr_read_b32 %1, %9\n\tv_accvgpr_read_b32 %2, %10\n\tv_accvgpr_read_b32 %3, %11\n\t"
                                 "v_accvgpr_read_b32 %4, %12\n\tv_accvgpr_read_b32 %5, %13\n\tv_accvgpr_read_b32 %6, %14\n\tv_accvgpr_read_b32 %7, %15"
                                 : "=v"(v0.x), "=v"(v0.y), "=v"(v0.z), "=v"(v0.w), "=v"(v1.x), "=v"(v1.y), "=v"(v1.z), "=v"(v1.w)
                                 : "a"(acc[ai][bj][m][0].x), "a"(acc[ai][bj][m][0].y), "a"(acc[ai][bj][m][0].z), "a"(acc[ai][bj][m][0].w),
                                   "a"(acc[ai][bj][m][1].x), "a"(acc[ai][bj][m][1].y), "a"(acc[ai][bj][m][1].z), "a"(acc[ai][bj][m][1].w));
                    f(u, ctx, ai, m, bj, ai * HALF + wr * 64 + m * 16 + fr, bj * HALF + wc * 32 + 4 * fq, v0, v1);
                }
    }
};
template <class PF, class F> __device__ __forceinline__ Epi<PF, F> make_epi(PF p, F f) { return Epi<PF, F>{p, f}; }
template <class PF, class F> struct EpiPerm {
    PF pre; F f;
    template <class Ctx>
    __device__ __forceinline__ void operator()(const f32x4 (&acc)[2][2][4][2], const Ctx& ctx, const Unit& u, int wr, int wc, int fr, int fq, PG8_LAS unsigned char*, int) const {
#pragma unroll
        for (int ai = 0; ai < 2; ++ai)
#pragma unroll
            for (int m = 0; m < 4; ++m)
#pragma unroll
                for (int bj = 0; bj < 2; ++bj) {
                    f32x4 v0, v1;
                    asm volatile("v_accvgpr_read_b32 %0, %8\n\tv_accvgpr_read_b32 %1, %9\n\tv_accvgpr_read_b32 %2, %10\n\tv_accvgpr_read_b32 %3, %11\n\t"
                                 "v_accvgpr_read_b32 %4, %12\n\tv_accvgpr_read_b32 %5, %13\n\tv_accvgpr_read_b32 %6, %14\n\tv_accvgpr_read_b32 %7, %15"
                                 : "=v"(v0.x), "=v"(v0.y), "=v"(v0.z), "=v"(v0.w), "=v"(v1.x), "=v"(v1.y), "=v"(v1.z), "=v"(v1.w)
                                 : "a"(acc[ai][bj][m][0].x), "a"(acc[ai][bj][m][0].y), "a"(acc[ai][bj][m][0].z), "a"(acc[ai][bj][m][0].w),
                                   "a"(acc[ai][bj][m][1].x), "a"(acc[ai][bj][m][1].y), "a"(acc[ai][bj][m][1].z), "a"(acc[ai][bj][m][1].w));
                    f(u, ctx, ai, m, bj, ai * HALF + wr * 64 + m * 16 + fr, bj * HALF + wc * 32 + 8 * fq, v0, v1);
                }
    }
};
template <class PF, class F> __device__ __forceinline__ EpiPerm<PF, F> make_epi_perm(PF p, F f) { return EpiPerm<PF, F>{p, f}; }
template <bool PERMC, class PF, class F, class RE> struct EpiRow {
    PF pre; F f; RE re;
    template <class Ctx>
    __device__ __forceinline__ void operator()(const f32x4 (&acc)[2][2][4][2], const Ctx& ctx, const Unit& u, int wr, int wc, int fr, int fq, PG8_LAS unsigned char*, int) const {
#pragma unroll
        for (int ai = 0; ai < 2; ++ai)
#pragma unroll
            for (int m = 0; m < 4; ++m) {
                float part = 0.f;
#pragma unroll
                for (int bj = 0; bj < 2; ++bj) {
                    f32x4 v0, v1;
                    asm volatile("v_accvgpr_read_b32 %0, %8\n\tv_accvgpr_read_b32 %1, %9\n\tv_accvgpr_read_b32 %2, %10\n\tv_accvgpr_read_b32 %3, %11\n\t"
                                 "v_accvgpr_read_b32 %4, %12\n\tv_accvgpr_read_b32 %5, %13\n\tv_accvgpr_read_b32 %6, %14\n\tv_accvgpr_read_b32 %7, %15"
                                 : "=v"(v0.x), "=v"(v0.y), "=v"(v0.z), "=v"(v0.w), "=v"(v1.x), "=v"(v1.y), "=v"(v1.z), "=v"(v1.w)
                                 : "a"(acc[ai][bj][m][0].x), "a"(acc[ai][bj][m][0].y), "a"(acc[ai][bj][m][0].z), "a"(acc[ai][bj][m][0].w),
                                   "a"(acc[ai][bj][m][1].x), "a"(acc[ai][bj][m][1].y), "a"(acc[ai][bj][m][1].z), "a"(acc[ai][bj][m][1].w));
                    part += f(u, ctx, ai, m, bj, ai * HALF + wr * 64 + m * 16 + fr, bj * HALF + wc * 32 + (PERMC ? 8 : 4) * fq, v0, v1);
                }
                re(u, ai, m, ai * HALF + wr * 64 + m * 16 + fr, wc, fq, part);
            }
    }
};
template <bool PERMC, class PF, class F, class RE> __device__ __forceinline__ EpiRow<PERMC, PF, F, RE> make_epi_row(PF p, F f, RE r) { return EpiRow<PERMC, PF, F, RE>{p, f, r}; }
template <class PF, class GP, class F> struct EpiG {
    PF pre; GP gp; F f;
    template <class Ctx>
    __device__ __forceinline__ void operator()(const f32x4 (&acc)[2][2][4][2], const Ctx& ctx, const Unit& u, int wr, int wc, int fr, int fq, PG8_LAS unsigned char*, int) const {
        auto gcur = gp(u, ctx, wr * 64 + fr, wc, fq);
#pragma unroll
        for (int ai = 0; ai < 2; ++ai)
#pragma unroll
            for (int m = 0; m < 4; ++m) {
                const int gn = ai * 4 + m + 1;
                auto gnxt = gcur;
                if (gn < 8) gnxt = gp(u, ctx, (gn >> 2) * HALF + wr * 64 + (gn & 3) * 16 + fr, wc, fq);
#pragma unroll
                for (int bj = 0; bj < 2; ++bj) {
                    f32x4 v0, v1;
                    asm volatile("v_accvgpr_read_b32 %0, %8\n\tv_accvgpr_read_b32 %1, %9\n\tv_accvgpr_read_b32 %2, %10\n\tv_accvgpr_read_b32 %3, %11\n\t"
                                 "v_accvgpr_read_b32 %4, %12\n\tv_accvgpr_read_b32 %5, %13\n\tv_accvgpr_read_b32 %6, %14\n\tv_accvgpr_read_b32 %7, %15"
                                 : "=v"(v0.x), "=v"(v0.y), "=v"(v0.z), "=v"(v0.w), "=v"(v1.x), "=v"(v1.y), "=v"(v1.z), "=v"(v1.w)
                                 : "a"(acc[ai][bj][m][0].x), "a"(acc[ai][bj][m][0].y), "a"(acc[ai][bj][m][0].z), "a"(acc[ai][bj][m][0].w),
                                   "a"(acc[ai][bj][m][1].x), "a"(acc[ai][bj][m][1].y), "a"(acc[ai][bj][m][1].z), "a"(acc[ai][bj][m][1].w));
                    f(u, ctx, gcur, ai, m, bj, ai * HALF + wr * 64 + m * 16 + fr, bj * HALF + wc * 32 + 4 * fq, v0, v1);
                }
                gcur = gnxt;
            }
    }
};
template <class PF, class GP, class F> __device__ __forceinline__ EpiG<PF, GP, F> make_epi_g(PF p, GP g, F f) { return EpiG<PF, GP, F>{p, g, f}; }
template <int MG, int TILE_BYTES, class PF, class F, class FL> struct EpiStaged {
    PF pre; F f; FL flush;
    template <class Ctx>
    __device__ __forceinline__ void operator()(const f32x4 (&acc)[2][2][4][2], const Ctx& ctx, const Unit& u, int wr, int wc, int fr, int fq, PG8_LAS unsigned char* tile, int tid) const {
#pragma unroll
        for (int ai = 0; ai < 2; ++ai)
#pragma unroll
            for (int m = 0; m < 4; ++m) {
#pragma unroll
                for (int bj = 0; bj < 2; ++bj) {
                    f32x4 v0, v1;
                    asm volatile("v_accvgpr_read_b32 %0, %8\n\tv_accvgpr_read_b32 %1, %9\n\tv_accvgpr_read_b32 %2, %10\n\tv_accvgpr_read_b32 %3, %11\n\t"
                                 "v_accvgpr_read_b32 %4, %12\n\tv_accvgpr_read_b32 %5, %13\n\tv_accvgpr_read_b32 %6, %14\n\tv_accvgpr_read_b32 %7, %15"
                                 : "=v"(v0.x), "=v"(v0.y), "=v"(v0.z), "=v"(v0.w), "=v"(v1.x), "=v"(v1.y), "=v"(v1.z), "=v"(v1.w)
                                 : "a"(acc[ai][bj][m][0].x), "a"(acc[ai][bj][m][0].y), "a"(acc[ai][bj][m][0].z), "a"(acc[ai][bj][m][0].w),
                                   "a"(acc[ai][bj][m][1].x), "a"(acc[ai][bj][m][1].y), "a"(acc[ai][bj][m][1].z), "a"(acc[ai][bj][m][1].w));
                    f(u, ctx, ai, m, bj, (m % MG) * 32 + wr * 16 + fr, bj * HALF + wc * 32 + 4 * fq, v0, v1, tile + (((ai * 4 + m) / MG) & 1) * TILE_BYTES);
                }
                if ((m % MG) == MG - 1) {
                    asm volatile("s_waitcnt lgkmcnt(0)" ::: "memory"); __builtin_amdgcn_s_barrier(); asm volatile("" ::: "memory");
                    flush(u, ctx, ai, m - (MG - 1), tid, tile + (((ai * 4 + m) / MG) & 1) * TILE_BYTES);
                }
            }
    }
};
template <int MG, int TILE_BYTES, class PF, class F, class FL> __device__ __forceinline__ EpiStaged<MG, TILE_BYTES, PF, F, FL> make_epi_staged(PF p, F f, FL fl) { return EpiStaged<MG, TILE_BYTES, PF, F, FL>{p, f, fl}; }
__host__ __device__ __forceinline__ int perm32(int rho) { const int n = rho >> 4, i = rho & 15; return 8 * (i >> 2) + 4 * n + (i & 3); }
template <bool FP8 = false, bool GATHER = false, bool PERM = false, class EpiT, class Sched, class StageT = NoStage>
__device__ __forceinline__ void gemm_phase(int tid, PG8_LAS unsigned char* lds, const Gemm g, const Sched& S, const EpiT& E, const StageT& SC = NoStage{}, int ctx_off = 0) {
    const int wid = __builtin_amdgcn_readfirstlane(tid >> 6), lane = tid & 63, wr = wid >> 2, wc = wid & 3, fr = lane & 15, fq = lane >> 4;
    int K = g.K; asm volatile("" : "+s"(K));
    const int nt = K / BK;
    unsigned voffA[2], voffB[2];
    int Rl[2], Cl[2];
#pragma unroll
    for (int i = 0; i < 2; ++i) { int R, C; stage_rc(tid * 16 + i * 8192, R, C); Rl[i] = R; Cl[i] = C; voffA[i] = (unsigned)(R * g.lda + C) * 2u; const int Rb = PERM ? ((R & ~31) + perm32(R & 31)) : R; voffB[i] = (unsigned)(Rb * g.ldb + C) * 2u; }
    unsigned gA00 = 0, gA01 = 0, gA10 = 0, gA11 = 0, gN00 = 0, gN01 = 0, gN10 = 0, gN11 = 0;
    const size_t kstep = (size_t)(BK * 2);
    const size_t hstepA = (size_t)HALF * g.lda * 2, hstepB = (size_t)HALF * g.ldb * 2;
    const size_t tstepA = 2 * hstepA, tstepB = 2 * hstepB;
    const unsigned ldsw = (unsigned)wid * 1024u;
    const int aoff = lds_byte(wr * 64 + fr, fq * 8), boff = lds_byte(wc * 32 + fr, fq * 8);
#define PG8_SA(b, h) (((b) * 2 + (h)) * HTB)
#define PG8_SB(b, h) ((4 + (b) * 2 + (h)) * HTB)
#define PG8_STAGE(bufoff, gbase, voff) do { _Pragma("unroll") for (int _i = 0; _i < 2; ++_i) \
        __builtin_amdgcn_global_load_lds((const unsigned*)((const char*)(gbase) + (voff)[_i]), (PG8_LAS unsigned*)(lds + (bufoff) + ldsw + _i * 8192), 16, 0, 0); } while (0)
#define PG8_LDA(dst, b, h) do { _Pragma("unroll") for (int m = 0; m < 4; ++m) { dst[m].lo = *(const PG8_LAS v4i_t*)(lds + PG8_SA(b, h) + aoff + m * 2048); dst[m].hi = *(const PG8_LAS v4i_t*)(lds + PG8_SA(b, h) + aoff + m * 2048 + 1024); } } while (0)
#define PG8_LDB(dst, b, h) do { _Pragma("unroll") for (int n = 0; n < 2; ++n) { dst[n].lo = *(const PG8_LAS v4i_t*)(lds + PG8_SB(b, h) + boff + n * 2048); dst[n].hi = *(const PG8_LAS v4i_t*)(lds + PG8_SB(b, h) + boff + n * 2048 + 1024); } } while (0)
#define PG8_MMA(ai, bj, At, Bt) do { __builtin_amdgcn_s_setprio(1); asm volatile("s_nop 1" ::: "memory");     \
        _Pragma("unroll") for (int m = 0; m < 4; ++m) _Pragma("unroll") for (int n = 0; n < 2; ++n) { \
        if constexpr (FP8) { asm volatile("v_mfma_scale_f32_16x16x128_f8f6f4 %0, %1, %2, %0, %3, %4 op_sel_hi:[0,0,0]" : "+a"(acc[ai][bj][m][n]) : "v"(Bt[n].v), "v"(At[m].v), "v"(scw), "v"(scx)); } \
        else { asm volatile("v_mfma_f32_16x16x32_bf16 %0, %1, %2, %0\n\tv_mfma_f32_16x16x32_bf16 %0, %3, %4, %0" : "+a"(acc[ai][bj][m][n]) : "v"(Bt[n].lo), "v"(At[m].lo), "v"(Bt[n].hi), "v"(At[m].hi)); } } \
        __builtin_amdgcn_s_setprio(0); } while (0)
#define PG8_WAIT_V(n) asm volatile("s_waitcnt vmcnt(" #n ")" ::: "memory")
#define PG8_WAIT_L(n) asm volatile("s_waitcnt lgkmcnt(" #n ")" ::: "memory")
#define PG8_BAR __builtin_amdgcn_s_barrier()
#define PG8_SCHED __builtin_amdgcn_sched_barrier(0)
    Unit cur, nxt; int ui = 0;
    if (!S.next(0, cur)) return;
    f32x4 acc[2][2][4][2];
#pragma unroll
    for (int a = 0; a < 2; ++a)
#pragma unroll
        for (int b = 0; b < 2; ++b)
#pragma unroll
            for (int m = 0; m < 4; ++m)
#pragma unroll
                for (int n = 0; n < 2; ++n) acc[a][b][m][n] = (f32x4){0.f, 0.f, 0.f, 0.f};
    FragT At[4], B0[2], B1[2];
    int scw = (FP8 && PROBE_KX2) ? 0x79797979 : 0x7a7a7a7a, scx = 0x7f7f7f7f; asm volatile("" : "+v"(scw), "+v"(scx));
    const char* cA = GATHER ? (const char*)g.A : (const char*)g.A + (size_t)cur.pm * tstepA; const char* cB = (const char*)g.Bt + (size_t)cur.pb * tstepB;
    SC(cur, lds + STAGE_BYTES + ctx_off, wid, lane);
    const int R0 = Rl[0], R1 = Rl[1]; const unsigned C0 = (unsigned)Cl[0] * 2u, C1 = (unsigned)Cl[1] * 2u;
    if constexpr (GATHER) { gA00 = S.a_off(cur, R0) + C0; gA01 = S.a_off(cur, R1) + C1; gA10 = S.a_off(cur, HALF + R0) + C0; gA11 = S.a_off(cur, HALF + R1) + C1; }
#define PG8_STAGE_A(bufoff, koff, O0, O1, dense_ptr) do { if constexpr (GATHER) { \
        __builtin_amdgcn_global_load_lds((const unsigned*)((const char*)g.A + (koff) + (O0)), (PG8_LAS unsigned*)(lds + (bufoff) + ldsw), 16, 0, 0); \
        __builtin_amdgcn_global_load_lds((const unsigned*)((const char*)g.A + (koff) + (O1)), (PG8_LAS unsigned*)(lds + (bufoff) + ldsw + 8192), 16, 0, 0); \
    } else { PG8_STAGE(bufoff, dense_ptr, voffA); } } while (0)
    PG8_STAGE(PG8_SB(0, 0), cB, voffB); PG8_STAGE(PG8_SB(0, 1), cB + hstepB, voffB); PG8_STAGE_A(PG8_SA(0, 0), 0, gA00, gA01, cA); PG8_STAGE_A(PG8_SA(0, 1), 0, gA10, gA11, cA + hstepA);
    if (wr == 1) PG8_BAR;
    PG8_WAIT_V(2); PG8_BAR;
    PG8_STAGE(PG8_SB(1, 0), cB + kstep, voffB); PG8_STAGE_A(PG8_SA(1, 0), kstep, gA00, gA01, cA + kstep); PG8_STAGE(PG8_SB(1, 1), cB + hstepB + kstep, voffB);
    PG8_WAIT_V(6); PG8_BAR;
    for (;;) {
        const bool has_next = S.next(ui + 1, nxt);
        const char* nA = GATHER ? cA : (has_next ? (const char*)g.A + (size_t)nxt.pm * tstepA : cA); const char* nB = has_next ? (const char*)g.Bt + (size_t)nxt.pb * tstepB : cB;
        if (has_next) SC(nxt, lds + STAGE_BYTES + ctx_off + ((ui + 1) % 3) * 4096, wid, lane);
        if constexpr (GATHER) {
            if (has_next) { gN00 = S.a_off(nxt, R0) + C0; gN01 = S.a_off(nxt, R1) + C1; gN10 = S.a_off(nxt, HALF + R0) + C0; gN11 = S.a_off(nxt, HALF + R1) + C1; }
            else { gN00 = gA00; gN01 = gA01; gN10 = gA10; gN11 = gA11; }
        }
        constexpr int KX = (FP8 && PROBE_KX2) ? 2 : 1;
        for (int t = 0; t < KX * nt; t += 2) {
            const bool last = (t == KX * nt - 2);
            const char* a1 = cA + (size_t)((t + 1) % nt) * kstep;
            const char* a2 = last ? nA : cA + (size_t)((t + 2) % nt) * kstep; const char* b2 = last ? nB : cB + (size_t)((t + 2) % nt) * kstep;
            const char* a3 = a2 + kstep; const char* b3 = b2 + kstep;
            const size_t k1 = (size_t)((t + 1) % nt) * kstep, k2 = last ? 0 : (size_t)((t + 2) % nt) * kstep;
            const unsigned gT00 = last ? gN00 : gA00, gT01 = last ? gN01 : gA01, gT10 = last ? gN10 : gA10, gT11 = last ? gN11 : gA11;
            PG8_LDB(B0, 0, 0); PG8_LDB(B1, 0, 1); PG8_SCHED; PG8_LDA(At, 0, 0); PG8_STAGE_A(PG8_SA(1, 1), k1, gA10, gA11, a1 + hstepA);
            PG8_WAIT_V(8); PG8_WAIT_L(0); PG8_BAR; PG8_MMA(0, 0, At, B0); PG8_MMA(0, 1, At, B1); PG8_BAR; PG8_SCHED;
            PG8_LDA(At, 0, 1); PG8_STAGE(PG8_SB(0, 0), b2, voffB); PG8_STAGE(PG8_SB(0, 1), b2 + hstepB, voffB); PG8_STAGE_A(PG8_SA(0, 0), k2, gT00, gT01, a2);
            PG8_WAIT_V(8); PG8_WAIT_L(0); PG8_BAR; PG8_MMA(1, 0, At, B0); PG8_MMA(1, 1, At, B1); PG8_BAR; PG8_SCHED;
            PG8_LDB(B0, 1, 0); PG8_LDB(B1, 1, 1); PG8_SCHED; PG8_LDA(At, 1, 0); PG8_STAGE_A(PG8_SA(0, 1), k2, gT10, gT11, a2 + hstepA);
            PG8_WAIT_V(8); PG8_WAIT_L(0); PG8_BAR; PG8_MMA(0, 0, At, B0); PG8_MMA(0, 1, At, B1); PG8_BAR; PG8_SCHED;
            PG8_LDA(At, 1, 1); PG8_STAGE(PG8_SB(1, 0), b3, voffB); PG8_STAGE(PG8_SB(1, 1), b3 + hstepB, voffB); PG8_STAGE_A(PG8_SA(1, 0), k2 + kstep, gT00, gT01, a3);
            PG8_WAIT_V(8); PG8_WAIT_L(0); PG8_BAR; PG8_MMA(1, 0, At, B0); PG8_MMA(1, 1, At, B1); PG8_BAR; PG8_SCHED;
        }
        unsigned long long tp0_ = 0; if constexpr (PROBE_SEG != 0 && PROBE_SEG == (FP8 ? (GATHER ? 2 : 1) : 3)) tp0_ = __builtin_amdgcn_s_memrealtime();
        const auto ectx = E.pre(cur, wr, wc, fr, fq, lds + STAGE_BYTES + ctx_off + (ui % 3) * 4096);
        if (wr == 0) PG8_BAR;
        asm volatile("s_nop 15\n\ts_nop 15" ::: "memory");
        E(acc, ectx, cur, wr, wc, fr, fq, lds + STAGE_BYTES, tid);
        if constexpr (FP8 && PROBE_EPI2) { asm volatile("" ::: "memory"); E(acc, ectx, cur, wr, wc, fr, fq, lds + STAGE_BYTES, tid); }
        if constexpr (PROBE_SEG != 0 && PROBE_SEG == (FP8 ? (GATHER ? 2 : 1) : 3)) { if (tid == 0) { PG8_LAS unsigned* acc_t = (PG8_LAS unsigned*)(lds + LDS_MISC + 48); *acc_t += (unsigned)(__builtin_amdgcn_s_memrealtime() - tp0_); } }
        if (!has_next) break;
#pragma unroll
        for (int a = 0; a < 2; ++a)
#pragma unroll
            for (int b = 0; b < 2; ++b)
#pragma unroll
                for (int m = 0; m < 4; ++m)
#pragma unroll
                    for (int n = 0; n < 2; ++n) acc[a][b][m][n] = (f32x4){0.f, 0.f, 0.f, 0.f};
        cur = nxt; cA = nA; cB = nB; ++ui;
        if constexpr (GATHER) { gA00 = gN00; gA01 = gN01; gA10 = gN10; gA11 = gN11; }
        if (wr == 1) PG8_BAR;
    }
    PG8_WAIT_V(0);
    PG8_BAR;
#undef PG8_SA
#undef PG8_SB
#undef PG8_STAGE
#undef PG8_STAGE_A
#undef PG8_LDA
#undef PG8_LDB
#undef PG8_MMA
#undef PG8_WAIT_V
#undef PG8_WAIT_L
#undef PG8_BAR
#undef PG8_SCHED
}
struct GridOrder {
    int nM, nN, nwg, G, c;
    __device__ __forceinline__ void init(int nM_, int nN_, int G_, int c_) { nM = nM_; nN = nN_; nwg = nM * nN; G = G_; c = c_; }
    __device__ __forceinline__ bool tile(int i, int& pm, int& pn) const {
        const long L = (long)i * G + c; if (L >= nwg) return false;
        int wgid = (int)L; { const int q = nwg / 8, r = nwg % 8, xcd = wgid % 8, off = wgid / 8; wgid = (xcd < r ? xcd * (q + 1) : r * (q + 1) + (xcd - r) * q) + off; }
        const int nig = 8 * nN, gid = wgid / nig, fm = gid * 8, gsz = (nM - fm) < 8 ? (nM - fm) : 8;
        pm = fm + ((wgid % nig) % gsz); pn = (wgid % nig) / gsz; return true;
    }
};
}


struct DenseOrder { pg8::GridOrder go;
    __device__ __forceinline__ bool next(int i, pg8::Unit& u) const { int pm, pn; if (!go.tile(i, pm, pn)) return false; u.pm = pm; u.pb = pn; u.pn = pn; u.aux = 0; return true; } };
struct MoeOrder { pg8::GridOrder go; const int* pst; const int* el_slot; int NT, ebase;
    __device__ __forceinline__ unsigned a_off(const pg8::Unit& u, int R) const { const int ro = u.pm * 256 - pst[u.aux] + R; const int tok = (ro < pst[64 + u.aux]) ? (el_slot[(size_t)u.aux * T + ro] >> 2) : 0; return (unsigned)tok * 1024u; }
    __device__ __forceinline__ bool next(int i, pg8::Unit& u) const { int pm, pn; if (!go.tile(i, pm, pn)) return false; int e = 0;
#pragma unroll
        for (int q = 1; q < 32; ++q) e = (pm * 256 >= pst[q]) ? q : e;
        e = __builtin_amdgcn_readfirstlane(e);
        u.pm = pm; u.pn = pn; u.pb = (ebase + e) * NT + pn; u.aux = e; return true; } };
struct S5Order { int G, c;
    __device__ __forceinline__ bool next(int i, pg8::Unit& u) const { const int L = i * G + c; if (L >= 256) return false; const int g = L >> 3, pmL = (L >> 2) & 1, pnL = L & 3;
        u.pm = g * 2 + pmL; u.pb = g * 4 + pnL; u.pn = pnL; u.aux = g; return true; } };

__device__ __forceinline__ void transpose_item(const float* W, int K, int N, bf16_t* WT, int ldt, float* scr, int item, int lane, int mode, const float* kscale = nullptr) {
    const int nblk = N / 32, kb = item / nblk, nb = item % nblk, k0 = 64 * kb, n0 = 32 * nb;
#pragma unroll 8
    for (int i = 0; i < 32; ++i) { const int kk = 2 * i + (lane >> 5); scr[kk * 33 + (lane & 31)] = W[(size_t)(k0 + kk) * N + n0 + (lane & 31)] * (kscale ? kscale[k0 + kk] : 1.0f); }
    __builtin_amdgcn_s_waitcnt(0xC07F); asm volatile("" ::: "memory");
    const int c = lane & 7;
#pragma unroll
    for (int j = 0; j < 4; ++j) {
        const int n = (lane >> 3) + 8 * j; const float* s = scr + (8 * c) * 33 + n;
        u32x4 o; o.x = pk2(s[0 * 33], s[1 * 33]); o.y = pk2(s[2 * 33], s[3 * 33]); o.z = pk2(s[4 * 33], s[5 * 33]); o.w = pk2(s[6 * 33], s[7 * 33]);
        int nn = n0 + n;
        if (mode == 1) { const int half = nn >= 1024; const int jj = nn - half * 1024; nn = 32 * (jj >> 4) + 16 * half + (jj & 15); }
        *(u32x4*)(WT + (size_t)nn * ldt + k0 + 8 * c) = o;
    }
    __builtin_amdgcn_s_waitcnt(0xC07F); asm volatile("" ::: "memory");
}
__device__ __forceinline__ void transpose_item_fp8(const float* W, int K, int N, unsigned char* WT, float* scr, int item, int lane, int mode, float scale) {
    const int nblk = N / 32, kb = item / nblk, nb = item % nblk, k0 = 128 * kb, n0 = 32 * nb;
#pragma unroll 8
    for (int i = 0; i < 64; ++i) { const int kk = 2 * i + (lane >> 5); scr[kk * 33 + (lane & 31)] = W[(size_t)(k0 + kk) * N + n0 + (lane & 31)] * scale; }
    __builtin_amdgcn_s_waitcnt(0xC07F); asm volatile("" ::: "memory");
    const int c = lane & 7;
#pragma unroll
    for (int j = 0; j < 4; ++j) {
        const int n = (lane >> 3) + 8 * j; const float* s = scr + (16 * c) * 33 + n;
        u32x4 o; o.x = pk4_fp8(s[0 * 33], s[1 * 33], s[2 * 33], s[3 * 33]); o.y = pk4_fp8(s[4 * 33], s[5 * 33], s[6 * 33], s[7 * 33]);
        o.z = pk4_fp8(s[8 * 33], s[9 * 33], s[10 * 33], s[11 * 33]); o.w = pk4_fp8(s[12 * 33], s[13 * 33], s[14 * 33], s[15 * 33]);
        int nn = n0 + n;
        if (mode == 1) { const int half = nn >= 1024; const int jj = nn - half * 1024; nn = 32 * (jj >> 4) + 16 * half + (jj & 15); }
        *(u32x4*)(WT + (size_t)nn * K + k0 + 16 * c) = o;
    }
    __builtin_amdgcn_s_waitcnt(0xC07F); asm volatile("" ::: "memory");
}
__device__ __forceinline__ void transpose_many_fp8(const float* W, int nmat, int K, int N, unsigned char* WT, size_t dst_stride, float* scr, int gw, int NGW, int lane, int mode, float scale) {
    const int per = (K / 128) * (N / 32); const long tot = (long)nmat * per;
    for (long it = gw; it < tot; it += NGW) {
        const int mt = (int)(it / per), r = (int)(it % per);
        transpose_item_fp8(W + (size_t)mt * K * N, K, N, WT + (size_t)mt * dst_stride, scr, r, lane, mode, scale);
    }
}
__device__ __forceinline__ void convert_fp8_queue(const float* Wgu, const float* Wdn, unsigned char* WTgu, unsigned char* WTdn, float* tile, volatile int* qslot, unsigned* qctr, int tid, float scale) {
    const int wave = tid >> 6, lane = tid & 63;
    constexpr int TOT_GU = 64 * 64, TOT = TOT_GU + 64 * 32;
    f32x4 v[16];
    auto src = [&](int item, int i) {
        const bool gu = item < TOT_GU; const int it2 = gu ? item : item - TOT_GU; const int N = gu ? 2048 : 1024, per = gu ? 64 : 32, nblk = N / 256;
        const int mt = it2 / per, r = it2 % per, kb = r / nblk, nb = r % nblk;
        return (const f32x4*)((gu ? Wgu : Wdn) + (size_t)mt * 1024 * N + (size_t)(128 * kb + wave + 8 * i) * N + 256 * nb + lane * 4); };
    if (tid == 0) qslot[0] = (int)atomicAdd(qctr, 1u);
    __syncthreads();
    int it = qslot[0];
    if (it < TOT) {
#pragma unroll
        for (int i = 0; i < 16; ++i) v[i] = *src(it, i);
    }
    while (it < TOT) {
        if (tid == 0) qslot[1] = (int)atomicAdd(qctr, 1u);
#pragma unroll
        for (int i = 0; i < 16; ++i) { float* d = tile + (wave + 8 * i) * 257 + lane * 4; d[0] = v[i].x * scale; d[1] = v[i].y * scale; d[2] = v[i].z * scale; d[3] = v[i].w * scale; }
        __syncthreads();
        const int nx = qslot[1];
        if (nx < TOT) {
#pragma unroll
            for (int i = 0; i < 16; ++i) v[i] = *src(nx, i);
        }
        {
            const bool gu = it < TOT_GU; const int it2 = gu ? it : it - TOT_GU; const int N = gu ? 2048 : 1024, per = gu ? 64 : 32, nblk = N / 256;
            const int mt = it2 / per, r = it2 % per, kb = r / nblk, nb = r % nblk, k0 = 128 * kb, n0 = 256 * nb;
            unsigned char* WT = (gu ? WTgu : WTdn) + (size_t)mt * N * 1024;
            const int c = tid & 7;
#pragma unroll 1
            for (int ps = 0; ps < 4; ++ps) {
                const int n = ps * 64 + (tid >> 3); const float* sp = tile + (16 * c) * 257 + n;
                u32x4 o; o.x = pk4_fp8(sp[0 * 257], sp[1 * 257], sp[2 * 257], sp[3 * 257]); o.y = pk4_fp8(sp[4 * 257], sp[5 * 257], sp[6 * 257], sp[7 * 257]);
                o.z = pk4_fp8(sp[8 * 257], sp[9 * 257], sp[10 * 257], sp[11 * 257]); o.w = pk4_fp8(sp[12 * 257], sp[13 * 257], sp[14 * 257], sp[15 * 257]);
                int nn = n0 + n;
                if (gu) { const int half = nn >= 1024; const int jj = nn - half * 1024; nn = 32 * (jj >> 4) + 16 * half + (jj & 15); }
                *(u32x4*)(WT + (size_t)nn * 1024 + k0 + 16 * c) = o;
            }
        }
        __syncthreads();
        it = nx;
    }
}
__device__ __forceinline__ void transpose_many(const float* W, int nmat, int K, int N, bf16_t* WT, size_t dst_stride, float* scr, int gw, int NGW, int lane, int mode, int ldt = 0, const float* kscale = nullptr) {
    if (ldt == 0) ldt = K;
    const int per = (K / 64) * (N / 32); const long tot = (long)nmat * per;
    for (long it = gw; it < tot; it += NGW) {
        const int mt = (int)(it / per), r = (int)(it % per);
        transpose_item(W + (size_t)mt * K * N, K, N, WT + (size_t)mt * dst_stride, ldt, scr, r, lane, mode, kscale);
    }
}

__device__ __forceinline__ void norm_mod_store(f32x4 (&v)[4], const float* g, const float* sc, const float* sh, bf16_t* orow, unsigned char* orow8, int lane) {
    float s = 0.f;
#pragma unroll
    for (int j = 0; j < 4; ++j) s += (v[j].x * v[j].x + v[j].y * v[j].y) + (v[j].z * v[j].z + v[j].w * v[j].w);
    const float r = rsqrtf(wave_sum(s) * (1.0f / D) + 1e-6f);
#pragma unroll
    for (int j = 0; j < 4; ++j) {
        const int c = 4 * lane + 256 * j;
        const f32x4 gg = *(const f32x4*)(g + c), s1 = *(const f32x4*)(sc + c), s0 = *(const f32x4*)(sh + c);
        const float a = v[j].x * r * gg.x * (1.f + s1.x) + s0.x, b = v[j].y * r * gg.y * (1.f + s1.y) + s0.y,
                    cc = v[j].z * r * gg.z * (1.f + s1.z) + s0.z, d = v[j].w * r * gg.w * (1.f + s1.w) + s0.w;
        u32x2 o; o.x = pk2(a, b); o.y = pk2(cc, d);
        *(u32x2*)(orow + c) = o;
        if (orow8) *(unsigned*)(orow8 + c) = pk4_fp8(a, b, cc, d);
    }
}

__device__ __forceinline__ void unpack8(const u32x4 w, float (&f)[8]) {
    f[0] = __uint_as_float(w.x << 16); f[1] = __uint_as_float(w.x & 0xffff0000u); f[2] = __uint_as_float(w.y << 16); f[3] = __uint_as_float(w.y & 0xffff0000u);
    f[4] = __uint_as_float(w.z << 16); f[5] = __uint_as_float(w.z & 0xffff0000u); f[6] = __uint_as_float(w.w << 16); f[7] = __uint_as_float(w.w & 0xffff0000u);
}
__device__ __forceinline__ u32x4 pack8(const float (&f)[8]) { u32x4 o; o.x = pk2(f[0], f[1]); o.y = pk2(f[2], f[3]); o.z = pk2(f[4], f[5]); o.w = pk2(f[6], f[7]); return o; }
__device__ __forceinline__ void norm_mod_store8(float (&v)[2][8], const float* g, const float* sc, const float* sh, bf16_t* orow, unsigned char* orow8, int lane) {
    float s = 0.f;
#pragma unroll
    for (int j = 0; j < 2; ++j)
#pragma unroll
        for (int i = 0; i < 8; ++i) s += v[j][i] * v[j][i];
    const float r = rsqrtf(wave_sum(s) * (1.0f / D) + 1e-6f);
#pragma unroll
    for (int j = 0; j < 2; ++j) {
        const int c = 8 * lane + 512 * j; float o[8];
#pragma unroll
        for (int q = 0; q < 2; ++q) {
            const f32x4 gg = *(const f32x4*)(g + c + 4 * q), s1 = *(const f32x4*)(sc + c + 4 * q), s0 = *(const f32x4*)(sh + c + 4 * q);
            o[4 * q + 0] = v[j][4 * q + 0] * r * gg.x * (1.f + s1.x) + s0.x; o[4 * q + 1] = v[j][4 * q + 1] * r * gg.y * (1.f + s1.y) + s0.y;
            o[4 * q + 2] = v[j][4 * q + 2] * r * gg.z * (1.f + s1.z) + s0.z; o[4 * q + 3] = v[j][4 * q + 3] * r * gg.w * (1.f + s1.w) + s0.w;
        }
        *(u32x4*)(orow + c) = pack8(o);
        if (orow8) { u32x2 w8; w8.x = pk4_fp8(o[0], o[1], o[2], o[3]); w8.y = pk4_fp8(o[4], o[5], o[6], o[7]); *(u32x2*)(orow8 + c) = w8; }
    }
}

template <int ph> __device__ __forceinline__ void phase_body(int wbase) {
    extern __shared__ __attribute__((aligned(16))) unsigned char lds[];
    {
        int tid = wbase + lane_id(); asm volatile("" : "+v"(tid));
        int vb = blockIdx.x, G = gridDim.x; asm volatile("" : "+s"(vb), "+s"(G));
        const int lane = tid & 63, wave = tid >> 6;
        const int gw = vb * NWAVE + wave, NGW = G * NWAVE;
        const __attribute__((address_space(4))) Params* kp = (const __attribute__((address_space(4))) Params*)__builtin_amdgcn_kernarg_segment_ptr();
        asm volatile("" : "+s"(kp));
        unsigned char* ws = kp->ws;
        unsigned* ctl = (unsigned*)(ws + WS_CTL);
        float* MOD = (float*)(ws + WS_MOD);
        float* S5AB = (float*)(ws + WS_S5AB); float* S5BB = (float*)(ws + WS_S5AB + 65536);
        float* PW = (float*)(ws + WS_PW); float* KTAB = (float*)(ws + WS_KTAB);
                int* EL_SLOT = (int*)(ws + WS_EL); float* EL_GATE = (float*)(ws + WS_EL + 4 * MiB);
            bf16_t* W_IN_E = (bf16_t*)(ws + WS_W_IN_E); bf16_t* W_UP = (bf16_t*)(ws + WS_W_UP); bf16_t* W_GLU = (bf16_t*)(ws + WS_W_GLU);
        bf16_t* W_OUT_E = (bf16_t*)(ws + WS_W_OUT_E); bf16_t* W_IN_O = (bf16_t*)(ws + WS_W_IN_O); bf16_t* W_OUT_O = (bf16_t*)(ws + WS_W_OUT_O);
        bf16_t* W_POOL = (bf16_t*)(ws + WS_W_POOL); bf16_t* W_SGU = (bf16_t*)(ws + WS_W_SGU); bf16_t* W_RT = (bf16_t*)(ws + WS_W_RT);
        bf16_t* BT_END = (bf16_t*)(ws + WS_BT_END); bf16_t* BT_MAIN = (bf16_t*)(ws + WS_BT_MAIN);
        unsigned char* W_GU = ws + WS_W_GU; unsigned char* W_DN = ws + WS_W_DN; unsigned char* HB8 = ws + WS_HB8;
        bf16_t* HB = (bf16_t*)(ws + WS_HB); bf16_t* MIXIN = (bf16_t*)(ws + WS_MIXIN); unsigned char* Y = ws + WS_Y;
        unsigned char* ACT = ws + WS_ACT;
        bf16_t* Z = (bf16_t*)(ws + WS_Z); float* RSP = (float*)(ws + WS_RSP); bf16_t* QKVRAW = (bf16_t*)(ws + WS_QKVRAW);
        bf16_t* Qb = (bf16_t*)(ws + WS_Q); bf16_t* Kb = (bf16_t*)(ws + WS_K); bf16_t* VT = (bf16_t*)(ws + WS_VT);
        bf16_t* AS5 = (bf16_t*)(ws + WS_AS5); float* LEND = (float*)(ws + WS_LEND); bf16_t* GACT = (bf16_t*)(ws + WS_GACT);
        bf16_t* POOLED = (bf16_t*)(ws + WS_POOLED); bf16_t* VTS = (bf16_t*)(ws + WS_VTS);
        float* OUT = kp->out; const float* XIN = kp->x; bf16_t* XR = (bf16_t*)(ws + WS_XR);
        const float* s5d = kp->s5_d; const float* glub = kp->s5_glu_b; const float* poolsc = kp->pool_scale; const float* sgub = kp->sgu_b;
        const float* bgu_all = kp->moe_b_gu; const float* bdn_all = kp->moe_b_dn; const float* rtb_all = kp->router_b;

        const int layer = (ph >= 17) ? 1 : 0;
        const int mph = (ph >= 17 && ph <= 19) ? ph - 8 : ph;
        const float* mod_l = MOD + (size_t)layer * NB * 6144;

        if (ph == 0) {
            const int gt = vb * NTHR + tid;
            if (gt < 2048) {
                const int g = gt >> 6, pp = gt & 63;
                const float dt = expf(kp->s5_log_dt[g]);
                const float lre = fminf(kp->s5_a_re[g * 64 + pp], -1e-4f), lim = kp->s5_a_im[g * 64 + pp];
                const float mag = expf(lre * dt);
                const float abr = mag * cosf(lim * dt), abi = mag * sinf(lim * dt);
                const float den = lre * lre + lim * lim, nr = abr - 1.0f;
                const float fre = (nr * lre + abi * lim) / den, fim = (abi * lre - nr * lim) / den;
                S5AB[(g * 64 + pp) * 2 + 0] = abr; S5AB[(g * 64 + pp) * 2 + 1] = abi;
                for (int j = 0; j < 16; ++j) {
                    const float br = kp->s5_b_re[(g * 64 + pp) * 16 + j], bi = kp->s5_b_im[(g * 64 + pp) * 16 + j];
                    S5BB[((g * 64 + pp) * 16 + j) * 2 + 0] = fre * br - fim * bi;
                    S5BB[((g * 64 + pp) * 16 + j) * 2 + 1] = fre * bi + fim * br;
                }
                float pr = 1.f, pi = 0.f;
                for (int tau = 0; tau <= 64; ++tau) {
                    PW[((g * 64 + pp) * 65 + tau) * 2 + 0] = pr; PW[((g * 64 + pp) * 65 + tau) * 2 + 1] = pi;
                    const float nr2 = pr * abr - pi * abi, ni2 = pr * abi + pi * abr; pr = nr2; pi = ni2;
                }
            }
            {
                float* ca = (float*)lds;
                for (int i = tid; i < NB * D; i += NTHR) { const float cv = kp->c[i]; ca[i] = cv * sigmoidf_(cv); }
                __syncthreads();
                float* part = (float*)(lds + 32768);
                for (int task = (vb >= 64 ? vb - 64 : vb + G - 64); task < 2 * 96; task += G) {
                    const int l = task / 96, cb = task % 96, col = cb * 64 + lane;
                    const float* W = kp->ada_w + (size_t)l * D * 6144 + col;
                    float acc[8];
#pragma unroll
                    for (int b = 0; b < 8; ++b) acc[b] = 0.f;
                    const int kb = wave * 128;
                    for (int k = kb; k < kb + 128; k += 16) {
                        float w[16];
#pragma unroll
                        for (int u = 0; u < 16; ++u) w[u] = W[(size_t)(k + u) * 6144];
#pragma unroll
                        for (int u = 0; u < 16; ++u)
#pragma unroll
                            for (int b = 0; b < 8; ++b) acc[b] += ca[b * D + k + u] * w[u];
                    }
#pragma unroll
                    for (int b = 0; b < 8; ++b) part[(wave * 8 + b) * 64 + lane] = acc[b];
                    __syncthreads();
                    {
                        const int b = tid >> 6;
                        float sum = kp->ada_b[l * 6144 + col];
#pragma unroll
                        for (int w8 = 0; w8 < 8; ++w8) sum += part[(w8 * 8 + b) * 64 + lane];
                        MOD[((size_t)l * NB + b) * 6144 + col] = sum;
                    }
                    __syncthreads();
                }
                __syncthreads();
            }
            {
                float* scr = (float*)(lds + wave * 16384);
                transpose_many(kp->even_w_in, 1, 1024, 928, W_IN_E, 0, scr, gw, NGW, lane, 0);
                transpose_many(kp->w_uq, 1, 256, 768, W_UP, 0, scr, gw, NGW, lane, 0, 384, kp->q_norm_g);
                transpose_many(kp->w_ukv, 1, 128, 1024, W_UP + (size_t)768 * 384 + 256, 0, scr, gw, NGW, lane, 0, 384, kp->kv_norm_g);
                for (int i = vb * NTHR + tid; i < 768 * 16 + 1024 * 32; i += G * NTHR) {
                    const u32x4 z = {0u, 0u, 0u, 0u};
                    if (i < 768 * 16) *(u32x4*)(W_UP + (size_t)(i >> 4) * 384 + 256 + (i & 15) * 8) = z;
                    else { const int q = i - 768 * 16; *(u32x4*)(W_UP + (size_t)(768 + (q >> 5)) * 384 + (q & 31) * 8) = z; }
                }
                transpose_many(kp->s5_glu_w, 1, 512, 512, W_GLU, 0, scr, gw, NGW, lane, 0);
                transpose_many(kp->even_w_out, 1, 1024, 1024, W_OUT_E, 0, scr, gw, NGW, lane, 0);
                transpose_many(kp->odd_w_in, 1, 1024, 1536, W_IN_O, 0, scr, gw, NGW, lane, 0);
                transpose_many(kp->odd_w_out, 1, 1024, 1024, W_OUT_O, 0, scr, gw, NGW, lane, 0);
                transpose_many(kp->pool_w, 4, 128, 128, W_POOL, 128 * 128, scr, gw, NGW, lane, 0);
                transpose_many(kp->router_w, 2, 1024, 32, W_RT, 128 * 1024, scr, gw, NGW, lane, 0);
                __syncthreads();
                convert_fp8_queue(kp->moe_w_gu, kp->moe_w_dn, W_GU, W_DN, (float*)lds, (volatile int*)(lds + LDS_MISC + 256), ctl + CW_Q, tid, 32.0f);
                for (int i = vb * NTHR + tid; i < 4 * 128 * 128; i += G * NTHR) {
                    const int t = (i >> 7) & 127, s_ = i & 127;
                    W_SGU[i] = (s_ <= t) ? f2bf(kp->sgu_w[i]) : (bf16_t)0;
                }
            }
        }
        else if (ph == 1 || ph == 12 || ph == 20) {
            const int lyr = (ph == 1) ? 0 : 1;
            const bool combine = (ph == 12 || ph == 20), donorm = (ph != 20);
            const int comb_layer = (ph == 12) ? 0 : 1;
            const bool ffn = false;
            const float* ng = (ffn ? kp->norm_ffn_g : kp->norm_mix_g) + lyr * D;
            if (ph == 1) {
                for (int rb = gw * 16; rb < T; rb += NGW * 16) {
                    const int b = rb / S;
                    const float* mm = MOD + ((size_t)lyr * NB + b) * 6144;
                    f32x4 pg[4], ps[4], ph_[4];
#pragma unroll
                    for (int j = 0; j < 4; ++j) { const int c = 4 * lane + 256 * j; pg[j] = *(const f32x4*)(ng + c); const f32x4 s1 = *(const f32x4*)(mm + D + c); ph_[j] = *(const f32x4*)(mm + c);
                        pg[j].x *= (1.f + s1.x); pg[j].y *= (1.f + s1.y); pg[j].z *= (1.f + s1.z); pg[j].w *= (1.f + s1.w); ps[j] = s1; }
                    f32x4 cur[4], nxt[4];
#pragma unroll
                    for (int j = 0; j < 4; ++j) cur[j] = *(const f32x4*)(XIN + (size_t)rb * D + 4 * lane + 256 * j);
                    for (int i = 0; i < 16; ++i) {
                        const int row = rb + i;
                        if (i + 1 < 16) {
#pragma unroll
                            for (int j = 0; j < 4; ++j) nxt[j] = *(const f32x4*)(XIN + (size_t)(row + 1) * D + 4 * lane + 256 * j);
                        }
                        float ss = 0.f;
#pragma unroll
                        for (int j = 0; j < 4; ++j) ss += (cur[j].x * cur[j].x + cur[j].y * cur[j].y) + (cur[j].z * cur[j].z + cur[j].w * cur[j].w);
                        const float r = rsqrtf(wave_sum(ss) * (1.0f / D) + 1e-6f);
#pragma unroll
                        for (int j = 0; j < 4; ++j) {
                            u32x2 o; o.x = pk2(cur[j].x * r * pg[j].x + ph_[j].x, cur[j].y * r * pg[j].y + ph_[j].y); o.y = pk2(cur[j].z * r * pg[j].z + ph_[j].z, cur[j].w * r * pg[j].w + ph_[j].w);
                            *(u32x2*)(HB + (size_t)row * D + 4 * lane + 256 * j) = o;
                        }
#pragma unroll
                        for (int j = 0; j < 4; ++j) cur[j] = nxt[j];
                    }
                }
            } else {
                for (int row0 = gw; row0 < T; row0 += 2 * NGW) {
                    float v[2][2][8];
#pragma unroll
                    for (int j = 0; j < 2; ++j) {
                        const int c = 8 * lane + 512 * j;
                        u32x4 xr[2]; u32x2 yr[2][4];
#pragma unroll
                        for (int q = 0; q < 2; ++q) {
                            const int row = row0 + q * NGW;
                            xr[q] = *(const u32x4*)(XR + (size_t)row * D + c);
#pragma unroll
                            for (int k = 0; k < 4; ++k) yr[q][k] = *(const u32x2*)(Y + ((size_t)row * 4 + k) * D + c);
                        }
#pragma unroll
                        for (int q = 0; q < 2; ++q) {
                            const int row = row0 + q * NGW, b = row / S;
                            const float* gf = MOD + ((size_t)comb_layer * NB + b) * 6144 + 5 * D;
                            float xf[8], acc[8];
                            unpack8(xr[q], xf);
#pragma unroll
                            for (int i = 0; i < 8; ++i) acc[i] = 0.f;
#pragma unroll
                            for (int k = 0; k < 4; ++k) {
                                typedef float f2_ __attribute__((ext_vector_type(2)));
                                const f2_ y01 = __builtin_amdgcn_cvt_pk_f32_fp8((int)yr[q][k].x, false), y23 = __builtin_amdgcn_cvt_pk_f32_fp8((int)yr[q][k].x, true);
                                const f2_ y45 = __builtin_amdgcn_cvt_pk_f32_fp8((int)yr[q][k].y, false), y67 = __builtin_amdgcn_cvt_pk_f32_fp8((int)yr[q][k].y, true);
                                acc[0] += y01.x; acc[1] += y01.y; acc[2] += y23.x; acc[3] += y23.y; acc[4] += y45.x; acc[5] += y45.y; acc[6] += y67.x; acc[7] += y67.y; }
                            f32x4 g0 = *(const f32x4*)(gf + c), g1 = *(const f32x4*)(gf + c + 4);
                            g0 = g0 * 0.0625f; g1 = g1 * 0.0625f;
                            float (&vv)[8] = v[q][j];
                            vv[0] = xf[0] + g0.x * acc[0]; vv[1] = xf[1] + g0.y * acc[1]; vv[2] = xf[2] + g0.z * acc[2]; vv[3] = xf[3] + g0.w * acc[3];
                            vv[4] = xf[4] + g1.x * acc[4]; vv[5] = xf[5] + g1.y * acc[5]; vv[6] = xf[6] + g1.z * acc[6]; vv[7] = xf[7] + g1.w * acc[7];
                            if (ph == 20) { *(f32x4*)(OUT + (size_t)row * D + c) = (f32x4){vv[0], vv[1], vv[2], vv[3]}; *(f32x4*)(OUT + (size_t)row * D + c + 4) = (f32x4){vv[4], vv[5], vv[6], vv[7]}; }
                            else *(u32x4*)(XR + (size_t)row * D + c) = pack8(vv);
                        }
                    }
                    if (donorm) {
#pragma unroll
                        for (int q = 0; q < 2; ++q) {
                            const int row = row0 + q * NGW, b = row / S;
                            const float* mm = MOD + ((size_t)lyr * NB + b) * 6144;
                            norm_mod_store8(v[q], ng, mm + D, mm, HB + (size_t)row * D, (unsigned char*)nullptr, lane);
                        }
                    }
                }
            }
            if (ph == 1) {
                __syncthreads();
                float* Cs = (float*)lds;
                float* Bs = Cs + 2048;
                float* As = Bs + 2048;
                for (int item = vb; item < 256; item += G) {
                    const int g = item >> 3, tq = item & 7;
                    for (int idx = tid; idx < 1024; idx += NTHR) {
                        const int i = idx >> 6, pp = idx & 63;
                        Cs[idx * 2] = kp->s5_c_re[(g * 16 + i) * 64 + pp]; Cs[idx * 2 + 1] = kp->s5_c_im[(g * 16 + i) * 64 + pp];
                        Bs[idx * 2] = S5BB[((size_t)g * 1024 + idx) * 2]; Bs[idx * 2 + 1] = S5BB[((size_t)g * 1024 + idx) * 2 + 1];
                    }
                    { const int pp = tid >> 3, tl = tid & 7; As[tid * 2] = PW[((g * 64 + pp) * 65 + tq * 8 + tl) * 2]; As[tid * 2 + 1] = PW[((g * 64 + pp) * 65 + tq * 8 + tl) * 2 + 1]; }
                    __syncthreads();
                    const int v0 = tid * 4, tl = v0 >> 8, i = (v0 >> 4) & 15, j0 = v0 & 15;
                    float acc[4] = {0.f, 0.f, 0.f, 0.f};
                    for (int pp = 0; pp < 64; ++pp) {
                        const float cr = Cs[(i * 64 + pp) * 2], ci = Cs[(i * 64 + pp) * 2 + 1];
                        const float ar = As[(pp * 8 + tl) * 2], ai = As[(pp * 8 + tl) * 2 + 1];
                        const f32x4 b01 = *(const f32x4*)(Bs + (pp * 16 + j0) * 2), b23 = *(const f32x4*)(Bs + (pp * 16 + j0) * 2 + 4);
                        const float wr_ = cr * ar - ci * ai, wi_ = cr * ai + ci * ar;
                        acc[0] += wr_ * b01.x - wi_ * b01.y; acc[1] += wr_ * b01.z - wi_ * b01.w; acc[2] += wr_ * b23.x - wi_ * b23.y; acc[3] += wr_ * b23.z - wi_ * b23.w;
                    }
                    *(f32x4*)(KTAB + (((size_t)g * 64 + tq * 8 + tl) * 16 + i) * 16 + j0) = (f32x4){acc[0], acc[1], acc[2], acc[3]};
                    __syncthreads();
                }
            }
        }
        else if (ph == 2) {
            {
                DenseOrder so; so.go.init(T / 256, 4, G, vb);
                auto f = [=](const pg8::Unit& u, const pg8::NoCtx&, int ai, int m, int bj, int r, int c, f32x4 v0, f32x4 v1) -> float {
                        const int row = u.pm * 256 + r, col = u.pn * 256 + c; float ss = 0.f;
                        u32x4 o; o.x = pk2(v0.x, v0.y); o.y = pk2(v0.z, v0.w); o.z = pk2(v1.x, v1.y); o.w = pk2(v1.z, v1.w);
                        if (col < 384) ss = ((v0.x * v0.x + v0.y * v0.y) + (v0.z * v0.z + v0.w * v0.w)) + ((v1.x * v1.x + v1.y * v1.y) + (v1.z * v1.z + v1.w * v1.w));
                        if (col < 416) *(u32x4*)(Z + (size_t)row * 1024 + col) = o;
                        else if (col < 928) {
                            const int ch = col - 416, g = ch >> 4, j = ch & 15, b = row / S, t = row % S;
                            *(u32x4*)(AS5 + ((size_t)g * 512 + b * 64 + (t >> 6)) * 1152 + 128 + (t & 63) * 16 + j) = o;
                        }
                        return ss;
                    };
                auto re = [=](const pg8::Unit& u, int ai, int m, int r, int wc, int fq, float part) {
                        if (u.pn < 2) {
                            part += __shfl_xor(part, 16); part += __shfl_xor(part, 32);
                            if (fq == 0) RSP[((size_t)(u.pm * 256 + r) * 2 + u.pn) * 4 + wc] = part;
                        }
                    };
                pg8::gemm_phase<false, false, true>(tid, (PG8_LAS unsigned char*)lds, pg8::Gemm{HB, W_IN_E, D, D, D}, so, pg8::make_epi_row<true>(pg8::NoPre{}, f, re));
            }
            {
                float* KT = (float*)lds;
                float* Cs = KT + 64 * 256;
                float* PWt = Cs + 2048;
                float* PWe = PWt + 1024;
                float* BBe = PWe + 2048;
                for (int item = vb; item < 256; item += G) {
                    const int g = item >> 3, tq = item & 7;
                    __syncthreads();
                    const int ntau = 8 * tq + 8;
                    for (int idx = tid; idx < ntau * 64; idx += NTHR) *(f32x4*)(KT + idx * 4) = *(const f32x4*)(KTAB + (size_t)g * 64 * 256 + idx * 4);
                    for (int idx = tid; idx < 1024; idx += NTHR) { const int i = idx >> 6, pp = idx & 63;
                        Cs[idx * 2] = kp->s5_c_re[(g * 16 + i) * 64 + pp]; Cs[idx * 2 + 1] = kp->s5_c_im[(g * 16 + i) * 64 + pp]; }
                    { const int pp = tid >> 3, tl = tid & 7; PWt[tid * 2] = PW[((g * 64 + pp) * 65 + tq * 8 + tl + 1) * 2]; PWt[tid * 2 + 1] = PW[((g * 64 + pp) * 65 + tq * 8 + tl + 1) * 2 + 1]; }
                    const int ri_e = tq >> 2, p0_e = (tq & 3) * 16;
                    for (int idx = tid; idx < 1024; idx += NTHR) { const int pl = idx >> 6, tau = idx & 63;
                        PWe[idx * 2] = PW[((g * 64 + p0_e + pl) * 65 + tau) * 2]; PWe[idx * 2 + 1] = PW[((g * 64 + p0_e + pl) * 65 + tau) * 2 + 1]; }
                    if (tid < 256) { const int pl = tid >> 4, j = tid & 15; BBe[tid * 2] = S5BB[((g * 64 + p0_e + pl) * 16 + j) * 2]; BBe[tid * 2 + 1] = S5BB[((g * 64 + p0_e + pl) * 16 + j) * 2 + 1]; }
                    __syncthreads();
                    for (int it = tid; it < 16 * 128; it += NTHR) {
                        const int pl = it >> 7, k8 = it & 127, s_ = k8 >> 1, j0 = (k8 & 1) * 8;
                        const float pr = PWe[(pl * 64 + 63 - s_) * 2], pi = PWe[(pl * 64 + 63 - s_) * 2 + 1];
                        float o[8];
#pragma unroll
                        for (int j = 0; j < 8; ++j) { const float br = BBe[(pl * 16 + j0 + j) * 2], bi = BBe[(pl * 16 + j0 + j) * 2 + 1]; o[j] = ri_e ? (pr * bi + pi * br) : (pr * br - pi * bi); }
                        u32x4 w; w.x = pk2(o[0], o[1]); w.y = pk2(o[2], o[3]); w.z = pk2(o[4], o[5]); w.w = pk2(o[6], o[7]);
                        *(u32x4*)(BT_END + ((size_t)g * 128 + ri_e * 64 + p0_e + pl) * 1024 + k8 * 8) = w;
                    }
                    for (int it = tid; it < 128 * 144; it += NTHR) {
                        const int rl = it / 144, k8 = it % 144, tl = rl >> 4, i = rl & 15, t = 8 * tq + tl;
                        float o[8];
                        if (k8 < 16) {
                            const int ri = k8 >> 3, p0 = (k8 & 7) * 8;
#pragma unroll
                            for (int j = 0; j < 8; ++j) {
                                const float cr = Cs[(i * 64 + p0 + j) * 2], ci = Cs[(i * 64 + p0 + j) * 2 + 1];
                                const float pr = PWt[((p0 + j) * 8 + tl) * 2], pi = PWt[((p0 + j) * 8 + tl) * 2 + 1];
                                o[j] = ri ? -(cr * pi + ci * pr) : (cr * pr - ci * pi);
                            }
                        } else {
                            const int kk = (k8 - 16) * 8, s_ = kk >> 4, j0 = kk & 15;
                            if (s_ <= t) { const f32x4 a = *(const f32x4*)(KT + (t - s_) * 256 + i * 16 + j0), c4 = *(const f32x4*)(KT + (t - s_) * 256 + i * 16 + j0 + 4);
                                o[0] = a.x; o[1] = a.y; o[2] = a.z; o[3] = a.w; o[4] = c4.x; o[5] = c4.y; o[6] = c4.z; o[7] = c4.w; }
                            else {
#pragma unroll
                                for (int j = 0; j < 8; ++j) o[j] = 0.f; }
                        }
                        u32x4 w; w.x = pk2(o[0], o[1]); w.y = pk2(o[2], o[3]); w.z = pk2(o[4], o[5]); w.w = pk2(o[6], o[7]);
                        *(u32x4*)(BT_MAIN + ((size_t)g * 1024 + 8 * tq * 16 + rl) * 1152 + k8 * 8) = w;
                    }
                }
                __syncthreads();
            }
        }
        else if (ph == 4) {
            {
                DenseOrder so; so.go.init(T / 256, 7, G, vb);
                struct UpCtx { float rs[8]; };
                auto pre = [=](const pg8::Unit& u, int wr, int wc, int fr, int fq, const PG8_LAS unsigned char* cxl) {
                        UpCtx cx; const int st = (u.pn >= 3) ? 1 : 0; const float inv = st ? (1.f / 128.f) : (1.f / 256.f);
#pragma unroll
                        for (int q = 0; q < 8; ++q) { const int row = u.pm * 256 + (q >> 2) * 128 + wr * 64 + (q & 3) * 16 + fr;
                            const f32x4 pp = *(const f32x4*)(RSP + ((size_t)row * 2 + st) * 4);
                            cx.rs[q] = rsqrtf(((pp.x + pp.y) + (pp.z + pp.w)) * inv + 1e-6f); }
                        return cx; };
                auto f = [=](const pg8::Unit& u, const UpCtx& cx, int ai, int m, int bj, int r, int c, f32x4 v0, f32x4 v1) {
                            const float rs = cx.rs[ai * 4 + m];
                            bf16_t* o = QKVRAW + (size_t)(u.pm * 256 + r) * 1792 + u.pn * 256 + c;
                            u32x4 a; a.x = pk2(v0.x * rs, v0.y * rs); a.y = pk2(v0.z * rs, v0.w * rs); a.z = pk2(v1.x * rs, v1.y * rs); a.w = pk2(v1.z * rs, v1.w * rs); *(u32x4*)o = a;
                        };
                pg8::gemm_phase<false, false, true>(tid, (PG8_LAS unsigned char*)lds, pg8::Gemm{Z, W_UP, 1024, 384, 384}, so, pg8::make_epi_perm(pre, f));
            }
            for (int u = (vb >= 128 ? vb - 128 : vb + 128); u < 128; u += G) {
                const int g = u >> 2, pm = u & 3;
                sg_tile(tid, lds, AS5 + ((size_t)g * 512 + pm * 128) * 1152 + 128, 1152, BT_END + (size_t)g * 128 * 1024, 1024, 1024,
                    [=](int r, int c, f32x4 v0, f32x4 v1) {
                        float* o = LEND + ((size_t)g * 512 + pm * 128 + r) * 128 + c;
                        *(f32x4*)o = v0; *(f32x4*)(o + 16) = v1;
                    });
            }
        }
        else if (ph == 5) {
            bf16_t* vts = (bf16_t*)lds;
            const float qscale = 0.10206207261596577f * 1.4426950408889634f;
            const int hh = lane >> 3, pp = lane & 7;
            float gq[12], gk[12];
#pragma unroll
            for (int g3 = 0; g3 < 3; ++g3)
#pragma unroll
                for (int e = 0; e < 4; ++e) { gq[g3 * 4 + e] = kp->q_head_g[32 * g3 + 4 * pp + e] * qscale; gk[g3 * 4 + e] = kp->k_head_g[32 * g3 + 4 * pp + e]; }
            float invf[4];
#pragma unroll
            for (int e = 0; e < 4; ++e) invf[e] = exp2f(-(float)(4 * (pp & 3) + e) * (13.287712379549449f / 16.0f));
            for (int tile = vb; tile < T / 64; tile += G) {
                u32x2 cq[3], ck[3], nq[3], nk[3]; u32x4 cv, nv; int cpos, npos;
#define P5_LOAD(row_, Q_, K_, V_, P_) do { const bf16_t* base_ = QKVRAW + (size_t)(row_) * 1792; \
                    _Pragma("unroll") for (int g3 = 0; g3 < 3; ++g3) Q_[g3] = *(const u32x2*)(base_ + hh * 96 + 32 * g3 + 4 * pp); \
                    K_[0] = *(const u32x2*)(base_ + 768 + hh * 128 + 4 * pp); K_[1] = *(const u32x2*)(base_ + 768 + hh * 128 + 32 + 4 * pp); K_[2] = *(const u32x2*)(Z + (size_t)(row_) * 1024 + 384 + 4 * pp); \
                    V_ = *(const u32x4*)(base_ + 768 + hh * 128 + 64 + 8 * pp); P_ = kp->pos[row_]; } while (0)
                P5_LOAD(tile * 64 + wave * 8, cq, ck, cv, cpos);
                for (int tt = 0; tt < 8; ++tt) {
                    const int tl = wave * 8 + tt, row = tile * 64 + tl, b = row / S, t = row % S;
                    if (tt + 1 < 8) P5_LOAD(row + 1, nq, nk, nv, npos);
                    float qv[12], kv[12];
#pragma unroll
                    for (int g3 = 0; g3 < 3; ++g3) {
                        qv[4 * g3 + 0] = __uint_as_float(cq[g3].x << 16); qv[4 * g3 + 1] = __uint_as_float(cq[g3].x & 0xffff0000u); qv[4 * g3 + 2] = __uint_as_float(cq[g3].y << 16); qv[4 * g3 + 3] = __uint_as_float(cq[g3].y & 0xffff0000u);
                        kv[4 * g3 + 0] = __uint_as_float(ck[g3].x << 16); kv[4 * g3 + 1] = __uint_as_float(ck[g3].x & 0xffff0000u); kv[4 * g3 + 2] = __uint_as_float(ck[g3].y << 16); kv[4 * g3 + 3] = __uint_as_float(ck[g3].y & 0xffff0000u);
                    }
                    float sq = 0.f, sk = 0.f;
#pragma unroll
                    for (int j = 0; j < 12; ++j) { sq += qv[j] * qv[j]; sk += kv[j] * kv[j]; }
                    sq += __shfl_xor(sq, 1); sq += __shfl_xor(sq, 2); sq += __shfl_xor(sq, 4);
                    sk += __shfl_xor(sk, 1); sk += __shfl_xor(sk, 2); sk += __shfl_xor(sk, 4);
                    const float rq = rsqrtf(sq * (1.f / 96.f) + 1e-6f), rk = rsqrtf(sk * (1.f / 96.f) + 1e-6f);
#pragma unroll
                    for (int j = 0; j < 12; ++j) { qv[j] *= rq * gq[j]; kv[j] *= rk * gk[j]; }
                    const float posf = (float)cpos; const bool lo = pp < 4;
#pragma unroll
                    for (int e = 0; e < 4; ++e) {
                        const float ang = posf * invf[e];
                        const float kq = rintf(ang * 0.15915494309189535f);
                        float rr = __builtin_fmaf(-kq, 6.28318548202514648f, ang); rr = __builtin_fmaf(-kq, -1.7484556e-7f, rr);
                        const float cs = __cosf(rr), sn = __sinf(rr);
                        const float qo = __shfl_xor(qv[8 + e], 4), ko = __shfl_xor(kv[8 + e], 4);
                        qv[8 + e] = lo ? (qv[8 + e] * cs - qo * sn) : (qo * sn + qv[8 + e] * cs);
                        kv[8 + e] = lo ? (kv[8 + e] * cs - ko * sn) : (ko * sn + kv[8 + e] * cs);
                    }
                    bf16_t* qd = Qb + (((size_t)b * 8 + hh) * S + t) * 96 + 4 * pp; bf16_t* kd = Kb + (((size_t)b * 8 + hh) * S + t) * 96 + 4 * pp;
#pragma unroll
                    for (int g3 = 0; g3 < 3; ++g3) {
                        u32x2 o; o.x = pk2(qv[4 * g3], qv[4 * g3 + 1]); o.y = pk2(qv[4 * g3 + 2], qv[4 * g3 + 3]); *(u32x2*)(qd + 32 * g3) = o;
                        u32x2 o2; o2.x = pk2(kv[4 * g3], kv[4 * g3 + 1]); o2.y = pk2(kv[4 * g3 + 2], kv[4 * g3 + 3]); *(u32x2*)(kd + 32 * g3) = o2;
                    }
                    { const unsigned w4[4] = {cv.x, cv.y, cv.z, cv.w};
#pragma unroll
                      for (int j = 0; j < 8; ++j) vts[(hh * 64 + 8 * pp + j) * 64 + tl] = (bf16_t)((j & 1) ? (w4[j >> 1] >> 16) : (w4[j >> 1] & 0xffffu)); }
#pragma unroll
                    for (int g3 = 0; g3 < 3; ++g3) { cq[g3] = nq[g3]; ck[g3] = nk[g3]; }
                    cv = nv; cpos = npos;
                }
#undef P5_LOAD
                __syncthreads();
                {
                    const int hd = tid, b = (tile * 64) / S, t0 = (tile * 64) % S;
                    bf16_t* dst = VT + (((size_t)b * 8 + (hd >> 6)) * 64 + (hd & 63)) * S + t0;
#pragma unroll
                    for (int i = 0; i < 8; ++i) *(u32x4*)(dst + i * 8) = *(const u32x4*)(vts + hd * 64 + i * 8);
                }
                __syncthreads();
            }
            if (wave == 0) {
                for (int ch = vb * 64 + lane; ch < NB * 32 * 64; ch += G * 64) {
                    const int pp = ch & 63, g = (ch >> 6) & 31, b = ch >> 11;
                    const float ar = PW[((g * 64 + pp) * 65 + 64) * 2], ai = PW[((g * 64 + pp) * 65 + 64) * 2 + 1];
                    float cr = 0.f, ci = 0.f;
                    for (int c0 = 0; c0 < 64; c0 += 16) {
                        float lr[16], li[16];
#pragma unroll
                        for (int u = 0; u < 16; ++u) { const float* le = LEND + ((size_t)g * 512 + b * 64 + c0 + u) * 128; lr[u] = le[pp]; li[u] = le[64 + pp]; }
#pragma unroll
                        for (int u = 0; u < 16; ++u) {
                            bf16_t* dst = AS5 + ((size_t)g * 512 + b * 64 + c0 + u) * 1152;
                            dst[pp] = f2bf(cr); dst[64 + pp] = f2bf(ci);
                            const float nr = ar * cr - ai * ci + lr[u], ni = ar * ci + ai * cr + li[u];
                            cr = nr; ci = ni;
                        }
                    }
                }
            }
        }
        else if (ph == 6) {
            unsigned char* Kr = lds;
            unsigned char* Vr = lds + 3 * 64 * 208;
            const int r32 = lane & 31, hi = lane >> 5;
#define ATT_MFMA_C(D, A, B, C) asm volatile("s_nop 1\n\tv_mfma_f32_32x32x16_bf16 %0, %1, %2, %3" : "+a"(D) : "v"(A), "v"(B), "a"(C))
#define ATT_MFMA(D, A, B)      asm volatile("s_nop 1\n\tv_mfma_f32_32x32x16_bf16 %0, %1, %2, %0" : "+a"(D) : "v"(A), "v"(B))
            for (int ui_ = 0; ui_ < 4 * (1 + PROBE_ATT2); ++ui_) { const int ui = ui_ & 3;
                if (vb >= 256) break;
                const int bh = vb & 63, kq = vb >> 6;
                const int qb = (ui == 0) ? 15 - kq : (ui == 1) ? 8 + kq : (ui == 2) ? 7 - kq : kq;
                const int q0 = qb * 256 + wave * 32;
                const bf16_t* Qg = Qb + ((size_t)bh * S + q0 + r32) * 96;
                const bf16_t* Kg = Kb + (size_t)bh * S * 96;
                const bf16_t* Vg = VT + (size_t)bh * 64 * S;
                unsigned char* Qs = lds + 3 * 64 * (208 + 136) + (wave * 32 + r32) * 208;
                __syncthreads();
#pragma unroll
                for (int d0 = 0; d0 < 6; ++d0) *(bf16x8*)(Qs + d0 * 32 + hi * 16) = *(const bf16x8*)(Qg + d0 * 16 + hi * 8);
                const int ntile = 4 * (qb + 1);
                const int ntw = (q0 + 31) / 64 + 1;
                const int kr0 = tid >> 3, kc0 = tid & 7;
                const int vr = tid >> 3, vc = tid & 7;
                u32x2 rk0, rk1, rk2; u32x4 rv;
#define ATT_LOAD(t_) do { { const u32x2* kp_ = (const u32x2*)(Kg + (size_t)((t_) * 64 + kr0) * 96 + kc0 * 12); rk0 = kp_[0]; rk1 = kp_[1]; rk2 = kp_[2]; } \
                    rv = *(const u32x4*)(Vg + (size_t)vr * S + (t_) * 64 + vc * 8); } while (0)
#define ATT_WRITE(t_) do { unsigned char* Ks_ = Kr + ((t_) % 3) * (64 * 208); unsigned char* Vs_ = Vr + ((t_) % 3) * (64 * 136); \
                    { u32x2* kd_ = (u32x2*)(Ks_ + kr0 * 208 + kc0 * 24); kd_[0] = rk0; kd_[1] = rk1; kd_[2] = rk2; } \
                    { u32x2 a_; a_.x = rv.x; a_.y = rv.y; u32x2 b_; b_.x = rv.z; b_.y = rv.w; *(u32x2*)(Vs_ + vr * 136 + vc * 16) = a_; *(u32x2*)(Vs_ + vr * 136 + vc * 16 + 8) = b_; } } while (0)
#define ATT_QK(t_) do { const unsigned char* Ks_ = Kr + ((t_) % 3) * (64 * 208); \
                    _Pragma("unroll") for (int d0 = 0; d0 < 6; ++d0) { \
                        const bf16x8 k0_ = *(const bf16x8*)(Ks_ + r32 * 208 + d0 * 32 + hi * 16); const bf16x8 k1_ = *(const bf16x8*)(Ks_ + (32 + r32) * 208 + d0 * 32 + hi * 16); \
                        const bf16x8 q_ = *(const bf16x8*)(Qs + d0 * 32 + hi * 16); \
                        if (d0 == 0) { ATT_MFMA_C(sA0, k0_, q_, negm); ATT_MFMA_C(sA1, k1_, q_, negm); } else { ATT_MFMA(sA0, k0_, q_); ATT_MFMA(sA1, k1_, q_); } } } while (0)
                f32x16 o0, o1, sA0, sA1, negm;
#pragma unroll
                for (int r = 0; r < 16; ++r) { o0[r] = 0.f; o1[r] = 0.f; negm[r] = 0.f; }
                float m_ref = 0.f, l_run = 0.f;
                ATT_LOAD(0); ATT_WRITE(0);
                if (ntile > 1) { ATT_LOAD(1); ATT_WRITE(1); }
                __syncthreads();
                ATT_QK(0);
                for (int t = 0; t < ntile; ++t) {
                    __syncthreads();
                    if (t + 2 < ntile) ATT_LOAD(t + 2);
                    if (t < ntw) {
                        asm volatile("s_nop 15\n\ts_nop 7" ::: "memory");
                        f32x16 s0 = sA0, s1 = sA1;
                        asm volatile("" : "+v"(s0), "+v"(s1));
                        if (t * 64 + 63 > q0) {
                            const int qi = q0 + r32;
#pragma unroll
                            for (int r = 0; r < 16; ++r) { const int key = t * 64 + crow(r, hi); if (key > qi) s0[r] = -INFINITY; if (key + 32 > qi) s1[r] = -INFINITY; }
                        }
                        float mx;
                        { auto max3 = [](float a_, float b_, float c_) { float r_; asm("v_max3_f32 %0, %1, %2, %3" : "=v"(r_) : "v"(a_), "v"(b_), "v"(c_)); return r_; };
                          float ma = max3(s0[0], s0[1], s1[0]), mb = max3(s0[2], s0[3], s1[1]); ma = max3(ma, s1[2], s1[3]);
#pragma unroll
                          for (int r = 4; r < 16; r += 4) { ma = max3(ma, s0[r], s0[r + 1]); mb = max3(mb, s0[r + 2], s0[r + 3]); ma = max3(ma, s1[r], s1[r + 1]); mb = max3(mb, s1[r + 2], s1[r + 3]); }
                          mx = max3(ma, mb, ma); mx = max3(mx, __shfl_xor(mx, 32), mx); }
                        if (__any(mx > 8.0f) || t == 0) {
                            const float dl = (t == 0) ? mx : fmaxf(mx, 0.f);
                            const float alpha = __builtin_amdgcn_exp2f(-dl);
                            m_ref += dl; l_run *= alpha;
#pragma unroll
                            for (int r = 0; r < 16; ++r) { s0[r] -= dl; s1[r] -= dl; }
                            if (t > 0) {
#pragma unroll
                                for (int r = 0; r < 16; ++r) { o0[r] *= alpha; o1[r] *= alpha; }
                            }
#pragma unroll
                            for (int r = 0; r < 16; ++r) negm[r] = -m_ref;
                        }
                        const bool doqk = t + 1 < ntw;
                        const unsigned char* Vs_ = Vr + (t % 3) * (64 * 136);
                        const unsigned char* Ks_ = Kr + ((t + 1) % 3) * (64 * 208);
                        typedef float f32x2_ __attribute__((ext_vector_type(2)));
                        f32x2_ ls2 = {0.f, 0.f};
#pragma unroll
                        for (int g4 = 0; g4 < 4; ++g4) {
                            const int kb = g4 >> 1, ks = g4 & 1;
                            u32x4 w;
                            if (kb == 0) {
#pragma unroll
                                for (int r = 0; r < 8; ++r) s0[8 * ks + r] = __builtin_amdgcn_exp2f(s0[8 * ks + r]);
#pragma unroll
                                for (int r = 0; r < 8; r += 2) ls2 += (f32x2_){s0[8 * ks + r], s0[8 * ks + r + 1]};
                                w.x = pk2(s0[8 * ks + 0], s0[8 * ks + 1]); w.y = pk2(s0[8 * ks + 2], s0[8 * ks + 3]); w.z = pk2(s0[8 * ks + 4], s0[8 * ks + 5]); w.w = pk2(s0[8 * ks + 6], s0[8 * ks + 7]);
                            } else {
#pragma unroll
                                for (int r = 0; r < 8; ++r) s1[8 * ks + r] = __builtin_amdgcn_exp2f(s1[8 * ks + r]);
#pragma unroll
                                for (int r = 0; r < 8; r += 2) ls2 += (f32x2_){s1[8 * ks + r], s1[8 * ks + r + 1]};
                                w.x = pk2(s1[8 * ks + 0], s1[8 * ks + 1]); w.y = pk2(s1[8 * ks + 2], s1[8 * ks + 3]); w.z = pk2(s1[8 * ks + 4], s1[8 * ks + 5]); w.w = pk2(s1[8 * ks + 6], s1[8 * ks + 7]);
                            }
                            const bf16x8 pfg = __builtin_bit_cast(bf16x8, w);
                            const int koff = (kb * 32 + 16 * ks + 4 * hi) * 2;
#pragma unroll
                            for (int dvb = 0; dvb < 2; ++dvb) {
                                const unsigned char* vp = Vs_ + (dvb * 32 + r32) * 136 + koff;
                                const u32x2 lo = *(const u32x2*)vp, hi2 = *(const u32x2*)(vp + 16);
                                u32x4 wv; wv.x = lo.x; wv.y = lo.y; wv.z = hi2.x; wv.w = hi2.y;
                                const bf16x8 vf = __builtin_bit_cast(bf16x8, wv);
                                if (dvb == 0) ATT_MFMA(o0, vf, pfg); else ATT_MFMA(o1, vf, pfg);
                                __builtin_amdgcn_sched_barrier(0);
                            }
                            if (doqk) {
#pragma unroll
                                for (int q3 = 0; q3 < 3; ++q3) {
                                    const int qi3 = g4 * 3 + q3, d0 = qi3 >> 1, kq = qi3 & 1;
                                    const bf16x8 k_ = *(const bf16x8*)(Ks_ + (kq * 32 + r32) * 208 + d0 * 32 + hi * 16);
                                    const bf16x8 q_ = *(const bf16x8*)(Qs + d0 * 32 + hi * 16);
                                    if (kq == 0) { if (d0 == 0) ATT_MFMA_C(sA0, k_, q_, negm); else ATT_MFMA(sA0, k_, q_); }
                                    else         { if (d0 == 0) ATT_MFMA_C(sA1, k_, q_, negm); else ATT_MFMA(sA1, k_, q_); }
                                    __builtin_amdgcn_sched_barrier(0);
                                }
                            }
                            __builtin_amdgcn_sched_barrier(0);
                        }
                        l_run += ls2.x + ls2.y;
                    }
                    if (t + 2 < ntile) ATT_WRITE(t + 2);
                }
                asm volatile("s_nop 15\n\ts_nop 7" ::: "memory");
                l_run += __shfl_xor(l_run, 32);
                const float rl = __builtin_amdgcn_rcpf(l_run);
                const int b = bh >> 3, h = bh & 7;
                bf16_t* orow = MIXIN + ((size_t)b * S + q0 + r32) * 1024 + h * 64;
#pragma unroll
                for (int rg = 0; rg < 4; ++rg) {
                    u32x2 a; a.x = pk2(o0[4 * rg] * rl, o0[4 * rg + 1] * rl); a.y = pk2(o0[4 * rg + 2] * rl, o0[4 * rg + 3] * rl);
                    *(u32x2*)(orow + 8 * rg + 4 * hi) = a;
                    u32x2 c2; c2.x = pk2(o1[4 * rg] * rl, o1[4 * rg + 1] * rl); c2.y = pk2(o1[4 * rg + 2] * rl, o1[4 * rg + 3] * rl);
                    *(u32x2*)(orow + 32 + 8 * rg + 4 * hi) = c2;
                }
            }
#undef ATT_MFMA_C
#undef ATT_MFMA
#undef ATT_LOAD
#undef ATT_WRITE
#undef ATT_QK
            __syncthreads();
            {
                S5Order so; so.G = G; so.c = vb;
                auto f = [=](const pg8::Unit& u, const pg8::NoCtx&, int ai, int m, int bj, int r, int c, f32x4 v0, f32x4 v1) {
                        const int g = u.aux, mr = (u.pm & 1) * 256 + r, b = mr >> 6, ck = mr & 63;
#pragma unroll
                        for (int h = 0; h < 2; ++h) {
                            const int n = u.pn * 256 + c + 16 * h; const f32x4 v = h ? v1 : v0;
                            const int tq = n >> 4, i = n & 15;
                            const u32x2 uu = *(const u32x2*)(AS5 + ((size_t)g * 512 + mr) * 1152 + 128 + n);
                            const f32x4 dd = *(const f32x4*)(s5d + g * 16 + i);
                            const float y0 = v.x + dd.x * __uint_as_float(uu.x << 16), y1 = v.y + dd.y * __uint_as_float(uu.x & 0xffff0000u),
                                        y2 = v.z + dd.z * __uint_as_float(uu.y << 16), y3 = v.w + dd.w * __uint_as_float(uu.y & 0xffff0000u);
                            u32x2 o; o.x = pk2(gelu_tanh(y0), gelu_tanh(y1)); o.y = pk2(gelu_tanh(y2), gelu_tanh(y3));
                            *(u32x2*)(GACT + ((size_t)b * S + ck * 64 + tq) * 512 + g * 16 + i) = o;
                        }
                    };
                const int tid2 = wbase + lane_id();
                pg8::gemm_phase(tid2, (PG8_LAS unsigned char*)lds, pg8::Gemm{AS5, BT_MAIN, 1152, 1152, 1152}, so, pg8::make_epi(pg8::NoPre{}, f));
            }
        }
        else if (ph == 7) {
            {
                DenseOrder so; so.go.init(T / 256, 2, G, vb);
                auto f = [=](const pg8::Unit& u, const pg8::NoCtx&, int ai, int m, int bj, int r, int c, f32x4 v0, f32x4 v1) {
                        const int row = u.pm * 256 + r, col = u.pn * 256 + c;
                        float gv[8]; unpack8(*(const u32x4*)(GACT + (size_t)row * 512 + col), gv);
                        const f32x4 b0 = *(const f32x4*)(glub + col), b1 = *(const f32x4*)(glub + col + 4);
                        u32x4 o; o.x = pk2(gv[0] * sigmoidf_(v0.x + b0.x), gv[1] * sigmoidf_(v0.y + b0.y)); o.y = pk2(gv[2] * sigmoidf_(v0.z + b0.z), gv[3] * sigmoidf_(v0.w + b0.w));
                        o.z = pk2(gv[4] * sigmoidf_(v1.x + b1.x), gv[5] * sigmoidf_(v1.y + b1.y)); o.w = pk2(gv[6] * sigmoidf_(v1.z + b1.z), gv[7] * sigmoidf_(v1.w + b1.w));
                        *(u32x4*)(MIXIN + (size_t)row * 1024 + 512 + col) = o;
                    };
                pg8::gemm_phase<false, false, true>(tid, (PG8_LAS unsigned char*)lds, pg8::Gemm{GACT, W_GLU, 512, 512, 512}, so, pg8::make_epi_perm(pg8::NoPre{}, f));
            }
        }
        else if (ph == 8 || ph == 16) {
            const int lyr = (ph == 8) ? 0 : 1;
            const bf16_t* W = lyr ? W_OUT_O : W_OUT_E;

            {
                DenseOrder so; so.go.init(T / 256, 4, G, vb);
                struct OCtx { f32x4 gm[2][2]; };
                struct OG { u32x4 x[2][2]; };
                auto pre = [=](const pg8::Unit& u, int wr, int wc, int fr, int fq, const PG8_LAS unsigned char* cxl) {
                        OCtx cx; const int b = (u.pm * 256) / S; const float* gm = MOD + ((size_t)lyr * NB + b) * 6144 + 2 * D;
#pragma unroll
                        for (int bj = 0; bj < 2; ++bj)
#pragma unroll
                            for (int h = 0; h < 2; ++h) cx.gm[bj][h] = *(const f32x4*)(gm + u.pn * 256 + bj * 128 + wc * 32 + 4 * fq + 16 * h);
                        return cx; };
                auto gp = [=](const pg8::Unit& u, const OCtx&, int r, int wc, int fq) {
                        OG g; const int row = u.pm * 256 + r;
#pragma unroll
                        for (int bj = 0; bj < 2; ++bj)
#pragma unroll
                            for (int h = 0; h < 2; ++h) { const int col = u.pn * 256 + bj * 128 + wc * 32 + 4 * fq + 16 * h;
                                if (lyr == 0) g.x[bj][h] = *(const u32x4*)(XIN + (size_t)row * D + col);
                                else { const u32x2 xx = *(const u32x2*)(XR + (size_t)row * D + col); g.x[bj][h] = (u32x4){xx.x, xx.y, 0u, 0u}; } }
                        return g; };
                auto f = [=](const pg8::Unit& u, const OCtx& cx, const OG& g, int ai, int m, int bj, int r, int c, f32x4 v0, f32x4 v1) {
                        const int row = u.pm * 256 + r;
#pragma unroll
                        for (int h = 0; h < 2; ++h) {
                            const int col = u.pn * 256 + c + 16 * h; const f32x4 v = h ? v1 : v0;
                            const f32x4 g4 = cx.gm[bj][h]; const u32x4 xx = g.x[bj][h]; f32x4 xs;
                            if (lyr == 0) { xs.x = __uint_as_float(xx.x); xs.y = __uint_as_float(xx.y); xs.z = __uint_as_float(xx.z); xs.w = __uint_as_float(xx.w); }
                            else { xs.x = __uint_as_float(xx.x << 16); xs.y = __uint_as_float(xx.x & 0xffff0000u); xs.z = __uint_as_float(xx.y << 16); xs.w = __uint_as_float(xx.y & 0xffff0000u); }
                            u32x2 o; o.x = pk2(xs.x + g4.x * v.x, xs.y + g4.y * v.y); o.y = pk2(xs.z + g4.z * v.z, xs.w + g4.w * v.w);
                            *(u32x2*)(XR + (size_t)row * D + col) = o;
                        }
                    };
                pg8::gemm_phase(tid, (PG8_LAS unsigned char*)lds, pg8::Gemm{MIXIN, W, D, D, D}, so, pg8::make_epi_g(pre, gp, f));
            }
        }
        else if (mph == 9) {
            const bf16_t* W = W_RT + (size_t)layer * 128 * 1024;
            const float* rb = rtb_all + layer * 32;
            unsigned char* Wl = lds;
            unsigned char* ht = lds + 32 * 2064;
            float* lgs = (float*)(lds + 64 * 2064);
            unsigned* hist = (unsigned*)(lds + LDS_MISC + 512);
            unsigned* gcnt = ctl + CW_CNT + layer * 64;
            const float* ng = kp->norm_ffn_g + layer * D;
            for (int q = tid; q < 4096; q += NTHR) { const int row = q >> 7, cc = q & 127; *(u32x4*)(Wl + row * 2064 + cc * 16) = *(const u32x4*)(W + (size_t)row * 1024 + cc * 8); }
            for (int tile = vb; tile < T / 128; tile += G) {
              for (int rep_ = 0; rep_ <= PROBE_RT2; ++rep_) {
                if (tid < 64) hist[tid] = 0u;
                for (int qt = 0; qt < 4; ++qt) {
                    {
                        u32x4 xr[4][2];
#pragma unroll
                        for (int q = 0; q < 4; ++q)
#pragma unroll
                            for (int j = 0; j < 2; ++j) xr[q][j] = *(const u32x4*)(XR + (size_t)(tile * 128 + qt * 32 + wave * 4 + q) * D + 8 * lane + 512 * j);
#pragma unroll
                        for (int q = 0; q < 4; ++q) {
                            const int rl = wave * 4 + q, row = tile * 128 + qt * 32 + rl, b = row / S;
                            float v[2][8]; unpack8(xr[q][0], v[0]); unpack8(xr[q][1], v[1]);
                            const float* mm = MOD + ((size_t)layer * NB + b) * 6144 + 3 * D;
                            norm_mod_store8(v, ng, mm + D, mm, (bf16_t*)(ht + rl * 2064), HB8 + (size_t)row * D, lane);
                        }
                    }
                    __syncthreads();
                    const int mb = wave & 1, nb = (wave >> 1) & 1, kq2 = wave >> 2, fr = lane & 15, fq = lane >> 4;
                    f32x4 acc = {0.f, 0.f, 0.f, 0.f};
#pragma unroll 4
                    for (int kk = 0; kk < 16; ++kk) {
                        const int kb = (kq2 * 512 + kk * 32 + fq * 8) * 2;
                        const bf16x8 av = *(const bf16x8*)(ht + (mb * 16 + fr) * 2064 + kb), bv = *(const bf16x8*)(Wl + (nb * 16 + fr) * 2064 + kb);
                        acc = __builtin_amdgcn_mfma_f32_16x16x32_bf16(bv, av, acc, 0, 0, 0);
                    }
                    float* lrow = lgs + (qt * 32 + mb * 16 + fr) * 33 + nb * 16 + 4 * fq;
                    if (kq2 == 0) { lrow[0] = acc.x + rb[nb * 16 + 4 * fq]; lrow[1] = acc.y + rb[nb * 16 + 4 * fq + 1]; lrow[2] = acc.z + rb[nb * 16 + 4 * fq + 2]; lrow[3] = acc.w + rb[nb * 16 + 4 * fq + 3]; }
                    __syncthreads();
                    if (kq2 == 1) { lrow[0] += acc.x; lrow[1] += acc.y; lrow[2] += acc.z; lrow[3] += acc.w; }
                }
              }
                __syncthreads();
                const bool act = tid < 128; const int rr = tid & 127;
                float lg[32];
#pragma unroll
                for (int e = 0; e < 32; ++e) lg[e] = lgs[rr * 33 + e];
                int e0 = 0, e1 = 0, e2 = 0, e3 = 0; float v0_ = 0.f, v1_ = 0.f, v2_ = 0.f, v3_ = 0.f;
#pragma unroll
                for (int k = 0; k < 4; ++k) {
                    float best = -INFINITY; int bi = 0;
#pragma unroll
                    for (int e = 0; e < 32; ++e) { const bool tk = lg[e] > best; best = tk ? lg[e] : best; bi = tk ? e : bi; }
                    if (k == 0) { e0 = bi; v0_ = best; } else if (k == 1) { e1 = bi; v1_ = best; } else if (k == 2) { e2 = bi; v2_ = best; } else { e3 = bi; v3_ = best; }
#pragma unroll
                    for (int e = 0; e < 32; ++e) lg[e] = (e == bi) ? -INFINITY : lg[e];
                }
                const float x1_ = __expf(v1_ - v0_), x2_ = __expf(v2_ - v0_), x3_ = __expf(v3_ - v0_);
                const float rden = 1.0f / (1.0f + x1_ + x2_ + x3_);
                unsigned l0 = 0, l1 = 0, l2 = 0, l3 = 0;
                if (act) { l0 = atomicAdd(hist + e0, 1u); l1 = atomicAdd(hist + e1, 1u); l2 = atomicAdd(hist + e2, 1u); l3 = atomicAdd(hist + e3, 1u); }
                __syncthreads();
                if (tid < 32) hist[32 + tid] = atomicAdd(gcnt + tid, (unsigned)hist[tid]);
                __syncthreads();
                if (act) {
                    const int tok = tile * 128 + tid;
                    size_t idx = (size_t)e0 * T + hist[32 + e0] + l0; EL_SLOT[idx] = tok * 4 + 0; EL_GATE[idx] = rden;
                    idx = (size_t)e1 * T + hist[32 + e1] + l1; EL_SLOT[idx] = tok * 4 + 1; EL_GATE[idx] = x1_ * rden;
                    idx = (size_t)e2 * T + hist[32 + e2] + l2; EL_SLOT[idx] = tok * 4 + 2; EL_GATE[idx] = x2_ * rden;
                    idx = (size_t)e3 * T + hist[32 + e3] + l3; EL_SLOT[idx] = tok * 4 + 3; EL_GATE[idx] = x3_ * rden;
                }
                __syncthreads();
            }
        }
        else if (mph == 10 || mph == 11) {
            int* pst = (int*)(lds + LDS_MISC + 1024);
            if (tid == 0) {
                const unsigned* gcnt = ctl + CW_CNT + layer * 64; int acc = 0;
                for (int e = 0; e < 32; ++e) { const int c = (int)gcnt[e]; pst[e] = acc; pst[64 + e] = c; acc += (c + 255) & ~255; }
                pst[32] = acc;
            }
            __syncthreads();
            const int total_rows = pst[32];
            if (mph == 10) {
                {
                    MoeOrder so; so.go.init(total_rows >> 8, 8, G, vb); so.pst = pst; so.NT = 8; so.ebase = layer * 32; so.el_slot = EL_SLOT;
                    struct G1Ctx { f32x4 b0[2], b1[2]; };
                    auto pre = [=](const pg8::Unit& u, int wr, int wc, int fr, int fq, const PG8_LAS unsigned char* cxl) {
                            G1Ctx cx;
#pragma unroll
                            for (int bj = 0; bj < 2; ++bj) { const int jl = (bj * 4 + wc) * 16 + 4 * fq;
                                cx.b0[bj] = *(const PG8_LAS f32x4*)(cxl + jl * 4); cx.b1[bj] = *(const PG8_LAS f32x4*)(cxl + 512 + jl * 4); }
                            return cx; };
                    auto stg = [=](const pg8::Unit& u, PG8_LAS unsigned char* cb, int wid, int lane) {
                            if (wid == 0) { const float* src = bgu_all + (size_t)(layer * 32 + u.aux) * 2048 + (lane >> 5) * 1024 + u.pn * 128 + (lane & 31) * 4;
                                __builtin_amdgcn_global_load_lds((const unsigned*)src, (PG8_LAS unsigned*)cb, 16, 0, 0); } };
                    auto f = [=](const pg8::Unit& u, const G1Ctx& cx, int ai, int m, int bj, int tr, int c, f32x4 v0, f32x4 v1, PG8_LAS unsigned char* tile) {
                            const int jl = (c >> 5) * 16 + (c & 15);
                            const f32x4 b0 = cx.b0[bj], b1 = cx.b1[bj];
                            typedef float f32x2 __attribute__((ext_vector_type(2)));
                            float o[4];
#pragma unroll
                            for (int q = 0; q < 2; ++q) {
                                f32x2 gt = (f32x2){v0[2 * q], v0[2 * q + 1]} + (f32x2){b0[2 * q], b0[2 * q + 1]};
                                f32x2 ln = (f32x2){v1[2 * q], v1[2 * q + 1]} + (f32x2){b1[2 * q], b1[2 * q + 1]};
                                gt.x = __builtin_amdgcn_fmed3f(gt.x, -INFINITY, 7.0f); gt.y = __builtin_amdgcn_fmed3f(gt.y, -INFINITY, 7.0f);
                                ln.x = __builtin_amdgcn_fmed3f(ln.x, -7.0f, 7.0f); ln.y = __builtin_amdgcn_fmed3f(ln.y, -7.0f, 7.0f);
                                const f32x2 t = gt * (-1.702f * 1.4426950408889634f);
                                f32x2 e; e.x = __builtin_amdgcn_exp2f(t.x); e.y = __builtin_amdgcn_exp2f(t.y);
                                const f32x2 d = e + 1.0f;
                                f32x2 r; r.x = __builtin_amdgcn_rcpf(d.x); r.y = __builtin_amdgcn_rcpf(d.y);
                                const f32x2 ov = (gt * r) * (ln + 1.0f);
                                o[2 * q] = ov.x; o[2 * q + 1] = ov.y;
                            }
                            *(PG8_LAS unsigned*)(tile + tr * 144 + jl) = pk4_fp8(o[0], o[1], o[2], o[3]);
                        };
                    auto fl = [=](const pg8::Unit& u, const G1Ctx&, int ai, int m0, int tid_, PG8_LAS unsigned char* tile) {
                            const int tr = tid_ >> 3, piece = tid_ & 7;
                            const u32x4 v = *(const PG8_LAS u32x4*)(tile + tr * 144 + piece * 16);
                            const int row = u.pm * 256 + ai * 128 + ((tr >> 4) & 1) * 64 + (m0 + (tr >> 5)) * 16 + (tr & 15);
                            *(u32x4*)(ACT + (size_t)row * D + u.pn * 128 + piece * 16) = v;
                        };
                    pg8::gemm_phase<true, true>(tid, (PG8_LAS unsigned char*)lds, pg8::Gemm{(const bf16_t*)HB8, (const bf16_t*)W_GU, 512, 512, 512}, so, pg8::make_epi_staged<2, 9216>(pre, f, fl), stg, LDS_CTX_OFF);
                }
            } else {
                {
                    MoeOrder so; so.go.init(total_rows >> 8, 4, G, vb); so.pst = pst; so.NT = 4; so.ebase = layer * 32; so.el_slot = EL_SLOT;
                    struct G2Ctx { float gate[8]; int slot[8]; f32x4 bb[2][2]; };
                    auto pre = [=](const pg8::Unit& u, int wr, int wc, int fr, int fq, const PG8_LAS unsigned char* cxl) {
                            G2Ctx cx;
                            const int ro0 = u.pm * 256 - pst[u.aux], cnt = pst[64 + u.aux];
#pragma unroll
                            for (int q = 0; q < 8; ++q) { const int rl = (q >> 2) * 128 + wr * 64 + (q & 3) * 16 + fr; const bool ok = ro0 + rl < cnt;
                                const float gv = *(const PG8_LAS float*)(cxl + 1024 + rl * 4); const int sv = *(const PG8_LAS int*)(cxl + 2048 + rl * 4);
                                cx.gate[q] = ok ? gv : 0.f; cx.slot[q] = ok ? sv : -1; }
#pragma unroll
                            for (int bj = 0; bj < 2; ++bj)
#pragma unroll
                                for (int h = 0; h < 2; ++h) cx.bb[bj][h] = *(const PG8_LAS f32x4*)(cxl + (bj * 128 + wc * 32 + 8 * fq + 4 * h) * 4);
                            return cx; };
                    auto stg = [=](const pg8::Unit& u, PG8_LAS unsigned char* cb, int wid, int lane) {
                            const size_t eo = (size_t)u.aux * T + (u.pm * 256 - pst[u.aux]) + lane * 4;
                            if (wid == 0) __builtin_amdgcn_global_load_lds((const unsigned*)(bdn_all + (size_t)(layer * 32 + u.aux) * 1024 + u.pn * 256 + lane * 4), (PG8_LAS unsigned*)cb, 16, 0, 0);
                            else if (wid == 1) __builtin_amdgcn_global_load_lds((const unsigned*)(EL_GATE + eo), (PG8_LAS unsigned*)(cb + 1024), 16, 0, 0);
                            else if (wid == 2) __builtin_amdgcn_global_load_lds((const unsigned*)(EL_SLOT + eo), (PG8_LAS unsigned*)(cb + 2048), 16, 0, 0); };
                    auto f = [=](const pg8::Unit& u, const G2Ctx& cx, int ai, int m, int bj, int r, int c8, f32x4 v0, f32x4 v1) {
                            const int slot = cx.slot[ai * 4 + m];
                            if (slot >= 0) {
                                const float gt = cx.gate[ai * 4 + m] * 16.0f; const f32x4 b0 = cx.bb[bj][0], b1 = cx.bb[bj][1];
                                u32x2 o; o.x = pk4_fp8((v0.x + b0.x) * gt, (v0.y + b0.y) * gt, (v0.z + b0.z) * gt, (v0.w + b0.w) * gt);
                                o.y = pk4_fp8((v1.x + b1.x) * gt, (v1.y + b1.y) * gt, (v1.z + b1.z) * gt, (v1.w + b1.w) * gt);
                                *(u32x2*)(Y + (size_t)slot * D + u.pn * 256 + c8) = o;
                            }
                        };
                    pg8::gemm_phase<true, false, true>(tid, (PG8_LAS unsigned char*)lds, pg8::Gemm{(const bf16_t*)ACT, (const bf16_t*)W_DN, 512, 512, 512}, so, pg8::make_epi_perm(pre, f), stg, LDS_CTX_OFF);
                }
            }
        }
        else if (ph == 13) {
            {
                DenseOrder so; so.go.init(T / 256, 6, G, vb);
                auto f = [=](const pg8::Unit& u, const pg8::NoCtx&, int ai, int m, int bj, int r, int c, f32x4 v0, f32x4 v1) {
                        const int row = u.pm * 256 + r, col = u.pn * 256 + c;
                        if (col >= 512) { v0.x = gelu_tanh(v0.x); v0.y = gelu_tanh(v0.y); v0.z = gelu_tanh(v0.z); v0.w = gelu_tanh(v0.w); v1.x = gelu_tanh(v1.x); v1.y = gelu_tanh(v1.y); v1.z = gelu_tanh(v1.z); v1.w = gelu_tanh(v1.w); }
                        u32x4 o; o.x = pk2(v0.x, v0.y); o.y = pk2(v0.z, v0.w); o.z = pk2(v1.x, v1.y); o.w = pk2(v1.z, v1.w);
                        *(u32x4*)(Z + (size_t)row * 1536 + col) = o;
                    };
                pg8::gemm_phase<false, false, true>(tid, (PG8_LAS unsigned char*)lds, pg8::Gemm{HB, W_IN_O, D, D, D}, so, pg8::make_epi_perm(pg8::NoPre{}, f));
            }
        }
        else if (ph == 14) {
            for (int ck = vb; ck < T / 128; ck += G) {
                bf16_t* tile = (bf16_t*)lds;
                {
                    const int ch0 = lane * 8, w = 2 << (ch0 >> 7);
                    const int row0 = ck * 128 + wave * 16, t0 = row0 % S;
                    float gsg[8];
#pragma unroll
                    for (int i = 0; i < 8; ++i) gsg[i] = kp->sgu_norm_g[lane * 8 + i];
                    float run[8];
#pragma unroll
                    for (int i = 0; i < 8; ++i) run[i] = 0.f;
                    for (int q = 1; q <= w; ++q) {
                        if (t0 - q >= 0) { float f[8]; unpack8(*(const u32x4*)(Z + (size_t)(row0 - q) * 1536 + ch0), f);
#pragma unroll
                            for (int i = 0; i < 8; ++i) run[i] += f[i]; }
                    }
                    u32x4 cu, cl, cz, nu, nl, nz;
#define P14_LOAD(r_, t_, U_, L_, Z_) do { U_ = *(const u32x4*)(Z + (size_t)(r_) * 1536 + ch0); L_ = ((t_) - w >= 0) ? *(const u32x4*)(Z + (size_t)((r_) - w) * 1536 + ch0) : (u32x4){0u, 0u, 0u, 0u}; \
                        Z_ = *(const u32x4*)(Z + (size_t)(r_) * 1536 + 1024 + lane * 8); } while (0)
                    P14_LOAD(row0, t0, cu, cl, cz);
                    for (int tt = 0; tt < 16; ++tt) {
                        const int sl = wave * 16 + tt, row = row0 + tt, t = t0 + tt;
                        if (tt + 1 < 16) P14_LOAD(row + 1, t + 1, nu, nl, nz);
                        float own[8], old[8];
                        unpack8(cu, own); unpack8(cl, old);
#pragma unroll
                        for (int i = 0; i < 8; ++i) run[i] += own[i] - old[i];
                        const int n = (t + 1 < w) ? t + 1 : w;
                        const float inv = 1.0f / (float)n;
                        float po[8];
#pragma unroll
                        for (int i = 0; i < 8; ++i) po[i] = run[i] * inv - own[i];
                        *(u32x4*)(POOLED + (size_t)row * 512 + ch0) = pack8(po);
                        float f[8]; unpack8(cz, f);
                        float ss = 0.f;
#pragma unroll
                        for (int i = 0; i < 8; ++i) ss += f[i] * f[i];
                        const float rr = rsqrtf(wave_sum(ss) * (1.f / 512.f) + 1e-6f);
#pragma unroll
                        for (int i = 0; i < 8; ++i) f[i] *= rr * gsg[i];
                        *(u32x4*)(tile + sl * 520 + lane * 8) = pack8(f);
                        cu = nu; cl = nl; cz = nz;
                    }
#undef P14_LOAD
                }
                __syncthreads();
                {
                    const int ch = tid;
                    bf16_t* dst = VTS + ((size_t)ck * 512 + ch) * 128;
                    for (int s8 = 0; s8 < 16; ++s8) {
                        unsigned w[4];
#pragma unroll
                        for (int i = 0; i < 4; ++i) w[i] = (unsigned)tile[(s8 * 8 + 2 * i) * 520 + ch] | ((unsigned)tile[(s8 * 8 + 2 * i + 1) * 520 + ch] << 16);
                        u32x4 o; o.x = w[0]; o.y = w[1]; o.z = w[2]; o.w = w[3];
                        *(u32x4*)(dst + s8 * 8) = o;
                    }
                }
                asm volatile("s_waitcnt vmcnt(0)" ::: "memory");
                __syncthreads();
                sg128_stream(tid, lds, 0, 1, 8,
                    [=](int q8, const bf16_t*& A, int& lda, const bf16_t*& Bt, int& ldb) {
                        if (q8 < 4) { A = POOLED + (size_t)ck * 128 * 512 + q8 * 128; lda = 512; Bt = W_POOL + (size_t)q8 * 128 * 128; ldb = 128; }
                        else { const int h4 = q8 - 4; A = W_SGU + (size_t)h4 * 128 * 128; lda = 128; Bt = VTS + ((size_t)ck * 512 + h4 * 128) * 128; ldb = 128; } },
                    [=](int q8, int rb, int c, Sg128Side& sd) {
#pragma unroll
                        for (int m = 0; m < 4; ++m) {
                            if (q8 < 4) { sd.b[m] = 0.f; sd.a[m][0] = (u32x2){0u, 0u}; sd.a[m][1] = (u32x2){0u, 0u}; }
                            else { const int h4 = q8 - 4, r = rb + 16 * m; sd.b[m] = sgub[h4 * 128 + r];
                                sd.a[m][0] = *(const u32x2*)(Z + (size_t)(ck * 128 + r) * 1536 + 512 + h4 * 128 + c); sd.a[m][1] = *(const u32x2*)(Z + (size_t)(ck * 128 + r) * 1536 + 512 + h4 * 128 + c + 16); }
                        } },
                    [=](int q8, int m, int r, int c, f32x4 v0, f32x4 v1, const Sg128Side& sd) {
                        const int row = ck * 128 + r;
                        if (q8 < 4) {
                            const int gi = q8;
#pragma unroll
                            for (int h = 0; h < 2; ++h) {
                                const int col = gi * 128 + c + 16 * h; const f32x4 v = h ? v1 : v0;
                                const f32x4 sc = *(const f32x4*)(poolsc + col);
                                u32x2 o; o.x = pk2(v.x * sc.x, v.y * sc.y); o.y = pk2(v.z * sc.z, v.w * sc.w);
                                *(u32x2*)(MIXIN + (size_t)row * 1024 + col) = o;
                            }
                        } else {
                            const int h4 = q8 - 4; const float bias = sd.b[m];
#pragma unroll
                            for (int h = 0; h < 2; ++h) {
                                const int dcol = c + 16 * h; const f32x4 v = h ? v1 : v0; const u32x2 ug = sd.a[m][h];
                                u32x2 o; o.x = pk2((v.x + bias) * __uint_as_float(ug.x << 16), (v.y + bias) * __uint_as_float(ug.x & 0xffff0000u));
                                o.y = pk2((v.z + bias) * __uint_as_float(ug.y << 16), (v.w + bias) * __uint_as_float(ug.y & 0xffff0000u));
                                *(u32x2*)(MIXIN + (size_t)row * 1024 + 512 + h4 * 128 + dcol) = o;
                            }
                        } });
                __syncthreads();
            }
        }

    }
}
template <int PH> struct PhaseSeq {
    static __device__ __forceinline__ void run(const XcdBarrier& bar) { PhaseSeq<PH - 1>::run(bar); if constexpr (PH == 3 || PH == 15) return;
        unsigned long long t0_ = 0; if constexpr (PH == PROBE_TPH) t0_ = __builtin_amdgcn_s_memrealtime();
        phase_body<PH>(bar.wbase);
        if constexpr (((PROBE_DUP_MASK >> PH) & 1ull) != 0) { xcd_barrier(bar); phase_body<PH>(bar.wbase); }
        if (PH + 1 < NPHASE) { xcd_barrier(bar); if constexpr (PROBE_BAR2) xcd_barrier(bar); }
        if constexpr (PH == PROBE_TPH) { if (bar.wbase == 0 && lane_id() == 0) { const unsigned dt = (unsigned)(__builtin_amdgcn_s_memrealtime() - t0_); bar.st[4] = dt; } }
    }
};
template <> struct PhaseSeq<-1> { static __device__ __forceinline__ void run(const XcdBarrier&) {} };

template <int PHSEL> __global__ void __launch_bounds__(NTHR, 2) hybrid_fwd(Params p) {
    extern __shared__ __attribute__((aligned(16))) unsigned char lds[];
    const int tid0 = threadIdx.x;
    for (int u = tid0; u < (LDS_BYTES - LDS_MISC) / 4; u += NTHR) ((unsigned*)(lds + LDS_MISC))[u] = 0u;
    __syncthreads();
    if constexpr (PHSEL >= 0) { phase_body<PHSEL>(__builtin_amdgcn_readfirstlane((int)threadIdx.x & ~63)); }
    else {
        volatile LAS unsigned* MISC = (volatile LAS unsigned*)((LAS unsigned char*)lds + LDS_MISC);
        unsigned* ctl0 = (unsigned*)(p.ws + WS_CTL);
        XcdBarrier bar = xcd_barrier_post(ctl0 + CW_BAR, MISC + 8);
        PhaseSeq<NPHASE - 1>::run(bar);
        if constexpr (PROBE_TPH >= 0 || PROBE_SEG != 0) { if (blockIdx.x == 0 && bar.wbase == 0 && lane_id() == 0) { const unsigned dt = MISC[12]; const unsigned long long te = __builtin_amdgcn_s_memrealtime(); while (__builtin_amdgcn_s_memrealtime() - te < 4ull * dt) __builtin_amdgcn_s_sleep(8); } }
    }
}

typedef void (*kfn_t)(Params);
template <int PH> struct Tab { static void fill(kfn_t* t) { t[PH] = hybrid_fwd<PH>; Tab<PH - 1>::fill(t); } };
template <> struct Tab<-1> { static void fill(kfn_t*) {} };
static kfn_t g_tab[NPHASE];
static void set_attrs() {
#if MK_ONE_LAUNCH
    (void)hipFuncSetAttribute((const void*)hybrid_fwd<-1>, hipFuncAttributeMaxDynamicSharedMemorySize, LDS_BYTES);
#else
    Tab<NPHASE - 1>::fill(g_tab);
    for (int i = 0; i < NPHASE; ++i) (void)hipFuncSetAttribute((const void*)g_tab[i], hipFuncAttributeMaxDynamicSharedMemorySize, LDS_BYTES);
#endif
}
#if !MK_ONE_LAUNCH
static void launch_all(const Params& p, int grid, hipStream_t stream) {
    for (int ph = 0; ph < NPHASE; ++ph) hipLaunchKernelGGL(g_tab[ph], dim3(grid), dim3(NTHR), LDS_BYTES, stream, p);
}
#endif
extern "C" void kernel_launch(void* const* d_in, const int* in_sizes, int n_in, void* d_out, int out_size, void* d_ws, size_t ws_size, hipStream_t stream) {
    static int ready = 0;
    if (ready == 0) {
        if (n_in != 38 || ws_size < WS_END) { fprintf(stderr, "kernel_launch: unexpected n_in %d / ws %zu\n", n_in, ws_size); ready = -1; return; }
        set_attrs();
        ready = 1;
    }
    if (ready < 0) return;
    (void)hipMemsetAsync((char*)d_ws + WS_CTL, 0, CTL_ZERO_BYTES, stream);
    Params p{};
    const float** fp = (const float**)&p.x;
    (void)fp;
    p.x = (const float*)d_in[0]; p.c = (const float*)d_in[1]; p.pos = (const int*)d_in[2];
    p.ada_w = (const float*)d_in[3]; p.ada_b = (const float*)d_in[4]; p.norm_mix_g = (const float*)d_in[5]; p.norm_ffn_g = (const float*)d_in[6];
    p.router_w = (const float*)d_in[7]; p.router_b = (const float*)d_in[8]; p.moe_w_gu = (const float*)d_in[9]; p.moe_b_gu = (const float*)d_in[10];
    p.moe_w_dn = (const float*)d_in[11]; p.moe_b_dn = (const float*)d_in[12];
    p.even_w_in = (const float*)d_in[13]; p.q_norm_g = (const float*)d_in[14]; p.w_uq = (const float*)d_in[15]; p.kv_norm_g = (const float*)d_in[16];
    p.w_ukv = (const float*)d_in[17]; p.q_head_g = (const float*)d_in[18]; p.k_head_g = (const float*)d_in[19];
    p.s5_a_re = (const float*)d_in[20]; p.s5_a_im = (const float*)d_in[21]; p.s5_log_dt = (const float*)d_in[22]; p.s5_b_re = (const float*)d_in[23];
    p.s5_b_im = (const float*)d_in[24]; p.s5_c_re = (const float*)d_in[25]; p.s5_c_im = (const float*)d_in[26]; p.s5_d = (const float*)d_in[27];
    p.s5_glu_w = (const float*)d_in[28]; p.s5_glu_b = (const float*)d_in[29]; p.even_w_out = (const float*)d_in[30];
    p.odd_w_in = (const float*)d_in[31]; p.pool_w = (const float*)d_in[32]; p.pool_scale = (const float*)d_in[33]; p.sgu_norm_g = (const float*)d_in[34];
    p.sgu_w = (const float*)d_in[35]; p.sgu_b = (const float*)d_in[36]; p.odd_w_out = (const float*)d_in[37];
    p.out = (float*)d_out; p.ws = (unsigned char*)d_ws;
    const int grid = 256;
#if MK_ONE_LAUNCH
    p.ph_lo = 0; p.ph_hi = NPHASE;
    hipLaunchKernelGGL(hybrid_fwd<-1>, dim3(grid), dim3(NTHR), LDS_BYTES, stream, p);
#else
    p.ph_lo = 0; p.ph_hi = 1;
    launch_all(p, grid, stream);
#endif
}
```
